# Optimizing an MI355X kernel written in HIP

```python
import jax, jax.numpy as jnp
from jax import lax
import numpy as np

D_MODEL = 1024
BATCH = 1
SEQ = 16384
DEPTH = 2

GRID_W = 64
CTX_LEN = 256
N_MIXERS = 4
MIX_W = D_MODEL
GROUP_W = MIX_W // N_MIXERS
EPS = 1e-6

POOL_WINDOWS = (2, 4, 8, 16)
POOL_CH = GROUP_W // len(POOL_WINDOWS)

MLA_HEADS = 4
MLA_NOPE = 64
MLA_ROPE = 32
MLA_QK = MLA_NOPE + MLA_ROPE
MLA_V = GROUP_W // MLA_HEADS
MLA_Q_RANK = 192
MLA_KV_RANK = 128
ROPE_BASE = 10000.0
Q_BLOCK = 128

SGU_HEADS = 4
SGU_HD = GROUP_W // SGU_HEADS
SGU_CHUNK = 128

LRU_HEADS = 4
LRU_HD = GROUP_W // LRU_HEADS
CONV_W = 4
CONV_LEFT = 1
LRU_C = 8.0

N_EXPERTS = 32
TOP_K = 4
D_EXPERT = D_MODEL
SWIGLU_LIMIT = 7.0
SWIGLU_ALPHA = 1.702
MOE_BLOCK = 256

COL_SIZES = (GROUP_W, MLA_Q_RANK, MLA_KV_RANK, MLA_ROPE, 2 * GROUP_W, GROUP_W, GROUP_W)
IN_COLS = sum(COL_SIZES)

kernel_name = 'hybrid_dit_parallel_groups'


def rms_norm(x, g):
    xf = x.astype(jnp.float32)
    y = xf * lax.rsqrt(jnp.mean(xf * xf, axis=-1, keepdims=True) + EPS)
    return (y * g.astype(jnp.float32)).astype(x.dtype)


def layer_norm(x, g, b):
    xf = x.astype(jnp.float32)
    mu = jnp.mean(xf, axis=-1, keepdims=True)
    var = jnp.mean(jnp.square(xf - mu), axis=-1, keepdims=True)
    y = (xf - mu) * lax.rsqrt(var + EPS)
    return (y * g.astype(jnp.float32) + b.astype(jnp.float32)).astype(x.dtype)


def modulate(h, shift, scale):
    return h * (1.0 + scale) + shift


def split_cols(p):
    idx, s = [], 0
    for z in COL_SIZES[:-1]:
        s += z
        idx.append(s)
    return jnp.split(p, idx, axis=-1)


def axial_rope_tables(rows):
    n_freq = MLA_ROPE // 4
    inv = ROPE_BASE ** (-jnp.arange(n_freq, dtype=jnp.float32) / n_freq)
    r = jnp.repeat(jnp.arange(rows, dtype=jnp.float32), GRID_W)
    col = jnp.tile(jnp.arange(GRID_W, dtype=jnp.float32), rows)
    ang = jnp.concatenate([r[:, None] * inv, col[:, None] * inv], axis=-1)
    return jnp.cos(ang), jnp.sin(ang)


def rope_tail(x, cos, sin):
    xn, xr = x[..., :MLA_NOPE], x[..., MLA_NOPE:]
    x1, x2 = jnp.split(xr, 2, axis=-1)
    cs = cos[None, :, None, :].astype(x.dtype)
    sn = sin[None, :, None, :].astype(x.dtype)
    return jnp.concatenate([xn, x1 * cs - x2 * sn, x1 * sn + x2 * cs], axis=-1)


def multiscale_pool(x, pool_w, pool_scale):
    B, N, _ = x.shape
    xf = x.astype(jnp.float32)
    csum = jnp.concatenate([jnp.zeros((B, 1, GROUP_W), jnp.float32), jnp.cumsum(xf, axis=1)], axis=1)
    t = jnp.arange(N)
    outs = []
    for g, w in enumerate(POOL_WINDOWS):
        lo = jnp.clip(t - w // 2, 0, N)
        hi = jnp.clip(t + w // 2, 0, N)
        cg = csum[..., g * POOL_CH:(g + 1) * POOL_CH]
        mean = (cg[:, hi] - cg[:, lo]) / (hi - lo).astype(jnp.float32)[:, None]
        diff = (mean - xf[..., g * POOL_CH:(g + 1) * POOL_CH]).astype(x.dtype)
        outs.append(diff @ pool_w[g])
    return jnp.concatenate(outs, axis=-1) * pool_scale


def mla_q(qa, q_a_norm, w_uq, q_norm):
    B, N, _ = qa.shape
    q = (rms_norm(qa, q_a_norm) @ w_uq).reshape(B, N, MLA_HEADS, MLA_QK)
    return rms_norm(q, q_norm)


def mla_kv(kva, kr, kv_a_norm, w_ukv, k_norm):
    B, N, _ = kva.shape
    kv = (rms_norm(kva, kv_a_norm) @ w_ukv).reshape(B, N, MLA_HEADS, MLA_NOPE + MLA_V)
    k_rope = jnp.broadcast_to(kr[:, :, None, :], (B, N, MLA_HEADS, MLA_ROPE))
    k = jnp.concatenate([kv[..., :MLA_NOPE], k_rope], axis=-1)
    return rms_norm(k, k_norm), kv[..., MLA_NOPE:]


def block_attention(q, k, v):
    B, Nq, H, dq = q.shape
    nb = Nq // Q_BLOCK
    qb = q.reshape(B, nb, Q_BLOCK, H, dq).transpose(1, 0, 2, 3, 4)
    scale = dq ** -0.5

    def one_block(qblk):
        s = jnp.einsum('bqhd,bkhd->bhqk', qblk, k).astype(jnp.float32) * scale
        p = jax.nn.softmax(s, axis=-1).astype(v.dtype)
        return jnp.einsum('bhqk,bkhd->bqhd', p, v)

    o = lax.map(one_block, qb)
    return o.transpose(1, 0, 2, 3, 4).reshape(B, Nq, H * v.shape[-1])


def chunk_sgu(z, norm_g, norm_b, ws, bs):
    B, N, _ = z.shape
    z = jax.nn.gelu(z)
    u, v = jnp.split(z, 2, axis=-1)
    v = layer_norm(v, norm_g, norm_b)
    nc = N // SGU_CHUNK
    v = v.reshape(B, nc, SGU_CHUNK, SGU_HEADS, SGU_HD)
    v = jnp.einsum('hpq,bcqhd->bcphd', ws, v) + bs.T[None, None, :, :, None]
    return u * v.reshape(B, N, GROUP_W)


def centred_dwconv(x, w, b):
    n = x.shape[1]
    xp = jnp.pad(x, ((0, 0), (CONV_LEFT, CONV_W - 1 - CONV_LEFT), (0, 0)))
    out = b
    for k in range(CONV_W):
        out = out + xp[:, k:k + n] * w[k]
    return out


def rglru_coeffs(x, wa, ba, wx, bx, lam):
    B, N, _ = x.shape
    xf = x.astype(jnp.float32)
    xh = xf.reshape(B, N, LRU_HEADS, LRU_HD)
    r = jax.nn.sigmoid(jnp.einsum('bnhi,hij->bnhj', xh, wa.astype(jnp.float32)).reshape(B, N, GROUP_W) + ba)
    i = jax.nn.sigmoid(jnp.einsum('bnhi,hij->bnhj', xh, wx.astype(jnp.float32)).reshape(B, N, GROUP_W) + bx)
    log_a = -LRU_C * r * jax.nn.softplus(-lam.astype(jnp.float32))
    a = jnp.exp(log_a)
    drive = jnp.sqrt(-jnp.expm1(2.0 * log_a)) * (i * xf)
    return a, drive


def _combine(e1, e2):
    a1, b1 = e1
    a2, b2 = e2
    return a1 * a2, a2 * b1 + b2


def linear_scan(a, b, h0, reverse):
    a_cum, h = lax.associative_scan(_combine, (a, b), reverse=reverse, axis=1)
    if h0 is not None:
        h = h + a_cum * h0[:, None, :]
    return h


def rglru_mixer(x_lat, gate_lat, x_ctx, gate_ctx, conv_w, conv_b, wa, ba, wx, bx, lam, need_ctx):
    xl = centred_dwconv(x_lat, conv_w, conv_b)
    xc = centred_dwconv(x_ctx, conv_w, conv_b)
    h_lat, h_ctx = [], []
    for d, rev in enumerate((False, True)):
        a_c, b_c = rglru_coeffs(xc, wa[d], ba[d], wx[d], bx[d], lam[d])
        hc = linear_scan(a_c, b_c, None, rev)
        h_end = hc[:, 0] if rev else hc[:, -1]
        a_l, b_l = rglru_coeffs(xl, wa[d], ba[d], wx[d], bx[d], lam[d])
        h_lat.append(linear_scan(a_l, b_l, h_end, rev))
        if need_ctx:
            h_ctx.append(hc)
    y_lat = jax.nn.gelu(gate_lat) * (h_lat[0] + h_lat[1]).astype(gate_lat.dtype)
    y_ctx = jax.nn.gelu(gate_ctx) * (h_ctx[0] + h_ctx[1]).astype(gate_ctx.dtype) if need_ctx else None
    return y_lat, y_ctx


def moe_ffn(h, router_w, router_b, w_gu, b_gu, w_down, b_down):
    T, D = h.shape
    logits = (h @ router_w + router_b).astype(jnp.float32)
    top_v, top_e = lax.top_k(logits, TOP_K)
    gates = jax.nn.softmax(top_v, axis=-1)
    n_assign = T * TOP_K
    e_flat = top_e.reshape(-1)
    tok_flat = jnp.arange(n_assign, dtype=jnp.int32) // TOP_K
    order = jnp.argsort(e_flat)
    e_sorted = e_flat[order]
    counts = jnp.zeros((N_EXPERTS,), jnp.int32).at[e_flat].add(1)
    starts = jnp.cumsum(counts) - counts
    padded = (counts + MOE_BLOCK - 1) // MOE_BLOCK * MOE_BLOCK
    pad_end = jnp.cumsum(padded)
    pad_start = pad_end - padded
    dest = pad_start[e_sorted] + jnp.arange(n_assign, dtype=jnp.int32) - starts[e_sorted]
    n_blocks = (n_assign + N_EXPERTS * (MOE_BLOCK - 1) + MOE_BLOCK - 1) // MOE_BLOCK
    n_rows = n_blocks * MOE_BLOCK
    row_tok = jnp.full((n_rows,), T, jnp.int32).at[dest].set(tok_flat[order])
    row_gate = jnp.zeros((n_rows,), jnp.float32).at[dest].set(gates.reshape(-1)[order])
    block_e = jnp.minimum(jnp.searchsorted(pad_end, jnp.arange(n_blocks, dtype=jnp.int32) * MOE_BLOCK, side='right'), N_EXPERTS - 1)
    h_pad = jnp.concatenate([h, jnp.zeros((1, D), h.dtype)], axis=0)
    xs = h_pad[row_tok].reshape(n_blocks, MOE_BLOCK, D)

    def expert_block(args):
        xb, e = args
        gu = xb @ w_gu[e] + b_gu[e]
        g, u = jnp.split(gu, 2, axis=-1)
        g = jnp.minimum(g, SWIGLU_LIMIT)
        u = jnp.clip(u, -SWIGLU_LIMIT, SWIGLU_LIMIT)
        act = (u + 1.0) * (g * jax.nn.sigmoid(SWIGLU_ALPHA * g))
        return act @ w_down[e] + b_down[e]

    ys = lax.map(expert_block, (xs, block_e)).reshape(n_rows, D)
    out = jnp.zeros((T + 1, D), h.dtype).at[row_tok].add(ys * row_gate[:, None].astype(h.dtype))
    return out[:T]


def setup_inputs(seed: int = 0) -> dict:
    key = jax.random.key(seed)
    ks = iter(jax.random.split(key, 48))

    def nrm(shape, scale):
        return jax.random.normal(next(ks), shape, jnp.float32) * scale

    def gain(shape):
        return 1.0 + nrm(shape, 0.02)

    L, D, E, F = DEPTH, D_MODEL, N_EXPERTS, D_EXPERT
    u = jax.random.uniform(next(ks), (L, 2, GROUP_W), jnp.float32, 0.9, 0.999)
    a0 = u ** (1.0 / LRU_C)
    return {
        'x': nrm((BATCH, SEQ, D), 1.0),
        'c': nrm((BATCH, D), 1.0),
        'ctx': nrm((BATCH, CTX_LEN, D), 1.0),
        'c_ctx': nrm((D,), 1.0),
        'w_mod': nrm((L, D, 6 * D), 0.5 * D ** -0.5),
        'b_mod': nrm((L, 6 * D), 0.02),
        'norm_mix': gain((L, D)),
        'norm_ffn': gain((L, D)),
        'w_in': nrm((L, D, IN_COLS), D ** -0.5),
        'w_out': nrm((L, MIX_W, D), MIX_W ** -0.5),
        'pool_w': nrm((L, len(POOL_WINDOWS), POOL_CH, POOL_CH), POOL_CH ** -0.5),
        'pool_scale': gain((L, GROUP_W)),
        'mla_q_a_norm': gain((L, MLA_Q_RANK)),
        'mla_w_uq': nrm((L, MLA_Q_RANK, MLA_HEADS * MLA_QK), MLA_Q_RANK ** -0.5),
        'mla_kv_a_norm': gain((L, MLA_KV_RANK)),
        'mla_w_ukv': nrm((L, MLA_KV_RANK, MLA_HEADS * (MLA_NOPE + MLA_V)), MLA_KV_RANK ** -0.5),
        'mla_q_norm': gain((L, MLA_QK)),
        'mla_k_norm': gain((L, MLA_QK)),
        'sgu_norm_g': gain((L, GROUP_W)),
        'sgu_norm_b': nrm((L, GROUP_W), 0.02),
        'sgu_ws': nrm((L, SGU_HEADS, SGU_CHUNK, SGU_CHUNK), SGU_CHUNK ** -0.5),
        'sgu_b': gain((L, SGU_HEADS, SGU_CHUNK)),
        'lru_conv_w': nrm((L, CONV_W, GROUP_W), CONV_W ** -0.5),
        'lru_conv_b': nrm((L, GROUP_W), 0.02),
        'lru_wa': nrm((L, 2, LRU_HEADS, LRU_HD, LRU_HD), LRU_HD ** -0.5),
        'lru_ba': nrm((L, 2, GROUP_W), 0.02),
        'lru_wx': nrm((L, 2, LRU_HEADS, LRU_HD, LRU_HD), LRU_HD ** -0.5),
        'lru_bx': nrm((L, 2, GROUP_W), 0.02),
        'lru_lambda': jnp.log(a0) - jnp.log1p(-a0),
        'router_w': nrm((L, D, E), D ** -0.5),
        'router_b': nrm((L, E), 0.01),
        'moe_w_gu': nrm((L, E, D, 2 * F), D ** -0.5),
        'moe_b_gu': nrm((L, E, 2 * F), 0.02),
        'moe_w_down': nrm((L, E, F, D), F ** -0.5),
        'moe_b_down': nrm((L, E, D), 0.02),
    }


def reference(x, c, ctx, c_ctx, w_mod, b_mod, norm_mix, norm_ffn, w_in, w_out, pool_w, pool_scale,
              mla_q_a_norm, mla_w_uq, mla_kv_a_norm, mla_w_ukv, mla_q_norm, mla_k_norm,
              sgu_norm_g, sgu_norm_b, sgu_ws, sgu_b,
              lru_conv_w, lru_conv_b, lru_wa, lru_ba, lru_wx, lru_bx, lru_lambda,
              router_w, router_b, moe_w_gu, moe_b_gu, moe_w_down, moe_b_down):
    B, N, D = x.shape
    rows = N // GRID_W
    cos, sin = axial_rope_tables(rows)
    lat, cx = x, ctx
    for l in range(DEPTH):
        need_ctx = l < DEPTH - 1
        mod_lat = jnp.split(jax.nn.silu(c) @ w_mod[l] + b_mod[l], 6, axis=-1)
        mod_ctx = jnp.split(jax.nn.silu(c_ctx) @ w_mod[l] + b_mod[l], 6, axis=-1)
        sh1, sc1, g1, sh2, sc2, g2 = [m[:, None, :] for m in mod_lat]
        csh1, csc1, cg1, csh2, csc2, cg2 = mod_ctx

        h_lat = modulate(rms_norm(lat, norm_mix[l]), sh1, sc1)
        h_ctx = modulate(rms_norm(cx, norm_mix[l]), csh1, csc1)
        p_lat = split_cols(h_lat @ w_in[l])
        p_ctx = split_cols(h_ctx @ w_in[l])

        a_lat = multiscale_pool(p_lat[0], pool_w[l], pool_scale[l])

        k_l, v_l = mla_kv(p_lat[2], p_lat[3], mla_kv_a_norm[l], mla_w_ukv[l], mla_k_norm[l])
        k_c, v_c = mla_kv(p_ctx[2], p_ctx[3], mla_kv_a_norm[l], mla_w_ukv[l], mla_k_norm[l])
        q_l = rope_tail(mla_q(p_lat[1], mla_q_a_norm[l], mla_w_uq[l], mla_q_norm[l]), cos, sin)
        k_l = rope_tail(k_l, cos, sin)
        b_lat = block_attention(q_l, jnp.concatenate([k_c, k_l], axis=1), jnp.concatenate([v_c, v_l], axis=1))

        c_lat = chunk_sgu(p_lat[4], sgu_norm_g[l], sgu_norm_b[l], sgu_ws[l], sgu_b[l])

        d_lat, d_ctx = rglru_mixer(p_lat[5], p_lat[6], p_ctx[5], p_ctx[6], lru_conv_w[l], lru_conv_b[l],
                                   lru_wa[l], lru_ba[l], lru_wx[l], lru_bx[l], lru_lambda[l], need_ctx)

        y_lat = jnp.concatenate([a_lat, b_lat, c_lat, d_lat], axis=-1) @ w_out[l]
        lat = lat + g1 * y_lat
        if need_ctx:
            a_ctx = multiscale_pool(p_ctx[0], pool_w[l], pool_scale[l])
            q_c = mla_q(p_ctx[1], mla_q_a_norm[l], mla_w_uq[l], mla_q_norm[l])
            b_ctx = block_attention(q_c, k_c, v_c)
            c_ctx_out = chunk_sgu(p_ctx[4], sgu_norm_g[l], sgu_norm_b[l], sgu_ws[l], sgu_b[l])
            y_ctx = jnp.concatenate([a_ctx, b_ctx, c_ctx_out, d_ctx], axis=-1) @ w_out[l]
            cx = cx + cg1 * y_ctx

        f_in = modulate(rms_norm(lat, norm_ffn[l]), sh2, sc2).reshape(B * N, D)
        if need_ctx:
            f_in_ctx = modulate(rms_norm(cx, norm_ffn[l]), csh2, csc2).reshape(B * CTX_LEN, D)
            f_in = jnp.concatenate([f_in, f_in_ctx], axis=0)
        f = moe_ffn(f_in, router_w[l], router_b[l], moe_w_gu[l], moe_b_gu[l], moe_w_down[l], moe_b_down[l])
        lat = lat + g2 * f[:B * N].reshape(B, N, D)
        if need_ctx:
            cx = cx + cg2 * f[B * N:].reshape(B, CTX_LEN, D)
    return lat
```

```cpp
#include <hip/hip_runtime.h>
#include <hip/hip_cooperative_groups.h>
#include <cstdio>
#include <cstdint>
namespace cg = cooperative_groups;

#define DEVI __device__ __forceinline__
constexpr int NTHR = 512;
constexpr int D = 1024, NLAT = 16384, NCTX = 256, T = NLAT + NCTX, NLAYER = 2;
constexpr int INC = 1632;
constexpr int OFF_A = 0, OFF_Q = 256, OFF_KV = 448, OFF_KR = 576, OFF_C = 608, OFF_DX = 1120, OFF_DG = 1376;
constexpr int NCHUNK = T / 128;
constexpr int NEXP = 32, TOPK = 4;
constexpr int MAXROWS = T * TOPK + NEXP * 128;
constexpr float EPS = 1e-6f;

enum { I_X = 0, I_C, I_CTX, I_CCTX, I_WMOD, I_BMOD, I_NMIX, I_NFFN, I_WIN, I_WOUT, I_POOLW, I_POOLS, I_QAN, I_WUQ, I_KVAN, I_WUKV,
       I_QN, I_KN, I_SGG, I_SGB, I_SGWS, I_SGBS, I_CONVW, I_CONVB, I_WA, I_BA, I_WX, I_BX, I_LAM, I_RW, I_RB, I_WGU, I_BGU, I_WDN, I_BDN, N_IN };

constexpr size_t al(size_t x) { return (x + 63) / 64 * 64; }
constexpr size_t W_X = 0;
constexpr size_t W_MOD = W_X + al((size_t)T * D);
constexpr size_t W_H = W_MOD + al(2 * 2 * 6144);
constexpr size_t W_P = W_H + al((size_t)T * D);
constexpr size_t W_YC = W_P + al((size_t)T * INC);
constexpr size_t W_Q = W_YC + al((size_t)T * D);
constexpr size_t W_K = W_Q + al((size_t)T * 384);
constexpr size_t W_V = W_K + al((size_t)T * 384);
constexpr size_t W_DIFF = W_V + al((size_t)T * 256);
constexpr size_t W_QN = W_DIFF + al((size_t)T * 256);
constexpr size_t W_KVN = W_QN + al((size_t)T * 192);
constexpr size_t W_U = W_KVN + al((size_t)T * 128);
constexpr size_t W_VN = W_U + al((size_t)T * 256);
constexpr size_t W_XC = W_VN + al((size_t)T * 256);
constexpr size_t W_QUP = W_XC + al((size_t)T * 256);
constexpr size_t W_KVUP = W_QUP + al((size_t)T * 384);
constexpr size_t W_LA = W_KVUP + al((size_t)T * 512);
constexpr size_t W_LB = W_LA + al((size_t)2 * T * 256);
constexpr size_t W_AGG = W_LB + al((size_t)2 * T * 256);
constexpr size_t W_CARRY = W_AGG + al((size_t)NCHUNK * 2 * 2 * 256);
constexpr size_t W_TOPE = W_CARRY + al((size_t)NCHUNK * 2 * 256);
constexpr size_t W_TOPG = W_TOPE + al((size_t)T * 4);
constexpr size_t W_TOPI = W_TOPG + al((size_t)T * 4);
constexpr size_t W_CNT = W_TOPI + al((size_t)T * 4);
constexpr size_t W_LIST = W_CNT + al(64);
constexpr size_t W_ACT = W_LIST + al((size_t)NEXP * T);
constexpr size_t W_YR = W_ACT + al((size_t)MAXROWS * D);
constexpr size_t W_END = W_YR + al((size_t)MAXROWS * D);

struct Params {
    const float* in[N_IN];
    float* out;
    float* ws;
};

DEVI int tid_() { int t = threadIdx.x; asm volatile("" : "+v"(t)); return t; }
DEVI int bid_() { int b = blockIdx.x; asm volatile("" : "+s"(b)); return b; }
DEVI float wave_sum(float v) {
#pragma unroll
    for (int o = 32; o > 0; o >>= 1) v += __shfl_xor(v, o);
    return v;
}
DEVI float gelu_tanh(float x) { const float u = 0.7978845608028654f * (x + 0.044715f * x * x * x); return 0.5f * x * (1.f + tanhf(u)); }
DEVI float sigm(float x) { return 1.f / (1.f + expf(-x)); }
DEVI float silu(float x) { return x * sigm(x); }

template <class ARow, class BMap, class Epi>
DEVI void gemm_tile(int K, ARow arow, const float* __restrict__ B, int ldb, BMap bmap, Epi epi, float* smem) {
    float (*As)[132] = (float (*)[132])smem;
    float (*Bs)[64] = (float (*)[64])(smem + 16 * 132);
    const int tid = tid_(), ty = tid >> 4, tx = tid & 15;
    float acc[4][4];
#pragma unroll
    for (int i = 0; i < 4; ++i)
#pragma unroll
        for (int j = 0; j < 4; ++j) acc[i][j] = 0.f;
    const int ar = tid >> 2, akq = tid & 3;
    const float* ap = arow(ar);
    const int bk0 = tid >> 6, bc = tid & 63;
    const int bcol = bmap(bc);
    for (int k0 = 0; k0 < K; k0 += 16) {
        float4 av = make_float4(0.f, 0.f, 0.f, 0.f);
        if (ap) av = *(const float4*)(ap + k0 + akq * 4);
        float b0 = 0.f, b1 = 0.f;
        if (bcol >= 0) { b0 = B[(size_t)(k0 + bk0) * ldb + bcol]; b1 = B[(size_t)(k0 + bk0 + 8) * ldb + bcol]; }
        __syncthreads();
        As[akq * 4 + 0][ar] = av.x; As[akq * 4 + 1][ar] = av.y; As[akq * 4 + 2][ar] = av.z; As[akq * 4 + 3][ar] = av.w;
        Bs[bk0][bc] = b0; Bs[bk0 + 8][bc] = b1;
        __syncthreads();
#pragma unroll
        for (int kk = 0; kk < 16; ++kk) {
            const float4 a = *(const float4*)&As[kk][ty * 4];
            const float4 b = *(const float4*)&Bs[kk][tx * 4];
            const float aa[4] = {a.x, a.y, a.z, a.w}, bb[4] = {b.x, b.y, b.z, b.w};
#pragma unroll
            for (int i = 0; i < 4; ++i)
#pragma unroll
                for (int j = 0; j < 4; ++j) acc[i][j] = fmaf(aa[i], bb[j], acc[i][j]);
        }
    }
#pragma unroll
    for (int i = 0; i < 4; ++i) epi(ty * 4 + i, tx, acc[i]);
    __syncthreads();
}

__device__ void phase_init(const Params& p) {
    const int tid = tid_(), bid = bid_(); (void)tid; (void)bid;
    float* ws = p.ws;
    const size_t n4 = (size_t)T * D / 4;
    for (size_t i = (size_t)bid * NTHR + tid; i < n4; i += (size_t)gridDim.x * NTHR) {
        const size_t e = i * 4;
        float4 v = (e < (size_t)NLAT * D) ? *(const float4*)(p.in[I_X] + e) : *(const float4*)(p.in[I_CTX] + (e - (size_t)NLAT * D));
        *(float4*)(ws + W_X + e) = v;
    }
    if (bid == 0 && tid < 64) ((int*)(ws + W_CNT))[tid] = 0;
}

__device__ void phase_mod(const Params& p, float* smem) {
    const int tid = tid_(), bid = bid_(); (void)tid; (void)bid;
    const int wave = tid >> 6, lane = tid & 63;
    for (int it = bid; it < NLAYER * 96; it += gridDim.x) {
        const int l = it / 96, j = (it % 96) * 64 + lane;
        const float* W = p.in[I_WMOD] + (size_t)l * 1024 * 6144;
        float a0 = 0.f, a1 = 0.f;
        for (int k = wave * 128; k < wave * 128 + 128; ++k) {
            const float w = W[(size_t)k * 6144 + j];
            a0 = fmaf(silu(p.in[I_C][k]), w, a0);
            a1 = fmaf(silu(p.in[I_CCTX][k]), w, a1);
        }
        smem[(wave * 2 + 0) * 64 + lane] = a0; smem[(wave * 2 + 1) * 64 + lane] = a1;
        __syncthreads();
        if (wave < 2) {
            float s = 0.f;
            for (int w = 0; w < 8; ++w) s += smem[(w * 2 + wave) * 64 + lane];
            p.ws[W_MOD + (size_t)(l * 2 + wave) * 6144 + j] = s + p.in[I_BMOD][l * 6144 + j];
        }
        __syncthreads();
    }
}

__device__ void phase_norm(const Params& p, int l, int which) {
    const int tid = tid_(), bid = bid_(); (void)tid; (void)bid;
    const int lane = tid & 63, gw = bid * (NTHR / 64) + (tid >> 6), nw = gridDim.x * (NTHR / 64);
    const float* g = p.in[which ? I_NFFN : I_NMIX] + l * D;
    for (int t = gw; t < T; t += nw) {
        const float* x = p.ws + W_X + (size_t)t * D;
        const float* mod = p.ws + W_MOD + (size_t)(l * 2 + (t >= NLAT ? 1 : 0)) * 6144;
        const float* sh = mod + (which ? 3 : 0) * D; const float* sc = mod + (which ? 4 : 1) * D;
        float4 v[4]; float ss = 0.f;
#pragma unroll
        for (int j = 0; j < 4; ++j) { v[j] = *(const float4*)(x + j * 256 + lane * 4); ss += v[j].x * v[j].x + v[j].y * v[j].y + v[j].z * v[j].z + v[j].w * v[j].w; }
        ss = wave_sum(ss);
        const float rstd = rsqrtf(ss * (1.f / D) + EPS);
        float* h = p.ws + W_H + (size_t)t * D;
#pragma unroll
        for (int j = 0; j < 4; ++j) {
            const int c = j * 256 + lane * 4;
            const float4 gg = *(const float4*)(g + c), s1 = *(const float4*)(sc + c), s0 = *(const float4*)(sh + c);
            float4 o;
            o.x = v[j].x * rstd * gg.x * (1.f + s1.x) + s0.x; o.y = v[j].y * rstd * gg.y * (1.f + s1.y) + s0.y;
            o.z = v[j].z * rstd * gg.z * (1.f + s1.z) + s0.z; o.w = v[j].w * rstd * gg.w * (1.f + s1.w) + s0.w;
            *(float4*)(h + c) = o;
        }
    }
}

__device__ void phase_inproj(const Params& p, int l, float* smem) {
    const int tid = tid_(), bid = bid_(); (void)tid; (void)bid;
    const float* Wm = p.in[I_WIN] + (size_t)l * D * INC;
    const int ntn = (INC + 63) / 64, ntm = T / 128;
    for (int tile = bid; tile < ntm * ntn; tile += gridDim.x) {
        const int tm = tile / ntn, tn = tile % ntn, m0 = tm * 128, n0 = tn * 64;
        const float* H = p.ws + W_H; float* P = p.ws + W_P;
        gemm_tile(D, [&](int r) { return H + (size_t)(m0 + r) * D; }, Wm, INC,
                  [&](int c) { return (n0 + c < INC) ? n0 + c : -1; },
                  [&](int r, int tx, const float (&acc)[4]) {
#pragma unroll
                      for (int j = 0; j < 4; ++j) { const int n = n0 + tx * 4 + j; if (n < INC) P[(size_t)(m0 + r) * INC + n] = acc[j]; }
                  }, smem);
    }
}

__device__ void phase_prep1(const Params& p, int l) {
    const int tid = tid_(), bid = bid_(); (void)tid; (void)bid;
    const int lane = tid & 63, gw = bid * (NTHR / 64) + (tid >> 6), nw = gridDim.x * (NTHR / 64);
    float* ws = p.ws;
    for (int t = gw; t < T; t += nw) {
        const int s0 = (t < NLAT) ? 0 : NLAT, sl = (t < NLAT) ? NLAT : NCTX, n = t - s0;
        const float* P = ws + W_P; const float* pr = P + (size_t)t * INC;
        {
            const int g = lane >> 4, w = 2 << g;
            const int lo = max(n - w / 2, 0), hi = min(n + w / 2, sl);
            float4 s = make_float4(0.f, 0.f, 0.f, 0.f);
            for (int m = lo; m < hi; ++m) { const float4 v = *(const float4*)(P + (size_t)(s0 + m) * INC + OFF_A + lane * 4); s.x += v.x; s.y += v.y; s.z += v.z; s.w += v.w; }
            const float inv = 1.f / (float)(hi - lo);
            const float4 x = *(const float4*)(pr + OFF_A + lane * 4);
            float4 d; d.x = s.x * inv - x.x; d.y = s.y * inv - x.y; d.z = s.z * inv - x.z; d.w = s.w * inv - x.w;
            *(float4*)(ws + W_DIFF + (size_t)t * 256 + lane * 4) = d;
        }
        {
            float v[3]; float ss = 0.f;
#pragma unroll
            for (int j = 0; j < 3; ++j) { v[j] = pr[OFF_Q + j * 64 + lane]; ss += v[j] * v[j]; }
            ss = wave_sum(ss); const float rstd = rsqrtf(ss * (1.f / 192.f) + EPS);
#pragma unroll
            for (int j = 0; j < 3; ++j) ws[W_QN + (size_t)t * 192 + j * 64 + lane] = v[j] * rstd * p.in[I_QAN][l * 192 + j * 64 + lane];
        }
        {
            float v[2]; float ss = 0.f;
#pragma unroll
            for (int j = 0; j < 2; ++j) { v[j] = pr[OFF_KV + j * 64 + lane]; ss += v[j] * v[j]; }
            ss = wave_sum(ss); const float rstd = rsqrtf(ss * (1.f / 128.f) + EPS);
#pragma unroll
            for (int j = 0; j < 2; ++j) ws[W_KVN + (size_t)t * 128 + j * 64 + lane] = v[j] * rstd * p.in[I_KVAN][l * 128 + j * 64 + lane];
        }
        {
            const float4 zu = *(const float4*)(pr + OFF_C + lane * 4), zv = *(const float4*)(pr + OFF_C + 256 + lane * 4);
            float4 u; u.x = gelu_tanh(zu.x); u.y = gelu_tanh(zu.y); u.z = gelu_tanh(zu.z); u.w = gelu_tanh(zu.w);
            *(float4*)(ws + W_U + (size_t)t * 256 + lane * 4) = u;
            float gv[4] = {gelu_tanh(zv.x), gelu_tanh(zv.y), gelu_tanh(zv.z), gelu_tanh(zv.w)};
            const float mu = wave_sum(gv[0] + gv[1] + gv[2] + gv[3]) * (1.f / 256.f);
            float q = 0.f;
#pragma unroll
            for (int j = 0; j < 4; ++j) { gv[j] -= mu; q += gv[j] * gv[j]; }
            const float rstd = rsqrtf(wave_sum(q) * (1.f / 256.f) + EPS);
#pragma unroll
            for (int j = 0; j < 4; ++j) ws[W_VN + (size_t)t * 256 + lane * 4 + j] = gv[j] * rstd * p.in[I_SGG][l * 256 + lane * 4 + j] + p.in[I_SGB][l * 256 + lane * 4 + j];
        }
        {
            const float* cw = p.in[I_CONVW] + (size_t)l * 4 * 256;
            float4 o = *(const float4*)(p.in[I_CONVB] + l * 256 + lane * 4);
#pragma unroll
            for (int k = 0; k < 4; ++k) {
                const int m = n - 1 + k;
                if (m >= 0 && m < sl) {
                    const float4 xv = *(const float4*)(P + (size_t)(s0 + m) * INC + OFF_DX + lane * 4), wv = *(const float4*)(cw + k * 256 + lane * 4);
                    o.x = fmaf(xv.x, wv.x, o.x); o.y = fmaf(xv.y, wv.y, o.y); o.z = fmaf(xv.z, wv.z, o.z); o.w = fmaf(xv.w, wv.w, o.w);
                }
            }
            *(float4*)(ws + W_XC + (size_t)t * 256 + lane * 4) = o;
        }
    }
}

__device__ void phase_small(const Params& p, int l) {
    const int tid = tid_(), bid = bid_(); (void)tid; (void)bid;
    float* ws = p.ws;
    const size_t total = (size_t)T * 1664;
    for (size_t i = (size_t)bid * NTHR + tid; i < total; i += (size_t)gridDim.x * NTHR) {
        const int t = (int)(i / 1664); int o = (int)(i % 1664);
        if (o < 256) {
            const int g = o >> 6, j = o & 63;
            const float* d = ws + W_DIFF + (size_t)t * 256 + g * 64; const float* w = p.in[I_POOLW] + ((size_t)(l * 4 + g) * 64) * 64 + j;
            float a = 0.f;
            for (int c = 0; c < 64; ++c) a = fmaf(d[c], w[c * 64], a);
            ws[W_YC + (size_t)t * D + o] = a * p.in[I_POOLS][l * 256 + o];
        } else if (o < 640) {
            o -= 256;
            const float* x = ws + W_QN + (size_t)t * 192; const float* w = p.in[I_WUQ] + (size_t)l * 192 * 384 + o;
            float a = 0.f;
            for (int c = 0; c < 192; ++c) a = fmaf(x[c], w[(size_t)c * 384], a);
            ws[W_QUP + (size_t)t * 384 + o] = a;
        } else if (o < 1152) {
            o -= 640;
            const float* x = ws + W_KVN + (size_t)t * 128; const float* w = p.in[I_WUKV] + (size_t)l * 128 * 512 + o;
            float a = 0.f;
            for (int c = 0; c < 128; ++c) a = fmaf(x[c], w[(size_t)c * 512], a);
            ws[W_KVUP + (size_t)t * 512 + o] = a;
        } else {
            o -= 1152;
            const int d = o >> 8, ch = o & 255, h = ch >> 6, j = ch & 63;
            const float* x = ws + W_XC + (size_t)t * 256 + h * 64;
            const float* wa = p.in[I_WA] + ((size_t)((l * 2 + d) * 4 + h) * 64) * 64 + j;
            const float* wx = p.in[I_WX] + ((size_t)((l * 2 + d) * 4 + h) * 64) * 64 + j;
            float ra = 0.f, rx = 0.f;
            for (int c = 0; c < 64; ++c) { const float xv = x[c]; ra = fmaf(xv, wa[c * 64], ra); rx = fmaf(xv, wx[c * 64], rx); }
            const int pi = (l * 2 + d) * 256 + ch;
            const float r = sigm(ra + p.in[I_BA][pi]), ig = sigm(rx + p.in[I_BX][pi]);
            const float lam = p.in[I_LAM][pi];
            const float sp = log1pf(expf(-lam));
            const float loga = -8.f * r * sp;
            const float a = expf(loga);
            const float drive = sqrtf(-expm1f(2.f * loga)) * (ig * x[j]);
            ws[W_LA + ((size_t)d * T + t) * 256 + ch] = a;
            ws[W_LB + ((size_t)d * T + t) * 256 + ch] = drive;
        }
    }
}

__device__ void phase_prep2(const Params& p, int l) {
    const int tid = tid_(), bid = bid_(); (void)tid; (void)bid;
    float* ws = p.ws;
    const int lane = tid & 63, gw = bid * (NTHR / 64) + (tid >> 6), nw = gridDim.x * (NTHR / 64);
    for (int it = gw; it < T * 4; it += nw) {
        const int t = it >> 2, h = it & 3;
        const bool lat = t < NLAT;
        float cs = 1.f, sn = 0.f;
        if (lat && lane < 32) {
            const int f = lane & 15; const float pos = (f < 8) ? (float)(t >> 6) : (float)(t & 63);
            const float inv = powf(10000.f, -(float)(f & 7) / 8.f);
            const float ang = pos * inv; cs = cosf(ang); sn = sinf(ang);
        }
        {
            float v0 = ws[W_QUP + (size_t)t * 384 + h * 96 + lane], v1 = (lane < 32) ? ws[W_QUP + (size_t)t * 384 + h * 96 + 64 + lane] : 0.f;
            const float rstd = rsqrtf(wave_sum(v0 * v0 + v1 * v1) * (1.f / 96.f) + EPS);
            v0 *= rstd * p.in[I_QN][l * 96 + lane]; v1 *= (lane < 32) ? rstd * p.in[I_QN][l * 96 + 64 + lane] : 0.f;
            const float pv = __shfl_xor(v1, 16);
            const float r1 = (lane < 16) ? v1 * cs - pv * sn : pv * sn + v1 * cs;
            ws[W_Q + (size_t)t * 384 + h * 96 + lane] = v0;
            if (lane < 32) ws[W_Q + (size_t)t * 384 + h * 96 + 64 + lane] = lat ? r1 : v1;
        }
        {
            float v0 = ws[W_KVUP + (size_t)t * 512 + h * 128 + lane], v1 = (lane < 32) ? ws[W_P + (size_t)t * INC + OFF_KR + lane] : 0.f;
            const float rstd = rsqrtf(wave_sum(v0 * v0 + v1 * v1) * (1.f / 96.f) + EPS);
            v0 *= rstd * p.in[I_KN][l * 96 + lane]; v1 *= (lane < 32) ? rstd * p.in[I_KN][l * 96 + 64 + lane] : 0.f;
            const float pv = __shfl_xor(v1, 16);
            const float r1 = (lane < 16) ? v1 * cs - pv * sn : pv * sn + v1 * cs;
            ws[W_K + (size_t)t * 384 + h * 96 + lane] = v0;
            if (lane < 32) ws[W_K + (size_t)t * 384 + h * 96 + 64 + lane] = lat ? r1 : v1;
            ws[W_V + (size_t)t * 256 + h * 64 + lane] = ws[W_KVUP + (size_t)t * 512 + h * 128 + 64 + lane];
        }
    }
    for (size_t i = (size_t)bid * NTHR + tid; i < (size_t)T * 256; i += (size_t)gridDim.x * NTHR) {
        const int t = (int)(i >> 8), ch = (int)(i & 255), c = t >> 7, pp = t & 127, h = ch >> 6;
        const float* w = p.in[I_SGWS] + ((size_t)(l * 4 + h) * 128 + pp) * 128;
        const float* vn = ws + W_VN + (size_t)c * 128 * 256 + ch;
        float a = 0.f;
        for (int q = 0; q < 128; ++q) a = fmaf(w[q], vn[(size_t)q * 256], a);
        a += p.in[I_SGBS][(l * 4 + h) * 128 + pp];
        ws[W_YC + (size_t)t * D + 512 + ch] = ws[W_U + (size_t)t * 256 + ch] * a;
    }
    for (int i = bid * NTHR + tid; i < NCHUNK * 512; i += gridDim.x * NTHR) {
        const int c = i >> 9, d = (i >> 8) & 1, ch = i & 255;
        float* A = ws + W_LA + ((size_t)d * T + (size_t)c * 128) * 256 + ch;
        float* B = ws + W_LB + ((size_t)d * T + (size_t)c * 128) * 256 + ch;
        float h = 0.f, ap = 1.f;
        for (int s = 0; s < 128; ++s) {
            const int q = d ? 127 - s : s;
            const float a = A[(size_t)q * 256], b = B[(size_t)q * 256];
            h = fmaf(a, h, b); ap *= a;
            A[(size_t)q * 256] = ap; B[(size_t)q * 256] = h;
        }
        ws[W_AGG + ((size_t)(c * 2 + d) * 2 + 0) * 256 + ch] = ap;
        ws[W_AGG + ((size_t)(c * 2 + d) * 2 + 1) * 256 + ch] = h;
    }
}

__device__ void lru_carries(const Params& p) {
    const int tid = tid_(), bid = bid_(); (void)tid; (void)bid;
    float* ws = p.ws;
    const int d = tid >> 8, ch = tid & 255;
    float s = 0.f;
    for (int k = 0; k < NCHUNK; ++k) {
        const int c = d ? (NCHUNK - 1 - k) : ((k + 128) % NCHUNK);
        ws[W_CARRY + (size_t)(c * 2 + d) * 256 + ch] = s;
        const float a = ws[W_AGG + ((size_t)(c * 2 + d) * 2 + 0) * 256 + ch], hh = ws[W_AGG + ((size_t)(c * 2 + d) * 2 + 1) * 256 + ch];
        s = fmaf(a, s, hh);
    }
}

__device__ void phase_attn(const Params& p) {
    const int tid = tid_(), bid = bid_(); (void)tid; (void)bid;
    float* ws = p.ws;
    const int nqb = T / 256;
    const float scale = 0.10206207261596577f;
    const int half = tid & 1;
    for (int it = bid; it < nqb * 4; it += gridDim.x) {
        const int h = it & 3, qb = it >> 2;
        const int t = qb * 256 + (tid >> 1);
        const int k0 = (qb * 256 >= NLAT) ? NLAT : 0;
        float q[48], o[32];
#pragma unroll
        for (int j = 0; j < 48; ++j) q[j] = ws[W_Q + (size_t)t * 384 + h * 96 + half * 48 + j] * scale;
#pragma unroll
        for (int j = 0; j < 32; ++j) o[j] = 0.f;
        float m = -1e30f, lsum = 0.f;
        for (int k = k0; k < T; ++k) {
            const float* kp = ws + W_K + (size_t)k * 384 + h * 96 + half * 48; const float* vp = ws + W_V + (size_t)k * 256 + h * 64 + half * 32;
            float s = 0.f;
#pragma unroll
            for (int j = 0; j < 48; ++j) s = fmaf(q[j], kp[j], s);
            s += __shfl_xor(s, 1);
            const float mn = fmaxf(m, s), corr = expf(m - mn), pe = expf(s - mn);
            lsum = lsum * corr + pe; m = mn;
#pragma unroll
            for (int j = 0; j < 32; ++j) o[j] = fmaf(pe, vp[j], o[j] * corr);
        }
        const float il = 1.f / lsum;
#pragma unroll
        for (int j = 0; j < 32; ++j) ws[W_YC + (size_t)t * D + 256 + h * 64 + half * 32 + j] = o[j] * il;
    }
}

__device__ void phase_lru_fin(const Params& p) {
    const int tid = tid_(), bid = bid_(); (void)tid; (void)bid;
    float* ws = p.ws;
    for (size_t i = (size_t)bid * NTHR + tid; i < (size_t)T * 256; i += (size_t)gridDim.x * NTHR) {
        const int t = (int)(i >> 8), ch = (int)(i & 255), c = t >> 7;
        float hs = 0.f;
#pragma unroll
        for (int d = 0; d < 2; ++d)
            hs += ws[W_LB + ((size_t)d * T + t) * 256 + ch] + ws[W_LA + ((size_t)d * T + t) * 256 + ch] * ws[W_CARRY + (size_t)(c * 2 + d) * 256 + ch];
        ws[W_YC + (size_t)t * D + 768 + ch] = gelu_tanh(ws[W_P + (size_t)t * INC + OFF_DG + ch]) * hs;
    }
}

__device__ void phase_outproj(const Params& p, int l, float* smem) {
    const int tid = tid_(), bid = bid_(); (void)tid; (void)bid;
    const float* Wm = p.in[I_WOUT] + (size_t)l * D * D;
    const int ntn = D / 64, ntm = T / 128;
    for (int tile = bid; tile < ntm * ntn; tile += gridDim.x) {
        const int tm = tile / ntn, tn = tile % ntn, m0 = tm * 128, n0 = tn * 64;
        const float* Y = p.ws + W_YC; float* X = p.ws + W_X;
        const float* g1 = p.ws + W_MOD + (size_t)(l * 2 + (m0 >= NLAT ? 1 : 0)) * 6144 + 2 * D;
        gemm_tile(D, [&](int r) { return Y + (size_t)(m0 + r) * D; }, Wm, D,
                  [&](int c) { return n0 + c; },
                  [&](int r, int tx, const float (&acc)[4]) {
#pragma unroll
                      for (int j = 0; j < 4; ++j) { const int n = n0 + tx * 4 + j; X[(size_t)(m0 + r) * D + n] += g1[n] * acc[j]; }
                  }, smem);
    }
}

__device__ void phase_router(const Params& p, int l) {
    const int tid = tid_(), bid = bid_(); (void)tid; (void)bid;
    float* ws = p.ws;
    const int lane = tid & 63, gw = bid * (NTHR / 64) + (tid >> 6), nw = gridDim.x * (NTHR / 64);
    const float* rw = p.in[I_RW] + (size_t)l * D * NEXP;
    int* cnt = (int*)(ws + W_CNT) + l * NEXP;
    int* list = (int*)(ws + W_LIST);
    const int e = lane & 31, half = lane >> 5;
    for (int t = gw; t < T; t += nw) {
        const float* f = ws + W_H + (size_t)t * D + half * 512;
        const float* w = rw + (size_t)half * 512 * NEXP + e;
        float a = 0.f;
        for (int k = 0; k < 512; ++k) a = fmaf(f[k], w[(size_t)k * NEXP], a);
        a += __shfl_xor(a, 32);
        a += p.in[I_RB][l * NEXP + e];
        float tv[4]; int te[4];
        float cur = a;
#pragma unroll
        for (int k = 0; k < 4; ++k) {
            float bv = cur; int bi = e;
#pragma unroll
            for (int o = 16; o > 0; o >>= 1) {
                const float ov = __shfl_xor(bv, o); const int oi = __shfl_xor(bi, o);
                if (ov > bv || (ov == bv && oi < bi)) { bv = ov; bi = oi; }
            }
            tv[k] = bv; te[k] = bi;
            if (e == bi) cur = -3.0e38f;
        }
        const float mx = tv[0];
        float ex[4], s = 0.f;
#pragma unroll
        for (int k = 0; k < 4; ++k) { ex[k] = expf(tv[k] - mx); s += ex[k]; }
        if (lane < 4) {
            const int ee = te[lane];
            const int idx = atomicAdd(&cnt[ee], 1);
            list[(size_t)ee * T + idx] = t;
            ((int*)(ws + W_TOPE))[t * 4 + lane] = ee;
            ((int*)(ws + W_TOPI))[t * 4 + lane] = idx;
            ws[W_TOPG + t * 4 + lane] = ex[lane] / s;
        }
    }
}

DEVI void moe_bases(const Params& p, int l, int* sb) {
    const int tid = tid_(), bid = bid_(); (void)tid; (void)bid;
    if (tid == 0) {
        const int* cnt = (const int*)(p.ws + W_CNT) + l * NEXP;
        int b = 0, tb = 0;
        for (int e = 0; e < NEXP; ++e) { sb[e] = b; sb[40 + e] = tb; const int c = cnt[e]; sb[80 + e] = c; const int mt = (c + 127) / 128; b += mt * 128; tb += mt; }
        sb[32] = b; sb[72] = tb;
    }
    __syncthreads();
}

__device__ void phase_moe1(const Params& p, int l, float* smem) {
    const int tid = tid_(), bid = bid_(); (void)tid; (void)bid;
    int* sb = (int*)(smem + 16 * 132 + 16 * 64);
    moe_bases(p, l, sb);
    const int ntn = 1024 / 32;
    const int ntiles = sb[72] * ntn;
    const int* list = (const int*)(p.ws + W_LIST);
    for (int tile = bid; tile < ntiles; tile += gridDim.x) {
        const int mt = tile / ntn, tn = tile % ntn;
        int e = 0; while (e < NEXP - 1 && sb[40 + e + 1] <= mt) ++e;
        const int mloc = (mt - sb[40 + e]) * 128, cnt = sb[80 + e], rbase = sb[e] + mloc;
        const float* Wm = p.in[I_WGU] + ((size_t)(l * NEXP + e) * D) * 2048;
        const float* bias = p.in[I_BGU] + (size_t)(l * NEXP + e) * 2048;
        const float* H = p.ws + W_H; float* ACT = p.ws + W_ACT;
        gemm_tile(D, [&](int r) { return (mloc + r < cnt) ? H + (size_t)list[(size_t)e * T + mloc + r] * D : (const float*)nullptr; }, Wm, 2048,
                  [&](int c) { const int q = c >> 2, r = c & 3; return (r < 2) ? tn * 32 + 2 * q + r : 1024 + tn * 32 + 2 * q + (r - 2); },
                  [&](int r, int tx, const float (&acc)[4]) {
                      if (mloc + r < cnt) {
#pragma unroll
                          for (int j = 0; j < 2; ++j) {
                              const int n = tn * 32 + 2 * tx + j;
                              float g = acc[j] + bias[n], u = acc[2 + j] + bias[1024 + n];
                              g = fminf(g, 7.f); u = fminf(fmaxf(u, -7.f), 7.f);
                              ACT[(size_t)(rbase + r) * D + n] = (u + 1.f) * (g * sigm(1.702f * g));
                          }
                      }
                  }, smem);
    }
    __syncthreads();
}

__device__ void phase_moe2(const Params& p, int l, float* smem) {
    const int tid = tid_(), bid = bid_(); (void)tid; (void)bid;
    int* sb = (int*)(smem + 16 * 132 + 16 * 64);
    moe_bases(p, l, sb);
    const int ntn = D / 64;
    const int ntiles = sb[72] * ntn;
    for (int tile = bid; tile < ntiles; tile += gridDim.x) {
        const int mt = tile / ntn, tn = tile % ntn, n0 = tn * 64;
        int e = 0; while (e < NEXP - 1 && sb[40 + e + 1] <= mt) ++e;
        const int mloc = (mt - sb[40 + e]) * 128, cnt = sb[80 + e], rbase = sb[e] + mloc;
        const float* Wm = p.in[I_WDN] + ((size_t)(l * NEXP + e) * D) * D;
        const float* bias = p.in[I_BDN] + (size_t)(l * NEXP + e) * D;
        const float* ACT = p.ws + W_ACT; float* YR = p.ws + W_YR;
        gemm_tile(D, [&](int r) { return (mloc + r < cnt) ? ACT + (size_t)(rbase + r) * D : (const float*)nullptr; }, Wm, D,
                  [&](int c) { return n0 + c; },
                  [&](int r, int tx, const float (&acc)[4]) {
                      if (mloc + r < cnt) {
#pragma unroll
                          for (int j = 0; j < 4; ++j) { const int n = n0 + tx * 4 + j; YR[(size_t)(rbase + r) * D + n] = acc[j] + bias[n]; }
                      }
                  }, smem);
    }
    __syncthreads();
}

__device__ void phase_combine(const Params& p, int l, float* smem, bool last) {
    const int tid = tid_(), bid = bid_(); (void)tid; (void)bid;
    int* sb = (int*)(smem + 16 * 132 + 16 * 64);
    moe_bases(p, l, sb);
    float* ws = p.ws;
    const int lane = tid & 63, gw = bid * (NTHR / 64) + (tid >> 6), nw = gridDim.x * (NTHR / 64);
    for (int t = gw; t < T; t += nw) {
        const float* g2 = ws + W_MOD + (size_t)(l * 2 + (t >= NLAT ? 1 : 0)) * 6144 + 5 * D;
        const float* yr[4]; float gt[4];
#pragma unroll
        for (int k = 0; k < 4; ++k) {
            const int e = ((const int*)(ws + W_TOPE))[t * 4 + k], idx = ((const int*)(ws + W_TOPI))[t * 4 + k];
            yr[k] = ws + W_YR + (size_t)(sb[e] + idx) * D; gt[k] = ws[W_TOPG + t * 4 + k];
        }
        float* x = ws + W_X + (size_t)t * D;
#pragma unroll
        for (int j = 0; j < 4; ++j) {
            const int c = j * 256 + lane * 4;
            float4 a = make_float4(0.f, 0.f, 0.f, 0.f);
#pragma unroll
            for (int k = 0; k < 4; ++k) { const float4 y = *(const float4*)(yr[k] + c); a.x = fmaf(gt[k], y.x, a.x); a.y = fmaf(gt[k], y.y, a.y); a.z = fmaf(gt[k], y.z, a.z); a.w = fmaf(gt[k], y.w, a.w); }
            float4 xv = *(const float4*)(x + c); const float4 gg = *(const float4*)(g2 + c);
            xv.x = fmaf(gg.x, a.x, xv.x); xv.y = fmaf(gg.y, a.y, xv.y); xv.z = fmaf(gg.z, a.z, xv.z); xv.w = fmaf(gg.w, a.w, xv.w);
            *(float4*)(x + c) = xv;
            if (last && t < NLAT) *(float4*)(p.out + (size_t)t * D + c) = xv;
        }
    }
    __syncthreads();
}

__global__ void __launch_bounds__(NTHR) fwd_kernel(Params p) {
    cg::grid_group grid = cg::this_grid();
    __shared__ __attribute__((aligned(16))) float smem[16 * 132 + 16 * 64 + 128];
    phase_init(p);
    phase_mod(p, smem);
    grid.sync();
    for (int l = 0; l < NLAYER; ++l) {
        phase_norm(p, l, 0);
        grid.sync();
        phase_inproj(p, l, smem);
        grid.sync();
        phase_prep1(p, l);
        grid.sync();
        phase_small(p, l);
        grid.sync();
        phase_prep2(p, l);
        grid.sync();
        if (blockIdx.x == gridDim.x - 1) lru_carries(p);
        phase_attn(p);
        grid.sync();
        phase_lru_fin(p);
        grid.sync();
        phase_outproj(p, l, smem);
        grid.sync();
        phase_norm(p, l, 1);
        grid.sync();
        phase_router(p, l);
        grid.sync();
        phase_moe1(p, l, smem);
        grid.sync();
        phase_moe2(p, l, smem);
        grid.sync();
        phase_combine(p, l, smem, l == NLAYER - 1);
        grid.sync();
    }
}

extern "C" void kernel_launch(void* const* d_in, const int* in_sizes, int n_in, void* d_out, int out_size, void* d_ws, size_t ws_size, hipStream_t stream) {
    static int grid_blocks = 0;
    if (!grid_blocks) {
        int dev = 0, cus = 0, per_cu = 0;
        hipGetDevice(&dev);
        hipDeviceGetAttribute(&cus, hipDeviceAttributeMultiprocessorCount, dev);
        hipOccupancyMaxActiveBlocksPerMultiprocessor(&per_cu, fwd_kernel, NTHR, 0);
        if (per_cu < 1) per_cu = 1;
        if (per_cu > 2) per_cu = 2;
        grid_blocks = cus * per_cu;
        if (ws_size < W_END * sizeof(float)) fprintf(stderr, "kernel_launch: workspace too small: %zu < %zu\n", ws_size, W_END * sizeof(float));
        if (n_in != N_IN) fprintf(stderr, "kernel_launch: n_in %d != %d\n", n_in, (int)N_IN);
    }
    Params p{};
    for (int i = 0; i < N_IN; ++i) p.in[i] = (const float*)d_in[i];
    p.out = (float*)d_out;
    p.ws = (float*)d_ws;
    void* args[] = {&p};
    hipError_t e = hipLaunchCooperativeKernel((void*)fwd_kernel, dim3(grid_blocks), dim3(NTHR), args, 0, stream);
    if (e != hipSuccess) fprintf(stderr, "cooperative launch failed: %s (grid %d)\n", hipGetErrorString(e), grid_blocks);
}
```

```cpp
#include <hip/hip_runtime.h>
#include <hip/hip_cooperative_groups.h>
#include <cstdio>
#include <cstdint>
namespace cg = cooperative_groups;

#define DEVI __device__ __forceinline__
constexpr int NTHR = 512;
constexpr int D = 1024, NLAT = 16384, NCTX = 256, T = NLAT + NCTX, NLAYER = 2;
constexpr int INC = 1632;
constexpr int OFF_A = 0, OFF_Q = 256, OFF_KV = 448, OFF_KR = 576, OFF_C = 608, OFF_DX = 1120, OFF_DG = 1376;
constexpr int NCHUNK = T / 128;
constexpr int NEXP = 32, TOPK = 4;
constexpr int MAXROWS = T * TOPK + NEXP * 256;
constexpr float EPS = 1e-6f;

enum { I_X = 0, I_C, I_CTX, I_CCTX, I_WMOD, I_BMOD, I_NMIX, I_NFFN, I_WIN, I_WOUT, I_POOLW, I_POOLS, I_QAN, I_WUQ, I_KVAN, I_WUKV,
       I_QN, I_KN, I_SGG, I_SGB, I_SGWS, I_SGBS, I_CONVW, I_CONVB, I_WA, I_BA, I_WX, I_BX, I_LAM, I_RW, I_RB, I_WGU, I_BGU, I_WDN, I_BDN, N_IN };

constexpr size_t al(size_t x) { return (x + 63) / 64 * 64; }
constexpr size_t W_X = 0;
constexpr size_t W_MOD = W_X + al((size_t)T * D);
constexpr size_t W_H = W_MOD + al(2 * 2 * 6144);
constexpr size_t W_P = W_H + al((size_t)T * D);
constexpr size_t W_YC = W_P + al((size_t)T * INC);
constexpr size_t W_Q = W_YC + al((size_t)T * D);
constexpr size_t W_K = W_Q + al((size_t)T * 384);
constexpr size_t W_V = W_K + al((size_t)T * 384);
constexpr size_t W_DIFF = W_V + al((size_t)T * 256);
constexpr size_t W_QN = W_DIFF + al((size_t)T * 256);
constexpr size_t W_KVN = W_QN + al((size_t)T * 192);
constexpr size_t W_U = W_KVN + al((size_t)T * 128);
constexpr size_t W_VN = W_U + al((size_t)T * 256);
constexpr size_t W_XC = W_VN + al((size_t)T * 256);
constexpr size_t W_QUP = W_XC + al((size_t)T * 256);
constexpr size_t W_KVUP = W_QUP + al((size_t)T * 384);
constexpr size_t W_LA = W_KVUP + al((size_t)T * 512);
constexpr size_t W_LB = W_LA + al((size_t)2 * T * 256);
constexpr size_t W_AGG = W_LB + al((size_t)2 * T * 256);
constexpr size_t W_CARRY = W_AGG + al((size_t)NCHUNK * 2 * 2 * 256);
constexpr size_t W_TOPE = W_CARRY + al((size_t)NCHUNK * 2 * 256);
constexpr size_t W_TOPG = W_TOPE + al((size_t)T * 4);
constexpr size_t W_TOPI = W_TOPG + al((size_t)T * 4);
constexpr size_t W_CNT = W_TOPI + al((size_t)T * 4);
constexpr size_t W_LIST = W_CNT + al(64);
constexpr size_t W_ACT = W_LIST + al((size_t)NEXP * T);
constexpr size_t W_YR = W_ACT + al((size_t)MAXROWS * D);
constexpr size_t W_HB = W_YR + al((size_t)MAXROWS * D);
constexpr size_t W_END = W_HB + al((size_t)T * D / 2);

struct Params {
    const float* in[N_IN];
    float* out;
    float* ws;
};

DEVI int tid_() { int t = threadIdx.x; asm volatile("" : "+v"(t)); return t; }
DEVI int bid_() { int b = blockIdx.x; asm volatile("" : "+s"(b)); return b; }
DEVI float wave_sum(float v) {
#pragma unroll
    for (int o = 32; o > 0; o >>= 1) v += __shfl_xor(v, o);
    return v;
}
DEVI float gelu_tanh(float x) { const float u = 0.7978845608028654f * (x + 0.044715f * x * x * x); return 0.5f * x * (1.f + tanhf(u)); }
DEVI float sigm(float x) { return 1.f / (1.f + expf(-x)); }
DEVI float silu(float x) { return x * sigm(x); }


typedef unsigned short bf16_t;
typedef short bf16x8 __attribute__((ext_vector_type(8)));
typedef float f32x4 __attribute__((ext_vector_type(4)));
typedef unsigned u32x4 __attribute__((ext_vector_type(4)));
typedef unsigned u32x2 __attribute__((ext_vector_type(2)));
DEVI unsigned cvt_pk_bf16(float lo, float hi) { unsigned r; asm volatile("v_cvt_pk_bf16_f32 %0, %1, %2" : "=v"(r) : "v"(lo), "v"(hi)); return r; }
DEVI bf16_t f2bf(float f) { return (bf16_t)(cvt_pk_bf16(f, 0.f) & 0xffffu); }
DEVI float bf2f(bf16_t b) { return __uint_as_float(((unsigned)b) << 16); }

constexpr int G_STAGE = 49152;
constexpr int G_LDS = 2 * G_STAGE;
DEVI int lds_byte(int r, int c) { const int st = (r >> 4) * 2 + (c >> 5), rr = r & 15, cc = c & 31, ob = rr * 64 + cc * 2; return st * 1024 + (ob ^ (((ob >> 9) & 1) << 5)); }

template <bool PAIRED, class ARow, class Epi>
DEVI void gemm_unit(char* lds, int K, ARow arow, const float* __restrict__ B0, const float* __restrict__ B1, int ldb, int ncol_valid, Epi epi) {
    const int tid = tid_(), wave = tid >> 6, lane = tid & 63, fr = lane & 15, fq = lane >> 4, wr = wave >> 1, wc = wave & 1;
    const int ac = tid & 7;
    const bf16_t* ap[4]; int a_lds[4];
#pragma unroll
    for (int i = 0; i < 4; ++i) { const int r = (tid >> 3) + 64 * i; const bf16_t* q = arow(r); ap[i] = q ? q + ac * 8 : nullptr; a_lds[i] = (r >> 7) * 16384 + lds_byte(r & 127, ac * 8); }
    const int kq = lane & 15, nq = (lane >> 4) + 4 * wave;
    const float* bp; bool bvalid;
    if (PAIRED) { const int seg = (nq >> 2) & 1, idx = (nq >> 3) * 16 + (nq & 3) * 4; bp = (seg ? B1 : B0) + idx; bvalid = idx < ncol_valid; }
    else { bp = B0 + 4 * nq; bvalid = 4 * nq < ncol_valid; }
    bp += (size_t)(4 * kq) * ldb;
    int b_lds[4];
#pragma unroll
    for (int i = 0; i < 4; ++i) b_lds[i] = 32768 + lds_byte(4 * nq + i, 4 * kq);
    const int aoff = (wr >> 1) * 16384 + lds_byte((wr & 1) * 64 + fr, fq * 8), boff = 32768 + lds_byte(wc * 64 + fr, fq * 8);
    u32x4 av[4]; f32x4 bv[4];
#define G_LOAD(t) do { _Pragma("unroll") for (int i = 0; i < 4; ++i) av[i] = ap[i] ? *(const u32x4*)(ap[i] + (t) * 64) : (u32x4){0u, 0u, 0u, 0u}; \
        _Pragma("unroll") for (int kk = 0; kk < 4; ++kk) bv[kk] = bvalid ? *(const f32x4*)(bp + ((size_t)(t) * 64 + kk) * ldb) : (f32x4){0.f, 0.f, 0.f, 0.f}; } while (0)
#define G_WRITE(buf) do { char* s_ = lds + (buf) * G_STAGE; _Pragma("unroll") for (int i = 0; i < 4; ++i) *(u32x4*)(s_ + a_lds[i]) = av[i]; \
        _Pragma("unroll") for (int i = 0; i < 4; ++i) { u32x2 w_; w_.x = cvt_pk_bf16(bv[0][i], bv[1][i]); w_.y = cvt_pk_bf16(bv[2][i], bv[3][i]); *(u32x2*)(s_ + b_lds[i]) = w_; } } while (0)
    f32x4 acc[4][4];
#pragma unroll
    for (int m = 0; m < 4; ++m)
#pragma unroll
        for (int n = 0; n < 4; ++n) acc[m][n] = (f32x4){0.f, 0.f, 0.f, 0.f};
    const int nk = K >> 6;
    G_LOAD(0);
    G_WRITE(0);
    if (nk > 1) G_LOAD(1);
    __syncthreads();
    for (int t = 0; t < nk; ++t) {
        const char* s_ = lds + (t & 1) * G_STAGE;
#pragma unroll
        for (int k = 0; k < 2; ++k) {
            bf16x8 Af[4], Bf[4];
#pragma unroll
            for (int m = 0; m < 4; ++m) Af[m] = *(const bf16x8*)(s_ + aoff + m * 2048 + k * 1024);
#pragma unroll
            for (int n = 0; n < 4; ++n) Bf[n] = *(const bf16x8*)(s_ + boff + n * 2048 + k * 1024);
#pragma unroll
            for (int m = 0; m < 4; ++m)
#pragma unroll
                for (int n = 0; n < 4; ++n) acc[m][n] = __builtin_amdgcn_mfma_f32_16x16x32_bf16(Bf[n], Af[m], acc[m][n], 0, 0, 0);
        }
        if (t + 1 < nk) { G_WRITE((t + 1) & 1); if (t + 2 < nk) G_LOAD(t + 2); }
        __syncthreads();
    }
#undef G_LOAD
#undef G_WRITE
    epi(acc, wr, wc, fr, fq);
}

template <class ARow, class BMap, class Epi>
DEVI void gemm_tile(int K, ARow arow, const float* __restrict__ B, int ldb, BMap bmap, Epi epi, float* smem) {
    float (*As)[132] = (float (*)[132])smem;
    float (*Bs)[64] = (float (*)[64])(smem + 16 * 132);
    const int tid = tid_(), ty = tid >> 4, tx = tid & 15;
    float acc[4][4];
#pragma unroll
    for (int i = 0; i < 4; ++i)
#pragma unroll
        for (int j = 0; j < 4; ++j) acc[i][j] = 0.f;
    const int ar = tid >> 2, akq = tid & 3;
    const float* ap = arow(ar);
    const int bk0 = tid >> 6, bc = tid & 63;
    const int bcol = bmap(bc);
    for (int k0 = 0; k0 < K; k0 += 16) {
        float4 av = make_float4(0.f, 0.f, 0.f, 0.f);
        if (ap) av = *(const float4*)(ap + k0 + akq * 4);
        float b0 = 0.f, b1 = 0.f;
        if (bcol >= 0) { b0 = B[(size_t)(k0 + bk0) * ldb + bcol]; b1 = B[(size_t)(k0 + bk0 + 8) * ldb + bcol]; }
        __syncthreads();
        As[akq * 4 + 0][ar] = av.x; As[akq * 4 + 1][ar] = av.y; As[akq * 4 + 2][ar] = av.z; As[akq * 4 + 3][ar] = av.w;
        Bs[bk0][bc] = b0; Bs[bk0 + 8][bc] = b1;
        __syncthreads();
#pragma unroll
        for (int kk = 0; kk < 16; ++kk) {
            const float4 a = *(const float4*)&As[kk][ty * 4];
            const float4 b = *(const float4*)&Bs[kk][tx * 4];
            const float aa[4] = {a.x, a.y, a.z, a.w}, bb[4] = {b.x, b.y, b.z, b.w};
#pragma unroll
            for (int i = 0; i < 4; ++i)
#pragma unroll
                for (int j = 0; j < 4; ++j) acc[i][j] = fmaf(aa[i], bb[j], acc[i][j]);
        }
    }
#pragma unroll
    for (int i = 0; i < 4; ++i) epi(ty * 4 + i, tx, acc[i]);
    __syncthreads();
}

__device__ void phase_init(const Params& p) {
    const int tid = tid_(), bid = bid_(); (void)tid; (void)bid;
    float* ws = p.ws;
    const size_t n4 = (size_t)T * D / 4;
    for (size_t i = (size_t)bid * NTHR + tid; i < n4; i += (size_t)gridDim.x * NTHR) {
        const size_t e = i * 4;
        float4 v = (e < (size_t)NLAT * D) ? *(const float4*)(p.in[I_X] + e) : *(const float4*)(p.in[I_CTX] + (e - (size_t)NLAT * D));
        *(float4*)(ws + W_X + e) = v;
    }
    if (bid == 0 && tid < 64) ((int*)(ws + W_CNT))[tid] = 0;
}

__device__ void phase_mod(const Params& p, float* smem) {
    const int tid = tid_(), bid = bid_(); (void)tid; (void)bid;
    const int wave = tid >> 6, lane = tid & 63;
    for (int it = bid; it < NLAYER * 96; it += gridDim.x) {
        const int l = it / 96, j = (it % 96) * 64 + lane;
        const float* W = p.in[I_WMOD] + (size_t)l * 1024 * 6144;
        float a0 = 0.f, a1 = 0.f;
        for (int k = wave * 128; k < wave * 128 + 128; ++k) {
            const float w = W[(size_t)k * 6144 + j];
            a0 = fmaf(silu(p.in[I_C][k]), w, a0);
            a1 = fmaf(silu(p.in[I_CCTX][k]), w, a1);
        }
        smem[(wave * 2 + 0) * 64 + lane] = a0; smem[(wave * 2 + 1) * 64 + lane] = a1;
        __syncthreads();
        if (wave < 2) {
            float s = 0.f;
            for (int w = 0; w < 8; ++w) s += smem[(w * 2 + wave) * 64 + lane];
            p.ws[W_MOD + (size_t)(l * 2 + wave) * 6144 + j] = s + p.in[I_BMOD][l * 6144 + j];
        }
        __syncthreads();
    }
}

__device__ void phase_norm(const Params& p, int l, int which) {
    const int tid = tid_(), bid = bid_(); (void)tid; (void)bid;
    const int lane = tid & 63, gw = bid * (NTHR / 64) + (tid >> 6), nw = gridDim.x * (NTHR / 64);
    const float* g = p.in[which ? I_NFFN : I_NMIX] + l * D;
    for (int t = gw; t < T; t += nw) {
        const float* x = p.ws + W_X + (size_t)t * D;
        const float* mod = p.ws + W_MOD + (size_t)(l * 2 + (t >= NLAT ? 1 : 0)) * 6144;
        const float* sh = mod + (which ? 3 : 0) * D; const float* sc = mod + (which ? 4 : 1) * D;
        float4 v[4]; float ss = 0.f;
#pragma unroll
        for (int j = 0; j < 4; ++j) { v[j] = *(const float4*)(x + j * 256 + lane * 4); ss += v[j].x * v[j].x + v[j].y * v[j].y + v[j].z * v[j].z + v[j].w * v[j].w; }
        ss = wave_sum(ss);
        const float rstd = rsqrtf(ss * (1.f / D) + EPS);
        float* h = p.ws + W_H + (size_t)t * D;
#pragma unroll
        for (int j = 0; j < 4; ++j) {
            const int c = j * 256 + lane * 4;
            const float4 gg = *(const float4*)(g + c), s1 = *(const float4*)(sc + c), s0 = *(const float4*)(sh + c);
            float4 o;
            o.x = v[j].x * rstd * gg.x * (1.f + s1.x) + s0.x; o.y = v[j].y * rstd * gg.y * (1.f + s1.y) + s0.y;
            o.z = v[j].z * rstd * gg.z * (1.f + s1.z) + s0.z; o.w = v[j].w * rstd * gg.w * (1.f + s1.w) + s0.w;
            *(float4*)(h + c) = o;
            { u32x2 w; w.x = cvt_pk_bf16(o.x, o.y); w.y = cvt_pk_bf16(o.z, o.w); *(u32x2*)((bf16_t*)(p.ws + W_HB) + (size_t)t * D + c) = w; }
        }
    }
}

__device__ void phase_inproj(const Params& p, int l, char* lds) {
    const int tid = tid_(), bid = bid_(); (void)tid;
    const float* Wm = p.in[I_WIN] + (size_t)l * D * INC;
    constexpr int ntn = (INC + 127) / 128, ntm = T / 256;
    const bf16_t* HB = (const bf16_t*)(p.ws + W_HB); float* P = p.ws + W_P;
    for (int tile = bid; tile < ntm * ntn; tile += gridDim.x) {
        const int tm = tile / ntn, tn = tile % ntn, m0 = tm * 256, n0 = tn * 128;
        gemm_unit<false>(lds, D, [&](int r) { return HB + (size_t)(m0 + r) * D; }, Wm + n0, Wm + n0, INC, INC - n0,
                  [&](const f32x4 (&acc)[4][4], int wr, int wc, int fr, int fq) {
#pragma unroll
                      for (int m = 0; m < 4; ++m) { float* row = P + (size_t)(m0 + wr * 64 + m * 16 + fr) * INC;
#pragma unroll
                          for (int n = 0; n < 4; ++n) { const int col = n0 + wc * 64 + n * 16 + 4 * fq; if (col < INC) *(f32x4*)(row + col) = acc[m][n]; } }
                  });
    }
}

__device__ void phase_prep1(const Params& p, int l) {
    const int tid = tid_(), bid = bid_(); (void)tid; (void)bid;
    const int lane = tid & 63, gw = bid * (NTHR / 64) + (tid >> 6), nw = gridDim.x * (NTHR / 64);
    float* ws = p.ws;
    for (int t = gw; t < T; t += nw) {
        const int s0 = (t < NLAT) ? 0 : NLAT, sl = (t < NLAT) ? NLAT : NCTX, n = t - s0;
        const float* P = ws + W_P; const float* pr = P + (size_t)t * INC;
        {
            const int g = lane >> 4, w = 2 << g;
            const int lo = max(n - w / 2, 0), hi = min(n + w / 2, sl);
            float4 s = make_float4(0.f, 0.f, 0.f, 0.f);
            for (int m = lo; m < hi; ++m) { const float4 v = *(const float4*)(P + (size_t)(s0 + m) * INC + OFF_A + lane * 4); s.x += v.x; s.y += v.y; s.z += v.z; s.w += v.w; }
            const float inv = 1.f / (float)(hi - lo);
            const float4 x = *(const float4*)(pr + OFF_A + lane * 4);
            float4 d; d.x = s.x * inv - x.x; d.y = s.y * inv - x.y; d.z = s.z * inv - x.z; d.w = s.w * inv - x.w;
            *(float4*)(ws + W_DIFF + (size_t)t * 256 + lane * 4) = d;
        }
        {
            float v[3]; float ss = 0.f;
#pragma unroll
            for (int j = 0; j < 3; ++j) { v[j] = pr[OFF_Q + j * 64 + lane]; ss += v[j] * v[j]; }
            ss = wave_sum(ss); const float rstd = rsqrtf(ss * (1.f / 192.f) + EPS);
#pragma unroll
            for (int j = 0; j < 3; ++j) ws[W_QN + (size_t)t * 192 + j * 64 + lane] = v[j] * rstd * p.in[I_QAN][l * 192 + j * 64 + lane];
        }
        {
            float v[2]; float ss = 0.f;
#pragma unroll
            for (int j = 0; j < 2; ++j) { v[j] = pr[OFF_KV + j * 64 + lane]; ss += v[j] * v[j]; }
            ss = wave_sum(ss); const float rstd = rsqrtf(ss * (1.f / 128.f) + EPS);
#pragma unroll
            for (int j = 0; j < 2; ++j) ws[W_KVN + (size_t)t * 128 + j * 64 + lane] = v[j] * rstd * p.in[I_KVAN][l * 128 + j * 64 + lane];
        }
        {
            const float4 zu = *(const float4*)(pr + OFF_C + lane * 4), zv = *(const float4*)(pr + OFF_C + 256 + lane * 4);
            float4 u; u.x = gelu_tanh(zu.x); u.y = gelu_tanh(zu.y); u.z = gelu_tanh(zu.z); u.w = gelu_tanh(zu.w);
            *(float4*)(ws + W_U + (size_t)t * 256 + lane * 4) = u;
            float gv[4] = {gelu_tanh(zv.x), gelu_tanh(zv.y), gelu_tanh(zv.z), gelu_tanh(zv.w)};
            const float mu = wave_sum(gv[0] + gv[1] + gv[2] + gv[3]) * (1.f / 256.f);
            float q = 0.f;
#pragma unroll
            for (int j = 0; j < 4; ++j) { gv[j] -= mu; q += gv[j] * gv[j]; }
            const float rstd = rsqrtf(wave_sum(q) * (1.f / 256.f) + EPS);
#pragma unroll
            for (int j = 0; j < 4; ++j) ws[W_VN + (size_t)t * 256 + lane * 4 + j] = gv[j] * rstd * p.in[I_SGG][l * 256 + lane * 4 + j] + p.in[I_SGB][l * 256 + lane * 4 + j];
        }
        {
            const float* cw = p.in[I_CONVW] + (size_t)l * 4 * 256;
            float4 o = *(const float4*)(p.in[I_CONVB] + l * 256 + lane * 4);
#pragma unroll
            for (int k = 0; k < 4; ++k) {
                const int m = n - 1 + k;
                if (m >= 0 && m < sl) {
                    const float4 xv = *(const float4*)(P + (size_t)(s0 + m) * INC + OFF_DX + lane * 4), wv = *(const float4*)(cw + k * 256 + lane * 4);
                    o.x = fmaf(xv.x, wv.x, o.x); o.y = fmaf(xv.y, wv.y, o.y); o.z = fmaf(xv.z, wv.z, o.z); o.w = fmaf(xv.w, wv.w, o.w);
                }
            }
            *(float4*)(ws + W_XC + (size_t)t * 256 + lane * 4) = o;
        }
    }
}

__device__ void phase_small(const Params& p, int l) {
    const int tid = tid_(), bid = bid_(); (void)tid; (void)bid;
    float* ws = p.ws;
    const size_t total = (size_t)T * 1664;
    for (size_t i = (size_t)bid * NTHR + tid; i < total; i += (size_t)gridDim.x * NTHR) {
        const int t = (int)(i / 1664); int o = (int)(i % 1664);
        if (o < 256) {
            const int g = o >> 6, j = o & 63;
            const float* d = ws + W_DIFF + (size_t)t * 256 + g * 64; const float* w = p.in[I_POOLW] + ((size_t)(l * 4 + g) * 64) * 64 + j;
            float a = 0.f;
            for (int c = 0; c < 64; ++c) a = fmaf(d[c], w[c * 64], a);
            ((bf16_t*)(ws + W_YC))[(size_t)t * D + o] = f2bf(a * p.in[I_POOLS][l * 256 + o]);
        } else if (o < 640) {
            o -= 256;
            const float* x = ws + W_QN + (size_t)t * 192; const float* w = p.in[I_WUQ] + (size_t)l * 192 * 384 + o;
            float a = 0.f;
            for (int c = 0; c < 192; ++c) a = fmaf(x[c], w[(size_t)c * 384], a);
            ws[W_QUP + (size_t)t * 384 + o] = a;
        } else if (o < 1152) {
            o -= 640;
            const float* x = ws + W_KVN + (size_t)t * 128; const float* w = p.in[I_WUKV] + (size_t)l * 128 * 512 + o;
            float a = 0.f;
            for (int c = 0; c < 128; ++c) a = fmaf(x[c], w[(size_t)c * 512], a);
            ws[W_KVUP + (size_t)t * 512 + o] = a;
        } else {
            o -= 1152;
            const int d = o >> 8, ch = o & 255, h = ch >> 6, j = ch & 63;
            const float* x = ws + W_XC + (size_t)t * 256 + h * 64;
            const float* wa = p.in[I_WA] + ((size_t)((l * 2 + d) * 4 + h) * 64) * 64 + j;
            const float* wx = p.in[I_WX] + ((size_t)((l * 2 + d) * 4 + h) * 64) * 64 + j;
            float ra = 0.f, rx = 0.f;
            for (int c = 0; c < 64; ++c) { const float xv = x[c]; ra = fmaf(xv, wa[c * 64], ra); rx = fmaf(xv, wx[c * 64], rx); }
            const int pi = (l * 2 + d) * 256 + ch;
            const float r = sigm(ra + p.in[I_BA][pi]), ig = sigm(rx + p.in[I_BX][pi]);
            const float lam = p.in[I_LAM][pi];
            const float sp = log1pf(expf(-lam));
            const float loga = -8.f * r * sp;
            const float a = expf(loga);
            const float drive = sqrtf(-expm1f(2.f * loga)) * (ig * x[j]);
            ws[W_LA + ((size_t)d * T + t) * 256 + ch] = a;
            ws[W_LB + ((size_t)d * T + t) * 256 + ch] = drive;
        }
    }
}

__device__ void phase_prep2(const Params& p, int l) {
    const int tid = tid_(), bid = bid_(); (void)tid; (void)bid;
    float* ws = p.ws;
    const int lane = tid & 63, gw = bid * (NTHR / 64) + (tid >> 6), nw = gridDim.x * (NTHR / 64);
    for (int it = gw; it < T * 4; it += nw) {
        const int t = it >> 2, h = it & 3;
        const bool lat = t < NLAT;
        float cs = 1.f, sn = 0.f;
        if (lat && lane < 32) {
            const int f = lane & 15; const float pos = (f < 8) ? (float)(t >> 6) : (float)(t & 63);
            const float inv = powf(10000.f, -(float)(f & 7) / 8.f);
            const float ang = pos * inv; cs = cosf(ang); sn = sinf(ang);
        }
        {
            float v0 = ws[W_QUP + (size_t)t * 384 + h * 96 + lane], v1 = (lane < 32) ? ws[W_QUP + (size_t)t * 384 + h * 96 + 64 + lane] : 0.f;
            const float rstd = rsqrtf(wave_sum(v0 * v0 + v1 * v1) * (1.f / 96.f) + EPS);
            v0 *= rstd * p.in[I_QN][l * 96 + lane]; v1 *= (lane < 32) ? rstd * p.in[I_QN][l * 96 + 64 + lane] : 0.f;
            const float pv = __shfl_xor(v1, 16);
            const float r1 = (lane < 16) ? v1 * cs - pv * sn : pv * sn + v1 * cs;
            ws[W_Q + (size_t)t * 384 + h * 96 + lane] = v0;
            if (lane < 32) ws[W_Q + (size_t)t * 384 + h * 96 + 64 + lane] = lat ? r1 : v1;
        }
        {
            float v0 = ws[W_KVUP + (size_t)t * 512 + h * 128 + lane], v1 = (lane < 32) ? ws[W_P + (size_t)t * INC + OFF_KR + lane] : 0.f;
            const float rstd = rsqrtf(wave_sum(v0 * v0 + v1 * v1) * (1.f / 96.f) + EPS);
            v0 *= rstd * p.in[I_KN][l * 96 + lane]; v1 *= (lane < 32) ? rstd * p.in[I_KN][l * 96 + 64 + lane] : 0.f;
            const float pv = __shfl_xor(v1, 16);
            const float r1 = (lane < 16) ? v1 * cs - pv * sn : pv * sn + v1 * cs;
            ws[W_K + (size_t)t * 384 + h * 96 + lane] = v0;
            if (lane < 32) ws[W_K + (size_t)t * 384 + h * 96 + 64 + lane] = lat ? r1 : v1;
            ws[W_V + (size_t)t * 256 + h * 64 + lane] = ws[W_KVUP + (size_t)t * 512 + h * 128 + 64 + lane];
        }
    }
    for (size_t i = (size_t)bid * NTHR + tid; i < (size_t)T * 256; i += (size_t)gridDim.x * NTHR) {
        const int t = (int)(i >> 8), ch = (int)(i & 255), c = t >> 7, pp = t & 127, h = ch >> 6;
        const float* w = p.in[I_SGWS] + ((size_t)(l * 4 + h) * 128 + pp) * 128;
        const float* vn = ws + W_VN + (size_t)c * 128 * 256 + ch;
        float a = 0.f;
        for (int q = 0; q < 128; ++q) a = fmaf(w[q], vn[(size_t)q * 256], a);
        a += p.in[I_SGBS][(l * 4 + h) * 128 + pp];
        ((bf16_t*)(ws + W_YC))[(size_t)t * D + 512 + ch] = f2bf(ws[W_U + (size_t)t * 256 + ch] * a);
    }
    for (int i = bid * NTHR + tid; i < NCHUNK * 512; i += gridDim.x * NTHR) {
        const int c = i >> 9, d = (i >> 8) & 1, ch = i & 255;
        float* A = ws + W_LA + ((size_t)d * T + (size_t)c * 128) * 256 + ch;
        float* B = ws + W_LB + ((size_t)d * T + (size_t)c * 128) * 256 + ch;
        float h = 0.f, ap = 1.f;
        for (int s = 0; s < 128; ++s) {
            const int q = d ? 127 - s : s;
            const float a = A[(size_t)q * 256], b = B[(size_t)q * 256];
            h = fmaf(a, h, b); ap *= a;
            A[(size_t)q * 256] = ap; B[(size_t)q * 256] = h;
        }
        ws[W_AGG + ((size_t)(c * 2 + d) * 2 + 0) * 256 + ch] = ap;
        ws[W_AGG + ((size_t)(c * 2 + d) * 2 + 1) * 256 + ch] = h;
    }
}

__device__ void lru_carries(const Params& p) {
    const int tid = tid_(), bid = bid_(); (void)tid; (void)bid;
    float* ws = p.ws;
    const int d = tid >> 8, ch = tid & 255;
    float s = 0.f;
    for (int k = 0; k < NCHUNK; ++k) {
        const int c = d ? (NCHUNK - 1 - k) : ((k + 128) % NCHUNK);
        ws[W_CARRY + (size_t)(c * 2 + d) * 256 + ch] = s;
        const float a = ws[W_AGG + ((size_t)(c * 2 + d) * 2 + 0) * 256 + ch], hh = ws[W_AGG + ((size_t)(c * 2 + d) * 2 + 1) * 256 + ch];
        s = fmaf(a, s, hh);
    }
}

__device__ void phase_attn(const Params& p) {
    const int tid = tid_(), bid = bid_(); (void)tid; (void)bid;
    float* ws = p.ws;
    const int nqb = T / 256;
    const float scale = 0.10206207261596577f;
    const int half = tid & 1;
    for (int it = bid; it < nqb * 4; it += gridDim.x) {
        const int h = it & 3, qb = it >> 2;
        const int t = qb * 256 + (tid >> 1);
        const int k0 = (qb * 256 >= NLAT) ? NLAT : 0;
        float q[48], o[32];
#pragma unroll
        for (int j = 0; j < 48; ++j) q[j] = ws[W_Q + (size_t)t * 384 + h * 96 + half * 48 + j] * scale;
#pragma unroll
        for (int j = 0; j < 32; ++j) o[j] = 0.f;
        float m = -1e30f, lsum = 0.f;
        for (int k = k0; k < T; ++k) {
            const float* kp = ws + W_K + (size_t)k * 384 + h * 96 + half * 48; const float* vp = ws + W_V + (size_t)k * 256 + h * 64 + half * 32;
            float s = 0.f;
#pragma unroll
            for (int j = 0; j < 48; ++j) s = fmaf(q[j], kp[j], s);
            s += __shfl_xor(s, 1);
            const float mn = fmaxf(m, s), corr = expf(m - mn), pe = expf(s - mn);
            lsum = lsum * corr + pe; m = mn;
#pragma unroll
            for (int j = 0; j < 32; ++j) o[j] = fmaf(pe, vp[j], o[j] * corr);
        }
        const float il = 1.f / lsum;
#pragma unroll
        for (int j = 0; j < 32; ++j) ((bf16_t*)(ws + W_YC))[(size_t)t * D + 256 + h * 64 + half * 32 + j] = f2bf(o[j] * il);
    }
}

__device__ void phase_lru_fin(const Params& p) {
    const int tid = tid_(), bid = bid_(); (void)tid; (void)bid;
    float* ws = p.ws;
    for (size_t i = (size_t)bid * NTHR + tid; i < (size_t)T * 256; i += (size_t)gridDim.x * NTHR) {
        const int t = (int)(i >> 8), ch = (int)(i & 255), c = t >> 7;
        float hs = 0.f;
#pragma unroll
        for (int d = 0; d < 2; ++d)
            hs += ws[W_LB + ((size_t)d * T + t) * 256 + ch] + ws[W_LA + ((size_t)d * T + t) * 256 + ch] * ws[W_CARRY + (size_t)(c * 2 + d) * 256 + ch];
        ((bf16_t*)(ws + W_YC))[(size_t)t * D + 768 + ch] = f2bf(gelu_tanh(ws[W_P + (size_t)t * INC + OFF_DG + ch]) * hs);
    }
}

__device__ void phase_outproj(const Params& p, int l, char* lds) {
    const int tid = tid_(), bid = bid_(); (void)tid;
    const float* Wm = p.in[I_WOUT] + (size_t)l * D * D;
    constexpr int ntn = D / 128, ntm = T / 256;
    const bf16_t* Y = (const bf16_t*)(p.ws + W_YC); float* X = p.ws + W_X;
    for (int tile = bid; tile < ntm * ntn; tile += gridDim.x) {
        const int tm = tile / ntn, tn = tile % ntn, m0 = tm * 256, n0 = tn * 128;
        const float* g1 = p.ws + W_MOD + (size_t)(l * 2 + (m0 >= NLAT ? 1 : 0)) * 6144 + 2 * D;
        gemm_unit<false>(lds, D, [&](int r) { return Y + (size_t)(m0 + r) * D; }, Wm + n0, Wm + n0, D, 128,
                  [&](const f32x4 (&acc)[4][4], int wr, int wc, int fr, int fq) {
#pragma unroll
                      for (int m = 0; m < 4; ++m) { float* row = X + (size_t)(m0 + wr * 64 + m * 16 + fr) * D;
#pragma unroll
                          for (int n = 0; n < 4; ++n) { const int col = n0 + wc * 64 + n * 16 + 4 * fq; const f32x4 g = *(const f32x4*)(g1 + col); f32x4 x = *(f32x4*)(row + col);
                              x = x + g * acc[m][n]; *(f32x4*)(row + col) = x; } }
                  });
    }
}

__device__ void phase_router(const Params& p, int l) {
    const int tid = tid_(), bid = bid_(); (void)tid; (void)bid;
    float* ws = p.ws;
    const int lane = tid & 63, gw = bid * (NTHR / 64) + (tid >> 6), nw = gridDim.x * (NTHR / 64);
    const float* rw = p.in[I_RW] + (size_t)l * D * NEXP;
    int* cnt = (int*)(ws + W_CNT) + l * NEXP;
    int* list = (int*)(ws + W_LIST);
    const int e = lane & 31, half = lane >> 5;
    for (int t = gw; t < T; t += nw) {
        const float* f = ws + W_H + (size_t)t * D + half * 512;
        const float* w = rw + (size_t)half * 512 * NEXP + e;
        float a = 0.f;
        for (int k = 0; k < 512; ++k) a = fmaf(f[k], w[(size_t)k * NEXP], a);
        a += __shfl_xor(a, 32);
        a += p.in[I_RB][l * NEXP + e];
        float tv[4]; int te[4];
        float cur = a;
#pragma unroll
        for (int k = 0; k < 4; ++k) {
            float bv = cur; int bi = e;
#pragma unroll
            for (int o = 16; o > 0; o >>= 1) {
                const float ov = __shfl_xor(bv, o); const int oi = __shfl_xor(bi, o);
                if (ov > bv || (ov == bv && oi < bi)) { bv = ov; bi = oi; }
            }
            tv[k] = bv; te[k] = bi;
            if (e == bi) cur = -3.0e38f;
        }
        const float mx = tv[0];
        float ex[4], s = 0.f;
#pragma unroll
        for (int k = 0; k < 4; ++k) { ex[k] = expf(tv[k] - mx); s += ex[k]; }
        if (lane < 4) {
            const int ee = te[lane];
            const int idx = atomicAdd(&cnt[ee], 1);
            list[(size_t)ee * T + idx] = t;
            ((int*)(ws + W_TOPE))[t * 4 + lane] = ee;
            ((int*)(ws + W_TOPI))[t * 4 + lane] = idx;
            ws[W_TOPG + t * 4 + lane] = ex[lane] / s;
        }
    }
}

DEVI void moe_bases(const Params& p, int l, int* sb) {
    const int tid = tid_();
    if (tid == 0) {
        const int* cnt = (const int*)(p.ws + W_CNT) + l * NEXP;
        int b = 0, tb = 0;
        for (int e = 0; e < NEXP; ++e) { sb[e] = b; sb[40 + e] = tb; const int c = cnt[e]; sb[80 + e] = c; const int mt = (c + 255) / 256; b += mt * 256; tb += mt; }
        sb[32] = b; sb[72] = tb;
    }
    __syncthreads();
}

__device__ void phase_moe1(const Params& p, int l, char* lds) {
    const int tid = tid_(), bid = bid_(); (void)tid;
    int* sb = (int*)(lds + G_LDS);
    moe_bases(p, l, sb);
    constexpr int ntn = 16;
    const int nunits = sb[72] * ntn;
    const int* list = (const int*)(p.ws + W_LIST);
    const bf16_t* HB = (const bf16_t*)(p.ws + W_HB); bf16_t* ACT = (bf16_t*)(p.ws + W_ACT);
    for (int u = bid; u < nunits; u += gridDim.x) {
        int e = 0; while (e < NEXP - 1 && sb[40 + e + 1] * ntn <= u) ++e;
        const int mts = sb[40 + e + 1] - sb[40 + e], loc = u - sb[40 + e] * ntn, tn = loc / mts, mt = loc % mts;
        const int mloc = mt * 256, cnt = sb[80 + e], rbase = sb[e] + mloc;
        const float* Wm = p.in[I_WGU] + ((size_t)(l * NEXP + e) * D) * 2048 + tn * 64;
        const float* bias = p.in[I_BGU] + (size_t)(l * NEXP + e) * 2048 + tn * 64;
        const int* le = list + (size_t)e * T + mloc;
        gemm_unit<true>(lds, D, [&](int r) { return (mloc + r < cnt) ? HB + (size_t)le[r] * D : (const bf16_t*)nullptr; }, Wm, Wm + 1024, 2048, 64,
                  [&](const f32x4 (&acc)[4][4], int wr, int wc, int fr, int fq) {
#pragma unroll
                      for (int m = 0; m < 4; ++m) { const int r = wr * 64 + m * 16 + fr;
                          if (mloc + r < cnt) {
#pragma unroll
                              for (int pp = 0; pp < 2; ++pp) { const int idx = (wc * 2 + pp) * 16 + 4 * fq;
                                  const f32x4 bg = *(const f32x4*)(bias + idx), bu = *(const f32x4*)(bias + 1024 + idx);
                                  float a[4];
#pragma unroll
                                  for (int j = 0; j < 4; ++j) { float g = acc[m][2 * pp][j] + bg[j], uu = acc[m][2 * pp + 1][j] + bu[j];
                                      g = fminf(g, 7.f); uu = fminf(fmaxf(uu, -7.f), 7.f); a[j] = (uu + 1.f) * (g * sigm(1.702f * g)); }
                                  u32x2 w; w.x = cvt_pk_bf16(a[0], a[1]); w.y = cvt_pk_bf16(a[2], a[3]);
                                  *(u32x2*)(ACT + (size_t)(rbase + r) * D + tn * 64 + idx) = w; } } }
                  });
    }
    __syncthreads();
}

__device__ void phase_moe2(const Params& p, int l, char* lds) {
    const int tid = tid_(), bid = bid_(); (void)tid;
    int* sb = (int*)(lds + G_LDS);
    moe_bases(p, l, sb);
    constexpr int ntn = D / 128;
    const int nunits = sb[72] * ntn;
    const bf16_t* ACT = (const bf16_t*)(p.ws + W_ACT); bf16_t* YR = (bf16_t*)(p.ws + W_YR);
    for (int u = bid; u < nunits; u += gridDim.x) {
        int e = 0; while (e < NEXP - 1 && sb[40 + e + 1] * ntn <= u) ++e;
        const int mts = sb[40 + e + 1] - sb[40 + e], loc = u - sb[40 + e] * ntn, tn = loc / mts, mt = loc % mts;
        const int mloc = mt * 256, cnt = sb[80 + e], rbase = sb[e] + mloc, n0 = tn * 128;
        const float* Wm = p.in[I_WDN] + ((size_t)(l * NEXP + e) * D) * D + n0;
        const float* bias = p.in[I_BDN] + (size_t)(l * NEXP + e) * D + n0;
        gemm_unit<false>(lds, D, [&](int r) { return (mloc + r < cnt) ? ACT + (size_t)(rbase + r) * D : (const bf16_t*)nullptr; }, Wm, Wm, D, 128,
                  [&](const f32x4 (&acc)[4][4], int wr, int wc, int fr, int fq) {
#pragma unroll
                      for (int m = 0; m < 4; ++m) { const int r = wr * 64 + m * 16 + fr;
                          if (mloc + r < cnt) {
#pragma unroll
                              for (int n = 0; n < 4; ++n) { const int c = wc * 64 + n * 16 + 4 * fq; const f32x4 b = *(const f32x4*)(bias + c); const f32x4 v = acc[m][n] + b;
                                  u32x2 w; w.x = cvt_pk_bf16(v[0], v[1]); w.y = cvt_pk_bf16(v[2], v[3]);
                                  *(u32x2*)(YR + (size_t)(rbase + r) * D + n0 + c) = w; } } }
                  });
    }
    __syncthreads();
}

__device__ void phase_combine(const Params& p, int l, char* lds, bool last) {
    const int tid = tid_(), bid = bid_();
    int* sb = (int*)(lds + G_LDS);
    moe_bases(p, l, sb);
    float* ws = p.ws;
    const bf16_t* YR = (const bf16_t*)(ws + W_YR);
    const int lane = tid & 63, gw = bid * (NTHR / 64) + (tid >> 6), nw = gridDim.x * (NTHR / 64);
    for (int t = gw; t < T; t += nw) {
        const float* g2 = ws + W_MOD + (size_t)(l * 2 + (t >= NLAT ? 1 : 0)) * 6144 + 5 * D;
        const bf16_t* yr[4]; float gt[4];
#pragma unroll
        for (int k = 0; k < 4; ++k) {
            const int e = ((const int*)(ws + W_TOPE))[t * 4 + k], idx = ((const int*)(ws + W_TOPI))[t * 4 + k];
            yr[k] = YR + (size_t)(sb[e] + idx) * D; gt[k] = ws[W_TOPG + t * 4 + k];
        }
        float* x = ws + W_X + (size_t)t * D;
#pragma unroll
        for (int j = 0; j < 4; ++j) {
            const int c = j * 256 + lane * 4;
            float a0 = 0.f, a1 = 0.f, a2 = 0.f, a3 = 0.f;
#pragma unroll
            for (int k = 0; k < 4; ++k) { const u32x2 y = *(const u32x2*)(yr[k] + c);
                a0 = fmaf(gt[k], __uint_as_float(y.x << 16), a0); a1 = fmaf(gt[k], __uint_as_float(y.x & 0xffff0000u), a1);
                a2 = fmaf(gt[k], __uint_as_float(y.y << 16), a2); a3 = fmaf(gt[k], __uint_as_float(y.y & 0xffff0000u), a3); }
            float4 xv = *(const float4*)(x + c); const float4 gg = *(const float4*)(g2 + c);
            xv.x = fmaf(gg.x, a0, xv.x); xv.y = fmaf(gg.y, a1, xv.y); xv.z = fmaf(gg.z, a2, xv.z); xv.w = fmaf(gg.w, a3, xv.w);
            *(float4*)(x + c) = xv;
            if (last && t < NLAT) *(float4*)(p.out + (size_t)t * D + c) = xv;
        }
    }
    __syncthreads();
}

constexpr int LDS_BYTES = G_LDS + 2048;
__global__ void __launch_bounds__(NTHR) fwd_kernel(Params p) {
    cg::grid_group grid = cg::this_grid();
    extern __shared__ __attribute__((aligned(16))) char lds[];
    float* smem = (float*)lds;
    phase_init(p);
    phase_mod(p, smem);
    grid.sync();
    for (int l = 0; l < NLAYER; ++l) {
        phase_norm(p, l, 0);
        grid.sync();
        phase_inproj(p, l, lds);
        grid.sync();
        phase_prep1(p, l);
        grid.sync();
        phase_small(p, l);
        grid.sync();
        phase_prep2(p, l);
        grid.sync();
        if (blockIdx.x == gridDim.x - 1) lru_carries(p);
        phase_attn(p);
        grid.sync();
        phase_lru_fin(p);
        grid.sync();
        phase_outproj(p, l, lds);
        grid.sync();
        phase_norm(p, l, 1);
        grid.sync();
        phase_router(p, l);
        grid.sync();
        phase_moe1(p, l, lds);
        grid.sync();
        phase_moe2(p, l, lds);
        grid.sync();
        phase_combine(p, l, lds, l == NLAYER - 1);
        grid.sync();
    }
}

extern "C" void kernel_launch(void* const* d_in, const int* in_sizes, int n_in, void* d_out, int out_size, void* d_ws, size_t ws_size, hipStream_t stream) {
    static int grid_blocks = 0;
    if (!grid_blocks) {
        int dev = 0, cus = 0, per_cu = 0;
        (void)hipGetDevice(&dev);
        (void)hipDeviceGetAttribute(&cus, hipDeviceAttributeMultiprocessorCount, dev);
        if (hipFuncSetAttribute((const void*)fwd_kernel, hipFuncAttributeMaxDynamicSharedMemorySize, LDS_BYTES) != hipSuccess) fprintf(stderr, "kernel_launch: hipFuncSetAttribute failed\n");
        if (hipOccupancyMaxActiveBlocksPerMultiprocessor(&per_cu, fwd_kernel, NTHR, LDS_BYTES) != hipSuccess || per_cu < 1) { fprintf(stderr, "kernel_launch: occupancy query says %d\n", per_cu); per_cu = 1; }
        if (per_cu > 1) per_cu = 1;
        grid_blocks = cus * per_cu;
        if (ws_size < W_END * sizeof(float)) fprintf(stderr, "kernel_launch: workspace too small: %zu < %zu\n", ws_size, W_END * sizeof(float));
        if (n_in != N_IN) fprintf(stderr, "kernel_launch: n_in %d != %d\n", n_in, (int)N_IN);
    }
    Params p{};
    for (int i = 0; i < N_IN; ++i) p.in[i] = (const float*)d_in[i];
    p.out = (float*)d_out;
    p.ws = (float*)d_ws;
    void* args[] = {&p};
    hipError_t e = hipLaunchCooperativeKernel((void*)fwd_kernel, dim3(grid_blocks), dim3(NTHR), args, LDS_BYTES, stream);
    if (e != hipSuccess) fprintf(stderr, "cooperative launch failed: %s (grid %d)\n", hipGetErrorString(e), grid_blocks);
}
```

```cpp
#include <hip/hip_runtime.h>
#include <hip/hip_cooperative_groups.h>
#include <cstdio>
#include <cstdint>
namespace cg = cooperative_groups;

#define DEVI __device__ __forceinline__
constexpr int NTHR = 512;
constexpr int D = 1024, NLAT = 16384, NCTX = 256, T = NLAT + NCTX, NLAYER = 2;
constexpr int INC = 1632;
constexpr int OFF_A = 0, OFF_Q = 256, OFF_KV = 448, OFF_KR = 576, OFF_C = 608, OFF_DX = 1120, OFF_DG = 1376;
constexpr int NCHUNK = T / 128;
constexpr int NEXP = 32, TOPK = 4;
constexpr int MAXROWS = T * TOPK + NEXP * 256;
constexpr float EPS = 1e-6f;

enum { I_X = 0, I_C, I_CTX, I_CCTX, I_WMOD, I_BMOD, I_NMIX, I_NFFN, I_WIN, I_WOUT, I_POOLW, I_POOLS, I_QAN, I_WUQ, I_KVAN, I_WUKV,
       I_QN, I_KN, I_SGG, I_SGB, I_SGWS, I_SGBS, I_CONVW, I_CONVB, I_WA, I_BA, I_WX, I_BX, I_LAM, I_RW, I_RB, I_WGU, I_BGU, I_WDN, I_BDN, N_IN };

constexpr size_t al(size_t x) { return (x + 63) / 64 * 64; }
constexpr size_t W_X = 0;
constexpr size_t W_MOD = W_X + al((size_t)T * D);
constexpr size_t W_H = W_MOD + al(2 * 2 * 6144);
constexpr size_t W_P = W_H + al((size_t)T * D);
constexpr size_t W_YC = W_P + al((size_t)T * INC);
constexpr size_t W_Q = W_YC + al((size_t)T * D);
constexpr size_t W_K = W_Q + al((size_t)T * 384);
constexpr size_t W_V = W_K + al((size_t)T * 384);
constexpr size_t W_DIFF = W_V + al((size_t)T * 256);
constexpr size_t W_QN = W_DIFF + al((size_t)T * 256);
constexpr size_t W_KVN = W_QN + al((size_t)T * 192);
constexpr size_t W_U = W_KVN + al((size_t)T * 128);
constexpr size_t W_VN = W_U + al((size_t)T * 256);
constexpr size_t W_XC = W_VN + al((size_t)T * 256);
constexpr size_t W_QUP = W_XC + al((size_t)T * 256);
constexpr size_t W_KVUP = W_QUP + al((size_t)T * 384);
constexpr size_t W_LA = W_KVUP + al((size_t)T * 512);
constexpr size_t W_LB = W_LA + al((size_t)2 * T * 256);
constexpr size_t W_AGG = W_LB + al((size_t)2 * T * 256);
constexpr size_t W_CARRY = W_AGG + al((size_t)NCHUNK * 2 * 2 * 256);
constexpr size_t W_TOPE = W_CARRY + al((size_t)NCHUNK * 2 * 256);
constexpr size_t W_TOPG = W_TOPE + al((size_t)T * 4);
constexpr size_t W_TOPI = W_TOPG + al((size_t)T * 4);
constexpr size_t W_CNT = W_TOPI + al((size_t)T * 4);
constexpr size_t W_LIST = W_CNT + al(64);
constexpr size_t W_ACT = W_LIST + al((size_t)NEXP * T);
constexpr size_t W_YR = W_ACT + al((size_t)MAXROWS * D);
constexpr size_t W_HB = W_YR + al((size_t)MAXROWS * D);
constexpr size_t W_END = W_HB + al((size_t)T * D / 2);

struct Params {
    const float* in[N_IN];
    float* out;
    float* ws;
};

DEVI int tid_() { int t = threadIdx.x; asm volatile("" : "+v"(t)); return t; }
DEVI int bid_() { int b = blockIdx.x; asm volatile("" : "+s"(b)); return b; }
DEVI float wave_sum(float v) {
#pragma unroll
    for (int o = 32; o > 0; o >>= 1) v += __shfl_xor(v, o);
    return v;
}
DEVI float gelu_tanh(float x) { const float u = 0.7978845608028654f * (x + 0.044715f * x * x * x); return 0.5f * x * (1.f + tanhf(u)); }
DEVI float sigm(float x) { return 1.f / (1.f + expf(-x)); }
DEVI float silu(float x) { return x * sigm(x); }


typedef unsigned short bf16_t;
typedef short bf16x8 __attribute__((ext_vector_type(8)));
typedef float f32x4 __attribute__((ext_vector_type(4)));
typedef unsigned u32x4 __attribute__((ext_vector_type(4)));
typedef unsigned u32x2 __attribute__((ext_vector_type(2)));
DEVI unsigned cvt_pk_bf16(float lo, float hi) { unsigned r; asm volatile("v_cvt_pk_bf16_f32 %0, %1, %2" : "=v"(r) : "v"(lo), "v"(hi)); return r; }
DEVI bf16_t f2bf(float f) { return (bf16_t)(cvt_pk_bf16(f, 0.f) & 0xffffu); }
DEVI float bf2f(bf16_t b) { return __uint_as_float(((unsigned)b) << 16); }

constexpr int G_STAGE = 49152;
constexpr int G_LDS = 2 * G_STAGE;
DEVI int lds_byte(int r, int c) { const int st = (r >> 4) * 2 + (c >> 5), rr = r & 15, cc = c & 31, ob = rr * 64 + cc * 2; return st * 1024 + (ob ^ (((ob >> 9) & 1) << 5)); }

template <bool PAIRED, class ARow, class Epi>
DEVI void gemm_unit(char* lds, int K, ARow arow, const float* __restrict__ B0, const float* __restrict__ B1, int ldb, int ncol_valid, Epi epi) {
    const int tid = tid_(), wave = tid >> 6, lane = tid & 63, fr = lane & 15, fq = lane >> 4, wr = wave >> 1, wc = wave & 1;
    const int ac = tid & 7;
    const bf16_t* ap[4]; int a_lds[4];
#pragma unroll
    for (int i = 0; i < 4; ++i) { const int r = (tid >> 3) + 64 * i; const bf16_t* q = arow(r); ap[i] = q ? q + ac * 8 : nullptr; a_lds[i] = (r >> 7) * 16384 + lds_byte(r & 127, ac * 8); }
    const int kq = lane & 15, nq = (lane >> 4) + 4 * wave;
    const float* bp; bool bvalid;
    if (PAIRED) { const int seg = (nq >> 2) & 1, idx = (nq >> 3) * 16 + (nq & 3) * 4; bp = (seg ? B1 : B0) + idx; bvalid = idx < ncol_valid; }
    else { bp = B0 + 4 * nq; bvalid = 4 * nq < ncol_valid; }
    bp += (size_t)(4 * kq) * ldb;
    int b_lds[4];
#pragma unroll
    for (int i = 0; i < 4; ++i) b_lds[i] = 32768 + lds_byte(4 * nq + i, 4 * kq);
    const int aoff = (wr >> 1) * 16384 + lds_byte((wr & 1) * 64 + fr, fq * 8), boff = 32768 + lds_byte(wc * 64 + fr, fq * 8);
    u32x4 av[4]; f32x4 bv[4];
#define G_LOAD(t) do { _Pragma("unroll") for (int i = 0; i < 4; ++i) av[i] = ap[i] ? *(const u32x4*)(ap[i] + (t) * 64) : (u32x4){0u, 0u, 0u, 0u}; \
        _Pragma("unroll") for (int kk = 0; kk < 4; ++kk) bv[kk] = bvalid ? *(const f32x4*)(bp + ((size_t)(t) * 64 + kk) * ldb) : (f32x4){0.f, 0.f, 0.f, 0.f}; } while (0)
#define G_WRITE(buf) do { char* s_ = lds + (buf) * G_STAGE; _Pragma("unroll") for (int i = 0; i < 4; ++i) *(u32x4*)(s_ + a_lds[i]) = av[i]; \
        _Pragma("unroll") for (int i = 0; i < 4; ++i) { u32x2 w_; w_.x = cvt_pk_bf16(bv[0][i], bv[1][i]); w_.y = cvt_pk_bf16(bv[2][i], bv[3][i]); *(u32x2*)(s_ + b_lds[i]) = w_; } } while (0)
    f32x4 acc[4][4];
#pragma unroll
    for (int m = 0; m < 4; ++m)
#pragma unroll
        for (int n = 0; n < 4; ++n) acc[m][n] = (f32x4){0.f, 0.f, 0.f, 0.f};
    const int nk = K >> 6;
    G_LOAD(0);
    G_WRITE(0);
    if (nk > 1) G_LOAD(1);
    __syncthreads();
    for (int t = 0; t < nk; ++t) {
        const char* s_ = lds + (t & 1) * G_STAGE;
#pragma unroll
        for (int k = 0; k < 2; ++k) {
            bf16x8 Af[4], Bf[4];
#pragma unroll
            for (int m = 0; m < 4; ++m) Af[m] = *(const bf16x8*)(s_ + aoff + m * 2048 + k * 1024);
#pragma unroll
            for (int n = 0; n < 4; ++n) Bf[n] = *(const bf16x8*)(s_ + boff + n * 2048 + k * 1024);
#pragma unroll
            for (int m = 0; m < 4; ++m)
#pragma unroll
                for (int n = 0; n < 4; ++n) acc[m][n] = __builtin_amdgcn_mfma_f32_16x16x32_bf16(Bf[n], Af[m], acc[m][n], 0, 0, 0);
        }
        if (t + 1 < nk) { G_WRITE((t + 1) & 1); if (t + 2 < nk) G_LOAD(t + 2); }
        __syncthreads();
    }
#undef G_LOAD
#undef G_WRITE
    epi(acc, wr, wc, fr, fq);
}


namespace att {
typedef short s16x4 __attribute__((ext_vector_type(4)));
typedef float f32x16 __attribute__((ext_vector_type(16)));
constexpr int KVBLK = 64;
constexpr float SCALE = 0.10206207261596577f;
constexpr float THR = 8.f;
constexpr int SHM_V = 16384, SHM_K = 16384, SHM_ATTN = 2 * SHM_V + 2 * SHM_K + 8 * 64 * 4;
#define KSWZ(row, colB) ((row) * 256 + ((colB) ^ (((row) & 7) << 4)))
#define SBAR() __builtin_amdgcn_sched_barrier(0)
DEVI int crow(int r, int hi) { return (r & 3) + 8 * (r >> 2) + 4 * hi; }
DEVI void partialSM(f32x16& p0, f32x16& p1, float& m_reg, float& mn, float& alpha) {
    constexpr float C = SCALE * 1.4426950408889634f;
    float pmax = p0[0];
#pragma unroll
    for (int r = 1; r < 16; ++r) pmax = fmaxf(pmax, p0[r]);
#pragma unroll
    for (int r = 0; r < 16; ++r) pmax = fmaxf(pmax, p1[r]);
    { auto rr = __builtin_amdgcn_permlane32_swap(__float_as_uint(pmax), __float_as_uint(pmax), false, false);
      pmax = fmaxf(__uint_as_float(rr[0]), __uint_as_float(rr[1])); }
    if (__builtin_expect(__all(pmax - m_reg <= THR / SCALE), 1)) { mn = m_reg; alpha = 1.f; }
    else { mn = fmaxf(m_reg, pmax); alpha = __builtin_amdgcn_exp2f((m_reg - mn) * C); m_reg = mn; }
    const float mnC = -mn * C;
#pragma unroll
    for (int r = 0; r < 16; ++r) p0[r] = fmaf(p0[r], C, mnC);
#pragma unroll
    for (int r = 0; r < 16; ++r) p1[r] = fmaf(p1[r], C, mnC);
#pragma unroll
    for (int r = 0; r < 16; ++r) p0[r] = __builtin_amdgcn_exp2f(p0[r]);
}
DEVI void finishSM(f32x16& p0, f32x16& p1, float alpha, float& l_reg, bf16x8& pa0, bf16x8& pa1, bf16x8& pa2, bf16x8& pa3) {
#pragma unroll
    for (int r = 0; r < 16; ++r) p1[r] = __builtin_amdgcn_exp2f(p1[r]);
    float ps = 0.f;
#pragma unroll
    for (int r = 0; r < 16; ++r) ps += p0[r];
#pragma unroll
    for (int r = 0; r < 16; ++r) ps += p1[r];
    { auto rr = __builtin_amdgcn_permlane32_swap(__float_as_uint(ps), __float_as_uint(ps), false, false);
      ps = __uint_as_float(rr[0]) + __uint_as_float(rr[1]); }
    l_reg = l_reg * alpha + ps;
#define PK4(P, BASE, OUT) do { unsigned a0 = cvt_pk_bf16(P[BASE + 0], P[BASE + 1]), a1 = cvt_pk_bf16(P[BASE + 2], P[BASE + 3]);   \
    unsigned b0 = cvt_pk_bf16(P[BASE + 4], P[BASE + 5]), b1 = cvt_pk_bf16(P[BASE + 6], P[BASE + 7]);                              \
    auto r0 = __builtin_amdgcn_permlane32_swap(a0, b0, false, false); auto r1 = __builtin_amdgcn_permlane32_swap(a1, b1, false, false); \
    u32x4 w = {r0[0], r1[0], r0[1], r1[1]}; OUT = *reinterpret_cast<bf16x8*>(&w); } while (0)
    PK4(p0, 0, pa0); PK4(p0, 8, pa1); PK4(p1, 0, pa2); PK4(p1, 8, pa3);
#undef PK4
}
DEVI void qkt(f32x16& p0, f32x16& p1, const char* Ks, const bf16x8* qr, int r32, int hi) {
    p0 = f32x16{}; p1 = f32x16{};
#pragma unroll
    for (int d0 = 0; d0 < 6; ++d0) { const int cb = (d0 * 16 + hi * 8) * 2;
        const bf16x8 b0 = *reinterpret_cast<const bf16x8*>(Ks + KSWZ(r32, cb));
        const bf16x8 b1 = *reinterpret_cast<const bf16x8*>(Ks + KSWZ(32 + r32, cb));
        p0 = __builtin_amdgcn_mfma_f32_32x32x16_bf16(b0, qr[d0], p0, 0, 0, 0);
        p1 = __builtin_amdgcn_mfma_f32_32x32x16_bf16(b1, qr[d0], p1, 0, 0, 0); }
}
DEVI int v_st(int k, int c) { const int kk = (k & ~0xC) | ((k & 4) << 1) | ((k & 8) >> 1); return ((kk >> 3) * 4 + (c >> 5)) * 512 + ((kk & 7) * 32 + (c & 31)) * 2; }
DEVI int v_rd_base(int lane) { return ((lane & 3) << 3) | (((lane >> 2) & 3) << 6) | (((lane >> 4) & 1) << 5) | (((lane >> 5) & 1) << 8); }
constexpr int v_rd_off(int d0, int ks, int half) { return d0 * 512 + ks * 4096 + half * 2048; }
template <int OFF> DEVI s16x4 tr_read(int vb) {
    s16x4 r; asm volatile("ds_read_b64_tr_b16 %0, %1 offset:%2" : "=&v"(r) : "v"(vb), "i"(OFF) : "memory"); return r;
}
template <int D0> DEVI void pv_one(f32x16& od, int vb, bf16x8 pa0, bf16x8 pa1, bf16x8 pa2, bf16x8 pa3) {
    const s16x4 l0 = tr_read<v_rd_off(D0, 0, 0)>(vb), h0 = tr_read<v_rd_off(D0, 0, 1)>(vb), l1 = tr_read<v_rd_off(D0, 1, 0)>(vb), h1 = tr_read<v_rd_off(D0, 1, 1)>(vb);
    const s16x4 l2 = tr_read<v_rd_off(D0, 2, 0)>(vb), h2 = tr_read<v_rd_off(D0, 2, 1)>(vb), l3 = tr_read<v_rd_off(D0, 3, 0)>(vb), h3 = tr_read<v_rd_off(D0, 3, 1)>(vb);
    asm volatile("s_waitcnt lgkmcnt(0)" ::: "memory"); SBAR();
#define PKV(L, H) (bf16x8){L[0], L[1], L[2], L[3], H[0], H[1], H[2], H[3]}
    od = __builtin_amdgcn_mfma_f32_32x32x16_bf16(pa0, PKV(l0, h0), od, 0, 0, 0);
    od = __builtin_amdgcn_mfma_f32_32x32x16_bf16(pa1, PKV(l1, h1), od, 0, 0, 0);
    od = __builtin_amdgcn_mfma_f32_32x32x16_bf16(pa2, PKV(l2, h2), od, 0, 0, 0);
    od = __builtin_amdgcn_mfma_f32_32x32x16_bf16(pa3, PKV(l3, h3), od, 0, 0, 0);
#undef PKV
}
DEVI void pv_d0(f32x16* o, int vb, bf16x8 pa0, bf16x8 pa1, bf16x8 pa2, bf16x8 pa3) {
    pv_one<0>(o[0], vb, pa0, pa1, pa2, pa3); pv_one<1>(o[1], vb, pa0, pa1, pa2, pa3);
}
DEVI void attn_unit(const bf16_t* __restrict__ Qb, const bf16_t* __restrict__ Kh, const bf16_t* __restrict__ Vh, int seq, bf16_t* __restrict__ Ob, int ldo, char* lds) {
    const int tid = tid_(), wid = tid >> 6, lane = tid & 63, r32 = lane & 31, hi = lane >> 5;
    char* V_lds = lds; char* K_lds = lds + 2 * SHM_V;
    float* wsl = (float*)(lds + 2 * SHM_V + 2 * SHM_K) + wid * 64; float* li_l = wsl; float* al_l = wsl + 32;
    float m_reg = -1e30f, l_reg = 0.f; f32x16 o[2] = {}; bf16x8 qr[6];
    const bf16_t* Qw = Qb + (size_t)(wid * 32 + r32) * 96 + hi * 8;
#pragma unroll
    for (int d0 = 0; d0 < 6; ++d0) qr[d0] = *reinterpret_cast<const bf16x8*>(Qw + d0 * 16);
    const int sr = tid >> 4, kc = tid & 15, kcl = (kc < 12 ? kc : 11) * 8;
    const int vr = tid >> 3, vc = (tid & 7) * 8, vst0 = v_st(vr, vc);
    const int kst0 = KSWZ(sr, kc * 16), kst1 = KSWZ(32 + sr, kc * 16);
    const int vb0 = (int)(uintptr_t)V_lds + v_rd_base(lane);
    bf16x8 sv0, sk00, sk01, sv1, sk10, sk11;
#define SLOAD0(k0) do { sv0 = *reinterpret_cast<const bf16x8*>(Vh + (size_t)((k0) + vr) * 64 + vc); sk00 = *reinterpret_cast<const bf16x8*>(Kh + (size_t)((k0) + sr) * 96 + kcl); \
    sk01 = *reinterpret_cast<const bf16x8*>(Kh + (size_t)((k0) + 32 + sr) * 96 + kcl); } while (0)
#define SLOAD1(k0) do { sv1 = *reinterpret_cast<const bf16x8*>(Vh + (size_t)((k0) + vr) * 64 + vc); sk10 = *reinterpret_cast<const bf16x8*>(Kh + (size_t)((k0) + sr) * 96 + kcl); \
    sk11 = *reinterpret_cast<const bf16x8*>(Kh + (size_t)((k0) + 32 + sr) * 96 + kcl); } while (0)
#define SWRITE0(b) do { *(bf16x8*)(V_lds + (b) * SHM_V + vst0) = sv0; *(bf16x8*)(K_lds + (b) * SHM_K + kst0) = sk00; *(bf16x8*)(K_lds + (b) * SHM_K + kst1) = sk01; } while (0)
#define SWRITE1(b) do { *(bf16x8*)(V_lds + (b) * SHM_V + vst0) = sv1; *(bf16x8*)(K_lds + (b) * SHM_K + kst0) = sk10; *(bf16x8*)(K_lds + (b) * SHM_K + kst1) = sk11; } while (0)
#define SWAIT() asm volatile("s_waitcnt vmcnt(3)" ::: "memory")
#define RESC(a) do { if (__any((a) < 1.f)) { if (hi == 0) al_l[r32] = (a); asm volatile("s_waitcnt lgkmcnt(0)" ::: "memory"); \
    _Pragma("unroll") for (int d = 0; d < 2; ++d) _Pragma("unroll") for (int r = 0; r < 16; ++r) o[d][r] *= al_l[crow(r, hi)]; } } while (0)
    f32x16 pA0, pA1, pB0, pB1; float mnA, mnB, alA, alB; bf16x8 pa0, pa1, pa2, pa3; const int NT = seq / KVBLK;
    SLOAD0(0); asm volatile("s_waitcnt vmcnt(0)" ::: "memory"); SWRITE0(0); __syncthreads();
    qkt(pA0, pA1, K_lds, qr, r32, hi); partialSM(pA0, pA1, m_reg, mnA, alA);
    SLOAD1(KVBLK); if (2 < NT) SLOAD0(2 * KVBLK);
    SWAIT(); SWRITE1(1); __syncthreads();
    for (int j = 1; j + 1 < NT; j += 2) {
        SBAR(); qkt(pB0, pB1, K_lds + SHM_K, qr, r32, hi);
        finishSM(pA0, pA1, alA, l_reg, pa0, pa1, pa2, pa3); SBAR();
        SLOAD1((j + 2) * KVBLK); SBAR();
        pv_d0(o, vb0, pa0, pa1, pa2, pa3); partialSM(pB0, pB1, m_reg, mnB, alB);
        __syncthreads(); SWAIT(); SWRITE0(0);
        RESC(alB); __syncthreads();
        SBAR(); qkt(pA0, pA1, K_lds, qr, r32, hi);
        finishSM(pB0, pB1, alB, l_reg, pa0, pa1, pa2, pa3); SBAR();
        if (j + 3 < NT) SLOAD0((j + 3) * KVBLK); SBAR();
        pv_d0(o, vb0 + SHM_V, pa0, pa1, pa2, pa3); partialSM(pA0, pA1, m_reg, mnA, alA);
        __syncthreads(); SWAIT(); SWRITE1(1);
        RESC(alA); __syncthreads();
    }
    SBAR(); qkt(pB0, pB1, K_lds + SHM_K, qr, r32, hi);
    finishSM(pA0, pA1, alA, l_reg, pa0, pa1, pa2, pa3); SBAR();
    pv_d0(o, vb0, pa0, pa1, pa2, pa3); partialSM(pB0, pB1, m_reg, mnB, alB);
    __syncthreads(); RESC(alB);
    finishSM(pB0, pB1, alB, l_reg, pa0, pa1, pa2, pa3); SBAR();
    pv_d0(o, vb0 + SHM_V, pa0, pa1, pa2, pa3);
    if (hi == 0) li_l[r32] = l_reg; asm volatile("s_waitcnt lgkmcnt(0)" ::: "memory");
    float rli[16];
#pragma unroll
    for (int r = 0; r < 16; ++r) rli[r] = __builtin_amdgcn_rcpf(li_l[crow(r, hi)]);
    bf16_t* Ow = Ob + (size_t)(wid * 32) * ldo;
#pragma unroll
    for (int r = 0; r < 16; ++r) { const int orow = crow(r, hi);
#pragma unroll
        for (int d0 = 0; d0 < 2; ++d0) Ow[(size_t)orow * ldo + d0 * 32 + r32] = f2bf(o[d0][r] * rli[r]); }
    __syncthreads();
#undef SLOAD0
#undef SLOAD1
#undef SWRITE0
#undef SWRITE1
#undef SWAIT
#undef RESC
}
#undef KSWZ
#undef SBAR
}

template <class ARow, class BMap, class Epi>
DEVI void gemm_tile(int K, ARow arow, const float* __restrict__ B, int ldb, BMap bmap, Epi epi, float* smem) {
    float (*As)[132] = (float (*)[132])smem;
    float (*Bs)[64] = (float (*)[64])(smem + 16 * 132);
    const int tid = tid_(), ty = tid >> 4, tx = tid & 15;
    float acc[4][4];
#pragma unroll
    for (int i = 0; i < 4; ++i)
#pragma unroll
        for (int j = 0; j < 4; ++j) acc[i][j] = 0.f;
    const int ar = tid >> 2, akq = tid & 3;
    const float* ap = arow(ar);
    const int bk0 = tid >> 6, bc = tid & 63;
    const int bcol = bmap(bc);
    for (int k0 = 0; k0 < K; k0 += 16) {
        float4 av = make_float4(0.f, 0.f, 0.f, 0.f);
        if (ap) av = *(const float4*)(ap + k0 + akq * 4);
        float b0 = 0.f, b1 = 0.f;
        if (bcol >= 0) { b0 = B[(size_t)(k0 + bk0) * ldb + bcol]; b1 = B[(size_t)(k0 + bk0 + 8) * ldb + bcol]; }
        __syncthreads();
        As[akq * 4 + 0][ar] = av.x; As[akq * 4 + 1][ar] = av.y; As[akq * 4 + 2][ar] = av.z; As[akq * 4 + 3][ar] = av.w;
        Bs[bk0][bc] = b0; Bs[bk0 + 8][bc] = b1;
        __syncthreads();
#pragma unroll
        for (int kk = 0; kk < 16; ++kk) {
            const float4 a = *(const float4*)&As[kk][ty * 4];
            const float4 b = *(const float4*)&Bs[kk][tx * 4];
            const float aa[4] = {a.x, a.y, a.z, a.w}, bb[4] = {b.x, b.y, b.z, b.w};
#pragma unroll
            for (int i = 0; i < 4; ++i)
#pragma unroll
                for (int j = 0; j < 4; ++j) acc[i][j] = fmaf(aa[i], bb[j], acc[i][j]);
        }
    }
#pragma unroll
    for (int i = 0; i < 4; ++i) epi(ty * 4 + i, tx, acc[i]);
    __syncthreads();
}

__device__ void phase_init(const Params& p) {
    const int tid = tid_(), bid = bid_(); (void)tid; (void)bid;
    float* ws = p.ws;
    const size_t n4 = (size_t)T * D / 4;
    for (size_t i = (size_t)bid * NTHR + tid; i < n4; i += (size_t)gridDim.x * NTHR) {
        const size_t e = i * 4;
        float4 v = (e < (size_t)NLAT * D) ? *(const float4*)(p.in[I_X] + e) : *(const float4*)(p.in[I_CTX] + (e - (size_t)NLAT * D));
        *(float4*)(ws + W_X + e) = v;
    }
    if (bid == 0 && tid < 64) ((int*)(ws + W_CNT))[tid] = 0;
}

__device__ void phase_mod(const Params& p, float* smem) {
    const int tid = tid_(), bid = bid_(); (void)tid; (void)bid;
    const int wave = tid >> 6, lane = tid & 63;
    for (int it = bid; it < NLAYER * 96; it += gridDim.x) {
        const int l = it / 96, j = (it % 96) * 64 + lane;
        const float* W = p.in[I_WMOD] + (size_t)l * 1024 * 6144;
        float a0 = 0.f, a1 = 0.f;
        for (int k = wave * 128; k < wave * 128 + 128; ++k) {
            const float w = W[(size_t)k * 6144 + j];
            a0 = fmaf(silu(p.in[I_C][k]), w, a0);
            a1 = fmaf(silu(p.in[I_CCTX][k]), w, a1);
        }
        smem[(wave * 2 + 0) * 64 + lane] = a0; smem[(wave * 2 + 1) * 64 + lane] = a1;
        __syncthreads();
        if (wave < 2) {
            float s = 0.f;
            for (int w = 0; w < 8; ++w) s += smem[(w * 2 + wave) * 64 + lane];
            p.ws[W_MOD + (size_t)(l * 2 + wave) * 6144 + j] = s + p.in[I_BMOD][l * 6144 + j];
        }
        __syncthreads();
    }
}

__device__ void phase_norm(const Params& p, int l, int which) {
    const int tid = tid_(), bid = bid_(); (void)tid; (void)bid;
    const int lane = tid & 63, gw = bid * (NTHR / 64) + (tid >> 6), nw = gridDim.x * (NTHR / 64);
    const float* g = p.in[which ? I_NFFN : I_NMIX] + l * D;
    for (int t = gw; t < T; t += nw) {
        const float* x = p.ws + W_X + (size_t)t * D;
        const float* mod = p.ws + W_MOD + (size_t)(l * 2 + (t >= NLAT ? 1 : 0)) * 6144;
        const float* sh = mod + (which ? 3 : 0) * D; const float* sc = mod + (which ? 4 : 1) * D;
        float4 v[4]; float ss = 0.f;
#pragma unroll
        for (int j = 0; j < 4; ++j) { v[j] = *(const float4*)(x + j * 256 + lane * 4); ss += v[j].x * v[j].x + v[j].y * v[j].y + v[j].z * v[j].z + v[j].w * v[j].w; }
        ss = wave_sum(ss);
        const float rstd = rsqrtf(ss * (1.f / D) + EPS);
        float* h = p.ws + W_H + (size_t)t * D;
#pragma unroll
        for (int j = 0; j < 4; ++j) {
            const int c = j * 256 + lane * 4;
            const float4 gg = *(const float4*)(g + c), s1 = *(const float4*)(sc + c), s0 = *(const float4*)(sh + c);
            float4 o;
            o.x = v[j].x * rstd * gg.x * (1.f + s1.x) + s0.x; o.y = v[j].y * rstd * gg.y * (1.f + s1.y) + s0.y;
            o.z = v[j].z * rstd * gg.z * (1.f + s1.z) + s0.z; o.w = v[j].w * rstd * gg.w * (1.f + s1.w) + s0.w;
            *(float4*)(h + c) = o;
            { u32x2 w; w.x = cvt_pk_bf16(o.x, o.y); w.y = cvt_pk_bf16(o.z, o.w); *(u32x2*)((bf16_t*)(p.ws + W_HB) + (size_t)t * D + c) = w; }
        }
    }
}

__device__ void phase_inproj(const Params& p, int l, char* lds) {
    const int tid = tid_(), bid = bid_(); (void)tid;
    const float* Wm = p.in[I_WIN] + (size_t)l * D * INC;
    constexpr int ntn = (INC + 127) / 128, ntm = T / 256;
    const bf16_t* HB = (const bf16_t*)(p.ws + W_HB); float* P = p.ws + W_P;
    for (int tile = bid; tile < ntm * ntn; tile += gridDim.x) {
        const int tm = tile / ntn, tn = tile % ntn, m0 = tm * 256, n0 = tn * 128;
        gemm_unit<false>(lds, D, [&](int r) { return HB + (size_t)(m0 + r) * D; }, Wm + n0, Wm + n0, INC, INC - n0,
                  [&](const f32x4 (&acc)[4][4], int wr, int wc, int fr, int fq) {
#pragma unroll
                      for (int m = 0; m < 4; ++m) { float* row = P + (size_t)(m0 + wr * 64 + m * 16 + fr) * INC;
#pragma unroll
                          for (int n = 0; n < 4; ++n) { const int col = n0 + wc * 64 + n * 16 + 4 * fq; if (col < INC) *(f32x4*)(row + col) = acc[m][n]; } }
                  });
    }
}

__device__ void phase_prep1(const Params& p, int l) {
    const int tid = tid_(), bid = bid_(); (void)tid; (void)bid;
    const int lane = tid & 63, gw = bid * (NTHR / 64) + (tid >> 6), nw = gridDim.x * (NTHR / 64);
    float* ws = p.ws;
    for (int t = gw; t < T; t += nw) {
        const int s0 = (t < NLAT) ? 0 : NLAT, sl = (t < NLAT) ? NLAT : NCTX, n = t - s0;
        const float* P = ws + W_P; const float* pr = P + (size_t)t * INC;
        {
            const int g = lane >> 4, w = 2 << g;
            const int lo = max(n - w / 2, 0), hi = min(n + w / 2, sl);
            float4 s = make_float4(0.f, 0.f, 0.f, 0.f);
            for (int m = lo; m < hi; ++m) { const float4 v = *(const float4*)(P + (size_t)(s0 + m) * INC + OFF_A + lane * 4); s.x += v.x; s.y += v.y; s.z += v.z; s.w += v.w; }
            const float inv = 1.f / (float)(hi - lo);
            const float4 x = *(const float4*)(pr + OFF_A + lane * 4);
            float4 d; d.x = s.x * inv - x.x; d.y = s.y * inv - x.y; d.z = s.z * inv - x.z; d.w = s.w * inv - x.w;
            *(float4*)(ws + W_DIFF + (size_t)t * 256 + lane * 4) = d;
        }
        {
            float v[3]; float ss = 0.f;
#pragma unroll
            for (int j = 0; j < 3; ++j) { v[j] = pr[OFF_Q + j * 64 + lane]; ss += v[j] * v[j]; }
            ss = wave_sum(ss); const float rstd = rsqrtf(ss * (1.f / 192.f) + EPS);
#pragma unroll
            for (int j = 0; j < 3; ++j) ws[W_QN + (size_t)t * 192 + j * 64 + lane] = v[j] * rstd * p.in[I_QAN][l * 192 + j * 64 + lane];
        }
        {
            float v[2]; float ss = 0.f;
#pragma unroll
            for (int j = 0; j < 2; ++j) { v[j] = pr[OFF_KV + j * 64 + lane]; ss += v[j] * v[j]; }
            ss = wave_sum(ss); const float rstd = rsqrtf(ss * (1.f / 128.f) + EPS);
#pragma unroll
            for (int j = 0; j < 2; ++j) ws[W_KVN + (size_t)t * 128 + j * 64 + lane] = v[j] * rstd * p.in[I_KVAN][l * 128 + j * 64 + lane];
        }
        {
            const float4 zu = *(const float4*)(pr + OFF_C + lane * 4), zv = *(const float4*)(pr + OFF_C + 256 + lane * 4);
            float4 u; u.x = gelu_tanh(zu.x); u.y = gelu_tanh(zu.y); u.z = gelu_tanh(zu.z); u.w = gelu_tanh(zu.w);
            *(float4*)(ws + W_U + (size_t)t * 256 + lane * 4) = u;
            float gv[4] = {gelu_tanh(zv.x), gelu_tanh(zv.y), gelu_tanh(zv.z), gelu_tanh(zv.w)};
            const float mu = wave_sum(gv[0] + gv[1] + gv[2] + gv[3]) * (1.f / 256.f);
            float q = 0.f;
#pragma unroll
            for (int j = 0; j < 4; ++j) { gv[j] -= mu; q += gv[j] * gv[j]; }
            const float rstd = rsqrtf(wave_sum(q) * (1.f / 256.f) + EPS);
#pragma unroll
            for (int j = 0; j < 4; ++j) ws[W_VN + (size_t)t * 256 + lane * 4 + j] = gv[j] * rstd * p.in[I_SGG][l * 256 + lane * 4 + j] + p.in[I_SGB][l * 256 + lane * 4 + j];
        }
        {
            const float* cw = p.in[I_CONVW] + (size_t)l * 4 * 256;
            float4 o = *(const float4*)(p.in[I_CONVB] + l * 256 + lane * 4);
#pragma unroll
            for (int k = 0; k < 4; ++k) {
                const int m = n - 1 + k;
                if (m >= 0 && m < sl) {
                    const float4 xv = *(const float4*)(P + (size_t)(s0 + m) * INC + OFF_DX + lane * 4), wv = *(const float4*)(cw + k * 256 + lane * 4);
                    o.x = fmaf(xv.x, wv.x, o.x); o.y = fmaf(xv.y, wv.y, o.y); o.z = fmaf(xv.z, wv.z, o.z); o.w = fmaf(xv.w, wv.w, o.w);
                }
            }
            *(float4*)(ws + W_XC + (size_t)t * 256 + lane * 4) = o;
        }
    }
}

__device__ void phase_small(const Params& p, int l) {
    const int tid = tid_(), bid = bid_(); (void)tid; (void)bid;
    float* ws = p.ws;
    const size_t total = (size_t)T * 1664;
    for (size_t i = (size_t)bid * NTHR + tid; i < total; i += (size_t)gridDim.x * NTHR) {
        const int t = (int)(i / 1664); int o = (int)(i % 1664);
        if (o < 256) {
            const int g = o >> 6, j = o & 63;
            const float* d = ws + W_DIFF + (size_t)t * 256 + g * 64; const float* w = p.in[I_POOLW] + ((size_t)(l * 4 + g) * 64) * 64 + j;
            float a = 0.f;
            for (int c = 0; c < 64; ++c) a = fmaf(d[c], w[c * 64], a);
            ((bf16_t*)(ws + W_YC))[(size_t)t * D + o] = f2bf(a * p.in[I_POOLS][l * 256 + o]);
        } else if (o < 640) {
            o -= 256;
            const float* x = ws + W_QN + (size_t)t * 192; const float* w = p.in[I_WUQ] + (size_t)l * 192 * 384 + o;
            float a = 0.f;
            for (int c = 0; c < 192; ++c) a = fmaf(x[c], w[(size_t)c * 384], a);
            ws[W_QUP + (size_t)t * 384 + o] = a;
        } else if (o < 1152) {
            o -= 640;
            const float* x = ws + W_KVN + (size_t)t * 128; const float* w = p.in[I_WUKV] + (size_t)l * 128 * 512 + o;
            float a = 0.f;
            for (int c = 0; c < 128; ++c) a = fmaf(x[c], w[(size_t)c * 512], a);
            ws[W_KVUP + (size_t)t * 512 + o] = a;
        } else {
            o -= 1152;
            const int d = o >> 8, ch = o & 255, h = ch >> 6, j = ch & 63;
            const float* x = ws + W_XC + (size_t)t * 256 + h * 64;
            const float* wa = p.in[I_WA] + ((size_t)((l * 2 + d) * 4 + h) * 64) * 64 + j;
            const float* wx = p.in[I_WX] + ((size_t)((l * 2 + d) * 4 + h) * 64) * 64 + j;
            float ra = 0.f, rx = 0.f;
            for (int c = 0; c < 64; ++c) { const float xv = x[c]; ra = fmaf(xv, wa[c * 64], ra); rx = fmaf(xv, wx[c * 64], rx); }
            const int pi = (l * 2 + d) * 256 + ch;
            const float r = sigm(ra + p.in[I_BA][pi]), ig = sigm(rx + p.in[I_BX][pi]);
            const float lam = p.in[I_LAM][pi];
            const float sp = log1pf(expf(-lam));
            const float loga = -8.f * r * sp;
            const float a = expf(loga);
            const float drive = sqrtf(-expm1f(2.f * loga)) * (ig * x[j]);
            ws[W_LA + ((size_t)d * T + t) * 256 + ch] = a;
            ws[W_LB + ((size_t)d * T + t) * 256 + ch] = drive;
        }
    }
}

__device__ void phase_prep2(const Params& p, int l) {
    const int tid = tid_(), bid = bid_(); (void)tid; (void)bid;
    float* ws = p.ws;
    const int lane = tid & 63, gw = bid * (NTHR / 64) + (tid >> 6), nw = gridDim.x * (NTHR / 64);
    for (int it = gw; it < T * 4; it += nw) {
        const int t = it >> 2, h = it & 3;
        const bool lat = t < NLAT;
        float cs = 1.f, sn = 0.f;
        if (lat && lane < 32) {
            const int f = lane & 15; const float pos = (f < 8) ? (float)(t >> 6) : (float)(t & 63);
            const float inv = powf(10000.f, -(float)(f & 7) / 8.f);
            const float ang = pos * inv; cs = cosf(ang); sn = sinf(ang);
        }
        {
            float v0 = ws[W_QUP + (size_t)t * 384 + h * 96 + lane], v1 = (lane < 32) ? ws[W_QUP + (size_t)t * 384 + h * 96 + 64 + lane] : 0.f;
            const float rstd = rsqrtf(wave_sum(v0 * v0 + v1 * v1) * (1.f / 96.f) + EPS);
            v0 *= rstd * p.in[I_QN][l * 96 + lane]; v1 *= (lane < 32) ? rstd * p.in[I_QN][l * 96 + 64 + lane] : 0.f;
            const float pv = __shfl_xor(v1, 16);
            const float r1 = (lane < 16) ? v1 * cs - pv * sn : pv * sn + v1 * cs;
            bf16_t* qo = (bf16_t*)(ws + W_Q) + ((size_t)h * T + t) * 96;
            qo[lane] = f2bf(v0);
            if (lane < 32) qo[64 + lane] = f2bf(lat ? r1 : v1);
        }
        {
            float v0 = ws[W_KVUP + (size_t)t * 512 + h * 128 + lane], v1 = (lane < 32) ? ws[W_P + (size_t)t * INC + OFF_KR + lane] : 0.f;
            const float rstd = rsqrtf(wave_sum(v0 * v0 + v1 * v1) * (1.f / 96.f) + EPS);
            v0 *= rstd * p.in[I_KN][l * 96 + lane]; v1 *= (lane < 32) ? rstd * p.in[I_KN][l * 96 + 64 + lane] : 0.f;
            const float pv = __shfl_xor(v1, 16);
            const float r1 = (lane < 16) ? v1 * cs - pv * sn : pv * sn + v1 * cs;
            bf16_t* ko = (bf16_t*)(ws + W_K) + ((size_t)h * T + t) * 96;
            ko[lane] = f2bf(v0);
            if (lane < 32) ko[64 + lane] = f2bf(lat ? r1 : v1);
            ((bf16_t*)(ws + W_V))[((size_t)h * T + t) * 64 + lane] = f2bf(ws[W_KVUP + (size_t)t * 512 + h * 128 + 64 + lane]);
        }
    }
    for (size_t i = (size_t)bid * NTHR + tid; i < (size_t)T * 256; i += (size_t)gridDim.x * NTHR) {
        const int t = (int)(i >> 8), ch = (int)(i & 255), c = t >> 7, pp = t & 127, h = ch >> 6;
        const float* w = p.in[I_SGWS] + ((size_t)(l * 4 + h) * 128 + pp) * 128;
        const float* vn = ws + W_VN + (size_t)c * 128 * 256 + ch;
        float a = 0.f;
        for (int q = 0; q < 128; ++q) a = fmaf(w[q], vn[(size_t)q * 256], a);
        a += p.in[I_SGBS][(l * 4 + h) * 128 + pp];
        ((bf16_t*)(ws + W_YC))[(size_t)t * D + 512 + ch] = f2bf(ws[W_U + (size_t)t * 256 + ch] * a);
    }
    for (int i = bid * NTHR + tid; i < NCHUNK * 512; i += gridDim.x * NTHR) {
        const int c = i >> 9, d = (i >> 8) & 1, ch = i & 255;
        float* A = ws + W_LA + ((size_t)d * T + (size_t)c * 128) * 256 + ch;
        float* B = ws + W_LB + ((size_t)d * T + (size_t)c * 128) * 256 + ch;
        float h = 0.f, ap = 1.f;
        for (int s = 0; s < 128; ++s) {
            const int q = d ? 127 - s : s;
            const float a = A[(size_t)q * 256], b = B[(size_t)q * 256];
            h = fmaf(a, h, b); ap *= a;
            A[(size_t)q * 256] = ap; B[(size_t)q * 256] = h;
        }
        ws[W_AGG + ((size_t)(c * 2 + d) * 2 + 0) * 256 + ch] = ap;
        ws[W_AGG + ((size_t)(c * 2 + d) * 2 + 1) * 256 + ch] = h;
    }
}

__device__ void lru_carries(const Params& p) {
    const int tid = tid_(), bid = bid_(); (void)tid; (void)bid;
    float* ws = p.ws;
    const int d = tid >> 8, ch = tid & 255;
    float s = 0.f;
    for (int k = 0; k < NCHUNK; ++k) {
        const int c = d ? (NCHUNK - 1 - k) : ((k + 128) % NCHUNK);
        ws[W_CARRY + (size_t)(c * 2 + d) * 256 + ch] = s;
        const float a = ws[W_AGG + ((size_t)(c * 2 + d) * 2 + 0) * 256 + ch], hh = ws[W_AGG + ((size_t)(c * 2 + d) * 2 + 1) * 256 + ch];
        s = fmaf(a, s, hh);
    }
}

__device__ void phase_attn(const Params& p, int l, char* lds) {
    const int tid = tid_(), bid = bid_(); (void)tid;
    const bf16_t* Qb = (const bf16_t*)(p.ws + W_Q); const bf16_t* Kb = (const bf16_t*)(p.ws + W_K); const bf16_t* Vb = (const bf16_t*)(p.ws + W_V);
    bf16_t* Y = (bf16_t*)(p.ws + W_YC);
    const int nunits = (l == 0) ? 260 : 256;
    for (int u = bid; u < nunits; u += gridDim.x) {
        int h, t0, k0, seq;
        if (u < 256) { h = (u & 7) >> 1; t0 = (((u >> 3) << 1) | (u & 1)) * 256; k0 = 0; seq = T; }
        else { h = u - 256; t0 = NLAT; k0 = NLAT; seq = NCTX; }
        att::attn_unit(Qb + ((size_t)h * T + t0) * 96, Kb + ((size_t)h * T + k0) * 96, Vb + ((size_t)h * T + k0) * 64, seq, Y + (size_t)t0 * D + 256 + h * 64, D, lds);
    }
}

__device__ void phase_lru_fin(const Params& p) {
    const int tid = tid_(), bid = bid_(); (void)tid; (void)bid;
    float* ws = p.ws;
    for (size_t i = (size_t)bid * NTHR + tid; i < (size_t)T * 256; i += (size_t)gridDim.x * NTHR) {
        const int t = (int)(i >> 8), ch = (int)(i & 255), c = t >> 7;
        float hs = 0.f;
#pragma unroll
        for (int d = 0; d < 2; ++d)
            hs += ws[W_LB + ((size_t)d * T + t) * 256 + ch] + ws[W_LA + ((size_t)d * T + t) * 256 + ch] * ws[W_CARRY + (size_t)(c * 2 + d) * 256 + ch];
        ((bf16_t*)(ws + W_YC))[(size_t)t * D + 768 + ch] = f2bf(gelu_tanh(ws[W_P + (size_t)t * INC + OFF_DG + ch]) * hs);
    }
}

__device__ void phase_outproj(const Params& p, int l, char* lds) {
    const int tid = tid_(), bid = bid_(); (void)tid;
    const float* Wm = p.in[I_WOUT] + (size_t)l * D * D;
    constexpr int ntn = D / 128, ntm = T / 256;
    const bf16_t* Y = (const bf16_t*)(p.ws + W_YC); float* X = p.ws + W_X;
    for (int tile = bid; tile < ntm * ntn; tile += gridDim.x) {
        const int tm = tile / ntn, tn = tile % ntn, m0 = tm * 256, n0 = tn * 128;
        const float* g1 = p.ws + W_MOD + (size_t)(l * 2 + (m0 >= NLAT ? 1 : 0)) * 6144 + 2 * D;
        gemm_unit<false>(lds, D, [&](int r) { return Y + (size_t)(m0 + r) * D; }, Wm + n0, Wm + n0, D, 128,
                  [&](const f32x4 (&acc)[4][4], int wr, int wc, int fr, int fq) {
#pragma unroll
                      for (int m = 0; m < 4; ++m) { float* row = X + (size_t)(m0 + wr * 64 + m * 16 + fr) * D;
#pragma unroll
                          for (int n = 0; n < 4; ++n) { const int col = n0 + wc * 64 + n * 16 + 4 * fq; const f32x4 g = *(const f32x4*)(g1 + col); f32x4 x = *(f32x4*)(row + col);
                              x = x + g * acc[m][n]; *(f32x4*)(row + col) = x; } }
                  });
    }
}

__device__ void phase_router(const Params& p, int l) {
    const int tid = tid_(), bid = bid_(); (void)tid; (void)bid;
    float* ws = p.ws;
    const int lane = tid & 63, gw = bid * (NTHR / 64) + (tid >> 6), nw = gridDim.x * (NTHR / 64);
    const float* rw = p.in[I_RW] + (size_t)l * D * NEXP;
    int* cnt = (int*)(ws + W_CNT) + l * NEXP;
    int* list = (int*)(ws + W_LIST);
    const int e = lane & 31, half = lane >> 5;
    for (int t = gw; t < T; t += nw) {
        const float* f = ws + W_H + (size_t)t * D + half * 512;
        const float* w = rw + (size_t)half * 512 * NEXP + e;
        float a = 0.f;
        for (int k = 0; k < 512; ++k) a = fmaf(f[k], w[(size_t)k * NEXP], a);
        a += __shfl_xor(a, 32);
        a += p.in[I_RB][l * NEXP + e];
        float tv[4]; int te[4];
        float cur = a;
#pragma unroll
        for (int k = 0; k < 4; ++k) {
            float bv = cur; int bi = e;
#pragma unroll
            for (int o = 16; o > 0; o >>= 1) {
                const float ov = __shfl_xor(bv, o); const int oi = __shfl_xor(bi, o);
                if (ov > bv || (ov == bv && oi < bi)) { bv = ov; bi = oi; }
            }
            tv[k] = bv; te[k] = bi;
            if (e == bi) cur = -3.0e38f;
        }
        const float mx = tv[0];
        float ex[4], s = 0.f;
#pragma unroll
        for (int k = 0; k < 4; ++k) { ex[k] = expf(tv[k] - mx); s += ex[k]; }
        if (lane < 4) {
            const int ee = te[lane];
            const int idx = atomicAdd(&cnt[ee], 1);
            list[(size_t)ee * T + idx] = t;
            ((int*)(ws + W_TOPE))[t * 4 + lane] = ee;
            ((int*)(ws + W_TOPI))[t * 4 + lane] = idx;
            ws[W_TOPG + t * 4 + lane] = ex[lane] / s;
        }
    }
}

DEVI void moe_bases(const Params& p, int l, int* sb) {
    const int tid = tid_();
    if (tid == 0) {
        const int* cnt = (const int*)(p.ws + W_CNT) + l * NEXP;
        int b = 0, tb = 0;
        for (int e = 0; e < NEXP; ++e) { sb[e] = b; sb[40 + e] = tb; const int c = cnt[e]; sb[80 + e] = c; const int mt = (c + 255) / 256; b += mt * 256; tb += mt; }
        sb[32] = b; sb[72] = tb;
    }
    __syncthreads();
}

__device__ void phase_moe1(const Params& p, int l, char* lds) {
    const int tid = tid_(), bid = bid_(); (void)tid;
    int* sb = (int*)(lds + G_LDS);
    moe_bases(p, l, sb);
    constexpr int ntn = 16;
    const int nunits = sb[72] * ntn;
    const int* list = (const int*)(p.ws + W_LIST);
    const bf16_t* HB = (const bf16_t*)(p.ws + W_HB); bf16_t* ACT = (bf16_t*)(p.ws + W_ACT);
    for (int u = bid; u < nunits; u += gridDim.x) {
        int e = 0; while (e < NEXP - 1 && sb[40 + e + 1] * ntn <= u) ++e;
        const int mts = sb[40 + e + 1] - sb[40 + e], loc = u - sb[40 + e] * ntn, tn = loc / mts, mt = loc % mts;
        const int mloc = mt * 256, cnt = sb[80 + e], rbase = sb[e] + mloc;
        const float* Wm = p.in[I_WGU] + ((size_t)(l * NEXP + e) * D) * 2048 + tn * 64;
        const float* bias = p.in[I_BGU] + (size_t)(l * NEXP + e) * 2048 + tn * 64;
        const int* le = list + (size_t)e * T + mloc;
        gemm_unit<true>(lds, D, [&](int r) { return (mloc + r < cnt) ? HB + (size_t)le[r] * D : (const bf16_t*)nullptr; }, Wm, Wm + 1024, 2048, 64,
                  [&](const f32x4 (&acc)[4][4], int wr, int wc, int fr, int fq) {
#pragma unroll
                      for (int m = 0; m < 4; ++m) { const int r = wr * 64 + m * 16 + fr;
                          if (mloc + r < cnt) {
#pragma unroll
                              for (int pp = 0; pp < 2; ++pp) { const int idx = (wc * 2 + pp) * 16 + 4 * fq;
                                  const f32x4 bg = *(const f32x4*)(bias + idx), bu = *(const f32x4*)(bias + 1024 + idx);
                                  float a[4];
#pragma unroll
                                  for (int j = 0; j < 4; ++j) { float g = acc[m][2 * pp][j] + bg[j], uu = acc[m][2 * pp + 1][j] + bu[j];
                                      g = fminf(g, 7.f); uu = fminf(fmaxf(uu, -7.f), 7.f); a[j] = (uu + 1.f) * (g * sigm(1.702f * g)); }
                                  u32x2 w; w.x = cvt_pk_bf16(a[0], a[1]); w.y = cvt_pk_bf16(a[2], a[3]);
                                  *(u32x2*)(ACT + (size_t)(rbase + r) * D + tn * 64 + idx) = w; } } }
                  });
    }
    __syncthreads();
}

__device__ void phase_moe2(const Params& p, int l, char* lds) {
    const int tid = tid_(), bid = bid_(); (void)tid;
    int* sb = (int*)(lds + G_LDS);
    moe_bases(p, l, sb);
    constexpr int ntn = D / 128;
    const int nunits = sb[72] * ntn;
    const bf16_t* ACT = (const bf16_t*)(p.ws + W_ACT); bf16_t* YR = (bf16_t*)(p.ws + W_YR);
    for (int u = bid; u < nunits; u += gridDim.x) {
        int e = 0; while (e < NEXP - 1 && sb[40 + e + 1] * ntn <= u) ++e;
        const int mts = sb[40 + e + 1] - sb[40 + e], loc = u - sb[40 + e] * ntn, tn = loc / mts, mt = loc % mts;
        const int mloc = mt * 256, cnt = sb[80 + e], rbase = sb[e] + mloc, n0 = tn * 128;
        const float* Wm = p.in[I_WDN] + ((size_t)(l * NEXP + e) * D) * D + n0;
        const float* bias = p.in[I_BDN] + (size_t)(l * NEXP + e) * D + n0;
        gemm_unit<false>(lds, D, [&](int r) { return (mloc + r < cnt) ? ACT + (size_t)(rbase + r) * D : (const bf16_t*)nullptr; }, Wm, Wm, D, 128,
                  [&](const f32x4 (&acc)[4][4], int wr, int wc, int fr, int fq) {
#pragma unroll
                      for (int m = 0; m < 4; ++m) { const int r = wr * 64 + m * 16 + fr;
                          if (mloc + r < cnt) {
#pragma unroll
                              for (int n = 0; n < 4; ++n) { const int c = wc * 64 + n * 16 + 4 * fq; const f32x4 b = *(const f32x4*)(bias + c); const f32x4 v = acc[m][n] + b;
                                  u32x2 w; w.x = cvt_pk_bf16(v[0], v[1]); w.y = cvt_pk_bf16(v[2], v[3]);
                                  *(u32x2*)(YR + (size_t)(rbase + r) * D + n0 + c) = w; } } }
                  });
    }
    __syncthreads();
}

__device__ void phase_combine(const Params& p, int l, char* lds, bool last) {
    const int tid = tid_(), bid = bid_();
    int* sb = (int*)(lds + G_LDS);
    moe_bases(p, l, sb);
    float* ws = p.ws;
    const bf16_t* YR = (const bf16_t*)(ws + W_YR);
    const int lane = tid & 63, gw = bid * (NTHR / 64) + (tid >> 6), nw = gridDim.x * (NTHR / 64);
    for (int t = gw; t < T; t += nw) {
        const float* g2 = ws + W_MOD + (size_t)(l * 2 + (t >= NLAT ? 1 : 0)) * 6144 + 5 * D;
        const bf16_t* yr[4]; float gt[4];
#pragma unroll
        for (int k = 0; k < 4; ++k) {
            const int e = ((const int*)(ws + W_TOPE))[t * 4 + k], idx = ((const int*)(ws + W_TOPI))[t * 4 + k];
            yr[k] = YR + (size_t)(sb[e] + idx) * D; gt[k] = ws[W_TOPG + t * 4 + k];
        }
        float* x = ws + W_X + (size_t)t * D;
#pragma unroll
        for (int j = 0; j < 4; ++j) {
            const int c = j * 256 + lane * 4;
            float a0 = 0.f, a1 = 0.f, a2 = 0.f, a3 = 0.f;
#pragma unroll
            for (int k = 0; k < 4; ++k) { const u32x2 y = *(const u32x2*)(yr[k] + c);
                a0 = fmaf(gt[k], __uint_as_float(y.x << 16), a0); a1 = fmaf(gt[k], __uint_as_float(y.x & 0xffff0000u), a1);
                a2 = fmaf(gt[k], __uint_as_float(y.y << 16), a2); a3 = fmaf(gt[k], __uint_as_float(y.y & 0xffff0000u), a3); }
            float4 xv = *(const float4*)(x + c); const float4 gg = *(const float4*)(g2 + c);
            xv.x = fmaf(gg.x, a0, xv.x); xv.y = fmaf(gg.y, a1, xv.y); xv.z = fmaf(gg.z, a2, xv.z); xv.w = fmaf(gg.w, a3, xv.w);
            *(float4*)(x + c) = xv;
            if (last && t < NLAT) *(float4*)(p.out + (size_t)t * D + c) = xv;
        }
    }
    __syncthreads();
}

constexpr int LDS_BYTES = G_LDS + 2048;
__global__ void __launch_bounds__(NTHR) fwd_kernel(Params p) {
    cg::grid_group grid = cg::this_grid();
    extern __shared__ __attribute__((aligned(16))) char lds[];
    float* smem = (float*)lds;
    phase_init(p);
    phase_mod(p, smem);
    grid.sync();
    for (int l = 0; l < NLAYER; ++l) {
        phase_norm(p, l, 0);
        grid.sync();
        phase_inproj(p, l, lds);
        grid.sync();
        phase_prep1(p, l);
        grid.sync();
        phase_small(p, l);
        grid.sync();
        phase_prep2(p, l);
        grid.sync();
        if (blockIdx.x == gridDim.x - 1) lru_carries(p);
        phase_attn(p, l, lds);
        grid.sync();
        phase_lru_fin(p);
        grid.sync();
        phase_outproj(p, l, lds);
        grid.sync();
        phase_norm(p, l, 1);
        grid.sync();
        phase_router(p, l);
        grid.sync();
        phase_moe1(p, l, lds);
        grid.sync();
        phase_moe2(p, l, lds);
        grid.sync();
        phase_combine(p, l, lds, l == NLAYER - 1);
        grid.sync();
    }
}

extern "C" void kernel_launch(void* const* d_in, const int* in_sizes, int n_in, void* d_out, int out_size, void* d_ws, size_t ws_size, hipStream_t stream) {
    static int grid_blocks = 0;
    if (!grid_blocks) {
        int dev = 0, cus = 0, per_cu = 0;
        (void)hipGetDevice(&dev);
        (void)hipDeviceGetAttribute(&cus, hipDeviceAttributeMultiprocessorCount, dev);
        if (hipFuncSetAttribute((const void*)fwd_kernel, hipFuncAttributeMaxDynamicSharedMemorySize, LDS_BYTES) != hipSuccess) fprintf(stderr, "kernel_launch: hipFuncSetAttribute failed\n");
        if (hipOccupancyMaxActiveBlocksPerMultiprocessor(&per_cu, fwd_kernel, NTHR, LDS_BYTES) != hipSuccess || per_cu < 1) { fprintf(stderr, "kernel_launch: occupancy query says %d\n", per_cu); per_cu = 1; }
        if (per_cu > 1) per_cu = 1;
        grid_blocks = cus * per_cu;
        if (ws_size < W_END * sizeof(float)) fprintf(stderr, "kernel_launch: workspace too small: %zu < %zu\n", ws_size, W_END * sizeof(float));
        if (n_in != N_IN) fprintf(stderr, "kernel_launch: n_in %d != %d\n", n_in, (int)N_IN);
    }
    Params p{};
    for (int i = 0; i < N_IN; ++i) p.in[i] = (const float*)d_in[i];
    p.out = (float*)d_out;
    p.ws = (float*)d_ws;
    void* args[] = {&p};
    hipError_t e = hipLaunchCooperativeKernel((void*)fwd_kernel, dim3(grid_blocks), dim3(NTHR), args, LDS_BYTES, stream);
    if (e != hipSuccess) fprintf(stderr, "cooperative launch failed: %s (grid %d)\n", hipGetErrorString(e), grid_blocks);
}
```

```cpp
#include <hip/hip_runtime.h>
#include <hip/hip_cooperative_groups.h>
#include <cstdio>
#include <cstdint>
namespace cg = cooperative_groups;

#define DEVI __device__ __forceinline__
constexpr int NTHR = 512;
constexpr int D = 1024, NLAT = 16384, NCTX = 256, T = NLAT + NCTX, NLAYER = 2;
constexpr int INC = 1632;
constexpr int OFF_A = 0, OFF_Q = 256, OFF_KV = 448, OFF_KR = 576, OFF_C = 608, OFF_DX = 1120, OFF_DG = 1376;
constexpr int NCHUNK = T / 128;
constexpr int NEXP = 32, TOPK = 4;
constexpr int MAXROWS = T * TOPK + NEXP * 256;
constexpr float EPS = 1e-6f;

enum { I_X = 0, I_C, I_CTX, I_CCTX, I_WMOD, I_BMOD, I_NMIX, I_NFFN, I_WIN, I_WOUT, I_POOLW, I_POOLS, I_QAN, I_WUQ, I_KVAN, I_WUKV,
       I_QN, I_KN, I_SGG, I_SGB, I_SGWS, I_SGBS, I_CONVW, I_CONVB, I_WA, I_BA, I_WX, I_BX, I_LAM, I_RW, I_RB, I_WGU, I_BGU, I_WDN, I_BDN, N_IN };

constexpr size_t al(size_t x) { return (x + 63) / 64 * 64; }
constexpr size_t W_X = 0;
constexpr size_t W_MOD = W_X + al((size_t)T * D);
constexpr size_t W_H = W_MOD + al(2 * 2 * 6144);
constexpr size_t W_P = W_H + al((size_t)T * D);
constexpr size_t W_YC = W_P + al((size_t)T * INC);
constexpr size_t W_Q = W_YC + al((size_t)T * D);
constexpr size_t W_K = W_Q + al((size_t)T * 384);
constexpr size_t W_V = W_K + al((size_t)T * 384);
constexpr size_t W_DIFF = W_V + al((size_t)T * 256);
constexpr size_t W_QN = W_DIFF + al((size_t)T * 256);
constexpr size_t W_KVN = W_QN + al((size_t)T * 192);
constexpr size_t W_U = W_KVN + al((size_t)T * 128);
constexpr size_t W_VN = W_U + al((size_t)T * 256);
constexpr size_t W_XC = W_VN + al((size_t)T * 256);
constexpr size_t W_QUP = W_XC + al((size_t)T * 256);
constexpr size_t W_KVUP = W_QUP + al((size_t)T * 384);
constexpr size_t W_LA = W_KVUP + al((size_t)T * 512);
constexpr size_t W_LB = W_LA + al((size_t)2 * T * 256);
constexpr size_t W_AGG = W_LB + al((size_t)2 * T * 256);
constexpr size_t W_CARRY = W_AGG + al((size_t)NCHUNK * 2 * 2 * 256);
constexpr size_t W_TOPE = W_CARRY + al((size_t)NCHUNK * 2 * 256);
constexpr size_t W_TOPG = W_TOPE + al((size_t)T * 4);
constexpr size_t W_TOPI = W_TOPG + al((size_t)T * 4);
constexpr size_t W_CNT = W_TOPI + al((size_t)T * 4);
constexpr size_t W_LIST = W_CNT + al(64);
constexpr size_t W_ACT = W_LIST + al((size_t)NEXP * T);
constexpr size_t W_YR = W_ACT + al((size_t)MAXROWS * D);
constexpr size_t W_HB = W_YR + al((size_t)MAXROWS * D);
constexpr size_t W_XCB = W_HB + al((size_t)T * D / 2);
constexpr size_t W_WSB = W_XCB + al((size_t)T * 256 / 2);
constexpr size_t W_END = W_WSB + al((size_t)NLAYER * 4 * 128 * 128 / 2);

struct Params {
    const float* in[N_IN];
    float* out;
    float* ws;
};

DEVI int tid_() { int t = threadIdx.x; asm volatile("" : "+v"(t)); return t; }
DEVI int bid_() { int b = blockIdx.x; asm volatile("" : "+s"(b)); return b; }
DEVI float wave_sum(float v) {
#pragma unroll
    for (int o = 32; o > 0; o >>= 1) v += __shfl_xor(v, o);
    return v;
}
DEVI float gelu_tanh(float x) { const float u = 0.7978845608028654f * (x + 0.044715f * x * x * x); return 0.5f * x * (1.f + tanhf(u)); }
DEVI float sigm(float x) { return 1.f / (1.f + expf(-x)); }
DEVI float silu(float x) { return x * sigm(x); }


typedef unsigned short bf16_t;
typedef short bf16x8 __attribute__((ext_vector_type(8)));
typedef float f32x4 __attribute__((ext_vector_type(4)));
typedef unsigned u32x4 __attribute__((ext_vector_type(4)));
typedef unsigned u32x2 __attribute__((ext_vector_type(2)));
DEVI unsigned cvt_pk_bf16(float lo, float hi) { unsigned r; asm volatile("v_cvt_pk_bf16_f32 %0, %1, %2" : "=v"(r) : "v"(lo), "v"(hi)); return r; }
DEVI bf16_t f2bf(float f) { return (bf16_t)(cvt_pk_bf16(f, 0.f) & 0xffffu); }
DEVI float bf2f(bf16_t b) { return __uint_as_float(((unsigned)b) << 16); }

constexpr int G_STAGE = 49152;
constexpr int G_LDS = 2 * G_STAGE;
DEVI int lds_byte(int r, int c) { const int st = (r >> 4) * 2 + (c >> 5), rr = r & 15, cc = c & 31, ob = rr * 64 + cc * 2; return st * 1024 + (ob ^ (((ob >> 9) & 1) << 5)); }

template <bool PAIRED, class ARow, class Epi>
DEVI void gemm_unit(char* lds, int K, ARow arow, const float* __restrict__ B0, const float* __restrict__ B1, int ldb, int ncol_valid, Epi epi) {
    const int tid = tid_(), wave = tid >> 6, lane = tid & 63, fr = lane & 15, fq = lane >> 4, wr = wave >> 1, wc = wave & 1;
    const int ac = tid & 7;
    const bf16_t* ap[4]; int a_lds[4];
#pragma unroll
    for (int i = 0; i < 4; ++i) { const int r = (tid >> 3) + 64 * i; const bf16_t* q = arow(r); ap[i] = q ? q + ac * 8 : nullptr; a_lds[i] = (r >> 7) * 16384 + lds_byte(r & 127, ac * 8); }
    const int kq = lane & 15, nq = (lane >> 4) + 4 * wave;
    const float* bp; bool bvalid;
    if (PAIRED) { const int seg = (nq >> 2) & 1, idx = (nq >> 3) * 16 + (nq & 3) * 4; bp = (seg ? B1 : B0) + idx; bvalid = idx < ncol_valid; }
    else { bp = B0 + 4 * nq; bvalid = 4 * nq < ncol_valid; }
    bp += (size_t)(4 * kq) * ldb;
    int b_lds[4];
#pragma unroll
    for (int i = 0; i < 4; ++i) b_lds[i] = 32768 + lds_byte(4 * nq + i, 4 * kq);
    const int aoff = (wr >> 1) * 16384 + lds_byte((wr & 1) * 64 + fr, fq * 8), boff = 32768 + lds_byte(wc * 64 + fr, fq * 8);
    u32x4 av[4]; f32x4 bv[4];
#define G_LOAD(t) do { _Pragma("unroll") for (int i = 0; i < 4; ++i) av[i] = ap[i] ? *(const u32x4*)(ap[i] + (t) * 64) : (u32x4){0u, 0u, 0u, 0u}; \
        _Pragma("unroll") for (int kk = 0; kk < 4; ++kk) bv[kk] = bvalid ? *(const f32x4*)(bp + ((size_t)(t) * 64 + kk) * ldb) : (f32x4){0.f, 0.f, 0.f, 0.f}; } while (0)
#define G_WRITE(buf) do { char* s_ = lds + (buf) * G_STAGE; _Pragma("unroll") for (int i = 0; i < 4; ++i) *(u32x4*)(s_ + a_lds[i]) = av[i]; \
        _Pragma("unroll") for (int i = 0; i < 4; ++i) { u32x2 w_; w_.x = cvt_pk_bf16(bv[0][i], bv[1][i]); w_.y = cvt_pk_bf16(bv[2][i], bv[3][i]); *(u32x2*)(s_ + b_lds[i]) = w_; } } while (0)
    f32x4 acc[4][4];
#pragma unroll
    for (int m = 0; m < 4; ++m)
#pragma unroll
        for (int n = 0; n < 4; ++n) acc[m][n] = (f32x4){0.f, 0.f, 0.f, 0.f};
    const int nk = K >> 6;
    G_LOAD(0);
    G_WRITE(0);
    if (nk > 1) G_LOAD(1);
    __syncthreads();
    for (int t = 0; t < nk; ++t) {
        const char* s_ = lds + (t & 1) * G_STAGE;
#pragma unroll
        for (int k = 0; k < 2; ++k) {
            bf16x8 Af[4], Bf[4];
#pragma unroll
            for (int m = 0; m < 4; ++m) Af[m] = *(const bf16x8*)(s_ + aoff + m * 2048 + k * 1024);
#pragma unroll
            for (int n = 0; n < 4; ++n) Bf[n] = *(const bf16x8*)(s_ + boff + n * 2048 + k * 1024);
#pragma unroll
            for (int m = 0; m < 4; ++m)
#pragma unroll
                for (int n = 0; n < 4; ++n) acc[m][n] = __builtin_amdgcn_mfma_f32_16x16x32_bf16(Bf[n], Af[m], acc[m][n], 0, 0, 0);
        }
        if (t + 1 < nk) { G_WRITE((t + 1) & 1); if (t + 2 < nk) G_LOAD(t + 2); }
        __syncthreads();
    }
#undef G_LOAD
#undef G_WRITE
    epi(acc, wr, wc, fr, fq);
}


namespace att {
typedef short s16x4 __attribute__((ext_vector_type(4)));
typedef float f32x16 __attribute__((ext_vector_type(16)));
constexpr int KVBLK = 64;
constexpr float SCALE = 0.10206207261596577f;
constexpr float THR = 8.f;
constexpr int SHM_V = 16384, SHM_K = 16384, SHM_ATTN = 2 * SHM_V + 2 * SHM_K + 8 * 64 * 4;
#define KSWZ(row, colB) ((row) * 256 + ((colB) ^ (((row) & 7) << 4)))
#define SBAR() __builtin_amdgcn_sched_barrier(0)
DEVI int crow(int r, int hi) { return (r & 3) + 8 * (r >> 2) + 4 * hi; }
DEVI void partialSM(f32x16& p0, f32x16& p1, float& m_reg, float& mn, float& alpha) {
    constexpr float C = SCALE * 1.4426950408889634f;
    float pmax = p0[0];
#pragma unroll
    for (int r = 1; r < 16; ++r) pmax = fmaxf(pmax, p0[r]);
#pragma unroll
    for (int r = 0; r < 16; ++r) pmax = fmaxf(pmax, p1[r]);
    { auto rr = __builtin_amdgcn_permlane32_swap(__float_as_uint(pmax), __float_as_uint(pmax), false, false);
      pmax = fmaxf(__uint_as_float(rr[0]), __uint_as_float(rr[1])); }
    if (__builtin_expect(__all(pmax - m_reg <= THR / SCALE), 1)) { mn = m_reg; alpha = 1.f; }
    else { mn = fmaxf(m_reg, pmax); alpha = __builtin_amdgcn_exp2f((m_reg - mn) * C); m_reg = mn; }
    const float mnC = -mn * C;
#pragma unroll
    for (int r = 0; r < 16; ++r) p0[r] = fmaf(p0[r], C, mnC);
#pragma unroll
    for (int r = 0; r < 16; ++r) p1[r] = fmaf(p1[r], C, mnC);
#pragma unroll
    for (int r = 0; r < 16; ++r) p0[r] = __builtin_amdgcn_exp2f(p0[r]);
}
DEVI void finishSM(f32x16& p0, f32x16& p1, float alpha, float& l_reg, bf16x8& pa0, bf16x8& pa1, bf16x8& pa2, bf16x8& pa3) {
#pragma unroll
    for (int r = 0; r < 16; ++r) p1[r] = __builtin_amdgcn_exp2f(p1[r]);
    float ps = 0.f;
#pragma unroll
    for (int r = 0; r < 16; ++r) ps += p0[r];
#pragma unroll
    for (int r = 0; r < 16; ++r) ps += p1[r];
    { auto rr = __builtin_amdgcn_permlane32_swap(__float_as_uint(ps), __float_as_uint(ps), false, false);
      ps = __uint_as_float(rr[0]) + __uint_as_float(rr[1]); }
    l_reg = l_reg * alpha + ps;
#define PK4(P, BASE, OUT) do { unsigned a0 = cvt_pk_bf16(P[BASE + 0], P[BASE + 1]), a1 = cvt_pk_bf16(P[BASE + 2], P[BASE + 3]);   \
    unsigned b0 = cvt_pk_bf16(P[BASE + 4], P[BASE + 5]), b1 = cvt_pk_bf16(P[BASE + 6], P[BASE + 7]);                              \
    auto r0 = __builtin_amdgcn_permlane32_swap(a0, b0, false, false); auto r1 = __builtin_amdgcn_permlane32_swap(a1, b1, false, false); \
    u32x4 w = {r0[0], r1[0], r0[1], r1[1]}; OUT = *reinterpret_cast<bf16x8*>(&w); } while (0)
    PK4(p0, 0, pa0); PK4(p0, 8, pa1); PK4(p1, 0, pa2); PK4(p1, 8, pa3);
#undef PK4
}
DEVI void qkt(f32x16& p0, f32x16& p1, const char* Ks, const bf16x8* qr, int r32, int hi) {
    p0 = f32x16{}; p1 = f32x16{};
#pragma unroll
    for (int d0 = 0; d0 < 6; ++d0) { const int cb = (d0 * 16 + hi * 8) * 2;
        const bf16x8 b0 = *reinterpret_cast<const bf16x8*>(Ks + KSWZ(r32, cb));
        const bf16x8 b1 = *reinterpret_cast<const bf16x8*>(Ks + KSWZ(32 + r32, cb));
        p0 = __builtin_amdgcn_mfma_f32_32x32x16_bf16(b0, qr[d0], p0, 0, 0, 0);
        p1 = __builtin_amdgcn_mfma_f32_32x32x16_bf16(b1, qr[d0], p1, 0, 0, 0); }
}
DEVI int v_st(int k, int c) { const int kk = (k & ~0xC) | ((k & 4) << 1) | ((k & 8) >> 1); return ((kk >> 3) * 4 + (c >> 5)) * 512 + ((kk & 7) * 32 + (c & 31)) * 2; }
DEVI int v_rd_base(int lane) { return ((lane & 3) << 3) | (((lane >> 2) & 3) << 6) | (((lane >> 4) & 1) << 5) | (((lane >> 5) & 1) << 8); }
constexpr int v_rd_off(int d0, int ks, int half) { return d0 * 512 + ks * 4096 + half * 2048; }
template <int OFF> DEVI s16x4 tr_read(int vb) {
    s16x4 r; asm volatile("ds_read_b64_tr_b16 %0, %1 offset:%2" : "=&v"(r) : "v"(vb), "i"(OFF) : "memory"); return r;
}
template <int D0> DEVI void pv_one(f32x16& od, int vb, bf16x8 pa0, bf16x8 pa1, bf16x8 pa2, bf16x8 pa3) {
    const s16x4 l0 = tr_read<v_rd_off(D0, 0, 0)>(vb), h0 = tr_read<v_rd_off(D0, 0, 1)>(vb), l1 = tr_read<v_rd_off(D0, 1, 0)>(vb), h1 = tr_read<v_rd_off(D0, 1, 1)>(vb);
    const s16x4 l2 = tr_read<v_rd_off(D0, 2, 0)>(vb), h2 = tr_read<v_rd_off(D0, 2, 1)>(vb), l3 = tr_read<v_rd_off(D0, 3, 0)>(vb), h3 = tr_read<v_rd_off(D0, 3, 1)>(vb);
    asm volatile("s_waitcnt lgkmcnt(0)" ::: "memory"); SBAR();
#define PKV(L, H) (bf16x8){L[0], L[1], L[2], L[3], H[0], H[1], H[2], H[3]}
    od = __builtin_amdgcn_mfma_f32_32x32x16_bf16(pa0, PKV(l0, h0), od, 0, 0, 0);
    od = __builtin_amdgcn_mfma_f32_32x32x16_bf16(pa1, PKV(l1, h1), od, 0, 0, 0);
    od = __builtin_amdgcn_mfma_f32_32x32x16_bf16(pa2, PKV(l2, h2), od, 0, 0, 0);
    od = __builtin_amdgcn_mfma_f32_32x32x16_bf16(pa3, PKV(l3, h3), od, 0, 0, 0);
#undef PKV
}
DEVI void pv_d0(f32x16* o, int vb, bf16x8 pa0, bf16x8 pa1, bf16x8 pa2, bf16x8 pa3) {
    pv_one<0>(o[0], vb, pa0, pa1, pa2, pa3); pv_one<1>(o[1], vb, pa0, pa1, pa2, pa3);
}
DEVI void attn_unit(const bf16_t* __restrict__ Qb, const bf16_t* __restrict__ Kh, const bf16_t* __restrict__ Vh, int seq, bf16_t* __restrict__ Ob, int ldo, char* lds) {
    const int tid = tid_(), wid = tid >> 6, lane = tid & 63, r32 = lane & 31, hi = lane >> 5;
    char* V_lds = lds; char* K_lds = lds + 2 * SHM_V;
    float* wsl = (float*)(lds + 2 * SHM_V + 2 * SHM_K) + wid * 64; float* li_l = wsl; float* al_l = wsl + 32;
    float m_reg = -1e30f, l_reg = 0.f; f32x16 o[2] = {}; bf16x8 qr[6];
    const bf16_t* Qw = Qb + (size_t)(wid * 32 + r32) * 96 + hi * 8;
#pragma unroll
    for (int d0 = 0; d0 < 6; ++d0) qr[d0] = *reinterpret_cast<const bf16x8*>(Qw + d0 * 16);
    const int sr = tid >> 4, kc = tid & 15, kcl = (kc < 12 ? kc : 11) * 8;
    const int vr = tid >> 3, vc = (tid & 7) * 8, vst0 = v_st(vr, vc);
    const int kst0 = KSWZ(sr, kc * 16), kst1 = KSWZ(32 + sr, kc * 16);
    const int vb0 = (int)(uintptr_t)V_lds + v_rd_base(lane);
    bf16x8 sv0, sk00, sk01, sv1, sk10, sk11;
#define SLOAD0(k0) do { sv0 = *reinterpret_cast<const bf16x8*>(Vh + (size_t)((k0) + vr) * 64 + vc); sk00 = *reinterpret_cast<const bf16x8*>(Kh + (size_t)((k0) + sr) * 96 + kcl); \
    sk01 = *reinterpret_cast<const bf16x8*>(Kh + (size_t)((k0) + 32 + sr) * 96 + kcl); } while (0)
#define SLOAD1(k0) do { sv1 = *reinterpret_cast<const bf16x8*>(Vh + (size_t)((k0) + vr) * 64 + vc); sk10 = *reinterpret_cast<const bf16x8*>(Kh + (size_t)((k0) + sr) * 96 + kcl); \
    sk11 = *reinterpret_cast<const bf16x8*>(Kh + (size_t)((k0) + 32 + sr) * 96 + kcl); } while (0)
#define SWRITE0(b) do { *(bf16x8*)(V_lds + (b) * SHM_V + vst0) = sv0; *(bf16x8*)(K_lds + (b) * SHM_K + kst0) = sk00; *(bf16x8*)(K_lds + (b) * SHM_K + kst1) = sk01; } while (0)
#define SWRITE1(b) do { *(bf16x8*)(V_lds + (b) * SHM_V + vst0) = sv1; *(bf16x8*)(K_lds + (b) * SHM_K + kst0) = sk10; *(bf16x8*)(K_lds + (b) * SHM_K + kst1) = sk11; } while (0)
#define SWAIT() asm volatile("s_waitcnt vmcnt(3)" ::: "memory")
#define RESC(a) do { if (__any((a) < 1.f)) { if (hi == 0) al_l[r32] = (a); asm volatile("s_waitcnt lgkmcnt(0)" ::: "memory"); \
    _Pragma("unroll") for (int d = 0; d < 2; ++d) _Pragma("unroll") for (int r = 0; r < 16; ++r) o[d][r] *= al_l[crow(r, hi)]; } } while (0)
    f32x16 pA0, pA1, pB0, pB1; float mnA, mnB, alA, alB; bf16x8 pa0, pa1, pa2, pa3; const int NT = seq / KVBLK;
    SLOAD0(0); asm volatile("s_waitcnt vmcnt(0)" ::: "memory"); SWRITE0(0); __syncthreads();
    qkt(pA0, pA1, K_lds, qr, r32, hi); partialSM(pA0, pA1, m_reg, mnA, alA);
    SLOAD1(KVBLK); if (2 < NT) SLOAD0(2 * KVBLK);
    SWAIT(); SWRITE1(1); __syncthreads();
    for (int j = 1; j + 1 < NT; j += 2) {
        SBAR(); qkt(pB0, pB1, K_lds + SHM_K, qr, r32, hi);
        finishSM(pA0, pA1, alA, l_reg, pa0, pa1, pa2, pa3); SBAR();
        SLOAD1((j + 2) * KVBLK); SBAR();
        pv_d0(o, vb0, pa0, pa1, pa2, pa3); partialSM(pB0, pB1, m_reg, mnB, alB);
        __syncthreads(); SWAIT(); SWRITE0(0);
        RESC(alB); __syncthreads();
        SBAR(); qkt(pA0, pA1, K_lds, qr, r32, hi);
        finishSM(pB0, pB1, alB, l_reg, pa0, pa1, pa2, pa3); SBAR();
        if (j + 3 < NT) SLOAD0((j + 3) * KVBLK); SBAR();
        pv_d0(o, vb0 + SHM_V, pa0, pa1, pa2, pa3); partialSM(pA0, pA1, m_reg, mnA, alA);
        __syncthreads(); SWAIT(); SWRITE1(1);
        RESC(alA); __syncthreads();
    }
    SBAR(); qkt(pB0, pB1, K_lds + SHM_K, qr, r32, hi);
    finishSM(pA0, pA1, alA, l_reg, pa0, pa1, pa2, pa3); SBAR();
    pv_d0(o, vb0, pa0, pa1, pa2, pa3); partialSM(pB0, pB1, m_reg, mnB, alB);
    __syncthreads(); RESC(alB);
    finishSM(pB0, pB1, alB, l_reg, pa0, pa1, pa2, pa3); SBAR();
    pv_d0(o, vb0 + SHM_V, pa0, pa1, pa2, pa3);
    if (hi == 0) li_l[r32] = l_reg; asm volatile("s_waitcnt lgkmcnt(0)" ::: "memory");
    float rli[16];
#pragma unroll
    for (int r = 0; r < 16; ++r) rli[r] = __builtin_amdgcn_rcpf(li_l[crow(r, hi)]);
    bf16_t* Ow = Ob + (size_t)(wid * 32) * ldo;
#pragma unroll
    for (int r = 0; r < 16; ++r) { const int orow = crow(r, hi);
#pragma unroll
        for (int d0 = 0; d0 < 2; ++d0) Ow[(size_t)orow * ldo + d0 * 32 + r32] = f2bf(o[d0][r] * rli[r]); }
    __syncthreads();
#undef SLOAD0
#undef SLOAD1
#undef SWRITE0
#undef SWRITE1
#undef SWAIT
#undef RESC
}
#undef KSWZ
#undef SBAR
}

template <class ARow, class BMap, class Epi>
DEVI void gemm_tile(int K, ARow arow, const float* __restrict__ B, int ldb, BMap bmap, Epi epi, float* smem) {
    float (*As)[132] = (float (*)[132])smem;
    float (*Bs)[64] = (float (*)[64])(smem + 16 * 132);
    const int tid = tid_(), ty = tid >> 4, tx = tid & 15;
    float acc[4][4];
#pragma unroll
    for (int i = 0; i < 4; ++i)
#pragma unroll
        for (int j = 0; j < 4; ++j) acc[i][j] = 0.f;
    const int ar = tid >> 2, akq = tid & 3;
    const float* ap = arow(ar);
    const int bk0 = tid >> 6, bc = tid & 63;
    const int bcol = bmap(bc);
    for (int k0 = 0; k0 < K; k0 += 16) {
        float4 av = make_float4(0.f, 0.f, 0.f, 0.f);
        if (ap) av = *(const float4*)(ap + k0 + akq * 4);
        float b0 = 0.f, b1 = 0.f;
        if (bcol >= 0) { b0 = B[(size_t)(k0 + bk0) * ldb + bcol]; b1 = B[(size_t)(k0 + bk0 + 8) * ldb + bcol]; }
        __syncthreads();
        As[akq * 4 + 0][ar] = av.x; As[akq * 4 + 1][ar] = av.y; As[akq * 4 + 2][ar] = av.z; As[akq * 4 + 3][ar] = av.w;
        Bs[bk0][bc] = b0; Bs[bk0 + 8][bc] = b1;
        __syncthreads();
#pragma unroll
        for (int kk = 0; kk < 16; ++kk) {
            const float4 a = *(const float4*)&As[kk][ty * 4];
            const float4 b = *(const float4*)&Bs[kk][tx * 4];
            const float aa[4] = {a.x, a.y, a.z, a.w}, bb[4] = {b.x, b.y, b.z, b.w};
#pragma unroll
            for (int i = 0; i < 4; ++i)
#pragma unroll
                for (int j = 0; j < 4; ++j) acc[i][j] = fmaf(aa[i], bb[j], acc[i][j]);
        }
    }
#pragma unroll
    for (int i = 0; i < 4; ++i) epi(ty * 4 + i, tx, acc[i]);
    __syncthreads();
}

__device__ void phase_init(const Params& p) {
    const int tid = tid_(), bid = bid_(); (void)tid; (void)bid;
    float* ws = p.ws;
    const size_t n4 = (size_t)T * D / 4;
    for (size_t i = (size_t)bid * NTHR + tid; i < n4; i += (size_t)gridDim.x * NTHR) {
        const size_t e = i * 4;
        float4 v = (e < (size_t)NLAT * D) ? *(const float4*)(p.in[I_X] + e) : *(const float4*)(p.in[I_CTX] + (e - (size_t)NLAT * D));
        *(float4*)(ws + W_X + e) = v;
    }
    for (int i = bid * NTHR + tid; i < NLAYER * 4 * 128 * 128; i += gridDim.x * NTHR) ((bf16_t*)(ws + W_WSB))[i] = f2bf(p.in[I_SGWS][i]);
    if (bid == 0 && tid < 64) ((int*)(ws + W_CNT))[tid] = 0;
}

__device__ void phase_mod(const Params& p, float* smem) {
    const int tid = tid_(), bid = bid_(); (void)tid; (void)bid;
    const int wave = tid >> 6, lane = tid & 63;
    for (int it = bid; it < NLAYER * 96; it += gridDim.x) {
        const int l = it / 96, j = (it % 96) * 64 + lane;
        const float* W = p.in[I_WMOD] + (size_t)l * 1024 * 6144;
        float a0 = 0.f, a1 = 0.f;
        for (int k = wave * 128; k < wave * 128 + 128; ++k) {
            const float w = W[(size_t)k * 6144 + j];
            a0 = fmaf(silu(p.in[I_C][k]), w, a0);
            a1 = fmaf(silu(p.in[I_CCTX][k]), w, a1);
        }
        smem[(wave * 2 + 0) * 64 + lane] = a0; smem[(wave * 2 + 1) * 64 + lane] = a1;
        __syncthreads();
        if (wave < 2) {
            float s = 0.f;
            for (int w = 0; w < 8; ++w) s += smem[(w * 2 + wave) * 64 + lane];
            p.ws[W_MOD + (size_t)(l * 2 + wave) * 6144 + j] = s + p.in[I_BMOD][l * 6144 + j];
        }
        __syncthreads();
    }
}

__device__ void phase_norm(const Params& p, int l, int which) {
    const int tid = tid_(), bid = bid_(); (void)tid; (void)bid;
    const int lane = tid & 63, gw = bid * (NTHR / 64) + (tid >> 6), nw = gridDim.x * (NTHR / 64);
    const float* g = p.in[which ? I_NFFN : I_NMIX] + l * D;
    for (int t = gw; t < T; t += nw) {
        const float* x = p.ws + W_X + (size_t)t * D;
        const float* mod = p.ws + W_MOD + (size_t)(l * 2 + (t >= NLAT ? 1 : 0)) * 6144;
        const float* sh = mod + (which ? 3 : 0) * D; const float* sc = mod + (which ? 4 : 1) * D;
        float4 v[4]; float ss = 0.f;
#pragma unroll
        for (int j = 0; j < 4; ++j) { v[j] = *(const float4*)(x + j * 256 + lane * 4); ss += v[j].x * v[j].x + v[j].y * v[j].y + v[j].z * v[j].z + v[j].w * v[j].w; }
        ss = wave_sum(ss);
        const float rstd = rsqrtf(ss * (1.f / D) + EPS);
        float* h = p.ws + W_H + (size_t)t * D;
#pragma unroll
        for (int j = 0; j < 4; ++j) {
            const int c = j * 256 + lane * 4;
            const float4 gg = *(const float4*)(g + c), s1 = *(const float4*)(sc + c), s0 = *(const float4*)(sh + c);
            float4 o;
            o.x = v[j].x * rstd * gg.x * (1.f + s1.x) + s0.x; o.y = v[j].y * rstd * gg.y * (1.f + s1.y) + s0.y;
            o.z = v[j].z * rstd * gg.z * (1.f + s1.z) + s0.z; o.w = v[j].w * rstd * gg.w * (1.f + s1.w) + s0.w;
            *(float4*)(h + c) = o;
            { u32x2 w; w.x = cvt_pk_bf16(o.x, o.y); w.y = cvt_pk_bf16(o.z, o.w); *(u32x2*)((bf16_t*)(p.ws + W_HB) + (size_t)t * D + c) = w; }
        }
    }
}

__device__ void phase_inproj(const Params& p, int l, char* lds) {
    const int tid = tid_(), bid = bid_(); (void)tid;
    const float* Wm = p.in[I_WIN] + (size_t)l * D * INC;
    constexpr int ntn = (INC + 127) / 128, ntm = T / 256;
    const bf16_t* HB = (const bf16_t*)(p.ws + W_HB); float* P = p.ws + W_P;
    for (int tile = bid; tile < ntm * ntn; tile += gridDim.x) {
        const int tm = tile / ntn, tn = tile % ntn, m0 = tm * 256, n0 = tn * 128;
        gemm_unit<false>(lds, D, [&](int r) { return HB + (size_t)(m0 + r) * D; }, Wm + n0, Wm + n0, INC, INC - n0,
                  [&](const f32x4 (&acc)[4][4], int wr, int wc, int fr, int fq) {
#pragma unroll
                      for (int m = 0; m < 4; ++m) { float* row = P + (size_t)(m0 + wr * 64 + m * 16 + fr) * INC;
#pragma unroll
                          for (int n = 0; n < 4; ++n) { const int col = n0 + wc * 64 + n * 16 + 4 * fq; if (col < INC) *(f32x4*)(row + col) = acc[m][n]; } }
                  });
    }
}

__device__ void phase_prep1(const Params& p, int l) {
    const int tid = tid_(), bid = bid_(); (void)tid; (void)bid;
    const int lane = tid & 63, gw = bid * (NTHR / 64) + (tid >> 6), nw = gridDim.x * (NTHR / 64);
    float* ws = p.ws;
    for (int t = gw; t < T; t += nw) {
        const int s0 = (t < NLAT) ? 0 : NLAT, sl = (t < NLAT) ? NLAT : NCTX, n = t - s0;
        const float* P = ws + W_P; const float* pr = P + (size_t)t * INC;
        {
            const int g = lane >> 4, w = 2 << g;
            const int lo = max(n - w / 2, 0), hi = min(n + w / 2, sl);
            float4 s = make_float4(0.f, 0.f, 0.f, 0.f);
            for (int m = lo; m < hi; ++m) { const float4 v = *(const float4*)(P + (size_t)(s0 + m) * INC + OFF_A + lane * 4); s.x += v.x; s.y += v.y; s.z += v.z; s.w += v.w; }
            const float inv = 1.f / (float)(hi - lo);
            const float4 x = *(const float4*)(pr + OFF_A + lane * 4);
            float4 d; d.x = s.x * inv - x.x; d.y = s.y * inv - x.y; d.z = s.z * inv - x.z; d.w = s.w * inv - x.w;
            { u32x2 w; w.x = cvt_pk_bf16(d.x, d.y); w.y = cvt_pk_bf16(d.z, d.w); *(u32x2*)((bf16_t*)(ws + W_DIFF) + (size_t)t * 256 + lane * 4) = w; }
        }
        {
            float v[3]; float ss = 0.f;
#pragma unroll
            for (int j = 0; j < 3; ++j) { v[j] = pr[OFF_Q + j * 64 + lane]; ss += v[j] * v[j]; }
            ss = wave_sum(ss); const float rstd = rsqrtf(ss * (1.f / 192.f) + EPS);
#pragma unroll
            for (int j = 0; j < 3; ++j) ((bf16_t*)(ws + W_QN))[(size_t)t * 192 + j * 64 + lane] = f2bf(v[j] * rstd * p.in[I_QAN][l * 192 + j * 64 + lane]);
        }
        {
            float v[2]; float ss = 0.f;
#pragma unroll
            for (int j = 0; j < 2; ++j) { v[j] = pr[OFF_KV + j * 64 + lane]; ss += v[j] * v[j]; }
            ss = wave_sum(ss); const float rstd = rsqrtf(ss * (1.f / 128.f) + EPS);
#pragma unroll
            for (int j = 0; j < 2; ++j) ((bf16_t*)(ws + W_KVN))[(size_t)t * 128 + j * 64 + lane] = f2bf(v[j] * rstd * p.in[I_KVAN][l * 128 + j * 64 + lane]);
        }
        {
            const float4 zu = *(const float4*)(pr + OFF_C + lane * 4), zv = *(const float4*)(pr + OFF_C + 256 + lane * 4);
            float4 u; u.x = gelu_tanh(zu.x); u.y = gelu_tanh(zu.y); u.z = gelu_tanh(zu.z); u.w = gelu_tanh(zu.w);
            *(float4*)(ws + W_U + (size_t)t * 256 + lane * 4) = u;
            float gv[4] = {gelu_tanh(zv.x), gelu_tanh(zv.y), gelu_tanh(zv.z), gelu_tanh(zv.w)};
            const float mu = wave_sum(gv[0] + gv[1] + gv[2] + gv[3]) * (1.f / 256.f);
            float q = 0.f;
#pragma unroll
            for (int j = 0; j < 4; ++j) { gv[j] -= mu; q += gv[j] * gv[j]; }
            const float rstd = rsqrtf(wave_sum(q) * (1.f / 256.f) + EPS);
#pragma unroll
            for (int j = 0; j < 4; ++j) ws[W_VN + (size_t)t * 256 + lane * 4 + j] = gv[j] * rstd * p.in[I_SGG][l * 256 + lane * 4 + j] + p.in[I_SGB][l * 256 + lane * 4 + j];
        }
        {
            const float* cw = p.in[I_CONVW] + (size_t)l * 4 * 256;
            float4 o = *(const float4*)(p.in[I_CONVB] + l * 256 + lane * 4);
#pragma unroll
            for (int k = 0; k < 4; ++k) {
                const int m = n - 1 + k;
                if (m >= 0 && m < sl) {
                    const float4 xv = *(const float4*)(P + (size_t)(s0 + m) * INC + OFF_DX + lane * 4), wv = *(const float4*)(cw + k * 256 + lane * 4);
                    o.x = fmaf(xv.x, wv.x, o.x); o.y = fmaf(xv.y, wv.y, o.y); o.z = fmaf(xv.z, wv.z, o.z); o.w = fmaf(xv.w, wv.w, o.w);
                }
            }
            *(float4*)(ws + W_XC + (size_t)t * 256 + lane * 4) = o;
            { u32x2 w; w.x = cvt_pk_bf16(o.x, o.y); w.y = cvt_pk_bf16(o.z, o.w); *(u32x2*)((bf16_t*)(ws + W_XCB) + (size_t)t * 256 + lane * 4) = w; }
        }
    }
}

__device__ void phase_small(const Params& p, int l, char* lds) {
    const int tid = tid_(), bid = bid_(); (void)tid;
    float* ws = p.ws;
    constexpr int NK = 19, NU1 = (T / 256) * NK, NU2 = NCHUNK * 2;
    bf16_t* Y = (bf16_t*)(ws + W_YC);
    for (int u = bid; u < NU1 + NU2; u += gridDim.x) {
        if (u < NU1) {
            const int tm = u / NK, kind = u % NK, m0 = tm * 256;
            if (kind < 11) {
                const bf16_t* A; int lda, K, ldb, nval; const float* B;
                if (kind < 4) { A = (const bf16_t*)(ws + W_DIFF) + kind * 64; lda = 256; K = 64; B = p.in[I_POOLW] + (size_t)(l * 4 + kind) * 64 * 64; ldb = 64; nval = 64; }
                else if (kind < 7) { A = (const bf16_t*)(ws + W_QN); lda = 192; K = 192; B = p.in[I_WUQ] + (size_t)l * 192 * 384 + (kind - 4) * 128; ldb = 384; nval = 128; }
                else { A = (const bf16_t*)(ws + W_KVN); lda = 128; K = 128; B = p.in[I_WUKV] + (size_t)l * 128 * 512 + (kind - 7) * 128; ldb = 512; nval = 128; }
                gemm_unit<false>(lds, K, [&](int r) { return A + (size_t)(m0 + r) * lda; }, B, B, ldb, nval,
                    [&](const f32x4 (&acc)[4][4], int wr, int wc, int fr, int fq) {
#pragma unroll
                        for (int m = 0; m < 4; ++m) { const int t = m0 + wr * 64 + m * 16 + fr;
#pragma unroll
                            for (int n = 0; n < 4; ++n) { const int c = wc * 64 + n * 16 + 4 * fq;
                                if (kind < 4) { if (wc == 0) { const f32x4 sc = *(const f32x4*)(p.in[I_POOLS] + l * 256 + kind * 64 + c); const f32x4 v = acc[m][n] * sc;
                                        u32x2 w; w.x = cvt_pk_bf16(v[0], v[1]); w.y = cvt_pk_bf16(v[2], v[3]); *(u32x2*)(Y + (size_t)t * D + kind * 64 + c) = w; } }
                                else if (kind < 7) *(f32x4*)(ws + W_QUP + (size_t)t * 384 + (kind - 4) * 128 + c) = acc[m][n];
                                else *(f32x4*)(ws + W_KVUP + (size_t)t * 512 + (kind - 7) * 128 + c) = acc[m][n]; } }
                    });
            } else {
                const int d = (kind - 11) >> 2, h = (kind - 11) & 3;
                const bf16_t* A = (const bf16_t*)(ws + W_XCB) + h * 64;
                const float* Ba = p.in[I_WA] + (size_t)((l * 2 + d) * 4 + h) * 64 * 64; const float* Bx = p.in[I_WX] + (size_t)((l * 2 + d) * 4 + h) * 64 * 64;
                const int pb = (l * 2 + d) * 256 + h * 64;
                gemm_unit<true>(lds, 64, [&](int r) { return A + (size_t)(m0 + r) * 256; }, Ba, Bx, 64, 64,
                    [&](const f32x4 (&acc)[4][4], int wr, int wc, int fr, int fq) {
#pragma unroll
                        for (int m = 0; m < 4; ++m) { const int t = m0 + wr * 64 + m * 16 + fr;
#pragma unroll
                            for (int pp = 0; pp < 2; ++pp) { const int idx = (wc * 2 + pp) * 16 + 4 * fq;
                                const f32x4 ba = *(const f32x4*)(p.in[I_BA] + pb + idx), bx = *(const f32x4*)(p.in[I_BX] + pb + idx), lam = *(const f32x4*)(p.in[I_LAM] + pb + idx);
                                const f32x4 xv = *(const f32x4*)(ws + W_XC + (size_t)t * 256 + h * 64 + idx);
                                f32x4 av, dv;
#pragma unroll
                                for (int j = 0; j < 4; ++j) { const float r = sigm(acc[m][2 * pp][j] + ba[j]), ig = sigm(acc[m][2 * pp + 1][j] + bx[j]);
                                    const float loga = -8.f * r * log1pf(expf(-lam[j]));
                                    av[j] = expf(loga); dv[j] = sqrtf(-expm1f(2.f * loga)) * (ig * xv[j]); }
                                *(f32x4*)(ws + W_LA + ((size_t)d * T + t) * 256 + h * 64 + idx) = av;
                                *(f32x4*)(ws + W_LB + ((size_t)d * T + t) * 256 + h * 64 + idx) = dv; } }
                    });
            }
        } else {
            const int v = u - NU1, c = v >> 1, hp = v & 1;
            const bf16_t* A = (const bf16_t*)(ws + W_WSB) + ((size_t)l * 512 + hp * 256) * 128;
            const float* B = ws + W_VN + (size_t)c * 128 * 256 + hp * 128;
            gemm_unit<false>(lds, 128, [&](int r) { return A + (size_t)r * 128; }, B, B, 256, 128,
                [&](const f32x4 (&acc)[4][4], int wr, int wc, int fr, int fq) {
                    if ((wr >> 1) == wc) {
                        const int h = hp * 2 + wc;
#pragma unroll
                        for (int m = 0; m < 4; ++m) { const int pp = (wr & 1) * 64 + m * 16 + fr, t = c * 128 + pp; const float bs = p.in[I_SGBS][(l * 4 + h) * 128 + pp];
#pragma unroll
                            for (int n = 0; n < 4; ++n) { const int ch = h * 64 + n * 16 + 4 * fq; const f32x4 uu = *(const f32x4*)(ws + W_U + (size_t)t * 256 + ch);
                                const f32x4 o = uu * (acc[m][n] + bs);
                                u32x2 w; w.x = cvt_pk_bf16(o[0], o[1]); w.y = cvt_pk_bf16(o[2], o[3]); *(u32x2*)(Y + (size_t)t * D + 512 + ch) = w; } }
                    }
                });
        }
    }
}

__device__ void phase_prep2(const Params& p, int l) {
    const int tid = tid_(), bid = bid_(); (void)tid; (void)bid;
    float* ws = p.ws;
    const int lane = tid & 63, gw = bid * (NTHR / 64) + (tid >> 6), nw = gridDim.x * (NTHR / 64);
    for (int it = gw; it < T * 4; it += nw) {
        const int t = it >> 2, h = it & 3;
        const bool lat = t < NLAT;
        float cs = 1.f, sn = 0.f;
        if (lat && lane < 32) {
            const int f = lane & 15; const float pos = (f < 8) ? (float)(t >> 6) : (float)(t & 63);
            const float inv = powf(10000.f, -(float)(f & 7) / 8.f);
            const float ang = pos * inv; cs = cosf(ang); sn = sinf(ang);
        }
        {
            float v0 = ws[W_QUP + (size_t)t * 384 + h * 96 + lane], v1 = (lane < 32) ? ws[W_QUP + (size_t)t * 384 + h * 96 + 64 + lane] : 0.f;
            const float rstd = rsqrtf(wave_sum(v0 * v0 + v1 * v1) * (1.f / 96.f) + EPS);
            v0 *= rstd * p.in[I_QN][l * 96 + lane]; v1 *= (lane < 32) ? rstd * p.in[I_QN][l * 96 + 64 + lane] : 0.f;
            const float pv = __shfl_xor(v1, 16);
            const float r1 = (lane < 16) ? v1 * cs - pv * sn : pv * sn + v1 * cs;
            bf16_t* qo = (bf16_t*)(ws + W_Q) + ((size_t)h * T + t) * 96;
            qo[lane] = f2bf(v0);
            if (lane < 32) qo[64 + lane] = f2bf(lat ? r1 : v1);
        }
        {
            float v0 = ws[W_KVUP + (size_t)t * 512 + h * 128 + lane], v1 = (lane < 32) ? ws[W_P + (size_t)t * INC + OFF_KR + lane] : 0.f;
            const float rstd = rsqrtf(wave_sum(v0 * v0 + v1 * v1) * (1.f / 96.f) + EPS);
            v0 *= rstd * p.in[I_KN][l * 96 + lane]; v1 *= (lane < 32) ? rstd * p.in[I_KN][l * 96 + 64 + lane] : 0.f;
            const float pv = __shfl_xor(v1, 16);
            const float r1 = (lane < 16) ? v1 * cs - pv * sn : pv * sn + v1 * cs;
            bf16_t* ko = (bf16_t*)(ws + W_K) + ((size_t)h * T + t) * 96;
            ko[lane] = f2bf(v0);
            if (lane < 32) ko[64 + lane] = f2bf(lat ? r1 : v1);
            ((bf16_t*)(ws + W_V))[((size_t)h * T + t) * 64 + lane] = f2bf(ws[W_KVUP + (size_t)t * 512 + h * 128 + 64 + lane]);
        }
    }
    for (int i = bid * NTHR + tid; i < NCHUNK * 512; i += gridDim.x * NTHR) {
        const int c = i >> 9, d = (i >> 8) & 1, ch = i & 255;
        float* A = ws + W_LA + ((size_t)d * T + (size_t)c * 128) * 256 + ch;
        float* B = ws + W_LB + ((size_t)d * T + (size_t)c * 128) * 256 + ch;
        float h = 0.f, ap = 1.f;
        for (int s = 0; s < 128; ++s) {
            const int q = d ? 127 - s : s;
            const float a = A[(size_t)q * 256], b = B[(size_t)q * 256];
            h = fmaf(a, h, b); ap *= a;
            A[(size_t)q * 256] = ap; B[(size_t)q * 256] = h;
        }
        ws[W_AGG + ((size_t)(c * 2 + d) * 2 + 0) * 256 + ch] = ap;
        ws[W_AGG + ((size_t)(c * 2 + d) * 2 + 1) * 256 + ch] = h;
    }
}


__device__ void phase_attn(const Params& p, int l, char* lds) {
    const int tid = tid_(), bid = bid_(); (void)tid;
    const bf16_t* Qb = (const bf16_t*)(p.ws + W_Q); const bf16_t* Kb = (const bf16_t*)(p.ws + W_K); const bf16_t* Vb = (const bf16_t*)(p.ws + W_V);
    bf16_t* Y = (bf16_t*)(p.ws + W_YC);
    const int nunits = (l == 0) ? 260 : 256;
    for (int u = bid; u < nunits; u += gridDim.x) {
        int h, t0, k0, seq;
        if (u < 256) { h = (u & 7) >> 1; t0 = (((u >> 3) << 1) | (u & 1)) * 256; k0 = 0; seq = T; }
        else { h = u - 256; t0 = NLAT; k0 = NLAT; seq = NCTX; }
        att::attn_unit(Qb + ((size_t)h * T + t0) * 96, Kb + ((size_t)h * T + k0) * 96, Vb + ((size_t)h * T + k0) * 64, seq, Y + (size_t)t0 * D + 256 + h * 64, D, lds);
    }
}

__device__ void phase_lru_fin(const Params& p, char* lds) {
    const int tid = tid_(), bid = bid_();
    float* ws = p.ws;
    float* carry = (float*)lds;
    for (int c = bid; c < NCHUNK; c += gridDim.x) {
        {
            const int d = tid >> 8, ch = tid & 255;
            const int npre = d ? (NCHUNK - 1 - c) : ((c + 2) % NCHUNK);
            float s = 0.f;
            for (int k = 0; k < npre; ++k) {
                const int q = d ? (NCHUNK - 1 - k) : ((k + 128) % NCHUNK);
                const float a = ws[W_AGG + ((size_t)(q * 2 + d) * 2 + 0) * 256 + ch], hh = ws[W_AGG + ((size_t)(q * 2 + d) * 2 + 1) * 256 + ch];
                s = fmaf(a, s, hh);
            }
            carry[tid] = s;
        }
        __syncthreads();
        for (int i = tid; i < 128 * 64; i += NTHR) {
            const int t = c * 128 + (i >> 6), ch = (i & 63) * 4;
            f32x4 hs = *(const f32x4*)(ws + W_LB + (size_t)t * 256 + ch) + *(const f32x4*)(ws + W_LA + (size_t)t * 256 + ch) * *(const f32x4*)(carry + ch);
            hs = hs + *(const f32x4*)(ws + W_LB + ((size_t)T + t) * 256 + ch) + *(const f32x4*)(ws + W_LA + ((size_t)T + t) * 256 + ch) * *(const f32x4*)(carry + 256 + ch);
            const f32x4 g = *(const f32x4*)(ws + W_P + (size_t)t * INC + OFF_DG + ch);
            u32x2 w; w.x = cvt_pk_bf16(gelu_tanh(g[0]) * hs[0], gelu_tanh(g[1]) * hs[1]); w.y = cvt_pk_bf16(gelu_tanh(g[2]) * hs[2], gelu_tanh(g[3]) * hs[3]);
            *(u32x2*)((bf16_t*)(ws + W_YC) + (size_t)t * D + 768 + ch) = w;
        }
        __syncthreads();
    }
}

__device__ void phase_outproj(const Params& p, int l, char* lds) {
    const int tid = tid_(), bid = bid_(); (void)tid;
    const float* Wm = p.in[I_WOUT] + (size_t)l * D * D;
    constexpr int ntn = D / 128, ntm = T / 256;
    const bf16_t* Y = (const bf16_t*)(p.ws + W_YC); float* X = p.ws + W_X;
    for (int tile = bid; tile < ntm * ntn; tile += gridDim.x) {
        const int tm = tile / ntn, tn = tile % ntn, m0 = tm * 256, n0 = tn * 128;
        const float* g1 = p.ws + W_MOD + (size_t)(l * 2 + (m0 >= NLAT ? 1 : 0)) * 6144 + 2 * D;
        gemm_unit<false>(lds, D, [&](int r) { return Y + (size_t)(m0 + r) * D; }, Wm + n0, Wm + n0, D, 128,
                  [&](const f32x4 (&acc)[4][4], int wr, int wc, int fr, int fq) {
#pragma unroll
                      for (int m = 0; m < 4; ++m) { float* row = X + (size_t)(m0 + wr * 64 + m * 16 + fr) * D;
#pragma unroll
                          for (int n = 0; n < 4; ++n) { const int col = n0 + wc * 64 + n * 16 + 4 * fq; const f32x4 g = *(const f32x4*)(g1 + col); f32x4 x = *(f32x4*)(row + col);
                              x = x + g * acc[m][n]; *(f32x4*)(row + col) = x; } }
                  });
    }
}

__device__ void phase_router(const Params& p, int l) {
    const int tid = tid_(), bid = bid_(); (void)tid; (void)bid;
    float* ws = p.ws;
    const int lane = tid & 63, gw = bid * (NTHR / 64) + (tid >> 6), nw = gridDim.x * (NTHR / 64);
    const float* rw = p.in[I_RW] + (size_t)l * D * NEXP;
    int* cnt = (int*)(ws + W_CNT) + l * NEXP;
    int* list = (int*)(ws + W_LIST);
    const int e = lane & 31, half = lane >> 5;
    for (int t = gw; t < T; t += nw) {
        const float* f = ws + W_H + (size_t)t * D + half * 512;
        const float* w = rw + (size_t)half * 512 * NEXP + e;
        float a = 0.f;
        for (int k = 0; k < 512; ++k) a = fmaf(f[k], w[(size_t)k * NEXP], a);
        a += __shfl_xor(a, 32);
        a += p.in[I_RB][l * NEXP + e];
        float tv[4]; int te[4];
        float cur = a;
#pragma unroll
        for (int k = 0; k < 4; ++k) {
            float bv = cur; int bi = e;
#pragma unroll
            for (int o = 16; o > 0; o >>= 1) {
                const float ov = __shfl_xor(bv, o); const int oi = __shfl_xor(bi, o);
                if (ov > bv || (ov == bv && oi < bi)) { bv = ov; bi = oi; }
            }
            tv[k] = bv; te[k] = bi;
            if (e == bi) cur = -3.0e38f;
        }
        const float mx = tv[0];
        float ex[4], s = 0.f;
#pragma unroll
        for (int k = 0; k < 4; ++k) { ex[k] = expf(tv[k] - mx); s += ex[k]; }
        if (lane < 4) {
            const int ee = te[lane];
            const int idx = atomicAdd(&cnt[ee], 1);
            list[(size_t)ee * T + idx] = t;
            ((int*)(ws + W_TOPE))[t * 4 + lane] = ee;
            ((int*)(ws + W_TOPI))[t * 4 + lane] = idx;
            ws[W_TOPG + t * 4 + lane] = ex[lane] / s;
        }
    }
}

DEVI void moe_bases(const Params& p, int l, int* sb) {
    const int tid = tid_();
    if (tid == 0) {
        const int* cnt = (const int*)(p.ws + W_CNT) + l * NEXP;
        int b = 0, tb = 0;
        for (int e = 0; e < NEXP; ++e) { sb[e] = b; sb[40 + e] = tb; const int c = cnt[e]; sb[80 + e] = c; const int mt = (c + 255) / 256; b += mt * 256; tb += mt; }
        sb[32] = b; sb[72] = tb;
    }
    __syncthreads();
}

__device__ void phase_moe1(const Params& p, int l, char* lds) {
    const int tid = tid_(), bid = bid_(); (void)tid;
    int* sb = (int*)(lds + G_LDS);
    moe_bases(p, l, sb);
    constexpr int ntn = 16;
    const int nunits = sb[72] * ntn;
    const int* list = (const int*)(p.ws + W_LIST);
    const bf16_t* HB = (const bf16_t*)(p.ws + W_HB); bf16_t* ACT = (bf16_t*)(p.ws + W_ACT);
    for (int u = bid; u < nunits; u += gridDim.x) {
        int e = 0; while (e < NEXP - 1 && sb[40 + e + 1] * ntn <= u) ++e;
        const int mts = sb[40 + e + 1] - sb[40 + e], loc = u - sb[40 + e] * ntn, tn = loc / mts, mt = loc % mts;
        const int mloc = mt * 256, cnt = sb[80 + e], rbase = sb[e] + mloc;
        const float* Wm = p.in[I_WGU] + ((size_t)(l * NEXP + e) * D) * 2048 + tn * 64;
        const float* bias = p.in[I_BGU] + (size_t)(l * NEXP + e) * 2048 + tn * 64;
        const int* le = list + (size_t)e * T + mloc;
        gemm_unit<true>(lds, D, [&](int r) { return (mloc + r < cnt) ? HB + (size_t)le[r] * D : (const bf16_t*)nullptr; }, Wm, Wm + 1024, 2048, 64,
                  [&](const f32x4 (&acc)[4][4], int wr, int wc, int fr, int fq) {
#pragma unroll
                      for (int m = 0; m < 4; ++m) { const int r = wr * 64 + m * 16 + fr;
                          if (mloc + r < cnt) {
#pragma unroll
                              for (int pp = 0; pp < 2; ++pp) { const int idx = (wc * 2 + pp) * 16 + 4 * fq;
                                  const f32x4 bg = *(const f32x4*)(bias + idx), bu = *(const f32x4*)(bias + 1024 + idx);
                                  float a[4];
#pragma unroll
                                  for (int j = 0; j < 4; ++j) { float g = acc[m][2 * pp][j] + bg[j], uu = acc[m][2 * pp + 1][j] + bu[j];
                                      g = fminf(g, 7.f); uu = fminf(fmaxf(uu, -7.f), 7.f); a[j] = (uu + 1.f) * (g * sigm(1.702f * g)); }
                                  u32x2 w; w.x = cvt_pk_bf16(a[0], a[1]); w.y = cvt_pk_bf16(a[2], a[3]);
                                  *(u32x2*)(ACT + (size_t)(rbase + r) * D + tn * 64 + idx) = w; } } }
                  });
    }
    __syncthreads();
}

__device__ void phase_moe2(const Params& p, int l, char* lds) {
    const int tid = tid_(), bid = bid_(); (void)tid;
    int* sb = (int*)(lds + G_LDS);
    moe_bases(p, l, sb);
    constexpr int ntn = D / 128;
    const int nunits = sb[72] * ntn;
    const bf16_t* ACT = (const bf16_t*)(p.ws + W_ACT); bf16_t* YR = (bf16_t*)(p.ws + W_YR);
    for (int u = bid; u < nunits; u += gridDim.x) {
        int e = 0; while (e < NEXP - 1 && sb[40 + e + 1] * ntn <= u) ++e;
        const int mts = sb[40 + e + 1] - sb[40 + e], loc = u - sb[40 + e] * ntn, tn = loc / mts, mt = loc % mts;
        const int mloc = mt * 256, cnt = sb[80 + e], rbase = sb[e] + mloc, n0 = tn * 128;
        const float* Wm = p.in[I_WDN] + ((size_t)(l * NEXP + e) * D) * D + n0;
        const float* bias = p.in[I_BDN] + (size_t)(l * NEXP + e) * D + n0;
        gemm_unit<false>(lds, D, [&](int r) { return (mloc + r < cnt) ? ACT + (size_t)(rbase + r) * D : (const bf16_t*)nullptr; }, Wm, Wm, D, 128,
                  [&](const f32x4 (&acc)[4][4], int wr, int wc, int fr, int fq) {
#pragma unroll
                      for (int m = 0; m < 4; ++m) { const int r = wr * 64 + m * 16 + fr;
                          if (mloc + r < cnt) {
#pragma unroll
                              for (int n = 0; n < 4; ++n) { const int c = wc * 64 + n * 16 + 4 * fq; const f32x4 b = *(const f32x4*)(bias + c); const f32x4 v = acc[m][n] + b;
                                  u32x2 w; w.x = cvt_pk_bf16(v[0], v[1]); w.y = cvt_pk_bf16(v[2], v[3]);
                                  *(u32x2*)(YR + (size_t)(rbase + r) * D + n0 + c) = w; } } }
                  });
    }
    __syncthreads();
}

__device__ void phase_combine(const Params& p, int l, char* lds, bool last) {
    const int tid = tid_(), bid = bid_();
    int* sb = (int*)(lds + G_LDS);
    moe_bases(p, l, sb);
    float* ws = p.ws;
    const bf16_t* YR = (const bf16_t*)(ws + W_YR);
    const int lane = tid & 63, gw = bid * (NTHR / 64) + (tid >> 6), nw = gridDim.x * (NTHR / 64);
    for (int t = gw; t < T; t += nw) {
        const float* g2 = ws + W_MOD + (size_t)(l * 2 + (t >= NLAT ? 1 : 0)) * 6144 + 5 * D;
        const bf16_t* yr[4]; float gt[4];
#pragma unroll
        for (int k = 0; k < 4; ++k) {
            const int e = ((const int*)(ws + W_TOPE))[t * 4 + k], idx = ((const int*)(ws + W_TOPI))[t * 4 + k];
            yr[k] = YR + (size_t)(sb[e] + idx) * D; gt[k] = ws[W_TOPG + t * 4 + k];
        }
        float* x = ws + W_X + (size_t)t * D;
#pragma unroll
        for (int j = 0; j < 4; ++j) {
            const int c = j * 256 + lane * 4;
            float a0 = 0.f, a1 = 0.f, a2 = 0.f, a3 = 0.f;
#pragma unroll
            for (int k = 0; k < 4; ++k) { const u32x2 y = *(const u32x2*)(yr[k] + c);
                a0 = fmaf(gt[k], __uint_as_float(y.x << 16), a0); a1 = fmaf(gt[k], __uint_as_float(y.x & 0xffff0000u), a1);
                a2 = fmaf(gt[k], __uint_as_float(y.y << 16), a2); a3 = fmaf(gt[k], __uint_as_float(y.y & 0xffff0000u), a3); }
            float4 xv = *(const float4*)(x + c); const float4 gg = *(const float4*)(g2 + c);
            xv.x = fmaf(gg.x, a0, xv.x); xv.y = fmaf(gg.y, a1, xv.y); xv.z = fmaf(gg.z, a2, xv.z); xv.w = fmaf(gg.w, a3, xv.w);
            *(float4*)(x + c) = xv;
            if (last && t < NLAT) *(float4*)(p.out + (size_t)t * D + c) = xv;
        }
    }
    __syncthreads();
}

constexpr int LDS_BYTES = G_LDS + 2048;
__global__ void __launch_bounds__(NTHR) fwd_kernel(Params p) {
    cg::grid_group grid = cg::this_grid();
    extern __shared__ __attribute__((aligned(16))) char lds[];
    float* smem = (float*)lds;
    phase_init(p);
    phase_mod(p, smem);
    grid.sync();
    for (int l = 0; l < NLAYER; ++l) {
        phase_norm(p, l, 0);
        grid.sync();
        phase_inproj(p, l, lds);
        grid.sync();
        phase_prep1(p, l);
        grid.sync();
        phase_small(p, l, lds);
        grid.sync();
        phase_prep2(p, l);
        grid.sync();
        phase_attn(p, l, lds);
        grid.sync();
        phase_lru_fin(p, lds);
        grid.sync();
        phase_outproj(p, l, lds);
        grid.sync();
        phase_norm(p, l, 1);
        grid.sync();
        phase_router(p, l);
        grid.sync();
        phase_moe1(p, l, lds);
        grid.sync();
        phase_moe2(p, l, lds);
        grid.sync();
        phase_combine(p, l, lds, l == NLAYER - 1);
        grid.sync();
    }
}

extern "C" void kernel_launch(void* const* d_in, const int* in_sizes, int n_in, void* d_out, int out_size, void* d_ws, size_t ws_size, hipStream_t stream) {
    static int grid_blocks = 0;
    if (!grid_blocks) {
        int dev = 0, cus = 0, per_cu = 0;
        (void)hipGetDevice(&dev);
        (void)hipDeviceGetAttribute(&cus, hipDeviceAttributeMultiprocessorCount, dev);
        if (hipFuncSetAttribute((const void*)fwd_kernel, hipFuncAttributeMaxDynamicSharedMemorySize, LDS_BYTES) != hipSuccess) fprintf(stderr, "kernel_launch: hipFuncSetAttribute failed\n");
        if (hipOccupancyMaxActiveBlocksPerMultiprocessor(&per_cu, fwd_kernel, NTHR, LDS_BYTES) != hipSuccess || per_cu < 1) { fprintf(stderr, "kernel_launch: occupancy query says %d\n", per_cu); per_cu = 1; }
        if (per_cu > 1) per_cu = 1;
        grid_blocks = cus * per_cu;
        if (ws_size < W_END * sizeof(float)) fprintf(stderr, "kernel_launch: workspace too small: %zu < %zu\n", ws_size, W_END * sizeof(float));
        if (n_in != N_IN) fprintf(stderr, "kernel_launch: n_in %d != %d\n", n_in, (int)N_IN);
    }
    Params p{};
    for (int i = 0; i < N_IN; ++i) p.in[i] = (const float*)d_in[i];
    p.out = (float*)d_out;
    p.ws = (float*)d_ws;
    void* args[] = {&p};
    hipError_t e = hipLaunchCooperativeKernel((void*)fwd_kernel, dim3(grid_blocks), dim3(NTHR), args, LDS_BYTES, stream);
    if (e != hipSuccess) fprintf(stderr, "cooperative launch failed: %s (grid %d)\n", hipGetErrorString(e), grid_blocks);
}
```

```cpp
#include <hip/hip_runtime.h>
#include <hip/hip_cooperative_groups.h>
#include <cstdio>
#include <cstdint>
namespace cg = cooperative_groups;

#define DEVI __device__ __forceinline__
constexpr int NTHR = 512;
constexpr int D = 1024, NLAT = 16384, NCTX = 256, T = NLAT + NCTX, NLAYER = 2;
constexpr int INC = 1632;
constexpr int OFF_A = 0, OFF_Q = 256, OFF_KV = 448, OFF_KR = 576, OFF_C = 608, OFF_DX = 1120, OFF_DG = 1376;
constexpr int NCHUNK = T / 128;
constexpr int NEXP = 32, TOPK = 4;
constexpr int MAXROWS = T * TOPK + NEXP * 256;
constexpr float EPS = 1e-6f;

enum { I_X = 0, I_C, I_CTX, I_CCTX, I_WMOD, I_BMOD, I_NMIX, I_NFFN, I_WIN, I_WOUT, I_POOLW, I_POOLS, I_QAN, I_WUQ, I_KVAN, I_WUKV,
       I_QN, I_KN, I_SGG, I_SGB, I_SGWS, I_SGBS, I_CONVW, I_CONVB, I_WA, I_BA, I_WX, I_BX, I_LAM, I_RW, I_RB, I_WGU, I_BGU, I_WDN, I_BDN, N_IN };

constexpr size_t al(size_t x) { return (x + 63) / 64 * 64; }
constexpr size_t W_X = 0;
constexpr size_t W_MOD = W_X + al((size_t)T * D);
constexpr size_t W_H = W_MOD + al(2 * 2 * 6144);
constexpr size_t W_P = W_H + al((size_t)T * D);
constexpr size_t W_YC = W_P + al((size_t)T * INC);
constexpr size_t W_Q = W_YC + al((size_t)T * D);
constexpr size_t W_K = W_Q + al((size_t)T * 384);
constexpr size_t W_V = W_K + al((size_t)T * 384);
constexpr size_t W_DIFF = W_V + al((size_t)T * 256);
constexpr size_t W_QN = W_DIFF + al((size_t)T * 256);
constexpr size_t W_KVN = W_QN + al((size_t)T * 192);
constexpr size_t W_U = W_KVN + al((size_t)T * 128);
constexpr size_t W_VN = W_U + al((size_t)T * 256);
constexpr size_t W_XC = W_VN + al((size_t)T * 256);
constexpr size_t W_QUP = W_XC + al((size_t)T * 256);
constexpr size_t W_KVUP = W_QUP + al((size_t)T * 384);
constexpr size_t W_LA = W_KVUP + al((size_t)T * 512);
constexpr size_t W_LB = W_LA + al((size_t)2 * T * 256);
constexpr size_t W_AGG = W_LB + al((size_t)2 * T * 256);
constexpr size_t W_CARRY = W_AGG + al((size_t)NCHUNK * 2 * 2 * 256);
constexpr size_t W_TOPE = W_CARRY + al((size_t)NCHUNK * 2 * 256);
constexpr size_t W_TOPG = W_TOPE + al((size_t)T * 4);
constexpr size_t W_TOPI = W_TOPG + al((size_t)T * 4);
constexpr size_t W_CNT = W_TOPI + al((size_t)T * 4);
constexpr size_t W_LIST = W_CNT + al(64);
constexpr size_t W_ACT = W_LIST + al((size_t)NEXP * T);
constexpr size_t W_YR = W_ACT + al((size_t)MAXROWS * D);
constexpr size_t W_HB = W_YR + al((size_t)MAXROWS * D);
constexpr size_t W_XCB = W_HB + al((size_t)T * D / 2);
constexpr size_t W_WSB = W_XCB + al((size_t)T * 256 / 2);
constexpr size_t W_BAR = W_WSB + al((size_t)NLAYER * 4 * 128 * 128 / 2);
constexpr size_t W_END = W_BAR + al(4096);

struct Params {
    const float* in[N_IN];
    float* out;
    float* ws;
};

DEVI int tid_() { int t = threadIdx.x; asm volatile("" : "+v"(t)); return t; }
DEVI int bid_() { int b = blockIdx.x; asm volatile("" : "+s"(b)); return b; }
DEVI float wave_sum(float v) {
#pragma unroll
    for (int o = 32; o > 0; o >>= 1) v += __shfl_xor(v, o);
    return v;
}
DEVI float gelu_tanh(float x) { const float u = 0.7978845608028654f * (x + 0.044715f * x * x * x); return 0.5f * x * (1.f + tanhf(u)); }
DEVI float sigm(float x) { return 1.f / (1.f + expf(-x)); }
DEVI float silu(float x) { return x * sigm(x); }


typedef unsigned short bf16_t;
typedef short bf16x8 __attribute__((ext_vector_type(8)));
typedef float f32x4 __attribute__((ext_vector_type(4)));
typedef unsigned u32x4 __attribute__((ext_vector_type(4)));
typedef unsigned u32x2 __attribute__((ext_vector_type(2)));
DEVI unsigned cvt_pk_bf16(float lo, float hi) { unsigned r; asm volatile("v_cvt_pk_bf16_f32 %0, %1, %2" : "=v"(r) : "v"(lo), "v"(hi)); return r; }
DEVI bf16_t f2bf(float f) { return (bf16_t)(cvt_pk_bf16(f, 0.f) & 0xffffu); }
DEVI float bf2f(bf16_t b) { return __uint_as_float(((unsigned)b) << 16); }

constexpr int G_STAGE = 49152;
constexpr int G_LDS = 2 * G_STAGE;
DEVI int lds_byte(int r, int c) { const int st = (r >> 4) * 2 + (c >> 5), rr = r & 15, cc = c & 31, ob = rr * 64 + cc * 2; return st * 1024 + (ob ^ (((ob >> 9) & 1) << 5)); }

template <bool PAIRED, class ARow, class Epi>
DEVI void gemm_unit(char* lds, int K, ARow arow, const float* __restrict__ B0, const float* __restrict__ B1, int ldb, int ncol_valid, Epi epi) {
    const int tid = tid_(), wave = tid >> 6, lane = tid & 63, fr = lane & 15, fq = lane >> 4, wr = wave >> 1, wc = wave & 1;
    const int ac = tid & 7;
    const bf16_t* ap[4]; int a_lds[4];
#pragma unroll
    for (int i = 0; i < 4; ++i) { const int r = (tid >> 3) + 64 * i; const bf16_t* q = arow(r); ap[i] = q ? q + ac * 8 : nullptr; a_lds[i] = (r >> 7) * 16384 + lds_byte(r & 127, ac * 8); }
    const int kq = lane & 15, nq = (lane >> 4) + 4 * wave;
    const float* bp; bool bvalid;
    if (PAIRED) { const int seg = (nq >> 2) & 1, idx = (nq >> 3) * 16 + (nq & 3) * 4; bp = (seg ? B1 : B0) + idx; bvalid = idx < ncol_valid; }
    else { bp = B0 + 4 * nq; bvalid = 4 * nq < ncol_valid; }
    bp += (size_t)(4 * kq) * ldb;
    int b_lds[4];
#pragma unroll
    for (int i = 0; i < 4; ++i) b_lds[i] = 32768 + lds_byte(4 * nq + i, 4 * kq);
    const int aoff = (wr >> 1) * 16384 + lds_byte((wr & 1) * 64 + fr, fq * 8), boff = 32768 + lds_byte(wc * 64 + fr, fq * 8);
    u32x4 av[4]; f32x4 bv[4];
#define G_LOAD(t) do { _Pragma("unroll") for (int i = 0; i < 4; ++i) av[i] = ap[i] ? *(const u32x4*)(ap[i] + (t) * 64) : (u32x4){0u, 0u, 0u, 0u}; \
        _Pragma("unroll") for (int kk = 0; kk < 4; ++kk) bv[kk] = bvalid ? *(const f32x4*)(bp + ((size_t)(t) * 64 + kk) * ldb) : (f32x4){0.f, 0.f, 0.f, 0.f}; } while (0)
#define G_WRITE(buf) do { char* s_ = lds + (buf) * G_STAGE; _Pragma("unroll") for (int i = 0; i < 4; ++i) *(u32x4*)(s_ + a_lds[i]) = av[i]; \
        _Pragma("unroll") for (int i = 0; i < 4; ++i) { u32x2 w_; w_.x = cvt_pk_bf16(bv[0][i], bv[1][i]); w_.y = cvt_pk_bf16(bv[2][i], bv[3][i]); *(u32x2*)(s_ + b_lds[i]) = w_; } } while (0)
    f32x4 acc[4][4];
#pragma unroll
    for (int m = 0; m < 4; ++m)
#pragma unroll
        for (int n = 0; n < 4; ++n) acc[m][n] = (f32x4){0.f, 0.f, 0.f, 0.f};
    const int nk = K >> 6;
    G_LOAD(0);
    G_WRITE(0);
    if (nk > 1) G_LOAD(1);
    __syncthreads();
    for (int t = 0; t < nk; ++t) {
        const char* s_ = lds + (t & 1) * G_STAGE;
#pragma unroll
        for (int k = 0; k < 2; ++k) {
            bf16x8 Af[4], Bf[4];
#pragma unroll
            for (int m = 0; m < 4; ++m) Af[m] = *(const bf16x8*)(s_ + aoff + m * 2048 + k * 1024);
#pragma unroll
            for (int n = 0; n < 4; ++n) Bf[n] = *(const bf16x8*)(s_ + boff + n * 2048 + k * 1024);
#pragma unroll
            for (int m = 0; m < 4; ++m)
#pragma unroll
                for (int n = 0; n < 4; ++n) acc[m][n] = __builtin_amdgcn_mfma_f32_16x16x32_bf16(Bf[n], Af[m], acc[m][n], 0, 0, 0);
        }
        if (t + 1 < nk) { G_WRITE((t + 1) & 1); if (t + 2 < nk) G_LOAD(t + 2); }
        __syncthreads();
    }
#undef G_LOAD
#undef G_WRITE
    epi(acc, wr, wc, fr, fq);
}


namespace att {
typedef short s16x4 __attribute__((ext_vector_type(4)));
typedef float f32x16 __attribute__((ext_vector_type(16)));
constexpr int KVBLK = 64;
constexpr float SCALE = 0.10206207261596577f;
constexpr float THR = 8.f;
constexpr int SHM_V = 16384, SHM_K = 16384, SHM_ATTN = 2 * SHM_V + 2 * SHM_K + 8 * 64 * 4;
#define KSWZ(row, colB) ((row) * 256 + ((colB) ^ (((row) & 7) << 4)))
#define SBAR() __builtin_amdgcn_sched_barrier(0)
DEVI int crow(int r, int hi) { return (r & 3) + 8 * (r >> 2) + 4 * hi; }
DEVI void partialSM(f32x16& p0, f32x16& p1, float& m_reg, float& mn, float& alpha) {
    constexpr float C = SCALE * 1.4426950408889634f;
    float pmax = p0[0];
#pragma unroll
    for (int r = 1; r < 16; ++r) pmax = fmaxf(pmax, p0[r]);
#pragma unroll
    for (int r = 0; r < 16; ++r) pmax = fmaxf(pmax, p1[r]);
    { auto rr = __builtin_amdgcn_permlane32_swap(__float_as_uint(pmax), __float_as_uint(pmax), false, false);
      pmax = fmaxf(__uint_as_float(rr[0]), __uint_as_float(rr[1])); }
    if (__builtin_expect(__all(pmax - m_reg <= THR / SCALE), 1)) { mn = m_reg; alpha = 1.f; }
    else { mn = fmaxf(m_reg, pmax); alpha = __builtin_amdgcn_exp2f((m_reg - mn) * C); m_reg = mn; }
    const float mnC = -mn * C;
#pragma unroll
    for (int r = 0; r < 16; ++r) p0[r] = fmaf(p0[r], C, mnC);
#pragma unroll
    for (int r = 0; r < 16; ++r) p1[r] = fmaf(p1[r], C, mnC);
#pragma unroll
    for (int r = 0; r < 16; ++r) p0[r] = __builtin_amdgcn_exp2f(p0[r]);
}
DEVI void finishSM(f32x16& p0, f32x16& p1, float alpha, float& l_reg, bf16x8& pa0, bf16x8& pa1, bf16x8& pa2, bf16x8& pa3) {
#pragma unroll
    for (int r = 0; r < 16; ++r) p1[r] = __builtin_amdgcn_exp2f(p1[r]);
    float ps = 0.f;
#pragma unroll
    for (int r = 0; r < 16; ++r) ps += p0[r];
#pragma unroll
    for (int r = 0; r < 16; ++r) ps += p1[r];
    { auto rr = __builtin_amdgcn_permlane32_swap(__float_as_uint(ps), __float_as_uint(ps), false, false);
      ps = __uint_as_float(rr[0]) + __uint_as_float(rr[1]); }
    l_reg = l_reg * alpha + ps;
#define PK4(P, BASE, OUT) do { unsigned a0 = cvt_pk_bf16(P[BASE + 0], P[BASE + 1]), a1 = cvt_pk_bf16(P[BASE + 2], P[BASE + 3]);   \
    unsigned b0 = cvt_pk_bf16(P[BASE + 4], P[BASE + 5]), b1 = cvt_pk_bf16(P[BASE + 6], P[BASE + 7]);                              \
    auto r0 = __builtin_amdgcn_permlane32_swap(a0, b0, false, false); auto r1 = __builtin_amdgcn_permlane32_swap(a1, b1, false, false); \
    u32x4 w = {r0[0], r1[0], r0[1], r1[1]}; OUT = *reinterpret_cast<bf16x8*>(&w); } while (0)
    PK4(p0, 0, pa0); PK4(p0, 8, pa1); PK4(p1, 0, pa2); PK4(p1, 8, pa3);
#undef PK4
}
DEVI void qkt(f32x16& p0, f32x16& p1, const char* Ks, const bf16x8* qr, int r32, int hi) {
    p0 = f32x16{}; p1 = f32x16{};
#pragma unroll
    for (int d0 = 0; d0 < 6; ++d0) { const int cb = (d0 * 16 + hi * 8) * 2;
        const bf16x8 b0 = *reinterpret_cast<const bf16x8*>(Ks + KSWZ(r32, cb));
        const bf16x8 b1 = *reinterpret_cast<const bf16x8*>(Ks + KSWZ(32 + r32, cb));
        p0 = __builtin_amdgcn_mfma_f32_32x32x16_bf16(b0, qr[d0], p0, 0, 0, 0);
        p1 = __builtin_amdgcn_mfma_f32_32x32x16_bf16(b1, qr[d0], p1, 0, 0, 0); }
}
DEVI int v_st(int k, int c) { const int kk = (k & ~0xC) | ((k & 4) << 1) | ((k & 8) >> 1); return ((kk >> 3) * 4 + (c >> 5)) * 512 + ((kk & 7) * 32 + (c & 31)) * 2; }
DEVI int v_rd_base(int lane) { return ((lane & 3) << 3) | (((lane >> 2) & 3) << 6) | (((lane >> 4) & 1) << 5) | (((lane >> 5) & 1) << 8); }
constexpr int v_rd_off(int d0, int ks, int half) { return d0 * 512 + ks * 4096 + half * 2048; }
template <int OFF> DEVI s16x4 tr_read(int vb) {
    s16x4 r; asm volatile("ds_read_b64_tr_b16 %0, %1 offset:%2" : "=&v"(r) : "v"(vb), "i"(OFF) : "memory"); return r;
}
template <int D0> DEVI void pv_one(f32x16& od, int vb, bf16x8 pa0, bf16x8 pa1, bf16x8 pa2, bf16x8 pa3) {
    const s16x4 l0 = tr_read<v_rd_off(D0, 0, 0)>(vb), h0 = tr_read<v_rd_off(D0, 0, 1)>(vb), l1 = tr_read<v_rd_off(D0, 1, 0)>(vb), h1 = tr_read<v_rd_off(D0, 1, 1)>(vb);
    const s16x4 l2 = tr_read<v_rd_off(D0, 2, 0)>(vb), h2 = tr_read<v_rd_off(D0, 2, 1)>(vb), l3 = tr_read<v_rd_off(D0, 3, 0)>(vb), h3 = tr_read<v_rd_off(D0, 3, 1)>(vb);
    asm volatile("s_waitcnt lgkmcnt(0)" ::: "memory"); SBAR();
#define PKV(L, H) (bf16x8){L[0], L[1], L[2], L[3], H[0], H[1], H[2], H[3]}
    od = __builtin_amdgcn_mfma_f32_32x32x16_bf16(pa0, PKV(l0, h0), od, 0, 0, 0);
    od = __builtin_amdgcn_mfma_f32_32x32x16_bf16(pa1, PKV(l1, h1), od, 0, 0, 0);
    od = __builtin_amdgcn_mfma_f32_32x32x16_bf16(pa2, PKV(l2, h2), od, 0, 0, 0);
    od = __builtin_amdgcn_mfma_f32_32x32x16_bf16(pa3, PKV(l3, h3), od, 0, 0, 0);
#undef PKV
}
DEVI void pv_d0(f32x16* o, int vb, bf16x8 pa0, bf16x8 pa1, bf16x8 pa2, bf16x8 pa3) {
    pv_one<0>(o[0], vb, pa0, pa1, pa2, pa3); pv_one<1>(o[1], vb, pa0, pa1, pa2, pa3);
}
DEVI void attn_unit(const bf16_t* __restrict__ Qb, const bf16_t* __restrict__ Kh, const bf16_t* __restrict__ Vh, int seq, bf16_t* __restrict__ Ob, int ldo, char* lds) {
    const int tid = tid_(), wid = tid >> 6, lane = tid & 63, r32 = lane & 31, hi = lane >> 5;
    char* V_lds = lds; char* K_lds = lds + 2 * SHM_V;
    float* wsl = (float*)(lds + 2 * SHM_V + 2 * SHM_K) + wid * 64; float* li_l = wsl; float* al_l = wsl + 32;
    float m_reg = -1e30f, l_reg = 0.f; f32x16 o[2] = {}; bf16x8 qr[6];
    const bf16_t* Qw = Qb + (size_t)(wid * 32 + r32) * 96 + hi * 8;
#pragma unroll
    for (int d0 = 0; d0 < 6; ++d0) qr[d0] = *reinterpret_cast<const bf16x8*>(Qw + d0 * 16);
    const int sr = tid >> 4, kc = tid & 15, kcl = (kc < 12 ? kc : 11) * 8;
    const int vr = tid >> 3, vc = (tid & 7) * 8, vst0 = v_st(vr, vc);
    const int kst0 = KSWZ(sr, kc * 16), kst1 = KSWZ(32 + sr, kc * 16);
    const int vb0 = (int)(uintptr_t)V_lds + v_rd_base(lane);
    bf16x8 sv0, sk00, sk01, sv1, sk10, sk11;
#define SLOAD0(k0) do { sv0 = *reinterpret_cast<const bf16x8*>(Vh + (size_t)((k0) + vr) * 64 + vc); sk00 = *reinterpret_cast<const bf16x8*>(Kh + (size_t)((k0) + sr) * 96 + kcl); \
    sk01 = *reinterpret_cast<const bf16x8*>(Kh + (size_t)((k0) + 32 + sr) * 96 + kcl); } while (0)
#define SLOAD1(k0) do { sv1 = *reinterpret_cast<const bf16x8*>(Vh + (size_t)((k0) + vr) * 64 + vc); sk10 = *reinterpret_cast<const bf16x8*>(Kh + (size_t)((k0) + sr) * 96 + kcl); \
    sk11 = *reinterpret_cast<const bf16x8*>(Kh + (size_t)((k0) + 32 + sr) * 96 + kcl); } while (0)
#define SWRITE0(b) do { *(bf16x8*)(V_lds + (b) * SHM_V + vst0) = sv0; *(bf16x8*)(K_lds + (b) * SHM_K + kst0) = sk00; *(bf16x8*)(K_lds + (b) * SHM_K + kst1) = sk01; } while (0)
#define SWRITE1(b) do { *(bf16x8*)(V_lds + (b) * SHM_V + vst0) = sv1; *(bf16x8*)(K_lds + (b) * SHM_K + kst0) = sk10; *(bf16x8*)(K_lds + (b) * SHM_K + kst1) = sk11; } while (0)
#define SWAIT() asm volatile("s_waitcnt vmcnt(3)" ::: "memory")
#define RESC(a) do { if (__any((a) < 1.f)) { if (hi == 0) al_l[r32] = (a); asm volatile("s_waitcnt lgkmcnt(0)" ::: "memory"); \
    _Pragma("unroll") for (int d = 0; d < 2; ++d) _Pragma("unroll") for (int r = 0; r < 16; ++r) o[d][r] *= al_l[crow(r, hi)]; } } while (0)
    f32x16 pA0, pA1, pB0, pB1; float mnA, mnB, alA, alB; bf16x8 pa0, pa1, pa2, pa3; const int NT = seq / KVBLK;
    SLOAD0(0); asm volatile("s_waitcnt vmcnt(0)" ::: "memory"); SWRITE0(0); __syncthreads();
    qkt(pA0, pA1, K_lds, qr, r32, hi); partialSM(pA0, pA1, m_reg, mnA, alA);
    SLOAD1(KVBLK); if (2 < NT) SLOAD0(2 * KVBLK);
    SWAIT(); SWRITE1(1); __syncthreads();
    for (int j = 1; j + 1 < NT; j += 2) {
        SBAR(); qkt(pB0, pB1, K_lds + SHM_K, qr, r32, hi);
        finishSM(pA0, pA1, alA, l_reg, pa0, pa1, pa2, pa3); SBAR();
        SLOAD1((j + 2) * KVBLK); SBAR();
        pv_d0(o, vb0, pa0, pa1, pa2, pa3); partialSM(pB0, pB1, m_reg, mnB, alB);
        __syncthreads(); SWAIT(); SWRITE0(0);
        RESC(alB); __syncthreads();
        SBAR(); qkt(pA0, pA1, K_lds, qr, r32, hi);
        finishSM(pB0, pB1, alB, l_reg, pa0, pa1, pa2, pa3); SBAR();
        if (j + 3 < NT) SLOAD0((j + 3) * KVBLK); SBAR();
        pv_d0(o, vb0 + SHM_V, pa0, pa1, pa2, pa3); partialSM(pA0, pA1, m_reg, mnA, alA);
        __syncthreads(); SWAIT(); SWRITE1(1);
        RESC(alA); __syncthreads();
    }
    SBAR(); qkt(pB0, pB1, K_lds + SHM_K, qr, r32, hi);
    finishSM(pA0, pA1, alA, l_reg, pa0, pa1, pa2, pa3); SBAR();
    pv_d0(o, vb0, pa0, pa1, pa2, pa3); partialSM(pB0, pB1, m_reg, mnB, alB);
    __syncthreads(); RESC(alB);
    finishSM(pB0, pB1, alB, l_reg, pa0, pa1, pa2, pa3); SBAR();
    pv_d0(o, vb0 + SHM_V, pa0, pa1, pa2, pa3);
    if (hi == 0) li_l[r32] = l_reg; asm volatile("s_waitcnt lgkmcnt(0)" ::: "memory");
    float rli[16];
#pragma unroll
    for (int r = 0; r < 16; ++r) rli[r] = __builtin_amdgcn_rcpf(li_l[crow(r, hi)]);
    bf16_t* Ow = Ob + (size_t)(wid * 32) * ldo;
#pragma unroll
    for (int r = 0; r < 16; ++r) { const int orow = crow(r, hi);
#pragma unroll
        for (int d0 = 0; d0 < 2; ++d0) Ow[(size_t)orow * ldo + d0 * 32 + r32] = f2bf(o[d0][r] * rli[r]); }
    __syncthreads();
#undef SLOAD0
#undef SLOAD1
#undef SWRITE0
#undef SWRITE1
#undef SWAIT
#undef RESC
}
#undef KSWZ
#undef SBAR
}

template <class ARow, class BMap, class Epi>
DEVI void gemm_tile(int K, ARow arow, const float* __restrict__ B, int ldb, BMap bmap, Epi epi, float* smem) {
    float (*As)[132] = (float (*)[132])smem;
    float (*Bs)[64] = (float (*)[64])(smem + 16 * 132);
    const int tid = tid_(), ty = tid >> 4, tx = tid & 15;
    float acc[4][4];
#pragma unroll
    for (int i = 0; i < 4; ++i)
#pragma unroll
        for (int j = 0; j < 4; ++j) acc[i][j] = 0.f;
    const int ar = tid >> 2, akq = tid & 3;
    const float* ap = arow(ar);
    const int bk0 = tid >> 6, bc = tid & 63;
    const int bcol = bmap(bc);
    for (int k0 = 0; k0 < K; k0 += 16) {
        float4 av = make_float4(0.f, 0.f, 0.f, 0.f);
        if (ap) av = *(const float4*)(ap + k0 + akq * 4);
        float b0 = 0.f, b1 = 0.f;
        if (bcol >= 0) { b0 = B[(size_t)(k0 + bk0) * ldb + bcol]; b1 = B[(size_t)(k0 + bk0 + 8) * ldb + bcol]; }
        __syncthreads();
        As[akq * 4 + 0][ar] = av.x; As[akq * 4 + 1][ar] = av.y; As[akq * 4 + 2][ar] = av.z; As[akq * 4 + 3][ar] = av.w;
        Bs[bk0][bc] = b0; Bs[bk0 + 8][bc] = b1;
        __syncthreads();
#pragma unroll
        for (int kk = 0; kk < 16; ++kk) {
            const float4 a = *(const float4*)&As[kk][ty * 4];
            const float4 b = *(const float4*)&Bs[kk][tx * 4];
            const float aa[4] = {a.x, a.y, a.z, a.w}, bb[4] = {b.x, b.y, b.z, b.w};
#pragma unroll
            for (int i = 0; i < 4; ++i)
#pragma unroll
                for (int j = 0; j < 4; ++j) acc[i][j] = fmaf(aa[i], bb[j], acc[i][j]);
        }
    }
#pragma unroll
    for (int i = 0; i < 4; ++i) epi(ty * 4 + i, tx, acc[i]);
    __syncthreads();
}

__device__ void phase_init(const Params& p) {
    const int tid = tid_(), bid = bid_(); (void)tid; (void)bid;
    float* ws = p.ws;
    const size_t n4 = (size_t)T * D / 4;
    for (size_t i = (size_t)bid * NTHR + tid; i < n4; i += (size_t)gridDim.x * NTHR) {
        const size_t e = i * 4;
        float4 v = (e < (size_t)NLAT * D) ? *(const float4*)(p.in[I_X] + e) : *(const float4*)(p.in[I_CTX] + (e - (size_t)NLAT * D));
        *(float4*)(ws + W_X + e) = v;
    }
    for (int i = bid * NTHR + tid; i < NLAYER * 4 * 128 * 128; i += gridDim.x * NTHR) ((bf16_t*)(ws + W_WSB))[i] = f2bf(p.in[I_SGWS][i]);
    if (bid == 0 && tid < 64) ((int*)(ws + W_CNT))[tid] = 0;
}

__device__ void phase_mod(const Params& p, float* smem) {
    const int tid = tid_(), bid = bid_(); (void)tid; (void)bid;
    const int wave = tid >> 6, lane = tid & 63;
    for (int it = bid; it < NLAYER * 96; it += gridDim.x) {
        const int l = it / 96, j = (it % 96) * 64 + lane;
        const float* W = p.in[I_WMOD] + (size_t)l * 1024 * 6144;
        float a0 = 0.f, a1 = 0.f;
        for (int k = wave * 128; k < wave * 128 + 128; ++k) {
            const float w = W[(size_t)k * 6144 + j];
            a0 = fmaf(silu(p.in[I_C][k]), w, a0);
            a1 = fmaf(silu(p.in[I_CCTX][k]), w, a1);
        }
        smem[(wave * 2 + 0) * 64 + lane] = a0; smem[(wave * 2 + 1) * 64 + lane] = a1;
        __syncthreads();
        if (wave < 2) {
            float s = 0.f;
            for (int w = 0; w < 8; ++w) s += smem[(w * 2 + wave) * 64 + lane];
            p.ws[W_MOD + (size_t)(l * 2 + wave) * 6144 + j] = s + p.in[I_BMOD][l * 6144 + j];
        }
        __syncthreads();
    }
}

__device__ void phase_norm(const Params& p, int l, int which) {
    const int tid = tid_(), bid = bid_(); (void)tid; (void)bid;
    const int lane = tid & 63, gw = bid * (NTHR / 64) + (tid >> 6), nw = gridDim.x * (NTHR / 64);
    const float* g = p.in[which ? I_NFFN : I_NMIX] + l * D;
    for (int t = gw; t < T; t += nw) {
        const float* x = p.ws + W_X + (size_t)t * D;
        const float* mod = p.ws + W_MOD + (size_t)(l * 2 + (t >= NLAT ? 1 : 0)) * 6144;
        const float* sh = mod + (which ? 3 : 0) * D; const float* sc = mod + (which ? 4 : 1) * D;
        float4 v[4]; float ss = 0.f;
#pragma unroll
        for (int j = 0; j < 4; ++j) { v[j] = *(const float4*)(x + j * 256 + lane * 4); ss += v[j].x * v[j].x + v[j].y * v[j].y + v[j].z * v[j].z + v[j].w * v[j].w; }
        ss = wave_sum(ss);
        const float rstd = rsqrtf(ss * (1.f / D) + EPS);
        float* h = p.ws + W_H + (size_t)t * D;
#pragma unroll
        for (int j = 0; j < 4; ++j) {
            const int c = j * 256 + lane * 4;
            const float4 gg = *(const float4*)(g + c), s1 = *(const float4*)(sc + c), s0 = *(const float4*)(sh + c);
            float4 o;
            o.x = v[j].x * rstd * gg.x * (1.f + s1.x) + s0.x; o.y = v[j].y * rstd * gg.y * (1.f + s1.y) + s0.y;
            o.z = v[j].z * rstd * gg.z * (1.f + s1.z) + s0.z; o.w = v[j].w * rstd * gg.w * (1.f + s1.w) + s0.w;
            *(float4*)(h + c) = o;
            { u32x2 w; w.x = cvt_pk_bf16(o.x, o.y); w.y = cvt_pk_bf16(o.z, o.w); *(u32x2*)((bf16_t*)(p.ws + W_HB) + (size_t)t * D + c) = w; }
        }
    }
}

__device__ void phase_inproj(const Params& p, int l, char* lds) {
    const int tid = tid_(), bid = bid_(); (void)tid;
    const float* Wm = p.in[I_WIN] + (size_t)l * D * INC;
    constexpr int ntn = (INC + 127) / 128, ntm = T / 256;
    const bf16_t* HB = (const bf16_t*)(p.ws + W_HB); float* P = p.ws + W_P;
    for (int tile = bid; tile < ntm * ntn; tile += gridDim.x) {
        const int tm = tile / ntn, tn = tile % ntn, m0 = tm * 256, n0 = tn * 128;
        gemm_unit<false>(lds, D, [&](int r) { return HB + (size_t)(m0 + r) * D; }, Wm + n0, Wm + n0, INC, INC - n0,
                  [&](const f32x4 (&acc)[4][4], int wr, int wc, int fr, int fq) {
#pragma unroll
                      for (int m = 0; m < 4; ++m) { float* row = P + (size_t)(m0 + wr * 64 + m * 16 + fr) * INC;
#pragma unroll
                          for (int n = 0; n < 4; ++n) { const int col = n0 + wc * 64 + n * 16 + 4 * fq; if (col < INC) *(f32x4*)(row + col) = acc[m][n]; } }
                  });
    }
}

__device__ void phase_prep1(const Params& p, int l) {
    const int tid = tid_(), bid = bid_(); (void)tid; (void)bid;
    const int lane = tid & 63, gw = bid * (NTHR / 64) + (tid >> 6), nw = gridDim.x * (NTHR / 64);
    float* ws = p.ws;
    for (int t = gw; t < T; t += nw) {
        const int s0 = (t < NLAT) ? 0 : NLAT, sl = (t < NLAT) ? NLAT : NCTX, n = t - s0;
        const float* P = ws + W_P; const float* pr = P + (size_t)t * INC;
        {
            const int g = lane >> 4, w = 2 << g;
            const int lo = max(n - w / 2, 0), hi = min(n + w / 2, sl);
            float4 s = make_float4(0.f, 0.f, 0.f, 0.f);
            for (int m = lo; m < hi; ++m) { const float4 v = *(const float4*)(P + (size_t)(s0 + m) * INC + OFF_A + lane * 4); s.x += v.x; s.y += v.y; s.z += v.z; s.w += v.w; }
            const float inv = 1.f / (float)(hi - lo);
            const float4 x = *(const float4*)(pr + OFF_A + lane * 4);
            float4 d; d.x = s.x * inv - x.x; d.y = s.y * inv - x.y; d.z = s.z * inv - x.z; d.w = s.w * inv - x.w;
            { u32x2 w; w.x = cvt_pk_bf16(d.x, d.y); w.y = cvt_pk_bf16(d.z, d.w); *(u32x2*)((bf16_t*)(ws + W_DIFF) + (size_t)t * 256 + lane * 4) = w; }
        }
        {
            float v[3]; float ss = 0.f;
#pragma unroll
            for (int j = 0; j < 3; ++j) { v[j] = pr[OFF_Q + j * 64 + lane]; ss += v[j] * v[j]; }
            ss = wave_sum(ss); const float rstd = rsqrtf(ss * (1.f / 192.f) + EPS);
#pragma unroll
            for (int j = 0; j < 3; ++j) ((bf16_t*)(ws + W_QN))[(size_t)t * 192 + j * 64 + lane] = f2bf(v[j] * rstd * p.in[I_QAN][l * 192 + j * 64 + lane]);
        }
        {
            float v[2]; float ss = 0.f;
#pragma unroll
            for (int j = 0; j < 2; ++j) { v[j] = pr[OFF_KV + j * 64 + lane]; ss += v[j] * v[j]; }
            ss = wave_sum(ss); const float rstd = rsqrtf(ss * (1.f / 128.f) + EPS);
#pragma unroll
            for (int j = 0; j < 2; ++j) ((bf16_t*)(ws + W_KVN))[(size_t)t * 128 + j * 64 + lane] = f2bf(v[j] * rstd * p.in[I_KVAN][l * 128 + j * 64 + lane]);
        }
        {
            const float4 zu = *(const float4*)(pr + OFF_C + lane * 4), zv = *(const float4*)(pr + OFF_C + 256 + lane * 4);
            float4 u; u.x = gelu_tanh(zu.x); u.y = gelu_tanh(zu.y); u.z = gelu_tanh(zu.z); u.w = gelu_tanh(zu.w);
            *(float4*)(ws + W_U + (size_t)t * 256 + lane * 4) = u;
            float gv[4] = {gelu_tanh(zv.x), gelu_tanh(zv.y), gelu_tanh(zv.z), gelu_tanh(zv.w)};
            const float mu = wave_sum(gv[0] + gv[1] + gv[2] + gv[3]) * (1.f / 256.f);
            float q = 0.f;
#pragma unroll
            for (int j = 0; j < 4; ++j) { gv[j] -= mu; q += gv[j] * gv[j]; }
            const float rstd = rsqrtf(wave_sum(q) * (1.f / 256.f) + EPS);
#pragma unroll
            for (int j = 0; j < 4; ++j) ws[W_VN + (size_t)t * 256 + lane * 4 + j] = gv[j] * rstd * p.in[I_SGG][l * 256 + lane * 4 + j] + p.in[I_SGB][l * 256 + lane * 4 + j];
        }
        {
            const float* cw = p.in[I_CONVW] + (size_t)l * 4 * 256;
            float4 o = *(const float4*)(p.in[I_CONVB] + l * 256 + lane * 4);
#pragma unroll
            for (int k = 0; k < 4; ++k) {
                const int m = n - 1 + k;
                if (m >= 0 && m < sl) {
                    const float4 xv = *(const float4*)(P + (size_t)(s0 + m) * INC + OFF_DX + lane * 4), wv = *(const float4*)(cw + k * 256 + lane * 4);
                    o.x = fmaf(xv.x, wv.x, o.x); o.y = fmaf(xv.y, wv.y, o.y); o.z = fmaf(xv.z, wv.z, o.z); o.w = fmaf(xv.w, wv.w, o.w);
                }
            }
            *(float4*)(ws + W_XC + (size_t)t * 256 + lane * 4) = o;
            { u32x2 w; w.x = cvt_pk_bf16(o.x, o.y); w.y = cvt_pk_bf16(o.z, o.w); *(u32x2*)((bf16_t*)(ws + W_XCB) + (size_t)t * 256 + lane * 4) = w; }
        }
    }
}

__device__ void phase_small(const Params& p, int l, char* lds) {
    const int tid = tid_(), bid = bid_(); (void)tid;
    float* ws = p.ws;
    constexpr int NK = 19, NU1 = (T / 256) * NK, NU2 = NCHUNK * 2;
    bf16_t* Y = (bf16_t*)(ws + W_YC);
    for (int u = bid; u < NU1 + NU2; u += gridDim.x) {
        if (u < NU1) {
            const int tm = u / NK, kind = u % NK, m0 = tm * 256;
            if (kind < 11) {
                const bf16_t* A; int lda, K, ldb, nval; const float* B;
                if (kind < 4) { A = (const bf16_t*)(ws + W_DIFF) + kind * 64; lda = 256; K = 64; B = p.in[I_POOLW] + (size_t)(l * 4 + kind) * 64 * 64; ldb = 64; nval = 64; }
                else if (kind < 7) { A = (const bf16_t*)(ws + W_QN); lda = 192; K = 192; B = p.in[I_WUQ] + (size_t)l * 192 * 384 + (kind - 4) * 128; ldb = 384; nval = 128; }
                else { A = (const bf16_t*)(ws + W_KVN); lda = 128; K = 128; B = p.in[I_WUKV] + (size_t)l * 128 * 512 + (kind - 7) * 128; ldb = 512; nval = 128; }
                gemm_unit<false>(lds, K, [&](int r) { return A + (size_t)(m0 + r) * lda; }, B, B, ldb, nval,
                    [&](const f32x4 (&acc)[4][4], int wr, int wc, int fr, int fq) {
#pragma unroll
                        for (int m = 0; m < 4; ++m) { const int t = m0 + wr * 64 + m * 16 + fr;
#pragma unroll
                            for (int n = 0; n < 4; ++n) { const int c = wc * 64 + n * 16 + 4 * fq;
                                if (kind < 4) { if (wc == 0) { const f32x4 sc = *(const f32x4*)(p.in[I_POOLS] + l * 256 + kind * 64 + c); const f32x4 v = acc[m][n] * sc;
                                        u32x2 w; w.x = cvt_pk_bf16(v[0], v[1]); w.y = cvt_pk_bf16(v[2], v[3]); *(u32x2*)(Y + (size_t)t * D + kind * 64 + c) = w; } }
                                else if (kind < 7) *(f32x4*)(ws + W_QUP + (size_t)t * 384 + (kind - 4) * 128 + c) = acc[m][n];
                                else *(f32x4*)(ws + W_KVUP + (size_t)t * 512 + (kind - 7) * 128 + c) = acc[m][n]; } }
                    });
            } else {
                const int d = (kind - 11) >> 2, h = (kind - 11) & 3;
                const bf16_t* A = (const bf16_t*)(ws + W_XCB) + h * 64;
                const float* Ba = p.in[I_WA] + (size_t)((l * 2 + d) * 4 + h) * 64 * 64; const float* Bx = p.in[I_WX] + (size_t)((l * 2 + d) * 4 + h) * 64 * 64;
                const int pb = (l * 2 + d) * 256 + h * 64;
                gemm_unit<true>(lds, 64, [&](int r) { return A + (size_t)(m0 + r) * 256; }, Ba, Bx, 64, 64,
                    [&](const f32x4 (&acc)[4][4], int wr, int wc, int fr, int fq) {
#pragma unroll
                        for (int m = 0; m < 4; ++m) { const int t = m0 + wr * 64 + m * 16 + fr;
#pragma unroll
                            for (int pp = 0; pp < 2; ++pp) { const int idx = (wc * 2 + pp) * 16 + 4 * fq;
                                const f32x4 ba = *(const f32x4*)(p.in[I_BA] + pb + idx), bx = *(const f32x4*)(p.in[I_BX] + pb + idx), lam = *(const f32x4*)(p.in[I_LAM] + pb + idx);
                                const f32x4 xv = *(const f32x4*)(ws + W_XC + (size_t)t * 256 + h * 64 + idx);
                                f32x4 av, dv;
#pragma unroll
                                for (int j = 0; j < 4; ++j) { const float r = sigm(acc[m][2 * pp][j] + ba[j]), ig = sigm(acc[m][2 * pp + 1][j] + bx[j]);
                                    const float loga = -8.f * r * log1pf(expf(-lam[j]));
                                    av[j] = expf(loga); dv[j] = sqrtf(-expm1f(2.f * loga)) * (ig * xv[j]); }
                                *(f32x4*)(ws + W_LA + ((size_t)d * T + t) * 256 + h * 64 + idx) = av;
                                *(f32x4*)(ws + W_LB + ((size_t)d * T + t) * 256 + h * 64 + idx) = dv; } }
                    });
            }
        } else {
            const int v = u - NU1, c = v >> 1, hp = v & 1;
            const bf16_t* A = (const bf16_t*)(ws + W_WSB) + ((size_t)l * 512 + hp * 256) * 128;
            const float* B = ws + W_VN + (size_t)c * 128 * 256 + hp * 128;
            gemm_unit<false>(lds, 128, [&](int r) { return A + (size_t)r * 128; }, B, B, 256, 128,
                [&](const f32x4 (&acc)[4][4], int wr, int wc, int fr, int fq) {
                    if ((wr >> 1) == wc) {
                        const int h = hp * 2 + wc;
#pragma unroll
                        for (int m = 0; m < 4; ++m) { const int pp = (wr & 1) * 64 + m * 16 + fr, t = c * 128 + pp; const float bs = p.in[I_SGBS][(l * 4 + h) * 128 + pp];
#pragma unroll
                            for (int n = 0; n < 4; ++n) { const int ch = h * 64 + n * 16 + 4 * fq; const f32x4 uu = *(const f32x4*)(ws + W_U + (size_t)t * 256 + ch);
                                const f32x4 o = uu * (acc[m][n] + bs);
                                u32x2 w; w.x = cvt_pk_bf16(o[0], o[1]); w.y = cvt_pk_bf16(o[2], o[3]); *(u32x2*)(Y + (size_t)t * D + 512 + ch) = w; } }
                    }
                });
        }
    }
}

__device__ void phase_prep2(const Params& p, int l) {
    const int tid = tid_(), bid = bid_(); (void)tid; (void)bid;
    float* ws = p.ws;
    const int lane = tid & 63, gw = bid * (NTHR / 64) + (tid >> 6), nw = gridDim.x * (NTHR / 64);
    for (int it = gw; it < T * 4; it += nw) {
        const int t = it >> 2, h = it & 3;
        const bool lat = t < NLAT;
        float cs = 1.f, sn = 0.f;
        if (lat && lane < 32) {
            const int f = lane & 15; const float pos = (f < 8) ? (float)(t >> 6) : (float)(t & 63);
            const float inv = powf(10000.f, -(float)(f & 7) / 8.f);
            const float ang = pos * inv; cs = cosf(ang); sn = sinf(ang);
        }
        {
            float v0 = ws[W_QUP + (size_t)t * 384 + h * 96 + lane], v1 = (lane < 32) ? ws[W_QUP + (size_t)t * 384 + h * 96 + 64 + lane] : 0.f;
            const float rstd = rsqrtf(wave_sum(v0 * v0 + v1 * v1) * (1.f / 96.f) + EPS);
            v0 *= rstd * p.in[I_QN][l * 96 + lane]; v1 *= (lane < 32) ? rstd * p.in[I_QN][l * 96 + 64 + lane] : 0.f;
            const float pv = __shfl_xor(v1, 16);
            const float r1 = (lane < 16) ? v1 * cs - pv * sn : pv * sn + v1 * cs;
            bf16_t* qo = (bf16_t*)(ws + W_Q) + ((size_t)h * T + t) * 96;
            qo[lane] = f2bf(v0);
            if (lane < 32) qo[64 + lane] = f2bf(lat ? r1 : v1);
        }
        {
            float v0 = ws[W_KVUP + (size_t)t * 512 + h * 128 + lane], v1 = (lane < 32) ? ws[W_P + (size_t)t * INC + OFF_KR + lane] : 0.f;
            const float rstd = rsqrtf(wave_sum(v0 * v0 + v1 * v1) * (1.f / 96.f) + EPS);
            v0 *= rstd * p.in[I_KN][l * 96 + lane]; v1 *= (lane < 32) ? rstd * p.in[I_KN][l * 96 + 64 + lane] : 0.f;
            const float pv = __shfl_xor(v1, 16);
            const float r1 = (lane < 16) ? v1 * cs - pv * sn : pv * sn + v1 * cs;
            bf16_t* ko = (bf16_t*)(ws + W_K) + ((size_t)h * T + t) * 96;
            ko[lane] = f2bf(v0);
            if (lane < 32) ko[64 + lane] = f2bf(lat ? r1 : v1);
            ((bf16_t*)(ws + W_V))[((size_t)h * T + t) * 64 + lane] = f2bf(ws[W_KVUP + (size_t)t * 512 + h * 128 + 64 + lane]);
        }
    }
    for (int i = bid * NTHR + tid; i < NCHUNK * 512; i += gridDim.x * NTHR) {
        const int c = i >> 9, d = (i >> 8) & 1, ch = i & 255;
        float* A = ws + W_LA + ((size_t)d * T + (size_t)c * 128) * 256 + ch;
        float* B = ws + W_LB + ((size_t)d * T + (size_t)c * 128) * 256 + ch;
        float h = 0.f, ap = 1.f;
        for (int s = 0; s < 128; ++s) {
            const int q = d ? 127 - s : s;
            const float a = A[(size_t)q * 256], b = B[(size_t)q * 256];
            h = fmaf(a, h, b); ap *= a;
            A[(size_t)q * 256] = ap; B[(size_t)q * 256] = h;
        }
        ws[W_AGG + ((size_t)(c * 2 + d) * 2 + 0) * 256 + ch] = ap;
        ws[W_AGG + ((size_t)(c * 2 + d) * 2 + 1) * 256 + ch] = h;
    }
}


__device__ void phase_attn(const Params& p, int l, char* lds) {
    const int tid = tid_(), bid = bid_(); (void)tid;
    const bf16_t* Qb = (const bf16_t*)(p.ws + W_Q); const bf16_t* Kb = (const bf16_t*)(p.ws + W_K); const bf16_t* Vb = (const bf16_t*)(p.ws + W_V);
    bf16_t* Y = (bf16_t*)(p.ws + W_YC);
    const int nunits = (l == 0) ? 260 : 256;
    for (int u = bid; u < nunits; u += gridDim.x) {
        int h, t0, k0, seq;
        if (u < 256) { h = (u & 7) >> 1; t0 = (((u >> 3) << 1) | (u & 1)) * 256; k0 = 0; seq = T; }
        else { h = u - 256; t0 = NLAT; k0 = NLAT; seq = NCTX; }
        att::attn_unit(Qb + ((size_t)h * T + t0) * 96, Kb + ((size_t)h * T + k0) * 96, Vb + ((size_t)h * T + k0) * 64, seq, Y + (size_t)t0 * D + 256 + h * 64, D, lds);
    }
}

__device__ void phase_lru_fin(const Params& p, char* lds) {
    const int tid = tid_(), bid = bid_();
    float* ws = p.ws;
    float* carry = (float*)lds;
    for (int c = bid; c < NCHUNK; c += gridDim.x) {
        {
            const int d = tid >> 8, ch = tid & 255;
            const int npre = d ? (NCHUNK - 1 - c) : ((c + 2) % NCHUNK);
            float s = 0.f;
            for (int k = 0; k < npre; ++k) {
                const int q = d ? (NCHUNK - 1 - k) : ((k + 128) % NCHUNK);
                const float a = ws[W_AGG + ((size_t)(q * 2 + d) * 2 + 0) * 256 + ch], hh = ws[W_AGG + ((size_t)(q * 2 + d) * 2 + 1) * 256 + ch];
                s = fmaf(a, s, hh);
            }
            carry[tid] = s;
        }
        __syncthreads();
        for (int i = tid; i < 128 * 64; i += NTHR) {
            const int t = c * 128 + (i >> 6), ch = (i & 63) * 4;
            f32x4 hs = *(const f32x4*)(ws + W_LB + (size_t)t * 256 + ch) + *(const f32x4*)(ws + W_LA + (size_t)t * 256 + ch) * *(const f32x4*)(carry + ch);
            hs = hs + *(const f32x4*)(ws + W_LB + ((size_t)T + t) * 256 + ch) + *(const f32x4*)(ws + W_LA + ((size_t)T + t) * 256 + ch) * *(const f32x4*)(carry + 256 + ch);
            const f32x4 g = *(const f32x4*)(ws + W_P + (size_t)t * INC + OFF_DG + ch);
            u32x2 w; w.x = cvt_pk_bf16(gelu_tanh(g[0]) * hs[0], gelu_tanh(g[1]) * hs[1]); w.y = cvt_pk_bf16(gelu_tanh(g[2]) * hs[2], gelu_tanh(g[3]) * hs[3]);
            *(u32x2*)((bf16_t*)(ws + W_YC) + (size_t)t * D + 768 + ch) = w;
        }
        __syncthreads();
    }
}

__device__ void phase_outproj(const Params& p, int l, char* lds) {
    const int tid = tid_(), bid = bid_(); (void)tid;
    const float* Wm = p.in[I_WOUT] + (size_t)l * D * D;
    constexpr int ntn = D / 128, ntm = T / 256;
    const bf16_t* Y = (const bf16_t*)(p.ws + W_YC); float* X = p.ws + W_X;
    for (int tile = bid; tile < ntm * ntn; tile += gridDim.x) {
        const int tm = tile / ntn, tn = tile % ntn, m0 = tm * 256, n0 = tn * 128;
        const float* g1 = p.ws + W_MOD + (size_t)(l * 2 + (m0 >= NLAT ? 1 : 0)) * 6144 + 2 * D;
        gemm_unit<false>(lds, D, [&](int r) { return Y + (size_t)(m0 + r) * D; }, Wm + n0, Wm + n0, D, 128,
                  [&](const f32x4 (&acc)[4][4], int wr, int wc, int fr, int fq) {
#pragma unroll
                      for (int m = 0; m < 4; ++m) { float* row = X + (size_t)(m0 + wr * 64 + m * 16 + fr) * D;
#pragma unroll
                          for (int n = 0; n < 4; ++n) { const int col = n0 + wc * 64 + n * 16 + 4 * fq; const f32x4 g = *(const f32x4*)(g1 + col); f32x4 x = *(f32x4*)(row + col);
                              x = x + g * acc[m][n]; *(f32x4*)(row + col) = x; } }
                  });
    }
}

__device__ void phase_router(const Params& p, int l) {
    const int tid = tid_(), bid = bid_(); (void)tid; (void)bid;
    float* ws = p.ws;
    const int lane = tid & 63, gw = bid * (NTHR / 64) + (tid >> 6), nw = gridDim.x * (NTHR / 64);
    const float* rw = p.in[I_RW] + (size_t)l * D * NEXP;
    int* cnt = (int*)(ws + W_CNT) + l * NEXP;
    int* list = (int*)(ws + W_LIST);
    const int e = lane & 31, half = lane >> 5;
    for (int t = gw; t < T; t += nw) {
        const float* f = ws + W_H + (size_t)t * D + half * 512;
        const float* w = rw + (size_t)half * 512 * NEXP + e;
        float a = 0.f;
        for (int k = 0; k < 512; ++k) a = fmaf(f[k], w[(size_t)k * NEXP], a);
        a += __shfl_xor(a, 32);
        a += p.in[I_RB][l * NEXP + e];
        float tv[4]; int te[4];
        float cur = a;
#pragma unroll
        for (int k = 0; k < 4; ++k) {
            float bv = cur; int bi = e;
#pragma unroll
            for (int o = 16; o > 0; o >>= 1) {
                const float ov = __shfl_xor(bv, o); const int oi = __shfl_xor(bi, o);
                if (ov > bv || (ov == bv && oi < bi)) { bv = ov; bi = oi; }
            }
            tv[k] = bv; te[k] = bi;
            if (e == bi) cur = -3.0e38f;
        }
        const float mx = tv[0];
        float ex[4], s = 0.f;
#pragma unroll
        for (int k = 0; k < 4; ++k) { ex[k] = expf(tv[k] - mx); s += ex[k]; }
        if (lane < 4) {
            const int ee = te[lane];
            const int idx = atomicAdd(&cnt[ee], 1);
            list[(size_t)ee * T + idx] = t;
            ((int*)(ws + W_TOPE))[t * 4 + lane] = ee;
            ((int*)(ws + W_TOPI))[t * 4 + lane] = idx;
            ws[W_TOPG + t * 4 + lane] = ex[lane] / s;
        }
    }
}

DEVI void moe_bases(const Params& p, int l, int* sb) {
    const int tid = tid_();
    if (tid == 0) {
        const int* cnt = (const int*)(p.ws + W_CNT) + l * NEXP;
        int b = 0, tb = 0;
        for (int e = 0; e < NEXP; ++e) { sb[e] = b; sb[40 + e] = tb; const int c = cnt[e]; sb[80 + e] = c; const int mt = (c + 255) / 256; b += mt * 256; tb += mt; }
        sb[32] = b; sb[72] = tb;
    }
    __syncthreads();
}

__device__ void phase_moe1(const Params& p, int l, char* lds) {
    const int tid = tid_(), bid = bid_(); (void)tid;
    int* sb = (int*)(lds + G_LDS);
    moe_bases(p, l, sb);
    constexpr int ntn = 16;
    const int nunits = sb[72] * ntn;
    const int* list = (const int*)(p.ws + W_LIST);
    const bf16_t* HB = (const bf16_t*)(p.ws + W_HB); bf16_t* ACT = (bf16_t*)(p.ws + W_ACT);
    for (int u = bid; u < nunits; u += gridDim.x) {
        int e = 0; while (e < NEXP - 1 && sb[40 + e + 1] * ntn <= u) ++e;
        const int mts = sb[40 + e + 1] - sb[40 + e], loc = u - sb[40 + e] * ntn, tn = loc / mts, mt = loc % mts;
        const int mloc = mt * 256, cnt = sb[80 + e], rbase = sb[e] + mloc;
        const float* Wm = p.in[I_WGU] + ((size_t)(l * NEXP + e) * D) * 2048 + tn * 64;
        const float* bias = p.in[I_BGU] + (size_t)(l * NEXP + e) * 2048 + tn * 64;
        const int* le = list + (size_t)e * T + mloc;
        gemm_unit<true>(lds, D, [&](int r) { return (mloc + r < cnt) ? HB + (size_t)le[r] * D : (const bf16_t*)nullptr; }, Wm, Wm + 1024, 2048, 64,
                  [&](const f32x4 (&acc)[4][4], int wr, int wc, int fr, int fq) {
#pragma unroll
                      for (int m = 0; m < 4; ++m) { const int r = wr * 64 + m * 16 + fr;
                          if (mloc + r < cnt) {
#pragma unroll
                              for (int pp = 0; pp < 2; ++pp) { const int idx = (wc * 2 + pp) * 16 + 4 * fq;
                                  const f32x4 bg = *(const f32x4*)(bias + idx), bu = *(const f32x4*)(bias + 1024 + idx);
                                  float a[4];
#pragma unroll
                                  for (int j = 0; j < 4; ++j) { float g = acc[m][2 * pp][j] + bg[j], uu = acc[m][2 * pp + 1][j] + bu[j];
                                      g = fminf(g, 7.f); uu = fminf(fmaxf(uu, -7.f), 7.f); a[j] = (uu + 1.f) * (g * sigm(1.702f * g)); }
                                  u32x2 w; w.x = cvt_pk_bf16(a[0], a[1]); w.y = cvt_pk_bf16(a[2], a[3]);
                                  *(u32x2*)(ACT + (size_t)(rbase + r) * D + tn * 64 + idx) = w; } } }
                  });
    }
    __syncthreads();
}

__device__ void phase_moe2(const Params& p, int l, char* lds) {
    const int tid = tid_(), bid = bid_(); (void)tid;
    int* sb = (int*)(lds + G_LDS);
    moe_bases(p, l, sb);
    constexpr int ntn = D / 128;
    const int nunits = sb[72] * ntn;
    const bf16_t* ACT = (const bf16_t*)(p.ws + W_ACT); bf16_t* YR = (bf16_t*)(p.ws + W_YR);
    for (int u = bid; u < nunits; u += gridDim.x) {
        int e = 0; while (e < NEXP - 1 && sb[40 + e + 1] * ntn <= u) ++e;
        const int mts = sb[40 + e + 1] - sb[40 + e], loc = u - sb[40 + e] * ntn, tn = loc / mts, mt = loc % mts;
        const int mloc = mt * 256, cnt = sb[80 + e], rbase = sb[e] + mloc, n0 = tn * 128;
        const float* Wm = p.in[I_WDN] + ((size_t)(l * NEXP + e) * D) * D + n0;
        const float* bias = p.in[I_BDN] + (size_t)(l * NEXP + e) * D + n0;
        gemm_unit<false>(lds, D, [&](int r) { return (mloc + r < cnt) ? ACT + (size_t)(rbase + r) * D : (const bf16_t*)nullptr; }, Wm, Wm, D, 128,
                  [&](const f32x4 (&acc)[4][4], int wr, int wc, int fr, int fq) {
#pragma unroll
                      for (int m = 0; m < 4; ++m) { const int r = wr * 64 + m * 16 + fr;
                          if (mloc + r < cnt) {
#pragma unroll
                              for (int n = 0; n < 4; ++n) { const int c = wc * 64 + n * 16 + 4 * fq; const f32x4 b = *(const f32x4*)(bias + c); const f32x4 v = acc[m][n] + b;
                                  u32x2 w; w.x = cvt_pk_bf16(v[0], v[1]); w.y = cvt_pk_bf16(v[2], v[3]);
                                  *(u32x2*)(YR + (size_t)(rbase + r) * D + n0 + c) = w; } } }
                  });
    }
    __syncthreads();
}

__device__ void phase_combine(const Params& p, int l, char* lds, bool last) {
    const int tid = tid_(), bid = bid_();
    int* sb = (int*)(lds + G_LDS);
    moe_bases(p, l, sb);
    float* ws = p.ws;
    const bf16_t* YR = (const bf16_t*)(ws + W_YR);
    const int lane = tid & 63, gw = bid * (NTHR / 64) + (tid >> 6), nw = gridDim.x * (NTHR / 64);
    for (int t = gw; t < T; t += nw) {
        const float* g2 = ws + W_MOD + (size_t)(l * 2 + (t >= NLAT ? 1 : 0)) * 6144 + 5 * D;
        const bf16_t* yr[4]; float gt[4];
#pragma unroll
        for (int k = 0; k < 4; ++k) {
            const int e = ((const int*)(ws + W_TOPE))[t * 4 + k], idx = ((const int*)(ws + W_TOPI))[t * 4 + k];
            yr[k] = YR + (size_t)(sb[e] + idx) * D; gt[k] = ws[W_TOPG + t * 4 + k];
        }
        float* x = ws + W_X + (size_t)t * D;
#pragma unroll
        for (int j = 0; j < 4; ++j) {
            const int c = j * 256 + lane * 4;
            float a0 = 0.f, a1 = 0.f, a2 = 0.f, a3 = 0.f;
#pragma unroll
            for (int k = 0; k < 4; ++k) { const u32x2 y = *(const u32x2*)(yr[k] + c);
                a0 = fmaf(gt[k], __uint_as_float(y.x << 16), a0); a1 = fmaf(gt[k], __uint_as_float(y.x & 0xffff0000u), a1);
                a2 = fmaf(gt[k], __uint_as_float(y.y << 16), a2); a3 = fmaf(gt[k], __uint_as_float(y.y & 0xffff0000u), a3); }
            float4 xv = *(const float4*)(x + c); const float4 gg = *(const float4*)(g2 + c);
            xv.x = fmaf(gg.x, a0, xv.x); xv.y = fmaf(gg.y, a1, xv.y); xv.z = fmaf(gg.z, a2, xv.z); xv.w = fmaf(gg.w, a3, xv.w);
            *(float4*)(x + c) = xv;
            if (last && t < NLAT) *(float4*)(p.out + (size_t)t * D + c) = xv;
        }
    }
    __syncthreads();
}

constexpr int LDS_BYTES = G_LDS + 2048;

#define XB_TMO      128
#define XB_XCNT(j)  (256  + 64 * (j))
#define XB_XSUB(j)  (1280 + 64 * (j))
#define XB_XGEN(j)  (2304 + 64 * (j))
#define XB_TOP      3328
#define XB_TOPGEN   3392
#define XCD_BAR_WORDS 3456
#define XB_SPIN_CAP (1u << 18)
#define LAS __attribute__((address_space(3)))
__device__ __forceinline__ unsigned xb_ld(unsigned* p)              { return __hip_atomic_load(p, __ATOMIC_RELAXED, __HIP_MEMORY_SCOPE_AGENT); }
__device__ __forceinline__ unsigned xb_add(unsigned* p, unsigned v) { return __hip_atomic_fetch_add(p, v, __ATOMIC_RELAXED, __HIP_MEMORY_SCOPE_AGENT); }
__device__ __forceinline__ unsigned xb_xcc_id() { return (unsigned)__builtin_amdgcn_s_getreg((3 << 11) | 20) & 0xFu; }
#define XB_SPIN(cond, bar) do { unsigned _sp = 0; while (cond) { __builtin_amdgcn_s_sleep(1); \
    if ((++_sp & 255u) == 0u) { if (xb_ld(&(bar)[XB_TMO])) break; if (_sp > XB_SPIN_CAP) { atomicAdd(&(bar)[XB_TMO], 1u); break; } } } } while (0)
struct XcdBarrier { unsigned* bar; unsigned x; volatile LAS unsigned* st; };
__device__ __forceinline__ XcdBarrier xcd_barrier_post(unsigned* bar, volatile LAS unsigned* st) {
    XcdBarrier b; b.bar = bar; b.x = xb_xcc_id(); b.st = st;
    if (threadIdx.x == 0) (void)xb_add(&bar[XB_XCNT(b.x)], 1u);
    return b;
}
__device__ __forceinline__ void xcd_barrier_complete(unsigned* bar, unsigned x, unsigned& nloc, unsigned& nx) {
    const unsigned G = gridDim.x * gridDim.y * gridDim.z;
    unsigned sum, cnt, mine, sp = 0u;
    for (;;) {
        sum = 0u; cnt = 0u; mine = 0u;
#pragma unroll
        for (unsigned j = 0; j < 16; ++j) { const unsigned c = xb_ld(&bar[XB_XCNT(j)]); sum += c; cnt += (c > 0u) ? 1u : 0u; mine = (j == x) ? c : mine; }
        if (sum == G) break;
        __builtin_amdgcn_s_sleep(1);
        if ((++sp & 255u) == 0u) { if (xb_ld(&bar[XB_TMO])) break; if (sp > XB_SPIN_CAP) { atomicAdd(&bar[XB_TMO], 1u); break; } }
    }
    nloc = mine > 0u ? mine : 1u; nx = cnt > 0u ? cnt : 1u;
}
__device__ __noinline__ void xcd_barrier(const XcdBarrier b) {
    asm volatile("s_waitcnt vmcnt(0)" ::: "memory");
    __syncthreads();
    if (threadIdx.x == 0) {
        unsigned* bar = b.bar;
        __builtin_amdgcn_s_waitcnt(0);
        unsigned nloc = b.st[0], nx = b.st[1];
        if (nloc == 0u) { xcd_barrier_complete(bar, b.x, nloc, nx); b.st[0] = nloc; b.st[1] = nx; }
        const unsigned old = xb_add(&bar[XB_XSUB(b.x)], 1u);
        const unsigned gen = old / nloc;
        if (old + 1u == (gen + 1u) * nloc) {
            __builtin_amdgcn_fence(__ATOMIC_RELEASE, "agent");
            asm volatile("s_waitcnt vmcnt(0)" ::: "memory");
            const unsigned og = xb_add(&bar[XB_TOP], 1u);
            const unsigned tg = og / nx;
            if (og + 1u == (tg + 1u) * nx) xb_add(&bar[XB_TOPGEN], 1u);
            else XB_SPIN(xb_ld(&bar[XB_TOPGEN]) == tg, bar);
            __builtin_amdgcn_fence(__ATOMIC_ACQUIRE, "agent");
            xb_add(&bar[XB_XGEN(b.x)], 1u);
            asm volatile("s_waitcnt vmcnt(0)" ::: "memory");
        } else {
            XB_SPIN(xb_ld(&bar[XB_XGEN(b.x)]) == gen, bar);
            __builtin_amdgcn_fence(__ATOMIC_ACQUIRE, "agent");
            asm volatile("s_waitcnt vmcnt(0)" ::: "memory");
        }
    }
    __syncthreads();
}

constexpr int REP_NORM = 1, REP_INPROJ = 1, REP_PREP1 = 1, REP_SMALL = 1, REP_ATTN = 1, REP_FIN = 1, REP_MOE1 = 1, REP_MOE2 = 1, REP_SYNC = 1;
__global__ void __launch_bounds__(NTHR) fwd_kernel(Params p) {
    cg::grid_group grid = cg::this_grid();
    extern __shared__ __attribute__((aligned(16))) char lds[];
    float* smem = (float*)lds;
    volatile LAS unsigned* xst = (volatile LAS unsigned*)(lds + LDS_BYTES - 16);
    if (threadIdx.x < 4) xst[threadIdx.x] = 0u;
    if (blockIdx.x == 0) for (int i = threadIdx.x; i < 4096; i += NTHR) ((unsigned*)(p.ws + W_BAR))[i] = 0u;
    phase_init(p);
    phase_mod(p, smem);
    grid.sync();
    XcdBarrier xbar = xcd_barrier_post((unsigned*)(p.ws + W_BAR), xst);
#define GSYNC() do { for (int r_ = 0; r_ < REP_SYNC; ++r_) xcd_barrier(xbar); } while (0)
    for (int l = 0; l < NLAYER; ++l) {
        for (int r = 0; r < REP_NORM; ++r) phase_norm(p, l, 0);
        GSYNC();
        for (int r = 0; r < REP_INPROJ; ++r) phase_inproj(p, l, lds);
        GSYNC();
        for (int r = 0; r < REP_PREP1; ++r) phase_prep1(p, l);
        GSYNC();
        for (int r = 0; r < REP_SMALL; ++r) phase_small(p, l, lds);
        GSYNC();
        phase_prep2(p, l);
        GSYNC();
        for (int r = 0; r < REP_ATTN; ++r) phase_attn(p, l, lds);
        GSYNC();
        for (int r = 0; r < REP_FIN; ++r) phase_lru_fin(p, lds);
        GSYNC();
        phase_outproj(p, l, lds);
        GSYNC();
        for (int r = 0; r < REP_NORM; ++r) phase_norm(p, l, 1);
        GSYNC();
        phase_router(p, l);
        GSYNC();
        for (int r = 0; r < REP_MOE1; ++r) phase_moe1(p, l, lds);
        GSYNC();
        for (int r = 0; r < REP_MOE2; ++r) phase_moe2(p, l, lds);
        GSYNC();
        phase_combine(p, l, lds, l == NLAYER - 1);
        GSYNC();
    }
}

extern "C" void kernel_launch(void* const* d_in, const int* in_sizes, int n_in, void* d_out, int out_size, void* d_ws, size_t ws_size, hipStream_t stream) {
    static int grid_blocks = 0;
    if (!grid_blocks) {
        int dev = 0, cus = 0, per_cu = 0;
        (void)hipGetDevice(&dev);
        (void)hipDeviceGetAttribute(&cus, hipDeviceAttributeMultiprocessorCount, dev);
        if (hipFuncSetAttribute((const void*)fwd_kernel, hipFuncAttributeMaxDynamicSharedMemorySize, LDS_BYTES) != hipSuccess) fprintf(stderr, "kernel_launch: hipFuncSetAttribute failed\n");
        if (hipOccupancyMaxActiveBlocksPerMultiprocessor(&per_cu, fwd_kernel, NTHR, LDS_BYTES) != hipSuccess || per_cu < 1) { fprintf(stderr, "kernel_launch: occupancy query says %d\n", per_cu); per_cu = 1; }
        if (per_cu > 1) per_cu = 1;
        grid_blocks = cus * per_cu;
        if (ws_size < W_END * sizeof(float)) fprintf(stderr, "kernel_launch: workspace too small: %zu < %zu\n", ws_size, W_END * sizeof(float));
        if (n_in != N_IN) fprintf(stderr, "kernel_launch: n_in %d != %d\n", n_in, (int)N_IN);
    }
    Params p{};
    for (int i = 0; i < N_IN; ++i) p.in[i] = (const float*)d_in[i];
    p.out = (float*)d_out;
    p.ws = (float*)d_ws;
    void* args[] = {&p};
    hipError_t e = hipLaunchCooperativeKernel((void*)fwd_kernel, dim3(grid_blocks), dim3(NTHR), args, LDS_BYTES, stream);
    if (e != hipSuccess) fprintf(stderr, "cooperative launch failed: %s (grid %d)\n", hipGetErrorString(e), grid_blocks);
}
```

```cpp
#include <hip/hip_runtime.h>
#include <hip/hip_cooperative_groups.h>
#include <cstdio>
#include <cstdint>
namespace cg = cooperative_groups;

#define DEVI __device__ __forceinline__
constexpr int NTHR = 512;
constexpr int D = 1024, NLAT = 16384, NCTX = 256, T = NLAT + NCTX, NLAYER = 2;
constexpr int INC = 1632;
constexpr int OFF_A = 0, OFF_Q = 256, OFF_KV = 448, OFF_KR = 576, OFF_C = 608, OFF_DX = 1120, OFF_DG = 1376;
constexpr int NCHUNK = T / 128;
constexpr int NEXP = 32, TOPK = 4;
constexpr int MAXROWS = T * TOPK + NEXP * 256;
constexpr float EPS = 1e-6f;

enum { I_X = 0, I_C, I_CTX, I_CCTX, I_WMOD, I_BMOD, I_NMIX, I_NFFN, I_WIN, I_WOUT, I_POOLW, I_POOLS, I_QAN, I_WUQ, I_KVAN, I_WUKV,
       I_QN, I_KN, I_SGG, I_SGB, I_SGWS, I_SGBS, I_CONVW, I_CONVB, I_WA, I_BA, I_WX, I_BX, I_LAM, I_RW, I_RB, I_WGU, I_BGU, I_WDN, I_BDN, N_IN };

constexpr size_t al(size_t x) { return (x + 63) / 64 * 64; }
constexpr size_t W_X = 0;
constexpr size_t W_MOD = W_X + al((size_t)T * D);
constexpr size_t W_H = W_MOD + al(2 * 2 * 6144);
constexpr size_t W_P = W_H + al((size_t)T * D);
constexpr size_t W_YC = W_P + al((size_t)T * INC);
constexpr size_t W_Q = W_YC + al((size_t)T * D);
constexpr size_t W_K = W_Q + al((size_t)T * 384);
constexpr size_t W_V = W_K + al((size_t)T * 384);
constexpr size_t W_DIFF = W_V + al((size_t)T * 256);
constexpr size_t W_QN = W_DIFF + al((size_t)T * 256);
constexpr size_t W_KVN = W_QN + al((size_t)T * 192);
constexpr size_t W_U = W_KVN + al((size_t)T * 128);
constexpr size_t W_VN = W_U + al((size_t)T * 256);
constexpr size_t W_XC = W_VN + al((size_t)T * 256);
constexpr size_t W_QUP = W_XC + al((size_t)T * 256);
constexpr size_t W_KVUP = W_QUP + al((size_t)T * 384);
constexpr size_t W_LA = W_KVUP + al((size_t)T * 512);
constexpr size_t W_LB = W_LA + al((size_t)2 * T * 256);
constexpr size_t W_AGG = W_LB + al((size_t)2 * T * 256);
constexpr size_t W_CARRY = W_AGG + al((size_t)NCHUNK * 2 * 2 * 256);
constexpr size_t W_TOPE = W_CARRY + al((size_t)NCHUNK * 2 * 256);
constexpr size_t W_TOPG = W_TOPE + al((size_t)T * 4);
constexpr size_t W_TOPI = W_TOPG + al((size_t)T * 4);
constexpr size_t W_CNT = W_TOPI + al((size_t)T * 4);
constexpr size_t W_LIST = W_CNT + al(64);
constexpr size_t W_ACT = W_LIST + al((size_t)NEXP * T);
constexpr size_t W_YR = W_ACT + al((size_t)MAXROWS * D);
constexpr size_t W_HB = W_YR + al((size_t)MAXROWS * D);
constexpr size_t W_XCB = W_HB + al((size_t)T * D / 2);
constexpr size_t W_WSB = W_XCB + al((size_t)T * 256 / 2);
constexpr size_t W_BAR = W_WSB + al((size_t)NLAYER * 4 * 128 * 128 / 2);
constexpr size_t W_ROPE = W_BAR + al(4096);
constexpr size_t W_END = W_ROPE + al((size_t)NLAT * 32);

struct Params {
    const float* in[N_IN];
    float* out;
    float* ws;
};

DEVI int tid_() { int t = threadIdx.x; asm volatile("" : "+v"(t)); return t; }
DEVI int bid_() { int b = blockIdx.x; asm volatile("" : "+s"(b)); return b; }
DEVI float wave_sum(float v) {
#pragma unroll
    for (int o = 32; o > 0; o >>= 1) v += __shfl_xor(v, o);
    return v;
}
DEVI float gelu_tanh(float x) { const float u = 0.7978845608028654f * (x + 0.044715f * x * x * x); return 0.5f * x * (1.f + tanhf(u)); }
DEVI float sigm(float x) { return 1.f / (1.f + expf(-x)); }
DEVI float silu(float x) { return x * sigm(x); }


typedef unsigned short bf16_t;
typedef short bf16x8 __attribute__((ext_vector_type(8)));
typedef float f32x4 __attribute__((ext_vector_type(4)));
typedef unsigned u32x4 __attribute__((ext_vector_type(4)));
typedef unsigned u32x2 __attribute__((ext_vector_type(2)));
DEVI unsigned cvt_pk_bf16(float lo, float hi) { unsigned r; asm volatile("v_cvt_pk_bf16_f32 %0, %1, %2" : "=v"(r) : "v"(lo), "v"(hi)); return r; }
DEVI bf16_t f2bf(float f) { return (bf16_t)(cvt_pk_bf16(f, 0.f) & 0xffffu); }
DEVI float bf2f(bf16_t b) { return __uint_as_float(((unsigned)b) << 16); }

constexpr int G_STAGE = 49152;
constexpr int G_LDS = 2 * G_STAGE;
DEVI int lds_byte(int r, int c) { const int st = (r >> 4) * 2 + (c >> 5), rr = r & 15, cc = c & 31, ob = rr * 64 + cc * 2; return st * 1024 + (ob ^ (((ob >> 9) & 1) << 5)); }

template <bool PAIRED, class ARow, class Epi>
DEVI void gemm_unit(char* lds, int K, ARow arow, const float* __restrict__ B0, const float* __restrict__ B1, int ldb, int ncol_valid, Epi epi) {
    const int tid = tid_(), wave = tid >> 6, lane = tid & 63, fr = lane & 15, fq = lane >> 4, wr = wave >> 1, wc = wave & 1;
    const int ac = tid & 7;
    const bf16_t* ap[4]; int a_lds[4];
#pragma unroll
    for (int i = 0; i < 4; ++i) { const int r = (tid >> 3) + 64 * i; const bf16_t* q = arow(r); ap[i] = q ? q + ac * 8 : nullptr; a_lds[i] = (r >> 7) * 16384 + lds_byte(r & 127, ac * 8); }
    const int kq = lane & 15, nq = (lane >> 4) + 4 * wave;
    const float* bp; bool bvalid;
    if (PAIRED) { const int seg = (nq >> 2) & 1, idx = (nq >> 3) * 16 + (nq & 3) * 4; bp = (seg ? B1 : B0) + idx; bvalid = idx < ncol_valid; }
    else { bp = B0 + 4 * nq; bvalid = 4 * nq < ncol_valid; }
    bp += (size_t)(4 * kq) * ldb;
    int b_lds[4];
#pragma unroll
    for (int i = 0; i < 4; ++i) b_lds[i] = 32768 + lds_byte(4 * nq + i, 4 * kq);
    const int aoff = (wr >> 1) * 16384 + lds_byte((wr & 1) * 64 + fr, fq * 8), boff = 32768 + lds_byte(wc * 64 + fr, fq * 8);
    u32x4 av[4]; f32x4 bv[4];
#define G_LOAD(t) do { _Pragma("unroll") for (int i = 0; i < 4; ++i) av[i] = ap[i] ? *(const u32x4*)(ap[i] + (t) * 64) : (u32x4){0u, 0u, 0u, 0u}; \
        _Pragma("unroll") for (int kk = 0; kk < 4; ++kk) bv[kk] = bvalid ? *(const f32x4*)(bp + ((size_t)(t) * 64 + kk) * ldb) : (f32x4){0.f, 0.f, 0.f, 0.f}; } while (0)
#define G_WRITE(buf) do { char* s_ = lds + (buf) * G_STAGE; _Pragma("unroll") for (int i = 0; i < 4; ++i) *(u32x4*)(s_ + a_lds[i]) = av[i]; \
        _Pragma("unroll") for (int i = 0; i < 4; ++i) { u32x2 w_; w_.x = cvt_pk_bf16(bv[0][i], bv[1][i]); w_.y = cvt_pk_bf16(bv[2][i], bv[3][i]); *(u32x2*)(s_ + b_lds[i]) = w_; } } while (0)
    f32x4 acc[4][4];
#pragma unroll
    for (int m = 0; m < 4; ++m)
#pragma unroll
        for (int n = 0; n < 4; ++n) acc[m][n] = (f32x4){0.f, 0.f, 0.f, 0.f};
    const int nk = K >> 6;
    G_LOAD(0);
    G_WRITE(0);
    if (nk > 1) G_LOAD(1);
    __syncthreads();
    for (int t = 0; t < nk; ++t) {
        const char* s_ = lds + (t & 1) * G_STAGE;
#pragma unroll
        for (int k = 0; k < 2; ++k) {
            bf16x8 Af[4], Bf[4];
#pragma unroll
            for (int m = 0; m < 4; ++m) Af[m] = *(const bf16x8*)(s_ + aoff + m * 2048 + k * 1024);
#pragma unroll
            for (int n = 0; n < 4; ++n) Bf[n] = *(const bf16x8*)(s_ + boff + n * 2048 + k * 1024);
#pragma unroll
            for (int m = 0; m < 4; ++m)
#pragma unroll
                for (int n = 0; n < 4; ++n) acc[m][n] = __builtin_amdgcn_mfma_f32_16x16x32_bf16(Bf[n], Af[m], acc[m][n], 0, 0, 0);
        }
        if (t + 1 < nk) { G_WRITE((t + 1) & 1); if (t + 2 < nk) G_LOAD(t + 2); }
        __syncthreads();
    }
#undef G_LOAD
#undef G_WRITE
    epi(acc, wr, wc, fr, fq);
}


namespace att {
typedef short s16x4 __attribute__((ext_vector_type(4)));
typedef float f32x16 __attribute__((ext_vector_type(16)));
constexpr int KVBLK = 64;
constexpr float SCALE = 0.10206207261596577f;
constexpr float THR = 8.f;
constexpr int SHM_V = 16384, SHM_K = 16384, SHM_ATTN = 2 * SHM_V + 2 * SHM_K + 8 * 64 * 4;
#define KSWZ(row, colB) ((row) * 256 + ((colB) ^ (((row) & 7) << 4)))
#define SBAR() __builtin_amdgcn_sched_barrier(0)
DEVI int crow(int r, int hi) { return (r & 3) + 8 * (r >> 2) + 4 * hi; }
DEVI void partialSM(f32x16& p0, f32x16& p1, float& m_reg, float& mn, float& alpha) {
    constexpr float C = SCALE * 1.4426950408889634f;
    float pmax = p0[0];
#pragma unroll
    for (int r = 1; r < 16; ++r) pmax = fmaxf(pmax, p0[r]);
#pragma unroll
    for (int r = 0; r < 16; ++r) pmax = fmaxf(pmax, p1[r]);
    { auto rr = __builtin_amdgcn_permlane32_swap(__float_as_uint(pmax), __float_as_uint(pmax), false, false);
      pmax = fmaxf(__uint_as_float(rr[0]), __uint_as_float(rr[1])); }
    if (__builtin_expect(__all(pmax - m_reg <= THR / SCALE), 1)) { mn = m_reg; alpha = 1.f; }
    else { mn = fmaxf(m_reg, pmax); alpha = __builtin_amdgcn_exp2f((m_reg - mn) * C); m_reg = mn; }
    const float mnC = -mn * C;
#pragma unroll
    for (int r = 0; r < 16; ++r) p0[r] = fmaf(p0[r], C, mnC);
#pragma unroll
    for (int r = 0; r < 16; ++r) p1[r] = fmaf(p1[r], C, mnC);
#pragma unroll
    for (int r = 0; r < 16; ++r) p0[r] = __builtin_amdgcn_exp2f(p0[r]);
}
DEVI void finishSM(f32x16& p0, f32x16& p1, float alpha, float& l_reg, bf16x8& pa0, bf16x8& pa1, bf16x8& pa2, bf16x8& pa3) {
#pragma unroll
    for (int r = 0; r < 16; ++r) p1[r] = __builtin_amdgcn_exp2f(p1[r]);
    float ps = 0.f;
#pragma unroll
    for (int r = 0; r < 16; ++r) ps += p0[r];
#pragma unroll
    for (int r = 0; r < 16; ++r) ps += p1[r];
    { auto rr = __builtin_amdgcn_permlane32_swap(__float_as_uint(ps), __float_as_uint(ps), false, false);
      ps = __uint_as_float(rr[0]) + __uint_as_float(rr[1]); }
    l_reg = l_reg * alpha + ps;
#define PK4(P, BASE, OUT) do { unsigned a0 = cvt_pk_bf16(P[BASE + 0], P[BASE + 1]), a1 = cvt_pk_bf16(P[BASE + 2], P[BASE + 3]);   \
    unsigned b0 = cvt_pk_bf16(P[BASE + 4], P[BASE + 5]), b1 = cvt_pk_bf16(P[BASE + 6], P[BASE + 7]);                              \
    auto r0 = __builtin_amdgcn_permlane32_swap(a0, b0, false, false); auto r1 = __builtin_amdgcn_permlane32_swap(a1, b1, false, false); \
    u32x4 w = {r0[0], r1[0], r0[1], r1[1]}; OUT = *reinterpret_cast<bf16x8*>(&w); } while (0)
    PK4(p0, 0, pa0); PK4(p0, 8, pa1); PK4(p1, 0, pa2); PK4(p1, 8, pa3);
#undef PK4
}
DEVI void qkt(f32x16& p0, f32x16& p1, const char* Ks, const bf16x8* qr, int r32, int hi) {
    p0 = f32x16{}; p1 = f32x16{};
#pragma unroll
    for (int d0 = 0; d0 < 6; ++d0) { const int cb = (d0 * 16 + hi * 8) * 2;
        const bf16x8 b0 = *reinterpret_cast<const bf16x8*>(Ks + KSWZ(r32, cb));
        const bf16x8 b1 = *reinterpret_cast<const bf16x8*>(Ks + KSWZ(32 + r32, cb));
        p0 = __builtin_amdgcn_mfma_f32_32x32x16_bf16(b0, qr[d0], p0, 0, 0, 0);
        p1 = __builtin_amdgcn_mfma_f32_32x32x16_bf16(b1, qr[d0], p1, 0, 0, 0); }
}
DEVI int v_st(int k, int c) { const int kk = (k & ~0xC) | ((k & 4) << 1) | ((k & 8) >> 1); return ((kk >> 3) * 4 + (c >> 5)) * 512 + ((kk & 7) * 32 + (c & 31)) * 2; }
DEVI int v_rd_base(int lane) { return ((lane & 3) << 3) | (((lane >> 2) & 3) << 6) | (((lane >> 4) & 1) << 5) | (((lane >> 5) & 1) << 8); }
constexpr int v_rd_off(int d0, int ks, int half) { return d0 * 512 + ks * 4096 + half * 2048; }
template <int OFF> DEVI s16x4 tr_read(int vb) {
    s16x4 r; asm volatile("ds_read_b64_tr_b16 %0, %1 offset:%2" : "=&v"(r) : "v"(vb), "i"(OFF) : "memory"); return r;
}
template <int D0> DEVI void pv_one(f32x16& od, int vb, bf16x8 pa0, bf16x8 pa1, bf16x8 pa2, bf16x8 pa3) {
    const s16x4 l0 = tr_read<v_rd_off(D0, 0, 0)>(vb), h0 = tr_read<v_rd_off(D0, 0, 1)>(vb), l1 = tr_read<v_rd_off(D0, 1, 0)>(vb), h1 = tr_read<v_rd_off(D0, 1, 1)>(vb);
    const s16x4 l2 = tr_read<v_rd_off(D0, 2, 0)>(vb), h2 = tr_read<v_rd_off(D0, 2, 1)>(vb), l3 = tr_read<v_rd_off(D0, 3, 0)>(vb), h3 = tr_read<v_rd_off(D0, 3, 1)>(vb);
    asm volatile("s_waitcnt lgkmcnt(0)" ::: "memory"); SBAR();
#define PKV(L, H) (bf16x8){L[0], L[1], L[2], L[3], H[0], H[1], H[2], H[3]}
    od = __builtin_amdgcn_mfma_f32_32x32x16_bf16(pa0, PKV(l0, h0), od, 0, 0, 0);
    od = __builtin_amdgcn_mfma_f32_32x32x16_bf16(pa1, PKV(l1, h1), od, 0, 0, 0);
    od = __builtin_amdgcn_mfma_f32_32x32x16_bf16(pa2, PKV(l2, h2), od, 0, 0, 0);
    od = __builtin_amdgcn_mfma_f32_32x32x16_bf16(pa3, PKV(l3, h3), od, 0, 0, 0);
#undef PKV
}
DEVI void pv_d0(f32x16* o, int vb, bf16x8 pa0, bf16x8 pa1, bf16x8 pa2, bf16x8 pa3) {
    pv_one<0>(o[0], vb, pa0, pa1, pa2, pa3); pv_one<1>(o[1], vb, pa0, pa1, pa2, pa3);
}
DEVI void attn_unit(const bf16_t* __restrict__ Qb, const bf16_t* __restrict__ Kh, const bf16_t* __restrict__ Vh, int seq, bf16_t* __restrict__ Ob, int ldo, char* lds) {
    const int tid = tid_(), wid = tid >> 6, lane = tid & 63, r32 = lane & 31, hi = lane >> 5;
    char* V_lds = lds; char* K_lds = lds + 2 * SHM_V;
    float* wsl = (float*)(lds + 2 * SHM_V + 2 * SHM_K) + wid * 64; float* li_l = wsl; float* al_l = wsl + 32;
    float m_reg = -1e30f, l_reg = 0.f; f32x16 o[2] = {}; bf16x8 qr[6];
    const bf16_t* Qw = Qb + (size_t)(wid * 32 + r32) * 96 + hi * 8;
#pragma unroll
    for (int d0 = 0; d0 < 6; ++d0) qr[d0] = *reinterpret_cast<const bf16x8*>(Qw + d0 * 16);
    const int sr = tid >> 4, kc = tid & 15, kcl = (kc < 12 ? kc : 11) * 8;
    const int vr = tid >> 3, vc = (tid & 7) * 8, vst0 = v_st(vr, vc);
    const int kst0 = KSWZ(sr, kc * 16), kst1 = KSWZ(32 + sr, kc * 16);
    const int vb0 = (int)(uintptr_t)V_lds + v_rd_base(lane);
    bf16x8 sv0, sk00, sk01, sv1, sk10, sk11;
#define SLOAD0(k0) do { sv0 = *reinterpret_cast<const bf16x8*>(Vh + (size_t)((k0) + vr) * 64 + vc); sk00 = *reinterpret_cast<const bf16x8*>(Kh + (size_t)((k0) + sr) * 96 + kcl); \
    sk01 = *reinterpret_cast<const bf16x8*>(Kh + (size_t)((k0) + 32 + sr) * 96 + kcl); } while (0)
#define SLOAD1(k0) do { sv1 = *reinterpret_cast<const bf16x8*>(Vh + (size_t)((k0) + vr) * 64 + vc); sk10 = *reinterpret_cast<const bf16x8*>(Kh + (size_t)((k0) + sr) * 96 + kcl); \
    sk11 = *reinterpret_cast<const bf16x8*>(Kh + (size_t)((k0) + 32 + sr) * 96 + kcl); } while (0)
#define SWRITE0(b) do { *(bf16x8*)(V_lds + (b) * SHM_V + vst0) = sv0; *(bf16x8*)(K_lds + (b) * SHM_K + kst0) = sk00; *(bf16x8*)(K_lds + (b) * SHM_K + kst1) = sk01; } while (0)
#define SWRITE1(b) do { *(bf16x8*)(V_lds + (b) * SHM_V + vst0) = sv1; *(bf16x8*)(K_lds + (b) * SHM_K + kst0) = sk10; *(bf16x8*)(K_lds + (b) * SHM_K + kst1) = sk11; } while (0)
#define SWAIT() asm volatile("s_waitcnt vmcnt(3)" ::: "memory")
#define RESC(a) do { if (__any((a) < 1.f)) { if (hi == 0) al_l[r32] = (a); asm volatile("s_waitcnt lgkmcnt(0)" ::: "memory"); \
    _Pragma("unroll") for (int d = 0; d < 2; ++d) _Pragma("unroll") for (int r = 0; r < 16; ++r) o[d][r] *= al_l[crow(r, hi)]; } } while (0)
    f32x16 pA0, pA1, pB0, pB1; float mnA, mnB, alA, alB; bf16x8 pa0, pa1, pa2, pa3; const int NT = seq / KVBLK;
    SLOAD0(0); asm volatile("s_waitcnt vmcnt(0)" ::: "memory"); SWRITE0(0); __syncthreads();
    qkt(pA0, pA1, K_lds, qr, r32, hi); partialSM(pA0, pA1, m_reg, mnA, alA);
    SLOAD1(KVBLK); if (2 < NT) SLOAD0(2 * KVBLK);
    SWAIT(); SWRITE1(1); __syncthreads();
    for (int j = 1; j + 1 < NT; j += 2) {
        SBAR(); qkt(pB0, pB1, K_lds + SHM_K, qr, r32, hi);
        finishSM(pA0, pA1, alA, l_reg, pa0, pa1, pa2, pa3); SBAR();
        SLOAD1((j + 2) * KVBLK); SBAR();
        pv_d0(o, vb0, pa0, pa1, pa2, pa3); partialSM(pB0, pB1, m_reg, mnB, alB);
        __syncthreads(); SWAIT(); SWRITE0(0);
        RESC(alB); __syncthreads();
        SBAR(); qkt(pA0, pA1, K_lds, qr, r32, hi);
        finishSM(pB0, pB1, alB, l_reg, pa0, pa1, pa2, pa3); SBAR();
        if (j + 3 < NT) SLOAD0((j + 3) * KVBLK); SBAR();
        pv_d0(o, vb0 + SHM_V, pa0, pa1, pa2, pa3); partialSM(pA0, pA1, m_reg, mnA, alA);
        __syncthreads(); SWAIT(); SWRITE1(1);
        RESC(alA); __syncthreads();
    }
    SBAR(); qkt(pB0, pB1, K_lds + SHM_K, qr, r32, hi);
    finishSM(pA0, pA1, alA, l_reg, pa0, pa1, pa2, pa3); SBAR();
    pv_d0(o, vb0, pa0, pa1, pa2, pa3); partialSM(pB0, pB1, m_reg, mnB, alB);
    __syncthreads(); RESC(alB);
    finishSM(pB0, pB1, alB, l_reg, pa0, pa1, pa2, pa3); SBAR();
    pv_d0(o, vb0 + SHM_V, pa0, pa1, pa2, pa3);
    if (hi == 0) li_l[r32] = l_reg; asm volatile("s_waitcnt lgkmcnt(0)" ::: "memory");
    float rli[16];
#pragma unroll
    for (int r = 0; r < 16; ++r) rli[r] = __builtin_amdgcn_rcpf(li_l[crow(r, hi)]);
    bf16_t* Ow = Ob + (size_t)(wid * 32) * ldo;
#pragma unroll
    for (int r = 0; r < 16; ++r) { const int orow = crow(r, hi);
#pragma unroll
        for (int d0 = 0; d0 < 2; ++d0) Ow[(size_t)orow * ldo + d0 * 32 + r32] = f2bf(o[d0][r] * rli[r]); }
    __syncthreads();
#undef SLOAD0
#undef SLOAD1
#undef SWRITE0
#undef SWRITE1
#undef SWAIT
#undef RESC
}
#undef KSWZ
#undef SBAR
}

template <class ARow, class BMap, class Epi>
DEVI void gemm_tile(int K, ARow arow, const float* __restrict__ B, int ldb, BMap bmap, Epi epi, float* smem) {
    float (*As)[132] = (float (*)[132])smem;
    float (*Bs)[64] = (float (*)[64])(smem + 16 * 132);
    const int tid = tid_(), ty = tid >> 4, tx = tid & 15;
    float acc[4][4];
#pragma unroll
    for (int i = 0; i < 4; ++i)
#pragma unroll
        for (int j = 0; j < 4; ++j) acc[i][j] = 0.f;
    const int ar = tid >> 2, akq = tid & 3;
    const float* ap = arow(ar);
    const int bk0 = tid >> 6, bc = tid & 63;
    const int bcol = bmap(bc);
    for (int k0 = 0; k0 < K; k0 += 16) {
        float4 av = make_float4(0.f, 0.f, 0.f, 0.f);
        if (ap) av = *(const float4*)(ap + k0 + akq * 4);
        float b0 = 0.f, b1 = 0.f;
        if (bcol >= 0) { b0 = B[(size_t)(k0 + bk0) * ldb + bcol]; b1 = B[(size_t)(k0 + bk0 + 8) * ldb + bcol]; }
        __syncthreads();
        As[akq * 4 + 0][ar] = av.x; As[akq * 4 + 1][ar] = av.y; As[akq * 4 + 2][ar] = av.z; As[akq * 4 + 3][ar] = av.w;
        Bs[bk0][bc] = b0; Bs[bk0 + 8][bc] = b1;
        __syncthreads();
#pragma unroll
        for (int kk = 0; kk < 16; ++kk) {
            const float4 a = *(const float4*)&As[kk][ty * 4];
            const float4 b = *(const float4*)&Bs[kk][tx * 4];
            const float aa[4] = {a.x, a.y, a.z, a.w}, bb[4] = {b.x, b.y, b.z, b.w};
#pragma unroll
            for (int i = 0; i < 4; ++i)
#pragma unroll
                for (int j = 0; j < 4; ++j) acc[i][j] = fmaf(aa[i], bb[j], acc[i][j]);
        }
    }
#pragma unroll
    for (int i = 0; i < 4; ++i) epi(ty * 4 + i, tx, acc[i]);
    __syncthreads();
}

__device__ void phase_init(const Params& p) {
    const int tid = tid_(), bid = bid_(); (void)tid; (void)bid;
    float* ws = p.ws;
    const size_t n4 = (size_t)T * D / 4;
    for (size_t i = (size_t)bid * NTHR + tid; i < n4; i += (size_t)gridDim.x * NTHR) {
        const size_t e = i * 4;
        float4 v = (e < (size_t)NLAT * D) ? *(const float4*)(p.in[I_X] + e) : *(const float4*)(p.in[I_CTX] + (e - (size_t)NLAT * D));
        *(float4*)(ws + W_X + e) = v;
    }
    for (int i = bid * NTHR + tid; i < NLAYER * 4 * 128 * 128; i += gridDim.x * NTHR) ((bf16_t*)(ws + W_WSB))[i] = f2bf(p.in[I_SGWS][i]);
    for (int i = bid * NTHR + tid; i < NLAT * 16; i += gridDim.x * NTHR) {
        const int t = i >> 4, f = i & 15; const float pos = (f < 8) ? (float)(t >> 6) : (float)(t & 63);
        const float ang = pos * powf(10000.f, -(float)(f & 7) / 8.f);
        ws[W_ROPE + (size_t)t * 32 + f] = cosf(ang); ws[W_ROPE + (size_t)t * 32 + 16 + f] = sinf(ang);
    }
    if (bid == 0 && tid < 64) ((int*)(ws + W_CNT))[tid] = 0;
}

__device__ void phase_mod(const Params& p, float* smem) {
    const int tid = tid_(), bid = bid_(); (void)tid; (void)bid;
    const int wave = tid >> 6, lane = tid & 63;
    for (int it = bid; it < NLAYER * 96; it += gridDim.x) {
        const int l = it / 96, j = (it % 96) * 64 + lane;
        const float* W = p.in[I_WMOD] + (size_t)l * 1024 * 6144;
        float a0 = 0.f, a1 = 0.f;
        for (int k = wave * 128; k < wave * 128 + 128; ++k) {
            const float w = W[(size_t)k * 6144 + j];
            a0 = fmaf(silu(p.in[I_C][k]), w, a0);
            a1 = fmaf(silu(p.in[I_CCTX][k]), w, a1);
        }
        smem[(wave * 2 + 0) * 64 + lane] = a0; smem[(wave * 2 + 1) * 64 + lane] = a1;
        __syncthreads();
        if (wave < 2) {
            float s = 0.f;
            for (int w = 0; w < 8; ++w) s += smem[(w * 2 + wave) * 64 + lane];
            p.ws[W_MOD + (size_t)(l * 2 + wave) * 6144 + j] = s + p.in[I_BMOD][l * 6144 + j];
        }
        __syncthreads();
    }
}

__device__ void phase_norm(const Params& p, int l, int which) {
    const int tid = tid_(), bid = bid_(); (void)tid; (void)bid;
    const int lane = tid & 63, gw = bid * (NTHR / 64) + (tid >> 6), nw = gridDim.x * (NTHR / 64);
    const float* g = p.in[which ? I_NFFN : I_NMIX] + l * D;
    for (int t = gw; t < T; t += nw) {
        const float* x = p.ws + W_X + (size_t)t * D;
        const float* mod = p.ws + W_MOD + (size_t)(l * 2 + (t >= NLAT ? 1 : 0)) * 6144;
        const float* sh = mod + (which ? 3 : 0) * D; const float* sc = mod + (which ? 4 : 1) * D;
        float4 v[4]; float ss = 0.f;
#pragma unroll
        for (int j = 0; j < 4; ++j) { v[j] = *(const float4*)(x + j * 256 + lane * 4); ss += v[j].x * v[j].x + v[j].y * v[j].y + v[j].z * v[j].z + v[j].w * v[j].w; }
        ss = wave_sum(ss);
        const float rstd = rsqrtf(ss * (1.f / D) + EPS);
#pragma unroll
        for (int j = 0; j < 4; ++j) {
            const int c = j * 256 + lane * 4;
            const float4 gg = *(const float4*)(g + c), s1 = *(const float4*)(sc + c), s0 = *(const float4*)(sh + c);
            float4 o;
            o.x = v[j].x * rstd * gg.x * (1.f + s1.x) + s0.x; o.y = v[j].y * rstd * gg.y * (1.f + s1.y) + s0.y;
            o.z = v[j].z * rstd * gg.z * (1.f + s1.z) + s0.z; o.w = v[j].w * rstd * gg.w * (1.f + s1.w) + s0.w;
            { u32x2 w; w.x = cvt_pk_bf16(o.x, o.y); w.y = cvt_pk_bf16(o.z, o.w); *(u32x2*)((bf16_t*)(p.ws + W_HB) + (size_t)t * D + c) = w; }
        }
    }
}

__device__ void phase_inproj(const Params& p, int l, char* lds) {
    const int tid = tid_(), bid = bid_(); (void)tid;
    const float* Wm = p.in[I_WIN] + (size_t)l * D * INC;
    constexpr int ntn = (INC + 127) / 128, ntm = T / 256;
    const bf16_t* HB = (const bf16_t*)(p.ws + W_HB); float* P = p.ws + W_P;
    for (int tile = bid; tile < ntm * ntn; tile += gridDim.x) {
        const int tm = tile / ntn, tn = tile % ntn, m0 = tm * 256, n0 = tn * 128;
        gemm_unit<false>(lds, D, [&](int r) { return HB + (size_t)(m0 + r) * D; }, Wm + n0, Wm + n0, INC, INC - n0,
                  [&](const f32x4 (&acc)[4][4], int wr, int wc, int fr, int fq) {
#pragma unroll
                      for (int m = 0; m < 4; ++m) { float* row = P + (size_t)(m0 + wr * 64 + m * 16 + fr) * INC;
#pragma unroll
                          for (int n = 0; n < 4; ++n) { const int col = n0 + wc * 64 + n * 16 + 4 * fq; if (col < INC) *(f32x4*)(row + col) = acc[m][n]; } }
                  });
    }
}

__device__ void phase_prep1(const Params& p, int l) {
    const int tid = tid_(), bid = bid_(); (void)tid; (void)bid;
    const int lane = tid & 63, gw = bid * (NTHR / 64) + (tid >> 6), nw = gridDim.x * (NTHR / 64);
    float* ws = p.ws;
    for (int t = gw; t < T; t += nw) {
        const int s0 = (t < NLAT) ? 0 : NLAT, sl = (t < NLAT) ? NLAT : NCTX, n = t - s0;
        const float* P = ws + W_P; const float* pr = P + (size_t)t * INC;
        {
            const int g = lane >> 4, w = 2 << g;
            const int lo = max(n - w / 2, 0), hi = min(n + w / 2, sl);
            float4 s = make_float4(0.f, 0.f, 0.f, 0.f);
            for (int m = lo; m < hi; ++m) { const float4 v = *(const float4*)(P + (size_t)(s0 + m) * INC + OFF_A + lane * 4); s.x += v.x; s.y += v.y; s.z += v.z; s.w += v.w; }
            const float inv = 1.f / (float)(hi - lo);
            const float4 x = *(const float4*)(pr + OFF_A + lane * 4);
            float4 d; d.x = s.x * inv - x.x; d.y = s.y * inv - x.y; d.z = s.z * inv - x.z; d.w = s.w * inv - x.w;
            { u32x2 w; w.x = cvt_pk_bf16(d.x, d.y); w.y = cvt_pk_bf16(d.z, d.w); *(u32x2*)((bf16_t*)(ws + W_DIFF) + (size_t)t * 256 + lane * 4) = w; }
        }
        {
            float v[3]; float ss = 0.f;
#pragma unroll
            for (int j = 0; j < 3; ++j) { v[j] = pr[OFF_Q + j * 64 + lane]; ss += v[j] * v[j]; }
            ss = wave_sum(ss); const float rstd = rsqrtf(ss * (1.f / 192.f) + EPS);
#pragma unroll
            for (int j = 0; j < 3; ++j) ((bf16_t*)(ws + W_QN))[(size_t)t * 192 + j * 64 + lane] = f2bf(v[j] * rstd * p.in[I_QAN][l * 192 + j * 64 + lane]);
        }
        {
            float v[2]; float ss = 0.f;
#pragma unroll
            for (int j = 0; j < 2; ++j) { v[j] = pr[OFF_KV + j * 64 + lane]; ss += v[j] * v[j]; }
            ss = wave_sum(ss); const float rstd = rsqrtf(ss * (1.f / 128.f) + EPS);
#pragma unroll
            for (int j = 0; j < 2; ++j) ((bf16_t*)(ws + W_KVN))[(size_t)t * 128 + j * 64 + lane] = f2bf(v[j] * rstd * p.in[I_KVAN][l * 128 + j * 64 + lane]);
        }
        {
            const float4 zu = *(const float4*)(pr + OFF_C + lane * 4), zv = *(const float4*)(pr + OFF_C + 256 + lane * 4);
            float4 u; u.x = gelu_tanh(zu.x); u.y = gelu_tanh(zu.y); u.z = gelu_tanh(zu.z); u.w = gelu_tanh(zu.w);
            *(float4*)(ws + W_U + (size_t)t * 256 + lane * 4) = u;
            float gv[4] = {gelu_tanh(zv.x), gelu_tanh(zv.y), gelu_tanh(zv.z), gelu_tanh(zv.w)};
            const float mu = wave_sum(gv[0] + gv[1] + gv[2] + gv[3]) * (1.f / 256.f);
            float q = 0.f;
#pragma unroll
            for (int j = 0; j < 4; ++j) { gv[j] -= mu; q += gv[j] * gv[j]; }
            const float rstd = rsqrtf(wave_sum(q) * (1.f / 256.f) + EPS);
#pragma unroll
            for (int j = 0; j < 4; ++j) ws[W_VN + (size_t)t * 256 + lane * 4 + j] = gv[j] * rstd * p.in[I_SGG][l * 256 + lane * 4 + j] + p.in[I_SGB][l * 256 + lane * 4 + j];
        }
        {
            const float* cw = p.in[I_CONVW] + (size_t)l * 4 * 256;
            float4 o = *(const float4*)(p.in[I_CONVB] + l * 256 + lane * 4);
#pragma unroll
            for (int k = 0; k < 4; ++k) {
                const int m = n - 1 + k;
                if (m >= 0 && m < sl) {
                    const float4 xv = *(const float4*)(P + (size_t)(s0 + m) * INC + OFF_DX + lane * 4), wv = *(const float4*)(cw + k * 256 + lane * 4);
                    o.x = fmaf(xv.x, wv.x, o.x); o.y = fmaf(xv.y, wv.y, o.y); o.z = fmaf(xv.z, wv.z, o.z); o.w = fmaf(xv.w, wv.w, o.w);
                }
            }
            *(float4*)(ws + W_XC + (size_t)t * 256 + lane * 4) = o;
            { u32x2 w; w.x = cvt_pk_bf16(o.x, o.y); w.y = cvt_pk_bf16(o.z, o.w); *(u32x2*)((bf16_t*)(ws + W_XCB) + (size_t)t * 256 + lane * 4) = w; }
        }
    }
}

__device__ void phase_small(const Params& p, int l, char* lds) {
    const int tid = tid_(), bid = bid_(); (void)tid;
    float* ws = p.ws;
    constexpr int NK = 19, NU1 = (T / 256) * NK, NU2 = NCHUNK * 2;
    bf16_t* Y = (bf16_t*)(ws + W_YC);
    for (int u = bid; u < NU1 + NU2; u += gridDim.x) {
        if (u < NU1) {
            const int tm = u / NK, kind = u % NK, m0 = tm * 256;
            if (kind < 11) {
                const bf16_t* A; int lda, K, ldb, nval; const float* B;
                if (kind < 4) { A = (const bf16_t*)(ws + W_DIFF) + kind * 64; lda = 256; K = 64; B = p.in[I_POOLW] + (size_t)(l * 4 + kind) * 64 * 64; ldb = 64; nval = 64; }
                else if (kind < 7) { A = (const bf16_t*)(ws + W_QN); lda = 192; K = 192; B = p.in[I_WUQ] + (size_t)l * 192 * 384 + (kind - 4) * 128; ldb = 384; nval = 128; }
                else { A = (const bf16_t*)(ws + W_KVN); lda = 128; K = 128; B = p.in[I_WUKV] + (size_t)l * 128 * 512 + (kind - 7) * 128; ldb = 512; nval = 128; }
                gemm_unit<false>(lds, K, [&](int r) { return A + (size_t)(m0 + r) * lda; }, B, B, ldb, nval,
                    [&](const f32x4 (&acc)[4][4], int wr, int wc, int fr, int fq) {
#pragma unroll
                        for (int m = 0; m < 4; ++m) { const int t = m0 + wr * 64 + m * 16 + fr;
#pragma unroll
                            for (int n = 0; n < 4; ++n) { const int c = wc * 64 + n * 16 + 4 * fq;
                                if (kind < 4) { if (wc == 0) { const f32x4 sc = *(const f32x4*)(p.in[I_POOLS] + l * 256 + kind * 64 + c); const f32x4 v = acc[m][n] * sc;
                                        u32x2 w; w.x = cvt_pk_bf16(v[0], v[1]); w.y = cvt_pk_bf16(v[2], v[3]); *(u32x2*)(Y + (size_t)t * D + kind * 64 + c) = w; } }
                                else if (kind < 7) *(f32x4*)(ws + W_QUP + (size_t)t * 384 + (kind - 4) * 128 + c) = acc[m][n];
                                else *(f32x4*)(ws + W_KVUP + (size_t)t * 512 + (kind - 7) * 128 + c) = acc[m][n]; } }
                    });
            } else {
                const int d = (kind - 11) >> 2, h = (kind - 11) & 3;
                const bf16_t* A = (const bf16_t*)(ws + W_XCB) + h * 64;
                const float* Ba = p.in[I_WA] + (size_t)((l * 2 + d) * 4 + h) * 64 * 64; const float* Bx = p.in[I_WX] + (size_t)((l * 2 + d) * 4 + h) * 64 * 64;
                const int pb = (l * 2 + d) * 256 + h * 64;
                gemm_unit<true>(lds, 64, [&](int r) { return A + (size_t)(m0 + r) * 256; }, Ba, Bx, 64, 64,
                    [&](const f32x4 (&acc)[4][4], int wr, int wc, int fr, int fq) {
#pragma unroll
                        for (int m = 0; m < 4; ++m) { const int t = m0 + wr * 64 + m * 16 + fr;
#pragma unroll
                            for (int pp = 0; pp < 2; ++pp) { const int idx = (wc * 2 + pp) * 16 + 4 * fq;
                                const f32x4 ba = *(const f32x4*)(p.in[I_BA] + pb + idx), bx = *(const f32x4*)(p.in[I_BX] + pb + idx), lam = *(const f32x4*)(p.in[I_LAM] + pb + idx);
                                const f32x4 xv = *(const f32x4*)(ws + W_XC + (size_t)t * 256 + h * 64 + idx);
                                f32x4 av, dv;
#pragma unroll
                                for (int j = 0; j < 4; ++j) { const float r = sigm(acc[m][2 * pp][j] + ba[j]), ig = sigm(acc[m][2 * pp + 1][j] + bx[j]);
                                    const float loga = -8.f * r * log1pf(expf(-lam[j]));
                                    av[j] = expf(loga); dv[j] = sqrtf(-expm1f(2.f * loga)) * (ig * xv[j]); }
                                *(f32x4*)(ws + W_LA + ((size_t)d * T + t) * 256 + h * 64 + idx) = av;
                                *(f32x4*)(ws + W_LB + ((size_t)d * T + t) * 256 + h * 64 + idx) = dv; } }
                    });
            }
        } else {
            const int v = u - NU1, c = v >> 1, hp = v & 1;
            const bf16_t* A = (const bf16_t*)(ws + W_WSB) + ((size_t)l * 512 + hp * 256) * 128;
            const float* B = ws + W_VN + (size_t)c * 128 * 256 + hp * 128;
            gemm_unit<false>(lds, 128, [&](int r) { return A + (size_t)r * 128; }, B, B, 256, 128,
                [&](const f32x4 (&acc)[4][4], int wr, int wc, int fr, int fq) {
                    if ((wr >> 1) == wc) {
                        const int h = hp * 2 + wc;
#pragma unroll
                        for (int m = 0; m < 4; ++m) { const int pp = (wr & 1) * 64 + m * 16 + fr, t = c * 128 + pp; const float bs = p.in[I_SGBS][(l * 4 + h) * 128 + pp];
#pragma unroll
                            for (int n = 0; n < 4; ++n) { const int ch = h * 64 + n * 16 + 4 * fq; const f32x4 uu = *(const f32x4*)(ws + W_U + (size_t)t * 256 + ch);
                                const f32x4 o = uu * (acc[m][n] + bs);
                                u32x2 w; w.x = cvt_pk_bf16(o[0], o[1]); w.y = cvt_pk_bf16(o[2], o[3]); *(u32x2*)(Y + (size_t)t * D + 512 + ch) = w; } }
                    }
                });
        }
    }
}

__device__ void phase_prep2(const Params& p, int l) {
    const int tid = tid_(), bid = bid_(); (void)tid; (void)bid;
    float* ws = p.ws;
    const int lane = tid & 63, gw = bid * (NTHR / 64) + (tid >> 6), nw = gridDim.x * (NTHR / 64);
    for (int it = gw; it < T * 4; it += nw) {
        const int t = it >> 2, h = it & 3;
        const bool lat = t < NLAT;
        float cs = 1.f, sn = 0.f;
        if (lat && lane < 32) { cs = ws[W_ROPE + (size_t)t * 32 + (lane & 15)]; sn = ws[W_ROPE + (size_t)t * 32 + 16 + (lane & 15)]; }
        {
            float v0 = ws[W_QUP + (size_t)t * 384 + h * 96 + lane], v1 = (lane < 32) ? ws[W_QUP + (size_t)t * 384 + h * 96 + 64 + lane] : 0.f;
            const float rstd = rsqrtf(wave_sum(v0 * v0 + v1 * v1) * (1.f / 96.f) + EPS);
            v0 *= rstd * p.in[I_QN][l * 96 + lane]; v1 *= (lane < 32) ? rstd * p.in[I_QN][l * 96 + 64 + lane] : 0.f;
            const float pv = __shfl_xor(v1, 16);
            const float r1 = (lane < 16) ? v1 * cs - pv * sn : pv * sn + v1 * cs;
            bf16_t* qo = (bf16_t*)(ws + W_Q) + ((size_t)h * T + t) * 96;
            qo[lane] = f2bf(v0);
            if (lane < 32) qo[64 + lane] = f2bf(lat ? r1 : v1);
        }
        {
            float v0 = ws[W_KVUP + (size_t)t * 512 + h * 128 + lane], v1 = (lane < 32) ? ws[W_P + (size_t)t * INC + OFF_KR + lane] : 0.f;
            const float rstd = rsqrtf(wave_sum(v0 * v0 + v1 * v1) * (1.f / 96.f) + EPS);
            v0 *= rstd * p.in[I_KN][l * 96 + lane]; v1 *= (lane < 32) ? rstd * p.in[I_KN][l * 96 + 64 + lane] : 0.f;
            const float pv = __shfl_xor(v1, 16);
            const float r1 = (lane < 16) ? v1 * cs - pv * sn : pv * sn + v1 * cs;
            bf16_t* ko = (bf16_t*)(ws + W_K) + ((size_t)h * T + t) * 96;
            ko[lane] = f2bf(v0);
            if (lane < 32) ko[64 + lane] = f2bf(lat ? r1 : v1);
            ((bf16_t*)(ws + W_V))[((size_t)h * T + t) * 64 + lane] = f2bf(ws[W_KVUP + (size_t)t * 512 + h * 128 + 64 + lane]);
        }
    }
    for (int i = bid * NTHR + tid; i < NCHUNK * 512; i += gridDim.x * NTHR) {
        const int c = i >> 9, d = (i >> 8) & 1, ch = i & 255;
        float* A = ws + W_LA + ((size_t)d * T + (size_t)c * 128) * 256 + ch;
        float* B = ws + W_LB + ((size_t)d * T + (size_t)c * 128) * 256 + ch;
        float h = 0.f, ap = 1.f;
        for (int s0 = 0; s0 < 128; s0 += 8) {
            float a[8], b[8];
#pragma unroll
            for (int j = 0; j < 8; ++j) { const int q = d ? 127 - (s0 + j) : s0 + j; a[j] = A[(size_t)q * 256]; b[j] = B[(size_t)q * 256]; }
#pragma unroll
            for (int j = 0; j < 8; ++j) { h = fmaf(a[j], h, b[j]); ap *= a[j]; a[j] = ap; b[j] = h; }
#pragma unroll
            for (int j = 0; j < 8; ++j) { const int q = d ? 127 - (s0 + j) : s0 + j; A[(size_t)q * 256] = a[j]; B[(size_t)q * 256] = b[j]; }
        }
        ws[W_AGG + ((size_t)(c * 2 + d) * 2 + 0) * 256 + ch] = ap;
        ws[W_AGG + ((size_t)(c * 2 + d) * 2 + 1) * 256 + ch] = h;
    }
}


__device__ void phase_attn(const Params& p, int l, char* lds) {
    const int tid = tid_(), bid = bid_(); (void)tid;
    const bf16_t* Qb = (const bf16_t*)(p.ws + W_Q); const bf16_t* Kb = (const bf16_t*)(p.ws + W_K); const bf16_t* Vb = (const bf16_t*)(p.ws + W_V);
    bf16_t* Y = (bf16_t*)(p.ws + W_YC);
    const int nunits = (l == 0) ? 260 : 256;
    for (int u = bid; u < nunits; u += gridDim.x) {
        int h, t0, k0, seq;
        if (u < 256) { h = (u & 7) >> 1; t0 = (((u >> 3) << 1) | (u & 1)) * 256; k0 = 0; seq = T; }
        else { h = u - 256; t0 = NLAT; k0 = NLAT; seq = NCTX; }
        att::attn_unit(Qb + ((size_t)h * T + t0) * 96, Kb + ((size_t)h * T + k0) * 96, Vb + ((size_t)h * T + k0) * 64, seq, Y + (size_t)t0 * D + 256 + h * 64, D, lds);
    }
}

__device__ void phase_lru_fin(const Params& p, char* lds) {
    const int tid = tid_(), bid = bid_();
    float* ws = p.ws;
    float* carry = (float*)lds;
    for (int c = bid; c < NCHUNK; c += gridDim.x) {
        {
            const int d = tid >> 8, ch = tid & 255;
            const int npre = d ? (NCHUNK - 1 - c) : ((c + 2) % NCHUNK);
            float s = 0.f;
            for (int k = 0; k < npre; ++k) {
                const int q = d ? (NCHUNK - 1 - k) : ((k + 128) % NCHUNK);
                const float a = ws[W_AGG + ((size_t)(q * 2 + d) * 2 + 0) * 256 + ch], hh = ws[W_AGG + ((size_t)(q * 2 + d) * 2 + 1) * 256 + ch];
                s = fmaf(a, s, hh);
            }
            carry[tid] = s;
        }
        __syncthreads();
        for (int i = tid; i < 128 * 64; i += NTHR) {
            const int t = c * 128 + (i >> 6), ch = (i & 63) * 4;
            f32x4 hs = *(const f32x4*)(ws + W_LB + (size_t)t * 256 + ch) + *(const f32x4*)(ws + W_LA + (size_t)t * 256 + ch) * *(const f32x4*)(carry + ch);
            hs = hs + *(const f32x4*)(ws + W_LB + ((size_t)T + t) * 256 + ch) + *(const f32x4*)(ws + W_LA + ((size_t)T + t) * 256 + ch) * *(const f32x4*)(carry + 256 + ch);
            const f32x4 g = *(const f32x4*)(ws + W_P + (size_t)t * INC + OFF_DG + ch);
            u32x2 w; w.x = cvt_pk_bf16(gelu_tanh(g[0]) * hs[0], gelu_tanh(g[1]) * hs[1]); w.y = cvt_pk_bf16(gelu_tanh(g[2]) * hs[2], gelu_tanh(g[3]) * hs[3]);
            *(u32x2*)((bf16_t*)(ws + W_YC) + (size_t)t * D + 768 + ch) = w;
        }
        __syncthreads();
    }
}

__device__ void phase_outproj(const Params& p, int l, char* lds) {
    const int tid = tid_(), bid = bid_(); (void)tid;
    const float* Wm = p.in[I_WOUT] + (size_t)l * D * D;
    constexpr int ntn = D / 128, ntm = T / 256;
    const bf16_t* Y = (const bf16_t*)(p.ws + W_YC); float* X = p.ws + W_X;
    for (int tile = bid; tile < ntm * ntn; tile += gridDim.x) {
        const int tm = tile / ntn, tn = tile % ntn, m0 = tm * 256, n0 = tn * 128;
        const float* g1 = p.ws + W_MOD + (size_t)(l * 2 + (m0 >= NLAT ? 1 : 0)) * 6144 + 2 * D;
        gemm_unit<false>(lds, D, [&](int r) { return Y + (size_t)(m0 + r) * D; }, Wm + n0, Wm + n0, D, 128,
                  [&](const f32x4 (&acc)[4][4], int wr, int wc, int fr, int fq) {
#pragma unroll
                      for (int m = 0; m < 4; ++m) { float* row = X + (size_t)(m0 + wr * 64 + m * 16 + fr) * D;
#pragma unroll
                          for (int n = 0; n < 4; ++n) { const int col = n0 + wc * 64 + n * 16 + 4 * fq; const f32x4 g = *(const f32x4*)(g1 + col); f32x4 x = *(f32x4*)(row + col);
                              x = x + g * acc[m][n]; *(f32x4*)(row + col) = x; } }
                  });
    }
}

constexpr int R_LDS = 1024 * 36 * 4;
__device__ void phase_router(const Params& p, int l, char* lds) {
    const int tid = tid_(), bid = bid_();
    float* ws = p.ws;
    float* wl = (float*)lds;
    {   const float* rw = p.in[I_RW] + (size_t)l * D * NEXP;
        for (int i = tid; i < 1024 * 8; i += NTHR) { const int k = i >> 3, e4 = i & 7; *(f32x4*)(wl + k * 36 + e4 * 4) = *(const f32x4*)(rw + k * 32 + e4 * 4); }
    }
    __syncthreads();
    const int lane = tid & 63, gw = bid * (NTHR / 64) + (tid >> 6), nw = gridDim.x * (NTHR / 64);
    const float* g = p.in[I_NFFN] + l * D;
    int* cnt = (int*)(ws + W_CNT) + l * NEXP;
    int* list = (int*)(ws + W_LIST);
    bf16_t* HB = (bf16_t*)(ws + W_HB);
    const int e = lane >> 1;
    const float rb = p.in[I_RB][l * NEXP + e];
    for (int t = gw; t < T; t += nw) {
        const float* x = ws + W_X + (size_t)t * D;
        const float* mod = ws + W_MOD + (size_t)(l * 2 + (t >= NLAT ? 1 : 0)) * 6144;
        float f[16]; float ss = 0.f;
#pragma unroll
        for (int m = 0; m < 16; ++m) { f[m] = x[lane + 64 * m]; ss = fmaf(f[m], f[m], ss); }
        const float rstd = rsqrtf(wave_sum(ss) * (1.f / D) + EPS);
#pragma unroll
        for (int m = 0; m < 16; ++m) { const int k = lane + 64 * m; f[m] = f[m] * rstd * g[k] * (1.f + mod[4 * D + k]) + mod[3 * D + k]; HB[(size_t)t * D + k] = f2bf(f[m]); }
        float acc[32];
#pragma unroll
        for (int j = 0; j < 32; ++j) acc[j] = 0.f;
#pragma unroll
        for (int m = 0; m < 16; ++m) {
            const float* wr = wl + (lane + 64 * m) * 36;
#pragma unroll
            for (int e4 = 0; e4 < 8; ++e4) { const f32x4 w4 = *(const f32x4*)(wr + e4 * 4);
#pragma unroll
                for (int j = 0; j < 4; ++j) acc[e4 * 4 + j] = fmaf(f[m], w4[j], acc[e4 * 4 + j]); }
        }
#pragma unroll
        for (int w = 16, msk = 32; w >= 1; w >>= 1, msk >>= 1) {
            const bool up = (lane & msk) != 0;
#pragma unroll
            for (int j = 0; j < w; ++j) { const float send = up ? acc[j] : acc[j + w], keep = up ? acc[j + w] : acc[j]; acc[j] = keep + __shfl_xor(send, msk); }
        }
        float a = acc[0] + __shfl_xor(acc[0], 1) + rb;
        float tv[4]; int te[4];
        float cur = a;
#pragma unroll
        for (int k = 0; k < 4; ++k) {
            float bv = cur; int bi = e;
#pragma unroll
            for (int o = 32; o > 1; o >>= 1) {
                const float ov = __shfl_xor(bv, o); const int oi = __shfl_xor(bi, o);
                if (ov > bv || (ov == bv && oi < bi)) { bv = ov; bi = oi; }
            }
            tv[k] = bv; te[k] = bi;
            if (e == bi) cur = -3.0e38f;
        }
        const float mx = tv[0];
        float ex[4], sm = 0.f;
#pragma unroll
        for (int k = 0; k < 4; ++k) { ex[k] = expf(tv[k] - mx); sm += ex[k]; }
        if (lane < 4) {
            const int ee = lane == 0 ? te[0] : lane == 1 ? te[1] : lane == 2 ? te[2] : te[3];
            const float eg = lane == 0 ? ex[0] : lane == 1 ? ex[1] : lane == 2 ? ex[2] : ex[3];
            const int idx = atomicAdd(&cnt[ee], 1);
            list[(size_t)ee * T + idx] = t;
            ((int*)(ws + W_TOPE))[t * 4 + lane] = ee;
            ((int*)(ws + W_TOPI))[t * 4 + lane] = idx;
            ws[W_TOPG + t * 4 + lane] = eg / sm;
        }
    }
    __syncthreads();
}

DEVI void moe_bases(const Params& p, int l, int* sb) {
    const int tid = tid_();
    if (tid == 0) {
        const int* cnt = (const int*)(p.ws + W_CNT) + l * NEXP;
        int b = 0, tb = 0;
        for (int e = 0; e < NEXP; ++e) { sb[e] = b; sb[40 + e] = tb; const int c = cnt[e]; sb[80 + e] = c; const int mt = (c + 255) / 256; b += mt * 256; tb += mt; }
        sb[32] = b; sb[72] = tb;
    }
    __syncthreads();
}

__device__ void phase_moe1(const Params& p, int l, char* lds) {
    const int tid = tid_(), bid = bid_(); (void)tid;
    int* sb = (int*)(lds + G_LDS);
    moe_bases(p, l, sb);
    constexpr int ntn = 16;
    const int nunits = sb[72] * ntn;
    const int* list = (const int*)(p.ws + W_LIST);
    const bf16_t* HB = (const bf16_t*)(p.ws + W_HB); bf16_t* ACT = (bf16_t*)(p.ws + W_ACT);
    for (int u = bid; u < nunits; u += gridDim.x) {
        int e = 0; while (e < NEXP - 1 && sb[40 + e + 1] * ntn <= u) ++e;
        const int mts = sb[40 + e + 1] - sb[40 + e], loc = u - sb[40 + e] * ntn, tn = loc / mts, mt = loc % mts;
        const int mloc = mt * 256, cnt = sb[80 + e], rbase = sb[e] + mloc;
        const float* Wm = p.in[I_WGU] + ((size_t)(l * NEXP + e) * D) * 2048 + tn * 64;
        const float* bias = p.in[I_BGU] + (size_t)(l * NEXP + e) * 2048 + tn * 64;
        const int* le = list + (size_t)e * T + mloc;
        gemm_unit<true>(lds, D, [&](int r) { return (mloc + r < cnt) ? HB + (size_t)le[r] * D : (const bf16_t*)nullptr; }, Wm, Wm + 1024, 2048, 64,
                  [&](const f32x4 (&acc)[4][4], int wr, int wc, int fr, int fq) {
#pragma unroll
                      for (int m = 0; m < 4; ++m) { const int r = wr * 64 + m * 16 + fr;
                          if (mloc + r < cnt) {
#pragma unroll
                              for (int pp = 0; pp < 2; ++pp) { const int idx = (wc * 2 + pp) * 16 + 4 * fq;
                                  const f32x4 bg = *(const f32x4*)(bias + idx), bu = *(const f32x4*)(bias + 1024 + idx);
                                  float a[4];
#pragma unroll
                                  for (int j = 0; j < 4; ++j) { float g = acc[m][2 * pp][j] + bg[j], uu = acc[m][2 * pp + 1][j] + bu[j];
                                      g = fminf(g, 7.f); uu = fminf(fmaxf(uu, -7.f), 7.f); a[j] = (uu + 1.f) * (g * sigm(1.702f * g)); }
                                  u32x2 w; w.x = cvt_pk_bf16(a[0], a[1]); w.y = cvt_pk_bf16(a[2], a[3]);
                                  *(u32x2*)(ACT + (size_t)(rbase + r) * D + tn * 64 + idx) = w; } } }
                  });
    }
    __syncthreads();
}

__device__ void phase_moe2(const Params& p, int l, char* lds) {
    const int tid = tid_(), bid = bid_(); (void)tid;
    int* sb = (int*)(lds + G_LDS);
    moe_bases(p, l, sb);
    constexpr int ntn = D / 128;
    const int nunits = sb[72] * ntn;
    const bf16_t* ACT = (const bf16_t*)(p.ws + W_ACT); bf16_t* YR = (bf16_t*)(p.ws + W_YR);
    for (int u = bid; u < nunits; u += gridDim.x) {
        int e = 0; while (e < NEXP - 1 && sb[40 + e + 1] * ntn <= u) ++e;
        const int mts = sb[40 + e + 1] - sb[40 + e], loc = u - sb[40 + e] * ntn, tn = loc / mts, mt = loc % mts;
        const int mloc = mt * 256, cnt = sb[80 + e], rbase = sb[e] + mloc, n0 = tn * 128;
        const float* Wm = p.in[I_WDN] + ((size_t)(l * NEXP + e) * D) * D + n0;
        const float* bias = p.in[I_BDN] + (size_t)(l * NEXP + e) * D + n0;
        gemm_unit<false>(lds, D, [&](int r) { return (mloc + r < cnt) ? ACT + (size_t)(rbase + r) * D : (const bf16_t*)nullptr; }, Wm, Wm, D, 128,
                  [&](const f32x4 (&acc)[4][4], int wr, int wc, int fr, int fq) {
#pragma unroll
                      for (int m = 0; m < 4; ++m) { const int r = wr * 64 + m * 16 + fr;
                          if (mloc + r < cnt) {
#pragma unroll
                              for (int n = 0; n < 4; ++n) { const int c = wc * 64 + n * 16 + 4 * fq; const f32x4 b = *(const f32x4*)(bias + c); const f32x4 v = acc[m][n] + b;
                                  u32x2 w; w.x = cvt_pk_bf16(v[0], v[1]); w.y = cvt_pk_bf16(v[2], v[3]);
                                  *(u32x2*)(YR + (size_t)(rbase + r) * D + n0 + c) = w; } } }
                  });
    }
    __syncthreads();
}

__device__ void phase_combine(const Params& p, int l, char* lds, bool last) {
    const int tid = tid_(), bid = bid_();
    int* sb = (int*)(lds + G_LDS);
    moe_bases(p, l, sb);
    float* ws = p.ws;
    const bf16_t* YR = (const bf16_t*)(ws + W_YR);
    const int lane = tid & 63, gw = bid * (NTHR / 64) + (tid >> 6), nw = gridDim.x * (NTHR / 64);
    for (int t = gw; t < T; t += nw) {
        const float* g2 = ws + W_MOD + (size_t)(l * 2 + (t >= NLAT ? 1 : 0)) * 6144 + 5 * D;
        const bf16_t* yr[4]; float gt[4];
#pragma unroll
        for (int k = 0; k < 4; ++k) {
            const int e = ((const int*)(ws + W_TOPE))[t * 4 + k], idx = ((const int*)(ws + W_TOPI))[t * 4 + k];
            yr[k] = YR + (size_t)(sb[e] + idx) * D; gt[k] = ws[W_TOPG + t * 4 + k];
        }
        float* x = ws + W_X + (size_t)t * D;
#pragma unroll
        for (int j = 0; j < 4; ++j) {
            const int c = j * 256 + lane * 4;
            float a0 = 0.f, a1 = 0.f, a2 = 0.f, a3 = 0.f;
#pragma unroll
            for (int k = 0; k < 4; ++k) { const u32x2 y = *(const u32x2*)(yr[k] + c);
                a0 = fmaf(gt[k], __uint_as_float(y.x << 16), a0); a1 = fmaf(gt[k], __uint_as_float(y.x & 0xffff0000u), a1);
                a2 = fmaf(gt[k], __uint_as_float(y.y << 16), a2); a3 = fmaf(gt[k], __uint_as_float(y.y & 0xffff0000u), a3); }
            float4 xv = *(const float4*)(x + c); const float4 gg = *(const float4*)(g2 + c);
            xv.x = fmaf(gg.x, a0, xv.x); xv.y = fmaf(gg.y, a1, xv.y); xv.z = fmaf(gg.z, a2, xv.z); xv.w = fmaf(gg.w, a3, xv.w);
            *(float4*)(x + c) = xv;
            if (last && t < NLAT) *(float4*)(p.out + (size_t)t * D + c) = xv;
        }
    }
    __syncthreads();
}

constexpr int LDS_BYTES = R_LDS + 2048;

#define XB_TMO      128
#define XB_XCNT(j)  (256  + 64 * (j))
#define XB_XSUB(j)  (1280 + 64 * (j))
#define XB_XGEN(j)  (2304 + 64 * (j))
#define XB_TOP      3328
#define XB_TOPGEN   3392
#define XCD_BAR_WORDS 3456
#define XB_SPIN_CAP (1u << 18)
#define LAS __attribute__((address_space(3)))
__device__ __forceinline__ unsigned xb_ld(unsigned* p)              { return __hip_atomic_load(p, __ATOMIC_RELAXED, __HIP_MEMORY_SCOPE_AGENT); }
__device__ __forceinline__ unsigned xb_add(unsigned* p, unsigned v) { return __hip_atomic_fetch_add(p, v, __ATOMIC_RELAXED, __HIP_MEMORY_SCOPE_AGENT); }
__device__ __forceinline__ unsigned xb_xcc_id() { return (unsigned)__builtin_amdgcn_s_getreg((3 << 11) | 20) & 0xFu; }
#define XB_SPIN(cond, bar) do { unsigned _sp = 0; while (cond) { __builtin_amdgcn_s_sleep(1); \
    if ((++_sp & 255u) == 0u) { if (xb_ld(&(bar)[XB_TMO])) break; if (_sp > XB_SPIN_CAP) { atomicAdd(&(bar)[XB_TMO], 1u); break; } } } } while (0)
struct XcdBarrier { unsigned* bar; unsigned x; volatile LAS unsigned* st; };
__device__ __forceinline__ XcdBarrier xcd_barrier_post(unsigned* bar, volatile LAS unsigned* st) {
    XcdBarrier b; b.bar = bar; b.x = xb_xcc_id(); b.st = st;
    if (threadIdx.x == 0) (void)xb_add(&bar[XB_XCNT(b.x)], 1u);
    return b;
}
__device__ __forceinline__ void xcd_barrier_complete(unsigned* bar, unsigned x, unsigned& nloc, unsigned& nx) {
    const unsigned G = gridDim.x * gridDim.y * gridDim.z;
    unsigned sum, cnt, mine, sp = 0u;
    for (;;) {
        sum = 0u; cnt = 0u; mine = 0u;
#pragma unroll
        for (unsigned j = 0; j < 16; ++j) { const unsigned c = xb_ld(&bar[XB_XCNT(j)]); sum += c; cnt += (c > 0u) ? 1u : 0u; mine = (j == x) ? c : mine; }
        if (sum == G) break;
        __builtin_amdgcn_s_sleep(1);
        if ((++sp & 255u) == 0u) { if (xb_ld(&bar[XB_TMO])) break; if (sp > XB_SPIN_CAP) { atomicAdd(&bar[XB_TMO], 1u); break; } }
    }
    nloc = mine > 0u ? mine : 1u; nx = cnt > 0u ? cnt : 1u;
}
__device__ __noinline__ void xcd_barrier(const XcdBarrier b) {
    asm volatile("s_waitcnt vmcnt(0)" ::: "memory");
    __syncthreads();
    if (threadIdx.x == 0) {
        unsigned* bar = b.bar;
        __builtin_amdgcn_s_waitcnt(0);
        unsigned nloc = b.st[0], nx = b.st[1];
        if (nloc == 0u) { xcd_barrier_complete(bar, b.x, nloc, nx); b.st[0] = nloc; b.st[1] = nx; }
        const unsigned old = xb_add(&bar[XB_XSUB(b.x)], 1u);
        const unsigned gen = old / nloc;
        if (old + 1u == (gen + 1u) * nloc) {
            __builtin_amdgcn_fence(__ATOMIC_RELEASE, "agent");
            asm volatile("s_waitcnt vmcnt(0)" ::: "memory");
            const unsigned og = xb_add(&bar[XB_TOP], 1u);
            const unsigned tg = og / nx;
            if (og + 1u == (tg + 1u) * nx) xb_add(&bar[XB_TOPGEN], 1u);
            else XB_SPIN(xb_ld(&bar[XB_TOPGEN]) == tg, bar);
            __builtin_amdgcn_fence(__ATOMIC_ACQUIRE, "agent");
            xb_add(&bar[XB_XGEN(b.x)], 1u);
            asm volatile("s_waitcnt vmcnt(0)" ::: "memory");
        } else {
            XB_SPIN(xb_ld(&bar[XB_XGEN(b.x)]) == gen, bar);
            __builtin_amdgcn_fence(__ATOMIC_ACQUIRE, "agent");
            asm volatile("s_waitcnt vmcnt(0)" ::: "memory");
        }
    }
    __syncthreads();
}

constexpr int REP_NORM = 1, REP_INPROJ = 1, REP_PREP1 = 1, REP_SMALL = 1, REP_ATTN = 1, REP_FIN = 1, REP_MOE1 = 1, REP_MOE2 = 1, REP_SYNC = 1;
__global__ void __launch_bounds__(NTHR) fwd_kernel(Params p) {
    cg::grid_group grid = cg::this_grid();
    extern __shared__ __attribute__((aligned(16))) char lds[];
    float* smem = (float*)lds;
    volatile LAS unsigned* xst = (volatile LAS unsigned*)(lds + LDS_BYTES - 16);
    if (threadIdx.x < 4) xst[threadIdx.x] = 0u;
    if (blockIdx.x == 0) for (int i = threadIdx.x; i < 4096; i += NTHR) ((unsigned*)(p.ws + W_BAR))[i] = 0u;
    phase_init(p);
    phase_mod(p, smem);
    grid.sync();
    XcdBarrier xbar = xcd_barrier_post((unsigned*)(p.ws + W_BAR), xst);
#define GSYNC() do { for (int r_ = 0; r_ < REP_SYNC; ++r_) xcd_barrier(xbar); } while (0)
    for (int l = 0; l < NLAYER; ++l) {
        for (int r = 0; r < REP_NORM; ++r) phase_norm(p, l, 0);
        GSYNC();
        for (int r = 0; r < REP_INPROJ; ++r) phase_inproj(p, l, lds);
        GSYNC();
        for (int r = 0; r < REP_PREP1; ++r) phase_prep1(p, l);
        GSYNC();
        for (int r = 0; r < REP_SMALL; ++r) phase_small(p, l, lds);
        GSYNC();
        phase_prep2(p, l);
        GSYNC();
        for (int r = 0; r < REP_ATTN; ++r) phase_attn(p, l, lds);
        GSYNC();
        for (int r = 0; r < REP_FIN; ++r) phase_lru_fin(p, lds);
        GSYNC();
        phase_outproj(p, l, lds);
        GSYNC();
        phase_router(p, l, lds);
        GSYNC();
        for (int r = 0; r < REP_MOE1; ++r) phase_moe1(p, l, lds);
        GSYNC();
        for (int r = 0; r < REP_MOE2; ++r) phase_moe2(p, l, lds);
        GSYNC();
        phase_combine(p, l, lds, l == NLAYER - 1);
        GSYNC();
    }
}

extern "C" void kernel_launch(void* const* d_in, const int* in_sizes, int n_in, void* d_out, int out_size, void* d_ws, size_t ws_size, hipStream_t stream) {
    static int grid_blocks = 0;
    if (!grid_blocks) {
        int dev = 0, cus = 0, per_cu = 0;
        (void)hipGetDevice(&dev);
        (void)hipDeviceGetAttribute(&cus, hipDeviceAttributeMultiprocessorCount, dev);
        if (hipFuncSetAttribute((const void*)fwd_kernel, hipFuncAttributeMaxDynamicSharedMemorySize, LDS_BYTES) != hipSuccess) fprintf(stderr, "kernel_launch: hipFuncSetAttribute failed\n");
        if (hipOccupancyMaxActiveBlocksPerMultiprocessor(&per_cu, fwd_kernel, NTHR, LDS_BYTES) != hipSuccess || per_cu < 1) { fprintf(stderr, "kernel_launch: occupancy query says %d\n", per_cu); per_cu = 1; }
        if (per_cu > 1) per_cu = 1;
        grid_blocks = cus * per_cu;
        if (ws_size < W_END * sizeof(float)) fprintf(stderr, "kernel_launch: workspace too small: %zu < %zu\n", ws_size, W_END * sizeof(float));
        if (n_in != N_IN) fprintf(stderr, "kernel_launch: n_in %d != %d\n", n_in, (int)N_IN);
    }
    Params p{};
    for (int i = 0; i < N_IN; ++i) p.in[i] = (const float*)d_in[i];
    p.out = (float*)d_out;
    p.ws = (float*)d_ws;
    void* args[] = {&p};
    hipError_t e = hipLaunchCooperativeKernel((void*)fwd_kernel, dim3(grid_blocks), dim3(NTHR), args, LDS_BYTES, stream);
    if (e != hipSuccess) fprintf(stderr, "cooperative launch failed: %s (grid %d)\n", hipGetErrorString(e), grid_blocks);
}
```

```cpp
#include <hip/hip_runtime.h>
#include <hip/hip_cooperative_groups.h>
#include <cstdio>
#include <cstdint>
namespace cg = cooperative_groups;

#define DEVI __device__ __forceinline__
constexpr int NTHR = 512;
constexpr int D = 1024, NLAT = 16384, NCTX = 256, T = NLAT + NCTX, NLAYER = 2;
constexpr int INC = 1632;
constexpr int OFF_A = 0, OFF_Q = 256, OFF_KV = 448, OFF_KR = 576, OFF_C = 608, OFF_DX = 1120, OFF_DG = 1376;
constexpr int NCHUNK = T / 128;
constexpr int NEXP = 32, TOPK = 4;
constexpr int MAXROWS = T * TOPK + NEXP * 256;
constexpr float EPS = 1e-6f;

enum { I_X = 0, I_C, I_CTX, I_CCTX, I_WMOD, I_BMOD, I_NMIX, I_NFFN, I_WIN, I_WOUT, I_POOLW, I_POOLS, I_QAN, I_WUQ, I_KVAN, I_WUKV,
       I_QN, I_KN, I_SGG, I_SGB, I_SGWS, I_SGBS, I_CONVW, I_CONVB, I_WA, I_BA, I_WX, I_BX, I_LAM, I_RW, I_RB, I_WGU, I_BGU, I_WDN, I_BDN, N_IN };

constexpr size_t al(size_t x) { return (x + 63) / 64 * 64; }
constexpr size_t W_X = 0;
constexpr size_t W_MOD = W_X + al((size_t)T * D);
constexpr size_t W_P = W_MOD + al(2 * 2 * 6144);
constexpr size_t W_YC = W_P + al((size_t)T * INC);
constexpr size_t W_Q = W_YC + al((size_t)T * D);
constexpr size_t W_K = W_Q + al((size_t)T * 384);
constexpr size_t W_V = W_K + al((size_t)T * 384);
constexpr size_t W_DIFF = W_V + al((size_t)T * 256);
constexpr size_t W_QN = W_DIFF + al((size_t)T * 256);
constexpr size_t W_KVN = W_QN + al((size_t)T * 192);
constexpr size_t W_U = W_KVN + al((size_t)T * 128);
constexpr size_t W_VN = W_U + al((size_t)T * 256);
constexpr size_t W_XC = W_VN + al((size_t)T * 256);
constexpr size_t W_QUP = W_XC + al((size_t)T * 256);
constexpr size_t W_KVUP = W_QUP + al((size_t)T * 384);
constexpr size_t W_LA = W_KVUP + al((size_t)T * 512);
constexpr size_t W_LB = W_LA + al((size_t)2 * T * 256);
constexpr size_t W_AGG = W_LB + al((size_t)2 * T * 256);
constexpr size_t W_CARRY = W_AGG + al((size_t)NCHUNK * 2 * 2 * 256);
constexpr size_t W_TOPE = W_CARRY + al((size_t)NCHUNK * 2 * 256);
constexpr size_t W_TOPG = W_TOPE + al((size_t)T * 4);
constexpr size_t W_TOPI = W_TOPG + al((size_t)T * 4);
constexpr size_t W_CNT = W_TOPI + al((size_t)T * 4);
constexpr size_t W_ACT = W_CNT + al(128);
constexpr size_t W_YR = W_ACT + al((size_t)MAXROWS * D / 2);
constexpr size_t W_XS = W_YR + al((size_t)MAXROWS * D / 2);
constexpr size_t W_HB = W_XS + al((size_t)MAXROWS * D / 2);
constexpr size_t W_XCB = W_HB + al((size_t)T * D / 2);
constexpr size_t W_WSB = W_XCB + al((size_t)T * 256 / 2);
constexpr size_t W_BAR = W_WSB + al((size_t)NLAYER * 4 * 128 * 128 / 2);
constexpr size_t W_ROPE = W_BAR + al(4096);
constexpr int NPAD_IN = 1792;
constexpr size_t W_WIN = W_ROPE + al((size_t)NLAT * 32);
constexpr size_t W_WOUT = W_WIN + al((size_t)NLAYER * NPAD_IN * D / 2);
constexpr size_t W_WGU = W_WOUT + al((size_t)NLAYER * D * D / 2);
constexpr size_t W_WDN = W_WGU + al((size_t)NLAYER * NEXP * 2048 * D / 2);
constexpr size_t W_END = W_WDN + al((size_t)NLAYER * NEXP * D * D / 2);

struct Params {
    const float* in[N_IN];
    float* out;
    float* ws;
};

DEVI int tid_() { int t = threadIdx.x; asm volatile("" : "+v"(t)); return t; }
DEVI int bid_() { int b = blockIdx.x; asm volatile("" : "+s"(b)); return b; }
DEVI float wave_sum(float v) {
#pragma unroll
    for (int o = 32; o > 0; o >>= 1) v += __shfl_xor(v, o);
    return v;
}
DEVI float gelu_tanh(float x) { const float u = 0.7978845608028654f * (x + 0.044715f * x * x * x); return 0.5f * x * (1.f + tanhf(u)); }
DEVI float sigm(float x) { return 1.f / (1.f + expf(-x)); }
DEVI float silu(float x) { return x * sigm(x); }


typedef unsigned short bf16_t;
typedef short bf16x8 __attribute__((ext_vector_type(8)));
typedef float f32x4 __attribute__((ext_vector_type(4)));
typedef unsigned u32x4 __attribute__((ext_vector_type(4)));
typedef unsigned u32x2 __attribute__((ext_vector_type(2)));
DEVI unsigned cvt_pk_bf16(float lo, float hi) { unsigned r; asm volatile("v_cvt_pk_bf16_f32 %0, %1, %2" : "=v"(r) : "v"(lo), "v"(hi)); return r; }
DEVI bf16_t f2bf(float f) { return (bf16_t)(cvt_pk_bf16(f, 0.f) & 0xffffu); }
DEVI float bf2f(bf16_t b) { return __uint_as_float(((unsigned)b) << 16); }

constexpr int G_STAGE = 49152;
constexpr int G_LDS = 2 * G_STAGE;
DEVI int swz(int row, int chunk) { return row * 128 + ((chunk ^ ((row >> 1) & 7)) << 4); }

template <bool PAIRED, class ARow, class Epi>
DEVI void gemm_unit(char* lds, int K, ARow arow, const float* __restrict__ B0, const float* __restrict__ B1, int ldb, int ncol_valid, Epi epi) {
    const int tid = tid_(), wave = tid >> 6, lane = tid & 63, fr = lane & 15, fq = lane >> 4, wr = wave >> 1, wc = wave & 1;
    const int ac = tid & 7;
    const bf16_t* ap[4]; int a_lds[4];
#pragma unroll
    for (int i = 0; i < 4; ++i) { const int r = (tid >> 3) + 64 * i; ap[i] = arow(r) + ac * 8; a_lds[i] = swz(r, ac); }
    const int kq = lane & 15, nq = (lane >> 4) + 4 * wave;
    const float* bp;
    if (PAIRED) { const int seg = (nq >> 2) & 1, idx = (nq >> 3) * 16 + (nq & 3) * 4; bp = (seg ? B1 : B0) + idx; }
    else { const int c4 = 4 * nq < ncol_valid ? 4 * nq : ncol_valid - 4; bp = B0 + c4; }
    bp += (size_t)(4 * kq) * ldb;
    int b_lds[4];
#pragma unroll
    for (int i = 0; i < 4; ++i) b_lds[i] = 32768 + swz(4 * nq + i, kq >> 1) + (kq & 1) * 8;
    const int sx = (fr >> 1) & 7;
    const int aoff0 = (wr * 64 + fr) * 128 + ((fq ^ sx) << 4), aoff1 = (wr * 64 + fr) * 128 + (((4 + fq) ^ sx) << 4);
    const int boff0 = 32768 + (wc * 64 + fr) * 128 + ((fq ^ sx) << 4), boff1 = 32768 + (wc * 64 + fr) * 128 + (((4 + fq) ^ sx) << 4);
    u32x4 av0[4], av1[4]; f32x4 bv0[4], bv1[4];
#define G_LOAD(av, bv, t) do { _Pragma("unroll") for (int i = 0; i < 4; ++i) av[i] = *(const u32x4*)(ap[i] + (t) * 64); \
        _Pragma("unroll") for (int kk = 0; kk < 4; ++kk) bv[kk] = *(const f32x4*)(bp + ((size_t)(t) * 64 + kk) * ldb); } while (0)
#define G_WRITE(s_, av, bv) do { _Pragma("unroll") for (int i = 0; i < 4; ++i) *(u32x4*)((s_) + a_lds[i]) = av[i]; \
        _Pragma("unroll") for (int i = 0; i < 4; ++i) { u32x2 w_; w_.x = cvt_pk_bf16(bv[0][i], bv[1][i]); w_.y = cvt_pk_bf16(bv[2][i], bv[3][i]); *(u32x2*)((s_) + b_lds[i]) = w_; } } while (0)
#define G_MMA(Af, Bf) do { __builtin_amdgcn_s_setprio(1); _Pragma("unroll") for (int m = 0; m < 4; ++m) _Pragma("unroll") for (int n = 0; n < 4; ++n) \
        acc[m][n] = __builtin_amdgcn_mfma_f32_16x16x32_bf16(Bf[n], Af[m], acc[m][n], 0, 0, 0); __builtin_amdgcn_s_setprio(0); } while (0)
#define G_SB() __builtin_amdgcn_sched_barrier(0)
#define G_ITER(t, c_, n_, av, bv, W_, L_) do { \
        bf16x8 Af[4], Bf[4]; \
        _Pragma("unroll") for (int m = 0; m < 4; ++m) Af[m] = *(const bf16x8*)((c_) + aoff0 + m * 2048); \
        _Pragma("unroll") for (int n = 0; n < 4; ++n) Bf[n] = *(const bf16x8*)((c_) + boff0 + n * 2048); \
        G_SB(); asm volatile("s_waitcnt lgkmcnt(0)" ::: "memory"); G_SB(); \
        G_MMA(Af, Bf); G_SB(); \
        _Pragma("unroll") for (int m = 0; m < 4; ++m) Af[m] = *(const bf16x8*)((c_) + aoff1 + m * 2048); \
        _Pragma("unroll") for (int n = 0; n < 4; ++n) Bf[n] = *(const bf16x8*)((c_) + boff1 + n * 2048); \
        G_SB(); \
        if (W_) { G_WRITE(n_, av, bv); G_SB(); asm volatile("s_waitcnt lgkmcnt(8)" ::: "memory"); } else { asm volatile("s_waitcnt lgkmcnt(0)" ::: "memory"); } \
        G_SB(); \
        G_MMA(Af, Bf); G_SB(); \
        if (L_) G_LOAD(av, bv, (t) + 3); \
        G_SB(); asm volatile("s_waitcnt lgkmcnt(0)" ::: "memory"); __builtin_amdgcn_s_barrier(); G_SB(); } while (0)
    f32x4 acc[4][4];
#pragma unroll
    for (int m = 0; m < 4; ++m)
#pragma unroll
        for (int n = 0; n < 4; ++n) acc[m][n] = (f32x4){0.f, 0.f, 0.f, 0.f};
    const int nk = K >> 6;
    char* L0 = lds; char* L1 = lds + G_STAGE;
    G_LOAD(av0, bv0, 0);
    G_WRITE(L0, av0, bv0);
    if (nk > 1) G_LOAD(av1, bv1, 1);
    if (nk > 2) G_LOAD(av0, bv0, 2);
    asm volatile("s_waitcnt lgkmcnt(0)" ::: "memory"); __builtin_amdgcn_s_barrier(); G_SB();
    int t = 0;
    for (; t + 4 < nk; t += 2) {
        G_ITER(t, L0, L1, av1, bv1, true, true);
        G_ITER(t + 1, L1, L0, av0, bv0, true, true);
    }
    for (; t < nk; t += 2) {
        G_ITER(t, L0, L1, av1, bv1, t + 1 < nk, t + 3 < nk);
        if (t + 1 < nk) G_ITER(t + 1, L1, L0, av0, bv0, t + 2 < nk, t + 4 < nk);
    }
#undef G_LOAD
#undef G_WRITE
#undef G_MMA
#undef G_ITER
#undef G_SB
    epi(acc, wr, wc, fr, fq);
}


#define PG8_LAS __attribute__((address_space(3)))
namespace pg8 {
constexpr int BM = 256, BK = 64, HALF = 128, HTB = HALF * BK * 2, STAGE_BYTES = 8 * HTB;
DEVI int lds_byte(int r, int c) { const int st = (r >> 4) * 2 + (c >> 5), rr = r & 15, cc = c & 31, ob = rr * 64 + cc * 2; return st * 1024 + (ob ^ (((ob >> 9) & 1) << 5)); }
DEVI void stage_rc(int b, int& R, int& C) { const int st = b / 1024, sb = b % 1024, swz_ = sb ^ (((sb >> 9) & 1) << 5); R = (st >> 1) * 16 + swz_ / 64; C = (st & 1) * 32 + (swz_ % 64) / 2; }
DEVI int perm32(int rho) { const int n = rho >> 4, i = rho & 15; return 8 * (i >> 2) + 4 * n + (i & 3); }
struct Unit { const char* a; const char* b; int x0, x1, x2; };
template <class Epi, class Sched>
DEVI void gemm_phase(PG8_LAS unsigned char* lds, int K, size_t hstepB, const Sched& S, const Epi& E) {
    const int tid = tid_(), wid = __builtin_amdgcn_readfirstlane(tid >> 6), lane = tid & 63, wr = wid >> 2, wc = wid & 3, fr = lane & 15, fq = lane >> 4;
    const int nt = K / BK;
    unsigned voffA[2], voffB[2];
#pragma unroll
    for (int i = 0; i < 2; ++i) { int R, C; stage_rc(tid * 16 + i * 8192, R, C); const int Rb = Epi::PERM ? ((R & ~31) + perm32(R & 31)) : R;
        voffA[i] = (unsigned)(R * K + C) * 2u; voffB[i] = (unsigned)(Rb * K + C) * 2u; }
    const size_t kstep = (size_t)(BK * 2);
    const size_t hstep = (size_t)HALF * K * 2;
    const unsigned ldsw = (unsigned)wid * 1024u;
    const int aoff = lds_byte(wr * 64 + fr, fq * 8), boff = lds_byte(wc * 32 + fr, fq * 8);
#define PG8_SA(b, h) (((b) * 2 + (h)) * HTB)
#define PG8_SB(b, h) ((4 + (b) * 2 + (h)) * HTB)
#define PG8_STAGE(bufoff, gbase, voff) do { _Pragma("unroll") for (int _i = 0; _i < 2; ++_i) \
        __builtin_amdgcn_global_load_lds((const unsigned*)((const char*)(gbase) + (voff)[_i]), (PG8_LAS unsigned*)(lds + (bufoff) + ldsw + _i * 8192), 16, 0, 0); } while (0)
#define PG8_LDA(dst, b, h) do { _Pragma("unroll") for (int m = 0; m < 4; ++m) _Pragma("unroll") for (int k = 0; k < 2; ++k) dst[m][k] = *(const PG8_LAS bf16x8*)(lds + PG8_SA(b, h) + aoff + m * 2048 + k * 1024); } while (0)
#define PG8_LDB(dst, b, h) do { _Pragma("unroll") for (int n = 0; n < 2; ++n) _Pragma("unroll") for (int k = 0; k < 2; ++k) dst[n][k] = *(const PG8_LAS bf16x8*)(lds + PG8_SB(b, h) + boff + n * 2048 + k * 1024); } while (0)
#define PG8_MMA(ai, bj, At, Bt) do { __builtin_amdgcn_s_setprio(1); _Pragma("unroll") for (int m = 0; m < 4; ++m) _Pragma("unroll") for (int n = 0; n < 2; ++n) _Pragma("unroll") for (int k = 0; k < 2; ++k) \
        acc[ai][bj][m][n] = __builtin_amdgcn_mfma_f32_16x16x32_bf16(Bt[n][k], At[m][k], acc[ai][bj][m][n], 0, 0, 0); __builtin_amdgcn_s_setprio(0); } while (0)
#define PG8_WAIT_V(n) asm volatile("s_waitcnt vmcnt(" #n ")" ::: "memory")
#define PG8_WAIT_L(n) asm volatile("s_waitcnt lgkmcnt(" #n ")" ::: "memory")
#define PG8_BAR __builtin_amdgcn_s_barrier()
#define PG8_SCHED __builtin_amdgcn_sched_barrier(0)
    Unit cur, nxt; int ui = 0;
    if (!S.next(0, cur)) return;
    f32x4 acc[2][2][4][2];
#pragma unroll
    for (int a = 0; a < 2; ++a)
#pragma unroll
        for (int b = 0; b < 2; ++b)
#pragma unroll
            for (int m = 0; m < 4; ++m)
#pragma unroll
                for (int n = 0; n < 2; ++n) acc[a][b][m][n] = (f32x4){0.f, 0.f, 0.f, 0.f};
    bf16x8 At[4][2], B0[2][2], B1[2][2];
    const char* cA = cur.a; const char* cB = cur.b;
    PG8_STAGE(PG8_SB(0, 0), cB, voffB); PG8_STAGE(PG8_SA(0, 0), cA, voffA); PG8_STAGE(PG8_SB(0, 1), cB + hstepB, voffB); PG8_STAGE(PG8_SA(0, 1), cA + hstep, voffA);
    if (wr == 1) PG8_BAR;
    PG8_WAIT_V(4); PG8_BAR;
    PG8_STAGE(PG8_SB(1, 0), cB + kstep, voffB); PG8_STAGE(PG8_SA(1, 0), cA + kstep, voffA); PG8_STAGE(PG8_SB(1, 1), cB + hstepB + kstep, voffB);
    PG8_WAIT_V(6); PG8_BAR;
    for (;;) {
        const bool has_next = S.next(ui + 1, nxt);
        const char* nA = has_next ? nxt.a : cA; const char* nB = has_next ? nxt.b : cB;
        for (int t = 0; t < nt; t += 2) {
            const bool last = (t == nt - 2);
            const char* a1 = cA + (size_t)(t + 1) * kstep;
            const char* a2 = last ? nA : cA + (size_t)(t + 2) * kstep; const char* b2 = last ? nB : cB + (size_t)(t + 2) * kstep;
            const char* a3 = a2 + kstep; const char* b3 = b2 + kstep;
            PG8_LDB(B0, 0, 0); PG8_SCHED; PG8_LDA(At, 0, 0); PG8_STAGE(PG8_SA(1, 1), a1 + hstep, voffA);
            PG8_WAIT_L(8); PG8_BAR; PG8_WAIT_L(0); PG8_MMA(0, 0, At, B0); PG8_BAR; PG8_SCHED;
            PG8_LDB(B1, 0, 1); PG8_STAGE(PG8_SB(0, 0), b2, voffB);
            PG8_BAR; PG8_WAIT_L(0); PG8_MMA(0, 1, At, B1); PG8_BAR;
            PG8_LDA(At, 0, 1); PG8_STAGE(PG8_SA(0, 0), a2, voffA);
            PG8_BAR; PG8_WAIT_L(0); PG8_MMA(1, 0, At, B0); PG8_BAR; PG8_SCHED;
            PG8_STAGE(PG8_SB(0, 1), b2 + hstepB, voffB);
            PG8_WAIT_V(6); PG8_BAR; PG8_MMA(1, 1, At, B1); PG8_BAR;
            PG8_LDB(B0, 1, 0); PG8_SCHED; PG8_LDA(At, 1, 0); PG8_STAGE(PG8_SA(0, 1), a2 + hstep, voffA);
            PG8_WAIT_L(8); PG8_BAR; PG8_WAIT_L(0); PG8_MMA(0, 0, At, B0); PG8_BAR; PG8_SCHED;
            PG8_LDB(B1, 1, 1); PG8_STAGE(PG8_SB(1, 0), b3, voffB);
            PG8_BAR; PG8_WAIT_L(0); PG8_MMA(0, 1, At, B1); PG8_BAR;
            PG8_LDA(At, 1, 1); PG8_STAGE(PG8_SA(1, 0), a3, voffA);
            PG8_BAR; PG8_WAIT_L(0); PG8_MMA(1, 0, At, B0); PG8_BAR; PG8_SCHED;
            PG8_STAGE(PG8_SB(1, 1), b3 + hstepB, voffB);
            PG8_WAIT_V(6); PG8_BAR; PG8_MMA(1, 1, At, B1); PG8_BAR;
        }
        E(acc, cur, wr, wc, fr, fq);
        if (!has_next) break;
#pragma unroll
        for (int a = 0; a < 2; ++a)
#pragma unroll
            for (int b = 0; b < 2; ++b)
#pragma unroll
                for (int m = 0; m < 4; ++m)
#pragma unroll
                    for (int n = 0; n < 2; ++n) acc[a][b][m][n] = (f32x4){0.f, 0.f, 0.f, 0.f};
        cur = nxt; cA = nA; cB = nB; ++ui;
    }
    PG8_WAIT_V(0);
    if (wr == 0) PG8_BAR;
    PG8_BAR;
#undef PG8_SA
#undef PG8_SB
#undef PG8_STAGE
#undef PG8_LDA
#undef PG8_LDB
#undef PG8_MMA
#undef PG8_WAIT_V
#undef PG8_WAIT_L
#undef PG8_BAR
#undef PG8_SCHED
}
}

DEVI void conv_item(const float* __restrict__ W, int K, int N, bf16_t* __restrict__ Wt, int kb, int nb, int lane) {
    const int ko = lane & 7, nq = lane >> 3;
    const float* src = W + (size_t)(kb * 64 + ko * 8) * N + nb * 32 + nq * 4;
    f32x4 v[8];
#pragma unroll
    for (int kk = 0; kk < 8; ++kk) v[kk] = *(const f32x4*)(src + (size_t)kk * N);
    bf16_t* dst = Wt + (size_t)(nb * 32 + nq * 4) * K + kb * 64 + ko * 8;
#pragma unroll
    for (int i = 0; i < 4; ++i) { u32x4 o; o.x = cvt_pk_bf16(v[0][i], v[1][i]); o.y = cvt_pk_bf16(v[2][i], v[3][i]); o.z = cvt_pk_bf16(v[4][i], v[5][i]); o.w = cvt_pk_bf16(v[6][i], v[7][i]);
        *(u32x4*)(dst + (size_t)i * K) = o; }
}

namespace att {
typedef short s16x4 __attribute__((ext_vector_type(4)));
typedef float f32x16 __attribute__((ext_vector_type(16)));
constexpr int KVBLK = 64;
constexpr float SCALE = 0.10206207261596577f;
constexpr float THR = 8.f;
constexpr int SHM_V = 16384, SHM_K = 16384, SHM_ATTN = 2 * SHM_V + 2 * SHM_K + 8 * 64 * 4;
#define KSWZ(row, colB) ((row) * 256 + ((colB) ^ (((row) & 7) << 4)))
#define SBAR() __builtin_amdgcn_sched_barrier(0)
DEVI int crow(int r, int hi) { return (r & 3) + 8 * (r >> 2) + 4 * hi; }
DEVI void partialSM(f32x16& p0, f32x16& p1, float& m_reg, float& mn, float& alpha) {
    constexpr float C = SCALE * 1.4426950408889634f;
    float pmax = p0[0];
#pragma unroll
    for (int r = 1; r < 16; ++r) pmax = fmaxf(pmax, p0[r]);
#pragma unroll
    for (int r = 0; r < 16; ++r) pmax = fmaxf(pmax, p1[r]);
    { auto rr = __builtin_amdgcn_permlane32_swap(__float_as_uint(pmax), __float_as_uint(pmax), false, false);
      pmax = fmaxf(__uint_as_float(rr[0]), __uint_as_float(rr[1])); }
    if (__builtin_expect(__all(pmax - m_reg <= THR / SCALE), 1)) { mn = m_reg; alpha = 1.f; }
    else { mn = fmaxf(m_reg, pmax); alpha = __builtin_amdgcn_exp2f((m_reg - mn) * C); m_reg = mn; }
    const float mnC = -mn * C;
#pragma unroll
    for (int r = 0; r < 16; ++r) p0[r] = fmaf(p0[r], C, mnC);
#pragma unroll
    for (int r = 0; r < 16; ++r) p1[r] = fmaf(p1[r], C, mnC);
#pragma unroll
    for (int r = 0; r < 16; ++r) p0[r] = __builtin_amdgcn_exp2f(p0[r]);
}
DEVI void finishSM(f32x16& p0, f32x16& p1, float alpha, float& l_reg, bf16x8& pa0, bf16x8& pa1, bf16x8& pa2, bf16x8& pa3) {
#pragma unroll
    for (int r = 0; r < 16; ++r) p1[r] = __builtin_amdgcn_exp2f(p1[r]);
    float ps = 0.f;
#pragma unroll
    for (int r = 0; r < 16; ++r) ps += p0[r];
#pragma unroll
    for (int r = 0; r < 16; ++r) ps += p1[r];
    { auto rr = __builtin_amdgcn_permlane32_swap(__float_as_uint(ps), __float_as_uint(ps), false, false);
      ps = __uint_as_float(rr[0]) + __uint_as_float(rr[1]); }
    l_reg = l_reg * alpha + ps;
#define PK4(P, BASE, OUT) do { unsigned a0 = cvt_pk_bf16(P[BASE + 0], P[BASE + 1]), a1 = cvt_pk_bf16(P[BASE + 2], P[BASE + 3]);   \
    unsigned b0 = cvt_pk_bf16(P[BASE + 4], P[BASE + 5]), b1 = cvt_pk_bf16(P[BASE + 6], P[BASE + 7]);                              \
    auto r0 = __builtin_amdgcn_permlane32_swap(a0, b0, false, false); auto r1 = __builtin_amdgcn_permlane32_swap(a1, b1, false, false); \
    u32x4 w = {r0[0], r1[0], r0[1], r1[1]}; OUT = *reinterpret_cast<bf16x8*>(&w); } while (0)
    PK4(p0, 0, pa0); PK4(p0, 8, pa1); PK4(p1, 0, pa2); PK4(p1, 8, pa3);
#undef PK4
}
DEVI void qkt(f32x16& p0, f32x16& p1, const char* Ks, const bf16x8* qr, int r32, int hi) {
    p0 = f32x16{}; p1 = f32x16{};
#pragma unroll
    for (int d0 = 0; d0 < 6; ++d0) { const int cb = (d0 * 16 + hi * 8) * 2;
        const bf16x8 b0 = *reinterpret_cast<const bf16x8*>(Ks + KSWZ(r32, cb));
        const bf16x8 b1 = *reinterpret_cast<const bf16x8*>(Ks + KSWZ(32 + r32, cb));
        p0 = __builtin_amdgcn_mfma_f32_32x32x16_bf16(b0, qr[d0], p0, 0, 0, 0);
        p1 = __builtin_amdgcn_mfma_f32_32x32x16_bf16(b1, qr[d0], p1, 0, 0, 0); }
}
DEVI int v_st(int k, int c) { const int kk = (k & ~0xC) | ((k & 4) << 1) | ((k & 8) >> 1); return ((kk >> 3) * 4 + (c >> 5)) * 512 + ((kk & 7) * 32 + (c & 31)) * 2; }
DEVI int v_rd_base(int lane) { return ((lane & 3) << 3) | (((lane >> 2) & 3) << 6) | (((lane >> 4) & 1) << 5) | (((lane >> 5) & 1) << 8); }
constexpr int v_rd_off(int d0, int ks, int half) { return d0 * 512 + ks * 4096 + half * 2048; }
template <int OFF> DEVI s16x4 tr_read(int vb) {
    s16x4 r; asm volatile("ds_read_b64_tr_b16 %0, %1 offset:%2" : "=&v"(r) : "v"(vb), "i"(OFF) : "memory"); return r;
}
template <int D0> DEVI void pv_one(f32x16& od, int vb, bf16x8 pa0, bf16x8 pa1, bf16x8 pa2, bf16x8 pa3) {
    const s16x4 l0 = tr_read<v_rd_off(D0, 0, 0)>(vb), h0 = tr_read<v_rd_off(D0, 0, 1)>(vb), l1 = tr_read<v_rd_off(D0, 1, 0)>(vb), h1 = tr_read<v_rd_off(D0, 1, 1)>(vb);
    const s16x4 l2 = tr_read<v_rd_off(D0, 2, 0)>(vb), h2 = tr_read<v_rd_off(D0, 2, 1)>(vb), l3 = tr_read<v_rd_off(D0, 3, 0)>(vb), h3 = tr_read<v_rd_off(D0, 3, 1)>(vb);
    asm volatile("s_waitcnt lgkmcnt(0)" ::: "memory"); SBAR();
#define PKV(L, H) (bf16x8){L[0], L[1], L[2], L[3], H[0], H[1], H[2], H[3]}
    od = __builtin_amdgcn_mfma_f32_32x32x16_bf16(pa0, PKV(l0, h0), od, 0, 0, 0);
    od = __builtin_amdgcn_mfma_f32_32x32x16_bf16(pa1, PKV(l1, h1), od, 0, 0, 0);
    od = __builtin_amdgcn_mfma_f32_32x32x16_bf16(pa2, PKV(l2, h2), od, 0, 0, 0);
    od = __builtin_amdgcn_mfma_f32_32x32x16_bf16(pa3, PKV(l3, h3), od, 0, 0, 0);
#undef PKV
}
DEVI void pv_d0(f32x16* o, int vb, bf16x8 pa0, bf16x8 pa1, bf16x8 pa2, bf16x8 pa3) {
    pv_one<0>(o[0], vb, pa0, pa1, pa2, pa3); pv_one<1>(o[1], vb, pa0, pa1, pa2, pa3);
}
DEVI void attn_unit(const bf16_t* __restrict__ Qb, const bf16_t* __restrict__ Kh, const bf16_t* __restrict__ Vh, int seq, bf16_t* __restrict__ Ob, int ldo, char* lds) {
    const int tid = tid_(), wid = tid >> 6, lane = tid & 63, r32 = lane & 31, hi = lane >> 5;
    char* V_lds = lds; char* K_lds = lds + 2 * SHM_V;
    float* wsl = (float*)(lds + 2 * SHM_V + 2 * SHM_K) + wid * 64; float* li_l = wsl; float* al_l = wsl + 32;
    float m_reg = -1e30f, l_reg = 0.f; f32x16 o[2] = {}; bf16x8 qr[6];
    const bf16_t* Qw = Qb + (size_t)(wid * 32 + r32) * 96 + hi * 8;
#pragma unroll
    for (int d0 = 0; d0 < 6; ++d0) qr[d0] = *reinterpret_cast<const bf16x8*>(Qw + d0 * 16);
    const int sr = tid >> 4, kc = tid & 15, kcl = (kc < 12 ? kc : 11) * 8;
    const int vr = tid >> 3, vc = (tid & 7) * 8, vst0 = v_st(vr, vc);
    const int kst0 = KSWZ(sr, kc * 16), kst1 = KSWZ(32 + sr, kc * 16);
    const int vb0 = (int)(uintptr_t)V_lds + v_rd_base(lane);
    bf16x8 sv0, sk00, sk01, sv1, sk10, sk11;
#define SLOAD0(k0) do { sv0 = *reinterpret_cast<const bf16x8*>(Vh + (size_t)((k0) + vr) * 64 + vc); sk00 = *reinterpret_cast<const bf16x8*>(Kh + (size_t)((k0) + sr) * 96 + kcl); \
    sk01 = *reinterpret_cast<const bf16x8*>(Kh + (size_t)((k0) + 32 + sr) * 96 + kcl); } while (0)
#define SLOAD1(k0) do { sv1 = *reinterpret_cast<const bf16x8*>(Vh + (size_t)((k0) + vr) * 64 + vc); sk10 = *reinterpret_cast<const bf16x8*>(Kh + (size_t)((k0) + sr) * 96 + kcl); \
    sk11 = *reinterpret_cast<const bf16x8*>(Kh + (size_t)((k0) + 32 + sr) * 96 + kcl); } while (0)
#define SWRITE0(b) do { *(bf16x8*)(V_lds + (b) * SHM_V + vst0) = sv0; *(bf16x8*)(K_lds + (b) * SHM_K + kst0) = sk00; *(bf16x8*)(K_lds + (b) * SHM_K + kst1) = sk01; } while (0)
#define SWRITE1(b) do { *(bf16x8*)(V_lds + (b) * SHM_V + vst0) = sv1; *(bf16x8*)(K_lds + (b) * SHM_K + kst0) = sk10; *(bf16x8*)(K_lds + (b) * SHM_K + kst1) = sk11; } while (0)
#define SWAIT() asm volatile("s_waitcnt vmcnt(3)" ::: "memory")
#define RESC(a) do { if (__any((a) < 1.f)) { if (hi == 0) al_l[r32] = (a); asm volatile("s_waitcnt lgkmcnt(0)" ::: "memory"); \
    _Pragma("unroll") for (int d = 0; d < 2; ++d) _Pragma("unroll") for (int r = 0; r < 16; ++r) o[d][r] *= al_l[crow(r, hi)]; } } while (0)
    f32x16 pA0, pA1, pB0, pB1; float mnA, mnB, alA, alB; bf16x8 pa0, pa1, pa2, pa3; const int NT = seq / KVBLK;
    SLOAD0(0); asm volatile("s_waitcnt vmcnt(0)" ::: "memory"); SWRITE0(0); __syncthreads();
    qkt(pA0, pA1, K_lds, qr, r32, hi); partialSM(pA0, pA1, m_reg, mnA, alA);
    SLOAD1(KVBLK); if (2 < NT) SLOAD0(2 * KVBLK);
    SWAIT(); SWRITE1(1); __syncthreads();
    for (int j = 1; j + 1 < NT; j += 2) {
        SBAR(); qkt(pB0, pB1, K_lds + SHM_K, qr, r32, hi);
        finishSM(pA0, pA1, alA, l_reg, pa0, pa1, pa2, pa3); SBAR();
        SLOAD1((j + 2) * KVBLK); SBAR();
        pv_d0(o, vb0, pa0, pa1, pa2, pa3); partialSM(pB0, pB1, m_reg, mnB, alB);
        __syncthreads(); SWAIT(); SWRITE0(0);
        RESC(alB); __syncthreads();
        SBAR(); qkt(pA0, pA1, K_lds, qr, r32, hi);
        finishSM(pB0, pB1, alB, l_reg, pa0, pa1, pa2, pa3); SBAR();
        if (j + 3 < NT) SLOAD0((j + 3) * KVBLK); SBAR();
        pv_d0(o, vb0 + SHM_V, pa0, pa1, pa2, pa3); partialSM(pA0, pA1, m_reg, mnA, alA);
        __syncthreads(); SWAIT(); SWRITE1(1);
        RESC(alA); __syncthreads();
    }
    SBAR(); qkt(pB0, pB1, K_lds + SHM_K, qr, r32, hi);
    finishSM(pA0, pA1, alA, l_reg, pa0, pa1, pa2, pa3); SBAR();
    pv_d0(o, vb0, pa0, pa1, pa2, pa3); partialSM(pB0, pB1, m_reg, mnB, alB);
    __syncthreads(); RESC(alB);
    finishSM(pB0, pB1, alB, l_reg, pa0, pa1, pa2, pa3); SBAR();
    pv_d0(o, vb0 + SHM_V, pa0, pa1, pa2, pa3);
    if (hi == 0) li_l[r32] = l_reg; asm volatile("s_waitcnt lgkmcnt(0)" ::: "memory");
    float rli[16];
#pragma unroll
    for (int r = 0; r < 16; ++r) rli[r] = __builtin_amdgcn_rcpf(li_l[crow(r, hi)]);
    bf16_t* Ow = Ob + (size_t)(wid * 32) * ldo;
#pragma unroll
    for (int r = 0; r < 16; ++r) { const int orow = crow(r, hi);
#pragma unroll
        for (int d0 = 0; d0 < 2; ++d0) Ow[(size_t)orow * ldo + d0 * 32 + r32] = f2bf(o[d0][r] * rli[r]); }
    __syncthreads();
#undef SLOAD0
#undef SLOAD1
#undef SWRITE0
#undef SWRITE1
#undef SWAIT
#undef RESC
}
#undef KSWZ
#undef SBAR
}

template <class ARow, class BMap, class Epi>
DEVI void gemm_tile(int K, ARow arow, const float* __restrict__ B, int ldb, BMap bmap, Epi epi, float* smem) {
    float (*As)[132] = (float (*)[132])smem;
    float (*Bs)[64] = (float (*)[64])(smem + 16 * 132);
    const int tid = tid_(), ty = tid >> 4, tx = tid & 15;
    float acc[4][4];
#pragma unroll
    for (int i = 0; i < 4; ++i)
#pragma unroll
        for (int j = 0; j < 4; ++j) acc[i][j] = 0.f;
    const int ar = tid >> 2, akq = tid & 3;
    const float* ap = arow(ar);
    const int bk0 = tid >> 6, bc = tid & 63;
    const int bcol = bmap(bc);
    for (int k0 = 0; k0 < K; k0 += 16) {
        float4 av = make_float4(0.f, 0.f, 0.f, 0.f);
        if (ap) av = *(const float4*)(ap + k0 + akq * 4);
        float b0 = 0.f, b1 = 0.f;
        if (bcol >= 0) { b0 = B[(size_t)(k0 + bk0) * ldb + bcol]; b1 = B[(size_t)(k0 + bk0 + 8) * ldb + bcol]; }
        __syncthreads();
        As[akq * 4 + 0][ar] = av.x; As[akq * 4 + 1][ar] = av.y; As[akq * 4 + 2][ar] = av.z; As[akq * 4 + 3][ar] = av.w;
        Bs[bk0][bc] = b0; Bs[bk0 + 8][bc] = b1;
        __syncthreads();
#pragma unroll
        for (int kk = 0; kk < 16; ++kk) {
            const float4 a = *(const float4*)&As[kk][ty * 4];
            const float4 b = *(const float4*)&Bs[kk][tx * 4];
            const float aa[4] = {a.x, a.y, a.z, a.w}, bb[4] = {b.x, b.y, b.z, b.w};
#pragma unroll
            for (int i = 0; i < 4; ++i)
#pragma unroll
                for (int j = 0; j < 4; ++j) acc[i][j] = fmaf(aa[i], bb[j], acc[i][j]);
        }
    }
#pragma unroll
    for (int i = 0; i < 4; ++i) epi(ty * 4 + i, tx, acc[i]);
    __syncthreads();
}


struct UnitRange { int lo, hi, step; };
DEVI UnitRange unit_range(int nunits, int bid) {
    UnitRange r;
    if ((gridDim.x & 7) == 0) { const int x = bid & 7, j = bid >> 3; r.lo = (int)(((long)nunits * x) >> 3) + j; r.hi = (int)(((long)nunits * (x + 1)) >> 3); r.step = gridDim.x >> 3; }
    else { r.lo = bid; r.hi = nunits; r.step = gridDim.x; }
    return r;
}

__device__ void phase_convert(const Params& p) {
    const int tid = tid_(), bid = bid_();
    const int lane = tid & 63, gw = bid * (NTHR / 64) + (tid >> 6), nw = gridDim.x * (NTHR / 64);
    constexpr int NI_GU = NLAYER * NEXP * 16 * 64, NI_DN = NLAYER * NEXP * 16 * 32, NI_OUT = NLAYER * 16 * 32, NI_IN = NLAYER * 16 * 51;
    bf16_t* wgu = (bf16_t*)(p.ws + W_WGU); bf16_t* wdn = (bf16_t*)(p.ws + W_WDN); bf16_t* wout = (bf16_t*)(p.ws + W_WOUT); bf16_t* win = (bf16_t*)(p.ws + W_WIN);
    for (int it = gw; it < NI_GU + NI_DN + NI_OUT + NI_IN; it += nw) {
        int r = it;
        if (r < NI_GU) { const int mat = r >> 10, q = r & 1023; conv_item(p.in[I_WGU] + (size_t)mat * D * 2048, D, 2048, wgu + (size_t)mat * 2048 * D, q >> 6, q & 63, lane); continue; }
        r -= NI_GU;
        if (r < NI_DN) { const int mat = r >> 9, q = r & 511; conv_item(p.in[I_WDN] + (size_t)mat * D * D, D, D, wdn + (size_t)mat * D * D, q >> 5, q & 31, lane); continue; }
        r -= NI_DN;
        if (r < NI_OUT) { const int mat = r >> 9, q = r & 511; conv_item(p.in[I_WOUT] + (size_t)mat * D * D, D, D, wout + (size_t)mat * D * D, q >> 5, q & 31, lane); continue; }
        r -= NI_OUT;
        { const int mat = r / 816, q = r % 816; conv_item(p.in[I_WIN] + (size_t)mat * D * INC, D, INC, win + (size_t)mat * NPAD_IN * D, q / 51, q % 51, lane); }
    }
}

__device__ void phase_init(const Params& p) {
    const int tid = tid_(), bid = bid_(); (void)tid; (void)bid;
    float* ws = p.ws;
    const size_t n4 = (size_t)T * D / 4;
    for (size_t i = (size_t)bid * NTHR + tid; i < n4; i += (size_t)gridDim.x * NTHR) {
        const size_t e = i * 4;
        float4 v = (e < (size_t)NLAT * D) ? *(const float4*)(p.in[I_X] + e) : *(const float4*)(p.in[I_CTX] + (e - (size_t)NLAT * D));
        *(float4*)(ws + W_X + e) = v;
    }
    for (int i = bid * NTHR + tid; i < NLAYER * 4 * 128 * 128; i += gridDim.x * NTHR) ((bf16_t*)(ws + W_WSB))[i] = f2bf(p.in[I_SGWS][i]);
    for (int i = bid * NTHR + tid; i < NLAT * 16; i += gridDim.x * NTHR) {
        const int t = i >> 4, f = i & 15; const float pos = (f < 8) ? (float)(t >> 6) : (float)(t & 63);
        const float ang = pos * powf(10000.f, -(float)(f & 7) / 8.f);
        ws[W_ROPE + (size_t)t * 32 + f] = cosf(ang); ws[W_ROPE + (size_t)t * 32 + 16 + f] = sinf(ang);
    }
    if (bid == 0 && tid < 128) ((int*)(ws + W_CNT))[tid] = 0;
}

__device__ void phase_mod(const Params& p, float* smem) {
    const int tid = tid_(), bid = bid_(); (void)tid; (void)bid;
    const int wave = tid >> 6, lane = tid & 63;
    for (int it = bid; it < NLAYER * 96; it += gridDim.x) {
        const int l = it / 96, j = (it % 96) * 64 + lane;
        const float* W = p.in[I_WMOD] + (size_t)l * 1024 * 6144;
        float a0 = 0.f, a1 = 0.f;
        for (int k = wave * 128; k < wave * 128 + 128; ++k) {
            const float w = W[(size_t)k * 6144 + j];
            a0 = fmaf(silu(p.in[I_C][k]), w, a0);
            a1 = fmaf(silu(p.in[I_CCTX][k]), w, a1);
        }
        smem[(wave * 2 + 0) * 64 + lane] = a0; smem[(wave * 2 + 1) * 64 + lane] = a1;
        __syncthreads();
        if (wave < 2) {
            float s = 0.f;
            for (int w = 0; w < 8; ++w) s += smem[(w * 2 + wave) * 64 + lane];
            p.ws[W_MOD + (size_t)(l * 2 + wave) * 6144 + j] = s + p.in[I_BMOD][l * 6144 + j];
        }
        __syncthreads();
    }
}

__device__ void phase_norm(const Params& p, int l, int which) {
    const int tid = tid_(), bid = bid_(); (void)tid; (void)bid;
    const int lane = tid & 63, gw = bid * (NTHR / 64) + (tid >> 6), nw = gridDim.x * (NTHR / 64);
    const float* g = p.in[which ? I_NFFN : I_NMIX] + l * D;
    for (int t = gw; t < T; t += nw) {
        const float* x = p.ws + W_X + (size_t)t * D;
        const float* mod = p.ws + W_MOD + (size_t)(l * 2 + (t >= NLAT ? 1 : 0)) * 6144;
        const float* sh = mod + (which ? 3 : 0) * D; const float* sc = mod + (which ? 4 : 1) * D;
        float4 v[4]; float ss = 0.f;
#pragma unroll
        for (int j = 0; j < 4; ++j) { v[j] = *(const float4*)(x + j * 256 + lane * 4); ss += v[j].x * v[j].x + v[j].y * v[j].y + v[j].z * v[j].z + v[j].w * v[j].w; }
        ss = wave_sum(ss);
        const float rstd = rsqrtf(ss * (1.f / D) + EPS);
#pragma unroll
        for (int j = 0; j < 4; ++j) {
            const int c = j * 256 + lane * 4;
            const float4 gg = *(const float4*)(g + c), s1 = *(const float4*)(sc + c), s0 = *(const float4*)(sh + c);
            float4 o;
            o.x = v[j].x * rstd * gg.x * (1.f + s1.x) + s0.x; o.y = v[j].y * rstd * gg.y * (1.f + s1.y) + s0.y;
            o.z = v[j].z * rstd * gg.z * (1.f + s1.z) + s0.z; o.w = v[j].w * rstd * gg.w * (1.f + s1.w) + s0.w;
            { u32x2 w; w.x = cvt_pk_bf16(o.x, o.y); w.y = cvt_pk_bf16(o.z, o.w); *(u32x2*)((bf16_t*)(p.ws + W_HB) + (size_t)t * D + c) = w; }
        }
    }
}

struct InprojSched {
    UnitRange ur; const char* A; const char* Bt;
    DEVI bool next(int i, pg8::Unit& u) const {
        const int id = ur.lo + i * ur.step; if (id >= ur.hi) return false;
        const int tm = id / 7, tn = id % 7;
        u.a = A + (size_t)tm * 256 * D * 2; u.b = Bt + (size_t)tn * 256 * D * 2; u.x0 = tm * 256; u.x1 = tn * 256; u.x2 = 0; return true;
    }
};
struct EpiInproj { static constexpr bool PERM = false; float* P;
    DEVI void operator()(const f32x4 (&acc)[2][2][4][2], const pg8::Unit& u, int wr, int wc, int fr, int fq) const {
#pragma unroll
        for (int ai = 0; ai < 2; ++ai)
#pragma unroll
            for (int m = 0; m < 4; ++m) { float* row = P + (size_t)(u.x0 + ai * 128 + wr * 64 + m * 16 + fr) * INC;
#pragma unroll
                for (int bj = 0; bj < 2; ++bj)
#pragma unroll
                    for (int n = 0; n < 2; ++n) { const int c = u.x1 + bj * 128 + wc * 32 + n * 16 + 4 * fq; if (c < INC) *(f32x4*)(row + c) = acc[ai][bj][m][n]; } }
    }
};
__device__ void phase_inproj(const Params& p, int l, char* lds) {
    const int tid = tid_(), bid = bid_(); (void)tid;
    InprojSched S; S.ur = unit_range((T / 256) * 7, bid); S.A = (const char*)(p.ws + W_HB); S.Bt = (const char*)((const bf16_t*)(p.ws + W_WIN) + (size_t)l * NPAD_IN * D);
    EpiInproj E; E.P = p.ws + W_P;
    pg8::gemm_phase((PG8_LAS unsigned char*)lds, D, (size_t)128 * D * 2, S, E);
}

__device__ void phase_prep1(const Params& p, int l) {
    const int tid = tid_(), bid = bid_(); (void)tid; (void)bid;
    const int lane = tid & 63, gw = bid * (NTHR / 64) + (tid >> 6), nw = gridDim.x * (NTHR / 64);
    float* ws = p.ws;
    for (int t = gw; t < T; t += nw) {
        const int s0 = (t < NLAT) ? 0 : NLAT, sl = (t < NLAT) ? NLAT : NCTX, n = t - s0;
        const float* P = ws + W_P; const float* pr = P + (size_t)t * INC;
        {
            const int g = lane >> 4, w = 2 << g;
            const int lo = max(n - w / 2, 0), hi = min(n + w / 2, sl);
            float4 s = make_float4(0.f, 0.f, 0.f, 0.f);
            for (int m = lo; m < hi; ++m) { const float4 v = *(const float4*)(P + (size_t)(s0 + m) * INC + OFF_A + lane * 4); s.x += v.x; s.y += v.y; s.z += v.z; s.w += v.w; }
            const float inv = 1.f / (float)(hi - lo);
            const float4 x = *(const float4*)(pr + OFF_A + lane * 4);
            float4 d; d.x = s.x * inv - x.x; d.y = s.y * inv - x.y; d.z = s.z * inv - x.z; d.w = s.w * inv - x.w;
            { u32x2 w; w.x = cvt_pk_bf16(d.x, d.y); w.y = cvt_pk_bf16(d.z, d.w); *(u32x2*)((bf16_t*)(ws + W_DIFF) + (size_t)t * 256 + lane * 4) = w; }
        }
        {
            float v[3]; float ss = 0.f;
#pragma unroll
            for (int j = 0; j < 3; ++j) { v[j] = pr[OFF_Q + j * 64 + lane]; ss += v[j] * v[j]; }
            ss = wave_sum(ss); const float rstd = rsqrtf(ss * (1.f / 192.f) + EPS);
#pragma unroll
            for (int j = 0; j < 3; ++j) ((bf16_t*)(ws + W_QN))[(size_t)t * 192 + j * 64 + lane] = f2bf(v[j] * rstd * p.in[I_QAN][l * 192 + j * 64 + lane]);
        }
        {
            float v[2]; float ss = 0.f;
#pragma unroll
            for (int j = 0; j < 2; ++j) { v[j] = pr[OFF_KV + j * 64 + lane]; ss += v[j] * v[j]; }
            ss = wave_sum(ss); const float rstd = rsqrtf(ss * (1.f / 128.f) + EPS);
#pragma unroll
            for (int j = 0; j < 2; ++j) ((bf16_t*)(ws + W_KVN))[(size_t)t * 128 + j * 64 + lane] = f2bf(v[j] * rstd * p.in[I_KVAN][l * 128 + j * 64 + lane]);
        }
        {
            const float4 zu = *(const float4*)(pr + OFF_C + lane * 4), zv = *(const float4*)(pr + OFF_C + 256 + lane * 4);
            float4 u; u.x = gelu_tanh(zu.x); u.y = gelu_tanh(zu.y); u.z = gelu_tanh(zu.z); u.w = gelu_tanh(zu.w);
            *(float4*)(ws + W_U + (size_t)t * 256 + lane * 4) = u;
            float gv[4] = {gelu_tanh(zv.x), gelu_tanh(zv.y), gelu_tanh(zv.z), gelu_tanh(zv.w)};
            const float mu = wave_sum(gv[0] + gv[1] + gv[2] + gv[3]) * (1.f / 256.f);
            float q = 0.f;
#pragma unroll
            for (int j = 0; j < 4; ++j) { gv[j] -= mu; q += gv[j] * gv[j]; }
            const float rstd = rsqrtf(wave_sum(q) * (1.f / 256.f) + EPS);
#pragma unroll
            for (int j = 0; j < 4; ++j) ws[W_VN + (size_t)t * 256 + lane * 4 + j] = gv[j] * rstd * p.in[I_SGG][l * 256 + lane * 4 + j] + p.in[I_SGB][l * 256 + lane * 4 + j];
        }
        {
            const float* cw = p.in[I_CONVW] + (size_t)l * 4 * 256;
            float4 o = *(const float4*)(p.in[I_CONVB] + l * 256 + lane * 4);
#pragma unroll
            for (int k = 0; k < 4; ++k) {
                const int m = n - 1 + k;
                if (m >= 0 && m < sl) {
                    const float4 xv = *(const float4*)(P + (size_t)(s0 + m) * INC + OFF_DX + lane * 4), wv = *(const float4*)(cw + k * 256 + lane * 4);
                    o.x = fmaf(xv.x, wv.x, o.x); o.y = fmaf(xv.y, wv.y, o.y); o.z = fmaf(xv.z, wv.z, o.z); o.w = fmaf(xv.w, wv.w, o.w);
                }
            }
            *(float4*)(ws + W_XC + (size_t)t * 256 + lane * 4) = o;
            { u32x2 w; w.x = cvt_pk_bf16(o.x, o.y); w.y = cvt_pk_bf16(o.z, o.w); *(u32x2*)((bf16_t*)(ws + W_XCB) + (size_t)t * 256 + lane * 4) = w; }
        }
    }
}

__device__ void phase_small(const Params& p, int l, char* lds) {
    const int tid = tid_(), bid = bid_(); (void)tid;
    float* ws = p.ws;
    constexpr int NK = 19, NU1 = (T / 256) * NK, NU2 = NCHUNK * 2;
    bf16_t* Y = (bf16_t*)(ws + W_YC);
    for (int u = bid; u < NU1 + NU2; u += gridDim.x) {
        if (u < NU1) {
            const int tm = u / NK, kind = u % NK, m0 = tm * 256;
            if (kind < 11) {
                const bf16_t* A; int lda, K, ldb, nval; const float* B;
                if (kind < 4) { A = (const bf16_t*)(ws + W_DIFF) + kind * 64; lda = 256; K = 64; B = p.in[I_POOLW] + (size_t)(l * 4 + kind) * 64 * 64; ldb = 64; nval = 64; }
                else if (kind < 7) { A = (const bf16_t*)(ws + W_QN); lda = 192; K = 192; B = p.in[I_WUQ] + (size_t)l * 192 * 384 + (kind - 4) * 128; ldb = 384; nval = 128; }
                else { A = (const bf16_t*)(ws + W_KVN); lda = 128; K = 128; B = p.in[I_WUKV] + (size_t)l * 128 * 512 + (kind - 7) * 128; ldb = 512; nval = 128; }
                gemm_unit<false>(lds, K, [&](int r) { return A + (size_t)(m0 + r) * lda; }, B, B, ldb, nval,
                    [&](const f32x4 (&acc)[4][4], int wr, int wc, int fr, int fq) {
#pragma unroll
                        for (int m = 0; m < 4; ++m) { const int t = m0 + wr * 64 + m * 16 + fr;
#pragma unroll
                            for (int n = 0; n < 4; ++n) { const int c = wc * 64 + n * 16 + 4 * fq;
                                if (kind < 4) { if (wc == 0) { const f32x4 sc = *(const f32x4*)(p.in[I_POOLS] + l * 256 + kind * 64 + c); const f32x4 v = acc[m][n] * sc;
                                        u32x2 w; w.x = cvt_pk_bf16(v[0], v[1]); w.y = cvt_pk_bf16(v[2], v[3]); *(u32x2*)(Y + (size_t)t * D + kind * 64 + c) = w; } }
                                else if (kind < 7) *(f32x4*)(ws + W_QUP + (size_t)t * 384 + (kind - 4) * 128 + c) = acc[m][n];
                                else *(f32x4*)(ws + W_KVUP + (size_t)t * 512 + (kind - 7) * 128 + c) = acc[m][n]; } }
                    });
            } else {
                const int d = (kind - 11) >> 2, h = (kind - 11) & 3;
                const bf16_t* A = (const bf16_t*)(ws + W_XCB) + h * 64;
                const float* Ba = p.in[I_WA] + (size_t)((l * 2 + d) * 4 + h) * 64 * 64; const float* Bx = p.in[I_WX] + (size_t)((l * 2 + d) * 4 + h) * 64 * 64;
                const int pb = (l * 2 + d) * 256 + h * 64;
                gemm_unit<true>(lds, 64, [&](int r) { return A + (size_t)(m0 + r) * 256; }, Ba, Bx, 64, 64,
                    [&](const f32x4 (&acc)[4][4], int wr, int wc, int fr, int fq) {
#pragma unroll
                        for (int m = 0; m < 4; ++m) { const int t = m0 + wr * 64 + m * 16 + fr;
#pragma unroll
                            for (int pp = 0; pp < 2; ++pp) { const int idx = (wc * 2 + pp) * 16 + 4 * fq;
                                const f32x4 ba = *(const f32x4*)(p.in[I_BA] + pb + idx), bx = *(const f32x4*)(p.in[I_BX] + pb + idx), lam = *(const f32x4*)(p.in[I_LAM] + pb + idx);
                                const f32x4 xv = *(const f32x4*)(ws + W_XC + (size_t)t * 256 + h * 64 + idx);
                                f32x4 av, dv;
#pragma unroll
                                for (int j = 0; j < 4; ++j) { const float r = sigm(acc[m][2 * pp][j] + ba[j]), ig = sigm(acc[m][2 * pp + 1][j] + bx[j]);
                                    const float loga = -8.f * r * log1pf(expf(-lam[j]));
                                    av[j] = expf(loga); dv[j] = sqrtf(-expm1f(2.f * loga)) * (ig * xv[j]); }
                                *(f32x4*)(ws + W_LA + ((size_t)d * T + t) * 256 + h * 64 + idx) = av;
                                *(f32x4*)(ws + W_LB + ((size_t)d * T + t) * 256 + h * 64 + idx) = dv; } }
                    });
            }
        } else {
            const int v = u - NU1, c = v >> 1, hp = v & 1;
            const bf16_t* A = (const bf16_t*)(ws + W_WSB) + ((size_t)l * 512 + hp * 256) * 128;
            const float* B = ws + W_VN + (size_t)c * 128 * 256 + hp * 128;
            gemm_unit<false>(lds, 128, [&](int r) { return A + (size_t)r * 128; }, B, B, 256, 128,
                [&](const f32x4 (&acc)[4][4], int wr, int wc, int fr, int fq) {
                    if ((wr >> 1) == wc) {
                        const int h = hp * 2 + wc;
#pragma unroll
                        for (int m = 0; m < 4; ++m) { const int pp = (wr & 1) * 64 + m * 16 + fr, t = c * 128 + pp; const float bs = p.in[I_SGBS][(l * 4 + h) * 128 + pp];
#pragma unroll
                            for (int n = 0; n < 4; ++n) { const int ch = h * 64 + n * 16 + 4 * fq; const f32x4 uu = *(const f32x4*)(ws + W_U + (size_t)t * 256 + ch);
                                const f32x4 o = uu * (acc[m][n] + bs);
                                u32x2 w; w.x = cvt_pk_bf16(o[0], o[1]); w.y = cvt_pk_bf16(o[2], o[3]); *(u32x2*)(Y + (size_t)t * D + 512 + ch) = w; } }
                    }
                });
        }
    }
}

__device__ void phase_prep2(const Params& p, int l) {
    const int tid = tid_(), bid = bid_(); (void)tid; (void)bid;
    float* ws = p.ws;
    const int lane = tid & 63, gw = bid * (NTHR / 64) + (tid >> 6), nw = gridDim.x * (NTHR / 64);
    for (int it = gw; it < T * 4; it += nw) {
        const int t = it >> 2, h = it & 3;
        const bool lat = t < NLAT;
        float cs = 1.f, sn = 0.f;
        if (lat && lane < 32) { cs = ws[W_ROPE + (size_t)t * 32 + (lane & 15)]; sn = ws[W_ROPE + (size_t)t * 32 + 16 + (lane & 15)]; }
        {
            float v0 = ws[W_QUP + (size_t)t * 384 + h * 96 + lane], v1 = (lane < 32) ? ws[W_QUP + (size_t)t * 384 + h * 96 + 64 + lane] : 0.f;
            const float rstd = rsqrtf(wave_sum(v0 * v0 + v1 * v1) * (1.f / 96.f) + EPS);
            v0 *= rstd * p.in[I_QN][l * 96 + lane]; v1 *= (lane < 32) ? rstd * p.in[I_QN][l * 96 + 64 + lane] : 0.f;
            const float pv = __shfl_xor(v1, 16);
            const float r1 = (lane < 16) ? v1 * cs - pv * sn : pv * sn + v1 * cs;
            bf16_t* qo = (bf16_t*)(ws + W_Q) + ((size_t)h * T + t) * 96;
            qo[lane] = f2bf(v0);
            if (lane < 32) qo[64 + lane] = f2bf(lat ? r1 : v1);
        }
        {
            float v0 = ws[W_KVUP + (size_t)t * 512 + h * 128 + lane], v1 = (lane < 32) ? ws[W_P + (size_t)t * INC + OFF_KR + lane] : 0.f;
            const float rstd = rsqrtf(wave_sum(v0 * v0 + v1 * v1) * (1.f / 96.f) + EPS);
            v0 *= rstd * p.in[I_KN][l * 96 + lane]; v1 *= (lane < 32) ? rstd * p.in[I_KN][l * 96 + 64 + lane] : 0.f;
            const float pv = __shfl_xor(v1, 16);
            const float r1 = (lane < 16) ? v1 * cs - pv * sn : pv * sn + v1 * cs;
            bf16_t* ko = (bf16_t*)(ws + W_K) + ((size_t)h * T + t) * 96;
            ko[lane] = f2bf(v0);
            if (lane < 32) ko[64 + lane] = f2bf(lat ? r1 : v1);
            ((bf16_t*)(ws + W_V))[((size_t)h * T + t) * 64 + lane] = f2bf(ws[W_KVUP + (size_t)t * 512 + h * 128 + 64 + lane]);
        }
    }
    for (int i = bid * NTHR + tid; i < NCHUNK * 512; i += gridDim.x * NTHR) {
        const int c = i >> 9, d = (i >> 8) & 1, ch = i & 255;
        float* A = ws + W_LA + ((size_t)d * T + (size_t)c * 128) * 256 + ch;
        float* B = ws + W_LB + ((size_t)d * T + (size_t)c * 128) * 256 + ch;
        float h = 0.f, ap = 1.f;
        for (int s0 = 0; s0 < 128; s0 += 8) {
            float a[8], b[8];
#pragma unroll
            for (int j = 0; j < 8; ++j) { const int q = d ? 127 - (s0 + j) : s0 + j; a[j] = A[(size_t)q * 256]; b[j] = B[(size_t)q * 256]; }
#pragma unroll
            for (int j = 0; j < 8; ++j) { h = fmaf(a[j], h, b[j]); ap *= a[j]; a[j] = ap; b[j] = h; }
#pragma unroll
            for (int j = 0; j < 8; ++j) { const int q = d ? 127 - (s0 + j) : s0 + j; A[(size_t)q * 256] = a[j]; B[(size_t)q * 256] = b[j]; }
        }
        ws[W_AGG + ((size_t)(c * 2 + d) * 2 + 0) * 256 + ch] = ap;
        ws[W_AGG + ((size_t)(c * 2 + d) * 2 + 1) * 256 + ch] = h;
    }
}


__device__ void phase_attn(const Params& p, int l, char* lds) {
    const int tid = tid_(), bid = bid_(); (void)tid;
    const bf16_t* Qb = (const bf16_t*)(p.ws + W_Q); const bf16_t* Kb = (const bf16_t*)(p.ws + W_K); const bf16_t* Vb = (const bf16_t*)(p.ws + W_V);
    bf16_t* Y = (bf16_t*)(p.ws + W_YC);
    const int nunits = (l == 0) ? 260 : 256;
    for (int u = bid; u < nunits; u += gridDim.x) {
        int h, t0, k0, seq;
        if (u < 256) { h = (u & 7) >> 1; t0 = (((u >> 3) << 1) | (u & 1)) * 256; k0 = 0; seq = T; }
        else { h = u - 256; t0 = NLAT; k0 = NLAT; seq = NCTX; }
        att::attn_unit(Qb + ((size_t)h * T + t0) * 96, Kb + ((size_t)h * T + k0) * 96, Vb + ((size_t)h * T + k0) * 64, seq, Y + (size_t)t0 * D + 256 + h * 64, D, lds);
    }
}

__device__ void phase_lru_fin(const Params& p, char* lds) {
    const int tid = tid_(), bid = bid_();
    float* ws = p.ws;
    float* carry = (float*)lds;
    for (int c = bid; c < NCHUNK; c += gridDim.x) {
        {
            const int d = tid >> 8, ch = tid & 255;
            const int npre = d ? (NCHUNK - 1 - c) : ((c + 2) % NCHUNK);
            float s = 0.f;
            for (int k = 0; k < npre; ++k) {
                const int q = d ? (NCHUNK - 1 - k) : ((k + 128) % NCHUNK);
                const float a = ws[W_AGG + ((size_t)(q * 2 + d) * 2 + 0) * 256 + ch], hh = ws[W_AGG + ((size_t)(q * 2 + d) * 2 + 1) * 256 + ch];
                s = fmaf(a, s, hh);
            }
            carry[tid] = s;
        }
        __syncthreads();
        for (int i = tid; i < 128 * 64; i += NTHR) {
            const int t = c * 128 + (i >> 6), ch = (i & 63) * 4;
            f32x4 hs = *(const f32x4*)(ws + W_LB + (size_t)t * 256 + ch) + *(const f32x4*)(ws + W_LA + (size_t)t * 256 + ch) * *(const f32x4*)(carry + ch);
            hs = hs + *(const f32x4*)(ws + W_LB + ((size_t)T + t) * 256 + ch) + *(const f32x4*)(ws + W_LA + ((size_t)T + t) * 256 + ch) * *(const f32x4*)(carry + 256 + ch);
            const f32x4 g = *(const f32x4*)(ws + W_P + (size_t)t * INC + OFF_DG + ch);
            u32x2 w; w.x = cvt_pk_bf16(gelu_tanh(g[0]) * hs[0], gelu_tanh(g[1]) * hs[1]); w.y = cvt_pk_bf16(gelu_tanh(g[2]) * hs[2], gelu_tanh(g[3]) * hs[3]);
            *(u32x2*)((bf16_t*)(ws + W_YC) + (size_t)t * D + 768 + ch) = w;
        }
        __syncthreads();
    }
}

struct OutprojSched {
    UnitRange ur; const char* A; const char* Bt;
    DEVI bool next(int i, pg8::Unit& u) const {
        const int id = ur.lo + i * ur.step; if (id >= ur.hi) return false;
        const int tm = id >> 2, tn = id & 3;
        u.a = A + (size_t)tm * 256 * D * 2; u.b = Bt + (size_t)tn * 256 * D * 2; u.x0 = tm * 256; u.x1 = tn * 256; u.x2 = 0; return true;
    }
};
struct EpiOutproj { static constexpr bool PERM = false; float* X; const float* modv;
    DEVI void operator()(const f32x4 (&acc)[2][2][4][2], const pg8::Unit& u, int wr, int wc, int fr, int fq) const {
        const float* g1 = modv + (u.x0 >= NLAT ? 6144 : 0) + 2 * D;
#pragma unroll
        for (int ai = 0; ai < 2; ++ai)
#pragma unroll
            for (int m = 0; m < 4; ++m) { float* row = X + (size_t)(u.x0 + ai * 128 + wr * 64 + m * 16 + fr) * D;
#pragma unroll
                for (int bj = 0; bj < 2; ++bj)
#pragma unroll
                    for (int n = 0; n < 2; ++n) { const int c = u.x1 + bj * 128 + wc * 32 + n * 16 + 4 * fq; const f32x4 g = *(const f32x4*)(g1 + c); f32x4 x = *(f32x4*)(row + c);
                        x = x + g * acc[ai][bj][m][n]; *(f32x4*)(row + c) = x; } }
    }
};
__device__ void phase_outproj(const Params& p, int l, char* lds) {
    const int tid = tid_(), bid = bid_(); (void)tid;
    const int ntm = (l == NLAYER - 1) ? NLAT / 256 : T / 256;
    OutprojSched S; S.ur = unit_range(ntm * 4, bid); S.A = (const char*)(p.ws + W_YC); S.Bt = (const char*)((const bf16_t*)(p.ws + W_WOUT) + (size_t)l * D * D);
    EpiOutproj E; E.X = p.ws + W_X; E.modv = p.ws + W_MOD + (size_t)l * 2 * 6144;
    pg8::gemm_phase((PG8_LAS unsigned char*)lds, D, (size_t)128 * D * 2, S, E);
}

constexpr int R_LDS = 1024 * 36 * 4;
__device__ void phase_router(const Params& p, int l, char* lds) {
    const int tid = tid_(), bid = bid_();
    float* ws = p.ws;
    float* wl = (float*)lds;
    {   const float* rw = p.in[I_RW] + (size_t)l * D * NEXP;
        for (int i = tid; i < 1024 * 8; i += NTHR) { const int k = i >> 3, e4 = i & 7; *(f32x4*)(wl + k * 36 + e4 * 4) = *(const f32x4*)(rw + k * 32 + e4 * 4); }
    }
    __syncthreads();
    const int lane = tid & 63, gw = bid * (NTHR / 64) + (tid >> 6), nw = gridDim.x * (NTHR / 64);
    const float* g = p.in[I_NFFN] + l * D;
    int* cnt = (int*)(ws + W_CNT) + l * 64;
    bf16_t* HB = (bf16_t*)(ws + W_HB);
    const int e = lane >> 1;
    const float rb = p.in[I_RB][l * NEXP + e];
    const int TL = (l == NLAYER - 1) ? NLAT : T;
    for (int t = gw; t < TL; t += nw) {
        const float* x = ws + W_X + (size_t)t * D;
        const float* mod = ws + W_MOD + (size_t)(l * 2 + (t >= NLAT ? 1 : 0)) * 6144;
        float f[16]; float ss = 0.f;
#pragma unroll
        for (int m = 0; m < 16; ++m) { f[m] = x[lane + 64 * m]; ss = fmaf(f[m], f[m], ss); }
        const float rstd = rsqrtf(wave_sum(ss) * (1.f / D) + EPS);
#pragma unroll
        for (int m = 0; m < 16; ++m) { const int k = lane + 64 * m; f[m] = f[m] * rstd * g[k] * (1.f + mod[4 * D + k]) + mod[3 * D + k]; HB[(size_t)t * D + k] = f2bf(f[m]); }
        float acc[32];
#pragma unroll
        for (int j = 0; j < 32; ++j) acc[j] = 0.f;
#pragma unroll
        for (int m = 0; m < 16; ++m) {
            const float* wr = wl + (lane + 64 * m) * 36;
#pragma unroll
            for (int e4 = 0; e4 < 8; ++e4) { const f32x4 w4 = *(const f32x4*)(wr + e4 * 4);
#pragma unroll
                for (int j = 0; j < 4; ++j) acc[e4 * 4 + j] = fmaf(f[m], w4[j], acc[e4 * 4 + j]); }
        }
#pragma unroll
        for (int w = 16, msk = 32; w >= 1; w >>= 1, msk >>= 1) {
            const bool up = (lane & msk) != 0;
#pragma unroll
            for (int j = 0; j < w; ++j) { const float send = up ? acc[j] : acc[j + w], keep = up ? acc[j + w] : acc[j]; acc[j] = keep + __shfl_xor(send, msk); }
        }
        float a = acc[0] + __shfl_xor(acc[0], 1) + rb;
        float tv[4]; int te[4];
        float cur = a;
#pragma unroll
        for (int k = 0; k < 4; ++k) {
            float bv = cur; int bi = e;
#pragma unroll
            for (int o = 32; o > 1; o >>= 1) {
                const float ov = __shfl_xor(bv, o); const int oi = __shfl_xor(bi, o);
                if (ov > bv || (ov == bv && oi < bi)) { bv = ov; bi = oi; }
            }
            tv[k] = bv; te[k] = bi;
            if (e == bi) cur = -3.0e38f;
        }
        const float mx = tv[0];
        float ex[4], sm = 0.f;
#pragma unroll
        for (int k = 0; k < 4; ++k) { ex[k] = expf(tv[k] - mx); sm += ex[k]; }
        if (lane < 4) {
            const int ee = lane == 0 ? te[0] : lane == 1 ? te[1] : lane == 2 ? te[2] : te[3];
            const float eg = lane == 0 ? ex[0] : lane == 1 ? ex[1] : lane == 2 ? ex[2] : ex[3];
            atomicAdd(&cnt[ee], 1);
            ((int*)(ws + W_TOPE))[t * 4 + lane] = ee;
            ws[W_TOPG + t * 4 + lane] = eg / sm;
        }
    }
    __syncthreads();
}

DEVI void moe_bases(const Params& p, int l, int* sb) {
    const int tid = tid_();
    if (tid == 0) {
        const int* cnt = (const int*)(p.ws + W_CNT) + l * 64;
        int b = 0, tb = 0;
        for (int e = 0; e < NEXP; ++e) { sb[e] = b; sb[40 + e] = tb; const int c = cnt[e]; sb[80 + e] = c; const int mt = (c + 255) / 256; b += mt * 256; tb += mt; }
        sb[32] = b; sb[72] = tb;
    }
    __syncthreads();
}

__device__ void phase_scatter(const Params& p, int l, char* lds) {
    const int tid = tid_(), bid = bid_();
    int* sb = (int*)(lds + G_LDS);
    moe_bases(p, l, sb);
    float* ws = p.ws;
    int* slot = (int*)(ws + W_CNT) + l * 64 + 32;
    const bf16_t* HB = (const bf16_t*)(ws + W_HB); bf16_t* XS = (bf16_t*)(ws + W_XS);
    const int lane = tid & 63, gw = bid * (NTHR / 64) + (tid >> 6), nw = gridDim.x * (NTHR / 64);
    const int TL = (l == NLAYER - 1) ? NLAT : T;
    for (int t = gw; t < TL; t += nw) {
        int row = 0;
        if (lane < 4) { const int e = ((const int*)(ws + W_TOPE))[t * 4 + lane]; row = sb[e] + atomicAdd(&slot[e], 1); ((int*)(ws + W_TOPI))[t * 4 + lane] = row; }
        const u32x4 v0 = *(const u32x4*)(HB + (size_t)t * D + lane * 8), v1 = *(const u32x4*)(HB + (size_t)t * D + 512 + lane * 8);
#pragma unroll
        for (int k = 0; k < 4; ++k) { const int rk = __shfl(row, k); bf16_t* d = XS + (size_t)rk * D; *(u32x4*)(d + lane * 8) = v0; *(u32x4*)(d + 512 + lane * 8) = v1; }
    }
    __syncthreads();
}

struct MoeSched {
    UnitRange ur; const int* sb; int ntn; const char* A; const char* Bt; size_t bstride_e, bstride_tn;
    DEVI bool next(int i, pg8::Unit& u) const {
        const int id = ur.lo + i * ur.step; if (id >= ur.hi) return false;
        int e = 0; while (e < NEXP - 1 && sb[40 + e + 1] * ntn <= id) ++e;
        const int mts = sb[40 + e + 1] - sb[40 + e], loc = id - sb[40 + e] * ntn, tng = loc / (mts * 4), rr = loc % (mts * 4), mt = rr >> 2, tn = tng * 4 + (rr & 3);
        const int r0 = sb[e] + mt * 256;
        u.a = A + (size_t)r0 * D * 2; u.b = Bt + (size_t)e * bstride_e + (size_t)tn * bstride_tn; u.x0 = r0; u.x1 = tn; u.x2 = e; return true;
    }
};
struct EpiMoe1 { static constexpr bool PERM = true; bf16_t* ACT; const float* bias;
    DEVI void operator()(const f32x4 (&acc)[2][2][4][2], const pg8::Unit& u, int wr, int wc, int fr, int fq) const {
        const int c0 = u.x1 * 128 + wc * 32 + 8 * fq;
        const float* bg = bias + (size_t)u.x2 * 2048 + c0; const float* bu = bg + 1024;
        f32x4 vg[2], vu[2];
#pragma unroll
        for (int n = 0; n < 2; ++n) { vg[n] = *(const f32x4*)(bg + 4 * n); vu[n] = *(const f32x4*)(bu + 4 * n); }
#pragma unroll
        for (int ai = 0; ai < 2; ++ai)
#pragma unroll
            for (int m = 0; m < 4; ++m) { bf16_t* rowp = ACT + (size_t)(u.x0 + ai * 128 + wr * 64 + m * 16 + fr) * D + c0;
                float a[8];
#pragma unroll
                for (int n = 0; n < 2; ++n)
#pragma unroll
                    for (int j = 0; j < 4; ++j) { float g = acc[ai][0][m][n][j] + vg[n][j], uu = acc[ai][1][m][n][j] + vu[n][j];
                        g = fminf(g, 7.f); uu = fminf(fmaxf(uu, -7.f), 7.f); a[n * 4 + j] = (uu + 1.f) * (g * sigm(1.702f * g)); }
                u32x4 w; w.x = cvt_pk_bf16(a[0], a[1]); w.y = cvt_pk_bf16(a[2], a[3]); w.z = cvt_pk_bf16(a[4], a[5]); w.w = cvt_pk_bf16(a[6], a[7]);
                *(u32x4*)rowp = w; }
    }
};
__device__ void phase_moe1(const Params& p, int l, char* lds) {
    const int tid = tid_(), bid = bid_(); (void)tid;
    int* sb = (int*)(lds + pg8::STAGE_BYTES);
    moe_bases(p, l, sb);
    MoeSched S; S.sb = sb; S.ntn = 8; S.ur = unit_range(sb[72] * 8, bid); S.A = (const char*)(p.ws + W_XS);
    S.Bt = (const char*)((const bf16_t*)(p.ws + W_WGU) + (size_t)l * NEXP * 2048 * D); S.bstride_e = (size_t)2048 * D * 2; S.bstride_tn = (size_t)128 * D * 2;
    EpiMoe1 E; E.ACT = (bf16_t*)(p.ws + W_ACT); E.bias = p.in[I_BGU] + (size_t)l * NEXP * 2048;
    pg8::gemm_phase((PG8_LAS unsigned char*)lds, D, (size_t)1024 * D * 2, S, E);
    __syncthreads();
}

struct EpiMoe2 { static constexpr bool PERM = true; bf16_t* YR; const float* bias;
    DEVI void operator()(const f32x4 (&acc)[2][2][4][2], const pg8::Unit& u, int wr, int wc, int fr, int fq) const {
        const int c0 = u.x1 * 256 + wc * 32 + 8 * fq;
        const float* bb = bias + (size_t)u.x2 * D + c0;
        f32x4 bv[2][2];
#pragma unroll
        for (int bj = 0; bj < 2; ++bj)
#pragma unroll
            for (int n = 0; n < 2; ++n) bv[bj][n] = *(const f32x4*)(bb + bj * 128 + 4 * n);
#pragma unroll
        for (int ai = 0; ai < 2; ++ai)
#pragma unroll
            for (int m = 0; m < 4; ++m) { bf16_t* rowp = YR + (size_t)(u.x0 + ai * 128 + wr * 64 + m * 16 + fr) * D + c0;
#pragma unroll
                for (int bj = 0; bj < 2; ++bj) { const f32x4 v0 = acc[ai][bj][m][0] + bv[bj][0], v1 = acc[ai][bj][m][1] + bv[bj][1];
                    u32x4 w; w.x = cvt_pk_bf16(v0[0], v0[1]); w.y = cvt_pk_bf16(v0[2], v0[3]); w.z = cvt_pk_bf16(v1[0], v1[1]); w.w = cvt_pk_bf16(v1[2], v1[3]);
                    *(u32x4*)(rowp + bj * 128) = w; } }
    }
};
__device__ void phase_moe2(const Params& p, int l, char* lds) {
    const int tid = tid_(), bid = bid_(); (void)tid;
    int* sb = (int*)(lds + pg8::STAGE_BYTES);
    moe_bases(p, l, sb);
    MoeSched S; S.sb = sb; S.ntn = 4; S.ur = unit_range(sb[72] * 4, bid); S.A = (const char*)(p.ws + W_ACT);
    S.Bt = (const char*)((const bf16_t*)(p.ws + W_WDN) + (size_t)l * NEXP * D * D); S.bstride_e = (size_t)D * D * 2; S.bstride_tn = (size_t)256 * D * 2;
    EpiMoe2 E; E.YR = (bf16_t*)(p.ws + W_YR); E.bias = p.in[I_BDN] + (size_t)l * NEXP * D;
    pg8::gemm_phase((PG8_LAS unsigned char*)lds, D, (size_t)128 * D * 2, S, E);
    __syncthreads();
}

__device__ void phase_combine(const Params& p, int l, char* lds, bool last) {
    const int tid = tid_(), bid = bid_();
    float* ws = p.ws;
    const bf16_t* YR = (const bf16_t*)(ws + W_YR);
    const int lane = tid & 63, gw = bid * (NTHR / 64) + (tid >> 6), nw = gridDim.x * (NTHR / 64);
    const int TL = last ? NLAT : T;
    for (int t = gw; t < TL; t += nw) {
        const float* g2 = ws + W_MOD + (size_t)(l * 2 + (t >= NLAT ? 1 : 0)) * 6144 + 5 * D;
        const bf16_t* yr[4]; float gt[4];
#pragma unroll
        for (int k = 0; k < 4; ++k) { yr[k] = YR + (size_t)((const int*)(ws + W_TOPI))[t * 4 + k] * D; gt[k] = ws[W_TOPG + t * 4 + k]; }
        float* x = ws + W_X + (size_t)t * D;
#pragma unroll
        for (int j = 0; j < 4; ++j) {
            const int c = j * 256 + lane * 4;
            float a0 = 0.f, a1 = 0.f, a2 = 0.f, a3 = 0.f;
#pragma unroll
            for (int k = 0; k < 4; ++k) { const u32x2 y = *(const u32x2*)(yr[k] + c);
                a0 = fmaf(gt[k], __uint_as_float(y.x << 16), a0); a1 = fmaf(gt[k], __uint_as_float(y.x & 0xffff0000u), a1);
                a2 = fmaf(gt[k], __uint_as_float(y.y << 16), a2); a3 = fmaf(gt[k], __uint_as_float(y.y & 0xffff0000u), a3); }
            float4 xv = *(const float4*)(x + c); const float4 gg = *(const float4*)(g2 + c);
            xv.x = fmaf(gg.x, a0, xv.x); xv.y = fmaf(gg.y, a1, xv.y); xv.z = fmaf(gg.z, a2, xv.z); xv.w = fmaf(gg.w, a3, xv.w);
            *(float4*)(x + c) = xv;
            if (last) *(float4*)(p.out + (size_t)t * D + c) = xv;
        }
    }
}

constexpr int LDS_BYTES = R_LDS + 2048;

#define XB_TMO      128
#define XB_XCNT(j)  (256  + 64 * (j))
#define XB_XSUB(j)  (1280 + 64 * (j))
#define XB_XGEN(j)  (2304 + 64 * (j))
#define XB_TOP      3328
#define XB_TOPGEN   3392
#define XCD_BAR_WORDS 3456
#define XB_SPIN_CAP (1u << 18)
#define LAS __attribute__((address_space(3)))
__device__ __forceinline__ unsigned xb_ld(unsigned* p)              { return __hip_atomic_load(p, __ATOMIC_RELAXED, __HIP_MEMORY_SCOPE_AGENT); }
__device__ __forceinline__ unsigned xb_add(unsigned* p, unsigned v) { return __hip_atomic_fetch_add(p, v, __ATOMIC_RELAXED, __HIP_MEMORY_SCOPE_AGENT); }
__device__ __forceinline__ unsigned xb_xcc_id() { return (unsigned)__builtin_amdgcn_s_getreg((3 << 11) | 20) & 0xFu; }
#define XB_SPIN(cond, bar) do { unsigned _sp = 0; while (cond) { __builtin_amdgcn_s_sleep(1); \
    if ((++_sp & 255u) == 0u) { if (xb_ld(&(bar)[XB_TMO])) break; if (_sp > XB_SPIN_CAP) { atomicAdd(&(bar)[XB_TMO], 1u); break; } } } } while (0)
struct XcdBarrier { unsigned* bar; unsigned x; volatile LAS unsigned* st; };
__device__ __forceinline__ XcdBarrier xcd_barrier_post(unsigned* bar, volatile LAS unsigned* st) {
    XcdBarrier b; b.bar = bar; b.x = xb_xcc_id(); b.st = st;
    if (threadIdx.x == 0) (void)xb_add(&bar[XB_XCNT(b.x)], 1u);
    return b;
}
__device__ __forceinline__ void xcd_barrier_complete(unsigned* bar, unsigned x, unsigned& nloc, unsigned& nx) {
    const unsigned G = gridDim.x * gridDim.y * gridDim.z;
    unsigned sum, cnt, mine, sp = 0u;
    for (;;) {
        sum = 0u; cnt = 0u; mine = 0u;
#pragma unroll
        for (unsigned j = 0; j < 16; ++j) { const unsigned c = xb_ld(&bar[XB_XCNT(j)]); sum += c; cnt += (c > 0u) ? 1u : 0u; mine = (j == x) ? c : mine; }
        if (sum == G) break;
        __builtin_amdgcn_s_sleep(1);
        if ((++sp & 255u) == 0u) { if (xb_ld(&bar[XB_TMO])) break; if (sp > XB_SPIN_CAP) { atomicAdd(&bar[XB_TMO], 1u); break; } }
    }
    nloc = mine > 0u ? mine : 1u; nx = cnt > 0u ? cnt : 1u;
}
__device__ __noinline__ void xcd_barrier(const XcdBarrier b) {
    asm volatile("s_waitcnt vmcnt(0)" ::: "memory");
    __syncthreads();
    if (threadIdx.x == 0) {
        unsigned* bar = b.bar;
        __builtin_amdgcn_s_waitcnt(0);
        unsigned nloc = b.st[0], nx = b.st[1];
        if (nloc == 0u) { xcd_barrier_complete(bar, b.x, nloc, nx); b.st[0] = nloc; b.st[1] = nx; }
        const unsigned old = xb_add(&bar[XB_XSUB(b.x)], 1u);
        const unsigned gen = old / nloc;
        if (old + 1u == (gen + 1u) * nloc) {
            __builtin_amdgcn_fence(__ATOMIC_RELEASE, "agent");
            asm volatile("s_waitcnt vmcnt(0)" ::: "memory");
            const unsigned og = xb_add(&bar[XB_TOP], 1u);
            const unsigned tg = og / nx;
            if (og + 1u == (tg + 1u) * nx) xb_add(&bar[XB_TOPGEN], 1u);
            else XB_SPIN(xb_ld(&bar[XB_TOPGEN]) == tg, bar);
            __builtin_amdgcn_fence(__ATOMIC_ACQUIRE, "agent");
            xb_add(&bar[XB_XGEN(b.x)], 1u);
            asm volatile("s_waitcnt vmcnt(0)" ::: "memory");
        } else {
            XB_SPIN(xb_ld(&bar[XB_XGEN(b.x)]) == gen, bar);
            __builtin_amdgcn_fence(__ATOMIC_ACQUIRE, "agent");
            asm volatile("s_waitcnt vmcnt(0)" ::: "memory");
        }
    }
    __syncthreads();
}

constexpr int REP_NORM = 1, REP_INPROJ = 1, REP_PREP1 = 1, REP_SMALL = 1, REP_ATTN = 1, REP_FIN = 1, REP_MOE1 = 1, REP_MOE2 = 1, REP_SYNC = 1;
__global__ void __launch_bounds__(NTHR) fwd_kernel(Params p) {
    cg::grid_group grid = cg::this_grid();
    extern __shared__ __attribute__((aligned(16))) char lds[];
    float* smem = (float*)lds;
    volatile LAS unsigned* xst = (volatile LAS unsigned*)(lds + LDS_BYTES - 16);
    if (threadIdx.x < 4) xst[threadIdx.x] = 0u;
    if (blockIdx.x == 0) for (int i = threadIdx.x; i < 4096; i += NTHR) ((unsigned*)(p.ws + W_BAR))[i] = 0u;
    phase_convert(p);
    phase_init(p);
    phase_mod(p, smem);
    grid.sync();
    XcdBarrier xbar = xcd_barrier_post((unsigned*)(p.ws + W_BAR), xst);
#define GSYNC() do { for (int r_ = 0; r_ < REP_SYNC; ++r_) xcd_barrier(xbar); } while (0)
    for (int l = 0; l < NLAYER; ++l) {
        for (int r = 0; r < REP_NORM; ++r) phase_norm(p, l, 0);
        GSYNC();
        for (int r = 0; r < REP_INPROJ; ++r) phase_inproj(p, l, lds);
        GSYNC();
        for (int r = 0; r < REP_PREP1; ++r) phase_prep1(p, l);
        GSYNC();
        for (int r = 0; r < REP_SMALL; ++r) phase_small(p, l, lds);
        GSYNC();
        phase_prep2(p, l);
        GSYNC();
        for (int r = 0; r < REP_ATTN; ++r) phase_attn(p, l, lds);
        GSYNC();
        for (int r = 0; r < REP_FIN; ++r) phase_lru_fin(p, lds);
        GSYNC();
        phase_outproj(p, l, lds);
        GSYNC();
        phase_router(p, l, lds);
        GSYNC();
        phase_scatter(p, l, lds);
        GSYNC();
        for (int r = 0; r < REP_MOE1; ++r) phase_moe1(p, l, lds);
        GSYNC();
        for (int r = 0; r < REP_MOE2; ++r) phase_moe2(p, l, lds);
        GSYNC();
        phase_combine(p, l, lds, l == NLAYER - 1);
        GSYNC();
    }
}

extern "C" void kernel_launch(void* const* d_in, const int* in_sizes, int n_in, void* d_out, int out_size, void* d_ws, size_t ws_size, hipStream_t stream) {
    static int grid_blocks = 0;
    if (!grid_blocks) {
        int dev = 0, cus = 0, per_cu = 0;
        (void)hipGetDevice(&dev);
        (void)hipDeviceGetAttribute(&cus, hipDeviceAttributeMultiprocessorCount, dev);
        if (hipFuncSetAttribute((const void*)fwd_kernel, hipFuncAttributeMaxDynamicSharedMemorySize, LDS_BYTES) != hipSuccess) fprintf(stderr, "kernel_launch: hipFuncSetAttribute failed\n");
        if (hipOccupancyMaxActiveBlocksPerMultiprocessor(&per_cu, fwd_kernel, NTHR, LDS_BYTES) != hipSuccess || per_cu < 1) { fprintf(stderr, "kernel_launch: occupancy query says %d\n", per_cu); per_cu = 1; }
        if (per_cu > 1) per_cu = 1;
        grid_blocks = cus * per_cu;
        if (ws_size < W_END * sizeof(float)) fprintf(stderr, "kernel_launch: workspace too small: %zu < %zu\n", ws_size, W_END * sizeof(float));
        if (n_in != N_IN) fprintf(stderr, "kernel_launch: n_in %d != %d\n", n_in, (int)N_IN);
    }
    Params p{};
    for (int i = 0; i < N_IN; ++i) p.in[i] = (const float*)d_in[i];
    p.out = (float*)d_out;
    p.ws = (float*)d_ws;
    void* args[] = {&p};
    hipError_t e = hipLaunchCooperativeKernel((void*)fwd_kernel, dim3(grid_blocks), dim3(NTHR), args, LDS_BYTES, stream);
    if (e != hipSuccess) fprintf(stderr, "cooperative launch failed: %s (grid %d)\n", hipGetErrorString(e), grid_blocks);
}
```

```cpp
#include <hip/hip_runtime.h>
#include <hip/hip_cooperative_groups.h>
#include <cstdio>
#include <cstdint>
namespace cg = cooperative_groups;

#define DEVI __device__ __forceinline__
constexpr int NTHR = 512;
constexpr int D = 1024, NLAT = 16384, NCTX = 256, T = NLAT + NCTX, NLAYER = 2;
constexpr int INC = 1632;
constexpr int OFF_A = 0, OFF_Q = 256, OFF_KV = 448, OFF_KR = 576, OFF_C = 608, OFF_DX = 1120, OFF_DG = 1376;
constexpr int NCHUNK = T / 128;
constexpr int NEXP = 32, TOPK = 4;
constexpr int MAXROWS = T * TOPK + NEXP * 256;
constexpr float EPS = 1e-6f;

enum { I_X = 0, I_C, I_CTX, I_CCTX, I_WMOD, I_BMOD, I_NMIX, I_NFFN, I_WIN, I_WOUT, I_POOLW, I_POOLS, I_QAN, I_WUQ, I_KVAN, I_WUKV,
       I_QN, I_KN, I_SGG, I_SGB, I_SGWS, I_SGBS, I_CONVW, I_CONVB, I_WA, I_BA, I_WX, I_BX, I_LAM, I_RW, I_RB, I_WGU, I_BGU, I_WDN, I_BDN, N_IN };

constexpr size_t al(size_t x) { return (x + 63) / 64 * 64; }
constexpr size_t W_X = 0;
constexpr size_t W_MOD = W_X + al((size_t)T * D);
constexpr size_t W_P = W_MOD + al(2 * 2 * 6144);
constexpr size_t W_YC = W_P + al((size_t)T * INC);
constexpr size_t W_Q = W_YC + al((size_t)T * D);
constexpr size_t W_K = W_Q + al((size_t)T * 384);
constexpr size_t W_V = W_K + al((size_t)T * 384);
constexpr size_t W_DIFF = W_V + al((size_t)T * 256);
constexpr size_t W_QN = W_DIFF + al((size_t)T * 256);
constexpr size_t W_KVN = W_QN + al((size_t)T * 192);
constexpr size_t W_U = W_KVN + al((size_t)T * 128);
constexpr size_t W_VN = W_U + al((size_t)T * 256);
constexpr size_t W_XC = W_VN + al((size_t)T * 256);
constexpr size_t W_QUP = W_XC + al((size_t)T * 256);
constexpr size_t W_KVUP = W_QUP + al((size_t)T * 384);
constexpr size_t W_LA = W_KVUP + al((size_t)T * 512);
constexpr size_t W_LB = W_LA + al((size_t)2 * T * 256);
constexpr size_t W_AGG = W_LB + al((size_t)2 * T * 256);
constexpr size_t W_CARRY = W_AGG + al((size_t)NCHUNK * 2 * 2 * 256);
constexpr size_t W_TOPE = W_CARRY + al((size_t)NCHUNK * 2 * 256);
constexpr size_t W_TOPG = W_TOPE + al((size_t)T * 4);
constexpr size_t W_TOPI = W_TOPG + al((size_t)T * 4);
constexpr size_t W_CNT = W_TOPI + al((size_t)T * 4);
constexpr size_t W_ACT = W_CNT + al(NLAYER * NEXP * 64);
constexpr size_t W_YR = W_ACT + al((size_t)MAXROWS * D / 2);
constexpr size_t W_XS = W_YR + al((size_t)MAXROWS * D / 2);
constexpr size_t W_HB = W_XS + al((size_t)MAXROWS * D / 2);
constexpr size_t W_XCB = W_HB + al((size_t)T * D / 2);
constexpr size_t W_WSB = W_XCB + al((size_t)T * 256 / 2);
constexpr size_t W_BAR = W_WSB + al((size_t)NLAYER * 4 * 128 * 128 / 2);
constexpr size_t W_ROPE = W_BAR + al(4096);
constexpr int NPAD_IN = 1792;
constexpr size_t W_WIN = W_ROPE + al((size_t)NLAT * 32);
constexpr size_t W_WOUT = W_WIN + al((size_t)NLAYER * NPAD_IN * D / 2);
constexpr size_t W_WGU = W_WOUT + al((size_t)NLAYER * D * D / 2);
constexpr size_t W_WDN = W_WGU + al((size_t)NLAYER * NEXP * 2048 * D / 2);
constexpr size_t W_END = W_WDN + al((size_t)NLAYER * NEXP * D * D / 2);

struct Params {
    const float* in[N_IN];
    float* out;
    float* ws;
};

DEVI int tid_() { int t = threadIdx.x; asm volatile("" : "+v"(t)); return t; }
DEVI int bid_() { int b = blockIdx.x; asm volatile("" : "+s"(b)); return b; }
DEVI float wave_sum(float v) {
#pragma unroll
    for (int o = 32; o > 0; o >>= 1) v += __shfl_xor(v, o);
    return v;
}
DEVI float gelu_tanh(float x) { const float u = 0.7978845608028654f * (x + 0.044715f * x * x * x); return 0.5f * x * (1.f + tanhf(u)); }
DEVI float sigm(float x) { return 1.f / (1.f + expf(-x)); }
DEVI float silu(float x) { return x * sigm(x); }


typedef unsigned short bf16_t;
typedef short bf16x8 __attribute__((ext_vector_type(8)));
typedef float f32x4 __attribute__((ext_vector_type(4)));
typedef unsigned u32x4 __attribute__((ext_vector_type(4)));
typedef unsigned u32x2 __attribute__((ext_vector_type(2)));
DEVI unsigned cvt_pk_bf16(float lo, float hi) { unsigned r; asm volatile("v_cvt_pk_bf16_f32 %0, %1, %2" : "=v"(r) : "v"(lo), "v"(hi)); return r; }
DEVI bf16_t f2bf(float f) { return (bf16_t)(cvt_pk_bf16(f, 0.f) & 0xffffu); }
DEVI float bf2f(bf16_t b) { return __uint_as_float(((unsigned)b) << 16); }

constexpr int G_STAGE = 49152;
constexpr int G_LDS = 2 * G_STAGE;
DEVI int swz(int row, int chunk) { return row * 128 + ((chunk ^ ((row >> 1) & 7)) << 4); }

template <bool PAIRED, class ARow, class Epi>
DEVI void gemm_unit(char* lds, int K, ARow arow, const float* __restrict__ B0, const float* __restrict__ B1, int ldb, int ncol_valid, Epi epi) {
    const int tid = tid_(), wave = tid >> 6, lane = tid & 63, fr = lane & 15, fq = lane >> 4, wr = wave >> 1, wc = wave & 1;
    const int ac = tid & 7;
    const bf16_t* ap[4]; int a_lds[4];
#pragma unroll
    for (int i = 0; i < 4; ++i) { const int r = (tid >> 3) + 64 * i; ap[i] = arow(r) + ac * 8; a_lds[i] = swz(r, ac); }
    const int kq = lane & 15, nq = (lane >> 4) + 4 * wave;
    const float* bp;
    if (PAIRED) { const int seg = (nq >> 2) & 1, idx = (nq >> 3) * 16 + (nq & 3) * 4; bp = (seg ? B1 : B0) + idx; }
    else { const int c4 = 4 * nq < ncol_valid ? 4 * nq : ncol_valid - 4; bp = B0 + c4; }
    bp += (size_t)(4 * kq) * ldb;
    int b_lds[4];
#pragma unroll
    for (int i = 0; i < 4; ++i) b_lds[i] = 32768 + swz(4 * nq + i, kq >> 1) + (kq & 1) * 8;
    const int sx = (fr >> 1) & 7;
    const int aoff0 = (wr * 64 + fr) * 128 + ((fq ^ sx) << 4), aoff1 = (wr * 64 + fr) * 128 + (((4 + fq) ^ sx) << 4);
    const int boff0 = 32768 + (wc * 64 + fr) * 128 + ((fq ^ sx) << 4), boff1 = 32768 + (wc * 64 + fr) * 128 + (((4 + fq) ^ sx) << 4);
    u32x4 av0[4], av1[4]; f32x4 bv0[4], bv1[4];
#define G_LOAD(av, bv, t) do { _Pragma("unroll") for (int i = 0; i < 4; ++i) av[i] = *(const u32x4*)(ap[i] + (t) * 64); \
        _Pragma("unroll") for (int kk = 0; kk < 4; ++kk) bv[kk] = *(const f32x4*)(bp + ((size_t)(t) * 64 + kk) * ldb); } while (0)
#define G_WRITE(s_, av, bv) do { _Pragma("unroll") for (int i = 0; i < 4; ++i) *(u32x4*)((s_) + a_lds[i]) = av[i]; \
        _Pragma("unroll") for (int i = 0; i < 4; ++i) { u32x2 w_; w_.x = cvt_pk_bf16(bv[0][i], bv[1][i]); w_.y = cvt_pk_bf16(bv[2][i], bv[3][i]); *(u32x2*)((s_) + b_lds[i]) = w_; } } while (0)
#define G_MMA(Af, Bf) do { __builtin_amdgcn_s_setprio(1); _Pragma("unroll") for (int m = 0; m < 4; ++m) _Pragma("unroll") for (int n = 0; n < 4; ++n) \
        acc[m][n] = __builtin_amdgcn_mfma_f32_16x16x32_bf16(Bf[n], Af[m], acc[m][n], 0, 0, 0); __builtin_amdgcn_s_setprio(0); } while (0)
#define G_SB() __builtin_amdgcn_sched_barrier(0)
#define G_ITER(t, c_, n_, av, bv, W_, L_) do { \
        bf16x8 Af[4], Bf[4]; \
        _Pragma("unroll") for (int m = 0; m < 4; ++m) Af[m] = *(const bf16x8*)((c_) + aoff0 + m * 2048); \
        _Pragma("unroll") for (int n = 0; n < 4; ++n) Bf[n] = *(const bf16x8*)((c_) + boff0 + n * 2048); \
        G_SB(); asm volatile("s_waitcnt lgkmcnt(0)" ::: "memory"); G_SB(); \
        G_MMA(Af, Bf); G_SB(); \
        _Pragma("unroll") for (int m = 0; m < 4; ++m) Af[m] = *(const bf16x8*)((c_) + aoff1 + m * 2048); \
        _Pragma("unroll") for (int n = 0; n < 4; ++n) Bf[n] = *(const bf16x8*)((c_) + boff1 + n * 2048); \
        G_SB(); \
        if (W_) { G_WRITE(n_, av, bv); G_SB(); asm volatile("s_waitcnt lgkmcnt(8)" ::: "memory"); } else { asm volatile("s_waitcnt lgkmcnt(0)" ::: "memory"); } \
        G_SB(); \
        G_MMA(Af, Bf); G_SB(); \
        if (L_) G_LOAD(av, bv, (t) + 3); \
        G_SB(); asm volatile("s_waitcnt lgkmcnt(0)" ::: "memory"); __builtin_amdgcn_s_barrier(); G_SB(); } while (0)
    f32x4 acc[4][4];
#pragma unroll
    for (int m = 0; m < 4; ++m)
#pragma unroll
        for (int n = 0; n < 4; ++n) acc[m][n] = (f32x4){0.f, 0.f, 0.f, 0.f};
    const int nk = K >> 6;
    char* L0 = lds; char* L1 = lds + G_STAGE;
    G_LOAD(av0, bv0, 0);
    G_WRITE(L0, av0, bv0);
    if (nk > 1) G_LOAD(av1, bv1, 1);
    if (nk > 2) G_LOAD(av0, bv0, 2);
    asm volatile("s_waitcnt lgkmcnt(0)" ::: "memory"); __builtin_amdgcn_s_barrier(); G_SB();
    int t = 0;
    for (; t + 4 < nk; t += 2) {
        G_ITER(t, L0, L1, av1, bv1, true, true);
        G_ITER(t + 1, L1, L0, av0, bv0, true, true);
    }
    for (; t < nk; t += 2) {
        G_ITER(t, L0, L1, av1, bv1, t + 1 < nk, t + 3 < nk);
        if (t + 1 < nk) G_ITER(t + 1, L1, L0, av0, bv0, t + 2 < nk, t + 4 < nk);
    }
#undef G_LOAD
#undef G_WRITE
#undef G_MMA
#undef G_ITER
#undef G_SB
    epi(acc, wr, wc, fr, fq);
}


#define PG8_LAS __attribute__((address_space(3)))
namespace pg8 {
constexpr int BM = 256, BK = 64, HALF = 128, HTB = HALF * BK * 2, STAGE_BYTES = 8 * HTB;
DEVI int lds_byte(int r, int c) { const int st = (r >> 4) * 2 + (c >> 5), rr = r & 15, cc = c & 31, ob = rr * 64 + cc * 2; return st * 1024 + (ob ^ (((ob >> 9) & 1) << 5)); }
DEVI void stage_rc(int b, int& R, int& C) { const int st = b / 1024, sb = b % 1024, swz_ = sb ^ (((sb >> 9) & 1) << 5); R = (st >> 1) * 16 + swz_ / 64; C = (st & 1) * 32 + (swz_ % 64) / 2; }
DEVI int perm32(int rho) { const int n = rho >> 4, i = rho & 15; return 8 * (i >> 2) + 4 * n + (i & 3); }
struct Unit { const char* a; const char* b; int x0, x1, x2; };
template <class Epi, class Sched>
DEVI void gemm_phase(PG8_LAS unsigned char* lds, int K, size_t hstepB, const Sched& S, const Epi& E) {
    const int tid = tid_(), wid = __builtin_amdgcn_readfirstlane(tid >> 6), lane = tid & 63, wr = wid >> 2, wc = wid & 3, fr = lane & 15, fq = lane >> 4;
    const int nt = K / BK;
    unsigned voffA[2], voffB[2];
#pragma unroll
    for (int i = 0; i < 2; ++i) { int R, C; stage_rc(tid * 16 + i * 8192, R, C); const int Rb = Epi::PERM ? ((R & ~31) + perm32(R & 31)) : R;
        voffA[i] = (unsigned)(R * K + C) * 2u; voffB[i] = (unsigned)(Rb * K + C) * 2u; }
    const size_t kstep = (size_t)(BK * 2);
    const size_t hstep = (size_t)HALF * K * 2;
    const unsigned ldsw = (unsigned)wid * 1024u;
    const int aoff = lds_byte(wr * 64 + fr, fq * 8), boff = lds_byte(wc * 32 + fr, fq * 8);
#define PG8_SA(b, h) (((b) * 2 + (h)) * HTB)
#define PG8_SB(b, h) ((4 + (b) * 2 + (h)) * HTB)
#define PG8_STAGE(bufoff, gbase, voff) do { _Pragma("unroll") for (int _i = 0; _i < 2; ++_i) \
        __builtin_amdgcn_global_load_lds((const unsigned*)((const char*)(gbase) + (voff)[_i]), (PG8_LAS unsigned*)(lds + (bufoff) + ldsw + _i * 8192), 16, 0, 0); } while (0)
#define PG8_LDA(dst, b, h) do { _Pragma("unroll") for (int m = 0; m < 4; ++m) _Pragma("unroll") for (int k = 0; k < 2; ++k) dst[m][k] = *(const PG8_LAS bf16x8*)(lds + PG8_SA(b, h) + aoff + m * 2048 + k * 1024); } while (0)
#define PG8_LDB(dst, b, h) do { _Pragma("unroll") for (int n = 0; n < 2; ++n) _Pragma("unroll") for (int k = 0; k < 2; ++k) dst[n][k] = *(const PG8_LAS bf16x8*)(lds + PG8_SB(b, h) + boff + n * 2048 + k * 1024); } while (0)
#define PG8_MMA(ai, bj, At, Bt) do { __builtin_amdgcn_s_setprio(1); _Pragma("unroll") for (int m = 0; m < 4; ++m) _Pragma("unroll") for (int n = 0; n < 2; ++n) _Pragma("unroll") for (int k = 0; k < 2; ++k) \
        acc[ai][bj][m][n] = __builtin_amdgcn_mfma_f32_16x16x32_bf16(Bt[n][k], At[m][k], acc[ai][bj][m][n], 0, 0, 0); __builtin_amdgcn_s_setprio(0); } while (0)
#define PG8_WAIT_V(n) asm volatile("s_waitcnt vmcnt(" #n ")" ::: "memory")
#define PG8_WAIT_L(n) asm volatile("s_waitcnt lgkmcnt(" #n ")" ::: "memory")
#define PG8_BAR __builtin_amdgcn_s_barrier()
#define PG8_SCHED __builtin_amdgcn_sched_barrier(0)
    Unit cur, nxt; int ui = 0;
    if (!S.next(0, cur)) return;
    f32x4 acc[2][2][4][2];
#pragma unroll
    for (int a = 0; a < 2; ++a)
#pragma unroll
        for (int b = 0; b < 2; ++b)
#pragma unroll
            for (int m = 0; m < 4; ++m)
#pragma unroll
                for (int n = 0; n < 2; ++n) acc[a][b][m][n] = (f32x4){0.f, 0.f, 0.f, 0.f};
    bf16x8 At[4][2], B0[2][2], B1[2][2];
    const char* cA = cur.a; const char* cB = cur.b;
    PG8_STAGE(PG8_SB(0, 0), cB, voffB); PG8_STAGE(PG8_SA(0, 0), cA, voffA); PG8_STAGE(PG8_SB(0, 1), cB + hstepB, voffB); PG8_STAGE(PG8_SA(0, 1), cA + hstep, voffA);
    if (wr == 1) PG8_BAR;
    PG8_WAIT_V(4); PG8_BAR;
    PG8_STAGE(PG8_SB(1, 0), cB + kstep, voffB); PG8_STAGE(PG8_SA(1, 0), cA + kstep, voffA); PG8_STAGE(PG8_SB(1, 1), cB + hstepB + kstep, voffB);
    PG8_WAIT_V(6); PG8_BAR;
    for (;;) {
        const bool has_next = S.next(ui + 1, nxt);
        const char* nA = has_next ? nxt.a : cA; const char* nB = has_next ? nxt.b : cB;
        for (int t = 0; t < nt; t += 2) {
            const bool last = (t == nt - 2);
            const char* a1 = cA + (size_t)(t + 1) * kstep;
            const char* a2 = last ? nA : cA + (size_t)(t + 2) * kstep; const char* b2 = last ? nB : cB + (size_t)(t + 2) * kstep;
            const char* a3 = a2 + kstep; const char* b3 = b2 + kstep;
            PG8_LDB(B0, 0, 0); PG8_SCHED; PG8_LDA(At, 0, 0); PG8_STAGE(PG8_SA(1, 1), a1 + hstep, voffA);
            PG8_WAIT_L(8); PG8_BAR; PG8_WAIT_L(0); PG8_MMA(0, 0, At, B0); PG8_BAR; PG8_SCHED;
            PG8_LDB(B1, 0, 1); PG8_STAGE(PG8_SB(0, 0), b2, voffB);
            PG8_BAR; PG8_WAIT_L(0); PG8_MMA(0, 1, At, B1); PG8_BAR;
            PG8_LDA(At, 0, 1); PG8_STAGE(PG8_SA(0, 0), a2, voffA);
            PG8_BAR; PG8_WAIT_L(0); PG8_MMA(1, 0, At, B0); PG8_BAR; PG8_SCHED;
            PG8_STAGE(PG8_SB(0, 1), b2 + hstepB, voffB);
            PG8_WAIT_V(6); PG8_BAR; PG8_MMA(1, 1, At, B1); PG8_BAR;
            PG8_LDB(B0, 1, 0); PG8_SCHED; PG8_LDA(At, 1, 0); PG8_STAGE(PG8_SA(0, 1), a2 + hstep, voffA);
            PG8_WAIT_L(8); PG8_BAR; PG8_WAIT_L(0); PG8_MMA(0, 0, At, B0); PG8_BAR; PG8_SCHED;
            PG8_LDB(B1, 1, 1); PG8_STAGE(PG8_SB(1, 0), b3, voffB);
            PG8_BAR; PG8_WAIT_L(0); PG8_MMA(0, 1, At, B1); PG8_BAR;
            PG8_LDA(At, 1, 1); PG8_STAGE(PG8_SA(1, 0), a3, voffA);
            PG8_BAR; PG8_WAIT_L(0); PG8_MMA(1, 0, At, B0); PG8_BAR; PG8_SCHED;
            PG8_STAGE(PG8_SB(1, 1), b3 + hstepB, voffB);
            PG8_WAIT_V(6); PG8_BAR; PG8_MMA(1, 1, At, B1); PG8_BAR;
        }
        E(acc, cur, wr, wc, fr, fq);
        if (!has_next) break;
#pragma unroll
        for (int a = 0; a < 2; ++a)
#pragma unroll
            for (int b = 0; b < 2; ++b)
#pragma unroll
                for (int m = 0; m < 4; ++m)
#pragma unroll
                    for (int n = 0; n < 2; ++n) acc[a][b][m][n] = (f32x4){0.f, 0.f, 0.f, 0.f};
        cur = nxt; cA = nA; cB = nB; ++ui;
    }
    PG8_WAIT_V(0);
    if (wr == 0) PG8_BAR;
    PG8_BAR;
#undef PG8_SA
#undef PG8_SB
#undef PG8_STAGE
#undef PG8_LDA
#undef PG8_LDB
#undef PG8_MMA
#undef PG8_WAIT_V
#undef PG8_WAIT_L
#undef PG8_BAR
#undef PG8_SCHED
}
}

DEVI void conv_item(const float* __restrict__ W, int K, int N, bf16_t* __restrict__ Wt, int kb, int nb, int lane) {
    const int ko = lane & 7, nq = lane >> 3;
    const float* src = W + (size_t)(kb * 64 + ko * 8) * N + nb * 32 + nq * 4;
    f32x4 v[8];
#pragma unroll
    for (int kk = 0; kk < 8; ++kk) v[kk] = *(const f32x4*)(src + (size_t)kk * N);
    bf16_t* dst = Wt + (size_t)(nb * 32 + nq * 4) * K + kb * 64 + ko * 8;
#pragma unroll
    for (int i = 0; i < 4; ++i) { u32x4 o; o.x = cvt_pk_bf16(v[0][i], v[1][i]); o.y = cvt_pk_bf16(v[2][i], v[3][i]); o.z = cvt_pk_bf16(v[4][i], v[5][i]); o.w = cvt_pk_bf16(v[6][i], v[7][i]);
        *(u32x4*)(dst + (size_t)i * K) = o; }
}

namespace att {
typedef short s16x4 __attribute__((ext_vector_type(4)));
typedef float f32x16 __attribute__((ext_vector_type(16)));
constexpr int KVBLK = 64;
constexpr float SCALE = 0.10206207261596577f;
constexpr float THR = 8.f;
constexpr int SHM_V = 16384, SHM_K = 16384, SHM_ATTN = 2 * SHM_V + 2 * SHM_K + 8 * 64 * 4;
#define KSWZ(row, colB) ((row) * 256 + ((colB) ^ (((row) & 7) << 4)))
#define SBAR() __builtin_amdgcn_sched_barrier(0)
DEVI int crow(int r, int hi) { return (r & 3) + 8 * (r >> 2) + 4 * hi; }
DEVI void partialSM(f32x16& p0, f32x16& p1, float& m_reg, float& mn, float& alpha) {
    constexpr float C = SCALE * 1.4426950408889634f;
    float pmax = p0[0];
#pragma unroll
    for (int r = 1; r < 16; ++r) pmax = fmaxf(pmax, p0[r]);
#pragma unroll
    for (int r = 0; r < 16; ++r) pmax = fmaxf(pmax, p1[r]);
    { auto rr = __builtin_amdgcn_permlane32_swap(__float_as_uint(pmax), __float_as_uint(pmax), false, false);
      pmax = fmaxf(__uint_as_float(rr[0]), __uint_as_float(rr[1])); }
    if (__builtin_expect(__all(pmax - m_reg <= THR / SCALE), 1)) { mn = m_reg; alpha = 1.f; }
    else { mn = fmaxf(m_reg, pmax); alpha = __builtin_amdgcn_exp2f((m_reg - mn) * C); m_reg = mn; }
    const float mnC = -mn * C;
#pragma unroll
    for (int r = 0; r < 16; ++r) p0[r] = fmaf(p0[r], C, mnC);
#pragma unroll
    for (int r = 0; r < 16; ++r) p1[r] = fmaf(p1[r], C, mnC);
#pragma unroll
    for (int r = 0; r < 16; ++r) p0[r] = __builtin_amdgcn_exp2f(p0[r]);
}
DEVI void finishSM(f32x16& p0, f32x16& p1, float alpha, float& l_reg, bf16x8& pa0, bf16x8& pa1, bf16x8& pa2, bf16x8& pa3) {
#pragma unroll
    for (int r = 0; r < 16; ++r) p1[r] = __builtin_amdgcn_exp2f(p1[r]);
    float ps = 0.f;
#pragma unroll
    for (int r = 0; r < 16; ++r) ps += p0[r];
#pragma unroll
    for (int r = 0; r < 16; ++r) ps += p1[r];
    { auto rr = __builtin_amdgcn_permlane32_swap(__float_as_uint(ps), __float_as_uint(ps), false, false);
      ps = __uint_as_float(rr[0]) + __uint_as_float(rr[1]); }
    l_reg = l_reg * alpha + ps;
#define PK4(P, BASE, OUT) do { unsigned a0 = cvt_pk_bf16(P[BASE + 0], P[BASE + 1]), a1 = cvt_pk_bf16(P[BASE + 2], P[BASE + 3]);   \
    unsigned b0 = cvt_pk_bf16(P[BASE + 4], P[BASE + 5]), b1 = cvt_pk_bf16(P[BASE + 6], P[BASE + 7]);                              \
    auto r0 = __builtin_amdgcn_permlane32_swap(a0, b0, false, false); auto r1 = __builtin_amdgcn_permlane32_swap(a1, b1, false, false); \
    u32x4 w = {r0[0], r1[0], r0[1], r1[1]}; OUT = *reinterpret_cast<bf16x8*>(&w); } while (0)
    PK4(p0, 0, pa0); PK4(p0, 8, pa1); PK4(p1, 0, pa2); PK4(p1, 8, pa3);
#undef PK4
}
DEVI void qkt(f32x16& p0, f32x16& p1, const char* Ks, const bf16x8* qr, int r32, int hi) {
    p0 = f32x16{}; p1 = f32x16{};
#pragma unroll
    for (int d0 = 0; d0 < 6; ++d0) { const int cb = (d0 * 16 + hi * 8) * 2;
        const bf16x8 b0 = *reinterpret_cast<const bf16x8*>(Ks + KSWZ(r32, cb));
        const bf16x8 b1 = *reinterpret_cast<const bf16x8*>(Ks + KSWZ(32 + r32, cb));
        p0 = __builtin_amdgcn_mfma_f32_32x32x16_bf16(b0, qr[d0], p0, 0, 0, 0);
        p1 = __builtin_amdgcn_mfma_f32_32x32x16_bf16(b1, qr[d0], p1, 0, 0, 0); }
}
DEVI int v_st(int k, int c) { const int kk = (k & ~0xC) | ((k & 4) << 1) | ((k & 8) >> 1); return ((kk >> 3) * 4 + (c >> 5)) * 512 + ((kk & 7) * 32 + (c & 31)) * 2; }
DEVI int v_rd_base(int lane) { return ((lane & 3) << 3) | (((lane >> 2) & 3) << 6) | (((lane >> 4) & 1) << 5) | (((lane >> 5) & 1) << 8); }
constexpr int v_rd_off(int d0, int ks, int half) { return d0 * 512 + ks * 4096 + half * 2048; }
template <int OFF> DEVI s16x4 tr_read(int vb) {
    s16x4 r; asm volatile("ds_read_b64_tr_b16 %0, %1 offset:%2" : "=&v"(r) : "v"(vb), "i"(OFF) : "memory"); return r;
}
template <int D0> DEVI void pv_one(f32x16& od, int vb, bf16x8 pa0, bf16x8 pa1, bf16x8 pa2, bf16x8 pa3) {
    const s16x4 l0 = tr_read<v_rd_off(D0, 0, 0)>(vb), h0 = tr_read<v_rd_off(D0, 0, 1)>(vb), l1 = tr_read<v_rd_off(D0, 1, 0)>(vb), h1 = tr_read<v_rd_off(D0, 1, 1)>(vb);
    const s16x4 l2 = tr_read<v_rd_off(D0, 2, 0)>(vb), h2 = tr_read<v_rd_off(D0, 2, 1)>(vb), l3 = tr_read<v_rd_off(D0, 3, 0)>(vb), h3 = tr_read<v_rd_off(D0, 3, 1)>(vb);
    asm volatile("s_waitcnt lgkmcnt(0)" ::: "memory"); SBAR();
#define PKV(L, H) (bf16x8){L[0], L[1], L[2], L[3], H[0], H[1], H[2], H[3]}
    od = __builtin_amdgcn_mfma_f32_32x32x16_bf16(pa0, PKV(l0, h0), od, 0, 0, 0);
    od = __builtin_amdgcn_mfma_f32_32x32x16_bf16(pa1, PKV(l1, h1), od, 0, 0, 0);
    od = __builtin_amdgcn_mfma_f32_32x32x16_bf16(pa2, PKV(l2, h2), od, 0, 0, 0);
    od = __builtin_amdgcn_mfma_f32_32x32x16_bf16(pa3, PKV(l3, h3), od, 0, 0, 0);
#undef PKV
}
DEVI void pv_d0(f32x16* o, int vb, bf16x8 pa0, bf16x8 pa1, bf16x8 pa2, bf16x8 pa3) {
    pv_one<0>(o[0], vb, pa0, pa1, pa2, pa3); pv_one<1>(o[1], vb, pa0, pa1, pa2, pa3);
}
DEVI void attn_unit(const bf16_t* __restrict__ Qb, const bf16_t* __restrict__ Kh, const bf16_t* __restrict__ Vh, int seq, bf16_t* __restrict__ Ob, int ldo, char* lds) {
    const int tid = tid_(), wid = tid >> 6, lane = tid & 63, r32 = lane & 31, hi = lane >> 5;
    char* V_lds = lds; char* K_lds = lds + 2 * SHM_V;
    float* wsl = (float*)(lds + 2 * SHM_V + 2 * SHM_K) + wid * 64; float* li_l = wsl; float* al_l = wsl + 32;
    float m_reg = -1e30f, l_reg = 0.f; f32x16 o[2] = {}; bf16x8 qr[6];
    const bf16_t* Qw = Qb + (size_t)(wid * 32 + r32) * 96 + hi * 8;
#pragma unroll
    for (int d0 = 0; d0 < 6; ++d0) qr[d0] = *reinterpret_cast<const bf16x8*>(Qw + d0 * 16);
    const int sr = tid >> 4, kc = tid & 15, kcl = (kc < 12 ? kc : 11) * 8;
    const int vr = tid >> 3, vc = (tid & 7) * 8, vst0 = v_st(vr, vc);
    const int kst0 = KSWZ(sr, kc * 16), kst1 = KSWZ(32 + sr, kc * 16);
    const int vb0 = (int)(uintptr_t)V_lds + v_rd_base(lane);
    bf16x8 sv0, sk00, sk01, sv1, sk10, sk11;
#define SLOAD0(k0) do { sv0 = *reinterpret_cast<const bf16x8*>(Vh + (size_t)((k0) + vr) * 64 + vc); sk00 = *reinterpret_cast<const bf16x8*>(Kh + (size_t)((k0) + sr) * 96 + kcl); \
    sk01 = *reinterpret_cast<const bf16x8*>(Kh + (size_t)((k0) + 32 + sr) * 96 + kcl); } while (0)
#define SLOAD1(k0) do { sv1 = *reinterpret_cast<const bf16x8*>(Vh + (size_t)((k0) + vr) * 64 + vc); sk10 = *reinterpret_cast<const bf16x8*>(Kh + (size_t)((k0) + sr) * 96 + kcl); \
    sk11 = *reinterpret_cast<const bf16x8*>(Kh + (size_t)((k0) + 32 + sr) * 96 + kcl); } while (0)
#define SWRITE0(b) do { *(bf16x8*)(V_lds + (b) * SHM_V + vst0) = sv0; *(bf16x8*)(K_lds + (b) * SHM_K + kst0) = sk00; *(bf16x8*)(K_lds + (b) * SHM_K + kst1) = sk01; } while (0)
#define SWRITE1(b) do { *(bf16x8*)(V_lds + (b) * SHM_V + vst0) = sv1; *(bf16x8*)(K_lds + (b) * SHM_K + kst0) = sk10; *(bf16x8*)(K_lds + (b) * SHM_K + kst1) = sk11; } while (0)
#define SWAIT() asm volatile("s_waitcnt vmcnt(3)" ::: "memory")
#define RESC(a) do { if (__any((a) < 1.f)) { if (hi == 0) al_l[r32] = (a); asm volatile("s_waitcnt lgkmcnt(0)" ::: "memory"); \
    _Pragma("unroll") for (int d = 0; d < 2; ++d) _Pragma("unroll") for (int r = 0; r < 16; ++r) o[d][r] *= al_l[crow(r, hi)]; } } while (0)
    f32x16 pA0, pA1, pB0, pB1; float mnA, mnB, alA, alB; bf16x8 pa0, pa1, pa2, pa3; const int NT = seq / KVBLK;
    SLOAD0(0); asm volatile("s_waitcnt vmcnt(0)" ::: "memory"); SWRITE0(0); __syncthreads();
    qkt(pA0, pA1, K_lds, qr, r32, hi); partialSM(pA0, pA1, m_reg, mnA, alA);
    SLOAD1(KVBLK); if (2 < NT) SLOAD0(2 * KVBLK);
    SWAIT(); SWRITE1(1); __syncthreads();
    for (int j = 1; j + 1 < NT; j += 2) {
        SBAR(); qkt(pB0, pB1, K_lds + SHM_K, qr, r32, hi);
        finishSM(pA0, pA1, alA, l_reg, pa0, pa1, pa2, pa3); SBAR();
        SLOAD1((j + 2) * KVBLK); SBAR();
        pv_d0(o, vb0, pa0, pa1, pa2, pa3); partialSM(pB0, pB1, m_reg, mnB, alB);
        __syncthreads(); SWAIT(); SWRITE0(0);
        RESC(alB); __syncthreads();
        SBAR(); qkt(pA0, pA1, K_lds, qr, r32, hi);
        finishSM(pB0, pB1, alB, l_reg, pa0, pa1, pa2, pa3); SBAR();
        if (j + 3 < NT) SLOAD0((j + 3) * KVBLK); SBAR();
        pv_d0(o, vb0 + SHM_V, pa0, pa1, pa2, pa3); partialSM(pA0, pA1, m_reg, mnA, alA);
        __syncthreads(); SWAIT(); SWRITE1(1);
        RESC(alA); __syncthreads();
    }
    SBAR(); qkt(pB0, pB1, K_lds + SHM_K, qr, r32, hi);
    finishSM(pA0, pA1, alA, l_reg, pa0, pa1, pa2, pa3); SBAR();
    pv_d0(o, vb0, pa0, pa1, pa2, pa3); partialSM(pB0, pB1, m_reg, mnB, alB);
    __syncthreads(); RESC(alB);
    finishSM(pB0, pB1, alB, l_reg, pa0, pa1, pa2, pa3); SBAR();
    pv_d0(o, vb0 + SHM_V, pa0, pa1, pa2, pa3);
    if (hi == 0) li_l[r32] = l_reg; asm volatile("s_waitcnt lgkmcnt(0)" ::: "memory");
    float rli[16];
#pragma unroll
    for (int r = 0; r < 16; ++r) rli[r] = __builtin_amdgcn_rcpf(li_l[crow(r, hi)]);
    bf16_t* Ow = Ob + (size_t)(wid * 32) * ldo;
#pragma unroll
    for (int r = 0; r < 16; ++r) { const int orow = crow(r, hi);
#pragma unroll
        for (int d0 = 0; d0 < 2; ++d0) Ow[(size_t)orow * ldo + d0 * 32 + r32] = f2bf(o[d0][r] * rli[r]); }
    __syncthreads();
#undef SLOAD0
#undef SLOAD1
#undef SWRITE0
#undef SWRITE1
#undef SWAIT
#undef RESC
}
#undef KSWZ
#undef SBAR
}

template <class ARow, class BMap, class Epi>
DEVI void gemm_tile(int K, ARow arow, const float* __restrict__ B, int ldb, BMap bmap, Epi epi, float* smem) {
    float (*As)[132] = (float (*)[132])smem;
    float (*Bs)[64] = (float (*)[64])(smem + 16 * 132);
    const int tid = tid_(), ty = tid >> 4, tx = tid & 15;
    float acc[4][4];
#pragma unroll
    for (int i = 0; i < 4; ++i)
#pragma unroll
        for (int j = 0; j < 4; ++j) acc[i][j] = 0.f;
    const int ar = tid >> 2, akq = tid & 3;
    const float* ap = arow(ar);
    const int bk0 = tid >> 6, bc = tid & 63;
    const int bcol = bmap(bc);
    for (int k0 = 0; k0 < K; k0 += 16) {
        float4 av = make_float4(0.f, 0.f, 0.f, 0.f);
        if (ap) av = *(const float4*)(ap + k0 + akq * 4);
        float b0 = 0.f, b1 = 0.f;
        if (bcol >= 0) { b0 = B[(size_t)(k0 + bk0) * ldb + bcol]; b1 = B[(size_t)(k0 + bk0 + 8) * ldb + bcol]; }
        __syncthreads();
        As[akq * 4 + 0][ar] = av.x; As[akq * 4 + 1][ar] = av.y; As[akq * 4 + 2][ar] = av.z; As[akq * 4 + 3][ar] = av.w;
        Bs[bk0][bc] = b0; Bs[bk0 + 8][bc] = b1;
        __syncthreads();
#pragma unroll
        for (int kk = 0; kk < 16; ++kk) {
            const float4 a = *(const float4*)&As[kk][ty * 4];
            const float4 b = *(const float4*)&Bs[kk][tx * 4];
            const float aa[4] = {a.x, a.y, a.z, a.w}, bb[4] = {b.x, b.y, b.z, b.w};
#pragma unroll
            for (int i = 0; i < 4; ++i)
#pragma unroll
                for (int j = 0; j < 4; ++j) acc[i][j] = fmaf(aa[i], bb[j], acc[i][j]);
        }
    }
#pragma unroll
    for (int i = 0; i < 4; ++i) epi(ty * 4 + i, tx, acc[i]);
    __syncthreads();
}


struct UnitRange { int lo, hi, step; };
DEVI UnitRange unit_range(int nunits, int bid) {
    UnitRange r;
    if ((gridDim.x & 7) == 0) { const int x = bid & 7, j = bid >> 3; r.lo = (int)(((long)nunits * x) >> 3) + j; r.hi = (int)(((long)nunits * (x + 1)) >> 3); r.step = gridDim.x >> 3; }
    else { r.lo = bid; r.hi = nunits; r.step = gridDim.x; }
    return r;
}

__device__ void phase_convert(const Params& p) {
    const int tid = tid_(), bid = bid_();
    const int lane = tid & 63, gw = bid * (NTHR / 64) + (tid >> 6), nw = gridDim.x * (NTHR / 64);
    constexpr int NI_GU = NLAYER * NEXP * 16 * 64, NI_DN = NLAYER * NEXP * 16 * 32, NI_OUT = NLAYER * 16 * 32, NI_IN = NLAYER * 16 * 51;
    bf16_t* wgu = (bf16_t*)(p.ws + W_WGU); bf16_t* wdn = (bf16_t*)(p.ws + W_WDN); bf16_t* wout = (bf16_t*)(p.ws + W_WOUT); bf16_t* win = (bf16_t*)(p.ws + W_WIN);
    for (int it = gw; it < NI_GU + NI_DN + NI_OUT + NI_IN; it += nw) {
        int r = it;
        if (r < NI_GU) { const int mat = r >> 10, q = r & 1023; conv_item(p.in[I_WGU] + (size_t)mat * D * 2048, D, 2048, wgu + (size_t)mat * 2048 * D, q >> 6, q & 63, lane); continue; }
        r -= NI_GU;
        if (r < NI_DN) { const int mat = r >> 9, q = r & 511; conv_item(p.in[I_WDN] + (size_t)mat * D * D, D, D, wdn + (size_t)mat * D * D, q >> 5, q & 31, lane); continue; }
        r -= NI_DN;
        if (r < NI_OUT) { const int mat = r >> 9, q = r & 511; conv_item(p.in[I_WOUT] + (size_t)mat * D * D, D, D, wout + (size_t)mat * D * D, q >> 5, q & 31, lane); continue; }
        r -= NI_OUT;
        { const int mat = r / 816, q = r % 816; conv_item(p.in[I_WIN] + (size_t)mat * D * INC, D, INC, win + (size_t)mat * NPAD_IN * D, q / 51, q % 51, lane); }
    }
}

__device__ void phase_init(const Params& p) {
    const int tid = tid_(), bid = bid_(); (void)tid; (void)bid;
    float* ws = p.ws;
    const size_t n4 = (size_t)T * D / 4;
    for (size_t i = (size_t)bid * NTHR + tid; i < n4; i += (size_t)gridDim.x * NTHR) {
        const size_t e = i * 4;
        float4 v = (e < (size_t)NLAT * D) ? *(const float4*)(p.in[I_X] + e) : *(const float4*)(p.in[I_CTX] + (e - (size_t)NLAT * D));
        *(float4*)(ws + W_X + e) = v;
    }
    for (int i = bid * NTHR + tid; i < NLAYER * 4 * 128 * 128; i += gridDim.x * NTHR) ((bf16_t*)(ws + W_WSB))[i] = f2bf(p.in[I_SGWS][i]);
    for (int i = bid * NTHR + tid; i < NLAT * 16; i += gridDim.x * NTHR) {
        const int t = i >> 4, f = i & 15; const float pos = (f < 8) ? (float)(t >> 6) : (float)(t & 63);
        const float ang = pos * powf(10000.f, -(float)(f & 7) / 8.f);
        ws[W_ROPE + (size_t)t * 32 + f] = cosf(ang); ws[W_ROPE + (size_t)t * 32 + 16 + f] = sinf(ang);
    }
    if (bid == 0) for (int i = tid; i < NLAYER * NEXP * 64; i += NTHR) ((int*)(ws + W_CNT))[i] = 0;
}

__device__ void phase_mod(const Params& p, float* smem) {
    const int tid = tid_(), bid = bid_(); (void)tid; (void)bid;
    const int wave = tid >> 6, lane = tid & 63;
    for (int it = bid; it < NLAYER * 96; it += gridDim.x) {
        const int l = it / 96, j = (it % 96) * 64 + lane;
        const float* W = p.in[I_WMOD] + (size_t)l * 1024 * 6144;
        float a0 = 0.f, a1 = 0.f;
        for (int k = wave * 128; k < wave * 128 + 128; ++k) {
            const float w = W[(size_t)k * 6144 + j];
            a0 = fmaf(silu(p.in[I_C][k]), w, a0);
            a1 = fmaf(silu(p.in[I_CCTX][k]), w, a1);
        }
        smem[(wave * 2 + 0) * 64 + lane] = a0; smem[(wave * 2 + 1) * 64 + lane] = a1;
        __syncthreads();
        if (wave < 2) {
            float s = 0.f;
            for (int w = 0; w < 8; ++w) s += smem[(w * 2 + wave) * 64 + lane];
            p.ws[W_MOD + (size_t)(l * 2 + wave) * 6144 + j] = s + p.in[I_BMOD][l * 6144 + j];
        }
        __syncthreads();
    }
}

__device__ void phase_norm(const Params& p, int l, int which) {
    const int tid = tid_(), bid = bid_(); (void)tid; (void)bid;
    const int lane = tid & 63, gw = bid * (NTHR / 64) + (tid >> 6), nw = gridDim.x * (NTHR / 64);
    const float* g = p.in[which ? I_NFFN : I_NMIX] + l * D;
    for (int t = gw; t < T; t += nw) {
        const float* x = p.ws + W_X + (size_t)t * D;
        const float* mod = p.ws + W_MOD + (size_t)(l * 2 + (t >= NLAT ? 1 : 0)) * 6144;
        const float* sh = mod + (which ? 3 : 0) * D; const float* sc = mod + (which ? 4 : 1) * D;
        float4 v[4]; float ss = 0.f;
#pragma unroll
        for (int j = 0; j < 4; ++j) { v[j] = *(const float4*)(x + j * 256 + lane * 4); ss += v[j].x * v[j].x + v[j].y * v[j].y + v[j].z * v[j].z + v[j].w * v[j].w; }
        ss = wave_sum(ss);
        const float rstd = rsqrtf(ss * (1.f / D) + EPS);
#pragma unroll
        for (int j = 0; j < 4; ++j) {
            const int c = j * 256 + lane * 4;
            const float4 gg = *(const float4*)(g + c), s1 = *(const float4*)(sc + c), s0 = *(const float4*)(sh + c);
            float4 o;
            o.x = v[j].x * rstd * gg.x * (1.f + s1.x) + s0.x; o.y = v[j].y * rstd * gg.y * (1.f + s1.y) + s0.y;
            o.z = v[j].z * rstd * gg.z * (1.f + s1.z) + s0.z; o.w = v[j].w * rstd * gg.w * (1.f + s1.w) + s0.w;
            { u32x2 w; w.x = cvt_pk_bf16(o.x, o.y); w.y = cvt_pk_bf16(o.z, o.w); *(u32x2*)((bf16_t*)(p.ws + W_HB) + (size_t)t * D + c) = w; }
        }
    }
}

struct InprojSched {
    UnitRange ur; const char* A; const char* Bt;
    DEVI bool next(int i, pg8::Unit& u) const {
        const int id = ur.lo + i * ur.step; if (id >= ur.hi) return false;
        const int tm = id / 7, tn = id % 7;
        u.a = A + (size_t)tm * 256 * D * 2; u.b = Bt + (size_t)tn * 256 * D * 2; u.x0 = tm * 256; u.x1 = tn * 256; u.x2 = 0; return true;
    }
};
struct EpiInproj { static constexpr bool PERM = false; float* P;
    DEVI void operator()(const f32x4 (&acc)[2][2][4][2], const pg8::Unit& u, int wr, int wc, int fr, int fq) const {
#pragma unroll
        for (int ai = 0; ai < 2; ++ai)
#pragma unroll
            for (int m = 0; m < 4; ++m) { float* row = P + (size_t)(u.x0 + ai * 128 + wr * 64 + m * 16 + fr) * INC;
#pragma unroll
                for (int bj = 0; bj < 2; ++bj)
#pragma unroll
                    for (int n = 0; n < 2; ++n) { const int c = u.x1 + bj * 128 + wc * 32 + n * 16 + 4 * fq; if (c < INC) *(f32x4*)(row + c) = acc[ai][bj][m][n]; } }
    }
};
__device__ void phase_inproj(const Params& p, int l, char* lds) {
    const int tid = tid_(), bid = bid_(); (void)tid;
    InprojSched S; S.ur = unit_range((T / 256) * 7, bid); S.A = (const char*)(p.ws + W_HB); S.Bt = (const char*)((const bf16_t*)(p.ws + W_WIN) + (size_t)l * NPAD_IN * D);
    EpiInproj E; E.P = p.ws + W_P;
    pg8::gemm_phase((PG8_LAS unsigned char*)lds, D, (size_t)128 * D * 2, S, E);
}

__device__ void phase_prep1(const Params& p, int l) {
    const int tid = tid_(), bid = bid_(); (void)tid; (void)bid;
    const int lane = tid & 63, gw = bid * (NTHR / 64) + (tid >> 6), nw = gridDim.x * (NTHR / 64);
    float* ws = p.ws;
    for (int t = gw; t < T; t += nw) {
        const int s0 = (t < NLAT) ? 0 : NLAT, sl = (t < NLAT) ? NLAT : NCTX, n = t - s0;
        const float* P = ws + W_P; const float* pr = P + (size_t)t * INC;
        {
            const int g = lane >> 4, w = 2 << g;
            const int lo = max(n - w / 2, 0), hi = min(n + w / 2, sl);
            float4 s = make_float4(0.f, 0.f, 0.f, 0.f);
            for (int m = lo; m < hi; ++m) { const float4 v = *(const float4*)(P + (size_t)(s0 + m) * INC + OFF_A + lane * 4); s.x += v.x; s.y += v.y; s.z += v.z; s.w += v.w; }
            const float inv = 1.f / (float)(hi - lo);
            const float4 x = *(const float4*)(pr + OFF_A + lane * 4);
            float4 d; d.x = s.x * inv - x.x; d.y = s.y * inv - x.y; d.z = s.z * inv - x.z; d.w = s.w * inv - x.w;
            { u32x2 w; w.x = cvt_pk_bf16(d.x, d.y); w.y = cvt_pk_bf16(d.z, d.w); *(u32x2*)((bf16_t*)(ws + W_DIFF) + (size_t)t * 256 + lane * 4) = w; }
        }
        {
            float v[3]; float ss = 0.f;
#pragma unroll
            for (int j = 0; j < 3; ++j) { v[j] = pr[OFF_Q + j * 64 + lane]; ss += v[j] * v[j]; }
            ss = wave_sum(ss); const float rstd = rsqrtf(ss * (1.f / 192.f) + EPS);
#pragma unroll
            for (int j = 0; j < 3; ++j) ((bf16_t*)(ws + W_QN))[(size_t)t * 192 + j * 64 + lane] = f2bf(v[j] * rstd * p.in[I_QAN][l * 192 + j * 64 + lane]);
        }
        {
            float v[2]; float ss = 0.f;
#pragma unroll
            for (int j = 0; j < 2; ++j) { v[j] = pr[OFF_KV + j * 64 + lane]; ss += v[j] * v[j]; }
            ss = wave_sum(ss); const float rstd = rsqrtf(ss * (1.f / 128.f) + EPS);
#pragma unroll
            for (int j = 0; j < 2; ++j) ((bf16_t*)(ws + W_KVN))[(size_t)t * 128 + j * 64 + lane] = f2bf(v[j] * rstd * p.in[I_KVAN][l * 128 + j * 64 + lane]);
        }
        {
            const float4 zu = *(const float4*)(pr + OFF_C + lane * 4), zv = *(const float4*)(pr + OFF_C + 256 + lane * 4);
            float4 u; u.x = gelu_tanh(zu.x); u.y = gelu_tanh(zu.y); u.z = gelu_tanh(zu.z); u.w = gelu_tanh(zu.w);
            *(float4*)(ws + W_U + (size_t)t * 256 + lane * 4) = u;
            float gv[4] = {gelu_tanh(zv.x), gelu_tanh(zv.y), gelu_tanh(zv.z), gelu_tanh(zv.w)};
            const float mu = wave_sum(gv[0] + gv[1] + gv[2] + gv[3]) * (1.f / 256.f);
            float q = 0.f;
#pragma unroll
            for (int j = 0; j < 4; ++j) { gv[j] -= mu; q += gv[j] * gv[j]; }
            const float rstd = rsqrtf(wave_sum(q) * (1.f / 256.f) + EPS);
#pragma unroll
            for (int j = 0; j < 4; ++j) ws[W_VN + (size_t)t * 256 + lane * 4 + j] = gv[j] * rstd * p.in[I_SGG][l * 256 + lane * 4 + j] + p.in[I_SGB][l * 256 + lane * 4 + j];
        }
        {
            const float* cw = p.in[I_CONVW] + (size_t)l * 4 * 256;
            float4 o = *(const float4*)(p.in[I_CONVB] + l * 256 + lane * 4);
#pragma unroll
            for (int k = 0; k < 4; ++k) {
                const int m = n - 1 + k;
                if (m >= 0 && m < sl) {
                    const float4 xv = *(const float4*)(P + (size_t)(s0 + m) * INC + OFF_DX + lane * 4), wv = *(const float4*)(cw + k * 256 + lane * 4);
                    o.x = fmaf(xv.x, wv.x, o.x); o.y = fmaf(xv.y, wv.y, o.y); o.z = fmaf(xv.z, wv.z, o.z); o.w = fmaf(xv.w, wv.w, o.w);
                }
            }
            *(float4*)(ws + W_XC + (size_t)t * 256 + lane * 4) = o;
            { u32x2 w; w.x = cvt_pk_bf16(o.x, o.y); w.y = cvt_pk_bf16(o.z, o.w); *(u32x2*)((bf16_t*)(ws + W_XCB) + (size_t)t * 256 + lane * 4) = w; }
        }
    }
}

__device__ void phase_small(const Params& p, int l, char* lds) {
    const int tid = tid_(), bid = bid_(); (void)tid;
    float* ws = p.ws;
    constexpr int NK = 19, NU1 = (T / 256) * NK, NU2 = NCHUNK * 2;
    bf16_t* Y = (bf16_t*)(ws + W_YC);
    for (int u = bid; u < NU1 + NU2; u += gridDim.x) {
        if (u < NU1) {
            const int tm = u / NK, kind = u % NK, m0 = tm * 256;
            if (kind < 11) {
                const bf16_t* A; int lda, K, ldb, nval; const float* B;
                if (kind < 4) { A = (const bf16_t*)(ws + W_DIFF) + kind * 64; lda = 256; K = 64; B = p.in[I_POOLW] + (size_t)(l * 4 + kind) * 64 * 64; ldb = 64; nval = 64; }
                else if (kind < 7) { A = (const bf16_t*)(ws + W_QN); lda = 192; K = 192; B = p.in[I_WUQ] + (size_t)l * 192 * 384 + (kind - 4) * 128; ldb = 384; nval = 128; }
                else { A = (const bf16_t*)(ws + W_KVN); lda = 128; K = 128; B = p.in[I_WUKV] + (size_t)l * 128 * 512 + (kind - 7) * 128; ldb = 512; nval = 128; }
                gemm_unit<false>(lds, K, [&](int r) { return A + (size_t)(m0 + r) * lda; }, B, B, ldb, nval,
                    [&](const f32x4 (&acc)[4][4], int wr, int wc, int fr, int fq) {
#pragma unroll
                        for (int m = 0; m < 4; ++m) { const int t = m0 + wr * 64 + m * 16 + fr;
#pragma unroll
                            for (int n = 0; n < 4; ++n) { const int c = wc * 64 + n * 16 + 4 * fq;
                                if (kind < 4) { if (wc == 0) { const f32x4 sc = *(const f32x4*)(p.in[I_POOLS] + l * 256 + kind * 64 + c); const f32x4 v = acc[m][n] * sc;
                                        u32x2 w; w.x = cvt_pk_bf16(v[0], v[1]); w.y = cvt_pk_bf16(v[2], v[3]); *(u32x2*)(Y + (size_t)t * D + kind * 64 + c) = w; } }
                                else if (kind < 7) *(f32x4*)(ws + W_QUP + (size_t)t * 384 + (kind - 4) * 128 + c) = acc[m][n];
                                else *(f32x4*)(ws + W_KVUP + (size_t)t * 512 + (kind - 7) * 128 + c) = acc[m][n]; } }
                    });
            } else {
                const int d = (kind - 11) >> 2, h = (kind - 11) & 3;
                const bf16_t* A = (const bf16_t*)(ws + W_XCB) + h * 64;
                const float* Ba = p.in[I_WA] + (size_t)((l * 2 + d) * 4 + h) * 64 * 64; const float* Bx = p.in[I_WX] + (size_t)((l * 2 + d) * 4 + h) * 64 * 64;
                const int pb = (l * 2 + d) * 256 + h * 64;
                gemm_unit<true>(lds, 64, [&](int r) { return A + (size_t)(m0 + r) * 256; }, Ba, Bx, 64, 64,
                    [&](const f32x4 (&acc)[4][4], int wr, int wc, int fr, int fq) {
#pragma unroll
                        for (int m = 0; m < 4; ++m) { const int t = m0 + wr * 64 + m * 16 + fr;
#pragma unroll
                            for (int pp = 0; pp < 2; ++pp) { const int idx = (wc * 2 + pp) * 16 + 4 * fq;
                                const f32x4 ba = *(const f32x4*)(p.in[I_BA] + pb + idx), bx = *(const f32x4*)(p.in[I_BX] + pb + idx), lam = *(const f32x4*)(p.in[I_LAM] + pb + idx);
                                const f32x4 xv = *(const f32x4*)(ws + W_XC + (size_t)t * 256 + h * 64 + idx);
                                f32x4 av, dv;
#pragma unroll
                                for (int j = 0; j < 4; ++j) { const float r = sigm(acc[m][2 * pp][j] + ba[j]), ig = sigm(acc[m][2 * pp + 1][j] + bx[j]);
                                    const float loga = -8.f * r * log1pf(expf(-lam[j]));
                                    av[j] = expf(loga); dv[j] = sqrtf(-expm1f(2.f * loga)) * (ig * xv[j]); }
                                *(f32x4*)(ws + W_LA + ((size_t)d * T + t) * 256 + h * 64 + idx) = av;
                                *(f32x4*)(ws + W_LB + ((size_t)d * T + t) * 256 + h * 64 + idx) = dv; } }
                    });
            }
        } else {
            const int v = u - NU1, c = v >> 1, hp = v & 1;
            const bf16_t* A = (const bf16_t*)(ws + W_WSB) + ((size_t)l * 512 + hp * 256) * 128;
            const float* B = ws + W_VN + (size_t)c * 128 * 256 + hp * 128;
            gemm_unit<false>(lds, 128, [&](int r) { return A + (size_t)r * 128; }, B, B, 256, 128,
                [&](const f32x4 (&acc)[4][4], int wr, int wc, int fr, int fq) {
                    if ((wr >> 1) == wc) {
                        const int h = hp * 2 + wc;
#pragma unroll
                        for (int m = 0; m < 4; ++m) { const int pp = (wr & 1) * 64 + m * 16 + fr, t = c * 128 + pp; const float bs = p.in[I_SGBS][(l * 4 + h) * 128 + pp];
#pragma unroll
                            for (int n = 0; n < 4; ++n) { const int ch = h * 64 + n * 16 + 4 * fq; const f32x4 uu = *(const f32x4*)(ws + W_U + (size_t)t * 256 + ch);
                                const f32x4 o = uu * (acc[m][n] + bs);
                                u32x2 w; w.x = cvt_pk_bf16(o[0], o[1]); w.y = cvt_pk_bf16(o[2], o[3]); *(u32x2*)(Y + (size_t)t * D + 512 + ch) = w; } }
                    }
                });
        }
    }
}

__device__ void phase_prep2(const Params& p, int l) {
    const int tid = tid_(), bid = bid_(); (void)tid; (void)bid;
    float* ws = p.ws;
    const int lane = tid & 63, gw = bid * (NTHR / 64) + (tid >> 6), nw = gridDim.x * (NTHR / 64);
    for (int it = gw; it < T * 4; it += nw) {
        const int t = it >> 2, h = it & 3;
        const bool lat = t < NLAT;
        float cs = 1.f, sn = 0.f;
        if (lat && lane < 32) { cs = ws[W_ROPE + (size_t)t * 32 + (lane & 15)]; sn = ws[W_ROPE + (size_t)t * 32 + 16 + (lane & 15)]; }
        {
            float v0 = ws[W_QUP + (size_t)t * 384 + h * 96 + lane], v1 = (lane < 32) ? ws[W_QUP + (size_t)t * 384 + h * 96 + 64 + lane] : 0.f;
            const float rstd = rsqrtf(wave_sum(v0 * v0 + v1 * v1) * (1.f / 96.f) + EPS);
            v0 *= rstd * p.in[I_QN][l * 96 + lane]; v1 *= (lane < 32) ? rstd * p.in[I_QN][l * 96 + 64 + lane] : 0.f;
            const float pv = __shfl_xor(v1, 16);
            const float r1 = (lane < 16) ? v1 * cs - pv * sn : pv * sn + v1 * cs;
            bf16_t* qo = (bf16_t*)(ws + W_Q) + ((size_t)h * T + t) * 96;
            qo[lane] = f2bf(v0);
            if (lane < 32) qo[64 + lane] = f2bf(lat ? r1 : v1);
        }
        {
            float v0 = ws[W_KVUP + (size_t)t * 512 + h * 128 + lane], v1 = (lane < 32) ? ws[W_P + (size_t)t * INC + OFF_KR + lane] : 0.f;
            const float rstd = rsqrtf(wave_sum(v0 * v0 + v1 * v1) * (1.f / 96.f) + EPS);
            v0 *= rstd * p.in[I_KN][l * 96 + lane]; v1 *= (lane < 32) ? rstd * p.in[I_KN][l * 96 + 64 + lane] : 0.f;
            const float pv = __shfl_xor(v1, 16);
            const float r1 = (lane < 16) ? v1 * cs - pv * sn : pv * sn + v1 * cs;
            bf16_t* ko = (bf16_t*)(ws + W_K) + ((size_t)h * T + t) * 96;
            ko[lane] = f2bf(v0);
            if (lane < 32) ko[64 + lane] = f2bf(lat ? r1 : v1);
            ((bf16_t*)(ws + W_V))[((size_t)h * T + t) * 64 + lane] = f2bf(ws[W_KVUP + (size_t)t * 512 + h * 128 + 64 + lane]);
        }
    }
    for (int i = bid * NTHR + tid; i < NCHUNK * 512; i += gridDim.x * NTHR) {
        const int c = i >> 9, d = (i >> 8) & 1, ch = i & 255;
        float* A = ws + W_LA + ((size_t)d * T + (size_t)c * 128) * 256 + ch;
        float* B = ws + W_LB + ((size_t)d * T + (size_t)c * 128) * 256 + ch;
        float h = 0.f, ap = 1.f;
        for (int s0 = 0; s0 < 128; s0 += 8) {
            float a[8], b[8];
#pragma unroll
            for (int j = 0; j < 8; ++j) { const int q = d ? 127 - (s0 + j) : s0 + j; a[j] = A[(size_t)q * 256]; b[j] = B[(size_t)q * 256]; }
#pragma unroll
            for (int j = 0; j < 8; ++j) { h = fmaf(a[j], h, b[j]); ap *= a[j]; a[j] = ap; b[j] = h; }
#pragma unroll
            for (int j = 0; j < 8; ++j) { const int q = d ? 127 - (s0 + j) : s0 + j; A[(size_t)q * 256] = a[j]; B[(size_t)q * 256] = b[j]; }
        }
        ws[W_AGG + ((size_t)(c * 2 + d) * 2 + 0) * 256 + ch] = ap;
        ws[W_AGG + ((size_t)(c * 2 + d) * 2 + 1) * 256 + ch] = h;
    }
}


__device__ void phase_attn(const Params& p, int l, char* lds) {
    const int tid = tid_(), bid = bid_(); (void)tid;
    const bf16_t* Qb = (const bf16_t*)(p.ws + W_Q); const bf16_t* Kb = (const bf16_t*)(p.ws + W_K); const bf16_t* Vb = (const bf16_t*)(p.ws + W_V);
    bf16_t* Y = (bf16_t*)(p.ws + W_YC);
    const int nunits = (l == 0) ? 260 : 256;
    for (int u = bid; u < nunits; u += gridDim.x) {
        int h, t0, k0, seq;
        if (u < 256) { h = (u & 7) >> 1; t0 = (((u >> 3) << 1) | (u & 1)) * 256; k0 = 0; seq = T; }
        else { h = u - 256; t0 = NLAT; k0 = NLAT; seq = NCTX; }
        att::attn_unit(Qb + ((size_t)h * T + t0) * 96, Kb + ((size_t)h * T + k0) * 96, Vb + ((size_t)h * T + k0) * 64, seq, Y + (size_t)t0 * D + 256 + h * 64, D, lds);
    }
}

__device__ void phase_lru_fin(const Params& p, char* lds) {
    const int tid = tid_(), bid = bid_();
    float* ws = p.ws;
    float* carry = (float*)lds;
    for (int c = bid; c < NCHUNK; c += gridDim.x) {
        {
            const int d = tid >> 8, ch = tid & 255;
            const int npre = d ? (NCHUNK - 1 - c) : ((c + 2) % NCHUNK);
            float s = 0.f;
            for (int k = 0; k < npre; ++k) {
                const int q = d ? (NCHUNK - 1 - k) : ((k + 128) % NCHUNK);
                const float a = ws[W_AGG + ((size_t)(q * 2 + d) * 2 + 0) * 256 + ch], hh = ws[W_AGG + ((size_t)(q * 2 + d) * 2 + 1) * 256 + ch];
                s = fmaf(a, s, hh);
            }
            carry[tid] = s;
        }
        __syncthreads();
        for (int i = tid; i < 128 * 64; i += NTHR) {
            const int t = c * 128 + (i >> 6), ch = (i & 63) * 4;
            f32x4 hs = *(const f32x4*)(ws + W_LB + (size_t)t * 256 + ch) + *(const f32x4*)(ws + W_LA + (size_t)t * 256 + ch) * *(const f32x4*)(carry + ch);
            hs = hs + *(const f32x4*)(ws + W_LB + ((size_t)T + t) * 256 + ch) + *(const f32x4*)(ws + W_LA + ((size_t)T + t) * 256 + ch) * *(const f32x4*)(carry + 256 + ch);
            const f32x4 g = *(const f32x4*)(ws + W_P + (size_t)t * INC + OFF_DG + ch);
            u32x2 w; w.x = cvt_pk_bf16(gelu_tanh(g[0]) * hs[0], gelu_tanh(g[1]) * hs[1]); w.y = cvt_pk_bf16(gelu_tanh(g[2]) * hs[2], gelu_tanh(g[3]) * hs[3]);
            *(u32x2*)((bf16_t*)(ws + W_YC) + (size_t)t * D + 768 + ch) = w;
        }
        __syncthreads();
    }
}

struct OutprojSched {
    UnitRange ur; const char* A; const char* Bt;
    DEVI bool next(int i, pg8::Unit& u) const {
        const int id = ur.lo + i * ur.step; if (id >= ur.hi) return false;
        const int tm = id >> 2, tn = id & 3;
        u.a = A + (size_t)tm * 256 * D * 2; u.b = Bt + (size_t)tn * 256 * D * 2; u.x0 = tm * 256; u.x1 = tn * 256; u.x2 = 0; return true;
    }
};
struct EpiOutproj { static constexpr bool PERM = false; float* X; const float* modv;
    DEVI void operator()(const f32x4 (&acc)[2][2][4][2], const pg8::Unit& u, int wr, int wc, int fr, int fq) const {
        const float* g1 = modv + (u.x0 >= NLAT ? 6144 : 0) + 2 * D;
#pragma unroll
        for (int ai = 0; ai < 2; ++ai)
#pragma unroll
            for (int m = 0; m < 4; ++m) { float* row = X + (size_t)(u.x0 + ai * 128 + wr * 64 + m * 16 + fr) * D;
#pragma unroll
                for (int bj = 0; bj < 2; ++bj)
#pragma unroll
                    for (int n = 0; n < 2; ++n) { const int c = u.x1 + bj * 128 + wc * 32 + n * 16 + 4 * fq; const f32x4 g = *(const f32x4*)(g1 + c); f32x4 x = *(f32x4*)(row + c);
                        x = x + g * acc[ai][bj][m][n]; *(f32x4*)(row + c) = x; } }
    }
};
__device__ void phase_outproj(const Params& p, int l, char* lds) {
    const int tid = tid_(), bid = bid_(); (void)tid;
    const int ntm = (l == NLAYER - 1) ? NLAT / 256 : T / 256;
    OutprojSched S; S.ur = unit_range(ntm * 4, bid); S.A = (const char*)(p.ws + W_YC); S.Bt = (const char*)((const bf16_t*)(p.ws + W_WOUT) + (size_t)l * D * D);
    EpiOutproj E; E.X = p.ws + W_X; E.modv = p.ws + W_MOD + (size_t)l * 2 * 6144;
    pg8::gemm_phase((PG8_LAS unsigned char*)lds, D, (size_t)128 * D * 2, S, E);
}

constexpr int R_LDS = 1024 * 36 * 4;
__device__ void phase_router(const Params& p, int l, char* lds) {
    const int tid = tid_(), bid = bid_();
    float* ws = p.ws;
    float* wl = (float*)lds;
    int* hist = (int*)(lds + R_LDS); int* bbase = hist + 32; int* tinfo = hist + 64 + (tid >> 6) * 40;
    if (tid < 32) hist[tid] = 0;
    {   const float* rw = p.in[I_RW] + (size_t)l * D * NEXP;
        for (int i = tid; i < 1024 * 8; i += NTHR) { const int k = i >> 3, e4 = i & 7; *(f32x4*)(wl + k * 36 + e4 * 4) = *(const f32x4*)(rw + k * 32 + e4 * 4); }
    }
    __syncthreads();
    const int lane = tid & 63, gw = bid * (NTHR / 64) + (tid >> 6), nw = gridDim.x * (NTHR / 64);
    const float* g = p.in[I_NFFN] + l * D;
    int* cnt = (int*)(ws + W_CNT) + l * NEXP * 64;
    bf16_t* HB = (bf16_t*)(ws + W_HB);

    const int e = lane >> 1;
    const float rb = p.in[I_RB][l * NEXP + e];
    const int TL = (l == NLAYER - 1) ? NLAT : T;
    int ti = 0;
    for (int t = gw; t < TL; t += nw, ++ti) {
        const float* x = ws + W_X + (size_t)t * D;
        const float* mod = ws + W_MOD + (size_t)(l * 2 + (t >= NLAT ? 1 : 0)) * 6144;
        float f[16]; float ss = 0.f;
#pragma unroll
        for (int m = 0; m < 16; ++m) { f[m] = x[lane + 64 * m]; ss = fmaf(f[m], f[m], ss); }
        const float rstd = rsqrtf(wave_sum(ss) * (1.f / D) + EPS);
#pragma unroll
        for (int m = 0; m < 16; ++m) { const int k = lane + 64 * m; f[m] = f[m] * rstd * g[k] * (1.f + mod[4 * D + k]) + mod[3 * D + k]; HB[(size_t)t * D + k] = f2bf(f[m]); }
        float acc[32];
#pragma unroll
        for (int j = 0; j < 32; ++j) acc[j] = 0.f;
#pragma unroll
        for (int m = 0; m < 16; ++m) {
            const float* wr = wl + (lane + 64 * m) * 36;
#pragma unroll
            for (int e4 = 0; e4 < 8; ++e4) { const f32x4 w4 = *(const f32x4*)(wr + e4 * 4);
#pragma unroll
                for (int j = 0; j < 4; ++j) acc[e4 * 4 + j] = fmaf(f[m], w4[j], acc[e4 * 4 + j]); }
        }
#pragma unroll
        for (int w = 16, msk = 32; w >= 1; w >>= 1, msk >>= 1) {
            const bool up = (lane & msk) != 0;
#pragma unroll
            for (int j = 0; j < w; ++j) { const float send = up ? acc[j] : acc[j + w], keep = up ? acc[j + w] : acc[j]; acc[j] = keep + __shfl_xor(send, msk); }
        }
        float a = acc[0] + __shfl_xor(acc[0], 1) + rb;
        float tv[4]; int te[4];
        float cur = a;
#pragma unroll
        for (int k = 0; k < 4; ++k) {
            float bv = cur; int bi = e;
#pragma unroll
            for (int o = 32; o > 1; o >>= 1) {
                const float ov = __shfl_xor(bv, o); const int oi = __shfl_xor(bi, o);
                if (ov > bv || (ov == bv && oi < bi)) { bv = ov; bi = oi; }
            }
            tv[k] = bv; te[k] = bi;
            if (e == bi) cur = -3.0e38f;
        }
        const float mx = tv[0];
        float ex[4], sm = 0.f;
#pragma unroll
        for (int k = 0; k < 4; ++k) { ex[k] = expf(tv[k] - mx); sm += ex[k]; }
        if (lane < 4) {
            const int ee = lane == 0 ? te[0] : lane == 1 ? te[1] : lane == 2 ? te[2] : te[3];
            const float eg = lane == 0 ? ex[0] : lane == 1 ? ex[1] : lane == 2 ? ex[2] : ex[3];
            const int lidx = atomicAdd(&hist[ee], 1);
            tinfo[ti * 4 + lane] = (ee << 16) | lidx;
            ((int*)(ws + W_TOPE))[t * 4 + lane] = ee;
            ws[W_TOPG + t * 4 + lane] = eg / sm;
        }
    }
    __syncthreads();
    if (tid < 32) bbase[tid] = atomicAdd(&cnt[tid * 64], hist[tid]);
    __syncthreads();
    ti = 0;
    for (int t = gw; t < TL; t += nw, ++ti)
        if (lane < 4) { const int v = tinfo[ti * 4 + lane]; ((int*)(ws + W_TOPI))[t * 4 + lane] = bbase[v >> 16] + (v & 0xffff); }
    __syncthreads();
}

DEVI void moe_bases(const Params& p, int l, int* sb) {
    const int tid = tid_();
    if (tid == 0) {
        const int* cnt = (const int*)(p.ws + W_CNT) + l * NEXP * 64;
        int b = 0, tb = 0;
        for (int e = 0; e < NEXP; ++e) { sb[e] = b; sb[40 + e] = tb; const int c = cnt[e * 64]; sb[80 + e] = c; const int mt = (c + 255) / 256; b += mt * 256; tb += mt; }
        sb[32] = b; sb[72] = tb;
    }
    __syncthreads();
}

__device__ void phase_scatter(const Params& p, int l, char* lds) {
    const int tid = tid_(), bid = bid_();
    int* sb = (int*)(lds + G_LDS);
    moe_bases(p, l, sb);
    float* ws = p.ws;
    const bf16_t* HB = (const bf16_t*)(ws + W_HB); bf16_t* XS = (bf16_t*)(ws + W_XS);
    const int lane = tid & 63, gw = bid * (NTHR / 64) + (tid >> 6), nw = gridDim.x * (NTHR / 64);
    const int TL = (l == NLAYER - 1) ? NLAT : T;
    for (int t = gw; t < TL; t += nw) {
        int row = 0;
        if (lane < 4) { const int e = ((const int*)(ws + W_TOPE))[t * 4 + lane]; row = sb[e] + ((const int*)(ws + W_TOPI))[t * 4 + lane]; ((int*)(ws + W_TOPI))[t * 4 + lane] = row; }
        const u32x4 v0 = *(const u32x4*)(HB + (size_t)t * D + lane * 8), v1 = *(const u32x4*)(HB + (size_t)t * D + 512 + lane * 8);
#pragma unroll
        for (int k = 0; k < 4; ++k) { const int rk = __shfl(row, k); bf16_t* d = XS + (size_t)rk * D; *(u32x4*)(d + lane * 8) = v0; *(u32x4*)(d + 512 + lane * 8) = v1; }
    }
    __syncthreads();
}

struct MoeSched {
    UnitRange ur; const int* sb; int ntn; const char* A; const char* Bt; size_t bstride_e, bstride_tn;
    DEVI bool next(int i, pg8::Unit& u) const {
        const int id = ur.lo + i * ur.step; if (id >= ur.hi) return false;
        int e = 0; while (e < NEXP - 1 && sb[40 + e + 1] * ntn <= id) ++e;
        const int mts = sb[40 + e + 1] - sb[40 + e], loc = id - sb[40 + e] * ntn, tng = loc / (mts * 4), rr = loc % (mts * 4), mt = rr >> 2, tn = tng * 4 + (rr & 3);
        const int r0 = __builtin_amdgcn_readfirstlane(sb[e] + mt * 256), tn_s = __builtin_amdgcn_readfirstlane(tn), e_s = __builtin_amdgcn_readfirstlane(e);
        u.a = A + (size_t)r0 * D * 2; u.b = Bt + (size_t)e_s * bstride_e + (size_t)tn_s * bstride_tn; u.x0 = r0; u.x1 = tn_s; u.x2 = e_s; return true;
    }
};
struct EpiMoe1 { static constexpr bool PERM = true; bf16_t* ACT; const float* bias;
    DEVI void operator()(const f32x4 (&acc)[2][2][4][2], const pg8::Unit& u, int wr, int wc, int fr, int fq) const {
        const int c0 = u.x1 * 128 + wc * 32 + 8 * fq;
        const float* bg = bias + (size_t)u.x2 * 2048 + c0; const float* bu = bg + 1024;
        f32x4 vg[2], vu[2];
#pragma unroll
        for (int n = 0; n < 2; ++n) { vg[n] = *(const f32x4*)(bg + 4 * n); vu[n] = *(const f32x4*)(bu + 4 * n); }
#pragma unroll
        for (int ai = 0; ai < 2; ++ai)
#pragma unroll
            for (int m = 0; m < 4; ++m) { bf16_t* rowp = ACT + (size_t)(u.x0 + ai * 128 + wr * 64 + m * 16 + fr) * D + c0;
                float a[8];
#pragma unroll
                for (int n = 0; n < 2; ++n)
#pragma unroll
                    for (int j = 0; j < 4; ++j) { float g = acc[ai][0][m][n][j] + vg[n][j], uu = acc[ai][1][m][n][j] + vu[n][j];
                        g = fminf(g, 7.f); uu = fminf(fmaxf(uu, -7.f), 7.f); a[n * 4 + j] = (uu + 1.f) * (g * sigm(1.702f * g)); }
                u32x4 w; w.x = cvt_pk_bf16(a[0], a[1]); w.y = cvt_pk_bf16(a[2], a[3]); w.z = cvt_pk_bf16(a[4], a[5]); w.w = cvt_pk_bf16(a[6], a[7]);
                *(u32x4*)rowp = w; }
    }
};
__device__ void phase_moe1(const Params& p, int l, char* lds) {
    const int tid = tid_(), bid = bid_(); (void)tid;
    int* sb = (int*)(lds + pg8::STAGE_BYTES);
    moe_bases(p, l, sb);
    MoeSched S; S.sb = sb; S.ntn = 8; S.ur = unit_range(sb[72] * 8, bid); S.A = (const char*)(p.ws + W_XS);
    S.Bt = (const char*)((const bf16_t*)(p.ws + W_WGU) + (size_t)l * NEXP * 2048 * D); S.bstride_e = (size_t)2048 * D * 2; S.bstride_tn = (size_t)128 * D * 2;
    EpiMoe1 E; E.ACT = (bf16_t*)(p.ws + W_ACT); E.bias = p.in[I_BGU] + (size_t)l * NEXP * 2048;
    pg8::gemm_phase((PG8_LAS unsigned char*)lds, D, (size_t)1024 * D * 2, S, E);
    __syncthreads();
}

struct EpiMoe2 { static constexpr bool PERM = true; bf16_t* YR; const float* bias;
    DEVI void operator()(const f32x4 (&acc)[2][2][4][2], const pg8::Unit& u, int wr, int wc, int fr, int fq) const {
        const int c0 = u.x1 * 256 + wc * 32 + 8 * fq;
        const float* bb = bias + (size_t)u.x2 * D + c0;
        f32x4 bv[2][2];
#pragma unroll
        for (int bj = 0; bj < 2; ++bj)
#pragma unroll
            for (int n = 0; n < 2; ++n) bv[bj][n] = *(const f32x4*)(bb + bj * 128 + 4 * n);
#pragma unroll
        for (int ai = 0; ai < 2; ++ai)
#pragma unroll
            for (int m = 0; m < 4; ++m) { bf16_t* rowp = YR + (size_t)(u.x0 + ai * 128 + wr * 64 + m * 16 + fr) * D + c0;
#pragma unroll
                for (int bj = 0; bj < 2; ++bj) { const f32x4 v0 = acc[ai][bj][m][0] + bv[bj][0], v1 = acc[ai][bj][m][1] + bv[bj][1];
                    u32x4 w; w.x = cvt_pk_bf16(v0[0], v0[1]); w.y = cvt_pk_bf16(v0[2], v0[3]); w.z = cvt_pk_bf16(v1[0], v1[1]); w.w = cvt_pk_bf16(v1[2], v1[3]);
                    *(u32x4*)(rowp + bj * 128) = w; } }
    }
};
__device__ void phase_moe2(const Params& p, int l, char* lds) {
    const int tid = tid_(), bid = bid_(); (void)tid;
    int* sb = (int*)(lds + pg8::STAGE_BYTES);
    moe_bases(p, l, sb);
    MoeSched S; S.sb = sb; S.ntn = 4; S.ur = unit_range(sb[72] * 4, bid); S.A = (const char*)(p.ws + W_ACT);
    S.Bt = (const char*)((const bf16_t*)(p.ws + W_WDN) + (size_t)l * NEXP * D * D); S.bstride_e = (size_t)D * D * 2; S.bstride_tn = (size_t)256 * D * 2;
    EpiMoe2 E; E.YR = (bf16_t*)(p.ws + W_YR); E.bias = p.in[I_BDN] + (size_t)l * NEXP * D;
    pg8::gemm_phase((PG8_LAS unsigned char*)lds, D, (size_t)128 * D * 2, S, E);
    __syncthreads();
}

__device__ void phase_combine(const Params& p, int l, char* lds, bool last) {
    const int tid = tid_(), bid = bid_();
    float* ws = p.ws;
    const bf16_t* YR = (const bf16_t*)(ws + W_YR);
    const int lane = tid & 63, gw = bid * (NTHR / 64) + (tid >> 6), nw = gridDim.x * (NTHR / 64);
    const int TL = last ? NLAT : T;
    for (int t = gw; t < TL; t += nw) {
        const float* g2 = ws + W_MOD + (size_t)(l * 2 + (t >= NLAT ? 1 : 0)) * 6144 + 5 * D;
        const bf16_t* yr[4]; float gt[4];
#pragma unroll
        for (int k = 0; k < 4; ++k) { yr[k] = YR + (size_t)((const int*)(ws + W_TOPI))[t * 4 + k] * D; gt[k] = ws[W_TOPG + t * 4 + k]; }
        float* x = ws + W_X + (size_t)t * D;
#pragma unroll
        for (int j = 0; j < 4; ++j) {
            const int c = j * 256 + lane * 4;
            float a0 = 0.f, a1 = 0.f, a2 = 0.f, a3 = 0.f;
#pragma unroll
            for (int k = 0; k < 4; ++k) { const u32x2 y = *(const u32x2*)(yr[k] + c);
                a0 = fmaf(gt[k], __uint_as_float(y.x << 16), a0); a1 = fmaf(gt[k], __uint_as_float(y.x & 0xffff0000u), a1);
                a2 = fmaf(gt[k], __uint_as_float(y.y << 16), a2); a3 = fmaf(gt[k], __uint_as_float(y.y & 0xffff0000u), a3); }
            float4 xv = *(const float4*)(x + c); const float4 gg = *(const float4*)(g2 + c);
            xv.x = fmaf(gg.x, a0, xv.x); xv.y = fmaf(gg.y, a1, xv.y); xv.z = fmaf(gg.z, a2, xv.z); xv.w = fmaf(gg.w, a3, xv.w);
            *(float4*)(x + c) = xv;
            if (last) *(float4*)(p.out + (size_t)t * D + c) = xv;
        }
    }
}

constexpr int LDS_BYTES = R_LDS + 2048;

#define XB_TMO      128
#define XB_XCNT(j)  (256  + 64 * (j))
#define XB_XSUB(j)  (1280 + 64 * (j))
#define XB_XGEN(j)  (2304 + 64 * (j))
#define XB_TOP      3328
#define XB_TOPGEN   3392
#define XCD_BAR_WORDS 3456
#define XB_SPIN_CAP (1u << 18)
#define LAS __attribute__((address_space(3)))
__device__ __forceinline__ unsigned xb_ld(unsigned* p)              { return __hip_atomic_load(p, __ATOMIC_RELAXED, __HIP_MEMORY_SCOPE_AGENT); }
__device__ __forceinline__ unsigned xb_add(unsigned* p, unsigned v) { return __hip_atomic_fetch_add(p, v, __ATOMIC_RELAXED, __HIP_MEMORY_SCOPE_AGENT); }
__device__ __forceinline__ unsigned xb_xcc_id() { return (unsigned)__builtin_amdgcn_s_getreg((3 << 11) | 20) & 0xFu; }
#define XB_SPIN(cond, bar) do { unsigned _sp = 0; while (cond) { __builtin_amdgcn_s_sleep(1); \
    if ((++_sp & 255u) == 0u) { if (xb_ld(&(bar)[XB_TMO])) break; if (_sp > XB_SPIN_CAP) { atomicAdd(&(bar)[XB_TMO], 1u); break; } } } } while (0)
struct XcdBarrier { unsigned* bar; unsigned x; volatile LAS unsigned* st; };
__device__ __forceinline__ XcdBarrier xcd_barrier_post(unsigned* bar, volatile LAS unsigned* st) {
    XcdBarrier b; b.bar = bar; b.x = xb_xcc_id(); b.st = st;
    if (threadIdx.x == 0) (void)xb_add(&bar[XB_XCNT(b.x)], 1u);
    return b;
}
__device__ __forceinline__ void xcd_barrier_complete(unsigned* bar, unsigned x, unsigned& nloc, unsigned& nx) {
    const unsigned G = gridDim.x * gridDim.y * gridDim.z;
    unsigned sum, cnt, mine, sp = 0u;
    for (;;) {
        sum = 0u; cnt = 0u; mine = 0u;
#pragma unroll
        for (unsigned j = 0; j < 16; ++j) { const unsigned c = xb_ld(&bar[XB_XCNT(j)]); sum += c; cnt += (c > 0u) ? 1u : 0u; mine = (j == x) ? c : mine; }
        if (sum == G) break;
        __builtin_amdgcn_s_sleep(1);
        if ((++sp & 255u) == 0u) { if (xb_ld(&bar[XB_TMO])) break; if (sp > XB_SPIN_CAP) { atomicAdd(&bar[XB_TMO], 1u); break; } }
    }
    nloc = mine > 0u ? mine : 1u; nx = cnt > 0u ? cnt : 1u;
}
__device__ __noinline__ void xcd_barrier(const XcdBarrier b) {
    asm volatile("s_waitcnt vmcnt(0)" ::: "memory");
    __syncthreads();
    if (threadIdx.x == 0) {
        unsigned* bar = b.bar;
        __builtin_amdgcn_s_waitcnt(0);
        unsigned nloc = b.st[0], nx = b.st[1];
        if (nloc == 0u) { xcd_barrier_complete(bar, b.x, nloc, nx); b.st[0] = nloc; b.st[1] = nx; }
        const unsigned old = xb_add(&bar[XB_XSUB(b.x)], 1u);
        const unsigned gen = old / nloc;
        if (old + 1u == (gen + 1u) * nloc) {
            __builtin_amdgcn_fence(__ATOMIC_RELEASE, "agent");
            asm volatile("s_waitcnt vmcnt(0)" ::: "memory");
            const unsigned og = xb_add(&bar[XB_TOP], 1u);
            const unsigned tg = og / nx;
            if (og + 1u == (tg + 1u) * nx) xb_add(&bar[XB_TOPGEN], 1u);
            else XB_SPIN(xb_ld(&bar[XB_TOPGEN]) == tg, bar);
            __builtin_amdgcn_fence(__ATOMIC_ACQUIRE, "agent");
            xb_add(&bar[XB_XGEN(b.x)], 1u);
            asm volatile("s_waitcnt vmcnt(0)" ::: "memory");
        } else {
            XB_SPIN(xb_ld(&bar[XB_XGEN(b.x)]) == gen, bar);
            __builtin_amdgcn_fence(__ATOMIC_ACQUIRE, "agent");
            asm volatile("s_waitcnt vmcnt(0)" ::: "memory");
        }
    }
    __syncthreads();
}

constexpr int REP_NORM = 1, REP_INPROJ = 1, REP_PREP1 = 1, REP_SMALL = 1, REP_ATTN = 1, REP_FIN = 1, REP_MOE1 = 1, REP_MOE2 = 1, REP_SYNC = 1, REP_CONV = 1;
__global__ void __launch_bounds__(NTHR) fwd_kernel(Params p) {
    cg::grid_group grid = cg::this_grid();
    extern __shared__ __attribute__((aligned(16))) char lds[];
    float* smem = (float*)lds;
    volatile LAS unsigned* xst = (volatile LAS unsigned*)(lds + LDS_BYTES - 16);
    if (threadIdx.x < 4) xst[threadIdx.x] = 0u;
    if (blockIdx.x == 0) for (int i = threadIdx.x; i < 4096; i += NTHR) ((unsigned*)(p.ws + W_BAR))[i] = 0u;
    for (int r = 0; r < REP_CONV; ++r) phase_convert(p);
    phase_init(p);
    phase_mod(p, smem);
    grid.sync();
    XcdBarrier xbar = xcd_barrier_post((unsigned*)(p.ws + W_BAR), xst);
#define GSYNC() do { for (int r_ = 0; r_ < REP_SYNC; ++r_) xcd_barrier(xbar); } while (0)
    for (int l = 0; l < NLAYER; ++l) {
        for (int r = 0; r < REP_NORM; ++r) phase_norm(p, l, 0);
        GSYNC();
        for (int r = 0; r < REP_INPROJ; ++r) phase_inproj(p, l, lds);
        GSYNC();
        for (int r = 0; r < REP_PREP1; ++r) phase_prep1(p, l);
        GSYNC();
        for (int r = 0; r < REP_SMALL; ++r) phase_small(p, l, lds);
        GSYNC();
        phase_prep2(p, l);
        GSYNC();
        for (int r = 0; r < REP_ATTN; ++r) phase_attn(p, l, lds);
        GSYNC();
        for (int r = 0; r < REP_FIN; ++r) phase_lru_fin(p, lds);
        GSYNC();
        phase_outproj(p, l, lds);
        GSYNC();
        phase_router(p, l, lds);
        GSYNC();
        phase_scatter(p, l, lds);
        GSYNC();
        for (int r = 0; r < REP_MOE1; ++r) phase_moe1(p, l, lds);
        GSYNC();
        for (int r = 0; r < REP_MOE2; ++r) phase_moe2(p, l, lds);
        GSYNC();
        phase_combine(p, l, lds, l == NLAYER - 1);
        GSYNC();
    }
}

extern "C" void kernel_launch(void* const* d_in, const int* in_sizes, int n_in, void* d_out, int out_size, void* d_ws, size_t ws_size, hipStream_t stream) {
    static int grid_blocks = 0;
    if (!grid_blocks) {
        int dev = 0, cus = 0, per_cu = 0;
        (void)hipGetDevice(&dev);
        (void)hipDeviceGetAttribute(&cus, hipDeviceAttributeMultiprocessorCount, dev);
        if (hipFuncSetAttribute((const void*)fwd_kernel, hipFuncAttributeMaxDynamicSharedMemorySize, LDS_BYTES) != hipSuccess) fprintf(stderr, "kernel_launch: hipFuncSetAttribute failed\n");
        if (hipOccupancyMaxActiveBlocksPerMultiprocessor(&per_cu, fwd_kernel, NTHR, LDS_BYTES) != hipSuccess || per_cu < 1) { fprintf(stderr, "kernel_launch: occupancy query says %d\n", per_cu); per_cu = 1; }
        if (per_cu > 1) per_cu = 1;
        grid_blocks = cus * per_cu;
        if (ws_size < W_END * sizeof(float)) fprintf(stderr, "kernel_launch: workspace too small: %zu < %zu\n", ws_size, W_END * sizeof(float));
        if (n_in != N_IN) fprintf(stderr, "kernel_launch: n_in %d != %d\n", n_in, (int)N_IN);
    }
    Params p{};
    for (int i = 0; i < N_IN; ++i) p.in[i] = (const float*)d_in[i];
    p.out = (float*)d_out;
    p.ws = (float*)d_ws;
    void* args[] = {&p};
    hipError_t e = hipLaunchCooperativeKernel((void*)fwd_kernel, dim3(grid_blocks), dim3(NTHR), args, LDS_BYTES, stream);
    if (e != hipSuccess) fprintf(stderr, "cooperative launch failed: %s (grid %d)\n", hipGetErrorString(e), grid_blocks);
}
```

```cpp
#include <hip/hip_runtime.h>
#include <hip/hip_cooperative_groups.h>
#include <cstdio>
#include <cstdint>
namespace cg = cooperative_groups;

#define DEVI __device__ __forceinline__
constexpr int NTHR = 512;
constexpr int D = 1024, NLAT = 16384, NCTX = 256, T = NLAT + NCTX, NLAYER = 2;
constexpr int INC = 1632;
constexpr int OFF_A = 0, OFF_Q = 256, OFF_KV = 448, OFF_KR = 576, OFF_C = 608, OFF_DX = 1120, OFF_DG = 1376;
constexpr int NCHUNK = T / 128;
constexpr int NEXP = 32, TOPK = 4;
constexpr int MAXROWS = T * TOPK + NEXP * 256;
constexpr float EPS = 1e-6f;

enum { I_X = 0, I_C, I_CTX, I_CCTX, I_WMOD, I_BMOD, I_NMIX, I_NFFN, I_WIN, I_WOUT, I_POOLW, I_POOLS, I_QAN, I_WUQ, I_KVAN, I_WUKV,
       I_QN, I_KN, I_SGG, I_SGB, I_SGWS, I_SGBS, I_CONVW, I_CONVB, I_WA, I_BA, I_WX, I_BX, I_LAM, I_RW, I_RB, I_WGU, I_BGU, I_WDN, I_BDN, N_IN };

constexpr size_t al(size_t x) { return (x + 63) / 64 * 64; }
constexpr size_t W_X = 0;
constexpr size_t W_MOD = W_X + al((size_t)T * D);
constexpr size_t W_P = W_MOD + al(2 * 2 * 6144);
constexpr size_t W_YC = W_P + al((size_t)T * INC);
constexpr size_t W_Q = W_YC + al((size_t)T * D);
constexpr size_t W_K = W_Q + al((size_t)T * 384);
constexpr size_t W_V = W_K + al((size_t)T * 384);
constexpr size_t W_DIFF = W_V + al((size_t)T * 256);
constexpr size_t W_QN = W_DIFF + al((size_t)T * 256);
constexpr size_t W_KVN = W_QN + al((size_t)T * 192);
constexpr size_t W_U = W_KVN + al((size_t)T * 128);
constexpr size_t W_VN = W_U + al((size_t)T * 256);
constexpr size_t W_XC = W_VN + al((size_t)T * 256);
constexpr size_t W_QUP = W_XC + al((size_t)T * 256);
constexpr size_t W_KVUP = W_QUP + al((size_t)T * 384);
constexpr size_t W_LA = W_KVUP + al((size_t)T * 512);
constexpr size_t W_LB = W_LA + al((size_t)2 * T * 256);
constexpr size_t W_AGG = W_LB + al((size_t)2 * T * 256);
constexpr size_t W_CARRY = W_AGG + al((size_t)NCHUNK * 2 * 2 * 256);
constexpr size_t W_TOPE = W_CARRY + al((size_t)NCHUNK * 2 * 256);
constexpr size_t W_TOPG = W_TOPE + al((size_t)T * 4);
constexpr size_t W_TOPI = W_TOPG + al((size_t)T * 4);
constexpr size_t W_CNT = W_TOPI + al((size_t)T * 4);
constexpr size_t W_ACT = W_CNT + al(NLAYER * NEXP * 64);
constexpr size_t W_YR = W_ACT + al((size_t)MAXROWS * D / 2);
constexpr size_t W_XS = W_YR + al((size_t)MAXROWS * D / 2);
constexpr size_t W_HB = W_XS + al((size_t)MAXROWS * D / 2);
constexpr size_t W_XCB = W_HB + al((size_t)T * D / 2);
constexpr size_t W_WSB = W_XCB + al((size_t)T * 256 / 2);
constexpr size_t W_BAR = W_WSB + al((size_t)NLAYER * 4 * 128 * 128 / 2);
constexpr size_t W_ROPE = W_BAR + al(4096);
constexpr size_t W_LA2 = W_ROPE + al((size_t)NLAT * 32);
constexpr size_t W_LB2 = W_LA2 + al((size_t)2 * T * 256);
constexpr size_t W_SP = W_LB2 + al((size_t)2 * T * 256);
constexpr int NPAD_IN = 1792;
constexpr size_t W_WIN = W_SP + al(NLAYER * 2 * 256);
constexpr size_t W_WOUT = W_WIN + al((size_t)NLAYER * NPAD_IN * D / 2);
constexpr size_t W_WGU = W_WOUT + al((size_t)NLAYER * D * D / 2);
constexpr size_t W_WDN = W_WGU + al((size_t)NLAYER * NEXP * 2048 * D / 2);
constexpr size_t W_END = W_WDN + al((size_t)NLAYER * NEXP * D * D / 2);

struct Params {
    const float* in[N_IN];
    float* out;
    float* ws;
};

DEVI int tid_() { int t = threadIdx.x; asm volatile("" : "+v"(t)); return t; }
DEVI float* ws_(float* w) { unsigned long long v = (unsigned long long)w; asm volatile("" : "+s"(v)); return (float*)v; }
extern __shared__ __attribute__((aligned(16))) char g_lds[];
constexpr int TAB_OFF = 149504;
DEVI unsigned long long tab_ld(int i) { const unsigned long long v = ((const volatile unsigned long long*)(g_lds + TAB_OFF))[i];
    return ((unsigned long long)(unsigned)__builtin_amdgcn_readfirstlane((int)(v >> 32)) << 32) | (unsigned)__builtin_amdgcn_readfirstlane((int)v); }
#define PIN(i) ((const float*)tab_ld(i))
DEVI int bid_() { int b = blockIdx.x; asm volatile("" : "+s"(b)); return b; }
DEVI float wave_sum(float v) {
#pragma unroll
    for (int o = 32; o > 0; o >>= 1) v += __shfl_xor(v, o);
    return v;
}
DEVI float gelu_tanh(float x) { const float u = 0.7978845608028654f * (x + 0.044715f * x * x * x); return 0.5f * x * (1.f + tanhf(u)); }
DEVI float sigm(float x) { return 1.f / (1.f + expf(-x)); }
DEVI float silu(float x) { return x * sigm(x); }
DEVI float fexp(float x) { return __builtin_amdgcn_exp2f(x * 1.4426950408889634f); }
DEVI float fsigm(float x) { return __builtin_amdgcn_rcpf(1.f + fexp(-x)); }


typedef unsigned short bf16_t;
typedef short bf16x8 __attribute__((ext_vector_type(8)));
typedef float f32x4 __attribute__((ext_vector_type(4)));
typedef unsigned u32x4 __attribute__((ext_vector_type(4)));
typedef unsigned u32x2 __attribute__((ext_vector_type(2)));
DEVI unsigned cvt_pk_bf16(float lo, float hi) { unsigned r; asm volatile("v_cvt_pk_bf16_f32 %0, %1, %2" : "=v"(r) : "v"(lo), "v"(hi)); return r; }
DEVI bf16_t f2bf(float f) { return (bf16_t)(cvt_pk_bf16(f, 0.f) & 0xffffu); }
DEVI float bf2f(bf16_t b) { return __uint_as_float(((unsigned)b) << 16); }

constexpr int G_STAGE = 49152;
constexpr int G_LDS = 2 * G_STAGE;
DEVI int swz(int row, int chunk) { return row * 128 + ((chunk ^ ((row >> 1) & 7)) << 4); }

template <bool PAIRED, class ARow, class Epi>
DEVI void gemm_unit(char* lds, int K, ARow arow, const float* __restrict__ B0, const float* __restrict__ B1, int ldb, int ncol_valid, Epi epi) {
    const int tid = tid_(), wave = tid >> 6, lane = tid & 63, fr = lane & 15, fq = lane >> 4, wr = wave >> 1, wc = wave & 1;
    const int ac = tid & 7;
    const bf16_t* ap[4]; int a_lds[4];
#pragma unroll
    for (int i = 0; i < 4; ++i) { const int r = (tid >> 3) + 64 * i; ap[i] = arow(r) + ac * 8; a_lds[i] = swz(r, ac); }
    const int kq = lane & 15, nq = (lane >> 4) + 4 * wave;
    const float* bp;
    if (PAIRED) { const int seg = (nq >> 2) & 1, idx = (nq >> 3) * 16 + (nq & 3) * 4; bp = (seg ? B1 : B0) + idx; }
    else { const int c4 = 4 * nq < ncol_valid ? 4 * nq : ncol_valid - 4; bp = B0 + c4; }
    bp += (size_t)(4 * kq) * ldb;
    int b_lds[4];
#pragma unroll
    for (int i = 0; i < 4; ++i) b_lds[i] = 32768 + swz(4 * nq + i, kq >> 1) + (kq & 1) * 8;
    const int sx = (fr >> 1) & 7;
    const int aoff0 = (wr * 64 + fr) * 128 + ((fq ^ sx) << 4), aoff1 = (wr * 64 + fr) * 128 + (((4 + fq) ^ sx) << 4);
    const int boff0 = 32768 + (wc * 64 + fr) * 128 + ((fq ^ sx) << 4), boff1 = 32768 + (wc * 64 + fr) * 128 + (((4 + fq) ^ sx) << 4);
    u32x4 av0[4], av1[4]; f32x4 bv0[4], bv1[4];
#define G_LOAD(av, bv, t) do { _Pragma("unroll") for (int i = 0; i < 4; ++i) av[i] = *(const u32x4*)(ap[i] + (t) * 64); \
        _Pragma("unroll") for (int kk = 0; kk < 4; ++kk) bv[kk] = *(const f32x4*)(bp + ((size_t)(t) * 64 + kk) * ldb); } while (0)
#define G_WRITE(s_, av, bv) do { _Pragma("unroll") for (int i = 0; i < 4; ++i) *(u32x4*)((s_) + a_lds[i]) = av[i]; \
        _Pragma("unroll") for (int i = 0; i < 4; ++i) { u32x2 w_; w_.x = cvt_pk_bf16(bv[0][i], bv[1][i]); w_.y = cvt_pk_bf16(bv[2][i], bv[3][i]); *(u32x2*)((s_) + b_lds[i]) = w_; } } while (0)
#define G_MMA(Af, Bf) do { __builtin_amdgcn_s_setprio(1); _Pragma("unroll") for (int m = 0; m < 4; ++m) _Pragma("unroll") for (int n = 0; n < 4; ++n) \
        acc[m][n] = __builtin_amdgcn_mfma_f32_16x16x32_bf16(Bf[n], Af[m], acc[m][n], 0, 0, 0); __builtin_amdgcn_s_setprio(0); } while (0)
#define G_SB() __builtin_amdgcn_sched_barrier(0)
#define G_ITER(t, c_, n_, av, bv, W_, L_) do { \
        bf16x8 Af[4], Bf[4]; \
        _Pragma("unroll") for (int m = 0; m < 4; ++m) Af[m] = *(const bf16x8*)((c_) + aoff0 + m * 2048); \
        _Pragma("unroll") for (int n = 0; n < 4; ++n) Bf[n] = *(const bf16x8*)((c_) + boff0 + n * 2048); \
        G_SB(); asm volatile("s_waitcnt lgkmcnt(0)" ::: "memory"); G_SB(); \
        G_MMA(Af, Bf); G_SB(); \
        _Pragma("unroll") for (int m = 0; m < 4; ++m) Af[m] = *(const bf16x8*)((c_) + aoff1 + m * 2048); \
        _Pragma("unroll") for (int n = 0; n < 4; ++n) Bf[n] = *(const bf16x8*)((c_) + boff1 + n * 2048); \
        G_SB(); \
        if (W_) { G_WRITE(n_, av, bv); G_SB(); asm volatile("s_waitcnt lgkmcnt(8)" ::: "memory"); } else { asm volatile("s_waitcnt lgkmcnt(0)" ::: "memory"); } \
        G_SB(); \
        G_MMA(Af, Bf); G_SB(); \
        if (L_) G_LOAD(av, bv, (t) + 3); \
        G_SB(); asm volatile("s_waitcnt lgkmcnt(0)" ::: "memory"); __builtin_amdgcn_s_barrier(); G_SB(); } while (0)
    f32x4 acc[4][4];
#pragma unroll
    for (int m = 0; m < 4; ++m)
#pragma unroll
        for (int n = 0; n < 4; ++n) acc[m][n] = (f32x4){0.f, 0.f, 0.f, 0.f};
    const int nk = K >> 6;
    char* L0 = lds; char* L1 = lds + G_STAGE;
    G_LOAD(av0, bv0, 0);
    G_WRITE(L0, av0, bv0);
    if (nk > 1) G_LOAD(av1, bv1, 1);
    if (nk > 2) G_LOAD(av0, bv0, 2);
    asm volatile("s_waitcnt lgkmcnt(0)" ::: "memory"); __builtin_amdgcn_s_barrier(); G_SB();
    int t = 0;
    for (; t + 4 < nk; t += 2) {
        G_ITER(t, L0, L1, av1, bv1, true, true);
        G_ITER(t + 1, L1, L0, av0, bv0, true, true);
    }
    for (; t < nk; t += 2) {
        G_ITER(t, L0, L1, av1, bv1, t + 1 < nk, t + 3 < nk);
        if (t + 1 < nk) G_ITER(t + 1, L1, L0, av0, bv0, t + 2 < nk, t + 4 < nk);
    }
#undef G_LOAD
#undef G_WRITE
#undef G_MMA
#undef G_ITER
#undef G_SB
    epi(acc, wr, wc, fr, fq);
}


#define PG8_LAS __attribute__((address_space(3)))
namespace pg8 {
constexpr int BM = 256, BK = 64, HALF = 128, HTB = HALF * BK * 2, STAGE_BYTES = 8 * HTB;
DEVI int lds_byte(int r, int c) { const int st = (r >> 4) * 2 + (c >> 5), rr = r & 15, cc = c & 31, ob = rr * 64 + cc * 2; return st * 1024 + (ob ^ (((ob >> 9) & 1) << 5)); }
DEVI void stage_rc(int b, int& R, int& C) { const int st = b / 1024, sb = b % 1024, swz_ = sb ^ (((sb >> 9) & 1) << 5); R = (st >> 1) * 16 + swz_ / 64; C = (st & 1) * 32 + (swz_ % 64) / 2; }
DEVI int perm32(int rho) { const int n = rho >> 4, i = rho & 15; return 8 * (i >> 2) + 4 * n + (i & 3); }
struct Unit { const char* a; const char* b; int x0, x1, x2; };
template <class Epi, class Sched>
DEVI void gemm_phase(PG8_LAS unsigned char* lds, int K, size_t hstepB, const Sched& S, const Epi& E) {
    const int tid = tid_(), wid = __builtin_amdgcn_readfirstlane(tid >> 6), lane = tid & 63, wr = wid >> 2, wc = wid & 3, fr = lane & 15, fq = lane >> 4;
    const int nt = K / BK;
    unsigned voffA[2], voffB[2];
#pragma unroll
    for (int i = 0; i < 2; ++i) { int R, C; stage_rc(tid * 16 + i * 8192, R, C); const int Rb = Epi::PERM ? ((R & ~31) + perm32(R & 31)) : R;
        voffA[i] = (unsigned)(R * K + C) * 2u; voffB[i] = (unsigned)(Rb * K + C) * 2u; }
    const size_t kstep = (size_t)(BK * 2);
    const size_t hstep = (size_t)HALF * K * 2;
    const unsigned ldsw = (unsigned)wid * 1024u;
    const int aoff = lds_byte(wr * 64 + fr, fq * 8), boff = lds_byte(wc * 32 + fr, fq * 8);
#define PG8_SA(b, h) (((b) * 2 + (h)) * HTB)
#define PG8_SB(b, h) ((4 + (b) * 2 + (h)) * HTB)
#define PG8_STAGE(bufoff, gbase, voff) do { _Pragma("unroll") for (int _i = 0; _i < 2; ++_i) \
        __builtin_amdgcn_global_load_lds((const unsigned*)((const char*)(gbase) + (voff)[_i]), (PG8_LAS unsigned*)(lds + (bufoff) + ldsw + _i * 8192), 16, 0, 0); } while (0)
#define PG8_LDA(dst, b, h) do { _Pragma("unroll") for (int m = 0; m < 4; ++m) _Pragma("unroll") for (int k = 0; k < 2; ++k) dst[m][k] = *(const PG8_LAS bf16x8*)(lds + PG8_SA(b, h) + aoff + m * 2048 + k * 1024); } while (0)
#define PG8_LDB(dst, b, h) do { _Pragma("unroll") for (int n = 0; n < 2; ++n) _Pragma("unroll") for (int k = 0; k < 2; ++k) dst[n][k] = *(const PG8_LAS bf16x8*)(lds + PG8_SB(b, h) + boff + n * 2048 + k * 1024); } while (0)
#define PG8_MMA(ai, bj, At, Bt) do { __builtin_amdgcn_s_setprio(1); _Pragma("unroll") for (int m = 0; m < 4; ++m) _Pragma("unroll") for (int n = 0; n < 2; ++n) _Pragma("unroll") for (int k = 0; k < 2; ++k) \
        acc[ai][bj][m][n] = __builtin_amdgcn_mfma_f32_16x16x32_bf16(Bt[n][k], At[m][k], acc[ai][bj][m][n], 0, 0, 0); __builtin_amdgcn_s_setprio(0); } while (0)
#define PG8_WAIT_V(n) asm volatile("s_waitcnt vmcnt(" #n ")" ::: "memory")
#define PG8_WAIT_L(n) asm volatile("s_waitcnt lgkmcnt(" #n ")" ::: "memory")
#define PG8_BAR __builtin_amdgcn_s_barrier()
#define PG8_SCHED __builtin_amdgcn_sched_barrier(0)
    Unit cur, nxt; int ui = 0;
    if (!S.next(0, cur)) return;
    f32x4 acc[2][2][4][2];
#pragma unroll
    for (int a = 0; a < 2; ++a)
#pragma unroll
        for (int b = 0; b < 2; ++b)
#pragma unroll
            for (int m = 0; m < 4; ++m)
#pragma unroll
                for (int n = 0; n < 2; ++n) acc[a][b][m][n] = (f32x4){0.f, 0.f, 0.f, 0.f};
    bf16x8 At[4][2], B0[2][2], B1[2][2];
    const char* cA = cur.a; const char* cB = cur.b;
    PG8_STAGE(PG8_SB(0, 0), cB, voffB); PG8_STAGE(PG8_SA(0, 0), cA, voffA); PG8_STAGE(PG8_SB(0, 1), cB + hstepB, voffB); PG8_STAGE(PG8_SA(0, 1), cA + hstep, voffA);
    if (wr == 1) PG8_BAR;
    PG8_WAIT_V(4); PG8_BAR;
    PG8_STAGE(PG8_SB(1, 0), cB + kstep, voffB); PG8_STAGE(PG8_SA(1, 0), cA + kstep, voffA); PG8_STAGE(PG8_SB(1, 1), cB + hstepB + kstep, voffB);
    PG8_WAIT_V(6); PG8_BAR;
    for (;;) {
        const bool has_next = S.next(ui + 1, nxt);
        const char* nA = has_next ? nxt.a : cA; const char* nB = has_next ? nxt.b : cB;
        for (int t = 0; t < nt; t += 2) {
            const bool last = (t == nt - 2);
            const char* a1 = cA + (size_t)(t + 1) * kstep;
            const char* a2 = last ? nA : cA + (size_t)(t + 2) * kstep; const char* b2 = last ? nB : cB + (size_t)(t + 2) * kstep;
            const char* a3 = a2 + kstep; const char* b3 = b2 + kstep;
            PG8_LDB(B0, 0, 0); PG8_SCHED; PG8_LDA(At, 0, 0); PG8_STAGE(PG8_SA(1, 1), a1 + hstep, voffA);
            PG8_WAIT_L(8); PG8_BAR; PG8_WAIT_L(0); PG8_MMA(0, 0, At, B0); PG8_BAR; PG8_SCHED;
            PG8_LDB(B1, 0, 1); PG8_STAGE(PG8_SB(0, 0), b2, voffB);
            PG8_BAR; PG8_WAIT_L(0); PG8_MMA(0, 1, At, B1); PG8_BAR;
            PG8_LDA(At, 0, 1); PG8_STAGE(PG8_SA(0, 0), a2, voffA);
            PG8_BAR; PG8_WAIT_L(0); PG8_MMA(1, 0, At, B0); PG8_BAR; PG8_SCHED;
            PG8_STAGE(PG8_SB(0, 1), b2 + hstepB, voffB);
            PG8_WAIT_V(6); PG8_BAR; PG8_MMA(1, 1, At, B1); PG8_BAR;
            PG8_LDB(B0, 1, 0); PG8_SCHED; PG8_LDA(At, 1, 0); PG8_STAGE(PG8_SA(0, 1), a2 + hstep, voffA);
            PG8_WAIT_L(8); PG8_BAR; PG8_WAIT_L(0); PG8_MMA(0, 0, At, B0); PG8_BAR; PG8_SCHED;
            PG8_LDB(B1, 1, 1); PG8_STAGE(PG8_SB(1, 0), b3, voffB);
            PG8_BAR; PG8_WAIT_L(0); PG8_MMA(0, 1, At, B1); PG8_BAR;
            PG8_LDA(At, 1, 1); PG8_STAGE(PG8_SA(1, 0), a3, voffA);
            PG8_BAR; PG8_WAIT_L(0); PG8_MMA(1, 0, At, B0); PG8_BAR; PG8_SCHED;
            PG8_STAGE(PG8_SB(1, 1), b3 + hstepB, voffB);
            PG8_WAIT_V(6); PG8_BAR; PG8_MMA(1, 1, At, B1); PG8_BAR;
        }
        E(acc, cur, wr, wc, fr, fq);
        if (!has_next) break;
#pragma unroll
        for (int a = 0; a < 2; ++a)
#pragma unroll
            for (int b = 0; b < 2; ++b)
#pragma unroll
                for (int m = 0; m < 4; ++m)
#pragma unroll
                    for (int n = 0; n < 2; ++n) acc[a][b][m][n] = (f32x4){0.f, 0.f, 0.f, 0.f};
        cur = nxt; cA = nA; cB = nB; ++ui;
    }
    PG8_WAIT_V(0);
    if (wr == 0) PG8_BAR;
    PG8_BAR;
#undef PG8_SA
#undef PG8_SB
#undef PG8_STAGE
#undef PG8_LDA
#undef PG8_LDB
#undef PG8_MMA
#undef PG8_WAIT_V
#undef PG8_WAIT_L
#undef PG8_BAR
#undef PG8_SCHED
}
}

DEVI void conv_item(const float* __restrict__ W, int K, int N, bf16_t* __restrict__ Wt, int kb, int nb, int lane) {
    const int ko = lane & 7, nq = lane >> 3;
    const float* src = W + (size_t)(kb * 64 + ko * 8) * N + nb * 32 + nq * 4;
    f32x4 v[8];
#pragma unroll
    for (int kk = 0; kk < 8; ++kk) v[kk] = *(const f32x4*)(src + (size_t)kk * N);
    bf16_t* dst = Wt + (size_t)(nb * 32 + nq * 4) * K + kb * 64 + ko * 8;
#pragma unroll
    for (int i = 0; i < 4; ++i) { u32x4 o; o.x = cvt_pk_bf16(v[0][i], v[1][i]); o.y = cvt_pk_bf16(v[2][i], v[3][i]); o.z = cvt_pk_bf16(v[4][i], v[5][i]); o.w = cvt_pk_bf16(v[6][i], v[7][i]);
        *(u32x4*)(dst + (size_t)i * K) = o; }
}

namespace att {
typedef short s16x4 __attribute__((ext_vector_type(4)));
typedef float f32x16 __attribute__((ext_vector_type(16)));
constexpr int KVBLK = 64;
constexpr float SCALE = 0.10206207261596577f;
constexpr float THR = 8.f;
constexpr int SHM_V = 16384, SHM_K = 16384, SHM_ATTN = 2 * SHM_V + 2 * SHM_K + 8 * 64 * 4;
#define KSWZ(row, colB) ((row) * 256 + ((colB) ^ (((row) & 7) << 4)))
#define SBAR() __builtin_amdgcn_sched_barrier(0)
DEVI int crow(int r, int hi) { return (r & 3) + 8 * (r >> 2) + 4 * hi; }
DEVI void partialSM(f32x16& p0, f32x16& p1, float& m_reg, float& mn, float& alpha) {
    constexpr float C = SCALE * 1.4426950408889634f;
    float pmax = p0[0];
#pragma unroll
    for (int r = 1; r < 16; ++r) pmax = fmaxf(pmax, p0[r]);
#pragma unroll
    for (int r = 0; r < 16; ++r) pmax = fmaxf(pmax, p1[r]);
    { auto rr = __builtin_amdgcn_permlane32_swap(__float_as_uint(pmax), __float_as_uint(pmax), false, false);
      pmax = fmaxf(__uint_as_float(rr[0]), __uint_as_float(rr[1])); }
    if (__builtin_expect(__all(pmax - m_reg <= THR / SCALE), 1)) { mn = m_reg; alpha = 1.f; }
    else { mn = fmaxf(m_reg, pmax); alpha = __builtin_amdgcn_exp2f((m_reg - mn) * C); m_reg = mn; }
    const float mnC = -mn * C;
#pragma unroll
    for (int r = 0; r < 16; ++r) p0[r] = fmaf(p0[r], C, mnC);
#pragma unroll
    for (int r = 0; r < 16; ++r) p1[r] = fmaf(p1[r], C, mnC);
#pragma unroll
    for (int r = 0; r < 16; ++r) p0[r] = __builtin_amdgcn_exp2f(p0[r]);
}
DEVI void finishSM(f32x16& p0, f32x16& p1, float alpha, float& l_reg, bf16x8& pa0, bf16x8& pa1, bf16x8& pa2, bf16x8& pa3) {
#pragma unroll
    for (int r = 0; r < 16; ++r) p1[r] = __builtin_amdgcn_exp2f(p1[r]);
    float ps = 0.f;
#pragma unroll
    for (int r = 0; r < 16; ++r) ps += p0[r];
#pragma unroll
    for (int r = 0; r < 16; ++r) ps += p1[r];
    { auto rr = __builtin_amdgcn_permlane32_swap(__float_as_uint(ps), __float_as_uint(ps), false, false);
      ps = __uint_as_float(rr[0]) + __uint_as_float(rr[1]); }
    l_reg = l_reg * alpha + ps;
#define PK4(P, BASE, OUT) do { unsigned a0 = cvt_pk_bf16(P[BASE + 0], P[BASE + 1]), a1 = cvt_pk_bf16(P[BASE + 2], P[BASE + 3]);   \
    unsigned b0 = cvt_pk_bf16(P[BASE + 4], P[BASE + 5]), b1 = cvt_pk_bf16(P[BASE + 6], P[BASE + 7]);                              \
    auto r0 = __builtin_amdgcn_permlane32_swap(a0, b0, false, false); auto r1 = __builtin_amdgcn_permlane32_swap(a1, b1, false, false); \
    u32x4 w = {r0[0], r1[0], r0[1], r1[1]}; OUT = *reinterpret_cast<bf16x8*>(&w); } while (0)
    PK4(p0, 0, pa0); PK4(p0, 8, pa1); PK4(p1, 0, pa2); PK4(p1, 8, pa3);
#undef PK4
}
DEVI void qkt(f32x16& p0, f32x16& p1, const char* Ks, const bf16x8* qr, int r32, int hi) {
    p0 = f32x16{}; p1 = f32x16{};
#pragma unroll
    for (int d0 = 0; d0 < 6; ++d0) { const int cb = (d0 * 16 + hi * 8) * 2;
        const bf16x8 b0 = *reinterpret_cast<const bf16x8*>(Ks + KSWZ(r32, cb));
        const bf16x8 b1 = *reinterpret_cast<const bf16x8*>(Ks + KSWZ(32 + r32, cb));
        p0 = __builtin_amdgcn_mfma_f32_32x32x16_bf16(b0, qr[d0], p0, 0, 0, 0);
        p1 = __builtin_amdgcn_mfma_f32_32x32x16_bf16(b1, qr[d0], p1, 0, 0, 0); }
}
DEVI int v_st(int k, int c) { const int kk = (k & ~0xC) | ((k & 4) << 1) | ((k & 8) >> 1); return ((kk >> 3) * 4 + (c >> 5)) * 512 + ((kk & 7) * 32 + (c & 31)) * 2; }
DEVI int v_rd_base(int lane) { return ((lane & 3) << 3) | (((lane >> 2) & 3) << 6) | (((lane >> 4) & 1) << 5) | (((lane >> 5) & 1) << 8); }
constexpr int v_rd_off(int d0, int ks, int half) { return d0 * 512 + ks * 4096 + half * 2048; }
template <int OFF> DEVI s16x4 tr_read(int vb) {
    s16x4 r; asm volatile("ds_read_b64_tr_b16 %0, %1 offset:%2" : "=&v"(r) : "v"(vb), "i"(OFF) : "memory"); return r;
}
template <int D0> DEVI void pv_one(f32x16& od, int vb, bf16x8 pa0, bf16x8 pa1, bf16x8 pa2, bf16x8 pa3) {
    const s16x4 l0 = tr_read<v_rd_off(D0, 0, 0)>(vb), h0 = tr_read<v_rd_off(D0, 0, 1)>(vb), l1 = tr_read<v_rd_off(D0, 1, 0)>(vb), h1 = tr_read<v_rd_off(D0, 1, 1)>(vb);
    const s16x4 l2 = tr_read<v_rd_off(D0, 2, 0)>(vb), h2 = tr_read<v_rd_off(D0, 2, 1)>(vb), l3 = tr_read<v_rd_off(D0, 3, 0)>(vb), h3 = tr_read<v_rd_off(D0, 3, 1)>(vb);
    asm volatile("s_waitcnt lgkmcnt(0)" ::: "memory"); SBAR();
#define PKV(L, H) (bf16x8){L[0], L[1], L[2], L[3], H[0], H[1], H[2], H[3]}
    od = __builtin_amdgcn_mfma_f32_32x32x16_bf16(pa0, PKV(l0, h0), od, 0, 0, 0);
    od = __builtin_amdgcn_mfma_f32_32x32x16_bf16(pa1, PKV(l1, h1), od, 0, 0, 0);
    od = __builtin_amdgcn_mfma_f32_32x32x16_bf16(pa2, PKV(l2, h2), od, 0, 0, 0);
    od = __builtin_amdgcn_mfma_f32_32x32x16_bf16(pa3, PKV(l3, h3), od, 0, 0, 0);
#undef PKV
}
DEVI void pv_d0(f32x16* o, int vb, bf16x8 pa0, bf16x8 pa1, bf16x8 pa2, bf16x8 pa3) {
    pv_one<0>(o[0], vb, pa0, pa1, pa2, pa3); pv_one<1>(o[1], vb, pa0, pa1, pa2, pa3);
}
DEVI void attn_unit(const bf16_t* __restrict__ Qb, const bf16_t* __restrict__ Kh, const bf16_t* __restrict__ Vh, int seq, bf16_t* __restrict__ Ob, int ldo, char* lds) {
    const int tid = tid_(), wid = tid >> 6, lane = tid & 63, r32 = lane & 31, hi = lane >> 5;
    char* V_lds = lds; char* K_lds = lds + 2 * SHM_V;
    float* wsl = (float*)(lds + 2 * SHM_V + 2 * SHM_K) + wid * 64; float* li_l = wsl; float* al_l = wsl + 32;
    float m_reg = -1e30f, l_reg = 0.f; f32x16 o[2] = {}; bf16x8 qr[6];
    const bf16_t* Qw = Qb + (size_t)(wid * 32 + r32) * 96 + hi * 8;
#pragma unroll
    for (int d0 = 0; d0 < 6; ++d0) qr[d0] = *reinterpret_cast<const bf16x8*>(Qw + d0 * 16);
    const int sr = tid >> 4, kc = tid & 15, kcl = (kc < 12 ? kc : 11) * 8;
    const int vr = tid >> 3, vc = (tid & 7) * 8, vst0 = v_st(vr, vc);
    const int kst0 = KSWZ(sr, kc * 16), kst1 = KSWZ(32 + sr, kc * 16);
    const int vb0 = (int)(uintptr_t)V_lds + v_rd_base(lane);
    bf16x8 sv0, sk00, sk01, sv1, sk10, sk11;
#define SLOAD0(k0) do { sv0 = *reinterpret_cast<const bf16x8*>(Vh + (size_t)((k0) + vr) * 64 + vc); sk00 = *reinterpret_cast<const bf16x8*>(Kh + (size_t)((k0) + sr) * 96 + kcl); \
    sk01 = *reinterpret_cast<const bf16x8*>(Kh + (size_t)((k0) + 32 + sr) * 96 + kcl); } while (0)
#define SLOAD1(k0) do { sv1 = *reinterpret_cast<const bf16x8*>(Vh + (size_t)((k0) + vr) * 64 + vc); sk10 = *reinterpret_cast<const bf16x8*>(Kh + (size_t)((k0) + sr) * 96 + kcl); \
    sk11 = *reinterpret_cast<const bf16x8*>(Kh + (size_t)((k0) + 32 + sr) * 96 + kcl); } while (0)
#define SWRITE0(b) do { *(bf16x8*)(V_lds + (b) * SHM_V + vst0) = sv0; *(bf16x8*)(K_lds + (b) * SHM_K + kst0) = sk00; *(bf16x8*)(K_lds + (b) * SHM_K + kst1) = sk01; } while (0)
#define SWRITE1(b) do { *(bf16x8*)(V_lds + (b) * SHM_V + vst0) = sv1; *(bf16x8*)(K_lds + (b) * SHM_K + kst0) = sk10; *(bf16x8*)(K_lds + (b) * SHM_K + kst1) = sk11; } while (0)
#define SWAIT() asm volatile("s_waitcnt vmcnt(3)" ::: "memory")
#define RESC(a) do { if (__any((a) < 1.f)) { if (hi == 0) al_l[r32] = (a); asm volatile("s_waitcnt lgkmcnt(0)" ::: "memory"); \
    _Pragma("unroll") for (int d = 0; d < 2; ++d) _Pragma("unroll") for (int r = 0; r < 16; ++r) o[d][r] *= al_l[crow(r, hi)]; } } while (0)
    f32x16 pA0, pA1, pB0, pB1; float mnA, mnB, alA, alB; bf16x8 pa0, pa1, pa2, pa3; const int NT = seq / KVBLK;
    SLOAD0(0); asm volatile("s_waitcnt vmcnt(0)" ::: "memory"); SWRITE0(0); __syncthreads();
    qkt(pA0, pA1, K_lds, qr, r32, hi); partialSM(pA0, pA1, m_reg, mnA, alA);
    SLOAD1(KVBLK); if (2 < NT) SLOAD0(2 * KVBLK);
    SWAIT(); SWRITE1(1); __syncthreads();
    for (int j = 1; j + 1 < NT; j += 2) {
        SBAR(); qkt(pB0, pB1, K_lds + SHM_K, qr, r32, hi);
        finishSM(pA0, pA1, alA, l_reg, pa0, pa1, pa2, pa3); SBAR();
        SLOAD1((j + 2) * KVBLK); SBAR();
        pv_d0(o, vb0, pa0, pa1, pa2, pa3); partialSM(pB0, pB1, m_reg, mnB, alB);
        __syncthreads(); SWAIT(); SWRITE0(0);
        RESC(alB); __syncthreads();
        SBAR(); qkt(pA0, pA1, K_lds, qr, r32, hi);
        finishSM(pB0, pB1, alB, l_reg, pa0, pa1, pa2, pa3); SBAR();
        if (j + 3 < NT) SLOAD0((j + 3) * KVBLK); SBAR();
        pv_d0(o, vb0 + SHM_V, pa0, pa1, pa2, pa3); partialSM(pA0, pA1, m_reg, mnA, alA);
        __syncthreads(); SWAIT(); SWRITE1(1);
        RESC(alA); __syncthreads();
    }
    SBAR(); qkt(pB0, pB1, K_lds + SHM_K, qr, r32, hi);
    finishSM(pA0, pA1, alA, l_reg, pa0, pa1, pa2, pa3); SBAR();
    pv_d0(o, vb0, pa0, pa1, pa2, pa3); partialSM(pB0, pB1, m_reg, mnB, alB);
    __syncthreads(); RESC(alB);
    finishSM(pB0, pB1, alB, l_reg, pa0, pa1, pa2, pa3); SBAR();
    pv_d0(o, vb0 + SHM_V, pa0, pa1, pa2, pa3);
    if (hi == 0) li_l[r32] = l_reg; asm volatile("s_waitcnt lgkmcnt(0)" ::: "memory");
    float rli[16];
#pragma unroll
    for (int r = 0; r < 16; ++r) rli[r] = __builtin_amdgcn_rcpf(li_l[crow(r, hi)]);
    bf16_t* Ow = Ob + (size_t)(wid * 32) * ldo;
#pragma unroll
    for (int r = 0; r < 16; ++r) { const int orow = crow(r, hi);
#pragma unroll
        for (int d0 = 0; d0 < 2; ++d0) Ow[(size_t)orow * ldo + d0 * 32 + r32] = f2bf(o[d0][r] * rli[r]); }
    __syncthreads();
#undef SLOAD0
#undef SLOAD1
#undef SWRITE0
#undef SWRITE1
#undef SWAIT
#undef RESC
}
#undef KSWZ
#undef SBAR
}

template <class ARow, class BMap, class Epi>
DEVI void gemm_tile(int K, ARow arow, const float* __restrict__ B, int ldb, BMap bmap, Epi epi, float* smem) {
    float (*As)[132] = (float (*)[132])smem;
    float (*Bs)[64] = (float (*)[64])(smem + 16 * 132);
    const int tid = tid_(), ty = tid >> 4, tx = tid & 15;
    float acc[4][4];
#pragma unroll
    for (int i = 0; i < 4; ++i)
#pragma unroll
        for (int j = 0; j < 4; ++j) acc[i][j] = 0.f;
    const int ar = tid >> 2, akq = tid & 3;
    const float* ap = arow(ar);
    const int bk0 = tid >> 6, bc = tid & 63;
    const int bcol = bmap(bc);
    for (int k0 = 0; k0 < K; k0 += 16) {
        float4 av = make_float4(0.f, 0.f, 0.f, 0.f);
        if (ap) av = *(const float4*)(ap + k0 + akq * 4);
        float b0 = 0.f, b1 = 0.f;
        if (bcol >= 0) { b0 = B[(size_t)(k0 + bk0) * ldb + bcol]; b1 = B[(size_t)(k0 + bk0 + 8) * ldb + bcol]; }
        __syncthreads();
        As[akq * 4 + 0][ar] = av.x; As[akq * 4 + 1][ar] = av.y; As[akq * 4 + 2][ar] = av.z; As[akq * 4 + 3][ar] = av.w;
        Bs[bk0][bc] = b0; Bs[bk0 + 8][bc] = b1;
        __syncthreads();
#pragma unroll
        for (int kk = 0; kk < 16; ++kk) {
            const float4 a = *(const float4*)&As[kk][ty * 4];
            const float4 b = *(const float4*)&Bs[kk][tx * 4];
            const float aa[4] = {a.x, a.y, a.z, a.w}, bb[4] = {b.x, b.y, b.z, b.w};
#pragma unroll
            for (int i = 0; i < 4; ++i)
#pragma unroll
                for (int j = 0; j < 4; ++j) acc[i][j] = fmaf(aa[i], bb[j], acc[i][j]);
        }
    }
#pragma unroll
    for (int i = 0; i < 4; ++i) epi(ty * 4 + i, tx, acc[i]);
    __syncthreads();
}


struct UnitRange { int lo, hi, step; };
DEVI UnitRange unit_range(int nunits, int bid) {
    UnitRange r;
    if ((gridDim.x & 7) == 0) { const int x = bid & 7, j = bid >> 3; r.lo = (int)(((long)nunits * x) >> 3) + j; r.hi = (int)(((long)nunits * (x + 1)) >> 3); r.step = gridDim.x >> 3; }
    else { r.lo = bid; r.hi = nunits; r.step = gridDim.x; }
    return r;
}

__device__ void phase_convert(const Params& p) {
    float* const ws = (float*)tab_ld(N_IN);
    const float* const pin_I_WDN = PIN(I_WDN);
    const float* const pin_I_WGU = PIN(I_WGU);
    const float* const pin_I_WIN = PIN(I_WIN);
    const float* const pin_I_WOUT = PIN(I_WOUT);
    const int tid = tid_(), bid = bid_();
    const int lane = tid & 63, gw = bid * (NTHR / 64) + (tid >> 6), nw = gridDim.x * (NTHR / 64);
    constexpr int NI_GU = NLAYER * NEXP * 16 * 64, NI_DN = NLAYER * NEXP * 16 * 32, NI_OUT = NLAYER * 16 * 32, NI_IN = NLAYER * 16 * 51;
    bf16_t* wgu = (bf16_t*)(ws + W_WGU); bf16_t* wdn = (bf16_t*)(ws + W_WDN); bf16_t* wout = (bf16_t*)(ws + W_WOUT); bf16_t* win = (bf16_t*)(ws + W_WIN);
    for (int it = gw; it < NI_GU + NI_DN + NI_OUT + NI_IN; it += nw) {
        int r = it;
        if (r < NI_GU) { const int mat = r >> 10, q = r & 1023; conv_item(pin_I_WGU + (size_t)mat * D * 2048, D, 2048, wgu + (size_t)mat * 2048 * D, q >> 6, q & 63, lane); continue; }
        r -= NI_GU;
        if (r < NI_DN) { const int mat = r >> 9, q = r & 511; conv_item(pin_I_WDN + (size_t)mat * D * D, D, D, wdn + (size_t)mat * D * D, q >> 5, q & 31, lane); continue; }
        r -= NI_DN;
        if (r < NI_OUT) { const int mat = r >> 9, q = r & 511; conv_item(pin_I_WOUT + (size_t)mat * D * D, D, D, wout + (size_t)mat * D * D, q >> 5, q & 31, lane); continue; }
        r -= NI_OUT;
        { const int mat = r / 816, q = r % 816; conv_item(pin_I_WIN + (size_t)mat * D * INC, D, INC, win + (size_t)mat * NPAD_IN * D, q / 51, q % 51, lane); }
    }
}

__device__ void phase_tables(const Params& p) {
    float* const ws = (float*)tab_ld(N_IN);
    const float* const pin_I_LAM = PIN(I_LAM);
    const float* const pin_I_SGWS = PIN(I_SGWS);
    const int tid = tid_(), bid = bid_(); (void)tid; (void)bid;
    for (int i = bid * NTHR + tid; i < NLAYER * 4 * 128 * 128; i += gridDim.x * NTHR) ((bf16_t*)(ws + W_WSB))[i] = f2bf(pin_I_SGWS[i]);
    for (int i = bid * NTHR + tid; i < NLAT * 16; i += gridDim.x * NTHR) {
        const int t = i >> 4, f = i & 15; const float pos = (f < 8) ? (float)(t >> 6) : (float)(t & 63);
        const float ang = pos * powf(10000.f, -(float)(f & 7) / 8.f);
        ws[W_ROPE + (size_t)t * 32 + f] = cosf(ang); ws[W_ROPE + (size_t)t * 32 + 16 + f] = sinf(ang);
    }
    if (bid == 1) for (int i = tid; i < NLAYER * 2 * 256; i += NTHR) ws[W_SP + i] = log1pf(expf(-pin_I_LAM[i]));
    if (bid == 0) for (int i = tid; i < NLAYER * NEXP * 64; i += NTHR) ((int*)(ws + W_CNT))[i] = 0;
}

DEVI void norm1_store(const Params& p, int l, int t, int lane, const float4 (&v)[4]) {
    const float* g = p.in[I_NMIX] + l * D;
    const float* mod = p.ws + W_MOD + (size_t)(l * 2 + (t >= NLAT ? 1 : 0)) * 6144;
    float ss = 0.f;
#pragma unroll
    for (int j = 0; j < 4; ++j) ss += v[j].x * v[j].x + v[j].y * v[j].y + v[j].z * v[j].z + v[j].w * v[j].w;
    const float rstd = rsqrtf(wave_sum(ss) * (1.f / D) + EPS);
    bf16_t* hb = (bf16_t*)(p.ws + W_HB) + (size_t)t * D;
#pragma unroll
    for (int j = 0; j < 4; ++j) {
        const int c = j * 256 + lane * 4;
        const float4 gg = *(const float4*)(g + c), s1 = *(const float4*)(mod + D + c), s0 = *(const float4*)(mod + c);
        u32x2 w; w.x = cvt_pk_bf16(v[j].x * rstd * gg.x * (1.f + s1.x) + s0.x, v[j].y * rstd * gg.y * (1.f + s1.y) + s0.y);
        w.y = cvt_pk_bf16(v[j].z * rstd * gg.z * (1.f + s1.z) + s0.z, v[j].w * rstd * gg.w * (1.f + s1.w) + s0.w);
        *(u32x2*)(hb + c) = w;
    }
}
__device__ void phase_init(const Params& p) {
    float* const ws = (float*)tab_ld(N_IN);
    const float* const pin_I_CTX = PIN(I_CTX);
    const float* const pin_I_X = PIN(I_X);
    const int tid = tid_(), bid = bid_();
    const int lane = tid & 63, gw = bid * (NTHR / 64) + (tid >> 6), nw = gridDim.x * (NTHR / 64);
    for (int t = gw; t < T; t += nw) {
        const float* src = (t < NLAT) ? pin_I_X + (size_t)t * D : pin_I_CTX + (size_t)(t - NLAT) * D;
        float4 v[4];
#pragma unroll
        for (int j = 0; j < 4; ++j) { v[j] = *(const float4*)(src + j * 256 + lane * 4); *(float4*)(ws + W_X + (size_t)t * D + j * 256 + lane * 4) = v[j]; }
        norm1_store(p, 0, t, lane, v);
    }
}

__device__ void phase_mod(const Params& p, float* smem) {
    float* const ws = (float*)tab_ld(N_IN);
    const float* const pin_I_BMOD = PIN(I_BMOD);
    const float* const pin_I_C = PIN(I_C);
    const float* const pin_I_CCTX = PIN(I_CCTX);
    const float* const pin_I_WMOD = PIN(I_WMOD);
    const int tid = tid_(), bid = bid_(); (void)tid; (void)bid;
    const int wave = tid >> 6, lane = tid & 63;
    for (int it = bid; it < NLAYER * 96; it += gridDim.x) {
        const int l = it / 96, j = (it % 96) * 64 + lane;
        const float* W = pin_I_WMOD + (size_t)l * 1024 * 6144;
        float a0 = 0.f, a1 = 0.f;
        for (int k = wave * 128; k < wave * 128 + 128; ++k) {
            const float w = W[(size_t)k * 6144 + j];
            a0 = fmaf(silu(pin_I_C[k]), w, a0);
            a1 = fmaf(silu(pin_I_CCTX[k]), w, a1);
        }
        smem[(wave * 2 + 0) * 64 + lane] = a0; smem[(wave * 2 + 1) * 64 + lane] = a1;
        __syncthreads();
        if (wave < 2) {
            float s = 0.f;
            for (int w = 0; w < 8; ++w) s += smem[(w * 2 + wave) * 64 + lane];
            ws[W_MOD + (size_t)(l * 2 + wave) * 6144 + j] = s + pin_I_BMOD[l * 6144 + j];
        }
        __syncthreads();
    }
}


struct InprojSched {
    UnitRange ur; const char* A; const char* Bt;
    DEVI bool next(int i, pg8::Unit& u) const {
        const int id = ur.lo + i * ur.step; if (id >= ur.hi) return false;
        const int tm = id / 7, tn = id % 7;
        u.a = A + (size_t)tm * 256 * D * 2; u.b = Bt + (size_t)tn * 256 * D * 2; u.x0 = tm * 256; u.x1 = tn * 256; u.x2 = 0; return true;
    }
};
struct EpiInproj { static constexpr bool PERM = false; float* P;
    DEVI void operator()(const f32x4 (&acc)[2][2][4][2], const pg8::Unit& u, int wr, int wc, int fr, int fq) const {
#pragma unroll
        for (int ai = 0; ai < 2; ++ai)
#pragma unroll
            for (int m = 0; m < 4; ++m) { float* row = P + (size_t)(u.x0 + ai * 128 + wr * 64 + m * 16 + fr) * INC;
#pragma unroll
                for (int bj = 0; bj < 2; ++bj)
#pragma unroll
                    for (int n = 0; n < 2; ++n) { const int c = u.x1 + bj * 128 + wc * 32 + n * 16 + 4 * fq; if (c < INC) *(f32x4*)(row + c) = acc[ai][bj][m][n]; } }
    }
};
__device__ void phase_inproj(const Params& p, int l, char* lds) {
    float* const ws = (float*)tab_ld(N_IN);
    const int tid = tid_(), bid = bid_(); (void)tid;
    InprojSched S; S.ur = unit_range((T / 256) * 7, bid); S.A = (const char*)(ws + W_HB); S.Bt = (const char*)((const bf16_t*)(ws + W_WIN) + (size_t)l * NPAD_IN * D);
    EpiInproj E; E.P = ws + W_P;
    pg8::gemm_phase((PG8_LAS unsigned char*)lds, D, (size_t)128 * D * 2, S, E);
}

__device__ void phase_prep1(const Params& p, int l) {
    float* const ws = (float*)tab_ld(N_IN);
    const float* const pin_I_CONVB = PIN(I_CONVB);
    const float* const pin_I_CONVW = PIN(I_CONVW);
    const float* const pin_I_KVAN = PIN(I_KVAN);
    const float* const pin_I_QAN = PIN(I_QAN);
    const float* const pin_I_SGB = PIN(I_SGB);
    const float* const pin_I_SGG = PIN(I_SGG);
    const int tid = tid_(), bid = bid_(); (void)tid; (void)bid;
    const int lane = tid & 63, gw = bid * (NTHR / 64) + (tid >> 6), nw = gridDim.x * (NTHR / 64);
    for (int t = gw; t < T; t += nw) {
        const int s0 = (t < NLAT) ? 0 : NLAT, sl = (t < NLAT) ? NLAT : NCTX, n = t - s0;
        const float* P = ws + W_P; const float* pr = P + (size_t)t * INC;
        {
            const int g = lane >> 4, w = 2 << g;
            const int lo = max(n - w / 2, 0), hi = min(n + w / 2, sl);
            float4 s = make_float4(0.f, 0.f, 0.f, 0.f);
            for (int m = lo; m < hi; ++m) { const float4 v = *(const float4*)(P + (size_t)(s0 + m) * INC + OFF_A + lane * 4); s.x += v.x; s.y += v.y; s.z += v.z; s.w += v.w; }
            const float inv = 1.f / (float)(hi - lo);
            const float4 x = *(const float4*)(pr + OFF_A + lane * 4);
            float4 d; d.x = s.x * inv - x.x; d.y = s.y * inv - x.y; d.z = s.z * inv - x.z; d.w = s.w * inv - x.w;
            { u32x2 w; w.x = cvt_pk_bf16(d.x, d.y); w.y = cvt_pk_bf16(d.z, d.w); *(u32x2*)((bf16_t*)(ws + W_DIFF) + (size_t)t * 256 + lane * 4) = w; }
        }
        {
            float v[3]; float ss = 0.f;
#pragma unroll
            for (int j = 0; j < 3; ++j) { v[j] = pr[OFF_Q + j * 64 + lane]; ss += v[j] * v[j]; }
            ss = wave_sum(ss); const float rstd = rsqrtf(ss * (1.f / 192.f) + EPS);
#pragma unroll
            for (int j = 0; j < 3; ++j) ((bf16_t*)(ws + W_QN))[(size_t)t * 192 + j * 64 + lane] = f2bf(v[j] * rstd * pin_I_QAN[l * 192 + j * 64 + lane]);
        }
        {
            float v[2]; float ss = 0.f;
#pragma unroll
            for (int j = 0; j < 2; ++j) { v[j] = pr[OFF_KV + j * 64 + lane]; ss += v[j] * v[j]; }
            ss = wave_sum(ss); const float rstd = rsqrtf(ss * (1.f / 128.f) + EPS);
#pragma unroll
            for (int j = 0; j < 2; ++j) ((bf16_t*)(ws + W_KVN))[(size_t)t * 128 + j * 64 + lane] = f2bf(v[j] * rstd * pin_I_KVAN[l * 128 + j * 64 + lane]);
        }
        {
            const float4 zu = *(const float4*)(pr + OFF_C + lane * 4), zv = *(const float4*)(pr + OFF_C + 256 + lane * 4);
            float4 u; u.x = gelu_tanh(zu.x); u.y = gelu_tanh(zu.y); u.z = gelu_tanh(zu.z); u.w = gelu_tanh(zu.w);
            *(float4*)(ws + W_U + (size_t)t * 256 + lane * 4) = u;
            float gv[4] = {gelu_tanh(zv.x), gelu_tanh(zv.y), gelu_tanh(zv.z), gelu_tanh(zv.w)};
            const float mu = wave_sum(gv[0] + gv[1] + gv[2] + gv[3]) * (1.f / 256.f);
            float q = 0.f;
#pragma unroll
            for (int j = 0; j < 4; ++j) { gv[j] -= mu; q += gv[j] * gv[j]; }
            const float rstd = rsqrtf(wave_sum(q) * (1.f / 256.f) + EPS);
#pragma unroll
            for (int j = 0; j < 4; ++j) ws[W_VN + (size_t)t * 256 + lane * 4 + j] = gv[j] * rstd * pin_I_SGG[l * 256 + lane * 4 + j] + pin_I_SGB[l * 256 + lane * 4 + j];
        }
        {
            const float* cw = pin_I_CONVW + (size_t)l * 4 * 256;
            float4 o = *(const float4*)(pin_I_CONVB + l * 256 + lane * 4);
#pragma unroll
            for (int k = 0; k < 4; ++k) {
                const int m = n - 1 + k;
                if (m >= 0 && m < sl) {
                    const float4 xv = *(const float4*)(P + (size_t)(s0 + m) * INC + OFF_DX + lane * 4), wv = *(const float4*)(cw + k * 256 + lane * 4);
                    o.x = fmaf(xv.x, wv.x, o.x); o.y = fmaf(xv.y, wv.y, o.y); o.z = fmaf(xv.z, wv.z, o.z); o.w = fmaf(xv.w, wv.w, o.w);
                }
            }
            *(float4*)(ws + W_XC + (size_t)t * 256 + lane * 4) = o;
            { u32x2 w; w.x = cvt_pk_bf16(o.x, o.y); w.y = cvt_pk_bf16(o.z, o.w); *(u32x2*)((bf16_t*)(ws + W_XCB) + (size_t)t * 256 + lane * 4) = w; }
        }
    }
}

__device__ void phase_small(const Params& p, int l, char* lds) {
    float* const ws = (float*)tab_ld(N_IN);
    const float* const pin_I_BA = PIN(I_BA);
    const float* const pin_I_BX = PIN(I_BX);
    const float* const pin_I_POOLS = PIN(I_POOLS);
    const float* const pin_I_POOLW = PIN(I_POOLW);
    const float* const pin_I_SGBS = PIN(I_SGBS);
    const float* const pin_I_WA = PIN(I_WA);
    const float* const pin_I_WUKV = PIN(I_WUKV);
    const float* const pin_I_WUQ = PIN(I_WUQ);
    const float* const pin_I_WX = PIN(I_WX);
    const int tid = tid_(), bid = bid_(); (void)tid;
    constexpr int NK = 19, NU1 = (T / 256) * NK, NU2 = NCHUNK * 2;
    bf16_t* Y = (bf16_t*)(ws + W_YC);
    for (int u = bid; u < NU1 + NU2; u += gridDim.x) {
        if (u < NU1) {
            const int tm = u / NK, kind = u % NK, m0 = tm * 256;
            if (kind < 11) {
                const bf16_t* A; int lda, K, ldb, nval; const float* B;
                if (kind < 4) { A = (const bf16_t*)(ws + W_DIFF) + kind * 64; lda = 256; K = 64; B = pin_I_POOLW + (size_t)(l * 4 + kind) * 64 * 64; ldb = 64; nval = 64; }
                else if (kind < 7) { A = (const bf16_t*)(ws + W_QN); lda = 192; K = 192; B = pin_I_WUQ + (size_t)l * 192 * 384 + (kind - 4) * 128; ldb = 384; nval = 128; }
                else { A = (const bf16_t*)(ws + W_KVN); lda = 128; K = 128; B = pin_I_WUKV + (size_t)l * 128 * 512 + (kind - 7) * 128; ldb = 512; nval = 128; }
                gemm_unit<false>(lds, K, [&](int r) { return A + (size_t)(m0 + r) * lda; }, B, B, ldb, nval,
                    [&](const f32x4 (&acc)[4][4], int wr, int wc, int fr, int fq) {
#pragma unroll
                        for (int m = 0; m < 4; ++m) { const int t = m0 + wr * 64 + m * 16 + fr;
#pragma unroll
                            for (int n = 0; n < 4; ++n) { const int c = wc * 64 + n * 16 + 4 * fq;
                                if (kind < 4) { if (wc == 0) { const f32x4 sc = *(const f32x4*)(pin_I_POOLS + l * 256 + kind * 64 + c); const f32x4 v = acc[m][n] * sc;
                                        u32x2 w; w.x = cvt_pk_bf16(v[0], v[1]); w.y = cvt_pk_bf16(v[2], v[3]); *(u32x2*)(Y + (size_t)t * D + kind * 64 + c) = w; } }
                                else if (kind < 7) *(f32x4*)(ws + W_QUP + (size_t)t * 384 + (kind - 4) * 128 + c) = acc[m][n];
                                else *(f32x4*)(ws + W_KVUP + (size_t)t * 512 + (kind - 7) * 128 + c) = acc[m][n]; } }
                    });
            } else {
                const int d = (kind - 11) >> 2, h = (kind - 11) & 3;
                const bf16_t* A = (const bf16_t*)(ws + W_XCB) + h * 64;
                const float* Ba = pin_I_WA + (size_t)((l * 2 + d) * 4 + h) * 64 * 64; const float* Bx = pin_I_WX + (size_t)((l * 2 + d) * 4 + h) * 64 * 64;
                const int pb = (l * 2 + d) * 256 + h * 64;
                gemm_unit<true>(lds, 64, [&](int r) { return A + (size_t)(m0 + r) * 256; }, Ba, Bx, 64, 64,
                    [&](const f32x4 (&acc)[4][4], int wr, int wc, int fr, int fq) {
#pragma unroll
                        for (int m = 0; m < 4; ++m) { const int t = m0 + wr * 64 + m * 16 + fr;
#pragma unroll
                            for (int pp = 0; pp < 2; ++pp) { const int idx = (wc * 2 + pp) * 16 + 4 * fq;
                                const f32x4 ba = *(const f32x4*)(pin_I_BA + pb + idx), bx = *(const f32x4*)(pin_I_BX + pb + idx), sp = *(const f32x4*)(ws + W_SP + pb + idx);
                                const f32x4 xv = *(const f32x4*)(ws + W_XC + (size_t)t * 256 + h * 64 + idx);
                                f32x4 av, dv;
#pragma unroll
                                for (int j = 0; j < 4; ++j) { const float r = fsigm(acc[m][2 * pp][j] + ba[j]), ig = fsigm(acc[m][2 * pp + 1][j] + bx[j]);
                                    const float loga = -8.f * r * sp[j], x2 = 2.f * loga;
                                    const float om = (x2 > -0.0625f) ? -x2 * (1.f + x2 * (0.5f + x2 * (0.16666667f + x2 * 0.041666668f))) : 1.f - fexp(x2);
                                    av[j] = fexp(loga); dv[j] = __builtin_amdgcn_sqrtf(om) * (ig * xv[j]); }
                                *(f32x4*)(ws + W_LA + ((size_t)d * T + t) * 256 + h * 64 + idx) = av;
                                *(f32x4*)(ws + W_LB + ((size_t)d * T + t) * 256 + h * 64 + idx) = dv; } }
                    });
            }
        } else {
            const int v = u - NU1, c = v >> 1, hp = v & 1;
            const bf16_t* A = (const bf16_t*)(ws + W_WSB) + ((size_t)l * 512 + hp * 256) * 128;
            const float* B = ws + W_VN + (size_t)c * 128 * 256 + hp * 128;
            gemm_unit<false>(lds, 128, [&](int r) { return A + (size_t)r * 128; }, B, B, 256, 128,
                [&](const f32x4 (&acc)[4][4], int wr, int wc, int fr, int fq) {
                    if ((wr >> 1) == wc) {
                        const int h = hp * 2 + wc;
#pragma unroll
                        for (int m = 0; m < 4; ++m) { const int pp = (wr & 1) * 64 + m * 16 + fr, t = c * 128 + pp; const float bs = pin_I_SGBS[(l * 4 + h) * 128 + pp];
#pragma unroll
                            for (int n = 0; n < 4; ++n) { const int ch = h * 64 + n * 16 + 4 * fq; const f32x4 uu = *(const f32x4*)(ws + W_U + (size_t)t * 256 + ch);
                                const f32x4 o = uu * (acc[m][n] + bs);
                                u32x2 w; w.x = cvt_pk_bf16(o[0], o[1]); w.y = cvt_pk_bf16(o[2], o[3]); *(u32x2*)(Y + (size_t)t * D + 512 + ch) = w; } }
                    }
                });
        }
    }
}

__device__ void phase_prep2(const Params& p, int l) {
    float* const ws = (float*)tab_ld(N_IN);
    const float* const pin_I_KN = PIN(I_KN);
    const float* const pin_I_QN = PIN(I_QN);
    const int tid = tid_(), bid = bid_();
    const int lane = tid & 63, gw = bid * (NTHR / 64) + (tid >> 6), nw = gridDim.x * (NTHR / 64);
    {
        const int h = lane >> 4, j = lane & 15;
        const f32x4 qw = *(const f32x4*)(pin_I_QN + l * 96 + 4 * j), kw = *(const f32x4*)(pin_I_KN + l * 96 + 4 * j);
        const float qw1 = pin_I_QN[l * 96 + 64 + j], qw2 = pin_I_QN[l * 96 + 80 + j], kw1 = pin_I_KN[l * 96 + 64 + j], kw2 = pin_I_KN[l * 96 + 80 + j];
        for (int t = gw; t < T; t += nw) {
            const bool lat = t < NLAT;
            float cs = 1.f, sn = 0.f;
            if (lat) { cs = ws[W_ROPE + (size_t)t * 32 + j]; sn = ws[W_ROPE + (size_t)t * 32 + 16 + j]; }
            const float* qr = ws + W_QUP + (size_t)t * 384 + h * 96; const float* kr = ws + W_KVUP + (size_t)t * 512 + h * 128; const float* pr = ws + W_P + (size_t)t * INC + OFF_KR;
            f32x4 qn = *(const f32x4*)(qr + 4 * j); float q1 = qr[64 + j], q2 = qr[80 + j];
            f32x4 kn = *(const f32x4*)(kr + 4 * j); float k1 = pr[j], k2 = pr[16 + j];
            const f32x4 vv = *(const f32x4*)(kr + 64 + 4 * j);
            float sq = qn[0] * qn[0] + qn[1] * qn[1] + qn[2] * qn[2] + qn[3] * qn[3] + q1 * q1 + q2 * q2;
            float sk = kn[0] * kn[0] + kn[1] * kn[1] + kn[2] * kn[2] + kn[3] * kn[3] + k1 * k1 + k2 * k2;
#pragma unroll
            for (int o = 1; o < 16; o <<= 1) { sq += __shfl_xor(sq, o); sk += __shfl_xor(sk, o); }
            const float rq = rsqrtf(sq * (1.f / 96.f) + EPS), rk = rsqrtf(sk * (1.f / 96.f) + EPS);
            qn = qn * qw * rq; q1 *= qw1 * rq; q2 *= qw2 * rq; kn = kn * kw * rk; k1 *= kw1 * rk; k2 *= kw2 * rk;
            const float qa = q1 * cs - q2 * sn, qb = q1 * sn + q2 * cs, ka = k1 * cs - k2 * sn, kb = k1 * sn + k2 * cs;
            bf16_t* qo = (bf16_t*)(ws + W_Q) + ((size_t)h * T + t) * 96; bf16_t* ko = (bf16_t*)(ws + W_K) + ((size_t)h * T + t) * 96; bf16_t* vo = (bf16_t*)(ws + W_V) + ((size_t)h * T + t) * 64;
            { u32x2 w; w.x = cvt_pk_bf16(qn[0], qn[1]); w.y = cvt_pk_bf16(qn[2], qn[3]); *(u32x2*)(qo + 4 * j) = w; qo[64 + j] = f2bf(qa); qo[80 + j] = f2bf(qb); }
            { u32x2 w; w.x = cvt_pk_bf16(kn[0], kn[1]); w.y = cvt_pk_bf16(kn[2], kn[3]); *(u32x2*)(ko + 4 * j) = w; ko[64 + j] = f2bf(ka); ko[80 + j] = f2bf(kb); }
            { u32x2 w; w.x = cvt_pk_bf16(vv[0], vv[1]); w.y = cvt_pk_bf16(vv[2], vv[3]); *(u32x2*)(vo + 4 * j) = w; }
        }
    }
    for (int i = bid * NTHR + tid; i < NCHUNK * 512; i += gridDim.x * NTHR) {
        const int c = i >> 9, d = (i >> 8) & 1, ch = i & 255;
        const size_t off = ((size_t)d * T + (size_t)c * 128) * 256 + ch;
        const float* __restrict__ A = ws + W_LA + off; const float* __restrict__ B = ws + W_LB + off;
        float* __restrict__ A2 = ws + W_LA2 + off; float* __restrict__ B2 = ws + W_LB2 + off;
        float h = 0.f, ap = 1.f;
        float a[8], b[8], an[8], bn[8];
#pragma unroll
        for (int j = 0; j < 8; ++j) { const int q = d ? 127 - j : j; a[j] = A[(size_t)q * 256]; b[j] = B[(size_t)q * 256]; }
        for (int s0 = 0; s0 < 128; s0 += 8) {
            const int s1 = (s0 + 8 < 128) ? s0 + 8 : s0;
#pragma unroll
            for (int j = 0; j < 8; ++j) { const int q = d ? 127 - (s1 + j) : s1 + j; an[j] = A[(size_t)q * 256]; bn[j] = B[(size_t)q * 256]; }
#pragma unroll
            for (int j = 0; j < 8; ++j) { h = fmaf(a[j], h, b[j]); ap *= a[j]; const int q = d ? 127 - (s0 + j) : s0 + j; A2[(size_t)q * 256] = ap; B2[(size_t)q * 256] = h; }
#pragma unroll
            for (int j = 0; j < 8; ++j) { a[j] = an[j]; b[j] = bn[j]; }
        }
        ws[W_AGG + ((size_t)(c * 2 + d) * 2 + 0) * 256 + ch] = ap;
        ws[W_AGG + ((size_t)(c * 2 + d) * 2 + 1) * 256 + ch] = h;
    }
}


__device__ void phase_attn(const Params& p, int l, char* lds) {
    float* const ws = (float*)tab_ld(N_IN);
    const int tid = tid_(), bid = bid_(); (void)tid;
    const bf16_t* Qb = (const bf16_t*)(ws + W_Q); const bf16_t* Kb = (const bf16_t*)(ws + W_K); const bf16_t* Vb = (const bf16_t*)(ws + W_V);
    bf16_t* Y = (bf16_t*)(ws + W_YC);
    const int nunits = (l == 0) ? 260 : 256;
    for (int u = bid; u < nunits; u += gridDim.x) {
        int h, t0, k0, seq;
        if (u < 256) { h = (u & 7) >> 1; t0 = (((u >> 3) << 1) | (u & 1)) * 256; k0 = 0; seq = T; }
        else { h = u - 256; t0 = NLAT; k0 = NLAT; seq = NCTX; }
        att::attn_unit(Qb + ((size_t)h * T + t0) * 96, Kb + ((size_t)h * T + k0) * 96, Vb + ((size_t)h * T + k0) * 64, seq, Y + (size_t)t0 * D + 256 + h * 64, D, lds);
    }
}

__device__ void phase_lru_fin(const Params& p, char* lds) {
    float* const ws = (float*)tab_ld(N_IN);
    const int tid = tid_(), bid = bid_();
    float* carry = (float*)lds;
    for (int it = bid; it < NCHUNK * 2; it += gridDim.x) {
        const int c = it >> 1, half = it & 1;
        {
            const int d = tid >> 8, ch = tid & 255;
            const int npre = d ? (NCHUNK - 1 - c) : ((c + 2) % NCHUNK);
            float s = 0.f;
            for (int k = 0; k < npre; ++k) {
                const int q = d ? (NCHUNK - 1 - k) : ((k + 128) % NCHUNK);
                const float a = ws[W_AGG + ((size_t)(q * 2 + d) * 2 + 0) * 256 + ch], hh = ws[W_AGG + ((size_t)(q * 2 + d) * 2 + 1) * 256 + ch];
                s = fmaf(a, s, hh);
            }
            carry[tid] = s;
        }
        __syncthreads();
        for (int i = tid; i < 64 * 64; i += NTHR) {
            const int t = c * 128 + half * 64 + (i >> 6), ch = (i & 63) * 4;
            f32x4 hs = *(const f32x4*)(ws + W_LB2 + (size_t)t * 256 + ch) + *(const f32x4*)(ws + W_LA2 + (size_t)t * 256 + ch) * *(const f32x4*)(carry + ch);
            hs = hs + *(const f32x4*)(ws + W_LB2 + ((size_t)T + t) * 256 + ch) + *(const f32x4*)(ws + W_LA2 + ((size_t)T + t) * 256 + ch) * *(const f32x4*)(carry + 256 + ch);
            const f32x4 g = *(const f32x4*)(ws + W_P + (size_t)t * INC + OFF_DG + ch);
            u32x2 w; w.x = cvt_pk_bf16(gelu_tanh(g[0]) * hs[0], gelu_tanh(g[1]) * hs[1]); w.y = cvt_pk_bf16(gelu_tanh(g[2]) * hs[2], gelu_tanh(g[3]) * hs[3]);
            *(u32x2*)((bf16_t*)(ws + W_YC) + (size_t)t * D + 768 + ch) = w;
        }
        __syncthreads();
    }
}

struct OutprojSched {
    UnitRange ur; const char* A; const char* Bt;
    DEVI bool next(int i, pg8::Unit& u) const {
        const int id = ur.lo + i * ur.step; if (id >= ur.hi) return false;
        const int tm = id >> 2, tn = id & 3;
        u.a = A + (size_t)tm * 256 * D * 2; u.b = Bt + (size_t)tn * 256 * D * 2; u.x0 = tm * 256; u.x1 = tn * 256; u.x2 = 0; return true;
    }
};
struct EpiOutproj { static constexpr bool PERM = false; float* X; const float* modv;
    DEVI void operator()(const f32x4 (&acc)[2][2][4][2], const pg8::Unit& u, int wr, int wc, int fr, int fq) const {
        const float* g1 = modv + (u.x0 >= NLAT ? 6144 : 0) + 2 * D;
#pragma unroll
        for (int ai = 0; ai < 2; ++ai)
#pragma unroll
            for (int m = 0; m < 4; ++m) { float* row = X + (size_t)(u.x0 + ai * 128 + wr * 64 + m * 16 + fr) * D;
#pragma unroll
                for (int bj = 0; bj < 2; ++bj)
#pragma unroll
                    for (int n = 0; n < 2; ++n) { const int c = u.x1 + bj * 128 + wc * 32 + n * 16 + 4 * fq; const f32x4 g = *(const f32x4*)(g1 + c); f32x4 x = *(f32x4*)(row + c);
                        x = x + g * acc[ai][bj][m][n]; *(f32x4*)(row + c) = x; } }
    }
};
__device__ void phase_outproj(const Params& p, int l, char* lds) {
    float* const ws = (float*)tab_ld(N_IN);
    const int tid = tid_(), bid = bid_(); (void)tid;
    const int ntm = (l == NLAYER - 1) ? NLAT / 256 : T / 256;
    OutprojSched S; S.ur = unit_range(ntm * 4, bid); S.A = (const char*)(ws + W_YC); S.Bt = (const char*)((const bf16_t*)(ws + W_WOUT) + (size_t)l * D * D);
    EpiOutproj E; E.X = ws + W_X; E.modv = ws + W_MOD + (size_t)l * 2 * 6144;
    pg8::gemm_phase((PG8_LAS unsigned char*)lds, D, (size_t)128 * D * 2, S, E);
}

constexpr int R_LDS = 1024 * 36 * 4;
__device__ void phase_router(const Params& p, int l, char* lds) {
    float* const ws = (float*)tab_ld(N_IN);
    const float* const pin_I_NFFN = PIN(I_NFFN);
    const float* const pin_I_RB = PIN(I_RB);
    const float* const pin_I_RW = PIN(I_RW);
    const int tid = tid_(), bid = bid_();
    float* wl = (float*)lds;
    int* hist = (int*)(lds + R_LDS); int* bbase = hist + 32; int* tinfo = hist + 64 + (tid >> 6) * 40;
    if (tid < 32) hist[tid] = 0;
    {   const float* rw = pin_I_RW + (size_t)l * D * NEXP;
        for (int i = tid; i < 1024 * 8; i += NTHR) { const int k = i >> 3, e4 = i & 7; *(f32x4*)(wl + k * 36 + e4 * 4) = *(const f32x4*)(rw + k * 32 + e4 * 4); }
    }
    __syncthreads();
    const int lane = tid & 63, gw = bid * (NTHR / 64) + (tid >> 6), nw = gridDim.x * (NTHR / 64);
    const float* g = pin_I_NFFN + l * D;
    int* cnt = (int*)(ws + W_CNT) + l * NEXP * 64;
    bf16_t* HB = (bf16_t*)(ws + W_HB);

    const int e = lane >> 1;
    const float rb = pin_I_RB[l * NEXP + e];
    const int TL = (l == NLAYER - 1) ? NLAT : T;
    int ti = 0;
    for (int t = gw; t < TL; t += nw, ++ti) {
        const float* x = ws + W_X + (size_t)t * D;
        const float* mod = ws + W_MOD + (size_t)(l * 2 + (t >= NLAT ? 1 : 0)) * 6144;
        float f[16]; float ss = 0.f;
#pragma unroll
        for (int m = 0; m < 16; ++m) { f[m] = x[lane + 64 * m]; ss = fmaf(f[m], f[m], ss); }
        const float rstd = rsqrtf(wave_sum(ss) * (1.f / D) + EPS);
#pragma unroll
        for (int m = 0; m < 16; ++m) { const int k = lane + 64 * m; f[m] = f[m] * rstd * g[k] * (1.f + mod[4 * D + k]) + mod[3 * D + k]; HB[(size_t)t * D + k] = f2bf(f[m]); }
        float acc[32];
#pragma unroll
        for (int j = 0; j < 32; ++j) acc[j] = 0.f;
#pragma unroll
        for (int m = 0; m < 16; ++m) {
            const float* wr = wl + (lane + 64 * m) * 36;
#pragma unroll
            for (int e4 = 0; e4 < 8; ++e4) { const f32x4 w4 = *(const f32x4*)(wr + e4 * 4);
#pragma unroll
                for (int j = 0; j < 4; ++j) acc[e4 * 4 + j] = fmaf(f[m], w4[j], acc[e4 * 4 + j]); }
        }
#pragma unroll
        for (int w = 16, msk = 32; w >= 1; w >>= 1, msk >>= 1) {
            const bool up = (lane & msk) != 0;
#pragma unroll
            for (int j = 0; j < w; ++j) { const float send = up ? acc[j] : acc[j + w], keep = up ? acc[j + w] : acc[j]; acc[j] = keep + __shfl_xor(send, msk); }
        }
        float a = acc[0] + __shfl_xor(acc[0], 1) + rb;
        float tv[4]; int te[4];
        float cur = a;
#pragma unroll
        for (int k = 0; k < 4; ++k) {
            float bv = cur; int bi = e;
#pragma unroll
            for (int o = 32; o > 1; o >>= 1) {
                const float ov = __shfl_xor(bv, o); const int oi = __shfl_xor(bi, o);
                if (ov > bv || (ov == bv && oi < bi)) { bv = ov; bi = oi; }
            }
            tv[k] = bv; te[k] = bi;
            if (e == bi) cur = -3.0e38f;
        }
        const float mx = tv[0];
        float ex[4], sm = 0.f;
#pragma unroll
        for (int k = 0; k < 4; ++k) { ex[k] = expf(tv[k] - mx); sm += ex[k]; }
        if (lane < 4) {
            const int ee = lane == 0 ? te[0] : lane == 1 ? te[1] : lane == 2 ? te[2] : te[3];
            const float eg = lane == 0 ? ex[0] : lane == 1 ? ex[1] : lane == 2 ? ex[2] : ex[3];
            const int lidx = atomicAdd(&hist[ee], 1);
            tinfo[ti * 4 + lane] = (ee << 16) | lidx;
            ((int*)(ws + W_TOPE))[t * 4 + lane] = ee;
            ws[W_TOPG + t * 4 + lane] = eg / sm;
        }
    }
    __syncthreads();
    if (tid < 32) bbase[tid] = atomicAdd(&cnt[tid * 64], hist[tid]);
    __syncthreads();
    ti = 0;
    for (int t = gw; t < TL; t += nw, ++ti)
        if (lane < 4) { const int v = tinfo[ti * 4 + lane]; ((int*)(ws + W_TOPI))[t * 4 + lane] = bbase[v >> 16] + (v & 0xffff); }
    __syncthreads();
}

DEVI void moe_bases(const Params& p, int l, int* sb) {
    float* const ws = (float*)tab_ld(N_IN);
    const int tid = tid_();
    if (tid == 0) {
        const int* cnt = (const int*)(ws + W_CNT) + l * NEXP * 64;
        int b = 0, tb = 0;
        for (int e = 0; e < NEXP; ++e) { sb[e] = b; sb[40 + e] = tb; const int c = cnt[e * 64]; sb[80 + e] = c; const int mt = (c + 255) / 256; b += mt * 256; tb += mt; }
        sb[32] = b; sb[72] = tb;
    }
    __syncthreads();
}

__device__ void phase_scatter(const Params& p, int l, char* lds) {
    float* const ws = (float*)tab_ld(N_IN);
    const int tid = tid_(), bid = bid_();
    int* sb = (int*)(lds + G_LDS);
    moe_bases(p, l, sb);
    const bf16_t* HB = (const bf16_t*)(ws + W_HB); bf16_t* XS = (bf16_t*)(ws + W_XS);
    const int lane = tid & 63, gw = bid * (NTHR / 64) + (tid >> 6), nw = gridDim.x * (NTHR / 64);
    const int TL = (l == NLAYER - 1) ? NLAT : T;
    for (int t = gw; t < TL; t += nw) {
        int row = 0;
        if (lane < 4) { const int e = ((const int*)(ws + W_TOPE))[t * 4 + lane]; row = sb[e] + ((const int*)(ws + W_TOPI))[t * 4 + lane]; ((int*)(ws + W_TOPI))[t * 4 + lane] = row; }
        const u32x4 v0 = *(const u32x4*)(HB + (size_t)t * D + lane * 8), v1 = *(const u32x4*)(HB + (size_t)t * D + 512 + lane * 8);
#pragma unroll
        for (int k = 0; k < 4; ++k) { const int rk = __shfl(row, k); bf16_t* d = XS + (size_t)rk * D; *(u32x4*)(d + lane * 8) = v0; *(u32x4*)(d + 512 + lane * 8) = v1; }
    }
    __syncthreads();
}

struct MoeSched {
    UnitRange ur; const int* sb; int ntn; const char* A; const char* Bt; size_t bstride_e, bstride_tn;
    DEVI bool next(int i, pg8::Unit& u) const {
        const int id = ur.lo + i * ur.step; if (id >= ur.hi) return false;
        int e = 0; while (e < NEXP - 1 && sb[40 + e + 1] * ntn <= id) ++e;
        const int mts = sb[40 + e + 1] - sb[40 + e], loc = id - sb[40 + e] * ntn, tng = loc / (mts * 4), rr = loc % (mts * 4), mt = rr >> 2, tn = tng * 4 + (rr & 3);
        const int r0 = __builtin_amdgcn_readfirstlane(sb[e] + mt * 256), tn_s = __builtin_amdgcn_readfirstlane(tn), e_s = __builtin_amdgcn_readfirstlane(e);
        u.a = A + (size_t)r0 * D * 2; u.b = Bt + (size_t)e_s * bstride_e + (size_t)tn_s * bstride_tn; u.x0 = r0; u.x1 = tn_s; u.x2 = e_s; return true;
    }
};
struct EpiMoe1 { static constexpr bool PERM = true; bf16_t* ACT; const float* bias;
    DEVI void operator()(const f32x4 (&acc)[2][2][4][2], const pg8::Unit& u, int wr, int wc, int fr, int fq) const {
        const int c0 = u.x1 * 128 + wc * 32 + 8 * fq;
        const float* bg = bias + (size_t)u.x2 * 2048 + c0; const float* bu = bg + 1024;
        f32x4 vg[2], vu[2];
#pragma unroll
        for (int n = 0; n < 2; ++n) { vg[n] = *(const f32x4*)(bg + 4 * n); vu[n] = *(const f32x4*)(bu + 4 * n); }
#pragma unroll
        for (int ai = 0; ai < 2; ++ai)
#pragma unroll
            for (int m = 0; m < 4; ++m) { bf16_t* rowp = ACT + (size_t)(u.x0 + ai * 128 + wr * 64 + m * 16 + fr) * D + c0;
                float a[8];
#pragma unroll
                for (int n = 0; n < 2; ++n)
#pragma unroll
                    for (int j = 0; j < 4; ++j) { float g = acc[ai][0][m][n][j] + vg[n][j], uu = acc[ai][1][m][n][j] + vu[n][j];
                        g = fminf(g, 7.f); uu = fminf(fmaxf(uu, -7.f), 7.f); a[n * 4 + j] = (uu + 1.f) * (g * sigm(1.702f * g)); }
                u32x4 w; w.x = cvt_pk_bf16(a[0], a[1]); w.y = cvt_pk_bf16(a[2], a[3]); w.z = cvt_pk_bf16(a[4], a[5]); w.w = cvt_pk_bf16(a[6], a[7]);
                *(u32x4*)rowp = w; }
    }
};
__device__ void phase_moe1(const Params& p, int l, char* lds) {
    float* const ws = (float*)tab_ld(N_IN);
    const float* const pin_I_BGU = PIN(I_BGU);
    const int tid = tid_(), bid = bid_(); (void)tid;
    int* sb = (int*)(lds + pg8::STAGE_BYTES);
    moe_bases(p, l, sb);
    MoeSched S; S.sb = sb; S.ntn = 8; S.ur = unit_range(sb[72] * 8, bid); S.A = (const char*)(ws + W_XS);
    S.Bt = (const char*)((const bf16_t*)(ws + W_WGU) + (size_t)l * NEXP * 2048 * D); S.bstride_e = (size_t)2048 * D * 2; S.bstride_tn = (size_t)128 * D * 2;
    EpiMoe1 E; E.ACT = (bf16_t*)(ws + W_ACT); E.bias = pin_I_BGU + (size_t)l * NEXP * 2048;
    pg8::gemm_phase((PG8_LAS unsigned char*)lds, D, (size_t)1024 * D * 2, S, E);
    __syncthreads();
}

struct EpiMoe2 { static constexpr bool PERM = true; bf16_t* YR; const float* bias;
    DEVI void operator()(const f32x4 (&acc)[2][2][4][2], const pg8::Unit& u, int wr, int wc, int fr, int fq) const {
        const int c0 = u.x1 * 256 + wc * 32 + 8 * fq;
        const float* bb = bias + (size_t)u.x2 * D + c0;
        f32x4 bv[2][2];
#pragma unroll
        for (int bj = 0; bj < 2; ++bj)
#pragma unroll
            for (int n = 0; n < 2; ++n) bv[bj][n] = *(const f32x4*)(bb + bj * 128 + 4 * n);
#pragma unroll
        for (int ai = 0; ai < 2; ++ai)
#pragma unroll
            for (int m = 0; m < 4; ++m) { bf16_t* rowp = YR + (size_t)(u.x0 + ai * 128 + wr * 64 + m * 16 + fr) * D + c0;
#pragma unroll
                for (int bj = 0; bj < 2; ++bj) { const f32x4 v0 = acc[ai][bj][m][0] + bv[bj][0], v1 = acc[ai][bj][m][1] + bv[bj][1];
                    u32x4 w; w.x = cvt_pk_bf16(v0[0], v0[1]); w.y = cvt_pk_bf16(v0[2], v0[3]); w.z = cvt_pk_bf16(v1[0], v1[1]); w.w = cvt_pk_bf16(v1[2], v1[3]);
                    *(u32x4*)(rowp + bj * 128) = w; } }
    }
};
__device__ void phase_moe2(const Params& p, int l, char* lds) {
    float* const ws = (float*)tab_ld(N_IN);
    const float* const pin_I_BDN = PIN(I_BDN);
    const int tid = tid_(), bid = bid_(); (void)tid;
    int* sb = (int*)(lds + pg8::STAGE_BYTES);
    moe_bases(p, l, sb);
    MoeSched S; S.sb = sb; S.ntn = 4; S.ur = unit_range(sb[72] * 4, bid); S.A = (const char*)(ws + W_ACT);
    S.Bt = (const char*)((const bf16_t*)(ws + W_WDN) + (size_t)l * NEXP * D * D); S.bstride_e = (size_t)D * D * 2; S.bstride_tn = (size_t)256 * D * 2;
    EpiMoe2 E; E.YR = (bf16_t*)(ws + W_YR); E.bias = pin_I_BDN + (size_t)l * NEXP * D;
    pg8::gemm_phase((PG8_LAS unsigned char*)lds, D, (size_t)128 * D * 2, S, E);
    __syncthreads();
}

__device__ void phase_combine(const Params& p, int l, char* lds, bool last) {
    float* const ws = (float*)tab_ld(N_IN);
    float* const pout = (float*)tab_ld(N_IN + 1);
    const int tid = tid_(), bid = bid_();
    const bf16_t* YR = (const bf16_t*)(ws + W_YR);
    const int lane = tid & 63, gw = bid * (NTHR / 64) + (tid >> 6), nw = gridDim.x * (NTHR / 64);
    const int TL = last ? NLAT : T;
    for (int t = gw; t < TL; t += nw) {
        const float* g2 = ws + W_MOD + (size_t)(l * 2 + (t >= NLAT ? 1 : 0)) * 6144 + 5 * D;
        const bf16_t* yr[4]; float gt[4];
#pragma unroll
        for (int k = 0; k < 4; ++k) { yr[k] = YR + (size_t)((const int*)(ws + W_TOPI))[t * 4 + k] * D; gt[k] = ws[W_TOPG + t * 4 + k]; }
        float* x = ws + W_X + (size_t)t * D; float4 xr[4];
#pragma unroll
        for (int j = 0; j < 4; ++j) {
            const int c = j * 256 + lane * 4;
            float a0 = 0.f, a1 = 0.f, a2 = 0.f, a3 = 0.f;
#pragma unroll
            for (int k = 0; k < 4; ++k) { const u32x2 y = *(const u32x2*)(yr[k] + c);
                a0 = fmaf(gt[k], __uint_as_float(y.x << 16), a0); a1 = fmaf(gt[k], __uint_as_float(y.x & 0xffff0000u), a1);
                a2 = fmaf(gt[k], __uint_as_float(y.y << 16), a2); a3 = fmaf(gt[k], __uint_as_float(y.y & 0xffff0000u), a3); }
            float4 xv = *(const float4*)(x + c); const float4 gg = *(const float4*)(g2 + c);
            xv.x = fmaf(gg.x, a0, xv.x); xv.y = fmaf(gg.y, a1, xv.y); xv.z = fmaf(gg.z, a2, xv.z); xv.w = fmaf(gg.w, a3, xv.w);
            *(float4*)(x + c) = xv; xr[j] = xv;
            if (last) *(float4*)(pout + (size_t)t * D + c) = xv;
        }
        if (!last) norm1_store(p, l + 1, t, lane, xr);
    }
}

constexpr int XST_OFF = R_LDS + 2048 - 16, STAMP_OFF = R_LDS + 2048 - 16 - 256;
constexpr int LDS_BYTES = TAB_OFF + 512;

#define XB_TMO      128
#define XB_XCNT(j)  (256  + 64 * (j))
#define XB_XSUB(j)  (1280 + 64 * (j))
#define XB_XGEN(j)  (2304 + 64 * (j))
#define XB_TOP      3328
#define XB_TOPGEN   3392
#define XCD_BAR_WORDS 3456
#define XB_SPIN_CAP (1u << 18)
#define LAS __attribute__((address_space(3)))
__device__ __forceinline__ unsigned xb_ld(unsigned* p)              { return __hip_atomic_load(p, __ATOMIC_RELAXED, __HIP_MEMORY_SCOPE_AGENT); }
__device__ __forceinline__ unsigned xb_add(unsigned* p, unsigned v) { return __hip_atomic_fetch_add(p, v, __ATOMIC_RELAXED, __HIP_MEMORY_SCOPE_AGENT); }
__device__ __forceinline__ unsigned xb_xcc_id() { return (unsigned)__builtin_amdgcn_s_getreg((3 << 11) | 20) & 0xFu; }
#define XB_SPIN(cond, bar) do { unsigned _sp = 0; while (cond) { __builtin_amdgcn_s_sleep(1); \
    if ((++_sp & 255u) == 0u) { if (xb_ld(&(bar)[XB_TMO])) break; if (_sp > XB_SPIN_CAP) { atomicAdd(&(bar)[XB_TMO], 1u); break; } } } } while (0)
struct XcdBarrier { unsigned* bar; unsigned x; volatile LAS unsigned* st; };
__device__ __forceinline__ XcdBarrier xcd_barrier_post(unsigned* bar, volatile LAS unsigned* st) {
    XcdBarrier b; b.bar = bar; b.x = xb_xcc_id(); b.st = st;
    if (threadIdx.x == 0) (void)xb_add(&bar[XB_XCNT(b.x)], 1u);
    return b;
}
__device__ __forceinline__ void xcd_barrier_complete(unsigned* bar, unsigned x, unsigned& nloc, unsigned& nx) {
    const unsigned G = gridDim.x * gridDim.y * gridDim.z;
    unsigned sum, cnt, mine, sp = 0u;
    for (;;) {
        sum = 0u; cnt = 0u; mine = 0u;
#pragma unroll
        for (unsigned j = 0; j < 16; ++j) { const unsigned c = xb_ld(&bar[XB_XCNT(j)]); sum += c; cnt += (c > 0u) ? 1u : 0u; mine = (j == x) ? c : mine; }
        if (sum == G) break;
        __builtin_amdgcn_s_sleep(1);
        if ((++sp & 255u) == 0u) { if (xb_ld(&bar[XB_TMO])) break; if (sp > XB_SPIN_CAP) { atomicAdd(&bar[XB_TMO], 1u); break; } }
    }
    nloc = mine > 0u ? mine : 1u; nx = cnt > 0u ? cnt : 1u;
}
__device__ __noinline__ void xcd_barrier(const XcdBarrier b) {
    asm volatile("s_waitcnt vmcnt(0)" ::: "memory");
    __syncthreads();
    if (threadIdx.x == 0) {
        unsigned* bar = b.bar;
        __builtin_amdgcn_s_waitcnt(0);
        unsigned nloc = b.st[0], nx = b.st[1];
        if (nloc == 0u) { xcd_barrier_complete(bar, b.x, nloc, nx); b.st[0] = nloc; b.st[1] = nx; }
        const unsigned old = xb_add(&bar[XB_XSUB(b.x)], 1u);
        const unsigned gen = old / nloc;
        if (old + 1u == (gen + 1u) * nloc) {
            __builtin_amdgcn_fence(__ATOMIC_RELEASE, "agent");
            asm volatile("s_waitcnt vmcnt(0)" ::: "memory");
            const unsigned og = xb_add(&bar[XB_TOP], 1u);
            const unsigned tg = og / nx;
            if (og + 1u == (tg + 1u) * nx) xb_add(&bar[XB_TOPGEN], 1u);
            else XB_SPIN(xb_ld(&bar[XB_TOPGEN]) == tg, bar);
            __builtin_amdgcn_fence(__ATOMIC_ACQUIRE, "agent");
            xb_add(&bar[XB_XGEN(b.x)], 1u);
            asm volatile("s_waitcnt vmcnt(0)" ::: "memory");
        } else {
            XB_SPIN(xb_ld(&bar[XB_XGEN(b.x)]) == gen, bar);
            __builtin_amdgcn_fence(__ATOMIC_ACQUIRE, "agent");
            asm volatile("s_waitcnt vmcnt(0)" ::: "memory");
        }
    }
    __syncthreads();
}

constexpr int PROBE_IDX = -1, PROBE_DIV = 10;
constexpr int REP_NORM = 1, REP_INPROJ = 1, REP_PREP1 = 1, REP_SMALL = 1, REP_ATTN = 1, REP_FIN = 1, REP_MOE1 = 1, REP_MOE2 = 1, REP_SYNC = 1, REP_CONV = 1;
__global__ void __launch_bounds__(NTHR) fwd_kernel(Params p) {
    cg::grid_group grid = cg::this_grid();
    char* lds = g_lds;
    float* smem = (float*)lds;
    if (threadIdx.x == 0) {
        unsigned long long* tab = (unsigned long long*)(lds + TAB_OFF);
#pragma unroll
        for (int i = 0; i < N_IN; ++i) tab[i] = (unsigned long long)p.in[i];
        tab[N_IN] = (unsigned long long)p.ws; tab[N_IN + 1] = (unsigned long long)p.out;
    }
    __syncthreads();
    volatile LAS unsigned* xst = (volatile LAS unsigned*)(lds + XST_OFF);
    if (threadIdx.x < 4) xst[threadIdx.x] = 0u;
    if (blockIdx.x == 0) for (int i = threadIdx.x; i < 4096; i += NTHR) ((unsigned*)(p.ws + W_BAR))[i] = 0u;
    for (int r = 0; r < REP_CONV; ++r) phase_convert(p);
    phase_tables(p);
    phase_mod(p, smem);
    grid.sync();
    XcdBarrier xbar = xcd_barrier_post((unsigned*)(p.ws + W_BAR), xst);
    unsigned long long* stamps = (unsigned long long*)(lds + STAMP_OFF); int nstamp = 0;
#define GSYNC() do { for (int r_ = 0; r_ < REP_SYNC; ++r_) xcd_barrier(xbar); if (PROBE_IDX >= 0) { if (blockIdx.x == 0 && threadIdx.x == 0) stamps[nstamp] = __builtin_amdgcn_s_memrealtime(); ++nstamp; } } while (0)
    phase_init(p);
    GSYNC();
    for (int lv = 0; lv < NLAYER; ++lv) {
        int l = lv; asm volatile("" : "+s"(l));
        for (int r = 0; r < REP_INPROJ; ++r) phase_inproj(p, l, lds);
        GSYNC();
        for (int r = 0; r < REP_PREP1; ++r) phase_prep1(p, l);
        GSYNC();
        for (int r = 0; r < REP_SMALL; ++r) phase_small(p, l, lds);
        GSYNC();
        phase_prep2(p, l);
        GSYNC();
        for (int r = 0; r < REP_ATTN; ++r) phase_attn(p, l, lds);
        for (int r = 0; r < REP_FIN; ++r) phase_lru_fin(p, lds);
        GSYNC();
        phase_outproj(p, l, lds);
        GSYNC();
        phase_router(p, l, lds);
        GSYNC();
        phase_scatter(p, l, lds);
        GSYNC();
        for (int r = 0; r < REP_MOE1; ++r) phase_moe1(p, l, lds);
        GSYNC();
        for (int r = 0; r < REP_MOE2; ++r) phase_moe2(p, l, lds);
        GSYNC();
        phase_combine(p, l, lds, l == NLAYER - 1);
        GSYNC();
    }
    if (PROBE_IDX >= 0 && blockIdx.x == 0 && threadIdx.x == 0) {
        const float us = (float)(stamps[PROBE_IDX + 1] - stamps[PROBE_IDX]) * 0.01f;
        ((float*)tab_ld(N_IN + 1))[0] += 2.f + us / (float)PROBE_DIV;
    }
}

extern "C" void kernel_launch(void* const* d_in, const int* in_sizes, int n_in, void* d_out, int out_size, void* d_ws, size_t ws_size, hipStream_t stream) {
    static int grid_blocks = 0;
    if (!grid_blocks) {
        int dev = 0, cus = 0, per_cu = 0;
        (void)hipGetDevice(&dev);
        (void)hipDeviceGetAttribute(&cus, hipDeviceAttributeMultiprocessorCount, dev);
        if (hipFuncSetAttribute((const void*)fwd_kernel, hipFuncAttributeMaxDynamicSharedMemorySize, LDS_BYTES) != hipSuccess) fprintf(stderr, "kernel_launch: hipFuncSetAttribute failed\n");
        if (hipOccupancyMaxActiveBlocksPerMultiprocessor(&per_cu, fwd_kernel, NTHR, LDS_BYTES) != hipSuccess || per_cu < 1) { fprintf(stderr, "kernel_launch: occupancy query says %d\n", per_cu); per_cu = 1; }
        if (per_cu > 1) per_cu = 1;
        grid_blocks = cus * per_cu;
        if (ws_size < W_END * sizeof(float)) fprintf(stderr, "kernel_launch: workspace too small: %zu < %zu\n", ws_size, W_END * sizeof(float));
        if (n_in != N_IN) fprintf(stderr, "kernel_launch: n_in %d != %d\n", n_in, (int)N_IN);
    }
    Params p{};
    for (int i = 0; i < N_IN; ++i) p.in[i] = (const float*)d_in[i];
    p.out = (float*)d_out;
    p.ws = (float*)d_ws;
    void* args[] = {&p};
    hipError_t e = hipLaunchCooperativeKernel((void*)fwd_kernel, dim3(grid_blocks), dim3(NTHR), args, LDS_BYTES, stream);
    if (e != hipSuccess) fprintf(stderr, "cooperative launch failed: %s (grid %d)\n", hipGetErrorString(e), grid_blocks);
}
```

```cpp
#include <hip/hip_runtime.h>
#include <hip/hip_cooperative_groups.h>
#include <cstdio>
#include <cstdint>
namespace cg = cooperative_groups;

#define DEVI __device__ __forceinline__
constexpr int NTHR = 512;
constexpr int D = 1024, NLAT = 16384, NCTX = 256, T = NLAT + NCTX, NLAYER = 2;
constexpr int INC = 1632;
constexpr int OFF_A = 0, OFF_Q = 256, OFF_KV = 448, OFF_KR = 576, OFF_C = 608, OFF_DX = 1120, OFF_DG = 1376;
constexpr int NCHUNK = T / 128;
constexpr int NEXP = 32, TOPK = 4;
constexpr int MAXROWS = T * TOPK + NEXP * 256;
constexpr float EPS = 1e-6f;

enum { I_X = 0, I_C, I_CTX, I_CCTX, I_WMOD, I_BMOD, I_NMIX, I_NFFN, I_WIN, I_WOUT, I_POOLW, I_POOLS, I_QAN, I_WUQ, I_KVAN, I_WUKV,
       I_QN, I_KN, I_SGG, I_SGB, I_SGWS, I_SGBS, I_CONVW, I_CONVB, I_WA, I_BA, I_WX, I_BX, I_LAM, I_RW, I_RB, I_WGU, I_BGU, I_WDN, I_BDN, N_IN };

constexpr size_t al(size_t x) { return (x + 63) / 64 * 64; }
constexpr size_t W_X = 0;
constexpr size_t W_MOD = W_X + al((size_t)T * D);
constexpr size_t W_P = W_MOD + al(2 * 2 * 6144);
constexpr size_t W_YC = W_P + al((size_t)T * INC);
constexpr size_t W_Q = W_YC + al((size_t)T * D);
constexpr size_t W_K = W_Q + al((size_t)T * 384);
constexpr size_t W_V = W_K + al((size_t)T * 384);
constexpr size_t W_DIFF = W_V + al((size_t)T * 256);
constexpr size_t W_QN = W_DIFF + al((size_t)T * 256);
constexpr size_t W_KVN = W_QN + al((size_t)T * 192);
constexpr size_t W_U = W_KVN + al((size_t)T * 128);
constexpr size_t W_VN = W_U + al((size_t)T * 256);
constexpr size_t W_XC = W_VN + al((size_t)T * 256);
constexpr size_t W_QUP = W_XC + al((size_t)T * 256);
constexpr size_t W_KVUP = W_QUP + al((size_t)T * 384);
constexpr size_t W_LA = W_KVUP + al((size_t)T * 512);
constexpr size_t W_LB = W_LA + al((size_t)2 * T * 256);
constexpr size_t W_AGG = W_LB + al((size_t)2 * T * 256);
constexpr size_t W_CARRY = W_AGG + al((size_t)NCHUNK * 2 * 2 * 256);
constexpr size_t W_TOPE = W_CARRY + al((size_t)NCHUNK * 2 * 256);
constexpr size_t W_TOPG = W_TOPE + al((size_t)T * 4);
constexpr size_t W_TOPI = W_TOPG + al((size_t)T * 4);
constexpr size_t W_CNT = W_TOPI + al((size_t)T * 4);
constexpr size_t W_ACT = W_CNT + al(NLAYER * NEXP * 64);
constexpr size_t W_YR = W_ACT + al((size_t)MAXROWS * D / 2);
constexpr size_t W_XS = W_YR + al((size_t)MAXROWS * D / 2);
constexpr size_t W_HB = W_XS + al((size_t)MAXROWS * D / 2);
constexpr size_t W_XCB = W_HB + al((size_t)T * D / 2);
constexpr size_t W_WSB = W_XCB + al((size_t)T * 256 / 2);
constexpr size_t W_BAR = W_WSB + al((size_t)NLAYER * 4 * 128 * 128 / 2);
constexpr size_t W_ROPE = W_BAR + al(4096);
constexpr size_t W_LA2 = W_ROPE + al((size_t)NLAT * 32);
constexpr size_t W_LB2 = W_LA2 + al((size_t)2 * T * 256);
constexpr size_t W_SP = W_LB2 + al((size_t)2 * T * 256);
constexpr int NPAD_IN = 1792;
constexpr size_t W_WIN = W_SP + al(NLAYER * 2 * 256);
constexpr size_t W_WOUT = W_WIN + al((size_t)NLAYER * NPAD_IN * D / 2);
constexpr size_t W_WGU = W_WOUT + al((size_t)NLAYER * D * D / 2);
constexpr size_t W_WDN = W_WGU + al((size_t)NLAYER * NEXP * 2048 * D / 2);
constexpr size_t W_END = W_WDN + al((size_t)NLAYER * NEXP * D * D / 2);

struct Params {
    const float* in[N_IN];
    float* out;
    float* ws;
};

DEVI int tid_() { int t = threadIdx.x; asm volatile("" : "+v"(t)); return t; }
DEVI float* ws_(float* w) { unsigned long long v = (unsigned long long)w; asm volatile("" : "+s"(v)); return (float*)v; }
extern __shared__ __attribute__((aligned(16))) char g_lds[];
constexpr int RSC_OFF = 149504 + 512;
constexpr int TAB_OFF = 149504;
DEVI unsigned long long tab_ld(int i) { const unsigned long long v = ((const volatile unsigned long long*)(g_lds + TAB_OFF))[i];
    return ((unsigned long long)(unsigned)__builtin_amdgcn_readfirstlane((int)(v >> 32)) << 32) | (unsigned)__builtin_amdgcn_readfirstlane((int)v); }
#define PIN(i) ((const float*)tab_ld(i))
DEVI int bid_() { int b = blockIdx.x; asm volatile("" : "+s"(b)); return b; }
DEVI float wave_sum(float v) {
#pragma unroll
    for (int o = 32; o > 0; o >>= 1) v += __shfl_xor(v, o);
    return v;
}
DEVI float fexp(float x) { return __builtin_amdgcn_exp2f(x * 1.4426950408889634f); }
DEVI float gelu_tanh(float x) { const float u = 1.5957691216057308f * (x + 0.044715f * x * x * x); return x * __builtin_amdgcn_rcpf(1.f + fexp(-u)); }
DEVI float sigm(float x) { return 1.f / (1.f + expf(-x)); }
DEVI float silu(float x) { return x * sigm(x); }
DEVI float fsigm(float x) { return __builtin_amdgcn_rcpf(1.f + fexp(-x)); }


typedef unsigned short bf16_t;
typedef short bf16x8 __attribute__((ext_vector_type(8)));
typedef float f32x4 __attribute__((ext_vector_type(4)));
typedef unsigned u32x4 __attribute__((ext_vector_type(4)));
typedef unsigned u32x2 __attribute__((ext_vector_type(2)));
DEVI unsigned cvt_pk_bf16(float lo, float hi) { unsigned r; asm volatile("v_cvt_pk_bf16_f32 %0, %1, %2" : "=v"(r) : "v"(lo), "v"(hi)); return r; }
DEVI bf16_t f2bf(float f) { return (bf16_t)(cvt_pk_bf16(f, 0.f) & 0xffffu); }
DEVI float bf2f(bf16_t b) { return __uint_as_float(((unsigned)b) << 16); }

constexpr int G_STAGE = 49152;
constexpr int G_LDS = 2 * G_STAGE;
DEVI int swz(int row, int chunk) { return row * 128 + ((chunk ^ ((row >> 1) & 7)) << 4); }

template <bool PAIRED, class ARow, class Epi>
DEVI void gemm_unit(char* lds, int K, ARow arow, const float* __restrict__ B0, const float* __restrict__ B1, int ldb, int ncol_valid, Epi epi) {
    const int tid = tid_(), wave = tid >> 6, lane = tid & 63, fr = lane & 15, fq = lane >> 4, wr = wave >> 1, wc = wave & 1;
    const int ac = tid & 7;
    const bf16_t* ap[4]; int a_lds[4];
#pragma unroll
    for (int i = 0; i < 4; ++i) { const int r = (tid >> 3) + 64 * i; ap[i] = arow(r) + ac * 8; a_lds[i] = swz(r, ac); }
    const int kq = lane & 15, nq = (lane >> 4) + 4 * wave;
    const float* bp;
    if (PAIRED) { const int seg = (nq >> 2) & 1, idx = (nq >> 3) * 16 + (nq & 3) * 4; bp = (seg ? B1 : B0) + idx; }
    else { const int c4 = 4 * nq < ncol_valid ? 4 * nq : ncol_valid - 4; bp = B0 + c4; }
    bp += (size_t)(4 * kq) * ldb;
    int b_lds[4];
#pragma unroll
    for (int i = 0; i < 4; ++i) b_lds[i] = 32768 + swz(4 * nq + i, kq >> 1) + (kq & 1) * 8;
    const int sx = (fr >> 1) & 7;
    const int aoff0 = (wr * 64 + fr) * 128 + ((fq ^ sx) << 4), aoff1 = (wr * 64 + fr) * 128 + (((4 + fq) ^ sx) << 4);
    const int boff0 = 32768 + (wc * 64 + fr) * 128 + ((fq ^ sx) << 4), boff1 = 32768 + (wc * 64 + fr) * 128 + (((4 + fq) ^ sx) << 4);
    u32x4 av0[4], av1[4]; f32x4 bv0[4], bv1[4];
#define G_LOAD(av, bv, t) do { _Pragma("unroll") for (int i = 0; i < 4; ++i) av[i] = *(const u32x4*)(ap[i] + (t) * 64); \
        _Pragma("unroll") for (int kk = 0; kk < 4; ++kk) bv[kk] = *(const f32x4*)(bp + ((size_t)(t) * 64 + kk) * ldb); } while (0)
#define G_WRITE(s_, av, bv) do { _Pragma("unroll") for (int i = 0; i < 4; ++i) *(u32x4*)((s_) + a_lds[i]) = av[i]; \
        _Pragma("unroll") for (int i = 0; i < 4; ++i) { u32x2 w_; w_.x = cvt_pk_bf16(bv[0][i], bv[1][i]); w_.y = cvt_pk_bf16(bv[2][i], bv[3][i]); *(u32x2*)((s_) + b_lds[i]) = w_; } } while (0)
#define G_MMA(Af, Bf) do { __builtin_amdgcn_s_setprio(1); _Pragma("unroll") for (int m = 0; m < 4; ++m) _Pragma("unroll") for (int n = 0; n < 4; ++n) \
        acc[m][n] = __builtin_amdgcn_mfma_f32_16x16x32_bf16(Bf[n], Af[m], acc[m][n], 0, 0, 0); __builtin_amdgcn_s_setprio(0); } while (0)
#define G_SB() __builtin_amdgcn_sched_barrier(0)
#define G_ITER(t, c_, n_, av, bv, W_, L_) do { \
        bf16x8 Af[4], Bf[4]; \
        _Pragma("unroll") for (int m = 0; m < 4; ++m) Af[m] = *(const bf16x8*)((c_) + aoff0 + m * 2048); \
        _Pragma("unroll") for (int n = 0; n < 4; ++n) Bf[n] = *(const bf16x8*)((c_) + boff0 + n * 2048); \
        G_SB(); asm volatile("s_waitcnt lgkmcnt(0)" ::: "memory"); G_SB(); \
        G_MMA(Af, Bf); G_SB(); \
        _Pragma("unroll") for (int m = 0; m < 4; ++m) Af[m] = *(const bf16x8*)((c_) + aoff1 + m * 2048); \
        _Pragma("unroll") for (int n = 0; n < 4; ++n) Bf[n] = *(const bf16x8*)((c_) + boff1 + n * 2048); \
        G_SB(); \
        if (W_) { G_WRITE(n_, av, bv); G_SB(); asm volatile("s_waitcnt lgkmcnt(8)" ::: "memory"); } else { asm volatile("s_waitcnt lgkmcnt(0)" ::: "memory"); } \
        G_SB(); \
        G_MMA(Af, Bf); G_SB(); \
        if (L_) G_LOAD(av, bv, (t) + 3); \
        G_SB(); asm volatile("s_waitcnt lgkmcnt(0)" ::: "memory"); __builtin_amdgcn_s_barrier(); G_SB(); } while (0)
    f32x4 acc[4][4];
#pragma unroll
    for (int m = 0; m < 4; ++m)
#pragma unroll
        for (int n = 0; n < 4; ++n) acc[m][n] = (f32x4){0.f, 0.f, 0.f, 0.f};
    const int nk = K >> 6;
    char* L0 = lds; char* L1 = lds + G_STAGE;
    G_LOAD(av0, bv0, 0);
    G_WRITE(L0, av0, bv0);
    if (nk > 1) G_LOAD(av1, bv1, 1);
    if (nk > 2) G_LOAD(av0, bv0, 2);
    asm volatile("s_waitcnt lgkmcnt(0)" ::: "memory"); __builtin_amdgcn_s_barrier(); G_SB();
    int t = 0;
    for (; t + 4 < nk; t += 2) {
        G_ITER(t, L0, L1, av1, bv1, true, true);
        G_ITER(t + 1, L1, L0, av0, bv0, true, true);
    }
    for (; t < nk; t += 2) {
        G_ITER(t, L0, L1, av1, bv1, t + 1 < nk, t + 3 < nk);
        if (t + 1 < nk) G_ITER(t + 1, L1, L0, av0, bv0, t + 2 < nk, t + 4 < nk);
    }
#undef G_LOAD
#undef G_WRITE
#undef G_MMA
#undef G_ITER
#undef G_SB
    epi(acc, wr, wc, fr, fq);
}


#define PG8_LAS __attribute__((address_space(3)))
namespace pg8 {
constexpr int BM = 256, BK = 64, HALF = 128, HTB = HALF * BK * 2, STAGE_BYTES = 8 * HTB;
DEVI int lds_byte(int r, int c) { const int st = (r >> 4) * 2 + (c >> 5), rr = r & 15, cc = c & 31, ob = rr * 64 + cc * 2; return st * 1024 + (ob ^ (((ob >> 9) & 1) << 5)); }
DEVI void stage_rc(int b, int& R, int& C) { const int st = b / 1024, sb = b % 1024, swz_ = sb ^ (((sb >> 9) & 1) << 5); R = (st >> 1) * 16 + swz_ / 64; C = (st & 1) * 32 + (swz_ % 64) / 2; }
DEVI int perm32(int rho) { const int n = rho >> 4, i = rho & 15; return 8 * (i >> 2) + 4 * n + (i & 3); }
struct Unit { const char* a; const char* b; int x0, x1, x2; };
template <class Epi, class Sched>
DEVI void gemm_phase(PG8_LAS unsigned char* lds, int K, size_t hstepB, const Sched& S, const Epi& E) {
    const int tid = tid_(), wid = __builtin_amdgcn_readfirstlane(tid >> 6), lane = tid & 63, wr = wid >> 2, wc = wid & 3, fr = lane & 15, fq = lane >> 4;
    const int nt = K / BK;
    unsigned voffA[2], voffB[2];
#pragma unroll
    for (int i = 0; i < 2; ++i) { int R, C; stage_rc(tid * 16 + i * 8192, R, C); const int Rb = Epi::PERM ? ((R & ~31) + perm32(R & 31)) : R;
        voffA[i] = (unsigned)(R * K + C) * 2u; voffB[i] = (unsigned)(Rb * K + C) * 2u; }
    const size_t kstep = (size_t)(BK * 2);
    const size_t hstep = (size_t)HALF * K * 2;
    const unsigned ldsw = (unsigned)wid * 1024u;
    const int aoff = lds_byte(wr * 64 + fr, fq * 8), boff = lds_byte(wc * 32 + fr, fq * 8);
#define PG8_SA(b, h) (((b) * 2 + (h)) * HTB)
#define PG8_SB(b, h) ((4 + (b) * 2 + (h)) * HTB)
#define PG8_STAGE(bufoff, gbase, voff) do { _Pragma("unroll") for (int _i = 0; _i < 2; ++_i) \
        __builtin_amdgcn_global_load_lds((const unsigned*)((const char*)(gbase) + (voff)[_i]), (PG8_LAS unsigned*)(lds + (bufoff) + ldsw + _i * 8192), 16, 0, 0); } while (0)
#define PG8_LDA(dst, b, h) do { _Pragma("unroll") for (int m = 0; m < 4; ++m) _Pragma("unroll") for (int k = 0; k < 2; ++k) dst[m][k] = *(const PG8_LAS bf16x8*)(lds + PG8_SA(b, h) + aoff + m * 2048 + k * 1024); } while (0)
#define PG8_LDB(dst, b, h) do { _Pragma("unroll") for (int n = 0; n < 2; ++n) _Pragma("unroll") for (int k = 0; k < 2; ++k) dst[n][k] = *(const PG8_LAS bf16x8*)(lds + PG8_SB(b, h) + boff + n * 2048 + k * 1024); } while (0)
#define PG8_MMA(ai, bj, At, Bt) do { __builtin_amdgcn_s_setprio(1); _Pragma("unroll") for (int m = 0; m < 4; ++m) _Pragma("unroll") for (int n = 0; n < 2; ++n) _Pragma("unroll") for (int k = 0; k < 2; ++k) \
        acc[ai][bj][m][n] = __builtin_amdgcn_mfma_f32_16x16x32_bf16(Bt[n][k], At[m][k], acc[ai][bj][m][n], 0, 0, 0); __builtin_amdgcn_s_setprio(0); } while (0)
#define PG8_WAIT_V(n) asm volatile("s_waitcnt vmcnt(" #n ")" ::: "memory")
#define PG8_WAIT_L(n) asm volatile("s_waitcnt lgkmcnt(" #n ")" ::: "memory")
#define PG8_BAR __builtin_amdgcn_s_barrier()
#define PG8_SCHED __builtin_amdgcn_sched_barrier(0)
    Unit cur, nxt; int ui = 0;
    if (!S.next(0, cur)) return;
    f32x4 acc[2][2][4][2];
#pragma unroll
    for (int a = 0; a < 2; ++a)
#pragma unroll
        for (int b = 0; b < 2; ++b)
#pragma unroll
            for (int m = 0; m < 4; ++m)
#pragma unroll
                for (int n = 0; n < 2; ++n) acc[a][b][m][n] = (f32x4){0.f, 0.f, 0.f, 0.f};
    bf16x8 At[4][2], B0[2][2], B1[2][2];
    const char* cA = cur.a; const char* cB = cur.b;
    PG8_STAGE(PG8_SB(0, 0), cB, voffB); PG8_STAGE(PG8_SA(0, 0), cA, voffA); PG8_STAGE(PG8_SB(0, 1), cB + hstepB, voffB); PG8_STAGE(PG8_SA(0, 1), cA + hstep, voffA);
    if (wr == 1) PG8_BAR;
    PG8_WAIT_V(4); PG8_BAR;
    PG8_STAGE(PG8_SB(1, 0), cB + kstep, voffB); PG8_STAGE(PG8_SA(1, 0), cA + kstep, voffA); PG8_STAGE(PG8_SB(1, 1), cB + hstepB + kstep, voffB);
    PG8_WAIT_V(6); PG8_BAR;
    for (;;) {
        const bool has_next = S.next(ui + 1, nxt);
        const char* nA = has_next ? nxt.a : cA; const char* nB = has_next ? nxt.b : cB;
        for (int t = 0; t < nt; t += 2) {
            const bool last = (t == nt - 2);
            const char* a1 = cA + (size_t)(t + 1) * kstep;
            const char* a2 = last ? nA : cA + (size_t)(t + 2) * kstep; const char* b2 = last ? nB : cB + (size_t)(t + 2) * kstep;
            const char* a3 = a2 + kstep; const char* b3 = b2 + kstep;
            PG8_LDB(B0, 0, 0); PG8_SCHED; PG8_LDA(At, 0, 0); PG8_STAGE(PG8_SA(1, 1), a1 + hstep, voffA);
            PG8_WAIT_L(8); PG8_BAR; PG8_WAIT_L(0); PG8_MMA(0, 0, At, B0); PG8_BAR; PG8_SCHED;
            PG8_LDB(B1, 0, 1); PG8_STAGE(PG8_SB(0, 0), b2, voffB);
            PG8_BAR; PG8_WAIT_L(0); PG8_MMA(0, 1, At, B1); PG8_BAR;
            PG8_LDA(At, 0, 1); PG8_STAGE(PG8_SA(0, 0), a2, voffA);
            PG8_BAR; PG8_WAIT_L(0); PG8_MMA(1, 0, At, B0); PG8_BAR; PG8_SCHED;
            PG8_STAGE(PG8_SB(0, 1), b2 + hstepB, voffB);
            PG8_WAIT_V(6); PG8_BAR; PG8_MMA(1, 1, At, B1); PG8_BAR;
            PG8_LDB(B0, 1, 0); PG8_SCHED; PG8_LDA(At, 1, 0); PG8_STAGE(PG8_SA(0, 1), a2 + hstep, voffA);
            PG8_WAIT_L(8); PG8_BAR; PG8_WAIT_L(0); PG8_MMA(0, 0, At, B0); PG8_BAR; PG8_SCHED;
            PG8_LDB(B1, 1, 1); PG8_STAGE(PG8_SB(1, 0), b3, voffB);
            PG8_BAR; PG8_WAIT_L(0); PG8_MMA(0, 1, At, B1); PG8_BAR;
            PG8_LDA(At, 1, 1); PG8_STAGE(PG8_SA(1, 0), a3, voffA);
            PG8_BAR; PG8_WAIT_L(0); PG8_MMA(1, 0, At, B0); PG8_BAR; PG8_SCHED;
            PG8_STAGE(PG8_SB(1, 1), b3 + hstepB, voffB);
            PG8_WAIT_V(6); PG8_BAR; PG8_MMA(1, 1, At, B1); PG8_BAR;
        }
        E(acc, cur, wr, wc, fr, fq);
        if (!has_next) break;
#pragma unroll
        for (int a = 0; a < 2; ++a)
#pragma unroll
            for (int b = 0; b < 2; ++b)
#pragma unroll
                for (int m = 0; m < 4; ++m)
#pragma unroll
                    for (int n = 0; n < 2; ++n) acc[a][b][m][n] = (f32x4){0.f, 0.f, 0.f, 0.f};
        cur = nxt; cA = nA; cB = nB; ++ui;
    }
    PG8_WAIT_V(0);
    if (wr == 0) PG8_BAR;
    PG8_BAR;
#undef PG8_SA
#undef PG8_SB
#undef PG8_STAGE
#undef PG8_LDA
#undef PG8_LDB
#undef PG8_MMA
#undef PG8_WAIT_V
#undef PG8_WAIT_L
#undef PG8_BAR
#undef PG8_SCHED
}
}

DEVI void conv_item(const float* __restrict__ W, int K, int N, bf16_t* __restrict__ Wt, int kb, int nb, int lane) {
    const int ko = lane & 7, nq = lane >> 3;
    const float* src = W + (size_t)(kb * 64 + ko * 8) * N + nb * 32 + nq * 4;
    f32x4 v[8];
#pragma unroll
    for (int kk = 0; kk < 8; ++kk) v[kk] = *(const f32x4*)(src + (size_t)kk * N);
    bf16_t* dst = Wt + (size_t)(nb * 32 + nq * 4) * K + kb * 64 + ko * 8;
#pragma unroll
    for (int i = 0; i < 4; ++i) { u32x4 o; o.x = cvt_pk_bf16(v[0][i], v[1][i]); o.y = cvt_pk_bf16(v[2][i], v[3][i]); o.z = cvt_pk_bf16(v[4][i], v[5][i]); o.w = cvt_pk_bf16(v[6][i], v[7][i]);
        *(u32x4*)(dst + (size_t)i * K) = o; }
}

namespace att {
typedef short s16x4 __attribute__((ext_vector_type(4)));
typedef float f32x16 __attribute__((ext_vector_type(16)));
constexpr int KVBLK = 64;
constexpr float SCALE = 0.10206207261596577f;
constexpr float THR = 8.f;
constexpr int SHM_V = 16384, SHM_K = 16384, SHM_ATTN = 2 * SHM_V + 2 * SHM_K + 8 * 64 * 4;
#define KSWZ(row, colB) ((row) * 256 + ((colB) ^ (((row) & 7) << 4)))
#define SBAR() __builtin_amdgcn_sched_barrier(0)
DEVI int crow(int r, int hi) { return (r & 3) + 8 * (r >> 2) + 4 * hi; }
DEVI void partialSM(f32x16& p0, f32x16& p1, float& m_reg, float& mn, float& alpha) {
    constexpr float C = SCALE * 1.4426950408889634f;
    float pmax = p0[0];
#pragma unroll
    for (int r = 1; r < 16; ++r) pmax = fmaxf(pmax, p0[r]);
#pragma unroll
    for (int r = 0; r < 16; ++r) pmax = fmaxf(pmax, p1[r]);
    { auto rr = __builtin_amdgcn_permlane32_swap(__float_as_uint(pmax), __float_as_uint(pmax), false, false);
      pmax = fmaxf(__uint_as_float(rr[0]), __uint_as_float(rr[1])); }
    if (__builtin_expect(__all(pmax - m_reg <= THR / SCALE), 1)) { mn = m_reg; alpha = 1.f; }
    else { mn = fmaxf(m_reg, pmax); alpha = __builtin_amdgcn_exp2f((m_reg - mn) * C); m_reg = mn; }
    const float mnC = -mn * C;
#pragma unroll
    for (int r = 0; r < 16; ++r) p0[r] = fmaf(p0[r], C, mnC);
#pragma unroll
    for (int r = 0; r < 16; ++r) p1[r] = fmaf(p1[r], C, mnC);
#pragma unroll
    for (int r = 0; r < 16; ++r) p0[r] = __builtin_amdgcn_exp2f(p0[r]);
}
DEVI void finishSM(f32x16& p0, f32x16& p1, float alpha, float& l_reg, bf16x8& pa0, bf16x8& pa1, bf16x8& pa2, bf16x8& pa3) {
#pragma unroll
    for (int r = 0; r < 16; ++r) p1[r] = __builtin_amdgcn_exp2f(p1[r]);
    float ps = 0.f;
#pragma unroll
    for (int r = 0; r < 16; ++r) ps += p0[r];
#pragma unroll
    for (int r = 0; r < 16; ++r) ps += p1[r];
    { auto rr = __builtin_amdgcn_permlane32_swap(__float_as_uint(ps), __float_as_uint(ps), false, false);
      ps = __uint_as_float(rr[0]) + __uint_as_float(rr[1]); }
    l_reg = l_reg * alpha + ps;
#define PK4(P, BASE, OUT) do { unsigned a0 = cvt_pk_bf16(P[BASE + 0], P[BASE + 1]), a1 = cvt_pk_bf16(P[BASE + 2], P[BASE + 3]);   \
    unsigned b0 = cvt_pk_bf16(P[BASE + 4], P[BASE + 5]), b1 = cvt_pk_bf16(P[BASE + 6], P[BASE + 7]);                              \
    auto r0 = __builtin_amdgcn_permlane32_swap(a0, b0, false, false); auto r1 = __builtin_amdgcn_permlane32_swap(a1, b1, false, false); \
    u32x4 w = {r0[0], r1[0], r0[1], r1[1]}; OUT = *reinterpret_cast<bf16x8*>(&w); } while (0)
    PK4(p0, 0, pa0); PK4(p0, 8, pa1); PK4(p1, 0, pa2); PK4(p1, 8, pa3);
#undef PK4
}
DEVI void qkt(f32x16& p0, f32x16& p1, const char* Ks, const bf16x8* qr, int r32, int hi) {
    p0 = f32x16{}; p1 = f32x16{};
#pragma unroll
    for (int d0 = 0; d0 < 6; ++d0) { const int cb = (d0 * 16 + hi * 8) * 2;
        const bf16x8 b0 = *reinterpret_cast<const bf16x8*>(Ks + KSWZ(r32, cb));
        const bf16x8 b1 = *reinterpret_cast<const bf16x8*>(Ks + KSWZ(32 + r32, cb));
        p0 = __builtin_amdgcn_mfma_f32_32x32x16_bf16(b0, qr[d0], p0, 0, 0, 0);
        p1 = __builtin_amdgcn_mfma_f32_32x32x16_bf16(b1, qr[d0], p1, 0, 0, 0); }
}
DEVI int v_st(int k, int c) { const int kk = (k & ~0xC) | ((k & 4) << 1) | ((k & 8) >> 1); return ((kk >> 3) * 4 + (c >> 5)) * 512 + ((kk & 7) * 32 + (c & 31)) * 2; }
DEVI int v_rd_base(int lane) { return ((lane & 3) << 3) | (((lane >> 2) & 3) << 6) | (((lane >> 4) & 1) << 5) | (((lane >> 5) & 1) << 8); }
constexpr int v_rd_off(int d0, int ks, int half) { return d0 * 512 + ks * 4096 + half * 2048; }
template <int OFF> DEVI s16x4 tr_read(int vb) {
    s16x4 r; asm volatile("ds_read_b64_tr_b16 %0, %1 offset:%2" : "=&v"(r) : "v"(vb), "i"(OFF) : "memory"); return r;
}
template <int D0> DEVI void pv_one(f32x16& od, int vb, bf16x8 pa0, bf16x8 pa1, bf16x8 pa2, bf16x8 pa3) {
    const s16x4 l0 = tr_read<v_rd_off(D0, 0, 0)>(vb), h0 = tr_read<v_rd_off(D0, 0, 1)>(vb), l1 = tr_read<v_rd_off(D0, 1, 0)>(vb), h1 = tr_read<v_rd_off(D0, 1, 1)>(vb);
    const s16x4 l2 = tr_read<v_rd_off(D0, 2, 0)>(vb), h2 = tr_read<v_rd_off(D0, 2, 1)>(vb), l3 = tr_read<v_rd_off(D0, 3, 0)>(vb), h3 = tr_read<v_rd_off(D0, 3, 1)>(vb);
    asm volatile("s_waitcnt lgkmcnt(0)" ::: "memory"); SBAR();
#define PKV(L, H) (bf16x8){L[0], L[1], L[2], L[3], H[0], H[1], H[2], H[3]}
    od = __builtin_amdgcn_mfma_f32_32x32x16_bf16(pa0, PKV(l0, h0), od, 0, 0, 0);
    od = __builtin_amdgcn_mfma_f32_32x32x16_bf16(pa1, PKV(l1, h1), od, 0, 0, 0);
    od = __builtin_amdgcn_mfma_f32_32x32x16_bf16(pa2, PKV(l2, h2), od, 0, 0, 0);
    od = __builtin_amdgcn_mfma_f32_32x32x16_bf16(pa3, PKV(l3, h3), od, 0, 0, 0);
#undef PKV
}
DEVI void pv_d0(f32x16* o, int vb, bf16x8 pa0, bf16x8 pa1, bf16x8 pa2, bf16x8 pa3) {
    pv_one<0>(o[0], vb, pa0, pa1, pa2, pa3); pv_one<1>(o[1], vb, pa0, pa1, pa2, pa3);
}
DEVI void attn_unit(const bf16_t* __restrict__ Qb, const bf16_t* __restrict__ Kh, const bf16_t* __restrict__ Vh, int seq, bf16_t* __restrict__ Ob, int ldo, char* lds) {
    const int tid = tid_(), wid = tid >> 6, lane = tid & 63, r32 = lane & 31, hi = lane >> 5;
    char* V_lds = lds; char* K_lds = lds + 2 * SHM_V;
    float* wsl = (float*)(lds + 2 * SHM_V + 2 * SHM_K) + wid * 64; float* li_l = wsl; float* al_l = wsl + 32;
    float m_reg = -1e30f, l_reg = 0.f; f32x16 o[2] = {}; bf16x8 qr[6];
    const bf16_t* Qw = Qb + (size_t)(wid * 32 + r32) * 96 + hi * 8;
#pragma unroll
    for (int d0 = 0; d0 < 6; ++d0) qr[d0] = *reinterpret_cast<const bf16x8*>(Qw + d0 * 16);
    const int sr = tid >> 4, kc = tid & 15, kcl = (kc < 12 ? kc : 11) * 8;
    const int vr = tid >> 3, vc = (tid & 7) * 8, vst0 = v_st(vr, vc);
    const int kst0 = KSWZ(sr, kc * 16), kst1 = KSWZ(32 + sr, kc * 16);
    const int vb0 = (int)(uintptr_t)V_lds + v_rd_base(lane);
    bf16x8 sv0, sk00, sk01, sv1, sk10, sk11;
#define SLOAD0(k0) do { sv0 = *reinterpret_cast<const bf16x8*>(Vh + (size_t)((k0) + vr) * 64 + vc); sk00 = *reinterpret_cast<const bf16x8*>(Kh + (size_t)((k0) + sr) * 96 + kcl); \
    sk01 = *reinterpret_cast<const bf16x8*>(Kh + (size_t)((k0) + 32 + sr) * 96 + kcl); } while (0)
#define SLOAD1(k0) do { sv1 = *reinterpret_cast<const bf16x8*>(Vh + (size_t)((k0) + vr) * 64 + vc); sk10 = *reinterpret_cast<const bf16x8*>(Kh + (size_t)((k0) + sr) * 96 + kcl); \
    sk11 = *reinterpret_cast<const bf16x8*>(Kh + (size_t)((k0) + 32 + sr) * 96 + kcl); } while (0)
#define SWRITE0(b) do { *(bf16x8*)(V_lds + (b) * SHM_V + vst0) = sv0; *(bf16x8*)(K_lds + (b) * SHM_K + kst0) = sk00; *(bf16x8*)(K_lds + (b) * SHM_K + kst1) = sk01; } while (0)
#define SWRITE1(b) do { *(bf16x8*)(V_lds + (b) * SHM_V + vst0) = sv1; *(bf16x8*)(K_lds + (b) * SHM_K + kst0) = sk10; *(bf16x8*)(K_lds + (b) * SHM_K + kst1) = sk11; } while (0)
#define SWAIT() asm volatile("s_waitcnt vmcnt(3)" ::: "memory")
#define RESC(a) do { if (__any((a) < 1.f)) { if (hi == 0) al_l[r32] = (a); asm volatile("s_waitcnt lgkmcnt(0)" ::: "memory"); \
    _Pragma("unroll") for (int d = 0; d < 2; ++d) _Pragma("unroll") for (int r = 0; r < 16; ++r) o[d][r] *= al_l[crow(r, hi)]; } } while (0)
    f32x16 pA0, pA1, pB0, pB1; float mnA, mnB, alA, alB; bf16x8 pa0, pa1, pa2, pa3; const int NT = seq / KVBLK;
    SLOAD0(0); asm volatile("s_waitcnt vmcnt(0)" ::: "memory"); SWRITE0(0); __syncthreads();
    qkt(pA0, pA1, K_lds, qr, r32, hi); partialSM(pA0, pA1, m_reg, mnA, alA);
    SLOAD1(KVBLK); if (2 < NT) SLOAD0(2 * KVBLK);
    SWAIT(); SWRITE1(1); __syncthreads();
    for (int j = 1; j + 1 < NT; j += 2) {
        SBAR(); qkt(pB0, pB1, K_lds + SHM_K, qr, r32, hi);
        finishSM(pA0, pA1, alA, l_reg, pa0, pa1, pa2, pa3); SBAR();
        SLOAD1((j + 2) * KVBLK); SBAR();
        pv_d0(o, vb0, pa0, pa1, pa2, pa3); partialSM(pB0, pB1, m_reg, mnB, alB);
        __syncthreads(); SWAIT(); SWRITE0(0);
        RESC(alB); __syncthreads();
        SBAR(); qkt(pA0, pA1, K_lds, qr, r32, hi);
        finishSM(pB0, pB1, alB, l_reg, pa0, pa1, pa2, pa3); SBAR();
        if (j + 3 < NT) SLOAD0((j + 3) * KVBLK); SBAR();
        pv_d0(o, vb0 + SHM_V, pa0, pa1, pa2, pa3); partialSM(pA0, pA1, m_reg, mnA, alA);
        __syncthreads(); SWAIT(); SWRITE1(1);
        RESC(alA); __syncthreads();
    }
    SBAR(); qkt(pB0, pB1, K_lds + SHM_K, qr, r32, hi);
    finishSM(pA0, pA1, alA, l_reg, pa0, pa1, pa2, pa3); SBAR();
    pv_d0(o, vb0, pa0, pa1, pa2, pa3); partialSM(pB0, pB1, m_reg, mnB, alB);
    __syncthreads(); RESC(alB);
    finishSM(pB0, pB1, alB, l_reg, pa0, pa1, pa2, pa3); SBAR();
    pv_d0(o, vb0 + SHM_V, pa0, pa1, pa2, pa3);
    if (hi == 0) li_l[r32] = l_reg; asm volatile("s_waitcnt lgkmcnt(0)" ::: "memory");
    float rli[16];
#pragma unroll
    for (int r = 0; r < 16; ++r) rli[r] = __builtin_amdgcn_rcpf(li_l[crow(r, hi)]);
    bf16_t* Ow = Ob + (size_t)(wid * 32) * ldo;
#pragma unroll
    for (int r = 0; r < 16; ++r) { const int orow = crow(r, hi);
#pragma unroll
        for (int d0 = 0; d0 < 2; ++d0) Ow[(size_t)orow * ldo + d0 * 32 + r32] = f2bf(o[d0][r] * rli[r]); }
    __syncthreads();
#undef SLOAD0
#undef SLOAD1
#undef SWRITE0
#undef SWRITE1
#undef SWAIT
#undef RESC
}
#undef KSWZ
#undef SBAR
}

template <class ARow, class BMap, class Epi>
DEVI void gemm_tile(int K, ARow arow, const float* __restrict__ B, int ldb, BMap bmap, Epi epi, float* smem) {
    float (*As)[132] = (float (*)[132])smem;
    float (*Bs)[64] = (float (*)[64])(smem + 16 * 132);
    const int tid = tid_(), ty = tid >> 4, tx = tid & 15;
    float acc[4][4];
#pragma unroll
    for (int i = 0; i < 4; ++i)
#pragma unroll
        for (int j = 0; j < 4; ++j) acc[i][j] = 0.f;
    const int ar = tid >> 2, akq = tid & 3;
    const float* ap = arow(ar);
    const int bk0 = tid >> 6, bc = tid & 63;
    const int bcol = bmap(bc);
    for (int k0 = 0; k0 < K; k0 += 16) {
        float4 av = make_float4(0.f, 0.f, 0.f, 0.f);
        if (ap) av = *(const float4*)(ap + k0 + akq * 4);
        float b0 = 0.f, b1 = 0.f;
        if (bcol >= 0) { b0 = B[(size_t)(k0 + bk0) * ldb + bcol]; b1 = B[(size_t)(k0 + bk0 + 8) * ldb + bcol]; }
        __syncthreads();
        As[akq * 4 + 0][ar] = av.x; As[akq * 4 + 1][ar] = av.y; As[akq * 4 + 2][ar] = av.z; As[akq * 4 + 3][ar] = av.w;
        Bs[bk0][bc] = b0; Bs[bk0 + 8][bc] = b1;
        __syncthreads();
#pragma unroll
        for (int kk = 0; kk < 16; ++kk) {
            const float4 a = *(const float4*)&As[kk][ty * 4];
            const float4 b = *(const float4*)&Bs[kk][tx * 4];
            const float aa[4] = {a.x, a.y, a.z, a.w}, bb[4] = {b.x, b.y, b.z, b.w};
#pragma unroll
            for (int i = 0; i < 4; ++i)
#pragma unroll
                for (int j = 0; j < 4; ++j) acc[i][j] = fmaf(aa[i], bb[j], acc[i][j]);
        }
    }
#pragma unroll
    for (int i = 0; i < 4; ++i) epi(ty * 4 + i, tx, acc[i]);
    __syncthreads();
}


struct UnitRange { int lo, hi, step; };
DEVI UnitRange unit_range(int nunits, int bid) {
    UnitRange r;
    if ((gridDim.x & 7) == 0) { const int x = bid & 7, j = bid >> 3; r.lo = (int)(((long)nunits * x) >> 3) + j; r.hi = (int)(((long)nunits * (x + 1)) >> 3); r.step = gridDim.x >> 3; }
    else { r.lo = bid; r.hi = nunits; r.step = gridDim.x; }
    return r;
}

__device__ void phase_convert(const Params& p) {
    float* const ws = (float*)tab_ld(N_IN);
    const float* const pin_I_WDN = PIN(I_WDN);
    const float* const pin_I_WGU = PIN(I_WGU);
    const float* const pin_I_WIN = PIN(I_WIN);
    const float* const pin_I_WOUT = PIN(I_WOUT);
    const int tid = tid_(), bid = bid_();
    const int lane = tid & 63, gw = bid * (NTHR / 64) + __builtin_amdgcn_readfirstlane(tid >> 6), nw = gridDim.x * (NTHR / 64);
    constexpr int NI_GU = NLAYER * NEXP * 16 * 64, NI_DN = NLAYER * NEXP * 16 * 32, NI_OUT = NLAYER * 16 * 32, NI_IN = NLAYER * 16 * 51;
    bf16_t* wgu = (bf16_t*)(ws + W_WGU); bf16_t* wdn = (bf16_t*)(ws + W_WDN); bf16_t* wout = (bf16_t*)(ws + W_WOUT); bf16_t* win = (bf16_t*)(ws + W_WIN);
    for (int it = gw; it < NI_GU + NI_DN + NI_OUT + NI_IN; it += nw) {
        int r = it;
        if (r < NI_GU) { const int mat = r >> 10, q = r & 1023; conv_item(pin_I_WGU + (size_t)mat * D * 2048, D, 2048, wgu + (size_t)mat * 2048 * D, q >> 6, q & 63, lane); continue; }
        r -= NI_GU;
        if (r < NI_DN) { const int mat = r >> 9, q = r & 511; conv_item(pin_I_WDN + (size_t)mat * D * D, D, D, wdn + (size_t)mat * D * D, q >> 5, q & 31, lane); continue; }
        r -= NI_DN;
        if (r < NI_OUT) { const int mat = r >> 9, q = r & 511; conv_item(pin_I_WOUT + (size_t)mat * D * D, D, D, wout + (size_t)mat * D * D, q >> 5, q & 31, lane); continue; }
        r -= NI_OUT;
        { const int mat = r / 816, q = r % 816; conv_item(pin_I_WIN + (size_t)mat * D * INC, D, INC, win + (size_t)mat * NPAD_IN * D, q / 51, q % 51, lane); }
    }
}

__device__ void phase_tables(const Params& p) {
    float* const ws = (float*)tab_ld(N_IN);
    const float* const pin_I_LAM = PIN(I_LAM);
    const float* const pin_I_SGWS = PIN(I_SGWS);
    const int tid = tid_(), bid = bid_(); (void)tid; (void)bid;
    for (int i = bid * NTHR + tid; i < NLAYER * 4 * 128 * 128; i += gridDim.x * NTHR) ((bf16_t*)(ws + W_WSB))[i] = f2bf(pin_I_SGWS[i]);
    for (int i = bid * NTHR + tid; i < NLAT * 16; i += gridDim.x * NTHR) {
        const int t = i >> 4, f = i & 15; const float pos = (f < 8) ? (float)(t >> 6) : (float)(t & 63);
        const float ang = pos * powf(10000.f, -(float)(f & 7) / 8.f);
        ws[W_ROPE + (size_t)t * 32 + f] = cosf(ang); ws[W_ROPE + (size_t)t * 32 + 16 + f] = sinf(ang);
    }
    if (bid == 1) for (int i = tid; i < NLAYER * 2 * 256; i += NTHR) ws[W_SP + i] = log1pf(expf(-pin_I_LAM[i]));
    if (bid == 0) for (int i = tid; i < NLAYER * NEXP * 64; i += NTHR) ((int*)(ws + W_CNT))[i] = 0;
}

DEVI void norm1_store(const Params& p, int l, int t, int lane, const float4 (&v)[4]) {
    const float* g = p.in[I_NMIX] + l * D;
    const float* mod = p.ws + W_MOD + (size_t)(l * 2 + (t >= NLAT ? 1 : 0)) * 6144;
    float ss = 0.f;
#pragma unroll
    for (int j = 0; j < 4; ++j) ss += v[j].x * v[j].x + v[j].y * v[j].y + v[j].z * v[j].z + v[j].w * v[j].w;
    const float rstd = rsqrtf(wave_sum(ss) * (1.f / D) + EPS);
    bf16_t* hb = (bf16_t*)(p.ws + W_HB) + (size_t)t * D;
#pragma unroll
    for (int j = 0; j < 4; ++j) {
        const int c = j * 256 + lane * 4;
        const float4 gg = *(const float4*)(g + c), s1 = *(const float4*)(mod + D + c), s0 = *(const float4*)(mod + c);
        u32x2 w; w.x = cvt_pk_bf16(v[j].x * rstd * gg.x * (1.f + s1.x) + s0.x, v[j].y * rstd * gg.y * (1.f + s1.y) + s0.y);
        w.y = cvt_pk_bf16(v[j].z * rstd * gg.z * (1.f + s1.z) + s0.z, v[j].w * rstd * gg.w * (1.f + s1.w) + s0.w);
        *(u32x2*)(hb + c) = w;
    }
}
__device__ void phase_init(const Params& p) {
    float* const ws = (float*)tab_ld(N_IN);
    const float* const pin_I_CTX = PIN(I_CTX);
    const float* const pin_I_X = PIN(I_X);
    const int tid = tid_(), bid = bid_();
    const int lane = tid & 63, gw = bid * (NTHR / 64) + __builtin_amdgcn_readfirstlane(tid >> 6), nw = gridDim.x * (NTHR / 64);
    for (int t = gw; t < T; t += nw) {
        const float* src = (t < NLAT) ? pin_I_X + (size_t)t * D : pin_I_CTX + (size_t)(t - NLAT) * D;
        float4 v[4];
#pragma unroll
        for (int j = 0; j < 4; ++j) { v[j] = *(const float4*)(src + j * 256 + lane * 4); *(float4*)(ws + W_X + (size_t)t * D + j * 256 + lane * 4) = v[j]; }
        norm1_store(p, 0, t, lane, v);
    }
}

__device__ void phase_mod(const Params& p, float* smem) {
    float* const ws = (float*)tab_ld(N_IN);
    const float* const pin_I_BMOD = PIN(I_BMOD);
    const float* const pin_I_C = PIN(I_C);
    const float* const pin_I_CCTX = PIN(I_CCTX);
    const float* const pin_I_WMOD = PIN(I_WMOD);
    const int tid = tid_(), bid = bid_(); (void)tid; (void)bid;
    const int wave = tid >> 6, lane = tid & 63;
    for (int it = bid; it < NLAYER * 96; it += gridDim.x) {
        const int l = it / 96, j = (it % 96) * 64 + lane;
        const float* W = pin_I_WMOD + (size_t)l * 1024 * 6144;
        float a0 = 0.f, a1 = 0.f;
        for (int k = wave * 128; k < wave * 128 + 128; ++k) {
            const float w = W[(size_t)k * 6144 + j];
            a0 = fmaf(silu(pin_I_C[k]), w, a0);
            a1 = fmaf(silu(pin_I_CCTX[k]), w, a1);
        }
        smem[(wave * 2 + 0) * 64 + lane] = a0; smem[(wave * 2 + 1) * 64 + lane] = a1;
        __syncthreads();
        if (wave < 2) {
            float s = 0.f;
            for (int w = 0; w < 8; ++w) s += smem[(w * 2 + wave) * 64 + lane];
            ws[W_MOD + (size_t)(l * 2 + wave) * 6144 + j] = s + pin_I_BMOD[l * 6144 + j];
        }
        __syncthreads();
    }
}


struct InprojSched {
    UnitRange ur; const char* A; const char* Bt;
    DEVI bool next(int i, pg8::Unit& u) const {
        const int id = ur.lo + i * ur.step; if (id >= ur.hi) return false;
        const int tm = id / 7, tn = id % 7;
        u.a = A + (size_t)tm * 256 * D * 2; u.b = Bt + (size_t)tn * 256 * D * 2; u.x0 = tm * 256; u.x1 = tn * 256; u.x2 = 0; return true;
    }
};
struct EpiInproj { static constexpr bool PERM = false; float* P;
    DEVI void operator()(const f32x4 (&acc)[2][2][4][2], const pg8::Unit& u, int wr, int wc, int fr, int fq) const {
#pragma unroll
        for (int ai = 0; ai < 2; ++ai)
#pragma unroll
            for (int m = 0; m < 4; ++m) { float* row = P + (size_t)(u.x0 + ai * 128 + wr * 64 + m * 16 + fr) * INC;
#pragma unroll
                for (int bj = 0; bj < 2; ++bj)
#pragma unroll
                    for (int n = 0; n < 2; ++n) { const int c = u.x1 + bj * 128 + wc * 32 + n * 16 + 4 * fq; if (c < INC) *(f32x4*)(row + c) = acc[ai][bj][m][n]; } }
    }
};
__device__ void phase_inproj(const Params& p, int l, char* lds) {
    float* const ws = (float*)tab_ld(N_IN);
    const int tid = tid_(), bid = bid_(); (void)tid;
    InprojSched S; S.ur = unit_range((T / 256) * 7, bid); S.A = (const char*)(ws + W_HB); S.Bt = (const char*)((const bf16_t*)(ws + W_WIN) + (size_t)l * NPAD_IN * D);
    EpiInproj E; E.P = ws + W_P;
    pg8::gemm_phase((PG8_LAS unsigned char*)lds, D, (size_t)128 * D * 2, S, E);
}

__device__ void phase_prep1(const Params& p, int l) {
    float* const ws = (float*)tab_ld(N_IN);
    const float* const pin_I_CONVB = PIN(I_CONVB);
    const float* const pin_I_CONVW = PIN(I_CONVW);
    const float* const pin_I_KVAN = PIN(I_KVAN);
    const float* const pin_I_QAN = PIN(I_QAN);
    const float* const pin_I_SGB = PIN(I_SGB);
    const float* const pin_I_SGG = PIN(I_SGG);
    const int tid = tid_(), bid = bid_(); (void)tid; (void)bid;
    const int lane = tid & 63, gw = bid * (NTHR / 64) + __builtin_amdgcn_readfirstlane(tid >> 6), nw = gridDim.x * (NTHR / 64);
    float qan[3], kvan[2];
#pragma unroll
    for (int j = 0; j < 3; ++j) qan[j] = pin_I_QAN[l * 192 + j * 64 + lane];
#pragma unroll
    for (int j = 0; j < 2; ++j) kvan[j] = pin_I_KVAN[l * 128 + j * 64 + lane];
    const f32x4 sgg = *(const f32x4*)(pin_I_SGG + l * 256 + lane * 4), sgb = *(const f32x4*)(pin_I_SGB + l * 256 + lane * 4);
    const f32x4 cb = *(const f32x4*)(pin_I_CONVB + l * 256 + lane * 4);
    f32x4 cw[4];
#pragma unroll
    for (int k = 0; k < 4; ++k) cw[k] = *(const f32x4*)(pin_I_CONVW + (size_t)l * 4 * 256 + k * 256 + lane * 4);
    const int g = lane >> 4, w = 2 << g;
    const float* P = ws + W_P;
    for (int t = gw; t < T; t += nw) {
        const int s0 = (t < NLAT) ? 0 : NLAT, sl = (t < NLAT) ? NLAT : NCTX, n = t - s0;
        const float* pr = P + (size_t)t * INC;
        const int lo = max(n - w / 2, 0), hi = min(n + w / 2, sl);
        f32x4 pw[16];
#pragma unroll
        for (int j = 0; j < 16; ++j) { const int m = min(lo + j, hi - 1); pw[j] = *(const f32x4*)(P + (size_t)(s0 + m) * INC + OFF_A + lane * 4); }
        const f32x4 xa = *(const f32x4*)(pr + OFF_A + lane * 4);
        float qv[3], kvv[2];
#pragma unroll
        for (int j = 0; j < 3; ++j) qv[j] = pr[OFF_Q + j * 64 + lane];
#pragma unroll
        for (int j = 0; j < 2; ++j) kvv[j] = pr[OFF_KV + j * 64 + lane];
        const f32x4 zu = *(const f32x4*)(pr + OFF_C + lane * 4), zv = *(const f32x4*)(pr + OFF_C + 256 + lane * 4);
        f32x4 xc[4];
#pragma unroll
        for (int k = 0; k < 4; ++k) { const int m = min(max(n - 1 + k, 0), sl - 1); xc[k] = *(const f32x4*)(P + (size_t)(s0 + m) * INC + OFF_DX + lane * 4); }
        {   f32x4 sacc = (f32x4){0.f, 0.f, 0.f, 0.f};
#pragma unroll
            for (int j = 0; j < 16; ++j) sacc = sacc + ((lo + j < hi) ? pw[j] : (f32x4){0.f, 0.f, 0.f, 0.f});
            const float inv = 1.f / (float)(hi - lo);
            const f32x4 d = sacc * inv - xa;
            u32x2 o; o.x = cvt_pk_bf16(d[0], d[1]); o.y = cvt_pk_bf16(d[2], d[3]); *(u32x2*)((bf16_t*)(ws + W_DIFF) + (size_t)t * 256 + lane * 4) = o; }
        {   const float rq = rsqrtf(wave_sum(qv[0] * qv[0] + qv[1] * qv[1] + qv[2] * qv[2]) * (1.f / 192.f) + EPS);
#pragma unroll
            for (int j = 0; j < 3; ++j) ((bf16_t*)(ws + W_QN))[(size_t)t * 192 + j * 64 + lane] = f2bf(qv[j] * rq * qan[j]);
            const float rk = rsqrtf(wave_sum(kvv[0] * kvv[0] + kvv[1] * kvv[1]) * (1.f / 128.f) + EPS);
#pragma unroll
            for (int j = 0; j < 2; ++j) ((bf16_t*)(ws + W_KVN))[(size_t)t * 128 + j * 64 + lane] = f2bf(kvv[j] * rk * kvan[j]); }
        {   f32x4 u, gv;
#pragma unroll
            for (int j = 0; j < 4; ++j) { u[j] = gelu_tanh(zu[j]); gv[j] = gelu_tanh(zv[j]); }
            *(f32x4*)(ws + W_U + (size_t)t * 256 + lane * 4) = u;
            const float mu = wave_sum(gv[0] + gv[1] + gv[2] + gv[3]) * (1.f / 256.f);
            gv = gv - mu;
            const float rstd = rsqrtf(wave_sum(gv[0] * gv[0] + gv[1] * gv[1] + gv[2] * gv[2] + gv[3] * gv[3]) * (1.f / 256.f) + EPS);
            *(f32x4*)(ws + W_VN + (size_t)t * 256 + lane * 4) = gv * rstd * sgg + sgb; }
        {   f32x4 o = cb;
#pragma unroll
            for (int k = 0; k < 4; ++k) { const int m = n - 1 + k; if (m >= 0 && m < sl) o = o + xc[k] * cw[k]; }
            *(f32x4*)(ws + W_XC + (size_t)t * 256 + lane * 4) = o;
            u32x2 ob; ob.x = cvt_pk_bf16(o[0], o[1]); ob.y = cvt_pk_bf16(o[2], o[3]); *(u32x2*)((bf16_t*)(ws + W_XCB) + (size_t)t * 256 + lane * 4) = ob; }
    }
}

__device__ void phase_small(const Params& p, int l, char* lds) {
    float* const ws = (float*)tab_ld(N_IN);
    const float* const pin_I_BA = PIN(I_BA);
    const float* const pin_I_BX = PIN(I_BX);
    const float* const pin_I_POOLS = PIN(I_POOLS);
    const float* const pin_I_POOLW = PIN(I_POOLW);
    const float* const pin_I_SGBS = PIN(I_SGBS);
    const float* const pin_I_WA = PIN(I_WA);
    const float* const pin_I_WUKV = PIN(I_WUKV);
    const float* const pin_I_WUQ = PIN(I_WUQ);
    const float* const pin_I_WX = PIN(I_WX);
    const int tid = tid_(), bid = bid_(); (void)tid;
    constexpr int NK = 19, NU1 = (T / 256) * NK, NU2 = NCHUNK * 2;
    bf16_t* Y = (bf16_t*)(ws + W_YC);
    for (int u = bid; u < NU1 + NU2; u += gridDim.x) {
        if (u < NU1) {
            const int tm = u / NK, kind = u % NK, m0 = tm * 256;
            if (kind < 11) {
                const bf16_t* A; int lda, K, ldb, nval; const float* B;
                if (kind < 4) { A = (const bf16_t*)(ws + W_DIFF) + kind * 64; lda = 256; K = 64; B = pin_I_POOLW + (size_t)(l * 4 + kind) * 64 * 64; ldb = 64; nval = 64; }
                else if (kind < 7) { A = (const bf16_t*)(ws + W_QN); lda = 192; K = 192; B = pin_I_WUQ + (size_t)l * 192 * 384 + (kind - 4) * 128; ldb = 384; nval = 128; }
                else { A = (const bf16_t*)(ws + W_KVN); lda = 128; K = 128; B = pin_I_WUKV + (size_t)l * 128 * 512 + (kind - 7) * 128; ldb = 512; nval = 128; }
                gemm_unit<false>(lds, K, [&](int r) { return A + (size_t)(m0 + r) * lda; }, B, B, ldb, nval,
                    [&](const f32x4 (&acc)[4][4], int wr, int wc, int fr, int fq) {
#pragma unroll
                        for (int m = 0; m < 4; ++m) { const int t = m0 + wr * 64 + m * 16 + fr;
#pragma unroll
                            for (int n = 0; n < 4; ++n) { const int c = wc * 64 + n * 16 + 4 * fq;
                                if (kind < 4) { if (wc == 0) { const f32x4 sc = *(const f32x4*)(pin_I_POOLS + l * 256 + kind * 64 + c); const f32x4 v = acc[m][n] * sc;
                                        u32x2 w; w.x = cvt_pk_bf16(v[0], v[1]); w.y = cvt_pk_bf16(v[2], v[3]); *(u32x2*)(Y + (size_t)t * D + kind * 64 + c) = w; } }
                                else if (kind < 7) *(f32x4*)(ws + W_QUP + (size_t)t * 384 + (kind - 4) * 128 + c) = acc[m][n];
                                else *(f32x4*)(ws + W_KVUP + (size_t)t * 512 + (kind - 7) * 128 + c) = acc[m][n]; } }
                    });
            } else {
                const int d = (kind - 11) >> 2, h = (kind - 11) & 3;
                const bf16_t* A = (const bf16_t*)(ws + W_XCB) + h * 64;
                const float* Ba = pin_I_WA + (size_t)((l * 2 + d) * 4 + h) * 64 * 64; const float* Bx = pin_I_WX + (size_t)((l * 2 + d) * 4 + h) * 64 * 64;
                const int pb = (l * 2 + d) * 256 + h * 64;
                gemm_unit<true>(lds, 64, [&](int r) { return A + (size_t)(m0 + r) * 256; }, Ba, Bx, 64, 64,
                    [&](const f32x4 (&acc)[4][4], int wr, int wc, int fr, int fq) {
#pragma unroll
                        for (int m = 0; m < 4; ++m) { const int t = m0 + wr * 64 + m * 16 + fr;
#pragma unroll
                            for (int pp = 0; pp < 2; ++pp) { const int idx = (wc * 2 + pp) * 16 + 4 * fq;
                                const f32x4 ba = *(const f32x4*)(pin_I_BA + pb + idx), bx = *(const f32x4*)(pin_I_BX + pb + idx), sp = *(const f32x4*)(ws + W_SP + pb + idx);
                                const f32x4 xv = *(const f32x4*)(ws + W_XC + (size_t)t * 256 + h * 64 + idx);
                                f32x4 av, dv;
#pragma unroll
                                for (int j = 0; j < 4; ++j) { const float r = fsigm(acc[m][2 * pp][j] + ba[j]), ig = fsigm(acc[m][2 * pp + 1][j] + bx[j]);
                                    const float loga = -8.f * r * sp[j], x2 = 2.f * loga;
                                    const float om = (x2 > -0.0625f) ? -x2 * (1.f + x2 * (0.5f + x2 * (0.16666667f + x2 * 0.041666668f))) : 1.f - fexp(x2);
                                    av[j] = fexp(loga); dv[j] = __builtin_amdgcn_sqrtf(om) * (ig * xv[j]); }
                                *(f32x4*)(ws + W_LA + ((size_t)d * T + t) * 256 + h * 64 + idx) = av;
                                *(f32x4*)(ws + W_LB + ((size_t)d * T + t) * 256 + h * 64 + idx) = dv; } }
                    });
            }
        } else {
            const int v = u - NU1, c = v >> 1, hp = v & 1;
            const bf16_t* A = (const bf16_t*)(ws + W_WSB) + ((size_t)l * 512 + hp * 256) * 128;
            const float* B = ws + W_VN + (size_t)c * 128 * 256 + hp * 128;
            gemm_unit<false>(lds, 128, [&](int r) { return A + (size_t)r * 128; }, B, B, 256, 128,
                [&](const f32x4 (&acc)[4][4], int wr, int wc, int fr, int fq) {
                    if ((wr >> 1) == wc) {
                        const int h = hp * 2 + wc;
#pragma unroll
                        for (int m = 0; m < 4; ++m) { const int pp = (wr & 1) * 64 + m * 16 + fr, t = c * 128 + pp; const float bs = pin_I_SGBS[(l * 4 + h) * 128 + pp];
#pragma unroll
                            for (int n = 0; n < 4; ++n) { const int ch = h * 64 + n * 16 + 4 * fq; const f32x4 uu = *(const f32x4*)(ws + W_U + (size_t)t * 256 + ch);
                                const f32x4 o = uu * (acc[m][n] + bs);
                                u32x2 w; w.x = cvt_pk_bf16(o[0], o[1]); w.y = cvt_pk_bf16(o[2], o[3]); *(u32x2*)(Y + (size_t)t * D + 512 + ch) = w; } }
                    }
                });
        }
    }
}

__device__ void phase_prep2(const Params& p, int l) {
    float* const ws = (float*)tab_ld(N_IN);
    const float* const pin_I_KN = PIN(I_KN);
    const float* const pin_I_QN = PIN(I_QN);
    const int tid = tid_(), bid = bid_();
    const int lane = tid & 63, gw = bid * (NTHR / 64) + __builtin_amdgcn_readfirstlane(tid >> 6), nw = gridDim.x * (NTHR / 64);
    {
        const int h = lane >> 4, j = lane & 15;
        const f32x4 qw = *(const f32x4*)(pin_I_QN + l * 96 + 4 * j), kw = *(const f32x4*)(pin_I_KN + l * 96 + 4 * j);
        const float qw1 = pin_I_QN[l * 96 + 64 + j], qw2 = pin_I_QN[l * 96 + 80 + j], kw1 = pin_I_KN[l * 96 + 64 + j], kw2 = pin_I_KN[l * 96 + 80 + j];
        for (int t = gw; t < T; t += nw) {
            const bool lat = t < NLAT;
            float cs = 1.f, sn = 0.f;
            if (lat) { cs = ws[W_ROPE + (size_t)t * 32 + j]; sn = ws[W_ROPE + (size_t)t * 32 + 16 + j]; }
            const float* qr = ws + W_QUP + (size_t)t * 384 + h * 96; const float* kr = ws + W_KVUP + (size_t)t * 512 + h * 128; const float* pr = ws + W_P + (size_t)t * INC + OFF_KR;
            f32x4 qn = *(const f32x4*)(qr + 4 * j); float q1 = qr[64 + j], q2 = qr[80 + j];
            f32x4 kn = *(const f32x4*)(kr + 4 * j); float k1 = pr[j], k2 = pr[16 + j];
            const f32x4 vv = *(const f32x4*)(kr + 64 + 4 * j);
            float sq = qn[0] * qn[0] + qn[1] * qn[1] + qn[2] * qn[2] + qn[3] * qn[3] + q1 * q1 + q2 * q2;
            float sk = kn[0] * kn[0] + kn[1] * kn[1] + kn[2] * kn[2] + kn[3] * kn[3] + k1 * k1 + k2 * k2;
#pragma unroll
            for (int o = 1; o < 16; o <<= 1) { sq += __shfl_xor(sq, o); sk += __shfl_xor(sk, o); }
            const float rq = rsqrtf(sq * (1.f / 96.f) + EPS), rk = rsqrtf(sk * (1.f / 96.f) + EPS);
            qn = qn * qw * rq; q1 *= qw1 * rq; q2 *= qw2 * rq; kn = kn * kw * rk; k1 *= kw1 * rk; k2 *= kw2 * rk;
            const float qa = q1 * cs - q2 * sn, qb = q1 * sn + q2 * cs, ka = k1 * cs - k2 * sn, kb = k1 * sn + k2 * cs;
            bf16_t* qo = (bf16_t*)(ws + W_Q) + ((size_t)h * T + t) * 96; bf16_t* ko = (bf16_t*)(ws + W_K) + ((size_t)h * T + t) * 96; bf16_t* vo = (bf16_t*)(ws + W_V) + ((size_t)h * T + t) * 64;
            { u32x2 w; w.x = cvt_pk_bf16(qn[0], qn[1]); w.y = cvt_pk_bf16(qn[2], qn[3]); *(u32x2*)(qo + 4 * j) = w; qo[64 + j] = f2bf(qa); qo[80 + j] = f2bf(qb); }
            { u32x2 w; w.x = cvt_pk_bf16(kn[0], kn[1]); w.y = cvt_pk_bf16(kn[2], kn[3]); *(u32x2*)(ko + 4 * j) = w; ko[64 + j] = f2bf(ka); ko[80 + j] = f2bf(kb); }
            { u32x2 w; w.x = cvt_pk_bf16(vv[0], vv[1]); w.y = cvt_pk_bf16(vv[2], vv[3]); *(u32x2*)(vo + 4 * j) = w; }
        }
    }
    for (int i = bid * NTHR + tid; i < NCHUNK * 512; i += gridDim.x * NTHR) {
        const int c = i >> 9, d = (i >> 8) & 1, ch = i & 255;
        const size_t off = ((size_t)d * T + (size_t)c * 128) * 256 + ch;
        const float* __restrict__ A = ws + W_LA + off; const float* __restrict__ B = ws + W_LB + off;
        float* __restrict__ A2 = ws + W_LA2 + off; float* __restrict__ B2 = ws + W_LB2 + off;
        float h = 0.f, ap = 1.f;
        float a[8], b[8], an[8], bn[8];
#pragma unroll
        for (int j = 0; j < 8; ++j) { const int q = d ? 127 - j : j; a[j] = A[(size_t)q * 256]; b[j] = B[(size_t)q * 256]; }
        for (int s0 = 0; s0 < 128; s0 += 8) {
            const int s1 = (s0 + 8 < 128) ? s0 + 8 : s0;
#pragma unroll
            for (int j = 0; j < 8; ++j) { const int q = d ? 127 - (s1 + j) : s1 + j; an[j] = A[(size_t)q * 256]; bn[j] = B[(size_t)q * 256]; }
#pragma unroll
            for (int j = 0; j < 8; ++j) { h = fmaf(a[j], h, b[j]); ap *= a[j]; const int q = d ? 127 - (s0 + j) : s0 + j; A2[(size_t)q * 256] = ap; B2[(size_t)q * 256] = h; }
#pragma unroll
            for (int j = 0; j < 8; ++j) { a[j] = an[j]; b[j] = bn[j]; }
        }
        ws[W_AGG + ((size_t)(c * 2 + d) * 2 + 0) * 256 + ch] = ap;
        ws[W_AGG + ((size_t)(c * 2 + d) * 2 + 1) * 256 + ch] = h;
    }
}


__device__ void phase_attn(const Params& p, int l, char* lds) {
    float* const ws = (float*)tab_ld(N_IN);
    const int tid = tid_(), bid = bid_(); (void)tid;
    const bf16_t* Qb = (const bf16_t*)(ws + W_Q); const bf16_t* Kb = (const bf16_t*)(ws + W_K); const bf16_t* Vb = (const bf16_t*)(ws + W_V);
    bf16_t* Y = (bf16_t*)(ws + W_YC);
    const int nunits = (l == 0) ? 260 : 256;
    for (int u = bid; u < nunits; u += gridDim.x) {
        int h, t0, k0, seq;
        if (u < 256) { h = (u & 7) >> 1; t0 = (((u >> 3) << 1) | (u & 1)) * 256; k0 = 0; seq = T; }
        else { h = u - 256; t0 = NLAT; k0 = NLAT; seq = NCTX; }
        att::attn_unit(Qb + ((size_t)h * T + t0) * 96, Kb + ((size_t)h * T + k0) * 96, Vb + ((size_t)h * T + k0) * 64, seq, Y + (size_t)t0 * D + 256 + h * 64, D, lds);
    }
}

__device__ void phase_lru_fin(const Params& p, char* lds) {
    float* const ws = (float*)tab_ld(N_IN);
    const int tid = tid_(), bid = bid_();
    float* carry = (float*)lds;
    for (int it = bid; it < NCHUNK * 2; it += gridDim.x) {
        const int c = it >> 1, half = it & 1;
        {
            const int d = tid >> 8, ch = tid & 255;
            const float* ag = ws + W_AGG + (size_t)d * 512 + ch;
            float s = 0.f;
            int q0, dq, n;
            if (d) { q0 = NCHUNK - 1; dq = -1; n = NCHUNK - 1 - c; }
            else if (c >= 128) { q0 = 128; dq = 1; n = c - 128; }
            else { s = fmaf(ag[(size_t)129 * 1024], ag[(size_t)128 * 1024 + 256], ag[(size_t)129 * 1024 + 256]); q0 = 0; dq = 1; n = c; }
            int k = 0;
            for (; k + 8 <= n; k += 8) {
                float a[8], hh[8];
#pragma unroll
                for (int j = 0; j < 8; ++j) { const float* r = ag + (size_t)(q0 + (k + j) * dq) * 1024; a[j] = r[0]; hh[j] = r[256]; }
#pragma unroll
                for (int j = 0; j < 8; ++j) s = fmaf(a[j], s, hh[j]);
            }
            for (; k < n; ++k) { const float* r = ag + (size_t)(q0 + k * dq) * 1024; s = fmaf(r[0], s, r[256]); }
            carry[tid] = s;
        }
        __syncthreads();
        for (int i = tid; i < 64 * 64; i += NTHR) {
            const int t = c * 128 + half * 64 + (i >> 6), ch = (i & 63) * 4;
            f32x4 hs = *(const f32x4*)(ws + W_LB2 + (size_t)t * 256 + ch) + *(const f32x4*)(ws + W_LA2 + (size_t)t * 256 + ch) * *(const f32x4*)(carry + ch);
            hs = hs + *(const f32x4*)(ws + W_LB2 + ((size_t)T + t) * 256 + ch) + *(const f32x4*)(ws + W_LA2 + ((size_t)T + t) * 256 + ch) * *(const f32x4*)(carry + 256 + ch);
            const f32x4 g = *(const f32x4*)(ws + W_P + (size_t)t * INC + OFF_DG + ch);
            u32x2 w; w.x = cvt_pk_bf16(gelu_tanh(g[0]) * hs[0], gelu_tanh(g[1]) * hs[1]); w.y = cvt_pk_bf16(gelu_tanh(g[2]) * hs[2], gelu_tanh(g[3]) * hs[3]);
            *(u32x2*)((bf16_t*)(ws + W_YC) + (size_t)t * D + 768 + ch) = w;
        }
        __syncthreads();
    }
}

struct OutprojSched {
    UnitRange ur; const char* A; const char* Bt;
    DEVI bool next(int i, pg8::Unit& u) const {
        const int id = ur.lo + i * ur.step; if (id >= ur.hi) return false;
        const int tm = id >> 2, tn = id & 3;
        u.a = A + (size_t)tm * 256 * D * 2; u.b = Bt + (size_t)tn * 256 * D * 2; u.x0 = tm * 256; u.x1 = tn * 256; u.x2 = 0; return true;
    }
};
struct EpiOutproj { static constexpr bool PERM = false; float* X; const float* modv;
    DEVI void operator()(const f32x4 (&acc)[2][2][4][2], const pg8::Unit& u, int wr, int wc, int fr, int fq) const {
        const float* g1 = modv + (u.x0 >= NLAT ? 6144 : 0) + 2 * D;
#pragma unroll
        for (int ai = 0; ai < 2; ++ai)
#pragma unroll
            for (int m = 0; m < 4; ++m) { float* row = X + (size_t)(u.x0 + ai * 128 + wr * 64 + m * 16 + fr) * D;
#pragma unroll
                for (int bj = 0; bj < 2; ++bj)
#pragma unroll
                    for (int n = 0; n < 2; ++n) { const int c = u.x1 + bj * 128 + wc * 32 + n * 16 + 4 * fq; const f32x4 g = *(const f32x4*)(g1 + c); f32x4 x = *(f32x4*)(row + c);
                        x = x + g * acc[ai][bj][m][n]; *(f32x4*)(row + c) = x; } }
    }
};
__device__ void phase_outproj(const Params& p, int l, char* lds) {
    float* const ws = (float*)tab_ld(N_IN);
    const int tid = tid_(), bid = bid_(); (void)tid;
    const int ntm = (l == NLAYER - 1) ? NLAT / 256 : T / 256;
    OutprojSched S; S.ur = unit_range(ntm * 4, bid); S.A = (const char*)(ws + W_YC); S.Bt = (const char*)((const bf16_t*)(ws + W_WOUT) + (size_t)l * D * D);
    EpiOutproj E; E.X = ws + W_X; E.modv = ws + W_MOD + (size_t)l * 2 * 6144;
    pg8::gemm_phase((PG8_LAS unsigned char*)lds, D, (size_t)128 * D * 2, S, E);
}

constexpr int R_LDS = 1024 * 36 * 4;
__device__ void phase_router(const Params& p, int l, char* lds) {
    float* const ws = (float*)tab_ld(N_IN);
    const float* const pin_I_NFFN = PIN(I_NFFN);
    const float* const pin_I_RB = PIN(I_RB);
    const float* const pin_I_RW = PIN(I_RW);
    const int tid = tid_(), bid = bid_();
    float* wl = (float*)lds;
    int* hist = (int*)(lds + R_LDS); int* bbase = hist + 32; int* tinfo = hist + 64 + (tid >> 6) * 40;
    float* wsc = (float*)(lds + RSC_OFF) + (tid >> 6) * 96;
    if (tid < 32) hist[tid] = 0;
    {   const float* rw = pin_I_RW + (size_t)l * D * NEXP;
        for (int i = tid; i < 1024 * 8; i += NTHR) { const int k = i >> 3, e4 = i & 7; *(f32x4*)(wl + k * 36 + e4 * 4) = *(const f32x4*)(rw + k * 32 + e4 * 4); }
    }
    __syncthreads();
    const int lane = tid & 63, gw = bid * (NTHR / 64) + __builtin_amdgcn_readfirstlane(tid >> 6), nw = gridDim.x * (NTHR / 64);
    const float* g = pin_I_NFFN + l * D;
    int* cnt = (int*)(ws + W_CNT) + l * NEXP * 64;
    bf16_t* HB = (bf16_t*)(ws + W_HB);
    const int e = lane >> 1;
    const float rb = pin_I_RB[l * NEXP + e];
    const int TL = (l == NLAYER - 1) ? NLAT : T;
    int ti = 0;
    for (int t0 = gw; t0 < TL; t0 += 2 * nw, ti += 2) {
        const int t1 = t0 + nw; const bool v1 = t1 < TL; const int t1c = v1 ? t1 : t0;
        const float* mod = ws + W_MOD + (size_t)(l * 2 + (t0 >= NLAT ? 1 : 0)) * 6144;
        float f0[16], f1[16]; float ss0 = 0.f, ss1 = 0.f;
#pragma unroll
        for (int m = 0; m < 16; ++m) { f0[m] = ws[W_X + (size_t)t0 * D + lane + 64 * m]; f1[m] = ws[W_X + (size_t)t1c * D + lane + 64 * m]; }
#pragma unroll
        for (int m = 0; m < 16; ++m) { ss0 = fmaf(f0[m], f0[m], ss0); ss1 = fmaf(f1[m], f1[m], ss1); }
#pragma unroll
        for (int o = 32; o > 0; o >>= 1) { ss0 += __shfl_xor(ss0, o); ss1 += __shfl_xor(ss1, o); }
        const float r0 = rsqrtf(ss0 * (1.f / D) + EPS), r1 = rsqrtf(ss1 * (1.f / D) + EPS);
#pragma unroll
        for (int m = 0; m < 16; ++m) { const int k = lane + 64 * m; const float gkm = g[k] * (1.f + mod[4 * D + k]), shm = mod[3 * D + k]; f0[m] = f0[m] * r0 * gkm + shm; f1[m] = f1[m] * r1 * gkm + shm;
            HB[(size_t)t0 * D + k] = f2bf(f0[m]); if (v1) HB[(size_t)t1 * D + k] = f2bf(f1[m]); }
        float acc0[32], acc1[32];
#pragma unroll
        for (int j = 0; j < 32; ++j) { acc0[j] = 0.f; acc1[j] = 0.f; }
#pragma unroll
        for (int m = 0; m < 16; ++m) {
            const float* wr = wl + (lane + 64 * m) * 36;
#pragma unroll
            for (int e4 = 0; e4 < 8; ++e4) { const f32x4 w4 = *(const f32x4*)(wr + e4 * 4);
#pragma unroll
                for (int j = 0; j < 4; ++j) { acc0[e4 * 4 + j] = fmaf(f0[m], w4[j], acc0[e4 * 4 + j]); acc1[e4 * 4 + j] = fmaf(f1[m], w4[j], acc1[e4 * 4 + j]); } }
            __builtin_amdgcn_sched_barrier(0);
        }
#define RS_STEP(W_, MSK_) do { const bool up = (lane & (MSK_)) != 0; \
            _Pragma("unroll") for (int j = 0; j < (W_); ++j) { const float s0_ = up ? acc0[j] : acc0[j + (W_)], k0_ = up ? acc0[j + (W_)] : acc0[j]; acc0[j] = k0_ + __shfl_xor(s0_, (MSK_)); \
                const float s1_ = up ? acc1[j] : acc1[j + (W_)], k1_ = up ? acc1[j + (W_)] : acc1[j]; acc1[j] = k1_ + __shfl_xor(s1_, (MSK_)); } } while (0)
        RS_STEP(16, 32); RS_STEP(8, 16); RS_STEP(4, 8); RS_STEP(2, 4); RS_STEP(1, 2);
#undef RS_STEP
        const float a0 = acc0[0] + __shfl_xor(acc0[0], 1) + rb, a1 = acc1[0] + __shfl_xor(acc1[0], 1) + rb;
        if ((lane & 1) == 0) { wsc[e] = a0; wsc[48 + e] = a1; }
        asm volatile("s_waitcnt lgkmcnt(0)" ::: "memory"); __builtin_amdgcn_wave_barrier();
        int rank0 = 0, rank1 = 0;
#pragma unroll
        for (int q = 0; q < 8; ++q) { const f32x4 x0 = *(const volatile f32x4*)(wsc + 4 * q), x1 = *(const volatile f32x4*)(wsc + 48 + 4 * q);
#pragma unroll
            for (int j = 0; j < 4; ++j) { const int eo = 4 * q + j;
                rank0 += (x0[j] > a0 || (x0[j] == a0 && eo < e)) ? 1 : 0; rank1 += (x1[j] > a1 || (x1[j] == a1 && eo < e)) ? 1 : 0; } }
        if ((lane & 1) == 0) {
            if (rank0 < 4) { ((int*)wsc)[32 + rank0] = e; wsc[36 + rank0] = a0; }
            if (rank1 < 4) { ((int*)wsc)[80 + rank1] = e; wsc[84 + rank1] = a1; }
        }
        asm volatile("s_waitcnt lgkmcnt(0)" ::: "memory"); __builtin_amdgcn_wave_barrier();
        if (lane < 8 && (lane < 4 || v1)) {
            const int u = lane >> 2, k = lane & 3, tt = u ? t1 : t0;
            const volatile float* sv = wsc + u * 48;
            const float mx = sv[36];
            const float sm = expf(sv[36] - mx) + expf(sv[37] - mx) + expf(sv[38] - mx) + expf(sv[39] - mx);
            const int ee = ((const volatile int*)sv)[32 + k]; const float eg = expf(sv[36 + k] - mx);
            const int lidx = atomicAdd(&hist[ee], 1);
            tinfo[(ti + u) * 4 + k] = (ee << 16) | lidx;
            ((int*)(ws + W_TOPE))[tt * 4 + k] = ee;
            ws[W_TOPG + tt * 4 + k] = eg / sm;
        }
        __builtin_amdgcn_wave_barrier();
    }
    __syncthreads();
    if (tid < 32) bbase[tid] = atomicAdd(&cnt[tid * 64], hist[tid]);
    __syncthreads();
    ti = 0;
    for (int t = gw; t < TL; t += nw, ++ti)
        if (lane < 4) { const int v = tinfo[ti * 4 + lane]; ((int*)(ws + W_TOPI))[t * 4 + lane] = bbase[v >> 16] + (v & 0xffff); }
    __syncthreads();
}

DEVI void moe_bases(const Params& p, int l, int* sb) {
    float* const ws = (float*)tab_ld(N_IN);
    const int tid = tid_();
    if (tid == 0) {
        const int* cnt = (const int*)(ws + W_CNT) + l * NEXP * 64;
        int b = 0, tb = 0;
        for (int e = 0; e < NEXP; ++e) { sb[e] = b; sb[40 + e] = tb; const int c = cnt[e * 64]; sb[80 + e] = c; const int mt = (c + 255) / 256; b += mt * 256; tb += mt; }
        sb[32] = b; sb[72] = tb;
    }
    __syncthreads();
}

__device__ void phase_scatter(const Params& p, int l, char* lds) {
    float* const ws = (float*)tab_ld(N_IN);
    const int tid = tid_(), bid = bid_();
    int* sb = (int*)(lds + G_LDS);
    moe_bases(p, l, sb);
    const bf16_t* HB = (const bf16_t*)(ws + W_HB); bf16_t* XS = (bf16_t*)(ws + W_XS);
    const int lane = tid & 63, gw = bid * (NTHR / 64) + __builtin_amdgcn_readfirstlane(tid >> 6), nw = gridDim.x * (NTHR / 64);
    const int TL = (l == NLAYER - 1) ? NLAT : T;
    for (int t0 = gw; t0 < TL; t0 += 2 * nw) {
        const int t1 = t0 + nw; const bool v1 = t1 < TL; const int t1c = v1 ? t1 : t0;
        int row = 0;
        if (lane < 8 && (lane < 4 || v1)) { const int tt = (lane < 4) ? t0 : t1, k = lane & 3;
            const int e = ((const int*)(ws + W_TOPE))[tt * 4 + k]; row = sb[e] + ((const int*)(ws + W_TOPI))[tt * 4 + k]; ((int*)(ws + W_TOPI))[tt * 4 + k] = row; }
        const u32x4 a0 = *(const u32x4*)(HB + (size_t)t0 * D + lane * 8), a1 = *(const u32x4*)(HB + (size_t)t0 * D + 512 + lane * 8);
        const u32x4 b0 = *(const u32x4*)(HB + (size_t)t1c * D + lane * 8), b1 = *(const u32x4*)(HB + (size_t)t1c * D + 512 + lane * 8);
#pragma unroll
        for (int k = 0; k < 4; ++k) { const int rk = __shfl(row, k); bf16_t* d = XS + (size_t)rk * D; *(u32x4*)(d + lane * 8) = a0; *(u32x4*)(d + 512 + lane * 8) = a1; }
        if (v1) {
#pragma unroll
            for (int k = 0; k < 4; ++k) { const int rk = __shfl(row, 4 + k); bf16_t* d = XS + (size_t)rk * D; *(u32x4*)(d + lane * 8) = b0; *(u32x4*)(d + 512 + lane * 8) = b1; } }
    }
    __syncthreads();
}

struct MoeSched {
    UnitRange ur; const int* sb; int ntn; const char* A; const char* Bt; size_t bstride_e, bstride_tn;
    DEVI bool next(int i, pg8::Unit& u) const {
        const int id = ur.lo + i * ur.step; if (id >= ur.hi) return false;
        int e = 0; while (e < NEXP - 1 && sb[40 + e + 1] * ntn <= id) ++e;
        const int mts = sb[40 + e + 1] - sb[40 + e], loc = id - sb[40 + e] * ntn, tng = loc / (mts * 4), rr = loc % (mts * 4), mt = rr >> 2, tn = tng * 4 + (rr & 3);
        const int r0 = __builtin_amdgcn_readfirstlane(sb[e] + mt * 256), tn_s = __builtin_amdgcn_readfirstlane(tn), e_s = __builtin_amdgcn_readfirstlane(e);
        u.a = A + (size_t)r0 * D * 2; u.b = Bt + (size_t)e_s * bstride_e + (size_t)tn_s * bstride_tn; u.x0 = r0; u.x1 = tn_s; u.x2 = e_s; return true;
    }
};
struct EpiMoe1 { static constexpr bool PERM = true; bf16_t* ACT; const float* bias;
    DEVI void operator()(const f32x4 (&acc)[2][2][4][2], const pg8::Unit& u, int wr, int wc, int fr, int fq) const {
        const int c0 = u.x1 * 128 + wc * 32 + 8 * fq;
        const float* bg = bias + (size_t)u.x2 * 2048 + c0; const float* bu = bg + 1024;
        f32x4 vg[2], vu[2];
#pragma unroll
        for (int n = 0; n < 2; ++n) { vg[n] = *(const f32x4*)(bg + 4 * n); vu[n] = *(const f32x4*)(bu + 4 * n); }
#pragma unroll
        for (int ai = 0; ai < 2; ++ai)
#pragma unroll
            for (int m = 0; m < 4; ++m) { bf16_t* rowp = ACT + (size_t)(u.x0 + ai * 128 + wr * 64 + m * 16 + fr) * D + c0;
                float a[8];
#pragma unroll
                for (int n = 0; n < 2; ++n)
#pragma unroll
                    for (int j = 0; j < 4; ++j) { float g = acc[ai][0][m][n][j] + vg[n][j], uu = acc[ai][1][m][n][j] + vu[n][j];
                        g = fminf(g, 7.f); uu = fminf(fmaxf(uu, -7.f), 7.f); a[n * 4 + j] = (uu + 1.f) * (g * sigm(1.702f * g)); }
                u32x4 w; w.x = cvt_pk_bf16(a[0], a[1]); w.y = cvt_pk_bf16(a[2], a[3]); w.z = cvt_pk_bf16(a[4], a[5]); w.w = cvt_pk_bf16(a[6], a[7]);
                *(u32x4*)rowp = w; }
    }
};
__device__ void phase_moe1(const Params& p, int l, char* lds) {
    float* const ws = (float*)tab_ld(N_IN);
    const float* const pin_I_BGU = PIN(I_BGU);
    const int tid = tid_(), bid = bid_(); (void)tid;
    int* sb = (int*)(lds + pg8::STAGE_BYTES);
    moe_bases(p, l, sb);
    MoeSched S; S.sb = sb; S.ntn = 8; S.ur = unit_range(sb[72] * 8, bid); S.A = (const char*)(ws + W_XS);
    S.Bt = (const char*)((const bf16_t*)(ws + W_WGU) + (size_t)l * NEXP * 2048 * D); S.bstride_e = (size_t)2048 * D * 2; S.bstride_tn = (size_t)128 * D * 2;
    EpiMoe1 E; E.ACT = (bf16_t*)(ws + W_ACT); E.bias = pin_I_BGU + (size_t)l * NEXP * 2048;
    pg8::gemm_phase((PG8_LAS unsigned char*)lds, D, (size_t)1024 * D * 2, S, E);
    __syncthreads();
}

struct EpiMoe2 { static constexpr bool PERM = true; bf16_t* YR; const float* bias;
    DEVI void operator()(const f32x4 (&acc)[2][2][4][2], const pg8::Unit& u, int wr, int wc, int fr, int fq) const {
        const int c0 = u.x1 * 256 + wc * 32 + 8 * fq;
        const float* bb = bias + (size_t)u.x2 * D + c0;
        f32x4 bv[2][2];
#pragma unroll
        for (int bj = 0; bj < 2; ++bj)
#pragma unroll
            for (int n = 0; n < 2; ++n) bv[bj][n] = *(const f32x4*)(bb + bj * 128 + 4 * n);
#pragma unroll
        for (int ai = 0; ai < 2; ++ai)
#pragma unroll
            for (int m = 0; m < 4; ++m) { bf16_t* rowp = YR + (size_t)(u.x0 + ai * 128 + wr * 64 + m * 16 + fr) * D + c0;
#pragma unroll
                for (int bj = 0; bj < 2; ++bj) { const f32x4 v0 = acc[ai][bj][m][0] + bv[bj][0], v1 = acc[ai][bj][m][1] + bv[bj][1];
                    u32x4 w; w.x = cvt_pk_bf16(v0[0], v0[1]); w.y = cvt_pk_bf16(v0[2], v0[3]); w.z = cvt_pk_bf16(v1[0], v1[1]); w.w = cvt_pk_bf16(v1[2], v1[3]);
                    *(u32x4*)(rowp + bj * 128) = w; } }
    }
};
__device__ void phase_moe2(const Params& p, int l, char* lds) {
    float* const ws = (float*)tab_ld(N_IN);
    const float* const pin_I_BDN = PIN(I_BDN);
    const int tid = tid_(), bid = bid_(); (void)tid;
    int* sb = (int*)(lds + pg8::STAGE_BYTES);
    moe_bases(p, l, sb);
    MoeSched S; S.sb = sb; S.ntn = 4; S.ur = unit_range(sb[72] * 4, bid); S.A = (const char*)(ws + W_ACT);
    S.Bt = (const char*)((const bf16_t*)(ws + W_WDN) + (size_t)l * NEXP * D * D); S.bstride_e = (size_t)D * D * 2; S.bstride_tn = (size_t)256 * D * 2;
    EpiMoe2 E; E.YR = (bf16_t*)(ws + W_YR); E.bias = pin_I_BDN + (size_t)l * NEXP * D;
    pg8::gemm_phase((PG8_LAS unsigned char*)lds, D, (size_t)128 * D * 2, S, E);
    __syncthreads();
}

__device__ void phase_combine(const Params& p, int l, char* lds, bool last) {
    float* const ws = (float*)tab_ld(N_IN);
    float* const pout = (float*)tab_ld(N_IN + 1);
    const int tid = tid_(), bid = bid_();
    const bf16_t* YR = (const bf16_t*)(ws + W_YR);
    const int lane = tid & 63, gw = bid * (NTHR / 64) + __builtin_amdgcn_readfirstlane(tid >> 6), nw = gridDim.x * (NTHR / 64);
    const int TL = last ? NLAT : T;
    for (int t0 = gw; t0 < TL; t0 += 2 * nw) {
        const int t1 = t0 + nw; const bool v1 = t1 < TL; const int t1c = v1 ? t1 : t0;
        const float* g2 = ws + W_MOD + (size_t)(l * 2 + (t0 >= NLAT ? 1 : 0)) * 6144 + 5 * D;
        const bf16_t* ya[4]; const bf16_t* yb[4]; float ga[4], gb[4];
#pragma unroll
        for (int k = 0; k < 4; ++k) { ya[k] = YR + (size_t)((const int*)(ws + W_TOPI))[t0 * 4 + k] * D; ga[k] = ws[W_TOPG + t0 * 4 + k];
                                      yb[k] = YR + (size_t)((const int*)(ws + W_TOPI))[t1c * 4 + k] * D; gb[k] = ws[W_TOPG + t1c * 4 + k]; }
        float* xa = ws + W_X + (size_t)t0 * D; float* xb = ws + W_X + (size_t)t1c * D;
        float4 ra[4], rb[4];
#pragma unroll
        for (int j = 0; j < 4; ++j) {
            const int c = j * 256 + lane * 4;
            u32x2 ua[4], ub[4];
#pragma unroll
            for (int k = 0; k < 4; ++k) { ua[k] = *(const u32x2*)(ya[k] + c); ub[k] = *(const u32x2*)(yb[k] + c); }
            float4 xva = *(const float4*)(xa + c), xvb = *(const float4*)(xb + c); const float4 gg = *(const float4*)(g2 + c);
            float a0 = 0.f, a1 = 0.f, a2 = 0.f, a3 = 0.f, b0 = 0.f, b1 = 0.f, b2 = 0.f, b3 = 0.f;
#pragma unroll
            for (int k = 0; k < 4; ++k) {
                a0 = fmaf(ga[k], __uint_as_float(ua[k].x << 16), a0); a1 = fmaf(ga[k], __uint_as_float(ua[k].x & 0xffff0000u), a1);
                a2 = fmaf(ga[k], __uint_as_float(ua[k].y << 16), a2); a3 = fmaf(ga[k], __uint_as_float(ua[k].y & 0xffff0000u), a3);
                b0 = fmaf(gb[k], __uint_as_float(ub[k].x << 16), b0); b1 = fmaf(gb[k], __uint_as_float(ub[k].x & 0xffff0000u), b1);
                b2 = fmaf(gb[k], __uint_as_float(ub[k].y << 16), b2); b3 = fmaf(gb[k], __uint_as_float(ub[k].y & 0xffff0000u), b3); }
            xva.x = fmaf(gg.x, a0, xva.x); xva.y = fmaf(gg.y, a1, xva.y); xva.z = fmaf(gg.z, a2, xva.z); xva.w = fmaf(gg.w, a3, xva.w);
            xvb.x = fmaf(gg.x, b0, xvb.x); xvb.y = fmaf(gg.y, b1, xvb.y); xvb.z = fmaf(gg.z, b2, xvb.z); xvb.w = fmaf(gg.w, b3, xvb.w);
            ra[j] = xva; rb[j] = xvb;
            if (last) { *(float4*)(pout + (size_t)t0 * D + c) = xva; if (v1) *(float4*)(pout + (size_t)t1 * D + c) = xvb; }
            else { *(float4*)(xa + c) = xva; if (v1) *(float4*)(xb + c) = xvb; }
        }
        if (!last) { norm1_store(p, l + 1, t0, lane, ra); if (v1) norm1_store(p, l + 1, t1, lane, rb); }
    }
}

constexpr int XST_OFF = R_LDS + 2048 - 16, STAMP_OFF = R_LDS + 2048 - 16 - 256;
constexpr int LDS_BYTES = RSC_OFF + 8 * 96 * 4;

#define XB_TMO      128
#define XB_XCNT(j)  (256  + 64 * (j))
#define XB_XSUB(j)  (1280 + 64 * (j))
#define XB_XGEN(j)  (2304 + 64 * (j))
#define XB_TOP      3328
#define XB_TOPGEN   3392
#define XCD_BAR_WORDS 3456
#define XB_SPIN_CAP (1u << 18)
#define LAS __attribute__((address_space(3)))
__device__ __forceinline__ unsigned xb_ld(unsigned* p)              { return __hip_atomic_load(p, __ATOMIC_RELAXED, __HIP_MEMORY_SCOPE_AGENT); }
__device__ __forceinline__ unsigned xb_add(unsigned* p, unsigned v) { return __hip_atomic_fetch_add(p, v, __ATOMIC_RELAXED, __HIP_MEMORY_SCOPE_AGENT); }
__device__ __forceinline__ unsigned xb_xcc_id() { return (unsigned)__builtin_amdgcn_s_getreg((3 << 11) | 20) & 0xFu; }
#define XB_SPIN(cond, bar) do { unsigned _sp = 0; while (cond) { __builtin_amdgcn_s_sleep(1); \
    if ((++_sp & 255u) == 0u) { if (xb_ld(&(bar)[XB_TMO])) break; if (_sp > XB_SPIN_CAP) { atomicAdd(&(bar)[XB_TMO], 1u); break; } } } } while (0)
struct XcdBarrier { unsigned* bar; unsigned x; volatile LAS unsigned* st; };
__device__ __forceinline__ XcdBarrier xcd_barrier_post(unsigned* bar, volatile LAS unsigned* st) {
    XcdBarrier b; b.bar = bar; b.x = xb_xcc_id(); b.st = st;
    if (threadIdx.x == 0) (void)xb_add(&bar[XB_XCNT(b.x)], 1u);
    return b;
}
__device__ __forceinline__ void xcd_barrier_complete(unsigned* bar, unsigned x, unsigned& nloc, unsigned& nx) {
    const unsigned G = gridDim.x * gridDim.y * gridDim.z;
    unsigned sum, cnt, mine, sp = 0u;
    for (;;) {
        sum = 0u; cnt = 0u; mine = 0u;
#pragma unroll
        for (unsigned j = 0; j < 16; ++j) { const unsigned c = xb_ld(&bar[XB_XCNT(j)]); sum += c; cnt += (c > 0u) ? 1u : 0u; mine = (j == x) ? c : mine; }
        if (sum == G) break;
        __builtin_amdgcn_s_sleep(1);
        if ((++sp & 255u) == 0u) { if (xb_ld(&bar[XB_TMO])) break; if (sp > XB_SPIN_CAP) { atomicAdd(&bar[XB_TMO], 1u); break; } }
    }
    nloc = mine > 0u ? mine : 1u; nx = cnt > 0u ? cnt : 1u;
}
__device__ __noinline__ void xcd_barrier(const XcdBarrier b) {
    asm volatile("s_waitcnt vmcnt(0)" ::: "memory");
    __syncthreads();
    if (threadIdx.x == 0) {
        unsigned* bar = b.bar;
        __builtin_amdgcn_s_waitcnt(0);
        unsigned nloc = b.st[0], nx = b.st[1];
        if (nloc == 0u) { xcd_barrier_complete(bar, b.x, nloc, nx); b.st[0] = nloc; b.st[1] = nx; }
        const unsigned old = xb_add(&bar[XB_XSUB(b.x)], 1u);
        const unsigned gen = old / nloc;
        if (old + 1u == (gen + 1u) * nloc) {
            __builtin_amdgcn_fence(__ATOMIC_RELEASE, "agent");
            asm volatile("s_waitcnt vmcnt(0)" ::: "memory");
            const unsigned og = xb_add(&bar[XB_TOP], 1u);
            const unsigned tg = og / nx;
            if (og + 1u == (tg + 1u) * nx) xb_add(&bar[XB_TOPGEN], 1u);
            else XB_SPIN(xb_ld(&bar[XB_TOPGEN]) == tg, bar);
            __builtin_amdgcn_fence(__ATOMIC_ACQUIRE, "agent");
            xb_add(&bar[XB_XGEN(b.x)], 1u);
            asm volatile("s_waitcnt vmcnt(0)" ::: "memory");
        } else {
            XB_SPIN(xb_ld(&bar[XB_XGEN(b.x)]) == gen, bar);
            __builtin_amdgcn_fence(__ATOMIC_ACQUIRE, "agent");
            asm volatile("s_waitcnt vmcnt(0)" ::: "memory");
        }
    }
    __syncthreads();
}

constexpr int PROBE_IDX = -1, PROBE_DIV = 10;
constexpr int REP_NORM = 1, REP_INPROJ = 1, REP_PREP1 = 1, REP_SMALL = 1, REP_ATTN = 1, REP_FIN = 1, REP_MOE1 = 1, REP_MOE2 = 1, REP_SYNC = 1, REP_CONV = 1;
__global__ void __launch_bounds__(NTHR) fwd_kernel(Params p) {
    cg::grid_group grid = cg::this_grid();
    char* lds = g_lds;
    float* smem = (float*)lds;
    if (threadIdx.x == 0) {
        unsigned long long* tab = (unsigned long long*)(lds + TAB_OFF);
#pragma unroll
        for (int i = 0; i < N_IN; ++i) tab[i] = (unsigned long long)p.in[i];
        tab[N_IN] = (unsigned long long)p.ws; tab[N_IN + 1] = (unsigned long long)p.out;
    }
    __syncthreads();
    volatile LAS unsigned* xst = (volatile LAS unsigned*)(lds + XST_OFF);
    if (threadIdx.x < 4) xst[threadIdx.x] = 0u;
    if (blockIdx.x == 0) for (int i = threadIdx.x; i < 4096; i += NTHR) ((unsigned*)(p.ws + W_BAR))[i] = 0u;
    for (int r = 0; r < REP_CONV; ++r) phase_convert(p);
    phase_tables(p);
    phase_mod(p, smem);
    grid.sync();
    XcdBarrier xbar = xcd_barrier_post((unsigned*)(p.ws + W_BAR), xst);
    unsigned long long* stamps = (unsigned long long*)(lds + STAMP_OFF); int nstamp = 0;
#define GSYNC() do { for (int r_ = 0; r_ < REP_SYNC; ++r_) xcd_barrier(xbar); if (PROBE_IDX >= 0) { if (blockIdx.x == 0 && threadIdx.x == 0) stamps[nstamp] = __builtin_amdgcn_s_memrealtime(); ++nstamp; } } while (0)
    phase_init(p);
    GSYNC();
    for (int lv = 0; lv < NLAYER; ++lv) {
        int l = lv; asm volatile("" : "+s"(l));
        for (int r = 0; r < REP_INPROJ; ++r) phase_inproj(p, l, lds);
        GSYNC();
        for (int r = 0; r < REP_PREP1; ++r) phase_prep1(p, l);
        GSYNC();
        for (int r = 0; r < REP_SMALL; ++r) phase_small(p, l, lds);
        GSYNC();
        phase_prep2(p, l);
        GSYNC();
        for (int r = 0; r < REP_ATTN; ++r) phase_attn(p, l, lds);
        for (int r = 0; r < REP_FIN; ++r) phase_lru_fin(p, lds);
        GSYNC();
        phase_outproj(p, l, lds);
        GSYNC();
        phase_router(p, l, lds);
        GSYNC();
        phase_scatter(p, l, lds);
        GSYNC();
        for (int r = 0; r < REP_MOE1; ++r) phase_moe1(p, l, lds);
        GSYNC();
        for (int r = 0; r < REP_MOE2; ++r) phase_moe2(p, l, lds);
        GSYNC();
        phase_combine(p, l, lds, l == NLAYER - 1);
        GSYNC();
    }
    if (PROBE_IDX >= 0 && blockIdx.x == 0 && threadIdx.x == 0) {
        const float us = (float)(stamps[PROBE_IDX + 1] - stamps[PROBE_IDX]) * 0.01f;
        ((float*)tab_ld(N_IN + 1))[0] += 2.f + us / (float)PROBE_DIV;
    }
}

extern "C" void kernel_launch(void* const* d_in, const int* in_sizes, int n_in, void* d_out, int out_size, void* d_ws, size_t ws_size, hipStream_t stream) {
    static int grid_blocks = 0;
    if (!grid_blocks) {
        int dev = 0, cus = 0, per_cu = 0;
        (void)hipGetDevice(&dev);
        (void)hipDeviceGetAttribute(&cus, hipDeviceAttributeMultiprocessorCount, dev);
        if (hipFuncSetAttribute((const void*)fwd_kernel, hipFuncAttributeMaxDynamicSharedMemorySize, LDS_BYTES) != hipSuccess) fprintf(stderr, "kernel_launch: hipFuncSetAttribute failed\n");
        if (hipOccupancyMaxActiveBlocksPerMultiprocessor(&per_cu, fwd_kernel, NTHR, LDS_BYTES) != hipSuccess || per_cu < 1) { fprintf(stderr, "kernel_launch: occupancy query says %d\n", per_cu); per_cu = 1; }
        if (per_cu > 1) per_cu = 1;
        grid_blocks = cus * per_cu;
        if (ws_size < W_END * sizeof(float)) fprintf(stderr, "kernel_launch: workspace too small: %zu < %zu\n", ws_size, W_END * sizeof(float));
        if (n_in != N_IN) fprintf(stderr, "kernel_launch: n_in %d != %d\n", n_in, (int)N_IN);
    }
    Params p{};
    for (int i = 0; i < N_IN; ++i) p.in[i] = (const float*)d_in[i];
    p.out = (float*)d_out;
    p.ws = (float*)d_ws;
    void* args[] = {&p};
    hipError_t e = hipLaunchCooperativeKernel((void*)fwd_kernel, dim3(grid_blocks), dim3(NTHR), args, LDS_BYTES, stream);
    if (e != hipSuccess) fprintf(stderr, "cooperative launch failed: %s (grid %d)\n", hipGetErrorString(e), grid_blocks);
}
```

```cpp
#include <hip/hip_runtime.h>
#include <hip/hip_cooperative_groups.h>
#include <cstdio>
#include <cstdint>
namespace cg = cooperative_groups;

#define DEVI __device__ __forceinline__
constexpr int NTHR = 512;
constexpr int D = 1024, NLAT = 16384, NCTX = 256, T = NLAT + NCTX, NLAYER = 2;
constexpr int INC = 1632;
constexpr int OFF_A = 0, OFF_Q = 256, OFF_KV = 448, OFF_KR = 576, OFF_C = 608, OFF_DX = 1120, OFF_DG = 1376;
constexpr int NCHUNK = T / 128;
constexpr int NEXP = 32, TOPK = 4;
constexpr int MAXROWS = T * TOPK + NEXP * 256;
constexpr float EPS = 1e-6f;

enum { I_X = 0, I_C, I_CTX, I_CCTX, I_WMOD, I_BMOD, I_NMIX, I_NFFN, I_WIN, I_WOUT, I_POOLW, I_POOLS, I_QAN, I_WUQ, I_KVAN, I_WUKV,
       I_QN, I_KN, I_SGG, I_SGB, I_SGWS, I_SGBS, I_CONVW, I_CONVB, I_WA, I_BA, I_WX, I_BX, I_LAM, I_RW, I_RB, I_WGU, I_BGU, I_WDN, I_BDN, N_IN };

constexpr size_t al(size_t x) { return (x + 63) / 64 * 64; }
constexpr size_t W_X = 0;
constexpr size_t W_MOD = W_X + al((size_t)T * D);
constexpr size_t W_P = W_MOD + al(2 * 2 * 6144);
constexpr size_t W_YC = W_P + al((size_t)T * INC);
constexpr size_t W_Q = W_YC + al((size_t)T * D);
constexpr size_t W_K = W_Q + al((size_t)T * 384);
constexpr size_t W_V = W_K + al((size_t)T * 384);
constexpr size_t W_DIFF = W_V + al((size_t)T * 256);
constexpr size_t W_QN = W_DIFF + al((size_t)T * 256);
constexpr size_t W_KVN = W_QN + al((size_t)T * 192);
constexpr size_t W_U = W_KVN + al((size_t)T * 128);
constexpr size_t W_VN = W_U + al((size_t)T * 256);
constexpr size_t W_XC = W_VN + al((size_t)T * 256);
constexpr size_t W_QUP = W_XC + al((size_t)T * 256);
constexpr size_t W_KVUP = W_QUP + al((size_t)T * 384);
constexpr size_t W_LA = W_KVUP + al((size_t)T * 512);
constexpr size_t W_LB = W_LA + al((size_t)2 * T * 256);
constexpr size_t W_AGG = W_LB + al((size_t)2 * T * 256);
constexpr size_t W_CARRY = W_AGG + al((size_t)NCHUNK * 2 * 2 * 256);
constexpr size_t W_TOPE = W_CARRY + al((size_t)NCHUNK * 2 * 256);
constexpr size_t W_TOPG = W_TOPE + al((size_t)T * 4);
constexpr size_t W_TOPI = W_TOPG + al((size_t)T * 4);
constexpr size_t W_CNT = W_TOPI + al((size_t)T * 4);
constexpr size_t W_ACT = W_CNT + al(NLAYER * NEXP * 64);
constexpr size_t W_YR = W_ACT + al((size_t)MAXROWS * D / 2);
constexpr size_t W_XS = W_YR + al((size_t)MAXROWS * D / 2);
constexpr size_t W_HB = W_XS + al((size_t)MAXROWS * D / 2);
constexpr size_t W_XCB = W_HB + al((size_t)T * D / 2);
constexpr size_t W_WSB = W_XCB + al((size_t)T * 256 / 2);
constexpr size_t W_BAR = W_WSB + al((size_t)NLAYER * 4 * 128 * 128 / 2);
constexpr size_t W_ROPE = W_BAR + al(4096);
constexpr size_t W_LA2 = W_ROPE + al((size_t)NLAT * 32);
constexpr size_t W_LB2 = W_LA2 + al((size_t)2 * T * 256);
constexpr size_t W_SP = W_LB2 + al((size_t)2 * T * 256);
constexpr size_t W_PART = W_SP + al(NLAYER * 2 * 256);
constexpr int NPAD_IN = 1792;
constexpr size_t W_WIN = W_PART + al((size_t)4 * NCTX * D);
constexpr size_t W_WOUT = W_WIN + al((size_t)NLAYER * NPAD_IN * D / 2);
constexpr size_t W_WGU = W_WOUT + al((size_t)NLAYER * D * D / 2);
constexpr size_t W_WDN = W_WGU + al((size_t)NLAYER * NEXP * 2048 * D / 2);
constexpr size_t W_END = W_WDN + al((size_t)NLAYER * NEXP * D * D / 2);

struct Params {
    const float* in[N_IN];
    float* out;
    float* ws;
};

DEVI int tid_() { int t = threadIdx.x; asm volatile("" : "+v"(t)); return t; }
DEVI float* ws_(float* w) { unsigned long long v = (unsigned long long)w; asm volatile("" : "+s"(v)); return (float*)v; }
extern __shared__ __attribute__((aligned(16))) char g_lds[];
constexpr int RSC_OFF = 149504 + 512;
constexpr int TAB_OFF = 149504;
DEVI unsigned long long tab_ld(int i) { const unsigned long long v = ((const volatile unsigned long long*)(g_lds + TAB_OFF))[i];
    return ((unsigned long long)(unsigned)__builtin_amdgcn_readfirstlane((int)(v >> 32)) << 32) | (unsigned)__builtin_amdgcn_readfirstlane((int)v); }
#define PIN(i) ((const float*)tab_ld(i))
DEVI int bid_() { int b = blockIdx.x; asm volatile("" : "+s"(b)); return b; }
DEVI float wave_sum(float v) {
#pragma unroll
    for (int o = 32; o > 0; o >>= 1) v += __shfl_xor(v, o);
    return v;
}
DEVI float fexp(float x) { return __builtin_amdgcn_exp2f(x * 1.4426950408889634f); }
DEVI float gelu_tanh(float x) { const float u = 1.5957691216057308f * (x + 0.044715f * x * x * x); return x * __builtin_amdgcn_rcpf(1.f + fexp(-u)); }
DEVI float sigm(float x) { return 1.f / (1.f + expf(-x)); }
DEVI float silu(float x) { return x * sigm(x); }
DEVI float fsigm(float x) { return __builtin_amdgcn_rcpf(1.f + fexp(-x)); }


typedef unsigned short bf16_t;
typedef short bf16x8 __attribute__((ext_vector_type(8)));
typedef float f32x4 __attribute__((ext_vector_type(4)));
typedef unsigned u32x4 __attribute__((ext_vector_type(4)));
typedef unsigned u32x2 __attribute__((ext_vector_type(2)));
DEVI unsigned cvt_pk_bf16(float lo, float hi) { unsigned r; asm volatile("v_cvt_pk_bf16_f32 %0, %1, %2" : "=v"(r) : "v"(lo), "v"(hi)); return r; }
DEVI bf16_t f2bf(float f) { return (bf16_t)(cvt_pk_bf16(f, 0.f) & 0xffffu); }
DEVI float bf2f(bf16_t b) { return __uint_as_float(((unsigned)b) << 16); }

constexpr int G_STAGE = 49152;
constexpr int G_LDS = 2 * G_STAGE;
DEVI int swz(int row, int chunk) { return row * 128 + ((chunk ^ ((row >> 1) & 7)) << 4); }

template <bool PAIRED, class ARow, class Epi>
DEVI void gemm_unit(char* lds, int K, ARow arow, const float* __restrict__ B0, const float* __restrict__ B1, int ldb, int ncol_valid, Epi epi) {
    const int tid = tid_(), wave = tid >> 6, lane = tid & 63, fr = lane & 15, fq = lane >> 4, wr = wave >> 1, wc = wave & 1;
    const int ac = tid & 7;
    const bf16_t* ap[4]; int a_lds[4];
#pragma unroll
    for (int i = 0; i < 4; ++i) { const int r = (tid >> 3) + 64 * i; ap[i] = arow(r) + ac * 8; a_lds[i] = swz(r, ac); }
    const int kq = lane & 15, nq = (lane >> 4) + 4 * wave;
    const float* bp;
    if (PAIRED) { const int seg = (nq >> 2) & 1, idx = (nq >> 3) * 16 + (nq & 3) * 4; bp = (seg ? B1 : B0) + idx; }
    else { const int c4 = 4 * nq < ncol_valid ? 4 * nq : ncol_valid - 4; bp = B0 + c4; }
    bp += (size_t)(4 * kq) * ldb;
    int b_lds[4];
#pragma unroll
    for (int i = 0; i < 4; ++i) b_lds[i] = 32768 + swz(4 * nq + i, kq >> 1) + (kq & 1) * 8;
    const int sx = (fr >> 1) & 7;
    const int aoff0 = (wr * 64 + fr) * 128 + ((fq ^ sx) << 4), aoff1 = (wr * 64 + fr) * 128 + (((4 + fq) ^ sx) << 4);
    const int boff0 = 32768 + (wc * 64 + fr) * 128 + ((fq ^ sx) << 4), boff1 = 32768 + (wc * 64 + fr) * 128 + (((4 + fq) ^ sx) << 4);
    u32x4 av0[4], av1[4]; f32x4 bv0[4], bv1[4];
#define G_LOAD(av, bv, t) do { _Pragma("unroll") for (int i = 0; i < 4; ++i) av[i] = *(const u32x4*)(ap[i] + (t) * 64); \
        _Pragma("unroll") for (int kk = 0; kk < 4; ++kk) bv[kk] = *(const f32x4*)(bp + ((size_t)(t) * 64 + kk) * ldb); } while (0)
#define G_WRITE(s_, av, bv) do { _Pragma("unroll") for (int i = 0; i < 4; ++i) *(u32x4*)((s_) + a_lds[i]) = av[i]; \
        _Pragma("unroll") for (int i = 0; i < 4; ++i) { u32x2 w_; w_.x = cvt_pk_bf16(bv[0][i], bv[1][i]); w_.y = cvt_pk_bf16(bv[2][i], bv[3][i]); *(u32x2*)((s_) + b_lds[i]) = w_; } } while (0)
#define G_MMA(Af, Bf) do { __builtin_amdgcn_s_setprio(1); _Pragma("unroll") for (int m = 0; m < 4; ++m) _Pragma("unroll") for (int n = 0; n < 4; ++n) \
        acc[m][n] = __builtin_amdgcn_mfma_f32_16x16x32_bf16(Bf[n], Af[m], acc[m][n], 0, 0, 0); __builtin_amdgcn_s_setprio(0); } while (0)
#define G_SB() __builtin_amdgcn_sched_barrier(0)
#define G_ITER(t, c_, n_, av, bv, W_, L_) do { \
        bf16x8 Af[4], Bf[4]; \
        _Pragma("unroll") for (int m = 0; m < 4; ++m) Af[m] = *(const bf16x8*)((c_) + aoff0 + m * 2048); \
        _Pragma("unroll") for (int n = 0; n < 4; ++n) Bf[n] = *(const bf16x8*)((c_) + boff0 + n * 2048); \
        G_SB(); asm volatile("s_waitcnt lgkmcnt(0)" ::: "memory"); G_SB(); \
        G_MMA(Af, Bf); G_SB(); \
        _Pragma("unroll") for (int m = 0; m < 4; ++m) Af[m] = *(const bf16x8*)((c_) + aoff1 + m * 2048); \
        _Pragma("unroll") for (int n = 0; n < 4; ++n) Bf[n] = *(const bf16x8*)((c_) + boff1 + n * 2048); \
        G_SB(); \
        if (W_) { G_WRITE(n_, av, bv); G_SB(); asm volatile("s_waitcnt lgkmcnt(8)" ::: "memory"); } else { asm volatile("s_waitcnt lgkmcnt(0)" ::: "memory"); } \
        G_SB(); \
        G_MMA(Af, Bf); G_SB(); \
        if (L_) G_LOAD(av, bv, (t) + 3); \
        G_SB(); asm volatile("s_waitcnt lgkmcnt(0)" ::: "memory"); __builtin_amdgcn_s_barrier(); G_SB(); } while (0)
    f32x4 acc[4][4];
#pragma unroll
    for (int m = 0; m < 4; ++m)
#pragma unroll
        for (int n = 0; n < 4; ++n) acc[m][n] = (f32x4){0.f, 0.f, 0.f, 0.f};
    const int nk = K >> 6;
    char* L0 = lds; char* L1 = lds + G_STAGE;
    G_LOAD(av0, bv0, 0);
    G_WRITE(L0, av0, bv0);
    if (nk > 1) G_LOAD(av1, bv1, 1);
    if (nk > 2) G_LOAD(av0, bv0, 2);
    asm volatile("s_waitcnt lgkmcnt(0)" ::: "memory"); __builtin_amdgcn_s_barrier(); G_SB();
    int t = 0;
    for (; t + 4 < nk; t += 2) {
        G_ITER(t, L0, L1, av1, bv1, true, true);
        G_ITER(t + 1, L1, L0, av0, bv0, true, true);
    }
    for (; t < nk; t += 2) {
        G_ITER(t, L0, L1, av1, bv1, t + 1 < nk, t + 3 < nk);
        if (t + 1 < nk) G_ITER(t + 1, L1, L0, av0, bv0, t + 2 < nk, t + 4 < nk);
    }
#undef G_LOAD
#undef G_WRITE
#undef G_MMA
#undef G_ITER
#undef G_SB
    epi(acc, wr, wc, fr, fq);
}


#define PG8_LAS __attribute__((address_space(3)))
namespace pg8 {
constexpr int BM = 256, BK = 64, HALF = 128, HTB = HALF * BK * 2, STAGE_BYTES = 8 * HTB;
DEVI int lds_byte(int r, int c) { const int st = (r >> 4) * 2 + (c >> 5), rr = r & 15, cc = c & 31, ob = rr * 64 + cc * 2; return st * 1024 + (ob ^ (((ob >> 9) & 1) << 5)); }
DEVI void stage_rc(int b, int& R, int& C) { const int st = b / 1024, sb = b % 1024, swz_ = sb ^ (((sb >> 9) & 1) << 5); R = (st >> 1) * 16 + swz_ / 64; C = (st & 1) * 32 + (swz_ % 64) / 2; }
DEVI int perm32(int rho) { const int n = rho >> 4, i = rho & 15; return 8 * (i >> 2) + 4 * n + (i & 3); }
struct Unit { const char* a; const char* b; int x0, x1, x2; const int* g; int gn; };
template <class Epi, class Sched, bool GATHER = false>
DEVI void gemm_phase(PG8_LAS unsigned char* lds, int K, size_t hstepB, const Sched& S, const Epi& E, int ktiles = 0, const char* Abase = nullptr) {
    const int tid = tid_(), wid = __builtin_amdgcn_readfirstlane(tid >> 6), lane = tid & 63, wr = wid >> 2, wc = wid & 3, fr = lane & 15, fq = lane >> 4;
    const int nt = ktiles ? ktiles : K / BK;
    unsigned voffA[2], voffB[2]; int Rr[2], Cc[2];
#pragma unroll
    for (int i = 0; i < 2; ++i) { int R, C; stage_rc(tid * 16 + i * 8192, R, C); const int Rb = Epi::PERM ? ((R & ~31) + perm32(R & 31)) : R; Rr[i] = R; Cc[i] = C;
        voffA[i] = (unsigned)(R * K + C) * 2u; voffB[i] = (unsigned)(Rb * K + C) * 2u; }
    unsigned offc[2][2], offn[2][2];
#define PG8_GOFF(dst, u_) do { _Pragma("unroll") for (int h_ = 0; h_ < 2; ++h_) _Pragma("unroll") for (int i_ = 0; i_ < 2; ++i_) { const int r_ = h_ * HALF + Rr[i_]; \
        const int row_ = (u_).g[r_ < (u_).gn ? r_ : 0]; dst[h_][i_] = (unsigned)(row_ * K + Cc[i_]) * 2u; } } while (0)
#define PG8_STAGE_A(bufoff, ptr, h_, offs, kb) do { if (GATHER) PG8_STAGE(bufoff, Abase + (kb), offs[h_]); else PG8_STAGE(bufoff, ptr, voffA); } while (0)
    const size_t kstep = (size_t)(BK * 2);
    const size_t hstep = (size_t)HALF * K * 2;
    const unsigned ldsw = (unsigned)wid * 1024u;
    const int aoff = lds_byte(wr * 64 + fr, fq * 8), boff = lds_byte(wc * 32 + fr, fq * 8);
#define PG8_SA(b, h) (((b) * 2 + (h)) * HTB)
#define PG8_SB(b, h) ((4 + (b) * 2 + (h)) * HTB)
#define PG8_STAGE(bufoff, gbase, voff) do { _Pragma("unroll") for (int _i = 0; _i < 2; ++_i) \
        __builtin_amdgcn_global_load_lds((const unsigned*)((const char*)(gbase) + (voff)[_i]), (PG8_LAS unsigned*)(lds + (bufoff) + ldsw + _i * 8192), 16, 0, 0); } while (0)
#define PG8_LDA(dst, b, h) do { _Pragma("unroll") for (int m = 0; m < 4; ++m) _Pragma("unroll") for (int k = 0; k < 2; ++k) dst[m][k] = *(const PG8_LAS bf16x8*)(lds + PG8_SA(b, h) + aoff + m * 2048 + k * 1024); } while (0)
#define PG8_LDB(dst, b, h) do { _Pragma("unroll") for (int n = 0; n < 2; ++n) _Pragma("unroll") for (int k = 0; k < 2; ++k) dst[n][k] = *(const PG8_LAS bf16x8*)(lds + PG8_SB(b, h) + boff + n * 2048 + k * 1024); } while (0)
#define PG8_MMA(ai, bj, At, Bt) do { __builtin_amdgcn_s_setprio(1); _Pragma("unroll") for (int m = 0; m < 4; ++m) _Pragma("unroll") for (int n = 0; n < 2; ++n) _Pragma("unroll") for (int k = 0; k < 2; ++k) \
        acc[ai][bj][m][n] = __builtin_amdgcn_mfma_f32_16x16x32_bf16(Bt[n][k], At[m][k], acc[ai][bj][m][n], 0, 0, 0); __builtin_amdgcn_s_setprio(0); } while (0)
#define PG8_WAIT_V(n) asm volatile("s_waitcnt vmcnt(" #n ")" ::: "memory")
#define PG8_WAIT_L(n) asm volatile("s_waitcnt lgkmcnt(" #n ")" ::: "memory")
#define PG8_BAR __builtin_amdgcn_s_barrier()
#define PG8_SCHED __builtin_amdgcn_sched_barrier(0)
    Unit cur, nxt; int ui = 0;
    if (!S.next(0, cur)) return;
    f32x4 acc[2][2][4][2];
#pragma unroll
    for (int a = 0; a < 2; ++a)
#pragma unroll
        for (int b = 0; b < 2; ++b)
#pragma unroll
            for (int m = 0; m < 4; ++m)
#pragma unroll
                for (int n = 0; n < 2; ++n) acc[a][b][m][n] = (f32x4){0.f, 0.f, 0.f, 0.f};
    bf16x8 At[4][2], B0[2][2], B1[2][2];
    const char* cA = cur.a; const char* cB = cur.b;
    if (GATHER) { PG8_GOFF(offc, cur); asm volatile("s_waitcnt vmcnt(0)" ::: "memory"); }
    PG8_STAGE(PG8_SB(0, 0), cB, voffB); PG8_STAGE_A(PG8_SA(0, 0), cA, 0, offc, 0); PG8_STAGE(PG8_SB(0, 1), cB + hstepB, voffB); PG8_STAGE_A(PG8_SA(0, 1), cA + hstep, 1, offc, 0);
    if (wr == 1) PG8_BAR;
    PG8_WAIT_V(4); PG8_BAR;
    PG8_STAGE(PG8_SB(1, 0), cB + kstep, voffB); PG8_STAGE_A(PG8_SA(1, 0), cA + kstep, 0, offc, kstep); PG8_STAGE(PG8_SB(1, 1), cB + hstepB + kstep, voffB);
    PG8_WAIT_V(6); PG8_BAR;
    for (;;) {
        const bool has_next = S.next(ui + 1, nxt);
        const char* nA = has_next ? nxt.a : cA; const char* nB = has_next ? nxt.b : cB;
        if (GATHER) { if (has_next) PG8_GOFF(offn, nxt); else {
#pragma unroll
            for (int h_ = 0; h_ < 2; ++h_)
#pragma unroll
                for (int i_ = 0; i_ < 2; ++i_) offn[h_][i_] = offc[h_][i_]; } }
        for (int t = 0; t < nt; t += 2) {
            const bool last = (t == nt - 2);
            const char* a1 = cA + (size_t)(t + 1) * kstep;
            const char* a2 = last ? nA : cA + (size_t)(t + 2) * kstep; const char* b2 = last ? nB : cB + (size_t)(t + 2) * kstep;
            const char* a3 = a2 + kstep; const char* b3 = b2 + kstep;
            unsigned o2[2][2]; const size_t k1 = (size_t)(t + 1) * kstep, k2 = last ? 0 : (size_t)(t + 2) * kstep, k3 = k2 + kstep;
            if (GATHER) {
                if (last) { asm volatile("" ::: "memory");
#pragma unroll
                    for (int h_ = 0; h_ < 2; ++h_)
#pragma unroll
                        for (int i_ = 0; i_ < 2; ++i_) o2[h_][i_] = offn[h_][i_]; }
                else {
#pragma unroll
                    for (int h_ = 0; h_ < 2; ++h_)
#pragma unroll
                        for (int i_ = 0; i_ < 2; ++i_) o2[h_][i_] = offc[h_][i_]; } }
            PG8_LDB(B0, 0, 0); PG8_SCHED; PG8_LDA(At, 0, 0); PG8_STAGE_A(PG8_SA(1, 1), a1 + hstep, 1, offc, k1);
            PG8_WAIT_L(8); PG8_BAR; PG8_WAIT_L(0); PG8_MMA(0, 0, At, B0); PG8_BAR; PG8_SCHED;
            PG8_LDB(B1, 0, 1); PG8_STAGE(PG8_SB(0, 0), b2, voffB);
            PG8_BAR; PG8_WAIT_L(0); PG8_MMA(0, 1, At, B1); PG8_BAR;
            PG8_LDA(At, 0, 1); PG8_STAGE_A(PG8_SA(0, 0), a2, 0, o2, k2);
            PG8_BAR; PG8_WAIT_L(0); PG8_MMA(1, 0, At, B0); PG8_BAR; PG8_SCHED;
            PG8_STAGE(PG8_SB(0, 1), b2 + hstepB, voffB);
            PG8_WAIT_V(6); PG8_BAR; PG8_MMA(1, 1, At, B1); PG8_BAR;
            PG8_LDB(B0, 1, 0); PG8_SCHED; PG8_LDA(At, 1, 0); PG8_STAGE_A(PG8_SA(0, 1), a2 + hstep, 1, o2, k2);
            PG8_WAIT_L(8); PG8_BAR; PG8_WAIT_L(0); PG8_MMA(0, 0, At, B0); PG8_BAR; PG8_SCHED;
            PG8_LDB(B1, 1, 1); PG8_STAGE(PG8_SB(1, 0), b3, voffB);
            PG8_BAR; PG8_WAIT_L(0); PG8_MMA(0, 1, At, B1); PG8_BAR;
            PG8_LDA(At, 1, 1); PG8_STAGE_A(PG8_SA(1, 0), a3, 0, o2, k3);
            PG8_BAR; PG8_WAIT_L(0); PG8_MMA(1, 0, At, B0); PG8_BAR; PG8_SCHED;
            PG8_STAGE(PG8_SB(1, 1), b3 + hstepB, voffB);
            PG8_WAIT_V(6); PG8_BAR; PG8_MMA(1, 1, At, B1); PG8_BAR;
        }
        E(acc, cur, wr, wc, fr, fq);
        if (!has_next) break;
#pragma unroll
        for (int a = 0; a < 2; ++a)
#pragma unroll
            for (int b = 0; b < 2; ++b)
#pragma unroll
                for (int m = 0; m < 4; ++m)
#pragma unroll
                    for (int n = 0; n < 2; ++n) acc[a][b][m][n] = (f32x4){0.f, 0.f, 0.f, 0.f};
        cur = nxt; cA = nA; cB = nB; ++ui;
        if (GATHER) {
#pragma unroll
            for (int h_ = 0; h_ < 2; ++h_)
#pragma unroll
                for (int i_ = 0; i_ < 2; ++i_) offc[h_][i_] = offn[h_][i_]; }
    }
    PG8_WAIT_V(0);
    if (wr == 0) PG8_BAR;
    PG8_BAR;
#undef PG8_SA
#undef PG8_SB
#undef PG8_STAGE
#undef PG8_STAGE_A
#undef PG8_GOFF
#undef PG8_LDA
#undef PG8_LDB
#undef PG8_MMA
#undef PG8_WAIT_V
#undef PG8_WAIT_L
#undef PG8_BAR
#undef PG8_SCHED
}
}

DEVI void conv_item(const float* __restrict__ W, int K, int N, bf16_t* __restrict__ Wt, int kb, int nb, int lane) {
    const int ko = lane & 7, nq = lane >> 3;
    const float* src = W + (size_t)(kb * 64 + ko * 8) * N + nb * 32 + nq * 4;
    f32x4 v[8];
#pragma unroll
    for (int kk = 0; kk < 8; ++kk) v[kk] = *(const f32x4*)(src + (size_t)kk * N);
    bf16_t* dst = Wt + (size_t)(nb * 32 + nq * 4) * K + kb * 64 + ko * 8;
#pragma unroll
    for (int i = 0; i < 4; ++i) { u32x4 o; o.x = cvt_pk_bf16(v[0][i], v[1][i]); o.y = cvt_pk_bf16(v[2][i], v[3][i]); o.z = cvt_pk_bf16(v[4][i], v[5][i]); o.w = cvt_pk_bf16(v[6][i], v[7][i]);
        *(u32x4*)(dst + (size_t)i * K) = o; }
}

namespace att {
typedef short s16x4 __attribute__((ext_vector_type(4)));
typedef float f32x16 __attribute__((ext_vector_type(16)));
constexpr int KVBLK = 64;
constexpr float SCALE = 0.10206207261596577f;
constexpr float THR = 8.f;
constexpr int SHM_V = 16384, SHM_K = 16384, SHM_ATTN = 2 * SHM_V + 2 * SHM_K + 8 * 64 * 4;
#define KSWZ(row, colB) ((row) * 256 + ((colB) ^ (((row) & 7) << 4)))
#define SBAR() __builtin_amdgcn_sched_barrier(0)
DEVI int crow(int r, int hi) { return (r & 3) + 8 * (r >> 2) + 4 * hi; }
DEVI void partialSM(f32x16& p0, f32x16& p1, float& m_reg, float& mn, float& alpha) {
    constexpr float C = SCALE * 1.4426950408889634f;
    float pmax = p0[0];
#pragma unroll
    for (int r = 1; r < 16; ++r) pmax = fmaxf(pmax, p0[r]);
#pragma unroll
    for (int r = 0; r < 16; ++r) pmax = fmaxf(pmax, p1[r]);
    { auto rr = __builtin_amdgcn_permlane32_swap(__float_as_uint(pmax), __float_as_uint(pmax), false, false);
      pmax = fmaxf(__uint_as_float(rr[0]), __uint_as_float(rr[1])); }
    if (__builtin_expect(__all(pmax - m_reg <= THR / SCALE), 1)) { mn = m_reg; alpha = 1.f; }
    else { mn = fmaxf(m_reg, pmax); alpha = __builtin_amdgcn_exp2f((m_reg - mn) * C); m_reg = mn; }
    const float mnC = -mn * C;
#pragma unroll
    for (int r = 0; r < 16; ++r) p0[r] = fmaf(p0[r], C, mnC);
#pragma unroll
    for (int r = 0; r < 16; ++r) p1[r] = fmaf(p1[r], C, mnC);
#pragma unroll
    for (int r = 0; r < 16; ++r) p0[r] = __builtin_amdgcn_exp2f(p0[r]);
}
DEVI void finishSM(f32x16& p0, f32x16& p1, float alpha, float& l_reg, bf16x8& pa0, bf16x8& pa1, bf16x8& pa2, bf16x8& pa3) {
#pragma unroll
    for (int r = 0; r < 16; ++r) p1[r] = __builtin_amdgcn_exp2f(p1[r]);
    float ps = 0.f;
#pragma unroll
    for (int r = 0; r < 16; ++r) ps += p0[r];
#pragma unroll
    for (int r = 0; r < 16; ++r) ps += p1[r];
    { auto rr = __builtin_amdgcn_permlane32_swap(__float_as_uint(ps), __float_as_uint(ps), false, false);
      ps = __uint_as_float(rr[0]) + __uint_as_float(rr[1]); }
    l_reg = l_reg * alpha + ps;
#define PK4(P, BASE, OUT) do { unsigned a0 = cvt_pk_bf16(P[BASE + 0], P[BASE + 1]), a1 = cvt_pk_bf16(P[BASE + 2], P[BASE + 3]);   \
    unsigned b0 = cvt_pk_bf16(P[BASE + 4], P[BASE + 5]), b1 = cvt_pk_bf16(P[BASE + 6], P[BASE + 7]);                              \
    auto r0 = __builtin_amdgcn_permlane32_swap(a0, b0, false, false); auto r1 = __builtin_amdgcn_permlane32_swap(a1, b1, false, false); \
    u32x4 w = {r0[0], r1[0], r0[1], r1[1]}; OUT = *reinterpret_cast<bf16x8*>(&w); } while (0)
    PK4(p0, 0, pa0); PK4(p0, 8, pa1); PK4(p1, 0, pa2); PK4(p1, 8, pa3);
#undef PK4
}
DEVI void qkt(f32x16& p0, f32x16& p1, const char* Ks, const bf16x8* qr, int r32, int hi) {
    p0 = f32x16{}; p1 = f32x16{};
#pragma unroll
    for (int d0 = 0; d0 < 6; ++d0) { const int cb = (d0 * 16 + hi * 8) * 2;
        const bf16x8 b0 = *reinterpret_cast<const bf16x8*>(Ks + KSWZ(r32, cb));
        const bf16x8 b1 = *reinterpret_cast<const bf16x8*>(Ks + KSWZ(32 + r32, cb));
        p0 = __builtin_amdgcn_mfma_f32_32x32x16_bf16(b0, qr[d0], p0, 0, 0, 0);
        p1 = __builtin_amdgcn_mfma_f32_32x32x16_bf16(b1, qr[d0], p1, 0, 0, 0); }
}
DEVI int v_st(int k, int c) { const int kk = (k & ~0xC) | ((k & 4) << 1) | ((k & 8) >> 1); return ((kk >> 3) * 4 + (c >> 5)) * 512 + ((kk & 7) * 32 + (c & 31)) * 2; }
DEVI int v_rd_base(int lane) { return ((lane & 3) << 3) | (((lane >> 2) & 3) << 6) | (((lane >> 4) & 1) << 5) | (((lane >> 5) & 1) << 8); }
constexpr int v_rd_off(int d0, int ks, int half) { return d0 * 512 + ks * 4096 + half * 2048; }
template <int OFF> DEVI s16x4 tr_read(int vb) {
    s16x4 r; asm volatile("ds_read_b64_tr_b16 %0, %1 offset:%2" : "=&v"(r) : "v"(vb), "i"(OFF) : "memory"); return r;
}
template <int D0> DEVI void pv_one(f32x16& od, int vb, bf16x8 pa0, bf16x8 pa1, bf16x8 pa2, bf16x8 pa3) {
    const s16x4 l0 = tr_read<v_rd_off(D0, 0, 0)>(vb), h0 = tr_read<v_rd_off(D0, 0, 1)>(vb), l1 = tr_read<v_rd_off(D0, 1, 0)>(vb), h1 = tr_read<v_rd_off(D0, 1, 1)>(vb);
    const s16x4 l2 = tr_read<v_rd_off(D0, 2, 0)>(vb), h2 = tr_read<v_rd_off(D0, 2, 1)>(vb), l3 = tr_read<v_rd_off(D0, 3, 0)>(vb), h3 = tr_read<v_rd_off(D0, 3, 1)>(vb);
    asm volatile("s_waitcnt lgkmcnt(0)" ::: "memory"); SBAR();
#define PKV(L, H) (bf16x8){L[0], L[1], L[2], L[3], H[0], H[1], H[2], H[3]}
    od = __builtin_amdgcn_mfma_f32_32x32x16_bf16(pa0, PKV(l0, h0), od, 0, 0, 0);
    od = __builtin_amdgcn_mfma_f32_32x32x16_bf16(pa1, PKV(l1, h1), od, 0, 0, 0);
    od = __builtin_amdgcn_mfma_f32_32x32x16_bf16(pa2, PKV(l2, h2), od, 0, 0, 0);
    od = __builtin_amdgcn_mfma_f32_32x32x16_bf16(pa3, PKV(l3, h3), od, 0, 0, 0);
#undef PKV
}
DEVI void pv_d0(f32x16* o, int vb, bf16x8 pa0, bf16x8 pa1, bf16x8 pa2, bf16x8 pa3) {
    pv_one<0>(o[0], vb, pa0, pa1, pa2, pa3); pv_one<1>(o[1], vb, pa0, pa1, pa2, pa3);
}
DEVI void attn_unit(const bf16_t* __restrict__ Qb, const bf16_t* __restrict__ Kh, const bf16_t* __restrict__ Vh, int seq, bf16_t* __restrict__ Ob, int ldo, char* lds) {
    const int tid = tid_(), wid = tid >> 6, lane = tid & 63, r32 = lane & 31, hi = lane >> 5;
    char* V_lds = lds; char* K_lds = lds + 2 * SHM_V;
    float* wsl = (float*)(lds + 2 * SHM_V + 2 * SHM_K) + wid * 64; float* li_l = wsl; float* al_l = wsl + 32;
    float m_reg = -1e30f, l_reg = 0.f; f32x16 o[2] = {}; bf16x8 qr[6];
    const bf16_t* Qw = Qb + (size_t)(wid * 32 + r32) * 96 + hi * 8;
#pragma unroll
    for (int d0 = 0; d0 < 6; ++d0) qr[d0] = *reinterpret_cast<const bf16x8*>(Qw + d0 * 16);
    const int sr = tid >> 4, kc = tid & 15, kcl = (kc < 12 ? kc : 11) * 8;
    const int vr = tid >> 3, vc = (tid & 7) * 8, vst0 = v_st(vr, vc);
    const int kst0 = KSWZ(sr, kc * 16), kst1 = KSWZ(32 + sr, kc * 16);
    const int vb0 = (int)(uintptr_t)V_lds + v_rd_base(lane);
    bf16x8 sv0, sk00, sk01, sv1, sk10, sk11;
#define SLOAD0(k0) do { sv0 = *reinterpret_cast<const bf16x8*>(Vh + (size_t)((k0) + vr) * 64 + vc); sk00 = *reinterpret_cast<const bf16x8*>(Kh + (size_t)((k0) + sr) * 96 + kcl); \
    sk01 = *reinterpret_cast<const bf16x8*>(Kh + (size_t)((k0) + 32 + sr) * 96 + kcl); } while (0)
#define SLOAD1(k0) do { sv1 = *reinterpret_cast<const bf16x8*>(Vh + (size_t)((k0) + vr) * 64 + vc); sk10 = *reinterpret_cast<const bf16x8*>(Kh + (size_t)((k0) + sr) * 96 + kcl); \
    sk11 = *reinterpret_cast<const bf16x8*>(Kh + (size_t)((k0) + 32 + sr) * 96 + kcl); } while (0)
#define SWRITE0(b) do { *(bf16x8*)(V_lds + (b) * SHM_V + vst0) = sv0; *(bf16x8*)(K_lds + (b) * SHM_K + kst0) = sk00; *(bf16x8*)(K_lds + (b) * SHM_K + kst1) = sk01; } while (0)
#define SWRITE1(b) do { *(bf16x8*)(V_lds + (b) * SHM_V + vst0) = sv1; *(bf16x8*)(K_lds + (b) * SHM_K + kst0) = sk10; *(bf16x8*)(K_lds + (b) * SHM_K + kst1) = sk11; } while (0)
#define SWAIT() asm volatile("s_waitcnt vmcnt(3)" ::: "memory")
#define RESC(a) do { if (__any((a) < 1.f)) { if (hi == 0) al_l[r32] = (a); asm volatile("s_waitcnt lgkmcnt(0)" ::: "memory"); \
    _Pragma("unroll") for (int d = 0; d < 2; ++d) _Pragma("unroll") for (int r = 0; r < 16; ++r) o[d][r] *= al_l[crow(r, hi)]; } } while (0)
    f32x16 pA0, pA1, pB0, pB1; float mnA, mnB, alA, alB; bf16x8 pa0, pa1, pa2, pa3; const int NT = seq / KVBLK;
    SLOAD0(0); asm volatile("s_waitcnt vmcnt(0)" ::: "memory"); SWRITE0(0); __syncthreads();
    qkt(pA0, pA1, K_lds, qr, r32, hi); partialSM(pA0, pA1, m_reg, mnA, alA);
    SLOAD1(KVBLK); if (2 < NT) SLOAD0(2 * KVBLK);
    SWAIT(); SWRITE1(1); __syncthreads();
    for (int j = 1; j + 1 < NT; j += 2) {
        SBAR(); qkt(pB0, pB1, K_lds + SHM_K, qr, r32, hi);
        finishSM(pA0, pA1, alA, l_reg, pa0, pa1, pa2, pa3); SBAR();
        SLOAD1((j + 2) * KVBLK); SBAR();
        pv_d0(o, vb0, pa0, pa1, pa2, pa3); partialSM(pB0, pB1, m_reg, mnB, alB);
        __syncthreads(); SWAIT(); SWRITE0(0);
        RESC(alB); __syncthreads();
        SBAR(); qkt(pA0, pA1, K_lds, qr, r32, hi);
        finishSM(pB0, pB1, alB, l_reg, pa0, pa1, pa2, pa3); SBAR();
        if (j + 3 < NT) SLOAD0((j + 3) * KVBLK); SBAR();
        pv_d0(o, vb0 + SHM_V, pa0, pa1, pa2, pa3); partialSM(pA0, pA1, m_reg, mnA, alA);
        __syncthreads(); SWAIT(); SWRITE1(1);
        RESC(alA); __syncthreads();
    }
    SBAR(); qkt(pB0, pB1, K_lds + SHM_K, qr, r32, hi);
    finishSM(pA0, pA1, alA, l_reg, pa0, pa1, pa2, pa3); SBAR();
    pv_d0(o, vb0, pa0, pa1, pa2, pa3); partialSM(pB0, pB1, m_reg, mnB, alB);
    __syncthreads(); RESC(alB);
    finishSM(pB0, pB1, alB, l_reg, pa0, pa1, pa2, pa3); SBAR();
    pv_d0(o, vb0 + SHM_V, pa0, pa1, pa2, pa3);
    if (hi == 0) li_l[r32] = l_reg; asm volatile("s_waitcnt lgkmcnt(0)" ::: "memory");
    float rli[16];
#pragma unroll
    for (int r = 0; r < 16; ++r) rli[r] = __builtin_amdgcn_rcpf(li_l[crow(r, hi)]);
    bf16_t* Ow = Ob + (size_t)(wid * 32) * ldo;
#pragma unroll
    for (int r = 0; r < 16; ++r) { const int orow = crow(r, hi);
#pragma unroll
        for (int d0 = 0; d0 < 2; ++d0) Ow[(size_t)orow * ldo + d0 * 32 + r32] = f2bf(o[d0][r] * rli[r]); }
    __syncthreads();
#undef SLOAD0
#undef SLOAD1
#undef SWRITE0
#undef SWRITE1
#undef SWAIT
#undef RESC
}
#undef KSWZ
#undef SBAR
}

template <class ARow, class BMap, class Epi>
DEVI void gemm_tile(int K, ARow arow, const float* __restrict__ B, int ldb, BMap bmap, Epi epi, float* smem) {
    float (*As)[132] = (float (*)[132])smem;
    float (*Bs)[64] = (float (*)[64])(smem + 16 * 132);
    const int tid = tid_(), ty = tid >> 4, tx = tid & 15;
    float acc[4][4];
#pragma unroll
    for (int i = 0; i < 4; ++i)
#pragma unroll
        for (int j = 0; j < 4; ++j) acc[i][j] = 0.f;
    const int ar = tid >> 2, akq = tid & 3;
    const float* ap = arow(ar);
    const int bk0 = tid >> 6, bc = tid & 63;
    const int bcol = bmap(bc);
    for (int k0 = 0; k0 < K; k0 += 16) {
        float4 av = make_float4(0.f, 0.f, 0.f, 0.f);
        if (ap) av = *(const float4*)(ap + k0 + akq * 4);
        float b0 = 0.f, b1 = 0.f;
        if (bcol >= 0) { b0 = B[(size_t)(k0 + bk0) * ldb + bcol]; b1 = B[(size_t)(k0 + bk0 + 8) * ldb + bcol]; }
        __syncthreads();
        As[akq * 4 + 0][ar] = av.x; As[akq * 4 + 1][ar] = av.y; As[akq * 4 + 2][ar] = av.z; As[akq * 4 + 3][ar] = av.w;
        Bs[bk0][bc] = b0; Bs[bk0 + 8][bc] = b1;
        __syncthreads();
#pragma unroll
        for (int kk = 0; kk < 16; ++kk) {
            const float4 a = *(const float4*)&As[kk][ty * 4];
            const float4 b = *(const float4*)&Bs[kk][tx * 4];
            const float aa[4] = {a.x, a.y, a.z, a.w}, bb[4] = {b.x, b.y, b.z, b.w};
#pragma unroll
            for (int i = 0; i < 4; ++i)
#pragma unroll
                for (int j = 0; j < 4; ++j) acc[i][j] = fmaf(aa[i], bb[j], acc[i][j]);
        }
    }
#pragma unroll
    for (int i = 0; i < 4; ++i) epi(ty * 4 + i, tx, acc[i]);
    __syncthreads();
}


struct UnitRange { int lo, hi, step; };
DEVI UnitRange unit_range(int nunits, int bid) {
    UnitRange r;
    if ((gridDim.x & 7) == 0) { const int x = bid & 7, j = bid >> 3; r.lo = (int)(((long)nunits * x) >> 3) + j; r.hi = (int)(((long)nunits * (x + 1)) >> 3); r.step = gridDim.x >> 3; }
    else { r.lo = bid; r.hi = nunits; r.step = gridDim.x; }
    return r;
}

__device__ void phase_convert(const Params& p) {
    float* const ws = (float*)tab_ld(N_IN);
    const float* const pin_I_WIN = PIN(I_WIN);
    const float* const pin_I_WOUT = PIN(I_WOUT);
    const int tid = tid_(), bid = bid_();
    const int lane = tid & 63, gw = bid * (NTHR / 64) + __builtin_amdgcn_readfirstlane(tid >> 6), nw = gridDim.x * (NTHR / 64);
    constexpr int NI_OUT = NLAYER * 16 * 32, NI_IN = NLAYER * 16 * 51;
    bf16_t* wout = (bf16_t*)(ws + W_WOUT); bf16_t* win = (bf16_t*)(ws + W_WIN);
    for (int it = gw; it < NI_OUT + NI_IN; it += nw) {
        int r = it;
        if (r < NI_OUT) { const int mat = r >> 9, q = r & 511; conv_item(pin_I_WOUT + (size_t)mat * D * D, D, D, wout + (size_t)mat * D * D, q >> 5, q & 31, lane); continue; }
        r -= NI_OUT;
        { const int mat = r / 816, q = r % 816; conv_item(pin_I_WIN + (size_t)mat * D * INC, D, INC, win + (size_t)mat * NPAD_IN * D, q / 51, q % 51, lane); }
    }
}
DEVI void conv_item2(const float* __restrict__ W0, int N0, bf16_t* __restrict__ T0, int kb0, int nb0, const float* __restrict__ W1, int N1, bf16_t* __restrict__ T1, int kb1, int nb1, int lane) {
    constexpr int K = D;
    const int ko = lane & 7, nq = lane >> 3;
    const float* s0 = W0 + (size_t)(kb0 * 64 + ko * 8) * N0 + nb0 * 32 + nq * 4; const float* s1 = W1 + (size_t)(kb1 * 64 + ko * 8) * N1 + nb1 * 32 + nq * 4;
    f32x4 v[8], w[8];
#pragma unroll
    for (int kk = 0; kk < 8; ++kk) v[kk] = *(const f32x4*)(s0 + (size_t)kk * N0);
#pragma unroll
    for (int kk = 0; kk < 8; ++kk) w[kk] = *(const f32x4*)(s1 + (size_t)kk * N1);
    bf16_t* d0 = T0 + (size_t)(nb0 * 32 + nq * 4) * K + kb0 * 64 + ko * 8; bf16_t* d1 = T1 + (size_t)(nb1 * 32 + nq * 4) * K + kb1 * 64 + ko * 8;
#pragma unroll
    for (int i = 0; i < 4; ++i) { u32x4 o; o.x = cvt_pk_bf16(v[0][i], v[1][i]); o.y = cvt_pk_bf16(v[2][i], v[3][i]); o.z = cvt_pk_bf16(v[4][i], v[5][i]); o.w = cvt_pk_bf16(v[6][i], v[7][i]);
        *(u32x4*)(d0 + (size_t)i * K) = o; }
#pragma unroll
    for (int i = 0; i < 4; ++i) { u32x4 o; o.x = cvt_pk_bf16(w[0][i], w[1][i]); o.y = cvt_pk_bf16(w[2][i], w[3][i]); o.z = cvt_pk_bf16(w[4][i], w[5][i]); o.w = cvt_pk_bf16(w[6][i], w[7][i]);
        *(u32x4*)(d1 + (size_t)i * K) = o; }
}
constexpr int NI_MOE = NEXP * 16 * 64 + NEXP * 16 * 32;
__device__ void conv_moe(const Params& p, int l, int quota) {
    float* const ws = (float*)tab_ld(N_IN);
    const float* const pin_I_WDN = PIN(I_WDN);
    const float* const pin_I_WGU = PIN(I_WGU);
    const int tid = tid_(), bid = bid_();
    const int lane = tid & 63;
    int* cursor = (int*)(ws + W_BAR) + 3584 + l * 64;
    bf16_t* wgu = (bf16_t*)(ws + W_WGU) + (size_t)l * NEXP * 2048 * D; bf16_t* wdn = (bf16_t*)(ws + W_WDN) + (size_t)l * NEXP * D * D;
    const float* sgu = pin_I_WGU + (size_t)l * NEXP * D * 2048; const float* sdn = pin_I_WDN + (size_t)l * NEXP * D * D;
#define CONV_DEC(it, S_, N_, T_, KB_, NB_) const float* S_; bf16_t* T_; int N_, KB_, NB_; \
        if ((it) < NEXP * 1024) { const int mat = (it) >> 10, q = (it) & 1023; S_ = sgu + (size_t)mat * D * 2048; N_ = 2048; T_ = wgu + (size_t)mat * 2048 * D; KB_ = q >> 6; NB_ = q & 63; } \
        else { const int r_ = (it) - NEXP * 1024, mat = r_ >> 9, q = r_ & 511; S_ = sdn + (size_t)mat * D * D; N_ = D; T_ = wdn + (size_t)mat * D * D; KB_ = q >> 5; NB_ = q & 31; }
#define CONV_PAIR(i0, i1) do { CONV_DEC(i0, sa_, na_, ta_, ka_, ba_) CONV_DEC(i1, sb_, nb_, tb_, kb_, bb_) conv_item2(sa_, na_, ta_, ka_, ba_, sb_, nb_, tb_, kb_, bb_, lane); } while (0)
    if (quota > 0) {
        int c0 = 0;
        if (lane == 0) c0 = atomicAdd(cursor, quota);
        c0 = __builtin_amdgcn_readfirstlane(c0);
        for (int it = c0; it < c0 + quota && it + 1 < NI_MOE; it += 2) CONV_PAIR(it, it + 1);
    } else {
        int c0 = __hip_atomic_load(cursor, __ATOMIC_RELAXED, __HIP_MEMORY_SCOPE_AGENT);
        c0 = __builtin_amdgcn_readfirstlane(c0); if (c0 > NI_MOE) c0 = NI_MOE;
        const int gw = bid * (NTHR / 64) + __builtin_amdgcn_readfirstlane(tid >> 6), nw = gridDim.x * (NTHR / 64);
        for (int it = c0 + 2 * gw; it + 1 < NI_MOE; it += 2 * nw) CONV_PAIR(it, it + 1);
    }
#undef CONV_DEC
#undef CONV_PAIR
}

__device__ void phase_tables(const Params& p) {
    float* const ws = (float*)tab_ld(N_IN);
    const float* const pin_I_LAM = PIN(I_LAM);
    const float* const pin_I_SGWS = PIN(I_SGWS);
    const int tid = tid_(), bid = bid_(); (void)tid; (void)bid;
    for (int i = bid * NTHR + tid; i < NLAYER * 4 * 128 * 128; i += gridDim.x * NTHR) ((bf16_t*)(ws + W_WSB))[i] = f2bf(pin_I_SGWS[i]);
    for (int i = bid * NTHR + tid; i < NLAT * 16; i += gridDim.x * NTHR) {
        const int t = i >> 4, f = i & 15; const float pos = (f < 8) ? (float)(t >> 6) : (float)(t & 63);
        const float ang = pos * powf(10000.f, -(float)(f & 7) / 8.f);
        ws[W_ROPE + (size_t)t * 32 + f] = cosf(ang); ws[W_ROPE + (size_t)t * 32 + 16 + f] = sinf(ang);
    }
    if (bid == 1) for (int i = tid; i < NLAYER * 2 * 256; i += NTHR) ws[W_SP + i] = log1pf(expf(-pin_I_LAM[i]));
    if (bid == 0) for (int i = tid; i < NLAYER * NEXP * 64; i += NTHR) ((int*)(ws + W_CNT))[i] = 0;
}

DEVI void norm1_store(const Params& p, int l, int t, int lane, const float4 (&v)[4]) {
    const float* g = p.in[I_NMIX] + l * D;
    const float* mod = p.ws + W_MOD + (size_t)(l * 2 + (t >= NLAT ? 1 : 0)) * 6144;
    float ss = 0.f;
#pragma unroll
    for (int j = 0; j < 4; ++j) ss += v[j].x * v[j].x + v[j].y * v[j].y + v[j].z * v[j].z + v[j].w * v[j].w;
    const float rstd = rsqrtf(wave_sum(ss) * (1.f / D) + EPS);
    bf16_t* hb = (bf16_t*)(p.ws + W_HB) + (size_t)t * D;
#pragma unroll
    for (int j = 0; j < 4; ++j) {
        const int c = j * 256 + lane * 4;
        const float4 gg = *(const float4*)(g + c), s1 = *(const float4*)(mod + D + c), s0 = *(const float4*)(mod + c);
        u32x2 w; w.x = cvt_pk_bf16(v[j].x * rstd * gg.x * (1.f + s1.x) + s0.x, v[j].y * rstd * gg.y * (1.f + s1.y) + s0.y);
        w.y = cvt_pk_bf16(v[j].z * rstd * gg.z * (1.f + s1.z) + s0.z, v[j].w * rstd * gg.w * (1.f + s1.w) + s0.w);
        *(u32x2*)(hb + c) = w;
    }
}
__device__ void phase_init(const Params& p) {
    float* const ws = (float*)tab_ld(N_IN);
    const float* const pin_I_CTX = PIN(I_CTX);
    const float* const pin_I_X = PIN(I_X);
    const int tid = tid_(), bid = bid_();
    const int lane = tid & 63, gw = bid * (NTHR / 64) + __builtin_amdgcn_readfirstlane(tid >> 6), nw = gridDim.x * (NTHR / 64);
    for (int t = gw; t < T; t += nw) {
        const float* src = (t < NLAT) ? pin_I_X + (size_t)t * D : pin_I_CTX + (size_t)(t - NLAT) * D;
        float4 v[4];
#pragma unroll
        for (int j = 0; j < 4; ++j) { v[j] = *(const float4*)(src + j * 256 + lane * 4); *(float4*)(ws + W_X + (size_t)t * D + j * 256 + lane * 4) = v[j]; }
        norm1_store(p, 0, t, lane, v);
    }
}

__device__ void phase_mod(const Params& p, float* smem) {
    float* const ws = (float*)tab_ld(N_IN);
    const float* const pin_I_BMOD = PIN(I_BMOD);
    const float* const pin_I_C = PIN(I_C);
    const float* const pin_I_CCTX = PIN(I_CCTX);
    const float* const pin_I_WMOD = PIN(I_WMOD);
    const int tid = tid_(), bid = bid_(); (void)tid; (void)bid;
    const int wave = tid >> 6, lane = tid & 63;
    for (int it = bid; it < NLAYER * 96; it += gridDim.x) {
        const int l = it / 96, j = (it % 96) * 64 + lane;
        const float* W = pin_I_WMOD + (size_t)l * 1024 * 6144;
        float a0 = 0.f, a1 = 0.f;
        for (int k = wave * 128; k < wave * 128 + 128; ++k) {
            const float w = W[(size_t)k * 6144 + j];
            a0 = fmaf(silu(pin_I_C[k]), w, a0);
            a1 = fmaf(silu(pin_I_CCTX[k]), w, a1);
        }
        smem[(wave * 2 + 0) * 64 + lane] = a0; smem[(wave * 2 + 1) * 64 + lane] = a1;
        __syncthreads();
        if (wave < 2) {
            float s = 0.f;
            for (int w = 0; w < 8; ++w) s += smem[(w * 2 + wave) * 64 + lane];
            ws[W_MOD + (size_t)(l * 2 + wave) * 6144 + j] = s + pin_I_BMOD[l * 6144 + j];
        }
        __syncthreads();
    }
}


struct InprojSched {
    UnitRange ur; const char* A; const char* Bt;
    DEVI bool next(int i, pg8::Unit& u) const {
        const int id = ur.lo + i * ur.step; if (id >= ur.hi) return false;
        const int tm = id / 7, tn = id % 7;
        u.a = A + (size_t)tm * 256 * D * 2; u.b = Bt + (size_t)tn * 256 * D * 2; u.x0 = tm * 256; u.x1 = tn * 256; u.x2 = 0; u.g = nullptr; u.gn = 0; return true;
    }
};
struct EpiInproj { static constexpr bool PERM = false; float* P;
    DEVI void operator()(const f32x4 (&acc)[2][2][4][2], const pg8::Unit& u, int wr, int wc, int fr, int fq) const {
#pragma unroll
        for (int ai = 0; ai < 2; ++ai)
#pragma unroll
            for (int m = 0; m < 4; ++m) { float* row = P + (size_t)(u.x0 + ai * 128 + wr * 64 + m * 16 + fr) * INC;
#pragma unroll
                for (int bj = 0; bj < 2; ++bj)
#pragma unroll
                    for (int n = 0; n < 2; ++n) { const int c = u.x1 + bj * 128 + wc * 32 + n * 16 + 4 * fq; if (c < INC) *(f32x4*)(row + c) = acc[ai][bj][m][n]; } }
    }
};
__device__ void phase_inproj(const Params& p, int l, char* lds) {
    float* const ws = (float*)tab_ld(N_IN);
    const int tid = tid_(), bid = bid_(); (void)tid;
    InprojSched S; S.ur = unit_range((T / 256) * 7, bid); S.A = (const char*)(ws + W_HB); S.Bt = (const char*)((const bf16_t*)(ws + W_WIN) + (size_t)l * NPAD_IN * D);
    EpiInproj E; E.P = ws + W_P;
    pg8::gemm_phase((PG8_LAS unsigned char*)lds, D, (size_t)128 * D * 2, S, E);
    { const int mine = (S.ur.hi - S.ur.lo + S.ur.step - 1) / S.ur.step, most = ((T / 256) * 7 / 8 + 1 + S.ur.step - 1) / S.ur.step;
      if (mine < most) conv_moe(p, l, 12); }
}

__device__ void phase_prep1(const Params& p, int l) {
    float* const ws = (float*)tab_ld(N_IN);
    const float* const pin_I_CONVB = PIN(I_CONVB);
    const float* const pin_I_CONVW = PIN(I_CONVW);
    const float* const pin_I_KVAN = PIN(I_KVAN);
    const float* const pin_I_QAN = PIN(I_QAN);
    const float* const pin_I_SGB = PIN(I_SGB);
    const float* const pin_I_SGG = PIN(I_SGG);
    const int tid = tid_(), bid = bid_(); (void)tid; (void)bid;
    const int lane = tid & 63, gw = bid * (NTHR / 64) + __builtin_amdgcn_readfirstlane(tid >> 6), nw = gridDim.x * (NTHR / 64);
    float qan[3], kvan[2];
#pragma unroll
    for (int j = 0; j < 3; ++j) qan[j] = pin_I_QAN[l * 192 + j * 64 + lane];
#pragma unroll
    for (int j = 0; j < 2; ++j) kvan[j] = pin_I_KVAN[l * 128 + j * 64 + lane];
    const f32x4 sgg = *(const f32x4*)(pin_I_SGG + l * 256 + lane * 4), sgb = *(const f32x4*)(pin_I_SGB + l * 256 + lane * 4);
    const f32x4 cb = *(const f32x4*)(pin_I_CONVB + l * 256 + lane * 4);
    f32x4 cw[4];
#pragma unroll
    for (int k = 0; k < 4; ++k) cw[k] = *(const f32x4*)(pin_I_CONVW + (size_t)l * 4 * 256 + k * 256 + lane * 4);
    const int g = lane >> 4, w = 2 << g;
    const float* P = ws + W_P;
    for (int t = gw; t < T; t += nw) {
        const int s0 = (t < NLAT) ? 0 : NLAT, sl = (t < NLAT) ? NLAT : NCTX, n = t - s0;
        const float* pr = P + (size_t)t * INC;
        const int lo = max(n - w / 2, 0), hi = min(n + w / 2, sl);
        f32x4 pw[16];
#pragma unroll
        for (int j = 0; j < 16; ++j) { const int m = min(lo + j, hi - 1); pw[j] = *(const f32x4*)(P + (size_t)(s0 + m) * INC + OFF_A + lane * 4); }
        const f32x4 xa = *(const f32x4*)(pr + OFF_A + lane * 4);
        float qv[3], kvv[2];
#pragma unroll
        for (int j = 0; j < 3; ++j) qv[j] = pr[OFF_Q + j * 64 + lane];
#pragma unroll
        for (int j = 0; j < 2; ++j) kvv[j] = pr[OFF_KV + j * 64 + lane];
        const f32x4 zu = *(const f32x4*)(pr + OFF_C + lane * 4), zv = *(const f32x4*)(pr + OFF_C + 256 + lane * 4);
        f32x4 xc[4];
#pragma unroll
        for (int k = 0; k < 4; ++k) { const int m = min(max(n - 1 + k, 0), sl - 1); xc[k] = *(const f32x4*)(P + (size_t)(s0 + m) * INC + OFF_DX + lane * 4); }
        {   f32x4 sacc = (f32x4){0.f, 0.f, 0.f, 0.f};
#pragma unroll
            for (int j = 0; j < 16; ++j) sacc = sacc + ((lo + j < hi) ? pw[j] : (f32x4){0.f, 0.f, 0.f, 0.f});
            const float inv = 1.f / (float)(hi - lo);
            const f32x4 d = sacc * inv - xa;
            u32x2 o; o.x = cvt_pk_bf16(d[0], d[1]); o.y = cvt_pk_bf16(d[2], d[3]); *(u32x2*)((bf16_t*)(ws + W_DIFF) + (size_t)t * 256 + lane * 4) = o; }
        {   const float rq = rsqrtf(wave_sum(qv[0] * qv[0] + qv[1] * qv[1] + qv[2] * qv[2]) * (1.f / 192.f) + EPS);
#pragma unroll
            for (int j = 0; j < 3; ++j) ((bf16_t*)(ws + W_QN))[(size_t)t * 192 + j * 64 + lane] = f2bf(qv[j] * rq * qan[j]);
            const float rk = rsqrtf(wave_sum(kvv[0] * kvv[0] + kvv[1] * kvv[1]) * (1.f / 128.f) + EPS);
#pragma unroll
            for (int j = 0; j < 2; ++j) ((bf16_t*)(ws + W_KVN))[(size_t)t * 128 + j * 64 + lane] = f2bf(kvv[j] * rk * kvan[j]); }
        {   f32x4 u, gv;
#pragma unroll
            for (int j = 0; j < 4; ++j) { u[j] = gelu_tanh(zu[j]); gv[j] = gelu_tanh(zv[j]); }
            *(f32x4*)(ws + W_U + (size_t)t * 256 + lane * 4) = u;
            const float mu = wave_sum(gv[0] + gv[1] + gv[2] + gv[3]) * (1.f / 256.f);
            gv = gv - mu;
            const float rstd = rsqrtf(wave_sum(gv[0] * gv[0] + gv[1] * gv[1] + gv[2] * gv[2] + gv[3] * gv[3]) * (1.f / 256.f) + EPS);
            *(f32x4*)(ws + W_VN + (size_t)t * 256 + lane * 4) = gv * rstd * sgg + sgb; }
        {   f32x4 o = cb;
#pragma unroll
            for (int k = 0; k < 4; ++k) { const int m = n - 1 + k; if (m >= 0 && m < sl) o = o + xc[k] * cw[k]; }
            *(f32x4*)(ws + W_XC + (size_t)t * 256 + lane * 4) = o;
            u32x2 ob; ob.x = cvt_pk_bf16(o[0], o[1]); ob.y = cvt_pk_bf16(o[2], o[3]); *(u32x2*)((bf16_t*)(ws + W_XCB) + (size_t)t * 256 + lane * 4) = ob; }
    }
}

__device__ void phase_small(const Params& p, int l, char* lds) {
    float* const ws = (float*)tab_ld(N_IN);
    const float* const pin_I_BA = PIN(I_BA);
    const float* const pin_I_BX = PIN(I_BX);
    const float* const pin_I_POOLS = PIN(I_POOLS);
    const float* const pin_I_POOLW = PIN(I_POOLW);
    const float* const pin_I_SGBS = PIN(I_SGBS);
    const float* const pin_I_WA = PIN(I_WA);
    const float* const pin_I_WUKV = PIN(I_WUKV);
    const float* const pin_I_WUQ = PIN(I_WUQ);
    const float* const pin_I_WX = PIN(I_WX);
    const int tid = tid_(), bid = bid_(); (void)tid;
    constexpr int NK = 19, NU1 = (T / 256) * NK, NU2 = NCHUNK * 2;
    bf16_t* Y = (bf16_t*)(ws + W_YC);
    for (int u = bid; u < NU1 + NU2; u += gridDim.x) {
        if (u < NU1) {
            const int tm = u / NK, kind = u % NK, m0 = tm * 256;
            if (kind < 11) {
                const bf16_t* A; int lda, K, ldb, nval; const float* B;
                if (kind < 4) { A = (const bf16_t*)(ws + W_DIFF) + kind * 64; lda = 256; K = 64; B = pin_I_POOLW + (size_t)(l * 4 + kind) * 64 * 64; ldb = 64; nval = 64; }
                else if (kind < 7) { A = (const bf16_t*)(ws + W_QN); lda = 192; K = 192; B = pin_I_WUQ + (size_t)l * 192 * 384 + (kind - 4) * 128; ldb = 384; nval = 128; }
                else { A = (const bf16_t*)(ws + W_KVN); lda = 128; K = 128; B = pin_I_WUKV + (size_t)l * 128 * 512 + (kind - 7) * 128; ldb = 512; nval = 128; }
                gemm_unit<false>(lds, K, [&](int r) { return A + (size_t)(m0 + r) * lda; }, B, B, ldb, nval,
                    [&](const f32x4 (&acc)[4][4], int wr, int wc, int fr, int fq) {
#pragma unroll
                        for (int m = 0; m < 4; ++m) { const int t = m0 + wr * 64 + m * 16 + fr;
#pragma unroll
                            for (int n = 0; n < 4; ++n) { const int c = wc * 64 + n * 16 + 4 * fq;
                                if (kind < 4) { if (wc == 0) { const f32x4 sc = *(const f32x4*)(pin_I_POOLS + l * 256 + kind * 64 + c); const f32x4 v = acc[m][n] * sc;
                                        u32x2 w; w.x = cvt_pk_bf16(v[0], v[1]); w.y = cvt_pk_bf16(v[2], v[3]); *(u32x2*)(Y + (size_t)t * D + kind * 64 + c) = w; } }
                                else if (kind < 7) *(f32x4*)(ws + W_QUP + (size_t)t * 384 + (kind - 4) * 128 + c) = acc[m][n];
                                else *(f32x4*)(ws + W_KVUP + (size_t)t * 512 + (kind - 7) * 128 + c) = acc[m][n]; } }
                    });
            } else {
                const int d = (kind - 11) >> 2, h = (kind - 11) & 3;
                const bf16_t* A = (const bf16_t*)(ws + W_XCB) + h * 64;
                const float* Ba = pin_I_WA + (size_t)((l * 2 + d) * 4 + h) * 64 * 64; const float* Bx = pin_I_WX + (size_t)((l * 2 + d) * 4 + h) * 64 * 64;
                const int pb = (l * 2 + d) * 256 + h * 64;
                gemm_unit<true>(lds, 64, [&](int r) { return A + (size_t)(m0 + r) * 256; }, Ba, Bx, 64, 64,
                    [&](const f32x4 (&acc)[4][4], int wr, int wc, int fr, int fq) {
#pragma unroll
                        for (int m = 0; m < 4; ++m) { const int t = m0 + wr * 64 + m * 16 + fr;
#pragma unroll
                            for (int pp = 0; pp < 2; ++pp) { const int idx = (wc * 2 + pp) * 16 + 4 * fq;
                                const f32x4 ba = *(const f32x4*)(pin_I_BA + pb + idx), bx = *(const f32x4*)(pin_I_BX + pb + idx), sp = *(const f32x4*)(ws + W_SP + pb + idx);
                                const f32x4 xv = *(const f32x4*)(ws + W_XC + (size_t)t * 256 + h * 64 + idx);
                                f32x4 av, dv;
#pragma unroll
                                for (int j = 0; j < 4; ++j) { const float r = fsigm(acc[m][2 * pp][j] + ba[j]), ig = fsigm(acc[m][2 * pp + 1][j] + bx[j]);
                                    const float loga = -8.f * r * sp[j], x2 = 2.f * loga;
                                    const float om = (x2 > -0.0625f) ? -x2 * (1.f + x2 * (0.5f + x2 * (0.16666667f + x2 * 0.041666668f))) : 1.f - fexp(x2);
                                    av[j] = fexp(loga); dv[j] = __builtin_amdgcn_sqrtf(om) * (ig * xv[j]); }
                                *(f32x4*)(ws + W_LA + ((size_t)d * T + t) * 256 + h * 64 + idx) = av;
                                *(f32x4*)(ws + W_LB + ((size_t)d * T + t) * 256 + h * 64 + idx) = dv; } }
                    });
            }
        } else {
            const int v = u - NU1, c = v >> 1, hp = v & 1;
            const bf16_t* A = (const bf16_t*)(ws + W_WSB) + ((size_t)l * 512 + hp * 256) * 128;
            const float* B = ws + W_VN + (size_t)c * 128 * 256 + hp * 128;
            gemm_unit<false>(lds, 128, [&](int r) { return A + (size_t)r * 128; }, B, B, 256, 128,
                [&](const f32x4 (&acc)[4][4], int wr, int wc, int fr, int fq) {
                    if ((wr >> 1) == wc) {
                        const int h = hp * 2 + wc;
#pragma unroll
                        for (int m = 0; m < 4; ++m) { const int pp = (wr & 1) * 64 + m * 16 + fr, t = c * 128 + pp; const float bs = pin_I_SGBS[(l * 4 + h) * 128 + pp];
#pragma unroll
                            for (int n = 0; n < 4; ++n) { const int ch = h * 64 + n * 16 + 4 * fq; const f32x4 uu = *(const f32x4*)(ws + W_U + (size_t)t * 256 + ch);
                                const f32x4 o = uu * (acc[m][n] + bs);
                                u32x2 w; w.x = cvt_pk_bf16(o[0], o[1]); w.y = cvt_pk_bf16(o[2], o[3]); *(u32x2*)(Y + (size_t)t * D + 512 + ch) = w; } }
                    }
                });
        }
    }
}

__device__ void phase_prep2(const Params& p, int l) {
    float* const ws = (float*)tab_ld(N_IN);
    const float* const pin_I_KN = PIN(I_KN);
    const float* const pin_I_QN = PIN(I_QN);
    const int tid = tid_(), bid = bid_();
    const int lane = tid & 63, gw = bid * (NTHR / 64) + __builtin_amdgcn_readfirstlane(tid >> 6), nw = gridDim.x * (NTHR / 64);
    {
        const int h = lane >> 4, j = lane & 15;
        const f32x4 qw = *(const f32x4*)(pin_I_QN + l * 96 + 4 * j), kw = *(const f32x4*)(pin_I_KN + l * 96 + 4 * j);
        const float qw1 = pin_I_QN[l * 96 + 64 + j], qw2 = pin_I_QN[l * 96 + 80 + j], kw1 = pin_I_KN[l * 96 + 64 + j], kw2 = pin_I_KN[l * 96 + 80 + j];
        for (int t = gw; t < T; t += nw) {
            const bool lat = t < NLAT;
            float cs = 1.f, sn = 0.f;
            if (lat) { cs = ws[W_ROPE + (size_t)t * 32 + j]; sn = ws[W_ROPE + (size_t)t * 32 + 16 + j]; }
            const float* qr = ws + W_QUP + (size_t)t * 384 + h * 96; const float* kr = ws + W_KVUP + (size_t)t * 512 + h * 128; const float* pr = ws + W_P + (size_t)t * INC + OFF_KR;
            f32x4 qn = *(const f32x4*)(qr + 4 * j); float q1 = qr[64 + j], q2 = qr[80 + j];
            f32x4 kn = *(const f32x4*)(kr + 4 * j); float k1 = pr[j], k2 = pr[16 + j];
            const f32x4 vv = *(const f32x4*)(kr + 64 + 4 * j);
            float sq = qn[0] * qn[0] + qn[1] * qn[1] + qn[2] * qn[2] + qn[3] * qn[3] + q1 * q1 + q2 * q2;
            float sk = kn[0] * kn[0] + kn[1] * kn[1] + kn[2] * kn[2] + kn[3] * kn[3] + k1 * k1 + k2 * k2;
#pragma unroll
            for (int o = 1; o < 16; o <<= 1) { sq += __shfl_xor(sq, o); sk += __shfl_xor(sk, o); }
            const float rq = rsqrtf(sq * (1.f / 96.f) + EPS), rk = rsqrtf(sk * (1.f / 96.f) + EPS);
            qn = qn * qw * rq; q1 *= qw1 * rq; q2 *= qw2 * rq; kn = kn * kw * rk; k1 *= kw1 * rk; k2 *= kw2 * rk;
            const float qa = q1 * cs - q2 * sn, qb = q1 * sn + q2 * cs, ka = k1 * cs - k2 * sn, kb = k1 * sn + k2 * cs;
            bf16_t* qo = (bf16_t*)(ws + W_Q) + ((size_t)h * T + t) * 96; bf16_t* ko = (bf16_t*)(ws + W_K) + ((size_t)h * T + t) * 96; bf16_t* vo = (bf16_t*)(ws + W_V) + ((size_t)h * T + t) * 64;
            { u32x2 w; w.x = cvt_pk_bf16(qn[0], qn[1]); w.y = cvt_pk_bf16(qn[2], qn[3]); *(u32x2*)(qo + 4 * j) = w; qo[64 + j] = f2bf(qa); qo[80 + j] = f2bf(qb); }
            { u32x2 w; w.x = cvt_pk_bf16(kn[0], kn[1]); w.y = cvt_pk_bf16(kn[2], kn[3]); *(u32x2*)(ko + 4 * j) = w; ko[64 + j] = f2bf(ka); ko[80 + j] = f2bf(kb); }
            { u32x2 w; w.x = cvt_pk_bf16(vv[0], vv[1]); w.y = cvt_pk_bf16(vv[2], vv[3]); *(u32x2*)(vo + 4 * j) = w; }
        }
    }
    for (int i = bid * NTHR + tid; i < NCHUNK * 512; i += gridDim.x * NTHR) {
        const int c = i >> 9, d = (i >> 8) & 1, ch = i & 255;
        const size_t off = ((size_t)d * T + (size_t)c * 128) * 256 + ch;
        const float* __restrict__ A = ws + W_LA + off; const float* __restrict__ B = ws + W_LB + off;
        float* __restrict__ A2 = ws + W_LA2 + off; float* __restrict__ B2 = ws + W_LB2 + off;
        float h = 0.f, ap = 1.f;
        float a[8], b[8], an[8], bn[8];
#pragma unroll
        for (int j = 0; j < 8; ++j) { const int q = d ? 127 - j : j; a[j] = A[(size_t)q * 256]; b[j] = B[(size_t)q * 256]; }
        for (int s0 = 0; s0 < 128; s0 += 8) {
            const int s1 = (s0 + 8 < 128) ? s0 + 8 : s0;
#pragma unroll
            for (int j = 0; j < 8; ++j) { const int q = d ? 127 - (s1 + j) : s1 + j; an[j] = A[(size_t)q * 256]; bn[j] = B[(size_t)q * 256]; }
#pragma unroll
            for (int j = 0; j < 8; ++j) { h = fmaf(a[j], h, b[j]); ap *= a[j]; const int q = d ? 127 - (s0 + j) : s0 + j; A2[(size_t)q * 256] = ap; B2[(size_t)q * 256] = h; }
#pragma unroll
            for (int j = 0; j < 8; ++j) { a[j] = an[j]; b[j] = bn[j]; }
        }
        ws[W_AGG + ((size_t)(c * 2 + d) * 2 + 0) * 256 + ch] = ap;
        ws[W_AGG + ((size_t)(c * 2 + d) * 2 + 1) * 256 + ch] = h;
    }
}


__device__ void phase_attn(const Params& p, int l, char* lds) {
    float* const ws = (float*)tab_ld(N_IN);
    const int tid = tid_(), bid = bid_(); (void)tid;
    const bf16_t* Qb = (const bf16_t*)(ws + W_Q); const bf16_t* Kb = (const bf16_t*)(ws + W_K); const bf16_t* Vb = (const bf16_t*)(ws + W_V);
    bf16_t* Y = (bf16_t*)(ws + W_YC);
    const int nunits = (l == 0) ? 260 : 256;
    for (int u = bid; u < nunits; u += gridDim.x) {
        int h, t0, k0, seq;
        if (u < 256) { h = (u & 7) >> 1; t0 = (((u >> 3) << 1) | (u & 1)) * 256; k0 = 0; seq = T; }
        else { h = u - 256; t0 = NLAT; k0 = NLAT; seq = NCTX; }
        att::attn_unit(Qb + ((size_t)h * T + t0) * 96, Kb + ((size_t)h * T + k0) * 96, Vb + ((size_t)h * T + k0) * 64, seq, Y + (size_t)t0 * D + 256 + h * 64, D, lds);
    }
}

__device__ void phase_lru_fin(const Params& p, char* lds) {
    float* const ws = (float*)tab_ld(N_IN);
    const int tid = tid_(), bid = bid_();
    float* carry = (float*)lds;
    for (int it = bid; it < NCHUNK * 2; it += gridDim.x) {
        const int c = it >> 1, half = it & 1;
        {
            const int d = tid >> 8, ch = tid & 255;
            const float* ag = ws + W_AGG + (size_t)d * 512 + ch;
            float s = 0.f;
            int q0, dq, n;
            if (d) { q0 = NCHUNK - 1; dq = -1; n = NCHUNK - 1 - c; }
            else if (c >= 128) { q0 = 128; dq = 1; n = c - 128; }
            else { s = fmaf(ag[(size_t)129 * 1024], ag[(size_t)128 * 1024 + 256], ag[(size_t)129 * 1024 + 256]); q0 = 0; dq = 1; n = c; }
            int k = 0;
            for (; k + 8 <= n; k += 8) {
                float a[8], hh[8];
#pragma unroll
                for (int j = 0; j < 8; ++j) { const float* r = ag + (size_t)(q0 + (k + j) * dq) * 1024; a[j] = r[0]; hh[j] = r[256]; }
#pragma unroll
                for (int j = 0; j < 8; ++j) s = fmaf(a[j], s, hh[j]);
            }
            for (; k < n; ++k) { const float* r = ag + (size_t)(q0 + k * dq) * 1024; s = fmaf(r[0], s, r[256]); }
            carry[tid] = s;
        }
        __syncthreads();
        for (int i = tid; i < 64 * 64; i += NTHR) {
            const int t = c * 128 + half * 64 + (i >> 6), ch = (i & 63) * 4;
            f32x4 hs = *(const f32x4*)(ws + W_LB2 + (size_t)t * 256 + ch) + *(const f32x4*)(ws + W_LA2 + (size_t)t * 256 + ch) * *(const f32x4*)(carry + ch);
            hs = hs + *(const f32x4*)(ws + W_LB2 + ((size_t)T + t) * 256 + ch) + *(const f32x4*)(ws + W_LA2 + ((size_t)T + t) * 256 + ch) * *(const f32x4*)(carry + 256 + ch);
            const f32x4 g = *(const f32x4*)(ws + W_P + (size_t)t * INC + OFF_DG + ch);
            u32x2 w; w.x = cvt_pk_bf16(gelu_tanh(g[0]) * hs[0], gelu_tanh(g[1]) * hs[1]); w.y = cvt_pk_bf16(gelu_tanh(g[2]) * hs[2], gelu_tanh(g[3]) * hs[3]);
            *(u32x2*)((bf16_t*)(ws + W_YC) + (size_t)t * D + 768 + ch) = w;
        }
        __syncthreads();
    }
}

struct OutprojSched {
    UnitRange ur; const char* A; const char* Bt;
    DEVI bool next(int i, pg8::Unit& u) const {
        const int id = ur.lo + i * ur.step; if (id >= ur.hi) return false;
        const int tm = id >> 2, tn = id & 3;
        u.a = A + (size_t)tm * 256 * D * 2; u.b = Bt + (size_t)tn * 256 * D * 2; u.x0 = tm * 256; u.x1 = tn * 256; u.x2 = 0; u.g = nullptr; u.gn = 0; return true;
    }
};
struct EpiOutproj { static constexpr bool PERM = false; float* X; const float* modv;
    DEVI void operator()(const f32x4 (&acc)[2][2][4][2], const pg8::Unit& u, int wr, int wc, int fr, int fq) const {
        const float* g1 = modv + (u.x0 >= NLAT ? 6144 : 0) + 2 * D;
#pragma unroll
        for (int ai = 0; ai < 2; ++ai)
#pragma unroll
            for (int m = 0; m < 4; ++m) { float* row = X + (size_t)(u.x0 + ai * 128 + wr * 64 + m * 16 + fr) * D;
#pragma unroll
                for (int bj = 0; bj < 2; ++bj)
#pragma unroll
                    for (int n = 0; n < 2; ++n) { const int c = u.x1 + bj * 128 + wc * 32 + n * 16 + 4 * fq; const f32x4 g = *(const f32x4*)(g1 + c); f32x4 x = *(f32x4*)(row + c);
                        x = x + g * acc[ai][bj][m][n]; *(f32x4*)(row + c) = x; } }
    }
};
struct CtxSplitSched {
    int first, step; const char* A; const char* Bt;
    DEVI bool next(int i, pg8::Unit& u) const {
        const int id = first + i * step; if (id >= 16) return false;
        const int tn = id >> 2, ks = id & 3;
        u.a = A + (size_t)NLAT * D * 2 + (size_t)ks * 256 * 2; u.b = Bt + (size_t)tn * 256 * D * 2 + (size_t)ks * 256 * 2; u.x0 = ks; u.x1 = tn * 256; u.x2 = 0; u.g = nullptr; u.gn = 0; return true;
    }
};
struct EpiCtxPart { static constexpr bool PERM = false; float* PART; const float* g1;
    DEVI void operator()(const f32x4 (&acc)[2][2][4][2], const pg8::Unit& u, int wr, int wc, int fr, int fq) const {
#pragma unroll
        for (int ai = 0; ai < 2; ++ai)
#pragma unroll
            for (int m = 0; m < 4; ++m) { float* row = PART + ((size_t)u.x0 * NCTX + ai * 128 + wr * 64 + m * 16 + fr) * D;
#pragma unroll
                for (int bj = 0; bj < 2; ++bj)
#pragma unroll
                    for (int n = 0; n < 2; ++n) { const int c = u.x1 + bj * 128 + wc * 32 + n * 16 + 4 * fq; *(f32x4*)(row + c) = *(const f32x4*)(g1 + c) * acc[ai][bj][m][n]; } }
    }
};
__device__ void phase_outproj(const Params& p, int l, char* lds) {
    float* const ws = (float*)tab_ld(N_IN);
    const int tid = tid_(), bid = bid_(); (void)tid;
    OutprojSched S; S.ur = unit_range((NLAT / 256) * 4, bid); S.A = (const char*)(ws + W_YC); S.Bt = (const char*)((const bf16_t*)(ws + W_WOUT) + (size_t)l * D * D);
    EpiOutproj E; E.X = ws + W_X; E.modv = ws + W_MOD + (size_t)l * 2 * 6144;
    pg8::gemm_phase((PG8_LAS unsigned char*)lds, D, (size_t)128 * D * 2, S, E);
    if (l < NLAYER - 1) {
        CtxSplitSched S2; S2.first = bid; S2.step = gridDim.x; S2.A = S.A; S2.Bt = S.Bt;
        EpiCtxPart E2; E2.PART = ws + W_PART; E2.g1 = ws + W_MOD + (size_t)(l * 2 + 1) * 6144 + 2 * D;
        pg8::gemm_phase((PG8_LAS unsigned char*)lds, D, (size_t)128 * D * 2, S2, E2, 4);
    }
}

constexpr int R_LDS = 1024 * 36 * 4;
__device__ void phase_router(const Params& p, int l, char* lds) {
    float* const ws = (float*)tab_ld(N_IN);
    const float* const pin_I_NFFN = PIN(I_NFFN);
    const float* const pin_I_RB = PIN(I_RB);
    const float* const pin_I_RW = PIN(I_RW);
    const int tid = tid_(), bid = bid_();
    float* wl = (float*)lds;
    int* hist = (int*)(lds + R_LDS); int* bbase = hist + 32; int* tinfo = hist + 64 + (tid >> 6) * 40;
    float* wsc = (float*)(lds + RSC_OFF) + (tid >> 6) * 96;
    if (tid < 32) hist[tid] = 0;
    {   const float* rw = pin_I_RW + (size_t)l * D * NEXP;
        for (int i = tid; i < 1024 * 8; i += NTHR) { const int k = i >> 3, e4 = i & 7; *(f32x4*)(wl + k * 36 + e4 * 4) = *(const f32x4*)(rw + k * 32 + e4 * 4); }
    }
    __syncthreads();
    const int lane = tid & 63, gw = bid * (NTHR / 64) + __builtin_amdgcn_readfirstlane(tid >> 6), nw = gridDim.x * (NTHR / 64);
    const float* g = pin_I_NFFN + l * D;
    int* cnt = (int*)(ws + W_CNT) + l * NEXP * 64;
    bf16_t* HB = (bf16_t*)(ws + W_HB);
    const int e = lane >> 1;
    const float rb = pin_I_RB[l * NEXP + e];
    const int TL = (l == NLAYER - 1) ? NLAT : T;
    int ti = 0;
    for (int t0 = gw; t0 < TL; t0 += 2 * nw, ti += 2) {
        const int t1 = t0 + nw; const bool v1 = t1 < TL; const int t1c = v1 ? t1 : t0;
        const float* mod = ws + W_MOD + (size_t)(l * 2 + (t0 >= NLAT ? 1 : 0)) * 6144;
        float f0[16], f1[16]; float ss0 = 0.f, ss1 = 0.f;
#pragma unroll
        for (int m = 0; m < 16; ++m) { f0[m] = ws[W_X + (size_t)t0 * D + lane + 64 * m]; f1[m] = ws[W_X + (size_t)t1c * D + lane + 64 * m]; }
        if (t0 >= NLAT) {
#pragma unroll
            for (int m = 0; m < 16; ++m) { const size_t o0 = (size_t)(t0 - NLAT) * D + lane + 64 * m, o1 = (size_t)(t1c - NLAT) * D + lane + 64 * m;
#pragma unroll
                for (int ks = 0; ks < 4; ++ks) { f0[m] += ws[W_PART + (size_t)ks * NCTX * D + o0]; f1[m] += ws[W_PART + (size_t)ks * NCTX * D + o1]; }
                ws[W_X + (size_t)t0 * D + lane + 64 * m] = f0[m]; if (v1) ws[W_X + (size_t)t1 * D + lane + 64 * m] = f1[m]; }
        }
#pragma unroll
        for (int m = 0; m < 16; ++m) { ss0 = fmaf(f0[m], f0[m], ss0); ss1 = fmaf(f1[m], f1[m], ss1); }
#pragma unroll
        for (int o = 32; o > 0; o >>= 1) { ss0 += __shfl_xor(ss0, o); ss1 += __shfl_xor(ss1, o); }
        const float r0 = rsqrtf(ss0 * (1.f / D) + EPS), r1 = rsqrtf(ss1 * (1.f / D) + EPS);
#pragma unroll
        for (int m = 0; m < 16; ++m) { const int k = lane + 64 * m; const float gkm = g[k] * (1.f + mod[4 * D + k]), shm = mod[3 * D + k]; f0[m] = f0[m] * r0 * gkm + shm; f1[m] = f1[m] * r1 * gkm + shm;
            HB[(size_t)t0 * D + k] = f2bf(f0[m]); if (v1) HB[(size_t)t1 * D + k] = f2bf(f1[m]); }
        float acc0[32], acc1[32];
#pragma unroll
        for (int j = 0; j < 32; ++j) { acc0[j] = 0.f; acc1[j] = 0.f; }
#pragma unroll
        for (int m = 0; m < 16; ++m) {
            const float* wr = wl + (lane + 64 * m) * 36;
#pragma unroll
            for (int e4 = 0; e4 < 8; ++e4) { const f32x4 w4 = *(const f32x4*)(wr + e4 * 4);
#pragma unroll
                for (int j = 0; j < 4; ++j) { acc0[e4 * 4 + j] = fmaf(f0[m], w4[j], acc0[e4 * 4 + j]); acc1[e4 * 4 + j] = fmaf(f1[m], w4[j], acc1[e4 * 4 + j]); } }
            __builtin_amdgcn_sched_barrier(0);
        }
#define RS_STEP(W_, MSK_) do { const bool up = (lane & (MSK_)) != 0; \
            _Pragma("unroll") for (int j = 0; j < (W_); ++j) { const float s0_ = up ? acc0[j] : acc0[j + (W_)], k0_ = up ? acc0[j + (W_)] : acc0[j]; acc0[j] = k0_ + __shfl_xor(s0_, (MSK_)); \
                const float s1_ = up ? acc1[j] : acc1[j + (W_)], k1_ = up ? acc1[j + (W_)] : acc1[j]; acc1[j] = k1_ + __shfl_xor(s1_, (MSK_)); } } while (0)
        RS_STEP(16, 32); RS_STEP(8, 16); RS_STEP(4, 8); RS_STEP(2, 4); RS_STEP(1, 2);
#undef RS_STEP
        const float a0 = acc0[0] + __shfl_xor(acc0[0], 1) + rb, a1 = acc1[0] + __shfl_xor(acc1[0], 1) + rb;
        if ((lane & 1) == 0) { wsc[e] = a0; wsc[48 + e] = a1; }
        asm volatile("s_waitcnt lgkmcnt(0)" ::: "memory"); __builtin_amdgcn_wave_barrier();
        int rank0 = 0, rank1 = 0;
#pragma unroll
        for (int q = 0; q < 8; ++q) { const f32x4 x0 = *(const volatile f32x4*)(wsc + 4 * q), x1 = *(const volatile f32x4*)(wsc + 48 + 4 * q);
#pragma unroll
            for (int j = 0; j < 4; ++j) { const int eo = 4 * q + j;
                rank0 += (x0[j] > a0 || (x0[j] == a0 && eo < e)) ? 1 : 0; rank1 += (x1[j] > a1 || (x1[j] == a1 && eo < e)) ? 1 : 0; } }
        if ((lane & 1) == 0) {
            if (rank0 < 4) { ((int*)wsc)[32 + rank0] = e; wsc[36 + rank0] = a0; }
            if (rank1 < 4) { ((int*)wsc)[80 + rank1] = e; wsc[84 + rank1] = a1; }
        }
        asm volatile("s_waitcnt lgkmcnt(0)" ::: "memory"); __builtin_amdgcn_wave_barrier();
        if (lane < 8 && (lane < 4 || v1)) {
            const int u = lane >> 2, k = lane & 3, tt = u ? t1 : t0;
            const volatile float* sv = wsc + u * 48;
            const float mx = sv[36];
            const float sm = expf(sv[36] - mx) + expf(sv[37] - mx) + expf(sv[38] - mx) + expf(sv[39] - mx);
            const int ee = ((const volatile int*)sv)[32 + k]; const float eg = expf(sv[36 + k] - mx);
            const int lidx = atomicAdd(&hist[ee], 1);
            tinfo[(ti + u) * 4 + k] = (ee << 16) | lidx;
            ((int*)(ws + W_TOPE))[tt * 4 + k] = ee;
            ws[W_TOPG + tt * 4 + k] = eg / sm;
        }
        __builtin_amdgcn_wave_barrier();
    }
    __syncthreads();
    if (tid < 32) bbase[tid] = atomicAdd(&cnt[tid * 64], hist[tid]);
    __syncthreads();
    ti = 0;
    for (int t = gw; t < TL; t += nw, ++ti)
        if (lane < 4) { const int v = tinfo[ti * 4 + lane]; const int slot = bbase[v >> 16] + (v & 0xffff);
            ((int*)(ws + W_TOPI))[t * 4 + lane] = slot; ((int*)(ws + W_XS))[(size_t)(v >> 16) * T + slot] = t; }
    __syncthreads();
    conv_moe(p, l, 0);
}

DEVI void moe_bases(const Params& p, int l, int* sb) {
    float* const ws = (float*)tab_ld(N_IN);
    const int tid = tid_();
    if (tid == 0) {
        const int* cnt = (const int*)(ws + W_CNT) + l * NEXP * 64;
        int b = 0, tb = 0;
        for (int e = 0; e < NEXP; ++e) { sb[e] = b; sb[40 + e] = tb; const int c = cnt[e * 64]; sb[80 + e] = c; const int mt = (c + 255) / 256; b += mt * 256; tb += mt; }
        sb[32] = b; sb[72] = tb;
    }
    __syncthreads();
}


struct MoeSched {
    UnitRange ur; const int* sb; int ntn; const char* A; const char* Bt; size_t bstride_e, bstride_tn; const int* lists;
    DEVI bool next(int i, pg8::Unit& u) const {
        const int id = ur.lo + i * ur.step; if (id >= ur.hi) return false;
        int e = 0; while (e < NEXP - 1 && sb[40 + e + 1] * ntn <= id) ++e;
        const int mts = sb[40 + e + 1] - sb[40 + e], loc = id - sb[40 + e] * ntn, tng = loc / (mts * 4), rr = loc % (mts * 4), mt = rr >> 2, tn = tng * 4 + (rr & 3);
        const int r0 = __builtin_amdgcn_readfirstlane(sb[e] + mt * 256), tn_s = __builtin_amdgcn_readfirstlane(tn), e_s = __builtin_amdgcn_readfirstlane(e);
        u.a = A + (size_t)r0 * D * 2; u.b = Bt + (size_t)e_s * bstride_e + (size_t)tn_s * bstride_tn; u.x0 = r0; u.x1 = tn_s; u.x2 = e_s;
        const int mt_s = __builtin_amdgcn_readfirstlane(mt), cnt_s = __builtin_amdgcn_readfirstlane(sb[80 + e]);
        u.g = lists ? lists + (size_t)e_s * T + mt_s * 256 : nullptr; u.gn = cnt_s - mt_s * 256 < 256 ? cnt_s - mt_s * 256 : 256; return true;
    }
};
struct EpiMoe1 { static constexpr bool PERM = true; bf16_t* ACT; const float* bias;
    DEVI void operator()(const f32x4 (&acc)[2][2][4][2], const pg8::Unit& u, int wr, int wc, int fr, int fq) const {
        const int c0 = u.x1 * 128 + wc * 32 + 8 * fq;
        const float* bg = bias + (size_t)u.x2 * 2048 + c0; const float* bu = bg + 1024;
        f32x4 vg[2], vu[2];
#pragma unroll
        for (int n = 0; n < 2; ++n) { vg[n] = *(const f32x4*)(bg + 4 * n); vu[n] = *(const f32x4*)(bu + 4 * n); }
#pragma unroll
        for (int ai = 0; ai < 2; ++ai)
#pragma unroll
            for (int m = 0; m < 4; ++m) { bf16_t* rowp = ACT + (size_t)(u.x0 + ai * 128 + wr * 64 + m * 16 + fr) * D + c0;
                float a[8];
#pragma unroll
                for (int n = 0; n < 2; ++n)
#pragma unroll
                    for (int j = 0; j < 4; ++j) { float g = acc[ai][0][m][n][j] + vg[n][j], uu = acc[ai][1][m][n][j] + vu[n][j];
                        g = fminf(g, 7.f); uu = fminf(fmaxf(uu, -7.f), 7.f); a[n * 4 + j] = (uu + 1.f) * (g * sigm(1.702f * g)); }
                u32x4 w; w.x = cvt_pk_bf16(a[0], a[1]); w.y = cvt_pk_bf16(a[2], a[3]); w.z = cvt_pk_bf16(a[4], a[5]); w.w = cvt_pk_bf16(a[6], a[7]);
                *(u32x4*)rowp = w; }
    }
};
__device__ void phase_moe1(const Params& p, int l, char* lds) {
    float* const ws = (float*)tab_ld(N_IN);
    const float* const pin_I_BGU = PIN(I_BGU);
    const int tid = tid_(), bid = bid_(); (void)tid;
    int* sb = (int*)(lds + pg8::STAGE_BYTES);
    moe_bases(p, l, sb);
    MoeSched S; S.sb = sb; S.ntn = 8; S.ur = unit_range(sb[72] * 8, bid); S.A = (const char*)(ws + W_HB); S.lists = (const int*)(ws + W_XS);
    S.Bt = (const char*)((const bf16_t*)(ws + W_WGU) + (size_t)l * NEXP * 2048 * D); S.bstride_e = (size_t)2048 * D * 2; S.bstride_tn = (size_t)128 * D * 2;
    EpiMoe1 E; E.ACT = (bf16_t*)(ws + W_ACT); E.bias = pin_I_BGU + (size_t)l * NEXP * 2048;
    pg8::gemm_phase<EpiMoe1, MoeSched, true>((PG8_LAS unsigned char*)lds, D, (size_t)1024 * D * 2, S, E, 0, (const char*)(ws + W_HB));
    __syncthreads();
}

struct EpiMoe2 { static constexpr bool PERM = true; bf16_t* YR; const float* bias;
    DEVI void operator()(const f32x4 (&acc)[2][2][4][2], const pg8::Unit& u, int wr, int wc, int fr, int fq) const {
        const int c0 = u.x1 * 256 + wc * 32 + 8 * fq;
        const float* bb = bias + (size_t)u.x2 * D + c0;
        f32x4 bv[2][2];
#pragma unroll
        for (int bj = 0; bj < 2; ++bj)
#pragma unroll
            for (int n = 0; n < 2; ++n) bv[bj][n] = *(const f32x4*)(bb + bj * 128 + 4 * n);
#pragma unroll
        for (int ai = 0; ai < 2; ++ai)
#pragma unroll
            for (int m = 0; m < 4; ++m) { bf16_t* rowp = YR + (size_t)(u.x0 + ai * 128 + wr * 64 + m * 16 + fr) * D + c0;
#pragma unroll
                for (int bj = 0; bj < 2; ++bj) { const f32x4 v0 = acc[ai][bj][m][0] + bv[bj][0], v1 = acc[ai][bj][m][1] + bv[bj][1];
                    u32x4 w; w.x = cvt_pk_bf16(v0[0], v0[1]); w.y = cvt_pk_bf16(v0[2], v0[3]); w.z = cvt_pk_bf16(v1[0], v1[1]); w.w = cvt_pk_bf16(v1[2], v1[3]);
                    *(u32x4*)(rowp + bj * 128) = w; } }
    }
};
__device__ void phase_moe2(const Params& p, int l, char* lds) {
    float* const ws = (float*)tab_ld(N_IN);
    const float* const pin_I_BDN = PIN(I_BDN);
    const int tid = tid_(), bid = bid_(); (void)tid;
    int* sb = (int*)(lds + pg8::STAGE_BYTES);
    moe_bases(p, l, sb);
    MoeSched S; S.sb = sb; S.ntn = 4; S.ur = unit_range(sb[72] * 4, bid); S.A = (const char*)(ws + W_ACT); S.lists = nullptr;
    S.Bt = (const char*)((const bf16_t*)(ws + W_WDN) + (size_t)l * NEXP * D * D); S.bstride_e = (size_t)D * D * 2; S.bstride_tn = (size_t)256 * D * 2;
    EpiMoe2 E; E.YR = (bf16_t*)(ws + W_YR); E.bias = pin_I_BDN + (size_t)l * NEXP * D;
    pg8::gemm_phase((PG8_LAS unsigned char*)lds, D, (size_t)128 * D * 2, S, E);
    __syncthreads();
}

__device__ void phase_combine(const Params& p, int l, char* lds, bool last) {
    float* const ws = (float*)tab_ld(N_IN);
    float* const pout = (float*)tab_ld(N_IN + 1);
    const int tid = tid_(), bid = bid_();
    const bf16_t* YR = (const bf16_t*)(ws + W_YR);
    int* sb = (int*)(lds + G_LDS);
    moe_bases(p, l, sb);
    const int lane = tid & 63, gw = bid * (NTHR / 64) + __builtin_amdgcn_readfirstlane(tid >> 6), nw = gridDim.x * (NTHR / 64);
    const int TL = last ? NLAT : T;
    for (int t0 = gw; t0 < TL; t0 += 2 * nw) {
        const int t1 = t0 + nw; const bool v1 = t1 < TL; const int t1c = v1 ? t1 : t0;
        const float* g2 = ws + W_MOD + (size_t)(l * 2 + (t0 >= NLAT ? 1 : 0)) * 6144 + 5 * D;
        const bf16_t* ya[4]; const bf16_t* yb[4]; float ga[4], gb[4];
#pragma unroll
        for (int k = 0; k < 4; ++k) { ya[k] = YR + (size_t)(sb[((const int*)(ws + W_TOPE))[t0 * 4 + k]] + ((const int*)(ws + W_TOPI))[t0 * 4 + k]) * D; ga[k] = ws[W_TOPG + t0 * 4 + k];
                                      yb[k] = YR + (size_t)(sb[((const int*)(ws + W_TOPE))[t1c * 4 + k]] + ((const int*)(ws + W_TOPI))[t1c * 4 + k]) * D; gb[k] = ws[W_TOPG + t1c * 4 + k]; }
        float* xa = ws + W_X + (size_t)t0 * D; float* xb = ws + W_X + (size_t)t1c * D;
        float4 ra[4], rb[4];
#pragma unroll
        for (int j = 0; j < 4; ++j) {
            const int c = j * 256 + lane * 4;
            u32x2 ua[4], ub[4];
#pragma unroll
            for (int k = 0; k < 4; ++k) { ua[k] = *(const u32x2*)(ya[k] + c); ub[k] = *(const u32x2*)(yb[k] + c); }
            float4 xva = *(const float4*)(xa + c), xvb = *(const float4*)(xb + c); const float4 gg = *(const float4*)(g2 + c);
            float a0 = 0.f, a1 = 0.f, a2 = 0.f, a3 = 0.f, b0 = 0.f, b1 = 0.f, b2 = 0.f, b3 = 0.f;
#pragma unroll
            for (int k = 0; k < 4; ++k) {
                a0 = fmaf(ga[k], __uint_as_float(ua[k].x << 16), a0); a1 = fmaf(ga[k], __uint_as_float(ua[k].x & 0xffff0000u), a1);
                a2 = fmaf(ga[k], __uint_as_float(ua[k].y << 16), a2); a3 = fmaf(ga[k], __uint_as_float(ua[k].y & 0xffff0000u), a3);
                b0 = fmaf(gb[k], __uint_as_float(ub[k].x << 16), b0); b1 = fmaf(gb[k], __uint_as_float(ub[k].x & 0xffff0000u), b1);
                b2 = fmaf(gb[k], __uint_as_float(ub[k].y << 16), b2); b3 = fmaf(gb[k], __uint_as_float(ub[k].y & 0xffff0000u), b3); }
            xva.x = fmaf(gg.x, a0, xva.x); xva.y = fmaf(gg.y, a1, xva.y); xva.z = fmaf(gg.z, a2, xva.z); xva.w = fmaf(gg.w, a3, xva.w);
            xvb.x = fmaf(gg.x, b0, xvb.x); xvb.y = fmaf(gg.y, b1, xvb.y); xvb.z = fmaf(gg.z, b2, xvb.z); xvb.w = fmaf(gg.w, b3, xvb.w);
            ra[j] = xva; rb[j] = xvb;
            if (last) { *(float4*)(pout + (size_t)t0 * D + c) = xva; if (v1) *(float4*)(pout + (size_t)t1 * D + c) = xvb; }
            else { *(float4*)(xa + c) = xva; if (v1) *(float4*)(xb + c) = xvb; }
        }
        if (!last) { norm1_store(p, l + 1, t0, lane, ra); if (v1) norm1_store(p, l + 1, t1, lane, rb); }
    }
}

constexpr int XST_OFF = R_LDS + 2048 - 16, STAMP_OFF = R_LDS + 2048 - 16 - 256;
constexpr int LDS_BYTES = RSC_OFF + 8 * 96 * 4;

#define XB_TMO      128
#define XB_XCNT(j)  (256  + 64 * (j))
#define XB_XSUB(j)  (1280 + 64 * (j))
#define XB_XGEN(j)  (2304 + 64 * (j))
#define XB_TOP      3328
#define XB_TOPGEN   3392
#define XCD_BAR_WORDS 3456
#define XB_SPIN_CAP (1u << 18)
#define LAS __attribute__((address_space(3)))
__device__ __forceinline__ unsigned xb_ld(unsigned* p)              { return __hip_atomic_load(p, __ATOMIC_RELAXED, __HIP_MEMORY_SCOPE_AGENT); }
__device__ __forceinline__ unsigned xb_add(unsigned* p, unsigned v) { return __hip_atomic_fetch_add(p, v, __ATOMIC_RELAXED, __HIP_MEMORY_SCOPE_AGENT); }
__device__ __forceinline__ unsigned xb_xcc_id() { return (unsigned)__builtin_amdgcn_s_getreg((3 << 11) | 20) & 0xFu; }
#define XB_SPIN(cond, bar) do { unsigned _sp = 0; while (cond) { __builtin_amdgcn_s_sleep(1); \
    if ((++_sp & 255u) == 0u) { if (xb_ld(&(bar)[XB_TMO])) break; if (_sp > XB_SPIN_CAP) { atomicAdd(&(bar)[XB_TMO], 1u); break; } } } } while (0)
struct XcdBarrier { unsigned* bar; unsigned x; volatile LAS unsigned* st; };
__device__ __forceinline__ XcdBarrier xcd_barrier_post(unsigned* bar, volatile LAS unsigned* st) {
    XcdBarrier b; b.bar = bar; b.x = xb_xcc_id(); b.st = st;
    if (threadIdx.x == 0) (void)xb_add(&bar[XB_XCNT(b.x)], 1u);
    return b;
}
__device__ __forceinline__ void xcd_barrier_complete(unsigned* bar, unsigned x, unsigned& nloc, unsigned& nx) {
    const unsigned G = gridDim.x * gridDim.y * gridDim.z;
    unsigned sum, cnt, mine, sp = 0u;
    for (;;) {
        sum = 0u; cnt = 0u; mine = 0u;
#pragma unroll
        for (unsigned j = 0; j < 16; ++j) { const unsigned c = xb_ld(&bar[XB_XCNT(j)]); sum += c; cnt += (c > 0u) ? 1u : 0u; mine = (j == x) ? c : mine; }
        if (sum == G) break;
        __builtin_amdgcn_s_sleep(1);
        if ((++sp & 255u) == 0u) { if (xb_ld(&bar[XB_TMO])) break; if (sp > XB_SPIN_CAP) { atomicAdd(&bar[XB_TMO], 1u); break; } }
    }
    nloc = mine > 0u ? mine : 1u; nx = cnt > 0u ? cnt : 1u;
}
__device__ __noinline__ void xcd_barrier(const XcdBarrier b) {
    asm volatile("s_waitcnt vmcnt(0)" ::: "memory");
    __syncthreads();
    if (threadIdx.x == 0) {
        unsigned* bar = b.bar;
        __builtin_amdgcn_s_waitcnt(0);
        unsigned nloc = b.st[0], nx = b.st[1];
        if (nloc == 0u) { xcd_barrier_complete(bar, b.x, nloc, nx); b.st[0] = nloc; b.st[1] = nx; }
        const unsigned old = xb_add(&bar[XB_XSUB(b.x)], 1u);
        const unsigned gen = old / nloc;
        if (old + 1u == (gen + 1u) * nloc) {
            __builtin_amdgcn_fence(__ATOMIC_RELEASE, "agent");
            asm volatile("s_waitcnt vmcnt(0)" ::: "memory");
            const unsigned og = xb_add(&bar[XB_TOP], 1u);
            const unsigned tg = og / nx;
            if (og + 1u == (tg + 1u) * nx) xb_add(&bar[XB_TOPGEN], 1u);
            else XB_SPIN(xb_ld(&bar[XB_TOPGEN]) == tg, bar);
            __builtin_amdgcn_fence(__ATOMIC_ACQUIRE, "agent");
            xb_add(&bar[XB_XGEN(b.x)], 1u);
            asm volatile("s_waitcnt vmcnt(0)" ::: "memory");
        } else {
            XB_SPIN(xb_ld(&bar[XB_XGEN(b.x)]) == gen, bar);
            __builtin_amdgcn_fence(__ATOMIC_ACQUIRE, "agent");
            asm volatile("s_waitcnt vmcnt(0)" ::: "memory");
        }
    }
    __syncthreads();
}

constexpr int PROBE_IDX = -1, PROBE_DIV = 10;
constexpr int REP_NORM = 1, REP_INPROJ = 1, REP_PREP1 = 1, REP_SMALL = 1, REP_ATTN = 1, REP_FIN = 1, REP_MOE1 = 1, REP_MOE2 = 1, REP_SYNC = 1, REP_CONV = 1;
__global__ void __launch_bounds__(NTHR) fwd_kernel(Params p) {
    cg::grid_group grid = cg::this_grid();
    char* lds = g_lds;
    float* smem = (float*)lds;
    if (threadIdx.x == 0) {
        unsigned long long* tab = (unsigned long long*)(lds + TAB_OFF);
#pragma unroll
        for (int i = 0; i < N_IN; ++i) tab[i] = (unsigned long long)p.in[i];
        tab[N_IN] = (unsigned long long)p.ws; tab[N_IN + 1] = (unsigned long long)p.out;
    }
    __syncthreads();
    volatile LAS unsigned* xst = (volatile LAS unsigned*)(lds + XST_OFF);
    if (threadIdx.x < 4) xst[threadIdx.x] = 0u;
    if (blockIdx.x == 0) for (int i = threadIdx.x; i < 4096; i += NTHR) ((unsigned*)(p.ws + W_BAR))[i] = 0u;
    for (int r = 0; r < REP_CONV; ++r) phase_convert(p);
    phase_tables(p);
    phase_mod(p, smem);
    grid.sync();
    XcdBarrier xbar = xcd_barrier_post((unsigned*)(p.ws + W_BAR), xst);
    unsigned long long* stamps = (unsigned long long*)(lds + STAMP_OFF); int nstamp = 0;
#define GSYNC() do { for (int r_ = 0; r_ < REP_SYNC; ++r_) xcd_barrier(xbar); if (PROBE_IDX >= 0) { if (blockIdx.x == 0 && threadIdx.x == 0) stamps[nstamp] = __builtin_amdgcn_s_memrealtime(); ++nstamp; } } while (0)
    phase_init(p);
    GSYNC();
    for (int lv = 0; lv < NLAYER; ++lv) {
        int l = lv; asm volatile("" : "+s"(l));
        for (int r = 0; r < REP_INPROJ; ++r) phase_inproj(p, l, lds);
        GSYNC();
        for (int r = 0; r < REP_PREP1; ++r) phase_prep1(p, l);
        GSYNC();
        for (int r = 0; r < REP_SMALL; ++r) phase_small(p, l, lds);
        GSYNC();
        phase_prep2(p, l);
        GSYNC();
        for (int r = 0; r < REP_ATTN; ++r) phase_attn(p, l, lds);
        for (int r = 0; r < REP_FIN; ++r) phase_lru_fin(p, lds);
        GSYNC();
        phase_outproj(p, l, lds);
        GSYNC();
        phase_router(p, l, lds);
        GSYNC();
        for (int r = 0; r < REP_MOE1; ++r) phase_moe1(p, l, lds);
        GSYNC();
        for (int r = 0; r < REP_MOE2; ++r) phase_moe2(p, l, lds);
        GSYNC();
        phase_combine(p, l, lds, l == NLAYER - 1);
        GSYNC();
    }
    if (PROBE_IDX >= 0 && blockIdx.x == 0 && threadIdx.x == 0) {
        const float us = (float)(stamps[PROBE_IDX + 1] - stamps[PROBE_IDX]) * 0.01f;
        ((float*)tab_ld(N_IN + 1))[0] += 2.f + us / (float)PROBE_DIV;
    }
}

extern "C" void kernel_launch(void* const* d_in, const int* in_sizes, int n_in, void* d_out, int out_size, void* d_ws, size_t ws_size, hipStream_t stream) {
    static int grid_blocks = 0;
    if (!grid_blocks) {
        int dev = 0, cus = 0, per_cu = 0;
        (void)hipGetDevice(&dev);
        (void)hipDeviceGetAttribute(&cus, hipDeviceAttributeMultiprocessorCount, dev);
        if (hipFuncSetAttribute((const void*)fwd_kernel, hipFuncAttributeMaxDynamicSharedMemorySize, LDS_BYTES) != hipSuccess) fprintf(stderr, "kernel_launch: hipFuncSetAttribute failed\n");
        if (hipOccupancyMaxActiveBlocksPerMultiprocessor(&per_cu, fwd_kernel, NTHR, LDS_BYTES) != hipSuccess || per_cu < 1) { fprintf(stderr, "kernel_launch: occupancy query says %d\n", per_cu); per_cu = 1; }
        if (per_cu > 1) per_cu = 1;
        grid_blocks = cus * per_cu;
        if (ws_size < W_END * sizeof(float)) fprintf(stderr, "kernel_launch: workspace too small: %zu < %zu\n", ws_size, W_END * sizeof(float));
        if (n_in != N_IN) fprintf(stderr, "kernel_launch: n_in %d != %d\n", n_in, (int)N_IN);
    }
    Params p{};
    for (int i = 0; i < N_IN; ++i) p.in[i] = (const float*)d_in[i];
    p.out = (float*)d_out;
    p.ws = (float*)d_ws;
    void* args[] = {&p};
    hipError_t e = hipLaunchCooperativeKernel((void*)fwd_kernel, dim3(grid_blocks), dim3(NTHR), args, LDS_BYTES, stream);
    if (e != hipSuccess) fprintf(stderr, "cooperative launch failed: %s (grid %d)\n", hipGetErrorString(e), grid_blocks);
}
```

```cpp
#include <hip/hip_runtime.h>
#include <hip/hip_cooperative_groups.h>
#include <cstdio>
#include <cstdint>
namespace cg = cooperative_groups;

#define DEVI __device__ __forceinline__
constexpr int NTHR = 512;
constexpr int D = 1024, NLAT = 16384, NCTX = 256, T = NLAT + NCTX, NLAYER = 2;
constexpr int INC = 1632;
constexpr int OFF_A = 0, OFF_Q = 256, OFF_KV = 448, OFF_KR = 576, OFF_C = 608, OFF_DX = 1120, OFF_DG = 1376;
constexpr int NCHUNK = T / 128;
constexpr int NEXP = 32, TOPK = 4;
constexpr int MAXROWS = T * TOPK + NEXP * 256;
constexpr float EPS = 1e-6f;

enum { I_X = 0, I_C, I_CTX, I_CCTX, I_WMOD, I_BMOD, I_NMIX, I_NFFN, I_WIN, I_WOUT, I_POOLW, I_POOLS, I_QAN, I_WUQ, I_KVAN, I_WUKV,
       I_QN, I_KN, I_SGG, I_SGB, I_SGWS, I_SGBS, I_CONVW, I_CONVB, I_WA, I_BA, I_WX, I_BX, I_LAM, I_RW, I_RB, I_WGU, I_BGU, I_WDN, I_BDN, N_IN };

constexpr size_t al(size_t x) { return (x + 63) / 64 * 64; }
constexpr size_t W_X = 0;
constexpr size_t W_MOD = W_X + al((size_t)T * D);
constexpr size_t W_P = W_MOD + al(2 * 2 * 6144);
constexpr size_t W_YC = W_P + al((size_t)T * INC);
constexpr size_t W_Q = W_YC + al((size_t)T * D);
constexpr size_t W_K = W_Q + al((size_t)T * 384);
constexpr size_t W_V = W_K + al((size_t)T * 384);
constexpr size_t W_DIFF = W_V + al((size_t)T * 256);
constexpr size_t W_QN = W_DIFF + al((size_t)T * 256);
constexpr size_t W_KVN = W_QN + al((size_t)T * 192);
constexpr size_t W_U = W_KVN + al((size_t)T * 128);
constexpr size_t W_VN = W_U + al((size_t)T * 256);
constexpr size_t W_XC = W_VN + al((size_t)T * 256);
constexpr size_t W_QUP = W_XC + al((size_t)T * 256);
constexpr size_t W_KVUP = W_QUP + al((size_t)T * 384);
constexpr size_t W_LA = W_KVUP + al((size_t)T * 512);
constexpr size_t W_LB = W_LA + al((size_t)2 * T * 256);
constexpr size_t W_AGG = W_LB + al((size_t)2 * T * 256);
constexpr int NSUB = T / 64;
constexpr size_t W_CARRY = W_AGG + al((size_t)NSUB * 2 * 2 * 256);
constexpr size_t W_TOPE = W_CARRY + al((size_t)NSUB * 2 * 256);
constexpr size_t W_TOPG = W_TOPE + al((size_t)T * 4);
constexpr size_t W_TOPI = W_TOPG + al((size_t)T * 4);
constexpr size_t W_CNT = W_TOPI + al((size_t)T * 4);
constexpr size_t W_ACT = W_CNT + al(NLAYER * NEXP * 64);
constexpr size_t W_YR = W_ACT + al((size_t)MAXROWS * D / 2);
constexpr size_t W_XS = W_YR + al((size_t)MAXROWS * D / 2);
constexpr size_t W_HB = W_XS + al((size_t)MAXROWS * D / 2);
constexpr size_t W_XCB = W_HB + al((size_t)T * D / 2);
constexpr size_t W_WSB = W_XCB + al((size_t)T * 256 / 2);
constexpr size_t W_BAR = W_WSB + al((size_t)NLAYER * 4 * 128 * 128 / 2);
constexpr size_t W_ROPE = W_BAR + al(4096);
constexpr size_t W_LA2 = W_ROPE + al((size_t)NLAT * 32);
constexpr size_t W_LB2 = W_LA2 + al((size_t)2 * T * 256);
constexpr size_t W_SP = W_LB2 + al((size_t)2 * T * 256);
constexpr size_t W_PART = W_SP + al(NLAYER * 2 * 256);
constexpr int NPAD_IN = 1792;
constexpr size_t W_WIN = W_PART + al((size_t)4 * NCTX * D);
constexpr size_t W_WOUT = W_WIN + al((size_t)NLAYER * NPAD_IN * D / 2);
constexpr size_t W_WGU = W_WOUT + al((size_t)NLAYER * D * D / 2);
constexpr size_t W_WDN = W_WGU + al((size_t)NLAYER * NEXP * 2048 * D / 2);
constexpr size_t W_END = W_WDN + al((size_t)NLAYER * NEXP * D * D / 2);

struct Params {
    const float* in[N_IN];
    float* out;
    float* ws;
};

DEVI int tid_() { int t = threadIdx.x; asm volatile("" : "+v"(t)); return t; }
DEVI float* ws_(float* w) { unsigned long long v = (unsigned long long)w; asm volatile("" : "+s"(v)); return (float*)v; }
extern __shared__ __attribute__((aligned(16))) char g_lds[];
constexpr int RSC_OFF = 149504 + 512;
constexpr int TAB_OFF = 149504;
DEVI unsigned long long tab_ld(int i) { const unsigned long long v = ((const volatile unsigned long long*)(g_lds + TAB_OFF))[i];
    return ((unsigned long long)(unsigned)__builtin_amdgcn_readfirstlane((int)(v >> 32)) << 32) | (unsigned)__builtin_amdgcn_readfirstlane((int)v); }
typedef __attribute__((address_space(1))) float gfloat_t;
#define PIN(i) ((const float*)(const gfloat_t*)tab_ld(i))
DEVI int bid_() { int b = blockIdx.x; asm volatile("" : "+s"(b)); return b; }
DEVI float wave_sum(float v) {
#pragma unroll
    for (int o = 32; o > 0; o >>= 1) v += __shfl_xor(v, o);
    return v;
}
DEVI float fexp(float x) { return __builtin_amdgcn_exp2f(x * 1.4426950408889634f); }
DEVI float gelu_tanh(float x) { const float u = 1.5957691216057308f * (x + 0.044715f * x * x * x); return x * __builtin_amdgcn_rcpf(1.f + fexp(-u)); }
DEVI float sigm(float x) { return 1.f / (1.f + expf(-x)); }
DEVI float silu(float x) { return x * sigm(x); }
DEVI float fsigm(float x) { return __builtin_amdgcn_rcpf(1.f + fexp(-x)); }


typedef unsigned short bf16_t;
typedef short bf16x8 __attribute__((ext_vector_type(8)));
typedef float f32x4 __attribute__((ext_vector_type(4)));
typedef unsigned u32x4 __attribute__((ext_vector_type(4)));
typedef unsigned u32x2 __attribute__((ext_vector_type(2)));
DEVI unsigned cvt_pk_bf16(float lo, float hi) { unsigned r; asm volatile("v_cvt_pk_bf16_f32 %0, %1, %2" : "=v"(r) : "v"(lo), "v"(hi)); return r; }
DEVI bf16_t f2bf(float f) { return (bf16_t)(cvt_pk_bf16(f, 0.f) & 0xffffu); }
DEVI f32x4 ld4bf(const bf16_t* p) { const u32x2 w = *(const u32x2*)p; return (f32x4){__uint_as_float(w.x << 16), __uint_as_float(w.x & 0xffff0000u), __uint_as_float(w.y << 16), __uint_as_float(w.y & 0xffff0000u)}; }
DEVI float bf2f(bf16_t b) { return __uint_as_float(((unsigned)b) << 16); }

constexpr int G_STAGE = 49152;
constexpr int G_LDS = 2 * G_STAGE;
DEVI int swz(int row, int chunk) { return row * 128 + ((chunk ^ ((row >> 1) & 7)) << 4); }

template <bool PAIRED, class ARow, class Epi>
DEVI void gemm_unit(char* lds, int K, ARow arow, const float* __restrict__ B0, const float* __restrict__ B1, int ldb, int ncol_valid, Epi epi) {
    const int tid = tid_(), wave = tid >> 6, lane = tid & 63, fr = lane & 15, fq = lane >> 4, wr = wave >> 1, wc = wave & 1;
    const int ac = tid & 7;
    const bf16_t* ap[4]; int a_lds[4];
#pragma unroll
    for (int i = 0; i < 4; ++i) { const int r = (tid >> 3) + 64 * i; ap[i] = arow(r) + ac * 8; a_lds[i] = swz(r, ac); }
    const int kq = lane & 15, nq = (lane >> 4) + 4 * wave;
    const float* bp;
    if (PAIRED) { const int seg = (nq >> 2) & 1, idx = (nq >> 3) * 16 + (nq & 3) * 4; bp = (seg ? B1 : B0) + idx; }
    else { const int c4 = 4 * nq < ncol_valid ? 4 * nq : ncol_valid - 4; bp = B0 + c4; }
    bp += (size_t)(4 * kq) * ldb;
    int b_lds[4];
#pragma unroll
    for (int i = 0; i < 4; ++i) b_lds[i] = 32768 + swz(4 * nq + i, kq >> 1) + (kq & 1) * 8;
    const int sx = (fr >> 1) & 7;
    const int aoff0 = (wr * 64 + fr) * 128 + ((fq ^ sx) << 4), aoff1 = (wr * 64 + fr) * 128 + (((4 + fq) ^ sx) << 4);
    const int boff0 = 32768 + (wc * 64 + fr) * 128 + ((fq ^ sx) << 4), boff1 = 32768 + (wc * 64 + fr) * 128 + (((4 + fq) ^ sx) << 4);
    u32x4 av0[4], av1[4]; f32x4 bv0[4], bv1[4];
#define G_LOAD(av, bv, t) do { _Pragma("unroll") for (int i = 0; i < 4; ++i) av[i] = *(const u32x4*)(ap[i] + (t) * 64); \
        _Pragma("unroll") for (int kk = 0; kk < 4; ++kk) bv[kk] = *(const f32x4*)(bp + ((size_t)(t) * 64 + kk) * ldb); } while (0)
#define G_WRITE(s_, av, bv) do { _Pragma("unroll") for (int i = 0; i < 4; ++i) *(u32x4*)((s_) + a_lds[i]) = av[i]; \
        _Pragma("unroll") for (int i = 0; i < 4; ++i) { u32x2 w_; w_.x = cvt_pk_bf16(bv[0][i], bv[1][i]); w_.y = cvt_pk_bf16(bv[2][i], bv[3][i]); *(u32x2*)((s_) + b_lds[i]) = w_; } } while (0)
#define G_MMA(Af, Bf) do { __builtin_amdgcn_s_setprio(1); _Pragma("unroll") for (int m = 0; m < 4; ++m) _Pragma("unroll") for (int n = 0; n < 4; ++n) \
        acc[m][n] = __builtin_amdgcn_mfma_f32_16x16x32_bf16(Bf[n], Af[m], acc[m][n], 0, 0, 0); __builtin_amdgcn_s_setprio(0); } while (0)
#define G_SB() __builtin_amdgcn_sched_barrier(0)
#define G_ITER(t, c_, n_, av, bv, W_, L_) do { \
        bf16x8 Af[4], Bf[4]; \
        _Pragma("unroll") for (int m = 0; m < 4; ++m) Af[m] = *(const bf16x8*)((c_) + aoff0 + m * 2048); \
        _Pragma("unroll") for (int n = 0; n < 4; ++n) Bf[n] = *(const bf16x8*)((c_) + boff0 + n * 2048); \
        G_SB(); asm volatile("s_waitcnt lgkmcnt(0)" ::: "memory"); G_SB(); \
        G_MMA(Af, Bf); G_SB(); \
        _Pragma("unroll") for (int m = 0; m < 4; ++m) Af[m] = *(const bf16x8*)((c_) + aoff1 + m * 2048); \
        _Pragma("unroll") for (int n = 0; n < 4; ++n) Bf[n] = *(const bf16x8*)((c_) + boff1 + n * 2048); \
        G_SB(); \
        if (W_) { G_WRITE(n_, av, bv); G_SB(); asm volatile("s_waitcnt lgkmcnt(8)" ::: "memory"); } else { asm volatile("s_waitcnt lgkmcnt(0)" ::: "memory"); } \
        G_SB(); \
        G_MMA(Af, Bf); G_SB(); \
        if (L_) G_LOAD(av, bv, (t) + 3); \
        G_SB(); asm volatile("s_waitcnt lgkmcnt(0)" ::: "memory"); __builtin_amdgcn_s_barrier(); G_SB(); } while (0)
    f32x4 acc[4][4];
#pragma unroll
    for (int m = 0; m < 4; ++m)
#pragma unroll
        for (int n = 0; n < 4; ++n) acc[m][n] = (f32x4){0.f, 0.f, 0.f, 0.f};
    const int nk = K >> 6;
    char* L0 = lds; char* L1 = lds + G_STAGE;
    G_LOAD(av0, bv0, 0);
    G_WRITE(L0, av0, bv0);
    if (nk > 1) G_LOAD(av1, bv1, 1);
    if (nk > 2) G_LOAD(av0, bv0, 2);
    asm volatile("s_waitcnt lgkmcnt(0)" ::: "memory"); __builtin_amdgcn_s_barrier(); G_SB();
    int t = 0;
    for (; t + 4 < nk; t += 2) {
        G_ITER(t, L0, L1, av1, bv1, true, true);
        G_ITER(t + 1, L1, L0, av0, bv0, true, true);
    }
    for (; t < nk; t += 2) {
        G_ITER(t, L0, L1, av1, bv1, t + 1 < nk, t + 3 < nk);
        if (t + 1 < nk) G_ITER(t + 1, L1, L0, av0, bv0, t + 2 < nk, t + 4 < nk);
    }
#undef G_LOAD
#undef G_WRITE
#undef G_MMA
#undef G_ITER
#undef G_SB
    { int fr_ = fr, fq_ = fq; asm volatile("" : "+v"(fr_), "+v"(fq_)); epi(acc, wr, wc, fr_, fq_); }
}


#define PG8_LAS __attribute__((address_space(3)))
namespace pg8 {
constexpr int BM = 256, BK = 64, HALF = 128, HTB = HALF * BK * 2, STAGE_BYTES = 8 * HTB;
DEVI int lds_byte(int r, int c) { const int st = (r >> 4) * 2 + (c >> 5), rr = r & 15, cc = c & 31, ob = rr * 64 + cc * 2; return st * 1024 + (ob ^ (((ob >> 9) & 1) << 5)); }
DEVI void stage_rc(int b, int& R, int& C) { const int st = b / 1024, sb = b % 1024, swz_ = sb ^ (((sb >> 9) & 1) << 5); R = (st >> 1) * 16 + swz_ / 64; C = (st & 1) * 32 + (swz_ % 64) / 2; }
DEVI int perm32(int rho) { const int n = rho >> 4, i = rho & 15; return 8 * (i >> 2) + 4 * n + (i & 3); }
struct Unit { const char* a; const char* b; int x0, x1, x2; const int* g; int gn; };
template <class Epi, class Sched, bool GATHER = false>
DEVI void gemm_phase(PG8_LAS unsigned char* lds, int K, size_t hstepB, const Sched& S, const Epi& E, int ktiles = 0, const char* Abase = nullptr) {
    const int tid = tid_(), wid = __builtin_amdgcn_readfirstlane(tid >> 6), lane = tid & 63, wr = wid >> 2, wc = wid & 3, fr = lane & 15, fq = lane >> 4;
    const int nt = ktiles ? ktiles : K / BK;
    unsigned voffA[2], voffB[2]; int Rr[2], Cc[2];
#pragma unroll
    for (int i = 0; i < 2; ++i) { int R, C; stage_rc(tid * 16 + i * 8192, R, C); const int Rb = Epi::PERM ? ((R & ~31) + perm32(R & 31)) : R; Rr[i] = R; Cc[i] = C;
        voffA[i] = (unsigned)(R * K + C) * 2u; voffB[i] = (unsigned)(Rb * K + C) * 2u; }
    unsigned offc[2][2], offn[2][2];
#define PG8_GOFF(dst, u_) do { _Pragma("unroll") for (int h_ = 0; h_ < 2; ++h_) _Pragma("unroll") for (int i_ = 0; i_ < 2; ++i_) { const int r_ = h_ * HALF + Rr[i_]; \
        const int row_ = (u_).g[r_ < (u_).gn ? r_ : 0]; dst[h_][i_] = (unsigned)(row_ * K + Cc[i_]) * 2u; } } while (0)
#define PG8_STAGE_A(bufoff, ptr, h_, offs, kb) do { if (GATHER) PG8_STAGE(bufoff, Abase + (kb), offs[h_]); else PG8_STAGE(bufoff, ptr, voffA); } while (0)
    const size_t kstep = (size_t)(BK * 2);
    const size_t hstep = (size_t)HALF * K * 2;
    const unsigned ldsw = (unsigned)wid * 1024u;
    const int aoff = lds_byte(wr * 64 + fr, fq * 8), boff = lds_byte(wc * 32 + fr, fq * 8);
#define PG8_SA(b, h) (((b) * 2 + (h)) * HTB)
#define PG8_SB(b, h) ((4 + (b) * 2 + (h)) * HTB)
#define PG8_STAGE(bufoff, gbase, voff) do { _Pragma("unroll") for (int _i = 0; _i < 2; ++_i) \
        __builtin_amdgcn_global_load_lds((const unsigned*)((const char*)(gbase) + (voff)[_i]), (PG8_LAS unsigned*)(lds + (bufoff) + ldsw + _i * 8192), 16, 0, 0); } while (0)
#define PG8_LDA(dst, b, h) do { _Pragma("unroll") for (int m = 0; m < 4; ++m) _Pragma("unroll") for (int k = 0; k < 2; ++k) dst[m][k] = *(const PG8_LAS bf16x8*)(lds + PG8_SA(b, h) + aoff + m * 2048 + k * 1024); } while (0)
#define PG8_LDB(dst, b, h) do { _Pragma("unroll") for (int n = 0; n < 2; ++n) _Pragma("unroll") for (int k = 0; k < 2; ++k) dst[n][k] = *(const PG8_LAS bf16x8*)(lds + PG8_SB(b, h) + boff + n * 2048 + k * 1024); } while (0)
#define PG8_MMA(ai, bj, At, Bt) do { __builtin_amdgcn_s_setprio(1); _Pragma("unroll") for (int m = 0; m < 4; ++m) _Pragma("unroll") for (int n = 0; n < 2; ++n) _Pragma("unroll") for (int k = 0; k < 2; ++k) \
        acc[ai][bj][m][n] = __builtin_amdgcn_mfma_f32_16x16x32_bf16(Bt[n][k], At[m][k], acc[ai][bj][m][n], 0, 0, 0); __builtin_amdgcn_s_setprio(0); } while (0)
#define PG8_WAIT_V(n) asm volatile("s_waitcnt vmcnt(" #n ")" ::: "memory")
#define PG8_WAIT_L(n) asm volatile("s_waitcnt lgkmcnt(" #n ")" ::: "memory")
#define PG8_BAR __builtin_amdgcn_s_barrier()
#define PG8_SCHED __builtin_amdgcn_sched_barrier(0)
    Unit cur, nxt; int ui = 0;
    if (!S.next(0, cur)) return;
    f32x4 acc[2][2][4][2];
#pragma unroll
    for (int a = 0; a < 2; ++a)
#pragma unroll
        for (int b = 0; b < 2; ++b)
#pragma unroll
            for (int m = 0; m < 4; ++m)
#pragma unroll
                for (int n = 0; n < 2; ++n) acc[a][b][m][n] = (f32x4){0.f, 0.f, 0.f, 0.f};
    bf16x8 At[4][2], B0[2][2], B1[2][2];
    const char* cA = cur.a; const char* cB = cur.b;
    if (GATHER) { PG8_GOFF(offc, cur); asm volatile("s_waitcnt vmcnt(0)" ::: "memory"); }
    PG8_STAGE(PG8_SB(0, 0), cB, voffB); PG8_STAGE_A(PG8_SA(0, 0), cA, 0, offc, 0); PG8_STAGE(PG8_SB(0, 1), cB + hstepB, voffB); PG8_STAGE_A(PG8_SA(0, 1), cA + hstep, 1, offc, 0);
    if (wr == 1) PG8_BAR;
    PG8_WAIT_V(4); PG8_BAR;
    PG8_STAGE(PG8_SB(1, 0), cB + kstep, voffB); PG8_STAGE_A(PG8_SA(1, 0), cA + kstep, 0, offc, kstep); PG8_STAGE(PG8_SB(1, 1), cB + hstepB + kstep, voffB);
    PG8_WAIT_V(6); PG8_BAR;
    for (;;) {
        const bool has_next = S.next(ui + 1, nxt);
        const char* nA = has_next ? nxt.a : cA; const char* nB = has_next ? nxt.b : cB;
        if (GATHER) { if (has_next) PG8_GOFF(offn, nxt); else {
#pragma unroll
            for (int h_ = 0; h_ < 2; ++h_)
#pragma unroll
                for (int i_ = 0; i_ < 2; ++i_) offn[h_][i_] = offc[h_][i_]; } }
        for (int t = 0; t < nt; t += 2) {
            const bool last = (t == nt - 2);
            const char* a1 = cA + (size_t)(t + 1) * kstep;
            const char* a2 = last ? nA : cA + (size_t)(t + 2) * kstep; const char* b2 = last ? nB : cB + (size_t)(t + 2) * kstep;
            const char* a3 = a2 + kstep; const char* b3 = b2 + kstep;
            unsigned o2[2][2]; const size_t k1 = (size_t)(t + 1) * kstep, k2 = last ? 0 : (size_t)(t + 2) * kstep, k3 = k2 + kstep;
            if (GATHER) {
                if (last) { asm volatile("" ::: "memory");
#pragma unroll
                    for (int h_ = 0; h_ < 2; ++h_)
#pragma unroll
                        for (int i_ = 0; i_ < 2; ++i_) o2[h_][i_] = offn[h_][i_]; }
                else {
#pragma unroll
                    for (int h_ = 0; h_ < 2; ++h_)
#pragma unroll
                        for (int i_ = 0; i_ < 2; ++i_) o2[h_][i_] = offc[h_][i_]; } }
            PG8_LDB(B0, 0, 0); PG8_SCHED; PG8_LDA(At, 0, 0); PG8_STAGE_A(PG8_SA(1, 1), a1 + hstep, 1, offc, k1);
            PG8_WAIT_L(8); PG8_BAR; PG8_WAIT_L(0); PG8_MMA(0, 0, At, B0); PG8_BAR; PG8_SCHED;
            PG8_LDB(B1, 0, 1); PG8_STAGE(PG8_SB(0, 0), b2, voffB);
            PG8_BAR; PG8_WAIT_L(0); PG8_MMA(0, 1, At, B1); PG8_BAR;
            PG8_LDA(At, 0, 1); PG8_STAGE_A(PG8_SA(0, 0), a2, 0, o2, k2);
            PG8_BAR; PG8_WAIT_L(0); PG8_MMA(1, 0, At, B0); PG8_BAR; PG8_SCHED;
            PG8_STAGE(PG8_SB(0, 1), b2 + hstepB, voffB);
            PG8_WAIT_V(6); PG8_BAR; PG8_MMA(1, 1, At, B1); PG8_BAR;
            PG8_LDB(B0, 1, 0); PG8_SCHED; PG8_LDA(At, 1, 0); PG8_STAGE_A(PG8_SA(0, 1), a2 + hstep, 1, o2, k2);
            PG8_WAIT_L(8); PG8_BAR; PG8_WAIT_L(0); PG8_MMA(0, 0, At, B0); PG8_BAR; PG8_SCHED;
            PG8_LDB(B1, 1, 1); PG8_STAGE(PG8_SB(1, 0), b3, voffB);
            PG8_BAR; PG8_WAIT_L(0); PG8_MMA(0, 1, At, B1); PG8_BAR;
            PG8_LDA(At, 1, 1); PG8_STAGE_A(PG8_SA(1, 0), a3, 0, o2, k3);
            PG8_BAR; PG8_WAIT_L(0); PG8_MMA(1, 0, At, B0); PG8_BAR; PG8_SCHED;
            PG8_STAGE(PG8_SB(1, 1), b3 + hstepB, voffB);
            PG8_WAIT_V(6); PG8_BAR; PG8_MMA(1, 1, At, B1); PG8_BAR;
        }
        { int fr_ = fr, fq_ = fq; asm volatile("" : "+v"(fr_), "+v"(fq_));
          E(acc, cur, wr, wc, fr_, fq_); }
        if (!has_next) break;
#pragma unroll
        for (int a = 0; a < 2; ++a)
#pragma unroll
            for (int b = 0; b < 2; ++b)
#pragma unroll
                for (int m = 0; m < 4; ++m)
#pragma unroll
                    for (int n = 0; n < 2; ++n) acc[a][b][m][n] = (f32x4){0.f, 0.f, 0.f, 0.f};
        cur = nxt; cA = nA; cB = nB; ++ui;
        if (GATHER) {
#pragma unroll
            for (int h_ = 0; h_ < 2; ++h_)
#pragma unroll
                for (int i_ = 0; i_ < 2; ++i_) offc[h_][i_] = offn[h_][i_]; }
    }
    PG8_WAIT_V(0);
    if (wr == 0) PG8_BAR;
    PG8_BAR;
#undef PG8_SA
#undef PG8_SB
#undef PG8_STAGE
#undef PG8_STAGE_A
#undef PG8_GOFF
#undef PG8_LDA
#undef PG8_LDB
#undef PG8_MMA
#undef PG8_WAIT_V
#undef PG8_WAIT_L
#undef PG8_BAR
#undef PG8_SCHED
}
}

DEVI void conv_item(const float* __restrict__ W, int K, int N, bf16_t* __restrict__ Wt, int kb, int nb, int lane) {
    const int ko = lane & 7, nq = lane >> 3;
    const float* src = W + (size_t)(kb * 64 + ko * 8) * N + nb * 32 + nq * 4;
    f32x4 v[8];
#pragma unroll
    for (int kk = 0; kk < 8; ++kk) v[kk] = *(const f32x4*)(src + (size_t)kk * N);
    bf16_t* dst = Wt + (size_t)(nb * 32 + nq * 4) * K + kb * 64 + ko * 8;
#pragma unroll
    for (int i = 0; i < 4; ++i) { u32x4 o; o.x = cvt_pk_bf16(v[0][i], v[1][i]); o.y = cvt_pk_bf16(v[2][i], v[3][i]); o.z = cvt_pk_bf16(v[4][i], v[5][i]); o.w = cvt_pk_bf16(v[6][i], v[7][i]);
        *(u32x4*)(dst + (size_t)i * K) = o; }
}

namespace att {
typedef short s16x4 __attribute__((ext_vector_type(4)));
typedef float f32x16 __attribute__((ext_vector_type(16)));
constexpr int KVBLK = 64;
constexpr float SCALE = 0.10206207261596577f;
constexpr float THR = 8.f;
constexpr int SHM_V = 16384, SHM_K = 16384, NBUF = 3, SHM_ATTN = NBUF * SHM_V + NBUF * SHM_K + 8 * 64 * 4;
#define KSWZ(row, colB) ((row) * 256 + ((colB) ^ (((row) & 7) << 4)))
#define SBAR() __builtin_amdgcn_sched_barrier(0)
DEVI int crow(int r, int hi) { return (r & 3) + 8 * (r >> 2) + 4 * hi; }
DEVI void partialSM(f32x16& p0, f32x16& p1, float& m_reg, float& mn, float& alpha) {
    constexpr float C = SCALE * 1.4426950408889634f;
    float pmax = p0[0];
#pragma unroll
    for (int r = 1; r < 16; ++r) pmax = fmaxf(pmax, p0[r]);
#pragma unroll
    for (int r = 0; r < 16; ++r) pmax = fmaxf(pmax, p1[r]);
    { auto rr = __builtin_amdgcn_permlane32_swap(__float_as_uint(pmax), __float_as_uint(pmax), false, false);
      pmax = fmaxf(__uint_as_float(rr[0]), __uint_as_float(rr[1])); }
    if (__builtin_expect(__all(pmax - m_reg <= THR / SCALE), 1)) { mn = m_reg; alpha = 1.f; }
    else { mn = fmaxf(m_reg, pmax); alpha = __builtin_amdgcn_exp2f((m_reg - mn) * C); m_reg = mn; }
    const float mnC = -mn * C;
#pragma unroll
    for (int r = 0; r < 16; ++r) p0[r] = fmaf(p0[r], C, mnC);
#pragma unroll
    for (int r = 0; r < 16; ++r) p1[r] = fmaf(p1[r], C, mnC);
#pragma unroll
    for (int r = 0; r < 16; ++r) p0[r] = __builtin_amdgcn_exp2f(p0[r]);
}
DEVI void finishSM(f32x16& p0, f32x16& p1, float alpha, float& l_reg, bf16x8& pa0, bf16x8& pa1, bf16x8& pa2, bf16x8& pa3) {
#pragma unroll
    for (int r = 0; r < 16; ++r) p1[r] = __builtin_amdgcn_exp2f(p1[r]);
    float ps = 0.f;
#pragma unroll
    for (int r = 0; r < 16; ++r) ps += p0[r];
#pragma unroll
    for (int r = 0; r < 16; ++r) ps += p1[r];
    { auto rr = __builtin_amdgcn_permlane32_swap(__float_as_uint(ps), __float_as_uint(ps), false, false);
      ps = __uint_as_float(rr[0]) + __uint_as_float(rr[1]); }
    l_reg = l_reg * alpha + ps;
#define PK4(P, BASE, OUT) do { unsigned a0 = cvt_pk_bf16(P[BASE + 0], P[BASE + 1]), a1 = cvt_pk_bf16(P[BASE + 2], P[BASE + 3]);   \
    unsigned b0 = cvt_pk_bf16(P[BASE + 4], P[BASE + 5]), b1 = cvt_pk_bf16(P[BASE + 6], P[BASE + 7]);                              \
    auto r0 = __builtin_amdgcn_permlane32_swap(a0, b0, false, false); auto r1 = __builtin_amdgcn_permlane32_swap(a1, b1, false, false); \
    u32x4 w = {r0[0], r1[0], r0[1], r1[1]}; OUT = *reinterpret_cast<bf16x8*>(&w); } while (0)
    PK4(p0, 0, pa0); PK4(p0, 8, pa1); PK4(p1, 0, pa2); PK4(p1, 8, pa3);
#undef PK4
}
DEVI void qkt(f32x16& p0, f32x16& p1, const char* Ks, const bf16x8* qr, int r32, int hi) {
    p0 = f32x16{}; p1 = f32x16{};
#pragma unroll
    for (int d0 = 0; d0 < 6; ++d0) { const int cb = (d0 * 16 + hi * 8) * 2;
        const bf16x8 b0 = *reinterpret_cast<const bf16x8*>(Ks + KSWZ(r32, cb));
        const bf16x8 b1 = *reinterpret_cast<const bf16x8*>(Ks + KSWZ(32 + r32, cb));
        p0 = __builtin_amdgcn_mfma_f32_32x32x16_bf16(b0, qr[d0], p0, 0, 0, 0);
        p1 = __builtin_amdgcn_mfma_f32_32x32x16_bf16(b1, qr[d0], p1, 0, 0, 0); }
}
DEVI int v_st(int k, int c) { const int kk = (k & ~0xC) | ((k & 4) << 1) | ((k & 8) >> 1); return ((kk >> 3) * 4 + (c >> 5)) * 512 + ((kk & 7) * 32 + (c & 31)) * 2; }
DEVI int v_rd_base(int lane) { return ((lane & 3) << 3) | (((lane >> 2) & 3) << 6) | (((lane >> 4) & 1) << 5) | (((lane >> 5) & 1) << 8); }
constexpr int v_rd_off(int d0, int ks, int half) { return d0 * 512 + ks * 4096 + half * 2048; }
template <int OFF> DEVI s16x4 tr_read(int vb) {
    s16x4 r; asm volatile("ds_read_b64_tr_b16 %0, %1 offset:%2" : "=&v"(r) : "v"(vb), "i"(OFF) : "memory"); return r;
}
template <int D0> DEVI void pv_one(f32x16& od, int vb, bf16x8 pa0, bf16x8 pa1, bf16x8 pa2, bf16x8 pa3) {
    const s16x4 l0 = tr_read<v_rd_off(D0, 0, 0)>(vb), h0 = tr_read<v_rd_off(D0, 0, 1)>(vb), l1 = tr_read<v_rd_off(D0, 1, 0)>(vb), h1 = tr_read<v_rd_off(D0, 1, 1)>(vb);
    const s16x4 l2 = tr_read<v_rd_off(D0, 2, 0)>(vb), h2 = tr_read<v_rd_off(D0, 2, 1)>(vb), l3 = tr_read<v_rd_off(D0, 3, 0)>(vb), h3 = tr_read<v_rd_off(D0, 3, 1)>(vb);
    asm volatile("s_waitcnt lgkmcnt(0)" ::: "memory"); SBAR();
#define PKV(L, H) (bf16x8){L[0], L[1], L[2], L[3], H[0], H[1], H[2], H[3]}
    od = __builtin_amdgcn_mfma_f32_32x32x16_bf16(pa0, PKV(l0, h0), od, 0, 0, 0);
    od = __builtin_amdgcn_mfma_f32_32x32x16_bf16(pa1, PKV(l1, h1), od, 0, 0, 0);
    od = __builtin_amdgcn_mfma_f32_32x32x16_bf16(pa2, PKV(l2, h2), od, 0, 0, 0);
    od = __builtin_amdgcn_mfma_f32_32x32x16_bf16(pa3, PKV(l3, h3), od, 0, 0, 0);
#undef PKV
}
DEVI void pv_d0(f32x16* o, int vb, bf16x8 pa0, bf16x8 pa1, bf16x8 pa2, bf16x8 pa3) {
    pv_one<0>(o[0], vb, pa0, pa1, pa2, pa3); pv_one<1>(o[1], vb, pa0, pa1, pa2, pa3);
}
DEVI void attn_unit(const bf16_t* __restrict__ Qb, const bf16_t* __restrict__ Kh, const bf16_t* __restrict__ Vh, int seq, bf16_t* __restrict__ Ob, int ldo, char* lds) {
    const int tid = tid_(), wid = tid >> 6, lane = tid & 63, r32 = lane & 31, hi = lane >> 5;
    char* V_lds = lds; char* K_lds = lds + NBUF * SHM_V;
    float* wsl = (float*)(lds + NBUF * SHM_V + NBUF * SHM_K) + wid * 64; float* li_l = wsl; float* al_l = wsl + 32;
    float m_reg = -1e30f, l_reg = 0.f; f32x16 o[2] = {}; bf16x8 qr[6];
    const bf16_t* Qw = Qb + (size_t)(wid * 32 + r32) * 96 + hi * 8;
#pragma unroll
    for (int d0 = 0; d0 < 6; ++d0) qr[d0] = *reinterpret_cast<const bf16x8*>(Qw + d0 * 16);
    const int sr = tid >> 4, kc = tid & 15, kcl = (kc < 12 ? kc : 11) * 8;
    const int vr = tid >> 3, vc = (tid & 7) * 8, vst0 = v_st(vr, vc);
    const int kst0 = KSWZ(sr, kc * 16), kst1 = KSWZ(32 + sr, kc * 16);
    const int vb0 = (int)(uintptr_t)V_lds + v_rd_base(lane);
    bf16x8 sv0, sk00, sk01, sv1, sk10, sk11;
#define SLOAD0(k0) do { sv0 = *reinterpret_cast<const bf16x8*>(Vh + (size_t)((k0) + vr) * 64 + vc); sk00 = *reinterpret_cast<const bf16x8*>(Kh + (size_t)((k0) + sr) * 96 + kcl); \
    sk01 = *reinterpret_cast<const bf16x8*>(Kh + (size_t)((k0) + 32 + sr) * 96 + kcl); } while (0)
#define SLOAD1(k0) do { sv1 = *reinterpret_cast<const bf16x8*>(Vh + (size_t)((k0) + vr) * 64 + vc); sk10 = *reinterpret_cast<const bf16x8*>(Kh + (size_t)((k0) + sr) * 96 + kcl); \
    sk11 = *reinterpret_cast<const bf16x8*>(Kh + (size_t)((k0) + 32 + sr) * 96 + kcl); } while (0)
#define SWRITE0(b) do { *(bf16x8*)(V_lds + (b) * SHM_V + vst0) = sv0; *(bf16x8*)(K_lds + (b) * SHM_K + kst0) = sk00; *(bf16x8*)(K_lds + (b) * SHM_K + kst1) = sk01; } while (0)
#define SWRITE1(b) do { *(bf16x8*)(V_lds + (b) * SHM_V + vst0) = sv1; *(bf16x8*)(K_lds + (b) * SHM_K + kst0) = sk10; *(bf16x8*)(K_lds + (b) * SHM_K + kst1) = sk11; } while (0)
#define SWAIT() asm volatile("s_waitcnt vmcnt(3)" ::: "memory")
#define RESC(a) do { if (__any((a) < 1.f)) { if (hi == 0) al_l[r32] = (a); asm volatile("s_waitcnt lgkmcnt(0)" ::: "memory"); \
    _Pragma("unroll") for (int d = 0; d < 2; ++d) _Pragma("unroll") for (int r = 0; r < 16; ++r) o[d][r] *= al_l[crow(r, hi)]; } } while (0)
#define BNEXT(b) ((b) == NBUF - 1 ? 0 : (b) + 1)
    f32x16 pA0, pA1, pB0, pB1; float mnA, mnB, alA, alB; bf16x8 pa0, pa1, pa2, pa3; const int NT = seq / KVBLK;
    SLOAD0(0); asm volatile("s_waitcnt vmcnt(0)" ::: "memory"); SWRITE0(0); __syncthreads();
    qkt(pA0, pA1, K_lds, qr, r32, hi); partialSM(pA0, pA1, m_reg, mnA, alA);
    SLOAD1(KVBLK); if (2 < NT) SLOAD0(2 * KVBLK);
    SWAIT(); SWRITE1(1); __syncthreads();
    int bp = 0, bc = 1, bn = 2;
    for (int j = 1; j + 1 < NT; j += 2) {
        SBAR(); qkt(pB0, pB1, K_lds + bc * SHM_K, qr, r32, hi);
        finishSM(pA0, pA1, alA, l_reg, pa0, pa1, pa2, pa3); SBAR();
        SLOAD1((j + 2) * KVBLK); SBAR();
        pv_d0(o, vb0 + bp * SHM_V, pa0, pa1, pa2, pa3); partialSM(pB0, pB1, m_reg, mnB, alB);
        SWAIT(); SWRITE0(bn);
        RESC(alB); __syncthreads();
        bp = bc; bc = bn; bn = BNEXT(bn);
        SBAR(); qkt(pA0, pA1, K_lds + bc * SHM_K, qr, r32, hi);
        finishSM(pB0, pB1, alB, l_reg, pa0, pa1, pa2, pa3); SBAR();
        if (j + 3 < NT) SLOAD0((j + 3) * KVBLK); SBAR();
        pv_d0(o, vb0 + bp * SHM_V, pa0, pa1, pa2, pa3); partialSM(pA0, pA1, m_reg, mnA, alA);
        SWAIT(); SWRITE1(bn);
        RESC(alA); __syncthreads();
        bp = bc; bc = bn; bn = BNEXT(bn);
    }
    SBAR(); qkt(pB0, pB1, K_lds + bc * SHM_K, qr, r32, hi);
    finishSM(pA0, pA1, alA, l_reg, pa0, pa1, pa2, pa3); SBAR();
    pv_d0(o, vb0 + bp * SHM_V, pa0, pa1, pa2, pa3); partialSM(pB0, pB1, m_reg, mnB, alB);
    RESC(alB);
    finishSM(pB0, pB1, alB, l_reg, pa0, pa1, pa2, pa3); SBAR();
    pv_d0(o, vb0 + bc * SHM_V, pa0, pa1, pa2, pa3);
    if (hi == 0) li_l[r32] = l_reg; asm volatile("s_waitcnt lgkmcnt(0)" ::: "memory");
    float rli[16];
#pragma unroll
    for (int r = 0; r < 16; ++r) rli[r] = __builtin_amdgcn_rcpf(li_l[crow(r, hi)]);
    bf16_t* Ow = Ob + (size_t)(wid * 32) * ldo;
#pragma unroll
    for (int r = 0; r < 16; ++r) { const int orow = crow(r, hi);
#pragma unroll
        for (int d0 = 0; d0 < 2; ++d0) Ow[(size_t)orow * ldo + d0 * 32 + r32] = f2bf(o[d0][r] * rli[r]); }
    __syncthreads();
#undef SLOAD0
#undef SLOAD1
#undef SWRITE0
#undef SWRITE1
#undef SWAIT
#undef RESC
#undef BNEXT
}
#undef KSWZ
#undef SBAR
}

template <class ARow, class BMap, class Epi>
DEVI void gemm_tile(int K, ARow arow, const float* __restrict__ B, int ldb, BMap bmap, Epi epi, float* smem) {
    float (*As)[132] = (float (*)[132])smem;
    float (*Bs)[64] = (float (*)[64])(smem + 16 * 132);
    const int tid = tid_(), ty = tid >> 4, tx = tid & 15;
    float acc[4][4];
#pragma unroll
    for (int i = 0; i < 4; ++i)
#pragma unroll
        for (int j = 0; j < 4; ++j) acc[i][j] = 0.f;
    const int ar = tid >> 2, akq = tid & 3;
    const float* ap = arow(ar);
    const int bk0 = tid >> 6, bc = tid & 63;
    const int bcol = bmap(bc);
    for (int k0 = 0; k0 < K; k0 += 16) {
        float4 av = make_float4(0.f, 0.f, 0.f, 0.f);
        if (ap) av = *(const float4*)(ap + k0 + akq * 4);
        float b0 = 0.f, b1 = 0.f;
        if (bcol >= 0) { b0 = B[(size_t)(k0 + bk0) * ldb + bcol]; b1 = B[(size_t)(k0 + bk0 + 8) * ldb + bcol]; }
        __syncthreads();
        As[akq * 4 + 0][ar] = av.x; As[akq * 4 + 1][ar] = av.y; As[akq * 4 + 2][ar] = av.z; As[akq * 4 + 3][ar] = av.w;
        Bs[bk0][bc] = b0; Bs[bk0 + 8][bc] = b1;
        __syncthreads();
#pragma unroll
        for (int kk = 0; kk < 16; ++kk) {
            const float4 a = *(const float4*)&As[kk][ty * 4];
            const float4 b = *(const float4*)&Bs[kk][tx * 4];
            const float aa[4] = {a.x, a.y, a.z, a.w}, bb[4] = {b.x, b.y, b.z, b.w};
#pragma unroll
            for (int i = 0; i < 4; ++i)
#pragma unroll
                for (int j = 0; j < 4; ++j) acc[i][j] = fmaf(aa[i], bb[j], acc[i][j]);
        }
    }
#pragma unroll
    for (int i = 0; i < 4; ++i) epi(ty * 4 + i, tx, acc[i]);
    __syncthreads();
}


struct UnitRange { int lo, hi, step; };
DEVI UnitRange unit_range(int nunits, int bid) {
    UnitRange r;
    if ((gridDim.x & 7) == 0) { const int x = bid & 7, j = bid >> 3; r.lo = (int)(((long)nunits * x) >> 3) + j; r.hi = (int)(((long)nunits * (x + 1)) >> 3); r.step = gridDim.x >> 3; }
    else { r.lo = bid; r.hi = nunits; r.step = gridDim.x; }
    return r;
}


template <bool REV> DEVI void scan16(float& a, float& b) {
#define SC_STEP(N_) do { const int ctrl_ = (REV ? 0x100 : 0x110) | (N_); \
        const float pa = __int_as_float(__builtin_amdgcn_update_dpp(0x3f800000, __float_as_int(a), ctrl_, 0xf, 0xf, false)); \
        const float pb = __int_as_float(__builtin_amdgcn_update_dpp(0, __float_as_int(b), ctrl_, 0xf, 0xf, false)); \
        b = fmaf(a, pb, b); a = a * pa; } while (0)
    SC_STEP(1); SC_STEP(2); SC_STEP(4); SC_STEP(8);
#undef SC_STEP
}

__device__ void phase_convert(const Params& p) {
    float* const ws = (float*)(gfloat_t*)tab_ld(N_IN);
    const float* const pin_I_WIN = PIN(I_WIN);
    const float* const pin_I_WOUT = PIN(I_WOUT);
    const int tid = tid_(), bid = bid_();
    const int lane = tid & 63, gw = bid * (NTHR / 64) + __builtin_amdgcn_readfirstlane(tid >> 6), nw = gridDim.x * (NTHR / 64);
    constexpr int NI_OUT = NLAYER * 16 * 32, NI_IN = NLAYER * 16 * 51;
    bf16_t* wout = (bf16_t*)(ws + W_WOUT); bf16_t* win = (bf16_t*)(ws + W_WIN);
    for (int it = gw; it < NI_OUT + NI_IN; it += nw) {
        int r = it;
        if (r < NI_OUT) { const int mat = r >> 9, q = r & 511; conv_item(pin_I_WOUT + (size_t)mat * D * D, D, D, wout + (size_t)mat * D * D, q >> 5, q & 31, lane); continue; }
        r -= NI_OUT;
        { const int mat = r / 816, q = r % 816; conv_item(pin_I_WIN + (size_t)mat * D * INC, D, INC, win + (size_t)mat * NPAD_IN * D, q / 51, q % 51, lane); }
    }
}
DEVI void conv_item2(const float* __restrict__ W0, int N0, bf16_t* __restrict__ T0, int kb0, int nb0, const float* __restrict__ W1, int N1, bf16_t* __restrict__ T1, int kb1, int nb1, int lane) {
    constexpr int K = D;
    const int ko = lane & 7, nq = lane >> 3;
    const float* s0 = W0 + (size_t)(kb0 * 64 + ko * 8) * N0 + nb0 * 32 + nq * 4; const float* s1 = W1 + (size_t)(kb1 * 64 + ko * 8) * N1 + nb1 * 32 + nq * 4;
    f32x4 v[8], w[8];
#pragma unroll
    for (int kk = 0; kk < 8; ++kk) v[kk] = __builtin_nontemporal_load((const f32x4*)(s0 + (size_t)kk * N0));
#pragma unroll
    for (int kk = 0; kk < 8; ++kk) w[kk] = __builtin_nontemporal_load((const f32x4*)(s1 + (size_t)kk * N1));
    bf16_t* d0 = T0 + (size_t)(nb0 * 32 + nq * 4) * K + kb0 * 64 + ko * 8; bf16_t* d1 = T1 + (size_t)(nb1 * 32 + nq * 4) * K + kb1 * 64 + ko * 8;
#pragma unroll
    for (int i = 0; i < 4; ++i) { u32x4 o; o.x = cvt_pk_bf16(v[0][i], v[1][i]); o.y = cvt_pk_bf16(v[2][i], v[3][i]); o.z = cvt_pk_bf16(v[4][i], v[5][i]); o.w = cvt_pk_bf16(v[6][i], v[7][i]);
        *(u32x4*)(d0 + (size_t)i * K) = o; }
#pragma unroll
    for (int i = 0; i < 4; ++i) { u32x4 o; o.x = cvt_pk_bf16(w[0][i], w[1][i]); o.y = cvt_pk_bf16(w[2][i], w[3][i]); o.z = cvt_pk_bf16(w[4][i], w[5][i]); o.w = cvt_pk_bf16(w[6][i], w[7][i]);
        *(u32x4*)(d1 + (size_t)i * K) = o; }
}
constexpr int NI_MOE = NEXP * 16 * 64 + NEXP * 16 * 32;
__device__ void conv_moe(const Params& p, int l, int quota) {
    float* const ws = (float*)(gfloat_t*)tab_ld(N_IN);
    const float* const pin_I_WDN = PIN(I_WDN);
    const float* const pin_I_WGU = PIN(I_WGU);
    const int tid = tid_(), bid = bid_();
    const int lane = tid & 63;
    int* cursor = (int*)(ws + W_BAR) + 3584 + l * 64;
    bf16_t* wgu = (bf16_t*)(ws + W_WGU) + (size_t)l * NEXP * 2048 * D; bf16_t* wdn = (bf16_t*)(ws + W_WDN) + (size_t)l * NEXP * D * D;
    const float* sgu = pin_I_WGU + (size_t)l * NEXP * D * 2048; const float* sdn = pin_I_WDN + (size_t)l * NEXP * D * D;
#define CONV_DEC(it, S_, N_, T_, KB_, NB_) const float* S_; bf16_t* T_; int N_, KB_, NB_; \
        if ((it) < NEXP * 1024) { const int mat = (it) >> 10, q = (it) & 1023; S_ = sgu + (size_t)mat * D * 2048; N_ = 2048; T_ = wgu + (size_t)mat * 2048 * D; KB_ = q >> 6; NB_ = q & 63; } \
        else { const int r_ = (it) - NEXP * 1024, mat = r_ >> 9, q = r_ & 511; S_ = sdn + (size_t)mat * D * D; N_ = D; T_ = wdn + (size_t)mat * D * D; KB_ = q >> 5; NB_ = q & 31; }
#define CONV_PAIR(i0, i1) do { CONV_DEC(i0, sa_, na_, ta_, ka_, ba_) CONV_DEC(i1, sb_, nb_, tb_, kb_, bb_) conv_item2(sa_, na_, ta_, ka_, ba_, sb_, nb_, tb_, kb_, bb_, lane); } while (0)
    if (quota > 0) {
        int c0 = 0;
        if (lane == 0) c0 = atomicAdd(cursor, quota);
        c0 = __builtin_amdgcn_readfirstlane(c0);
        for (int it = c0; it < c0 + quota && it + 1 < NI_MOE; it += 2) CONV_PAIR(it, it + 1);
    } else {
        int c0 = __hip_atomic_load(cursor, __ATOMIC_RELAXED, __HIP_MEMORY_SCOPE_AGENT);
        c0 = __builtin_amdgcn_readfirstlane(c0); if (c0 > NI_MOE) c0 = NI_MOE;
        const int gw = bid * (NTHR / 64) + __builtin_amdgcn_readfirstlane(tid >> 6), nw = gridDim.x * (NTHR / 64);
        for (int it = c0 + 2 * gw; it + 1 < NI_MOE; it += 2 * nw) CONV_PAIR(it, it + 1);
    }
#undef CONV_DEC
#undef CONV_PAIR
}

__device__ void phase_tables(const Params& p) {
    float* const ws = (float*)(gfloat_t*)tab_ld(N_IN);
    const float* const pin_I_LAM = PIN(I_LAM);
    const float* const pin_I_SGWS = PIN(I_SGWS);
    const int tid = tid_(), bid = bid_(); (void)tid; (void)bid;
    for (int i = bid * NTHR + tid; i < NLAYER * 4 * 128 * 128; i += gridDim.x * NTHR) ((bf16_t*)(ws + W_WSB))[i] = f2bf(pin_I_SGWS[i]);
    for (int i = bid * NTHR + tid; i < NLAT * 16; i += gridDim.x * NTHR) {
        const int t = i >> 4, f = i & 15; const float pos = (f < 8) ? (float)(t >> 6) : (float)(t & 63);
        const float ang = pos * powf(10000.f, -(float)(f & 7) / 8.f);
        ws[W_ROPE + (size_t)t * 32 + f] = cosf(ang); ws[W_ROPE + (size_t)t * 32 + 16 + f] = sinf(ang);
    }
    if (bid == 1) for (int i = tid; i < NLAYER * 2 * 256; i += NTHR) ws[W_SP + i] = log1pf(expf(-pin_I_LAM[i]));
    if (bid == 0) for (int i = tid; i < NLAYER * NEXP * 64; i += NTHR) ((int*)(ws + W_CNT))[i] = 0;
}

DEVI void norm1_store(const Params& p, int l, int t, int lane, const float4 (&v)[4]) {
    const float* g = p.in[I_NMIX] + l * D;
    const float* mod = p.ws + W_MOD + (size_t)(l * 2 + (t >= NLAT ? 1 : 0)) * 6144;
    float ss = 0.f;
#pragma unroll
    for (int j = 0; j < 4; ++j) ss += v[j].x * v[j].x + v[j].y * v[j].y + v[j].z * v[j].z + v[j].w * v[j].w;
    const float rstd = rsqrtf(wave_sum(ss) * (1.f / D) + EPS);
    bf16_t* hb = (bf16_t*)(p.ws + W_HB) + (size_t)t * D;
#pragma unroll
    for (int j = 0; j < 4; ++j) {
        const int c = j * 256 + lane * 4;
        const float4 gg = *(const float4*)(g + c), s1 = *(const float4*)(mod + D + c), s0 = *(const float4*)(mod + c);
        u32x2 w; w.x = cvt_pk_bf16(v[j].x * rstd * gg.x * (1.f + s1.x) + s0.x, v[j].y * rstd * gg.y * (1.f + s1.y) + s0.y);
        w.y = cvt_pk_bf16(v[j].z * rstd * gg.z * (1.f + s1.z) + s0.z, v[j].w * rstd * gg.w * (1.f + s1.w) + s0.w);
        *(u32x2*)(hb + c) = w;
    }
}
__device__ void phase_init(const Params& p) {
    float* const ws = (float*)(gfloat_t*)tab_ld(N_IN);
    const float* const pin_I_CTX = PIN(I_CTX);
    const float* const pin_I_X = PIN(I_X);
    const int tid = tid_(), bid = bid_();
    const int lane = tid & 63, gw = bid * (NTHR / 64) + __builtin_amdgcn_readfirstlane(tid >> 6), nw = gridDim.x * (NTHR / 64);
    for (int t = gw; t < T; t += nw) {
        const float* src = (t < NLAT) ? pin_I_X + (size_t)t * D : pin_I_CTX + (size_t)(t - NLAT) * D;
        float4 v[4];
#pragma unroll
        for (int j = 0; j < 4; ++j) { v[j] = *(const float4*)(src + j * 256 + lane * 4); if (t >= NLAT) *(float4*)(ws + W_X + (size_t)t * D + j * 256 + lane * 4) = v[j]; }
        norm1_store(p, 0, t, lane, v);
    }
}

__device__ void phase_mod(const Params& p, float* smem) {
    float* const ws = (float*)(gfloat_t*)tab_ld(N_IN);
    const float* const pin_I_BMOD = PIN(I_BMOD);
    const float* const pin_I_C = PIN(I_C);
    const float* const pin_I_CCTX = PIN(I_CCTX);
    const float* const pin_I_WMOD = PIN(I_WMOD);
    const int tid = tid_(), bid = bid_();
    const int wave = tid >> 6, lane = tid & 63;
    float* sc = smem + 1024;
    for (int i = tid; i < 1024; i += NTHR) { sc[i] = silu(pin_I_C[i]); sc[1024 + i] = silu(pin_I_CCTX[i]); }
    __syncthreads();
    for (int it = bid; it < NLAYER * 96; it += gridDim.x) {
        const int l = it / 96, j = (it % 96) * 64 + lane;
        const float* W = pin_I_WMOD + (size_t)l * 1024 * 6144 + j;
        float a0 = 0.f, a1 = 0.f;
        for (int k0 = wave * 128; k0 < wave * 128 + 128; k0 += 16) {
            float w[16];
#pragma unroll
            for (int q = 0; q < 16; ++q) w[q] = W[(size_t)(k0 + q) * 6144];
#pragma unroll
            for (int q = 0; q < 16; ++q) { a0 = fmaf(sc[k0 + q], w[q], a0); a1 = fmaf(sc[1024 + k0 + q], w[q], a1); }
        }
        smem[(wave * 2 + 0) * 64 + lane] = a0; smem[(wave * 2 + 1) * 64 + lane] = a1;
        __syncthreads();
        if (wave < 2) {
            float s = 0.f;
            for (int w = 0; w < 8; ++w) s += smem[(w * 2 + wave) * 64 + lane];
            ws[W_MOD + (size_t)(l * 2 + wave) * 6144 + j] = s + pin_I_BMOD[l * 6144 + j];
        }
        __syncthreads();
    }
}


struct InprojSched {
    UnitRange ur; const char* A; const char* Bt;
    DEVI bool next(int i, pg8::Unit& u) const {
        const int id = ur.lo + i * ur.step; if (id >= ur.hi) return false;
        const int tm = id / 7, tn = id % 7;
        u.a = A + (size_t)tm * 256 * D * 2; u.b = Bt + (size_t)tn * 256 * D * 2; u.x0 = tm * 256; u.x1 = tn * 256; u.x2 = 0; u.g = nullptr; u.gn = 0; return true;
    }
};
struct EpiInproj { static constexpr bool PERM = true; bf16_t* P;
    DEVI void operator()(const f32x4 (&acc)[2][2][4][2], const pg8::Unit& u, int wr, int wc, int fr, int fq) const {
#pragma unroll
        for (int ai = 0; ai < 2; ++ai)
#pragma unroll
            for (int m = 0; m < 4; ++m) { bf16_t* row = P + (size_t)(u.x0 + ai * 128 + wr * 64 + m * 16 + fr) * INC;
#pragma unroll
                for (int bj = 0; bj < 2; ++bj) { const int c = u.x1 + bj * 128 + wc * 32 + 8 * fq;
                    if (c < INC) { const f32x4 v0 = acc[ai][bj][m][0], v1 = acc[ai][bj][m][1];
                        u32x4 w; w.x = cvt_pk_bf16(v0[0], v0[1]); w.y = cvt_pk_bf16(v0[2], v0[3]); w.z = cvt_pk_bf16(v1[0], v1[1]); w.w = cvt_pk_bf16(v1[2], v1[3]);
                        *(u32x4*)(row + c) = w; } } }
    }
};
__device__ void phase_inproj(const Params& p, int l, char* lds) {
    float* const ws = (float*)(gfloat_t*)tab_ld(N_IN);
    const int tid = tid_(), bid = bid_(); (void)tid;
    InprojSched S; S.ur = unit_range((T / 256) * 7, bid); S.A = (const char*)(ws + W_HB); S.Bt = (const char*)((const bf16_t*)(ws + W_WIN) + (size_t)l * NPAD_IN * D);
    EpiInproj E; E.P = (bf16_t*)(ws + W_P);
    pg8::gemm_phase((PG8_LAS unsigned char*)lds, D, (size_t)128 * D * 2, S, E);
    { const int mine = (S.ur.hi - S.ur.lo + S.ur.step - 1) / S.ur.step, most = ((T / 256) * 7 / 8 + 1 + S.ur.step - 1) / S.ur.step;
      if (mine < most) conv_moe(p, l, 12); }
}

__device__ void phase_prep1(const Params& p, int l) {
    float* const ws = (float*)(gfloat_t*)tab_ld(N_IN);
    const float* const pin_I_CONVB = PIN(I_CONVB);
    const float* const pin_I_CONVW = PIN(I_CONVW);
    const float* const pin_I_KVAN = PIN(I_KVAN);
    const float* const pin_I_QAN = PIN(I_QAN);
    const float* const pin_I_SGB = PIN(I_SGB);
    const float* const pin_I_SGG = PIN(I_SGG);
    const int tid = tid_(), bid = bid_(); (void)tid; (void)bid;
    const int lane = tid & 63, gw = bid * (NTHR / 64) + __builtin_amdgcn_readfirstlane(tid >> 6), nw = gridDim.x * (NTHR / 64);
    float qan[3], kvan[2];
#pragma unroll
    for (int j = 0; j < 3; ++j) qan[j] = pin_I_QAN[l * 192 + j * 64 + lane];
#pragma unroll
    for (int j = 0; j < 2; ++j) kvan[j] = pin_I_KVAN[l * 128 + j * 64 + lane];
    const f32x4 sgg = *(const f32x4*)(pin_I_SGG + l * 256 + lane * 4), sgb = *(const f32x4*)(pin_I_SGB + l * 256 + lane * 4);
    const f32x4 cb = *(const f32x4*)(pin_I_CONVB + l * 256 + lane * 4);
    f32x4 cw[4];
#pragma unroll
    for (int k = 0; k < 4; ++k) cw[k] = *(const f32x4*)(pin_I_CONVW + (size_t)l * 4 * 256 + k * 256 + lane * 4);
    const int g = lane >> 4, w = 2 << g;
    const bf16_t* P = (const bf16_t*)(ws + W_P);
    for (int t = gw; t < T; t += nw) {
        const int s0 = (t < NLAT) ? 0 : NLAT, sl = (t < NLAT) ? NLAT : NCTX, n = t - s0;
        const bf16_t* pr = P + (size_t)t * INC;
        const int lo = max(n - w / 2, 0), hi = min(n + w / 2, sl);
        f32x4 pw[16];
#pragma unroll
        for (int j = 0; j < 16; ++j) { const int m = min(lo + j, hi - 1); pw[j] = ld4bf(P + (size_t)(s0 + m) * INC + OFF_A + lane * 4); }
        const f32x4 xa = ld4bf(pr + OFF_A + lane * 4);
        float qv[3], kvv[2];
#pragma unroll
        for (int j = 0; j < 3; ++j) qv[j] = bf2f(pr[OFF_Q + j * 64 + lane]);
#pragma unroll
        for (int j = 0; j < 2; ++j) kvv[j] = bf2f(pr[OFF_KV + j * 64 + lane]);
        const f32x4 zu = ld4bf(pr + OFF_C + lane * 4), zv = ld4bf(pr + OFF_C + 256 + lane * 4);
        f32x4 xc[4];
#pragma unroll
        for (int k = 0; k < 4; ++k) { const int m = min(max(n - 1 + k, 0), sl - 1); xc[k] = ld4bf(P + (size_t)(s0 + m) * INC + OFF_DX + lane * 4); }
        {   f32x4 sacc = (f32x4){0.f, 0.f, 0.f, 0.f};
#pragma unroll
            for (int j = 0; j < 16; ++j) sacc = sacc + ((lo + j < hi) ? pw[j] : (f32x4){0.f, 0.f, 0.f, 0.f});
            const float inv = 1.f / (float)(hi - lo);
            const f32x4 d = sacc * inv - xa;
            u32x2 o; o.x = cvt_pk_bf16(d[0], d[1]); o.y = cvt_pk_bf16(d[2], d[3]); *(u32x2*)((bf16_t*)(ws + W_DIFF) + (size_t)t * 256 + lane * 4) = o; }
        {   const float rq = rsqrtf(wave_sum(qv[0] * qv[0] + qv[1] * qv[1] + qv[2] * qv[2]) * (1.f / 192.f) + EPS);
#pragma unroll
            for (int j = 0; j < 3; ++j) ((bf16_t*)(ws + W_QN))[(size_t)t * 192 + j * 64 + lane] = f2bf(qv[j] * rq * qan[j]);
            const float rk = rsqrtf(wave_sum(kvv[0] * kvv[0] + kvv[1] * kvv[1]) * (1.f / 128.f) + EPS);
#pragma unroll
            for (int j = 0; j < 2; ++j) ((bf16_t*)(ws + W_KVN))[(size_t)t * 128 + j * 64 + lane] = f2bf(kvv[j] * rk * kvan[j]); }
        {   f32x4 u, gv;
#pragma unroll
            for (int j = 0; j < 4; ++j) { u[j] = gelu_tanh(zu[j]); gv[j] = gelu_tanh(zv[j]); }
            *(f32x4*)(ws + W_U + (size_t)t * 256 + lane * 4) = u;
            const float mu = wave_sum(gv[0] + gv[1] + gv[2] + gv[3]) * (1.f / 256.f);
            gv = gv - mu;
            const float rstd = rsqrtf(wave_sum(gv[0] * gv[0] + gv[1] * gv[1] + gv[2] * gv[2] + gv[3] * gv[3]) * (1.f / 256.f) + EPS);
            *(f32x4*)(ws + W_VN + (size_t)t * 256 + lane * 4) = gv * rstd * sgg + sgb; }
        {   f32x4 o = cb;
#pragma unroll
            for (int k = 0; k < 4; ++k) { const int m = n - 1 + k; if (m >= 0 && m < sl) o = o + xc[k] * cw[k]; }
            u32x2 ob; ob.x = cvt_pk_bf16(o[0], o[1]); ob.y = cvt_pk_bf16(o[2], o[3]); *(u32x2*)((bf16_t*)(ws + W_XCB) + (size_t)t * 256 + lane * 4) = ob; }
    }
}

__device__ void phase_small(const Params& p, int l, char* lds) {
    float* const ws = (float*)(gfloat_t*)tab_ld(N_IN);
    const float* const pin_I_BA = PIN(I_BA);
    const float* const pin_I_BX = PIN(I_BX);
    const float* const pin_I_POOLS = PIN(I_POOLS);
    const float* const pin_I_POOLW = PIN(I_POOLW);
    const float* const pin_I_SGBS = PIN(I_SGBS);
    const float* const pin_I_WA = PIN(I_WA);
    const float* const pin_I_WUKV = PIN(I_WUKV);
    const float* const pin_I_WUQ = PIN(I_WUQ);
    const float* const pin_I_WX = PIN(I_WX);
    const int tid = tid_(), bid = bid_(); (void)tid;
    constexpr int NK = 19, NU1 = (T / 256) * NK, NU2 = NCHUNK * 2;
    bf16_t* Y = (bf16_t*)(ws + W_YC);
    for (int u = bid; u < NU1 + NU2; u += gridDim.x) {
        if (u < NU1) {
            const int tm = u / NK, kind = u % NK, m0 = tm * 256;
            if (kind < 11) {
                const bf16_t* A; int lda, K, ldb, nval; const float* B;
                if (kind < 4) { A = (const bf16_t*)(ws + W_DIFF) + kind * 64; lda = 256; K = 64; B = pin_I_POOLW + (size_t)(l * 4 + kind) * 64 * 64; ldb = 64; nval = 64; }
                else if (kind < 7) { A = (const bf16_t*)(ws + W_QN); lda = 192; K = 192; B = pin_I_WUQ + (size_t)l * 192 * 384 + (kind - 4) * 128; ldb = 384; nval = 128; }
                else { A = (const bf16_t*)(ws + W_KVN); lda = 128; K = 128; B = pin_I_WUKV + (size_t)l * 128 * 512 + (kind - 7) * 128; ldb = 512; nval = 128; }
                gemm_unit<false>(lds, K, [&](int r) { return A + (size_t)(m0 + r) * lda; }, B, B, ldb, nval,
                    [&](const f32x4 (&acc)[4][4], int wr, int wc, int fr, int fq) {
#pragma unroll
                        for (int m = 0; m < 4; ++m) { const int t = m0 + wr * 64 + m * 16 + fr;
#pragma unroll
                            for (int n = 0; n < 4; ++n) { const int c = wc * 64 + n * 16 + 4 * fq;
                                if (kind < 4) { if (wc == 0) { const f32x4 sc = *(const f32x4*)(pin_I_POOLS + l * 256 + kind * 64 + c); const f32x4 v = acc[m][n] * sc;
                                        u32x2 w; w.x = cvt_pk_bf16(v[0], v[1]); w.y = cvt_pk_bf16(v[2], v[3]); *(u32x2*)(Y + (size_t)t * D + kind * 64 + c) = w; } }
                                else if (kind < 7) { const f32x4 v_ = acc[m][n]; u32x2 w_; w_.x = cvt_pk_bf16(v_[0], v_[1]); w_.y = cvt_pk_bf16(v_[2], v_[3]); *(u32x2*)((bf16_t*)(ws + W_QUP) + (size_t)t * 384 + (kind - 4) * 128 + c) = w_; }
                                else { const f32x4 v_ = acc[m][n]; u32x2 w_; w_.x = cvt_pk_bf16(v_[0], v_[1]); w_.y = cvt_pk_bf16(v_[2], v_[3]); *(u32x2*)((bf16_t*)(ws + W_KVUP) + (size_t)t * 512 + (kind - 7) * 128 + c) = w_; } } }
                    });
            } else {
                const int d = (kind - 11) >> 2, h = (kind - 11) & 3;
                const bf16_t* A = (const bf16_t*)(ws + W_XCB) + h * 64;
                const float* Ba = pin_I_WA + (size_t)((l * 2 + d) * 4 + h) * 64 * 64; const float* Bx = pin_I_WX + (size_t)((l * 2 + d) * 4 + h) * 64 * 64;
                const int pb = (l * 2 + d) * 256 + h * 64;
                gemm_unit<true>(lds, 64, [&](int r) { return A + (size_t)(m0 + r) * 256; }, Ba, Bx, 64, 64,
                    [&](const f32x4 (&acc)[4][4], int wr, int wc, int fr, int fq) {
                        const int sub = tm * 4 + wr;
                        const int lane16 = (fr == (d ? 0 : 15));
#pragma unroll
                        for (int pp = 0; pp < 2; ++pp) { const int idx = (wc * 2 + pp) * 16 + 4 * fq;
                            const f32x4 ba = *(const f32x4*)(pin_I_BA + pb + idx), bx = *(const f32x4*)(pin_I_BX + pb + idx), sp = *(const f32x4*)(ws + W_SP + pb + idx);
                            f32x4 Hc = (f32x4){0.f, 0.f, 0.f, 0.f}, Ac = (f32x4){1.f, 1.f, 1.f, 1.f};
#pragma unroll
                            for (int mm = 0; mm < 4; ++mm) { const int m = d ? 3 - mm : mm; const int t = m0 + wr * 64 + m * 16 + fr;
                                const f32x4 xv = ld4bf((const bf16_t*)(ws + W_XCB) + (size_t)t * 256 + h * 64 + idx);
                                f32x4 av, dv;
#pragma unroll
                                for (int j = 0; j < 4; ++j) { const float r = fsigm(acc[m][2 * pp][j] + ba[j]), ig = fsigm(acc[m][2 * pp + 1][j] + bx[j]);
                                    const float loga = -8.f * r * sp[j], x2 = 2.f * loga;
                                    const float om = (x2 > -0.0625f) ? -x2 * (1.f + x2 * (0.5f + x2 * (0.16666667f + x2 * 0.041666668f))) : 1.f - fexp(x2);
                                    float a_ = fexp(loga), b_ = __builtin_amdgcn_sqrtf(om) * (ig * xv[j]);
                                    if (d) scan16<true>(a_, b_); else scan16<false>(a_, b_);
                                    b_ = fmaf(a_, Hc[j], b_); a_ = a_ * Ac[j];
                                    av[j] = a_; dv[j] = b_; }
                                { const f32x4 v_ = av; u32x2 w_; w_.x = cvt_pk_bf16(v_[0], v_[1]); w_.y = cvt_pk_bf16(v_[2], v_[3]); *(u32x2*)((bf16_t*)(ws + W_LA2) + ((size_t)d * T + t) * 256 + h * 64 + idx) = w_; }
                                { const f32x4 v_ = dv; u32x2 w_; w_.x = cvt_pk_bf16(v_[0], v_[1]); w_.y = cvt_pk_bf16(v_[2], v_[3]); *(u32x2*)((bf16_t*)(ws + W_LB2) + ((size_t)d * T + t) * 256 + h * 64 + idx) = w_; }
                                const int src = ((fq << 4) | (d ? 0 : 15)) << 2;
#pragma unroll
                                for (int j = 0; j < 4; ++j) { Ac[j] = __int_as_float(__builtin_amdgcn_ds_bpermute(src, __float_as_int(av[j]))); Hc[j] = __int_as_float(__builtin_amdgcn_ds_bpermute(src, __float_as_int(dv[j]))); }
                            }
                            if (lane16) { *(f32x4*)(ws + W_AGG + ((size_t)(sub * 2 + d) * 2 + 0) * 256 + h * 64 + idx) = Ac; *(f32x4*)(ws + W_AGG + ((size_t)(sub * 2 + d) * 2 + 1) * 256 + h * 64 + idx) = Hc; }
                        }
                    });
            }
        } else {
            const int v = u - NU1, c = v >> 1, hp = v & 1;
            const bf16_t* A = (const bf16_t*)(ws + W_WSB) + ((size_t)l * 512 + hp * 256) * 128;
            const float* B = ws + W_VN + (size_t)c * 128 * 256 + hp * 128;
            gemm_unit<false>(lds, 128, [&](int r) { return A + (size_t)r * 128; }, B, B, 256, 128,
                [&](const f32x4 (&acc)[4][4], int wr, int wc, int fr, int fq) {
                    if ((wr >> 1) == wc) {
                        const int h = hp * 2 + wc;
#pragma unroll
                        for (int m = 0; m < 4; ++m) { const int pp = (wr & 1) * 64 + m * 16 + fr, t = c * 128 + pp; const float bs = pin_I_SGBS[(l * 4 + h) * 128 + pp];
#pragma unroll
                            for (int n = 0; n < 4; ++n) { const int ch = h * 64 + n * 16 + 4 * fq; const f32x4 uu = *(const f32x4*)(ws + W_U + (size_t)t * 256 + ch);
                                const f32x4 o = uu * (acc[m][n] + bs);
                                u32x2 w; w.x = cvt_pk_bf16(o[0], o[1]); w.y = cvt_pk_bf16(o[2], o[3]); *(u32x2*)(Y + (size_t)t * D + 512 + ch) = w; } }
                    }
                });
        }
    }
}

__device__ void phase_prep2(const Params& p, int l) {
    float* const ws = (float*)(gfloat_t*)tab_ld(N_IN);
    const float* const pin_I_KN = PIN(I_KN);
    const float* const pin_I_QN = PIN(I_QN);
    const int tid = tid_(), bid = bid_();
    const int lane = tid & 63, gw = bid * (NTHR / 64) + __builtin_amdgcn_readfirstlane(tid >> 6), nw = gridDim.x * (NTHR / 64);
    {
        const int h = lane >> 4, j = lane & 15;
        const f32x4 qw = *(const f32x4*)(pin_I_QN + l * 96 + 4 * j), kw = *(const f32x4*)(pin_I_KN + l * 96 + 4 * j);
        const float qw1 = pin_I_QN[l * 96 + 64 + j], qw2 = pin_I_QN[l * 96 + 80 + j], kw1 = pin_I_KN[l * 96 + 64 + j], kw2 = pin_I_KN[l * 96 + 80 + j];
        for (int t = gw; t < T; t += nw) {
            const bool lat = t < NLAT;
            float cs = 1.f, sn = 0.f;
            if (lat) { cs = ws[W_ROPE + (size_t)t * 32 + j]; sn = ws[W_ROPE + (size_t)t * 32 + 16 + j]; }
            const bf16_t* qr = (const bf16_t*)(ws + W_QUP) + (size_t)t * 384 + h * 96; const bf16_t* kr = (const bf16_t*)(ws + W_KVUP) + (size_t)t * 512 + h * 128; const bf16_t* pr = (const bf16_t*)(ws + W_P) + (size_t)t * INC + OFF_KR;
            f32x4 qn = ld4bf(qr + 4 * j); float q1 = bf2f(qr[64 + j]), q2 = bf2f(qr[80 + j]);
            f32x4 kn = ld4bf(kr + 4 * j); float k1 = bf2f(pr[j]), k2 = bf2f(pr[16 + j]);
            const u32x2 vraw = *(const u32x2*)(kr + 64 + 4 * j);
            float sq = qn[0] * qn[0] + qn[1] * qn[1] + qn[2] * qn[2] + qn[3] * qn[3] + q1 * q1 + q2 * q2;
            float sk = kn[0] * kn[0] + kn[1] * kn[1] + kn[2] * kn[2] + kn[3] * kn[3] + k1 * k1 + k2 * k2;
#pragma unroll
            for (int o = 1; o < 16; o <<= 1) { sq += __shfl_xor(sq, o); sk += __shfl_xor(sk, o); }
            const float rq = rsqrtf(sq * (1.f / 96.f) + EPS), rk = rsqrtf(sk * (1.f / 96.f) + EPS);
            qn = qn * qw * rq; q1 *= qw1 * rq; q2 *= qw2 * rq; kn = kn * kw * rk; k1 *= kw1 * rk; k2 *= kw2 * rk;
            const float qa = q1 * cs - q2 * sn, qb = q1 * sn + q2 * cs, ka = k1 * cs - k2 * sn, kb = k1 * sn + k2 * cs;
            bf16_t* qo = (bf16_t*)(ws + W_Q) + ((size_t)h * T + t) * 96; bf16_t* ko = (bf16_t*)(ws + W_K) + ((size_t)h * T + t) * 96; bf16_t* vo = (bf16_t*)(ws + W_V) + ((size_t)h * T + t) * 64;
            { u32x2 w; w.x = cvt_pk_bf16(qn[0], qn[1]); w.y = cvt_pk_bf16(qn[2], qn[3]); *(u32x2*)(qo + 4 * j) = w; qo[64 + j] = f2bf(qa); qo[80 + j] = f2bf(qb); }
            { u32x2 w; w.x = cvt_pk_bf16(kn[0], kn[1]); w.y = cvt_pk_bf16(kn[2], kn[3]); *(u32x2*)(ko + 4 * j) = w; ko[64 + j] = f2bf(ka); ko[80 + j] = f2bf(kb); }
            *(u32x2*)(vo + 4 * j) = vraw;
        }
    }
    for (int chain = gw; chain < 512; chain += nw) {
        const int d = chain >> 8, ch = chain & 255;
        const float* ag = ws + W_AGG + (size_t)d * 512 + ch;
        float* cr = ws + W_CARRY + (size_t)d * 256 + ch;
        float run = 0.f;
        for (int k0 = 0; k0 < NSUB; k0 += 64) {
            const int k = k0 + lane; const bool valid = k < NSUB;
            const int q = d ? (NSUB - 1 - k) : (k < 4 ? 256 + k : k - 4);
            float a = 1.f, b = 0.f;
            if (valid) { a = ag[(size_t)q * 1024]; b = ag[(size_t)q * 1024 + 256]; }
#pragma unroll
            for (int o = 1; o < 64; o <<= 1) { const float pa = __shfl_up(a, o), pb = __shfl_up(b, o); if (lane >= o) { b = fmaf(a, pb, b); a = a * pa; } }
            float ea = __shfl_up(a, 1), eb = __shfl_up(b, 1); if (lane == 0) { ea = 1.f; eb = 0.f; }
            if (valid) cr[(size_t)q * 512] = fmaf(ea, run, eb);
            const float ta = __shfl(a, 63), tb = __shfl(b, 63);
            run = fmaf(ta, run, tb);
        }
    }
}


__device__ void phase_attn(const Params& p, int l, char* lds) {
    float* const ws = (float*)(gfloat_t*)tab_ld(N_IN);
    const int tid = tid_(), bid = bid_(); (void)tid;
    const bf16_t* Qb = (const bf16_t*)(ws + W_Q); const bf16_t* Kb = (const bf16_t*)(ws + W_K); const bf16_t* Vb = (const bf16_t*)(ws + W_V);
    bf16_t* Y = (bf16_t*)(ws + W_YC);
    const int nunits = (l == 0) ? 260 : 256;
    for (int u = bid; u < nunits; u += gridDim.x) {
        int h, t0, k0, seq;
        if (u < 256) { h = (u & 7) >> 1; t0 = (((u >> 3) << 1) | (u & 1)) * 256; k0 = 0; seq = T; }
        else { h = u - 256; t0 = NLAT; k0 = NLAT; seq = NCTX; }
        att::attn_unit(Qb + ((size_t)h * T + t0) * 96, Kb + ((size_t)h * T + k0) * 96, Vb + ((size_t)h * T + k0) * 64, seq, Y + (size_t)t0 * D + 256 + h * 64, D, lds);
    }
}

__device__ void phase_lru_fin(const Params& p, char* lds) {
    float* const ws = (float*)(gfloat_t*)tab_ld(N_IN);
    const int tid = tid_(), bid = bid_();
    float* carry = (float*)lds;
    for (int sub = bid; sub < NSUB; sub += gridDim.x) {
        carry[tid] = ws[W_CARRY + (size_t)sub * 512 + tid];
        __syncthreads();
        for (int i = tid; i < 64 * 64; i += NTHR) {
            const int t = sub * 64 + (i >> 6), ch = (i & 63) * 4;
            const bf16_t* la = (const bf16_t*)(ws + W_LA2); const bf16_t* lb = (const bf16_t*)(ws + W_LB2);
            f32x4 hs = ld4bf(lb + (size_t)t * 256 + ch) + ld4bf(la + (size_t)t * 256 + ch) * *(const f32x4*)(carry + ch);
            hs = hs + ld4bf(lb + ((size_t)T + t) * 256 + ch) + ld4bf(la + ((size_t)T + t) * 256 + ch) * *(const f32x4*)(carry + 256 + ch);
            const f32x4 g = ld4bf((const bf16_t*)(ws + W_P) + (size_t)t * INC + OFF_DG + ch);
            u32x2 w; w.x = cvt_pk_bf16(gelu_tanh(g[0]) * hs[0], gelu_tanh(g[1]) * hs[1]); w.y = cvt_pk_bf16(gelu_tanh(g[2]) * hs[2], gelu_tanh(g[3]) * hs[3]);
            *(u32x2*)((bf16_t*)(ws + W_YC) + (size_t)t * D + 768 + ch) = w;
        }
        __syncthreads();
    }
}

struct OutprojSched {
    UnitRange ur; const char* A; const char* Bt;
    DEVI bool next(int i, pg8::Unit& u) const {
        const int id = ur.lo + i * ur.step; if (id >= ur.hi) return false;
        const int tm = id >> 2, tn = id & 3;
        u.a = A + (size_t)tm * 256 * D * 2; u.b = Bt + (size_t)tn * 256 * D * 2; u.x0 = tm * 256; u.x1 = tn * 256; u.x2 = 0; u.g = nullptr; u.gn = 0; return true;
    }
};
struct EpiOutproj { static constexpr bool PERM = false; float* X; const float* Xin; const float* modv;
    DEVI void operator()(const f32x4 (&acc)[2][2][4][2], const pg8::Unit& u, int wr, int wc, int fr, int fq) const {
        const float* g1 = modv + (u.x0 >= NLAT ? 6144 : 0) + 2 * D;
#pragma unroll
        for (int ai = 0; ai < 2; ++ai)
#pragma unroll
            for (int m = 0; m < 4; ++m) { const size_t ro = (size_t)(u.x0 + ai * 128 + wr * 64 + m * 16 + fr) * D; float* row = X + ro; const float* rin = Xin + ro;
#pragma unroll
                for (int bj = 0; bj < 2; ++bj)
#pragma unroll
                    for (int n = 0; n < 2; ++n) { const int c = u.x1 + bj * 128 + wc * 32 + n * 16 + 4 * fq; const f32x4 g = *(const f32x4*)(g1 + c); f32x4 x = *(const f32x4*)(rin + c);
                        x = x + g * acc[ai][bj][m][n]; *(f32x4*)(row + c) = x; } }
    }
};
struct CtxSplitSched {
    int first, step; const char* A; const char* Bt;
    DEVI bool next(int i, pg8::Unit& u) const {
        const int id = first + i * step; if (id >= 16) return false;
        const int tn = id >> 2, ks = id & 3;
        u.a = A + (size_t)NLAT * D * 2 + (size_t)ks * 256 * 2; u.b = Bt + (size_t)tn * 256 * D * 2 + (size_t)ks * 256 * 2; u.x0 = ks; u.x1 = tn * 256; u.x2 = 0; u.g = nullptr; u.gn = 0; return true;
    }
};
struct EpiCtxPart { static constexpr bool PERM = false; float* PART; const float* g1;
    DEVI void operator()(const f32x4 (&acc)[2][2][4][2], const pg8::Unit& u, int wr, int wc, int fr, int fq) const {
#pragma unroll
        for (int ai = 0; ai < 2; ++ai)
#pragma unroll
            for (int m = 0; m < 4; ++m) { float* row = PART + ((size_t)u.x0 * NCTX + ai * 128 + wr * 64 + m * 16 + fr) * D;
#pragma unroll
                for (int bj = 0; bj < 2; ++bj)
#pragma unroll
                    for (int n = 0; n < 2; ++n) { const int c = u.x1 + bj * 128 + wc * 32 + n * 16 + 4 * fq; *(f32x4*)(row + c) = *(const f32x4*)(g1 + c) * acc[ai][bj][m][n]; } }
    }
};
__device__ void phase_outproj(const Params& p, int l, char* lds) {
    float* const ws = (float*)(gfloat_t*)tab_ld(N_IN);
    const int tid = tid_(), bid = bid_(); (void)tid;
    OutprojSched S; S.ur = unit_range((NLAT / 256) * 4, bid); S.A = (const char*)(ws + W_YC); S.Bt = (const char*)((const bf16_t*)(ws + W_WOUT) + (size_t)l * D * D);
    EpiOutproj E; E.X = ws + W_X; E.Xin = (l == 0) ? PIN(I_X) : (const float*)(ws + W_X); E.modv = ws + W_MOD + (size_t)l * 2 * 6144;
    pg8::gemm_phase((PG8_LAS unsigned char*)lds, D, (size_t)128 * D * 2, S, E);
    if (l < NLAYER - 1) {
        CtxSplitSched S2; S2.first = bid; S2.step = gridDim.x; S2.A = S.A; S2.Bt = S.Bt;
        EpiCtxPart E2; E2.PART = ws + W_PART; E2.g1 = ws + W_MOD + (size_t)(l * 2 + 1) * 6144 + 2 * D;
        pg8::gemm_phase((PG8_LAS unsigned char*)lds, D, (size_t)128 * D * 2, S2, E2, 4);
    }
}

constexpr int R_LDS = 1024 * 36 * 4;
__device__ void phase_router(const Params& p, int l, char* lds) {
    float* const ws = (float*)(gfloat_t*)tab_ld(N_IN);
    const float* const pin_I_NFFN = PIN(I_NFFN);
    const float* const pin_I_RB = PIN(I_RB);
    const float* const pin_I_RW = PIN(I_RW);
    const int tid = tid_(), bid = bid_();
    float* wl = (float*)lds;
    int* hist = (int*)(lds + R_LDS); int* bbase = hist + 32; int* tinfo = hist + 64 + (tid >> 6) * 40;
    __attribute__((address_space(3))) float* wsc = (__attribute__((address_space(3))) float*)((__attribute__((address_space(3))) char*)g_lds + RSC_OFF) + (tid >> 6) * 96;
    if (tid < 32) hist[tid] = 0;
    {   const float* rw = pin_I_RW + (size_t)l * D * NEXP;
        for (int i = tid; i < 1024 * 8; i += NTHR) { const int k = i >> 3, e4 = i & 7; *(f32x4*)(wl + k * 36 + e4 * 4) = *(const f32x4*)(rw + k * 32 + e4 * 4); }
    }
    __syncthreads();
    const int lane = tid & 63, gw = bid * (NTHR / 64) + __builtin_amdgcn_readfirstlane(tid >> 6), nw = gridDim.x * (NTHR / 64);
    const float* g = pin_I_NFFN + l * D;
    int* cnt = (int*)(ws + W_CNT) + l * NEXP * 64;
    bf16_t* HB = (bf16_t*)(ws + W_HB);
    const int e = lane >> 1;
    const float rb = pin_I_RB[l * NEXP + e];
    const int TL = (l == NLAYER - 1) ? NLAT : T;
    int ti = 0;
    for (int t0 = gw; t0 < TL; t0 += 2 * nw, ti += 2) {
        const int t1 = t0 + nw; const bool v1 = t1 < TL; const int t1c = v1 ? t1 : t0;
        const float* mod = ws + W_MOD + (size_t)(l * 2 + (t0 >= NLAT ? 1 : 0)) * 6144;
        float f0[16], f1[16]; float ss0 = 0.f, ss1 = 0.f;
#pragma unroll
        for (int m = 0; m < 16; ++m) { f0[m] = ws[W_X + (size_t)t0 * D + lane + 64 * m]; f1[m] = ws[W_X + (size_t)t1c * D + lane + 64 * m]; }
        if (t0 >= NLAT) {
#pragma unroll
            for (int m = 0; m < 16; ++m) { const size_t o0 = (size_t)(t0 - NLAT) * D + lane + 64 * m, o1 = (size_t)(t1c - NLAT) * D + lane + 64 * m;
#pragma unroll
                for (int ks = 0; ks < 4; ++ks) { f0[m] += ws[W_PART + (size_t)ks * NCTX * D + o0]; f1[m] += ws[W_PART + (size_t)ks * NCTX * D + o1]; }
                ws[W_X + (size_t)t0 * D + lane + 64 * m] = f0[m]; if (v1) ws[W_X + (size_t)t1 * D + lane + 64 * m] = f1[m]; }
        }
#pragma unroll
        for (int m = 0; m < 16; ++m) { ss0 = fmaf(f0[m], f0[m], ss0); ss1 = fmaf(f1[m], f1[m], ss1); }
#pragma unroll
        for (int o = 32; o > 0; o >>= 1) { ss0 += __shfl_xor(ss0, o); ss1 += __shfl_xor(ss1, o); }
        const float r0 = rsqrtf(ss0 * (1.f / D) + EPS), r1 = rsqrtf(ss1 * (1.f / D) + EPS);
#pragma unroll
        for (int m = 0; m < 16; ++m) { const int k = lane + 64 * m; const float gkm = g[k] * (1.f + mod[4 * D + k]), shm = mod[3 * D + k]; f0[m] = f0[m] * r0 * gkm + shm; f1[m] = f1[m] * r1 * gkm + shm;
            HB[(size_t)t0 * D + k] = f2bf(f0[m]); if (v1) HB[(size_t)t1 * D + k] = f2bf(f1[m]); }
        float acc0[32], acc1[32];
#pragma unroll
        for (int j = 0; j < 32; ++j) { acc0[j] = 0.f; acc1[j] = 0.f; }
#pragma unroll
        for (int m = 0; m < 16; ++m) {
            const float* wr = wl + (lane + 64 * m) * 36;
#pragma unroll
            for (int e4 = 0; e4 < 8; ++e4) { const f32x4 w4 = *(const f32x4*)(wr + e4 * 4);
#pragma unroll
                for (int j = 0; j < 4; ++j) { acc0[e4 * 4 + j] = fmaf(f0[m], w4[j], acc0[e4 * 4 + j]); acc1[e4 * 4 + j] = fmaf(f1[m], w4[j], acc1[e4 * 4 + j]); } }
            __builtin_amdgcn_sched_barrier(0);
        }
#define RS_STEP(W_, MSK_) do { const bool up = (lane & (MSK_)) != 0; \
            _Pragma("unroll") for (int j = 0; j < (W_); ++j) { const float s0_ = up ? acc0[j] : acc0[j + (W_)], k0_ = up ? acc0[j + (W_)] : acc0[j]; acc0[j] = k0_ + __shfl_xor(s0_, (MSK_)); \
                const float s1_ = up ? acc1[j] : acc1[j + (W_)], k1_ = up ? acc1[j + (W_)] : acc1[j]; acc1[j] = k1_ + __shfl_xor(s1_, (MSK_)); } } while (0)
        RS_STEP(16, 32); RS_STEP(8, 16); RS_STEP(4, 8); RS_STEP(2, 4); RS_STEP(1, 2);
#undef RS_STEP
        const float a0 = acc0[0] + __shfl_xor(acc0[0], 1) + rb, a1 = acc1[0] + __shfl_xor(acc1[0], 1) + rb;
        if ((lane & 1) == 0) { wsc[e] = a0; wsc[48 + e] = a1; }
        asm volatile("s_waitcnt lgkmcnt(0)" ::: "memory"); __builtin_amdgcn_wave_barrier();
        int rank0 = 0, rank1 = 0;
#pragma unroll
        for (int q = 0; q < 8; ++q) { const f32x4 x0 = *(const volatile __attribute__((address_space(3))) f32x4*)(wsc + 4 * q), x1 = *(const volatile __attribute__((address_space(3))) f32x4*)(wsc + 48 + 4 * q);
#pragma unroll
            for (int j = 0; j < 4; ++j) { const int eo = 4 * q + j;
                rank0 += (x0[j] > a0 || (x0[j] == a0 && eo < e)) ? 1 : 0; rank1 += (x1[j] > a1 || (x1[j] == a1 && eo < e)) ? 1 : 0; } }
        if ((lane & 1) == 0) {
            if (rank0 < 4) { ((__attribute__((address_space(3))) int*)wsc)[32 + rank0] = e; wsc[36 + rank0] = a0; }
            if (rank1 < 4) { ((__attribute__((address_space(3))) int*)wsc)[80 + rank1] = e; wsc[84 + rank1] = a1; }
        }
        asm volatile("s_waitcnt lgkmcnt(0)" ::: "memory"); __builtin_amdgcn_wave_barrier();
        if (lane < 8 && (lane < 4 || v1)) {
            const int u = lane >> 2, k = lane & 3, tt = u ? t1 : t0;
            const volatile __attribute__((address_space(3))) float* sv = wsc + u * 48;
            const float mx = sv[36];
            const float sm = expf(sv[36] - mx) + expf(sv[37] - mx) + expf(sv[38] - mx) + expf(sv[39] - mx);
            const int ee = ((const volatile __attribute__((address_space(3))) int*)sv)[32 + k]; const float eg = expf(sv[36 + k] - mx);
            const int lidx = atomicAdd(&hist[ee], 1);
            tinfo[(ti + u) * 4 + k] = (ee << 16) | lidx;
            ((int*)(ws + W_TOPE))[tt * 4 + k] = ee;
            ws[W_TOPG + tt * 4 + k] = eg / sm;
        }
        __builtin_amdgcn_wave_barrier();
    }
    __syncthreads();
    if (tid < 32) bbase[tid] = atomicAdd(&cnt[tid * 64], hist[tid]);
    __syncthreads();
    ti = 0;
    for (int t = gw; t < TL; t += nw, ++ti)
        if (lane < 4) { const int v = tinfo[ti * 4 + lane]; const int slot = bbase[v >> 16] + (v & 0xffff);
            ((int*)(ws + W_TOPI))[t * 4 + lane] = slot; ((int*)(ws + W_XS))[(size_t)(v >> 16) * T + slot] = t; }
    __syncthreads();
    conv_moe(p, l, 0);
}

DEVI void moe_bases(const Params& p, int l, int* sb) {
    float* const ws = (float*)(gfloat_t*)tab_ld(N_IN);
    const int tid = tid_();
    if (tid == 0) {
        const int* cnt = (const int*)(ws + W_CNT) + l * NEXP * 64;
        int b = 0, tb = 0;
        for (int e = 0; e < NEXP; ++e) { sb[e] = b; sb[40 + e] = tb; const int c = cnt[e * 64]; sb[80 + e] = c; const int mt = (c + 255) / 256; b += mt * 256; tb += mt; }
        sb[32] = b; sb[72] = tb;
    }
    __syncthreads();
}


struct MoeSched {
    UnitRange ur; const int* sb; int ntn; const char* A; const char* Bt; size_t bstride_e, bstride_tn; const int* lists;
    DEVI bool next(int i, pg8::Unit& u) const {
        const int id = ur.lo + i * ur.step; if (id >= ur.hi) return false;
        int e = 0; while (e < NEXP - 1 && sb[40 + e + 1] * ntn <= id) ++e;
        const int mts = sb[40 + e + 1] - sb[40 + e], loc = id - sb[40 + e] * ntn, tng = loc / (mts * 4), rr = loc % (mts * 4), mt = rr >> 2, tn = tng * 4 + (rr & 3);
        const int r0 = __builtin_amdgcn_readfirstlane(sb[e] + mt * 256), tn_s = __builtin_amdgcn_readfirstlane(tn), e_s = __builtin_amdgcn_readfirstlane(e);
        u.a = A + (size_t)r0 * D * 2; u.b = Bt + (size_t)e_s * bstride_e + (size_t)tn_s * bstride_tn; u.x0 = r0; u.x1 = tn_s; u.x2 = e_s;
        const int mt_s = __builtin_amdgcn_readfirstlane(mt), cnt_s = __builtin_amdgcn_readfirstlane(sb[80 + e]);
        u.g = lists ? lists + (size_t)e_s * T + mt_s * 256 : nullptr; u.gn = cnt_s - mt_s * 256 < 256 ? cnt_s - mt_s * 256 : 256; return true;
    }
};
struct EpiMoe1 { static constexpr bool PERM = true; bf16_t* ACT; const float* bias;
    DEVI void operator()(const f32x4 (&acc)[2][2][4][2], const pg8::Unit& u, int wr, int wc, int fr, int fq) const {
        const int c0 = u.x1 * 128 + wc * 32 + 8 * fq;
        const float* bg = bias + (size_t)u.x2 * 2048 + c0; const float* bu = bg + 1024;
        f32x4 vg[2], vu[2];
#pragma unroll
        for (int n = 0; n < 2; ++n) { vg[n] = *(const f32x4*)(bg + 4 * n); vu[n] = *(const f32x4*)(bu + 4 * n); }
#pragma unroll
        for (int ai = 0; ai < 2; ++ai)
#pragma unroll
            for (int m = 0; m < 4; ++m) { bf16_t* rowp = ACT + (size_t)(u.x0 + ai * 128 + wr * 64 + m * 16 + fr) * D + c0;
                float a[8];
#pragma unroll
                for (int n = 0; n < 2; ++n)
#pragma unroll
                    for (int j = 0; j < 4; ++j) { float g = acc[ai][0][m][n][j] + vg[n][j], uu = acc[ai][1][m][n][j] + vu[n][j];
                        g = fminf(g, 7.f); uu = fminf(fmaxf(uu, -7.f), 7.f); a[n * 4 + j] = (uu + 1.f) * (g * sigm(1.702f * g)); }
                u32x4 w; w.x = cvt_pk_bf16(a[0], a[1]); w.y = cvt_pk_bf16(a[2], a[3]); w.z = cvt_pk_bf16(a[4], a[5]); w.w = cvt_pk_bf16(a[6], a[7]);
                *(u32x4*)rowp = w; }
    }
};
__device__ void phase_moe1(const Params& p, int l, char* lds) {
    float* const ws = (float*)(gfloat_t*)tab_ld(N_IN);
    const float* const pin_I_BGU = PIN(I_BGU);
    const int tid = tid_(), bid = bid_(); (void)tid;
    int* sb = (int*)(lds + pg8::STAGE_BYTES);
    moe_bases(p, l, sb);
    MoeSched S; S.sb = sb; S.ntn = 8; S.ur = unit_range(sb[72] * 8, bid); S.A = (const char*)(ws + W_HB); S.lists = (const int*)(ws + W_XS);
    S.Bt = (const char*)((const bf16_t*)(ws + W_WGU) + (size_t)l * NEXP * 2048 * D); S.bstride_e = (size_t)2048 * D * 2; S.bstride_tn = (size_t)128 * D * 2;
    EpiMoe1 E; E.ACT = (bf16_t*)(ws + W_ACT); E.bias = pin_I_BGU + (size_t)l * NEXP * 2048;
    pg8::gemm_phase<EpiMoe1, MoeSched, true>((PG8_LAS unsigned char*)lds, D, (size_t)1024 * D * 2, S, E, 0, (const char*)(ws + W_HB));
    __syncthreads();
}

struct EpiMoe2 { static constexpr bool PERM = true; bf16_t* YR; const float* bias;
    DEVI void operator()(const f32x4 (&acc)[2][2][4][2], const pg8::Unit& u, int wr, int wc, int fr, int fq) const {
        const int c0 = u.x1 * 256 + wc * 32 + 8 * fq;
        const float* bb = bias + (size_t)u.x2 * D + c0;
        f32x4 bv[2][2];
#pragma unroll
        for (int bj = 0; bj < 2; ++bj)
#pragma unroll
            for (int n = 0; n < 2; ++n) bv[bj][n] = *(const f32x4*)(bb + bj * 128 + 4 * n);
#pragma unroll
        for (int ai = 0; ai < 2; ++ai)
#pragma unroll
            for (int m = 0; m < 4; ++m) { bf16_t* rowp = YR + (size_t)(u.x0 + ai * 128 + wr * 64 + m * 16 + fr) * D + c0;
#pragma unroll
                for (int bj = 0; bj < 2; ++bj) { const f32x4 v0 = acc[ai][bj][m][0] + bv[bj][0], v1 = acc[ai][bj][m][1] + bv[bj][1];
                    u32x4 w; w.x = cvt_pk_bf16(v0[0], v0[1]); w.y = cvt_pk_bf16(v0[2], v0[3]); w.z = cvt_pk_bf16(v1[0], v1[1]); w.w = cvt_pk_bf16(v1[2], v1[3]);
                    *(u32x4*)(rowp + bj * 128) = w; } }
    }
};
__device__ void phase_moe2(const Params& p, int l, char* lds) {
    float* const ws = (float*)(gfloat_t*)tab_ld(N_IN);
    const float* const pin_I_BDN = PIN(I_BDN);
    const int tid = tid_(), bid = bid_(); (void)tid;
    int* sb = (int*)(lds + pg8::STAGE_BYTES);
    moe_bases(p, l, sb);
    MoeSched S; S.sb = sb; S.ntn = 4; S.ur = unit_range(sb[72] * 4, bid); S.A = (const char*)(ws + W_ACT); S.lists = nullptr;
    S.Bt = (const char*)((const bf16_t*)(ws + W_WDN) + (size_t)l * NEXP * D * D); S.bstride_e = (size_t)D * D * 2; S.bstride_tn = (size_t)256 * D * 2;
    EpiMoe2 E; E.YR = (bf16_t*)(ws + W_YR); E.bias = pin_I_BDN + (size_t)l * NEXP * D;
    pg8::gemm_phase((PG8_LAS unsigned char*)lds, D, (size_t)128 * D * 2, S, E);
    __syncthreads();
}

DEVI void norm1_store8(float* ws, const float* g, int l, int t, int lane, const float (&v)[2][8]) {
    const float* mod = ws + W_MOD + (size_t)(l * 2 + (t >= NLAT ? 1 : 0)) * 6144;
    float ss = 0.f;
#pragma unroll
    for (int jj = 0; jj < 2; ++jj)
#pragma unroll
        for (int i = 0; i < 8; ++i) ss = fmaf(v[jj][i], v[jj][i], ss);
    const float rstd = rsqrtf(wave_sum(ss) * (1.f / D) + EPS);
    bf16_t* hb = (bf16_t*)(ws + W_HB) + (size_t)t * D;
#pragma unroll
    for (int jj = 0; jj < 2; ++jj) {
        const int c = jj * 512 + lane * 8;
        float o[8];
#pragma unroll
        for (int q = 0; q < 2; ++q) { const f32x4 gg = *(const f32x4*)(g + c + 4 * q), s1 = *(const f32x4*)(mod + D + c + 4 * q), s0 = *(const f32x4*)(mod + c + 4 * q);
#pragma unroll
            for (int i = 0; i < 4; ++i) o[4 * q + i] = v[jj][4 * q + i] * rstd * gg[i] * (1.f + s1[i]) + s0[i]; }
        u32x4 w; w.x = cvt_pk_bf16(o[0], o[1]); w.y = cvt_pk_bf16(o[2], o[3]); w.z = cvt_pk_bf16(o[4], o[5]); w.w = cvt_pk_bf16(o[6], o[7]);
        *(u32x4*)(hb + c) = w;
    }
}
__device__ void phase_combine(const Params& p, int l, char* lds, bool last) {
    float* const ws = (float*)(gfloat_t*)tab_ld(N_IN);
    float* const pout = (float*)(gfloat_t*)tab_ld(N_IN + 1);
    const float* const pin_I_NMIX = PIN(I_NMIX);
    const int tid = tid_(), bid = bid_();
    const bf16_t* YR = (const bf16_t*)(ws + W_YR);
    int* sb = (int*)(lds + G_LDS);
    moe_bases(p, l, sb);
    const int lane = tid & 63, gw = bid * (NTHR / 64) + __builtin_amdgcn_readfirstlane(tid >> 6), nw = gridDim.x * (NTHR / 64);
    const int TL = last ? NLAT : T;
    const float* gn = pin_I_NMIX + (last ? 0 : (l + 1) * D);
    for (int t0 = gw; t0 < TL; t0 += 2 * nw) {
        const int t1 = t0 + nw; const bool v1 = t1 < TL; const int t1c = v1 ? t1 : t0;
        const float* g2 = ws + W_MOD + (size_t)(l * 2 + (t0 >= NLAT ? 1 : 0)) * 6144 + 5 * D;
        const bf16_t* ya[4]; const bf16_t* yb[4]; float ga[4], gb[4];
#pragma unroll
        for (int k = 0; k < 4; ++k) { ya[k] = YR + (size_t)(sb[((const int*)(ws + W_TOPE))[t0 * 4 + k]] + ((const int*)(ws + W_TOPI))[t0 * 4 + k]) * D; ga[k] = ws[W_TOPG + t0 * 4 + k];
                                      yb[k] = YR + (size_t)(sb[((const int*)(ws + W_TOPE))[t1c * 4 + k]] + ((const int*)(ws + W_TOPI))[t1c * 4 + k]) * D; gb[k] = ws[W_TOPG + t1c * 4 + k]; }
        float* xa = ws + W_X + (size_t)t0 * D; float* xb = ws + W_X + (size_t)t1c * D;
        float ra[2][8], rb[2][8];
#pragma unroll
        for (int jj = 0; jj < 2; ++jj) {
            const int c = jj * 512 + lane * 8;
            u32x4 ua[4], ub[4];
#pragma unroll
            for (int k = 0; k < 4; ++k) { ua[k] = *(const u32x4*)(ya[k] + c); ub[k] = *(const u32x4*)(yb[k] + c); }
            const f32x4 xa0 = *(const f32x4*)(xa + c), xa1 = *(const f32x4*)(xa + c + 4), xb0 = *(const f32x4*)(xb + c), xb1 = *(const f32x4*)(xb + c + 4);
            const f32x4 gg0 = *(const f32x4*)(g2 + c), gg1 = *(const f32x4*)(g2 + c + 4);
            float a[8], b[8];
#pragma unroll
            for (int i = 0; i < 8; ++i) { a[i] = 0.f; b[i] = 0.f; }
#pragma unroll
            for (int k = 0; k < 4; ++k)
#pragma unroll
                for (int q = 0; q < 4; ++q) { const unsigned wa = ua[k][q], wb = ub[k][q];
                    a[2 * q] = fmaf(ga[k], __uint_as_float(wa << 16), a[2 * q]); a[2 * q + 1] = fmaf(ga[k], __uint_as_float(wa & 0xffff0000u), a[2 * q + 1]);
                    b[2 * q] = fmaf(gb[k], __uint_as_float(wb << 16), b[2 * q]); b[2 * q + 1] = fmaf(gb[k], __uint_as_float(wb & 0xffff0000u), b[2 * q + 1]); }
#pragma unroll
            for (int i = 0; i < 4; ++i) { ra[jj][i] = fmaf(gg0[i], a[i], xa0[i]); ra[jj][4 + i] = fmaf(gg1[i], a[4 + i], xa1[i]); rb[jj][i] = fmaf(gg0[i], b[i], xb0[i]); rb[jj][4 + i] = fmaf(gg1[i], b[4 + i], xb1[i]); }
            float* da = last ? pout + (size_t)t0 * D + c : xa + c; float* db = last ? pout + (size_t)t1c * D + c : xb + c;
            *(f32x4*)da = (f32x4){ra[jj][0], ra[jj][1], ra[jj][2], ra[jj][3]}; *(f32x4*)(da + 4) = (f32x4){ra[jj][4], ra[jj][5], ra[jj][6], ra[jj][7]};
            if (v1) { *(f32x4*)db = (f32x4){rb[jj][0], rb[jj][1], rb[jj][2], rb[jj][3]}; *(f32x4*)(db + 4) = (f32x4){rb[jj][4], rb[jj][5], rb[jj][6], rb[jj][7]}; }
        }
        if (!last) { norm1_store8(ws, gn, l + 1, t0, lane, ra); if (v1) norm1_store8(ws, gn, l + 1, t1, lane, rb); }
    }
}

constexpr int XST_OFF = R_LDS + 2048 - 16, STAMP_OFF = R_LDS + 2048 - 16 - 256;
constexpr int LDS_BYTES = RSC_OFF + 8 * 96 * 4;

#define XB_TMO      128
#define XB_XCNT(j)  (256  + 64 * (j))
#define XB_XSUB(j)  (1280 + 64 * (j))
#define XB_XGEN(j)  (2304 + 64 * (j))
#define XB_TOP      3328
#define XB_TOPGEN   3392
#define XCD_BAR_WORDS 3456
#define XB_SPIN_CAP (1u << 18)
#define LAS __attribute__((address_space(3)))
__device__ __forceinline__ unsigned xb_ld(unsigned* p)              { return __hip_atomic_load(p, __ATOMIC_RELAXED, __HIP_MEMORY_SCOPE_AGENT); }
__device__ __forceinline__ unsigned xb_add(unsigned* p, unsigned v) { return __hip_atomic_fetch_add(p, v, __ATOMIC_RELAXED, __HIP_MEMORY_SCOPE_AGENT); }
__device__ __forceinline__ unsigned xb_xcc_id() { return (unsigned)__builtin_amdgcn_s_getreg((3 << 11) | 20) & 0xFu; }
#define XB_SPIN(cond, bar) do { unsigned _sp = 0; while (cond) { __builtin_amdgcn_s_sleep(1); \
    if ((++_sp & 255u) == 0u) { if (xb_ld(&(bar)[XB_TMO])) break; if (_sp > XB_SPIN_CAP) { atomicAdd(&(bar)[XB_TMO], 1u); break; } } } } while (0)
struct XcdBarrier { unsigned* bar; unsigned x; volatile LAS unsigned* st; };
__device__ __forceinline__ XcdBarrier xcd_barrier_post(unsigned* bar, volatile LAS unsigned* st) {
    XcdBarrier b; b.bar = bar; b.x = xb_xcc_id(); b.st = st;
    if (threadIdx.x == 0) (void)xb_add(&bar[XB_XCNT(b.x)], 1u);
    return b;
}
__device__ __forceinline__ void xcd_barrier_complete(unsigned* bar, unsigned x, unsigned& nloc, unsigned& nx) {
    const unsigned G = gridDim.x * gridDim.y * gridDim.z;
    unsigned sum, cnt, mine, sp = 0u;
    for (;;) {
        sum = 0u; cnt = 0u; mine = 0u;
#pragma unroll
        for (unsigned j = 0; j < 16; ++j) { const unsigned c = xb_ld(&bar[XB_XCNT(j)]); sum += c; cnt += (c > 0u) ? 1u : 0u; mine = (j == x) ? c : mine; }
        if (sum == G) break;
        __builtin_amdgcn_s_sleep(1);
        if ((++sp & 255u) == 0u) { if (xb_ld(&bar[XB_TMO])) break; if (sp > XB_SPIN_CAP) { atomicAdd(&bar[XB_TMO], 1u); break; } }
    }
    nloc = mine > 0u ? mine : 1u; nx = cnt > 0u ? cnt : 1u;
}
__device__ __noinline__ void xcd_barrier(const XcdBarrier b, const int tid) {
    asm volatile("s_waitcnt vmcnt(0)" ::: "memory");
    __syncthreads();
    if (tid == 0) {
        unsigned* bar = b.bar;
        __builtin_amdgcn_s_waitcnt(0);
        unsigned nloc = b.st[0], nx = b.st[1];
        if (nloc == 0u) { xcd_barrier_complete(bar, b.x, nloc, nx); b.st[0] = nloc; b.st[1] = nx; }
        const unsigned old = xb_add(&bar[XB_XSUB(b.x)], 1u);
        const unsigned gen = old / nloc;
        if (old + 1u == (gen + 1u) * nloc) {
            __builtin_amdgcn_fence(__ATOMIC_RELEASE, "agent");
            asm volatile("s_waitcnt vmcnt(0)" ::: "memory");
            const unsigned og = xb_add(&bar[XB_TOP], 1u);
            const unsigned tg = og / nx;
            if (og + 1u == (tg + 1u) * nx) xb_add(&bar[XB_TOPGEN], 1u);
            else XB_SPIN(xb_ld(&bar[XB_TOPGEN]) == tg, bar);
            __builtin_amdgcn_fence(__ATOMIC_ACQUIRE, "agent");
            xb_add(&bar[XB_XGEN(b.x)], 1u);
            asm volatile("s_waitcnt vmcnt(0)" ::: "memory");
        } else {
            XB_SPIN(xb_ld(&bar[XB_XGEN(b.x)]) == gen, bar);
            __builtin_amdgcn_fence(__ATOMIC_ACQUIRE, "agent");
            asm volatile("s_waitcnt vmcnt(0)" ::: "memory");
        }
    }
    __syncthreads();
}

constexpr int PROBE_IDX = -1, PROBE_END = -1, PROBE_DIV = 10;
constexpr int REP_NORM = 1, REP_INPROJ = 1, REP_PREP1 = 1, REP_SMALL = 1, REP_ATTN = 1, REP_FIN = 1, REP_MOE1 = 1, REP_MOE2 = 1, REP_SYNC = 1, REP_CONV = 1;
__global__ void __launch_bounds__(NTHR) fwd_kernel(Params p) {
    cg::grid_group grid = cg::this_grid();
    char* lds = g_lds;
    float* smem = (float*)lds;
    if (threadIdx.x == 0) {
        unsigned long long* tab = (unsigned long long*)(lds + TAB_OFF);
#pragma unroll
        for (int i = 0; i < N_IN; ++i) tab[i] = (unsigned long long)p.in[i];
        tab[N_IN] = (unsigned long long)p.ws; tab[N_IN + 1] = (unsigned long long)p.out;
    }
    __syncthreads();
    volatile LAS unsigned* xst = (volatile LAS unsigned*)(lds + XST_OFF);
    if (threadIdx.x < 4) xst[threadIdx.x] = 0u;
    if (blockIdx.x == 0) for (int i = threadIdx.x; i < 4096; i += NTHR) ((unsigned*)(p.ws + W_BAR))[i] = 0u;
    for (int r = 0; r < REP_CONV; ++r) phase_convert(p);
    phase_tables(p);
    phase_mod(p, smem);
    grid.sync();
    XcdBarrier xbar = xcd_barrier_post((unsigned*)(p.ws + W_BAR), xst);
    unsigned long long* stamps = (unsigned long long*)(lds + STAMP_OFF); int nstamp = 0;
#define GSYNC() do { for (int r_ = 0; r_ < REP_SYNC; ++r_) { XcdBarrier b_ = xbar; unsigned long long bp_ = (unsigned long long)b_.bar; unsigned bx_ = b_.x; asm volatile("" : "+s"(bp_), "+s"(bx_)); b_.bar = (unsigned*)bp_; b_.x = bx_; xcd_barrier(b_, (int)threadIdx.x); } if (PROBE_IDX >= 0) { if (blockIdx.x == 0 && threadIdx.x == 0) stamps[nstamp] = __builtin_amdgcn_s_memrealtime(); ++nstamp; } } while (0)
    phase_init(p);
    GSYNC();
    for (int lv = 0; lv < NLAYER; ++lv) {
        int l = lv; asm volatile("" : "+s"(l));
        for (int r = 0; r < REP_INPROJ; ++r) phase_inproj(p, l, lds);
        GSYNC();
        for (int r = 0; r < REP_PREP1; ++r) phase_prep1(p, l);
        GSYNC();
        for (int r = 0; r < REP_SMALL; ++r) phase_small(p, l, lds);
        GSYNC();
        phase_prep2(p, l);
        GSYNC();
        for (int r = 0; r < REP_ATTN; ++r) phase_attn(p, l, lds);
        for (int r = 0; r < REP_FIN; ++r) phase_lru_fin(p, lds);
        GSYNC();
        phase_outproj(p, l, lds);
        GSYNC();
        phase_router(p, l, lds);
        GSYNC();
        for (int r = 0; r < REP_MOE1; ++r) phase_moe1(p, l, lds);
        GSYNC();
        for (int r = 0; r < REP_MOE2; ++r) phase_moe2(p, l, lds);
        GSYNC();
        phase_combine(p, l, lds, l == NLAYER - 1);
        if (l + 1 < NLAYER || PROBE_IDX >= 0) GSYNC();
    }
    if (PROBE_IDX >= 0 && blockIdx.x == 0 && threadIdx.x == 0) {
        const float us = (float)(stamps[PROBE_END < 0 ? PROBE_IDX + 1 : PROBE_END] - stamps[PROBE_IDX]) * 0.01f;
        ((float*)(gfloat_t*)tab_ld(N_IN + 1))[0] += 2.f + us / (float)PROBE_DIV;
    }
}

extern "C" void kernel_launch(void* const* d_in, const int* in_sizes, int n_in, void* d_out, int out_size, void* d_ws, size_t ws_size, hipStream_t stream) {
    static int grid_blocks = 0;
    if (!grid_blocks) {
        int dev = 0, cus = 0, per_cu = 0;
        (void)hipGetDevice(&dev);
        (void)hipDeviceGetAttribute(&cus, hipDeviceAttributeMultiprocessorCount, dev);
        if (hipFuncSetAttribute((const void*)fwd_kernel, hipFuncAttributeMaxDynamicSharedMemorySize, LDS_BYTES) != hipSuccess) fprintf(stderr, "kernel_launch: hipFuncSetAttribute failed\n");
        if (hipOccupancyMaxActiveBlocksPerMultiprocessor(&per_cu, fwd_kernel, NTHR, LDS_BYTES) != hipSuccess || per_cu < 1) { fprintf(stderr, "kernel_launch: occupancy query says %d\n", per_cu); per_cu = 1; }
        if (per_cu > 1) per_cu = 1;
        grid_blocks = cus * per_cu;
        if (ws_size < W_END * sizeof(float)) fprintf(stderr, "kernel_launch: workspace too small: %zu < %zu\n", ws_size, W_END * sizeof(float));
        if (n_in != N_IN) fprintf(stderr, "kernel_launch: n_in %d != %d\n", n_in, (int)N_IN);
    }
    Params p{};
    for (int i = 0; i < N_IN; ++i) p.in[i] = (const float*)d_in[i];
    p.out = (float*)d_out;
    p.ws = (float*)d_ws;
    void* args[] = {&p};
    hipError_t e = hipLaunchCooperativeKernel((void*)fwd_kernel, dim3(grid_blocks), dim3(NTHR), args, LDS_BYTES, stream);
    if (e != hipSuccess) fprintf(stderr, "cooperative launch failed: %s (grid %d)\n", hipGetErrorString(e), grid_blocks);
}
```

```cpp
#include <hip/hip_runtime.h>
#include <hip/hip_cooperative_groups.h>
#include <cstdio>
#include <cstdint>
namespace cg = cooperative_groups;

#define DEVI __device__ __forceinline__
constexpr int NTHR = 512;
constexpr int D = 1024, NLAT = 16384, NCTX = 256, T = NLAT + NCTX, NLAYER = 2;
constexpr int INC = 1632;
constexpr int OFF_A = 0, OFF_Q = 256, OFF_KV = 448, OFF_KR = 576, OFF_C = 608, OFF_DX = 1120, OFF_DG = 1376;
constexpr int NCHUNK = T / 128;
constexpr int NEXP = 32, TOPK = 4;
constexpr int MAXROWS = T * TOPK + NEXP * 256;
constexpr float EPS = 1e-6f;

enum { I_X = 0, I_C, I_CTX, I_CCTX, I_WMOD, I_BMOD, I_NMIX, I_NFFN, I_WIN, I_WOUT, I_POOLW, I_POOLS, I_QAN, I_WUQ, I_KVAN, I_WUKV,
       I_QN, I_KN, I_SGG, I_SGB, I_SGWS, I_SGBS, I_CONVW, I_CONVB, I_WA, I_BA, I_WX, I_BX, I_LAM, I_RW, I_RB, I_WGU, I_BGU, I_WDN, I_BDN, N_IN };

constexpr size_t al(size_t x) { return (x + 63) / 64 * 64; }
constexpr size_t W_X = 0;
constexpr size_t W_MOD = W_X + al((size_t)T * D);
constexpr size_t W_P = W_MOD + al(2 * 2 * 6144);
constexpr size_t W_YC = W_P + al((size_t)T * INC);
constexpr size_t W_Q = W_YC + al((size_t)T * D);
constexpr size_t W_K = W_Q + al((size_t)T * 384);
constexpr size_t W_V = W_K + al((size_t)T * 384);
constexpr size_t W_DIFF = W_V + al((size_t)T * 256);
constexpr size_t W_QN = W_DIFF + al((size_t)T * 256);
constexpr size_t W_KVN = W_QN + al((size_t)T * 192);
constexpr size_t W_U = W_KVN + al((size_t)T * 128);
constexpr size_t W_VN = W_U + al((size_t)T * 256);
constexpr size_t W_XC = W_VN + al((size_t)T * 256);
constexpr size_t W_QUP = W_XC + al((size_t)T * 256);
constexpr size_t W_KVUP = W_QUP + al((size_t)T * 384);
constexpr size_t W_LA = W_KVUP + al((size_t)T * 512);
constexpr size_t W_LB = W_LA + al((size_t)2 * T * 256);
constexpr size_t W_AGG = W_LB + al((size_t)2 * T * 256);
constexpr int NSUB = T / 64;
constexpr size_t W_CARRY = W_AGG + al((size_t)NSUB * 2 * 2 * 256);
constexpr size_t W_TOPE = W_CARRY + al((size_t)NSUB * 2 * 256);
constexpr size_t W_TOPG = W_TOPE + al((size_t)T * 4);
constexpr size_t W_TOPI = W_TOPG + al((size_t)T * 4);
constexpr size_t W_CNT = W_TOPI + al((size_t)T * 4);
constexpr size_t W_ACT = W_CNT + al(NLAYER * NEXP * 64);
constexpr size_t W_YR = W_ACT + al((size_t)MAXROWS * D / 2);
constexpr size_t W_XS = W_YR + al((size_t)MAXROWS * D / 2);
constexpr size_t W_HB = W_XS + al((size_t)MAXROWS * D / 2);
constexpr size_t W_XCB = W_HB + al((size_t)T * D / 2);
constexpr size_t W_WSB = W_XCB + al((size_t)T * 256 / 2);
constexpr size_t W_BAR = W_WSB + al((size_t)NLAYER * 4 * 128 * 128 / 2);
constexpr size_t W_ROPE = W_BAR + al(4096);
constexpr size_t W_LA2 = W_ROPE + al((size_t)NLAT * 32);
constexpr size_t W_LB2 = W_LA2 + al((size_t)2 * T * 256);
constexpr size_t W_SP = W_LB2 + al((size_t)2 * T * 256);
constexpr size_t W_PART = W_SP + al(NLAYER * 2 * 256);
constexpr int NPAD_IN = 1792;
constexpr size_t W_WIN = W_PART + al((size_t)4 * NCTX * D);
constexpr size_t W_WOUT = W_WIN + al((size_t)NLAYER * NPAD_IN * D / 2);
constexpr size_t W_WGU = W_WOUT + al((size_t)NLAYER * D * D / 2);
constexpr size_t W_WDN = W_WGU + al((size_t)NLAYER * NEXP * 2048 * D / 2);
constexpr size_t W_END = W_WDN + al((size_t)NLAYER * NEXP * D * D / 2);

struct Params {
    const float* in[N_IN];
    float* out;
    float* ws;
};

DEVI int tid_() { int t = threadIdx.x; asm volatile("" : "+v"(t)); return t; }
DEVI float* ws_(float* w) { unsigned long long v = (unsigned long long)w; asm volatile("" : "+s"(v)); return (float*)v; }
extern __shared__ __attribute__((aligned(16))) char g_lds[];
constexpr int RSC_OFF = 149504 + 512;
constexpr int TAB_OFF = 149504;
DEVI unsigned long long tab_ld(int i) { const unsigned long long v = ((const volatile unsigned long long*)(g_lds + TAB_OFF))[i];
    return ((unsigned long long)(unsigned)__builtin_amdgcn_readfirstlane((int)(v >> 32)) << 32) | (unsigned)__builtin_amdgcn_readfirstlane((int)v); }
typedef __attribute__((address_space(1))) float gfloat_t;
#define PIN(i) ((const float*)(const gfloat_t*)tab_ld(i))
DEVI int bid_() { int b = blockIdx.x; asm volatile("" : "+s"(b)); return b; }
DEVI float wave_sum(float v) {
#pragma unroll
    for (int o = 32; o > 0; o >>= 1) v += __shfl_xor(v, o);
    return v;
}
DEVI float fexp(float x) { return __builtin_amdgcn_exp2f(x * 1.4426950408889634f); }
DEVI float gelu_tanh(float x) { const float u = 1.5957691216057308f * (x + 0.044715f * x * x * x); return x * __builtin_amdgcn_rcpf(1.f + fexp(-u)); }
DEVI float sigm(float x) { return 1.f / (1.f + expf(-x)); }
DEVI float silu(float x) { return x * sigm(x); }
DEVI float fsigm(float x) { return __builtin_amdgcn_rcpf(1.f + fexp(-x)); }


typedef unsigned short bf16_t;
typedef short bf16x8 __attribute__((ext_vector_type(8)));
typedef float f32x4 __attribute__((ext_vector_type(4)));
typedef unsigned u32x4 __attribute__((ext_vector_type(4)));
typedef unsigned u32x2 __attribute__((ext_vector_type(2)));
DEVI unsigned cvt_pk_bf16(float lo, float hi) { unsigned r; asm volatile("v_cvt_pk_bf16_f32 %0, %1, %2" : "=v"(r) : "v"(lo), "v"(hi)); return r; }
DEVI bf16_t f2bf(float f) { return (bf16_t)(cvt_pk_bf16(f, 0.f) & 0xffffu); }
DEVI f32x4 ld4bf(const bf16_t* p) { const u32x2 w = *(const u32x2*)p; return (f32x4){__uint_as_float(w.x << 16), __uint_as_float(w.x & 0xffff0000u), __uint_as_float(w.y << 16), __uint_as_float(w.y & 0xffff0000u)}; }
typedef int i32x8 __attribute__((ext_vector_type(8)));
typedef int i32x4 __attribute__((ext_vector_type(4)));
DEVI float bf2f(bf16_t b) { return __uint_as_float(((unsigned)b) << 16); }

constexpr int G_STAGE = 49152;
constexpr int G_LDS = 2 * G_STAGE;
DEVI int swz(int row, int chunk) { return row * 128 + ((chunk ^ ((row >> 1) & 7)) << 4); }

template <bool PAIRED, class ARow, class Epi>
DEVI void gemm_unit(char* lds, int K, ARow arow, const float* __restrict__ B0, const float* __restrict__ B1, int ldb, int ncol_valid, Epi epi) {
    const int tid = tid_(), wave = tid >> 6, lane = tid & 63, fr = lane & 15, fq = lane >> 4, wr = wave >> 1, wc = wave & 1;
    const int ac = tid & 7;
    const bf16_t* ap[4]; int a_lds[4];
#pragma unroll
    for (int i = 0; i < 4; ++i) { const int r = (tid >> 3) + 64 * i; ap[i] = arow(r) + ac * 8; a_lds[i] = swz(r, ac); }
    const int kq = lane & 15, nq = (lane >> 4) + 4 * wave;
    const float* bp;
    if (PAIRED) { const int seg = (nq >> 2) & 1, idx = (nq >> 3) * 16 + (nq & 3) * 4; bp = (seg ? B1 : B0) + idx; }
    else { const int c4 = 4 * nq < ncol_valid ? 4 * nq : ncol_valid - 4; bp = B0 + c4; }
    bp += (size_t)(4 * kq) * ldb;
    int b_lds[4];
#pragma unroll
    for (int i = 0; i < 4; ++i) b_lds[i] = 32768 + swz(4 * nq + i, kq >> 1) + (kq & 1) * 8;
    const int sx = (fr >> 1) & 7;
    const int aoff0 = (wr * 64 + fr) * 128 + ((fq ^ sx) << 4), aoff1 = (wr * 64 + fr) * 128 + (((4 + fq) ^ sx) << 4);
    const int boff0 = 32768 + (wc * 64 + fr) * 128 + ((fq ^ sx) << 4), boff1 = 32768 + (wc * 64 + fr) * 128 + (((4 + fq) ^ sx) << 4);
    u32x4 av0[4], av1[4]; f32x4 bv0[4], bv1[4];
#define G_LOAD(av, bv, t) do { _Pragma("unroll") for (int i = 0; i < 4; ++i) av[i] = *(const u32x4*)(ap[i] + (t) * 64); \
        _Pragma("unroll") for (int kk = 0; kk < 4; ++kk) bv[kk] = *(const f32x4*)(bp + ((size_t)(t) * 64 + kk) * ldb); } while (0)
#define G_WRITE(s_, av, bv) do { _Pragma("unroll") for (int i = 0; i < 4; ++i) *(u32x4*)((s_) + a_lds[i]) = av[i]; \
        _Pragma("unroll") for (int i = 0; i < 4; ++i) { u32x2 w_; w_.x = cvt_pk_bf16(bv[0][i], bv[1][i]); w_.y = cvt_pk_bf16(bv[2][i], bv[3][i]); *(u32x2*)((s_) + b_lds[i]) = w_; } } while (0)
#define G_MMA(Af, Bf) do { __builtin_amdgcn_s_setprio(1); _Pragma("unroll") for (int m = 0; m < 4; ++m) _Pragma("unroll") for (int n = 0; n < 4; ++n) \
        acc[m][n] = __builtin_amdgcn_mfma_f32_16x16x32_bf16(Bf[n], Af[m], acc[m][n], 0, 0, 0); __builtin_amdgcn_s_setprio(0); } while (0)
#define G_SB() __builtin_amdgcn_sched_barrier(0)
#define G_ITER(t, c_, n_, av, bv, W_, L_) do { \
        bf16x8 Af[4], Bf[4]; \
        _Pragma("unroll") for (int m = 0; m < 4; ++m) Af[m] = *(const bf16x8*)((c_) + aoff0 + m * 2048); \
        _Pragma("unroll") for (int n = 0; n < 4; ++n) Bf[n] = *(const bf16x8*)((c_) + boff0 + n * 2048); \
        G_SB(); asm volatile("s_waitcnt lgkmcnt(0)" ::: "memory"); G_SB(); \
        G_MMA(Af, Bf); G_SB(); \
        _Pragma("unroll") for (int m = 0; m < 4; ++m) Af[m] = *(const bf16x8*)((c_) + aoff1 + m * 2048); \
        _Pragma("unroll") for (int n = 0; n < 4; ++n) Bf[n] = *(const bf16x8*)((c_) + boff1 + n * 2048); \
        G_SB(); \
        if (W_) { G_WRITE(n_, av, bv); G_SB(); asm volatile("s_waitcnt lgkmcnt(8)" ::: "memory"); } else { asm volatile("s_waitcnt lgkmcnt(0)" ::: "memory"); } \
        G_SB(); \
        G_MMA(Af, Bf); G_SB(); \
        if (L_) G_LOAD(av, bv, (t) + 3); \
        G_SB(); asm volatile("s_waitcnt lgkmcnt(0)" ::: "memory"); __builtin_amdgcn_s_barrier(); G_SB(); } while (0)
    f32x4 acc[4][4];
#pragma unroll
    for (int m = 0; m < 4; ++m)
#pragma unroll
        for (int n = 0; n < 4; ++n) acc[m][n] = (f32x4){0.f, 0.f, 0.f, 0.f};
    const int nk = K >> 6;
    char* L0 = lds; char* L1 = lds + G_STAGE;
    G_LOAD(av0, bv0, 0);
    G_WRITE(L0, av0, bv0);
    if (nk > 1) G_LOAD(av1, bv1, 1);
    if (nk > 2) G_LOAD(av0, bv0, 2);
    asm volatile("s_waitcnt lgkmcnt(0)" ::: "memory"); __builtin_amdgcn_s_barrier(); G_SB();
    int t = 0;
    for (; t + 4 < nk; t += 2) {
        G_ITER(t, L0, L1, av1, bv1, true, true);
        G_ITER(t + 1, L1, L0, av0, bv0, true, true);
    }
    for (; t < nk; t += 2) {
        G_ITER(t, L0, L1, av1, bv1, t + 1 < nk, t + 3 < nk);
        if (t + 1 < nk) G_ITER(t + 1, L1, L0, av0, bv0, t + 2 < nk, t + 4 < nk);
    }
#undef G_LOAD
#undef G_WRITE
#undef G_MMA
#undef G_ITER
#undef G_SB
    { int fr_ = fr, fq_ = fq; asm volatile("" : "+v"(fr_), "+v"(fq_)); epi(acc, wr, wc, fr_, fq_); }
}


#define PG8_LAS __attribute__((address_space(3)))
namespace pg8 {
constexpr int BM = 256, BK = 64, HALF = 128, HTB = HALF * BK * 2, STAGE_BYTES = 8 * HTB;
DEVI int lds_byte(int r, int c) { const int st = (r >> 4) * 2 + (c >> 5), rr = r & 15, cc = c & 31, ob = rr * 64 + cc * 2; return st * 1024 + (ob ^ (((ob >> 9) & 1) << 5)); }
DEVI void stage_rc(int b, int& R, int& C) { const int st = b / 1024, sb = b % 1024, swz_ = sb ^ (((sb >> 9) & 1) << 5); R = (st >> 1) * 16 + swz_ / 64; C = (st & 1) * 32 + (swz_ % 64) / 2; }
DEVI int perm32(int rho) { const int n = rho >> 4, i = rho & 15; return 8 * (i >> 2) + 4 * n + (i & 3); }
struct Unit { const char* a; const char* b; int x0, x1, x2; const int* g; int gn; };
template <class Epi, class Sched, bool GATHER = false, bool F8 = false>
DEVI void gemm_phase(PG8_LAS unsigned char* lds, int K, size_t hstepB, const Sched& S, const Epi& E, int ktiles = 0, const char* Abase = nullptr) {
    const int tid = tid_(), wid = __builtin_amdgcn_readfirstlane(tid >> 6), lane = tid & 63, wr = wid >> 2, wc = wid & 3, fr = lane & 15, fq = lane >> 4;
    const int nt = ktiles ? ktiles : K / BK;
    unsigned voffA[2], voffB[2]; int Rr[2], Cc[2];
#pragma unroll
    for (int i = 0; i < 2; ++i) { int R, C; stage_rc(tid * 16 + i * 8192, R, C); const int Rb = Epi::PERM ? ((R & ~31) + perm32(R & 31)) : R; Rr[i] = R; Cc[i] = C;
        voffA[i] = (unsigned)(R * K + C) * 2u; voffB[i] = (unsigned)(Rb * K + C) * 2u; }
    unsigned offc[2][2], offn[2][2];
#define PG8_GOFF(dst, u_) do { _Pragma("unroll") for (int h_ = 0; h_ < 2; ++h_) _Pragma("unroll") for (int i_ = 0; i_ < 2; ++i_) { const int r_ = h_ * HALF + Rr[i_]; \
        const int row_ = (u_).g[r_ < (u_).gn ? r_ : 0]; dst[h_][i_] = (unsigned)(row_ * K + Cc[i_]) * 2u; } } while (0)
#define PG8_STAGE_A(bufoff, ptr, h_, offs, kb) do { if (GATHER) PG8_STAGE(bufoff, Abase + (kb), offs[h_]); else PG8_STAGE(bufoff, ptr, voffA); } while (0)
    const size_t kstep = (size_t)(BK * 2);
    const size_t hstep = (size_t)HALF * K * 2;
    const unsigned ldsw = (unsigned)wid * 1024u;
    const int aoff = lds_byte(wr * 64 + fr, fq * 8), boff = lds_byte(wc * 32 + fr, fq * 8);
#define PG8_SA(b, h) (((b) * 2 + (h)) * HTB)
#define PG8_SB(b, h) ((4 + (b) * 2 + (h)) * HTB)
#define PG8_STAGE(bufoff, gbase, voff) do { _Pragma("unroll") for (int _i = 0; _i < 2; ++_i) \
        __builtin_amdgcn_global_load_lds((const unsigned*)((const char*)(gbase) + (voff)[_i]), (PG8_LAS unsigned*)(lds + (bufoff) + ldsw + _i * 8192), 16, 0, 0); } while (0)
#define PG8_LDA(dst, b, h) do { _Pragma("unroll") for (int m = 0; m < 4; ++m) { dst##L[m] = *(const PG8_LAS i32x4*)(lds + PG8_SA(b, h) + aoff + m * 2048); dst##H[m] = *(const PG8_LAS i32x4*)(lds + PG8_SA(b, h) + aoff + m * 2048 + 1024); } } while (0)
#define PG8_LDB(dst, b, h) do { _Pragma("unroll") for (int n = 0; n < 2; ++n) { dst##L[n] = *(const PG8_LAS i32x4*)(lds + PG8_SB(b, h) + boff + n * 2048); dst##H[n] = *(const PG8_LAS i32x4*)(lds + PG8_SB(b, h) + boff + n * 2048 + 1024); } } while (0)
#define PG8_CAT(x, y) __builtin_shufflevector(x, y, 0, 1, 2, 3, 4, 5, 6, 7)
#define PG8_MMA(ai, bj, At, Bt) do { __builtin_amdgcn_s_setprio(1); \
        if (F8) { _Pragma("unroll") for (int m = 0; m < 4; ++m) _Pragma("unroll") for (int n = 0; n < 2; ++n) \
            asm volatile("v_mfma_scale_f32_16x16x128_f8f6f4 %0, %1, %2, %0, %3, %3 op_sel_hi:[0,0,0]" : "+v"(acc[ai][bj][m][n]) : "v"(PG8_CAT(Bt##L[n], Bt##H[n])), "v"(PG8_CAT(At##L[m], At##H[m])), "v"(sc_one)); } \
        else { _Pragma("unroll") for (int m = 0; m < 4; ++m) _Pragma("unroll") for (int n = 0; n < 2; ++n) { \
            acc[ai][bj][m][n] = __builtin_amdgcn_mfma_f32_16x16x32_bf16(__builtin_bit_cast(bf16x8, Bt##L[n]), __builtin_bit_cast(bf16x8, At##L[m]), acc[ai][bj][m][n], 0, 0, 0); \
            acc[ai][bj][m][n] = __builtin_amdgcn_mfma_f32_16x16x32_bf16(__builtin_bit_cast(bf16x8, Bt##H[n]), __builtin_bit_cast(bf16x8, At##H[m]), acc[ai][bj][m][n], 0, 0, 0); } } \
        __builtin_amdgcn_s_setprio(0); } while (0)
#define PG8_WAIT_V(n) asm volatile("s_waitcnt vmcnt(" #n ")" ::: "memory")
#define PG8_WAIT_L(n) asm volatile("s_waitcnt lgkmcnt(" #n ")" ::: "memory")
#define PG8_BAR __builtin_amdgcn_s_barrier()
#define PG8_SCHED __builtin_amdgcn_sched_barrier(0)
    Unit cur, nxt; int ui = 0;
    if (!S.next(0, cur)) return;
    f32x4 acc[2][2][4][2];
#pragma unroll
    for (int a = 0; a < 2; ++a)
#pragma unroll
        for (int b = 0; b < 2; ++b)
#pragma unroll
            for (int m = 0; m < 4; ++m)
#pragma unroll
                for (int n = 0; n < 2; ++n) acc[a][b][m][n] = (f32x4){0.f, 0.f, 0.f, 0.f};
    int sc_one = 0x7f7f7f7f; asm volatile("" : "+v"(sc_one));
    i32x4 AtL[4], AtH[4], B0L[2], B0H[2], B1L[2], B1H[2];
    const char* cA = cur.a; const char* cB = cur.b;
    if (GATHER) { PG8_GOFF(offc, cur); asm volatile("s_waitcnt vmcnt(0)" ::: "memory"); }
    PG8_STAGE(PG8_SB(0, 0), cB, voffB); PG8_STAGE_A(PG8_SA(0, 0), cA, 0, offc, 0); PG8_STAGE(PG8_SB(0, 1), cB + hstepB, voffB); PG8_STAGE_A(PG8_SA(0, 1), cA + hstep, 1, offc, 0);
    if (wr == 1) PG8_BAR;
    PG8_WAIT_V(4); PG8_BAR;
    PG8_STAGE(PG8_SB(1, 0), cB + kstep, voffB); PG8_STAGE_A(PG8_SA(1, 0), cA + kstep, 0, offc, kstep); PG8_STAGE(PG8_SB(1, 1), cB + hstepB + kstep, voffB);
    PG8_WAIT_V(6); PG8_BAR;
    for (;;) {
        const bool has_next = S.next(ui + 1, nxt);
        const char* nA = has_next ? nxt.a : cA; const char* nB = has_next ? nxt.b : cB;
        if (GATHER) { if (has_next) PG8_GOFF(offn, nxt); else {
#pragma unroll
            for (int h_ = 0; h_ < 2; ++h_)
#pragma unroll
                for (int i_ = 0; i_ < 2; ++i_) offn[h_][i_] = offc[h_][i_]; } }
        for (int t = 0; t < nt; t += 2) {
            const bool last = (t == nt - 2);
            const char* a1 = cA + (size_t)(t + 1) * kstep;
            const char* a2 = last ? nA : cA + (size_t)(t + 2) * kstep; const char* b2 = last ? nB : cB + (size_t)(t + 2) * kstep;
            const char* a3 = a2 + kstep; const char* b3 = b2 + kstep;
            unsigned o2[2][2]; const size_t k1 = (size_t)(t + 1) * kstep, k2 = last ? 0 : (size_t)(t + 2) * kstep, k3 = k2 + kstep;
            if (GATHER) {
                if (last) { asm volatile("" ::: "memory");
#pragma unroll
                    for (int h_ = 0; h_ < 2; ++h_)
#pragma unroll
                        for (int i_ = 0; i_ < 2; ++i_) o2[h_][i_] = offn[h_][i_]; }
                else {
#pragma unroll
                    for (int h_ = 0; h_ < 2; ++h_)
#pragma unroll
                        for (int i_ = 0; i_ < 2; ++i_) o2[h_][i_] = offc[h_][i_]; } }
            PG8_LDB(B0, 0, 0); PG8_SCHED; PG8_LDA(At, 0, 0); PG8_STAGE_A(PG8_SA(1, 1), a1 + hstep, 1, offc, k1);
            PG8_WAIT_L(8); PG8_BAR; PG8_WAIT_L(0); PG8_MMA(0, 0, At, B0); PG8_BAR; PG8_SCHED;
            PG8_LDB(B1, 0, 1); PG8_STAGE(PG8_SB(0, 0), b2, voffB);
            PG8_BAR; PG8_WAIT_L(0); PG8_MMA(0, 1, At, B1); PG8_BAR;
            PG8_LDA(At, 0, 1); PG8_STAGE_A(PG8_SA(0, 0), a2, 0, o2, k2);
            PG8_BAR; PG8_WAIT_L(0); PG8_MMA(1, 0, At, B0); PG8_BAR; PG8_SCHED;
            PG8_STAGE(PG8_SB(0, 1), b2 + hstepB, voffB);
            PG8_WAIT_V(6); PG8_BAR; PG8_MMA(1, 1, At, B1); PG8_BAR;
            PG8_LDB(B0, 1, 0); PG8_SCHED; PG8_LDA(At, 1, 0); PG8_STAGE_A(PG8_SA(0, 1), a2 + hstep, 1, o2, k2);
            PG8_WAIT_L(8); PG8_BAR; PG8_WAIT_L(0); PG8_MMA(0, 0, At, B0); PG8_BAR; PG8_SCHED;
            PG8_LDB(B1, 1, 1); PG8_STAGE(PG8_SB(1, 0), b3, voffB);
            PG8_BAR; PG8_WAIT_L(0); PG8_MMA(0, 1, At, B1); PG8_BAR;
            PG8_LDA(At, 1, 1); PG8_STAGE_A(PG8_SA(1, 0), a3, 0, o2, k3);
            PG8_BAR; PG8_WAIT_L(0); PG8_MMA(1, 0, At, B0); PG8_BAR; PG8_SCHED;
            PG8_STAGE(PG8_SB(1, 1), b3 + hstepB, voffB);
            PG8_WAIT_V(6); PG8_BAR; PG8_MMA(1, 1, At, B1); PG8_BAR;
        }
        if (F8) asm volatile("s_nop 15\n\ts_nop 15" ::: "memory");
        { int fr_ = fr, fq_ = fq; asm volatile("" : "+v"(fr_), "+v"(fq_));
          E(acc, cur, wr, wc, fr_, fq_); }
        if (!has_next) break;
#pragma unroll
        for (int a = 0; a < 2; ++a)
#pragma unroll
            for (int b = 0; b < 2; ++b)
#pragma unroll
                for (int m = 0; m < 4; ++m)
#pragma unroll
                    for (int n = 0; n < 2; ++n) acc[a][b][m][n] = (f32x4){0.f, 0.f, 0.f, 0.f};
        cur = nxt; cA = nA; cB = nB; ++ui;
        if (GATHER) {
#pragma unroll
            for (int h_ = 0; h_ < 2; ++h_)
#pragma unroll
                for (int i_ = 0; i_ < 2; ++i_) offc[h_][i_] = offn[h_][i_]; }
    }
    PG8_WAIT_V(0);
    if (wr == 0) PG8_BAR;
    PG8_BAR;
#undef PG8_SA
#undef PG8_SB
#undef PG8_STAGE
#undef PG8_STAGE_A
#undef PG8_GOFF
#undef PG8_LDA
#undef PG8_LDB
#undef PG8_MMA
#undef PG8_WAIT_V
#undef PG8_WAIT_L
#undef PG8_BAR
#undef PG8_SCHED
}
}

DEVI void conv_item(const float* __restrict__ W, int K, int N, bf16_t* __restrict__ Wt, int kb, int nb, int lane) {
    const int ko = lane & 7, nq = lane >> 3;
    const float* src = W + (size_t)(kb * 64 + ko * 8) * N + nb * 32 + nq * 4;
    f32x4 v[8];
#pragma unroll
    for (int kk = 0; kk < 8; ++kk) v[kk] = *(const f32x4*)(src + (size_t)kk * N);
    bf16_t* dst = Wt + (size_t)(nb * 32 + nq * 4) * K + kb * 64 + ko * 8;
#pragma unroll
    for (int i = 0; i < 4; ++i) { u32x4 o; o.x = cvt_pk_bf16(v[0][i], v[1][i]); o.y = cvt_pk_bf16(v[2][i], v[3][i]); o.z = cvt_pk_bf16(v[4][i], v[5][i]); o.w = cvt_pk_bf16(v[6][i], v[7][i]);
        *(u32x4*)(dst + (size_t)i * K) = o; }
}

namespace att {
typedef short s16x4 __attribute__((ext_vector_type(4)));
typedef float f32x16 __attribute__((ext_vector_type(16)));
constexpr int KVBLK = 64;
constexpr float SCALE = 0.10206207261596577f;
constexpr float THR = 8.f;
constexpr int SHM_V = 16384, SHM_K = 16384, NBUF = 3, SHM_ATTN = NBUF * SHM_V + NBUF * SHM_K + 8 * 64 * 4;
#define KSWZ(row, colB) ((row) * 256 + ((colB) ^ (((row) & 7) << 4)))
#define SBAR() __builtin_amdgcn_sched_barrier(0)
DEVI int crow(int r, int hi) { return (r & 3) + 8 * (r >> 2) + 4 * hi; }
DEVI void partialSM(f32x16& p0, f32x16& p1, float& m_reg, float& mn, float& alpha) {
    constexpr float C = SCALE * 1.4426950408889634f;
    float pmax = p0[0];
#pragma unroll
    for (int r = 1; r < 16; ++r) pmax = fmaxf(pmax, p0[r]);
#pragma unroll
    for (int r = 0; r < 16; ++r) pmax = fmaxf(pmax, p1[r]);
    { auto rr = __builtin_amdgcn_permlane32_swap(__float_as_uint(pmax), __float_as_uint(pmax), false, false);
      pmax = fmaxf(__uint_as_float(rr[0]), __uint_as_float(rr[1])); }
    if (__builtin_expect(__all(pmax - m_reg <= THR / SCALE), 1)) { mn = m_reg; alpha = 1.f; }
    else { mn = fmaxf(m_reg, pmax); alpha = __builtin_amdgcn_exp2f((m_reg - mn) * C); m_reg = mn; }
    const float mnC = -mn * C;
#pragma unroll
    for (int r = 0; r < 16; ++r) p0[r] = fmaf(p0[r], C, mnC);
#pragma unroll
    for (int r = 0; r < 16; ++r) p1[r] = fmaf(p1[r], C, mnC);
#pragma unroll
    for (int r = 0; r < 16; ++r) p0[r] = __builtin_amdgcn_exp2f(p0[r]);
}
DEVI void finishSM(f32x16& p0, f32x16& p1, float alpha, float& l_reg, bf16x8& pa0, bf16x8& pa1, bf16x8& pa2, bf16x8& pa3) {
#pragma unroll
    for (int r = 0; r < 16; ++r) p1[r] = __builtin_amdgcn_exp2f(p1[r]);
    float ps = 0.f;
#pragma unroll
    for (int r = 0; r < 16; ++r) ps += p0[r];
#pragma unroll
    for (int r = 0; r < 16; ++r) ps += p1[r];
    { auto rr = __builtin_amdgcn_permlane32_swap(__float_as_uint(ps), __float_as_uint(ps), false, false);
      ps = __uint_as_float(rr[0]) + __uint_as_float(rr[1]); }
    l_reg = l_reg * alpha + ps;
#define PK4(P, BASE, OUT) do { unsigned a0 = cvt_pk_bf16(P[BASE + 0], P[BASE + 1]), a1 = cvt_pk_bf16(P[BASE + 2], P[BASE + 3]);   \
    unsigned b0 = cvt_pk_bf16(P[BASE + 4], P[BASE + 5]), b1 = cvt_pk_bf16(P[BASE + 6], P[BASE + 7]);                              \
    auto r0 = __builtin_amdgcn_permlane32_swap(a0, b0, false, false); auto r1 = __builtin_amdgcn_permlane32_swap(a1, b1, false, false); \
    u32x4 w = {r0[0], r1[0], r0[1], r1[1]}; OUT = *reinterpret_cast<bf16x8*>(&w); } while (0)
    PK4(p0, 0, pa0); PK4(p0, 8, pa1); PK4(p1, 0, pa2); PK4(p1, 8, pa3);
#undef PK4
}
DEVI void qkt(f32x16& p0, f32x16& p1, const char* Ks, const bf16x8* qr, int r32, int hi) {
    p0 = f32x16{}; p1 = f32x16{};
#pragma unroll
    for (int d0 = 0; d0 < 6; ++d0) { const int cb = (d0 * 16 + hi * 8) * 2;
        const bf16x8 b0 = *reinterpret_cast<const bf16x8*>(Ks + KSWZ(r32, cb));
        const bf16x8 b1 = *reinterpret_cast<const bf16x8*>(Ks + KSWZ(32 + r32, cb));
        p0 = __builtin_amdgcn_mfma_f32_32x32x16_bf16(b0, qr[d0], p0, 0, 0, 0);
        p1 = __builtin_amdgcn_mfma_f32_32x32x16_bf16(b1, qr[d0], p1, 0, 0, 0); }
}
DEVI int v_st(int k, int c) { const int kk = (k & ~0xC) | ((k & 4) << 1) | ((k & 8) >> 1); return ((kk >> 3) * 4 + (c >> 5)) * 512 + ((kk & 7) * 32 + (c & 31)) * 2; }
DEVI int v_rd_base(int lane) { return ((lane & 3) << 3) | (((lane >> 2) & 3) << 6) | (((lane >> 4) & 1) << 5) | (((lane >> 5) & 1) << 8); }
constexpr int v_rd_off(int d0, int ks, int half) { return d0 * 512 + ks * 4096 + half * 2048; }
template <int OFF> DEVI s16x4 tr_read(int vb) {
    s16x4 r; asm volatile("ds_read_b64_tr_b16 %0, %1 offset:%2" : "=&v"(r) : "v"(vb), "i"(OFF) : "memory"); return r;
}
template <int D0> DEVI void pv_one(f32x16& od, int vb, bf16x8 pa0, bf16x8 pa1, bf16x8 pa2, bf16x8 pa3) {
    const s16x4 l0 = tr_read<v_rd_off(D0, 0, 0)>(vb), h0 = tr_read<v_rd_off(D0, 0, 1)>(vb), l1 = tr_read<v_rd_off(D0, 1, 0)>(vb), h1 = tr_read<v_rd_off(D0, 1, 1)>(vb);
    const s16x4 l2 = tr_read<v_rd_off(D0, 2, 0)>(vb), h2 = tr_read<v_rd_off(D0, 2, 1)>(vb), l3 = tr_read<v_rd_off(D0, 3, 0)>(vb), h3 = tr_read<v_rd_off(D0, 3, 1)>(vb);
    asm volatile("s_waitcnt lgkmcnt(0)" ::: "memory"); SBAR();
#define PKV(L, H) (bf16x8){L[0], L[1], L[2], L[3], H[0], H[1], H[2], H[3]}
    od = __builtin_amdgcn_mfma_f32_32x32x16_bf16(pa0, PKV(l0, h0), od, 0, 0, 0);
    od = __builtin_amdgcn_mfma_f32_32x32x16_bf16(pa1, PKV(l1, h1), od, 0, 0, 0);
    od = __builtin_amdgcn_mfma_f32_32x32x16_bf16(pa2, PKV(l2, h2), od, 0, 0, 0);
    od = __builtin_amdgcn_mfma_f32_32x32x16_bf16(pa3, PKV(l3, h3), od, 0, 0, 0);
#undef PKV
}
DEVI void pv_d0(f32x16* o, int vb, bf16x8 pa0, bf16x8 pa1, bf16x8 pa2, bf16x8 pa3) {
    pv_one<0>(o[0], vb, pa0, pa1, pa2, pa3); pv_one<1>(o[1], vb, pa0, pa1, pa2, pa3);
}
DEVI void attn_unit(const bf16_t* __restrict__ Qb, const bf16_t* __restrict__ Kh, const bf16_t* __restrict__ Vh, int seq, bf16_t* __restrict__ Ob, int ldo, char* lds) {
    const int tid = tid_(), wid = tid >> 6, lane = tid & 63, r32 = lane & 31, hi = lane >> 5;
    char* V_lds = lds; char* K_lds = lds + NBUF * SHM_V;
    float* wsl = (float*)(lds + NBUF * SHM_V + NBUF * SHM_K) + wid * 64; float* li_l = wsl; float* al_l = wsl + 32;
    float m_reg = -1e30f, l_reg = 0.f; f32x16 o[2] = {}; bf16x8 qr[6];
    const bf16_t* Qw = Qb + (size_t)(wid * 32 + r32) * 96 + hi * 8;
#pragma unroll
    for (int d0 = 0; d0 < 6; ++d0) qr[d0] = *reinterpret_cast<const bf16x8*>(Qw + d0 * 16);
    const int sr = tid >> 4, kc = tid & 15, kcl = (kc < 12 ? kc : 11) * 8;
    const int vr = tid >> 3, vc = (tid & 7) * 8, vst0 = v_st(vr, vc);
    const int kst0 = KSWZ(sr, kc * 16), kst1 = KSWZ(32 + sr, kc * 16);
    const int vb0 = (int)(uintptr_t)V_lds + v_rd_base(lane);
    bf16x8 sv0, sk00, sk01, sv1, sk10, sk11;
#define SLOAD0(k0) do { sv0 = *reinterpret_cast<const bf16x8*>(Vh + (size_t)((k0) + vr) * 64 + vc); sk00 = *reinterpret_cast<const bf16x8*>(Kh + (size_t)((k0) + sr) * 96 + kcl); \
    sk01 = *reinterpret_cast<const bf16x8*>(Kh + (size_t)((k0) + 32 + sr) * 96 + kcl); } while (0)
#define SLOAD1(k0) do { sv1 = *reinterpret_cast<const bf16x8*>(Vh + (size_t)((k0) + vr) * 64 + vc); sk10 = *reinterpret_cast<const bf16x8*>(Kh + (size_t)((k0) + sr) * 96 + kcl); \
    sk11 = *reinterpret_cast<const bf16x8*>(Kh + (size_t)((k0) + 32 + sr) * 96 + kcl); } while (0)
#define SWRITE0(b) do { *(bf16x8*)(V_lds + (b) * SHM_V + vst0) = sv0; *(bf16x8*)(K_lds + (b) * SHM_K + kst0) = sk00; *(bf16x8*)(K_lds + (b) * SHM_K + kst1) = sk01; } while (0)
#define SWRITE1(b) do { *(bf16x8*)(V_lds + (b) * SHM_V + vst0) = sv1; *(bf16x8*)(K_lds + (b) * SHM_K + kst0) = sk10; *(bf16x8*)(K_lds + (b) * SHM_K + kst1) = sk11; } while (0)
#define SWAIT() asm volatile("s_waitcnt vmcnt(3)" ::: "memory")
#define RESC(a) do { if (__any((a) < 1.f)) { if (hi == 0) al_l[r32] = (a); asm volatile("s_waitcnt lgkmcnt(0)" ::: "memory"); \
    _Pragma("unroll") for (int d = 0; d < 2; ++d) _Pragma("unroll") for (int r = 0; r < 16; ++r) o[d][r] *= al_l[crow(r, hi)]; } } while (0)
#define BNEXT(b) ((b) == NBUF - 1 ? 0 : (b) + 1)
    f32x16 pA0, pA1, pB0, pB1; float mnA, mnB, alA, alB; bf16x8 pa0, pa1, pa2, pa3; const int NT = seq / KVBLK;
    SLOAD0(0); asm volatile("s_waitcnt vmcnt(0)" ::: "memory"); SWRITE0(0); __syncthreads();
    qkt(pA0, pA1, K_lds, qr, r32, hi); partialSM(pA0, pA1, m_reg, mnA, alA);
    SLOAD1(KVBLK); if (2 < NT) SLOAD0(2 * KVBLK);
    SWAIT(); SWRITE1(1); __syncthreads();
    int bp = 0, bc = 1, bn = 2;
    for (int j = 1; j + 1 < NT; j += 2) {
        SBAR(); qkt(pB0, pB1, K_lds + bc * SHM_K, qr, r32, hi);
        finishSM(pA0, pA1, alA, l_reg, pa0, pa1, pa2, pa3); SBAR();
        SLOAD1((j + 2) * KVBLK); SBAR();
        pv_d0(o, vb0 + bp * SHM_V, pa0, pa1, pa2, pa3); partialSM(pB0, pB1, m_reg, mnB, alB);
        SWAIT(); SWRITE0(bn);
        RESC(alB); __syncthreads();
        bp = bc; bc = bn; bn = BNEXT(bn);
        SBAR(); qkt(pA0, pA1, K_lds + bc * SHM_K, qr, r32, hi);
        finishSM(pB0, pB1, alB, l_reg, pa0, pa1, pa2, pa3); SBAR();
        if (j + 3 < NT) SLOAD0((j + 3) * KVBLK); SBAR();
        pv_d0(o, vb0 + bp * SHM_V, pa0, pa1, pa2, pa3); partialSM(pA0, pA1, m_reg, mnA, alA);
        SWAIT(); SWRITE1(bn);
        RESC(alA); __syncthreads();
        bp = bc; bc = bn; bn = BNEXT(bn);
    }
    SBAR(); qkt(pB0, pB1, K_lds + bc * SHM_K, qr, r32, hi);
    finishSM(pA0, pA1, alA, l_reg, pa0, pa1, pa2, pa3); SBAR();
    pv_d0(o, vb0 + bp * SHM_V, pa0, pa1, pa2, pa3); partialSM(pB0, pB1, m_reg, mnB, alB);
    RESC(alB);
    finishSM(pB0, pB1, alB, l_reg, pa0, pa1, pa2, pa3); SBAR();
    pv_d0(o, vb0 + bc * SHM_V, pa0, pa1, pa2, pa3);
    if (hi == 0) li_l[r32] = l_reg; asm volatile("s_waitcnt lgkmcnt(0)" ::: "memory");
    float rli[16];
#pragma unroll
    for (int r = 0; r < 16; ++r) rli[r] = __builtin_amdgcn_rcpf(li_l[crow(r, hi)]);
    bf16_t* Ow = Ob + (size_t)(wid * 32) * ldo;
#pragma unroll
    for (int r = 0; r < 16; ++r) { const int orow = crow(r, hi);
#pragma unroll
        for (int d0 = 0; d0 < 2; ++d0) Ow[(size_t)orow * ldo + d0 * 32 + r32] = f2bf(o[d0][r] * rli[r]); }
    __syncthreads();
#undef SLOAD0
#undef SLOAD1
#undef SWRITE0
#undef SWRITE1
#undef SWAIT
#undef RESC
#undef BNEXT
}
#undef KSWZ
#undef SBAR
}

template <class ARow, class BMap, class Epi>
DEVI void gemm_tile(int K, ARow arow, const float* __restrict__ B, int ldb, BMap bmap, Epi epi, float* smem) {
    float (*As)[132] = (float (*)[132])smem;
    float (*Bs)[64] = (float (*)[64])(smem + 16 * 132);
    const int tid = tid_(), ty = tid >> 4, tx = tid & 15;
    float acc[4][4];
#pragma unroll
    for (int i = 0; i < 4; ++i)
#pragma unroll
        for (int j = 0; j < 4; ++j) acc[i][j] = 0.f;
    const int ar = tid >> 2, akq = tid & 3;
    const float* ap = arow(ar);
    const int bk0 = tid >> 6, bc = tid & 63;
    const int bcol = bmap(bc);
    for (int k0 = 0; k0 < K; k0 += 16) {
        float4 av = make_float4(0.f, 0.f, 0.f, 0.f);
        if (ap) av = *(const float4*)(ap + k0 + akq * 4);
        float b0 = 0.f, b1 = 0.f;
        if (bcol >= 0) { b0 = B[(size_t)(k0 + bk0) * ldb + bcol]; b1 = B[(size_t)(k0 + bk0 + 8) * ldb + bcol]; }
        __syncthreads();
        As[akq * 4 + 0][ar] = av.x; As[akq * 4 + 1][ar] = av.y; As[akq * 4 + 2][ar] = av.z; As[akq * 4 + 3][ar] = av.w;
        Bs[bk0][bc] = b0; Bs[bk0 + 8][bc] = b1;
        __syncthreads();
#pragma unroll
        for (int kk = 0; kk < 16; ++kk) {
            const float4 a = *(const float4*)&As[kk][ty * 4];
            const float4 b = *(const float4*)&Bs[kk][tx * 4];
            const float aa[4] = {a.x, a.y, a.z, a.w}, bb[4] = {b.x, b.y, b.z, b.w};
#pragma unroll
            for (int i = 0; i < 4; ++i)
#pragma unroll
                for (int j = 0; j < 4; ++j) acc[i][j] = fmaf(aa[i], bb[j], acc[i][j]);
        }
    }
#pragma unroll
    for (int i = 0; i < 4; ++i) epi(ty * 4 + i, tx, acc[i]);
    __syncthreads();
}


struct UnitRange { int lo, hi, step; };
DEVI UnitRange unit_range(int nunits, int bid) {
    UnitRange r;
    if ((gridDim.x & 7) == 0) { const int x = bid & 7, j = bid >> 3; r.lo = (int)(((long)nunits * x) >> 3) + j; r.hi = (int)(((long)nunits * (x + 1)) >> 3); r.step = gridDim.x >> 3; }
    else { r.lo = bid; r.hi = nunits; r.step = gridDim.x; }
    return r;
}


template <bool REV> DEVI void scan16(float& a, float& b) {
#define SC_STEP(N_) do { const int ctrl_ = (REV ? 0x100 : 0x110) | (N_); \
        const float pa = __int_as_float(__builtin_amdgcn_update_dpp(0x3f800000, __float_as_int(a), ctrl_, 0xf, 0xf, false)); \
        const float pb = __int_as_float(__builtin_amdgcn_update_dpp(0, __float_as_int(b), ctrl_, 0xf, 0xf, false)); \
        b = fmaf(a, pb, b); a = a * pa; } while (0)
    SC_STEP(1); SC_STEP(2); SC_STEP(4); SC_STEP(8);
#undef SC_STEP
}

__device__ void phase_convert(const Params& p) {
    float* const ws = (float*)(gfloat_t*)tab_ld(N_IN);
    const float* const pin_I_WIN = PIN(I_WIN);
    const float* const pin_I_WOUT = PIN(I_WOUT);
    const int tid = tid_(), bid = bid_();
    const int lane = tid & 63, gw = bid * (NTHR / 64) + __builtin_amdgcn_readfirstlane(tid >> 6), nw = gridDim.x * (NTHR / 64);
    constexpr int NI_OUT = NLAYER * 16 * 32, NI_IN = NLAYER * 16 * 51;
    bf16_t* wout = (bf16_t*)(ws + W_WOUT); bf16_t* win = (bf16_t*)(ws + W_WIN);
    for (int it = gw; it < NI_OUT + NI_IN; it += nw) {
        int r = it;
        if (r < NI_OUT) { const int mat = r >> 9, q = r & 511; conv_item(pin_I_WOUT + (size_t)mat * D * D, D, D, wout + (size_t)mat * D * D, q >> 5, q & 31, lane); continue; }
        r -= NI_OUT;
        { const int mat = r / 816, q = r % 816; conv_item(pin_I_WIN + (size_t)mat * D * INC, D, INC, win + (size_t)mat * NPAD_IN * D, q / 51, q % 51, lane); }
    }
}
DEVI void conv_item2(const float* __restrict__ W0, int N0, bf16_t* __restrict__ T0, int kb0, int nb0, const float* __restrict__ W1, int N1, bf16_t* __restrict__ T1, int kb1, int nb1, int lane) {
    constexpr int K = D;
    const int ko = lane & 7, nq = lane >> 3;
    const float* s0 = W0 + (size_t)(kb0 * 64 + ko * 8) * N0 + nb0 * 32 + nq * 4; const float* s1 = W1 + (size_t)(kb1 * 64 + ko * 8) * N1 + nb1 * 32 + nq * 4;
    f32x4 v[8], w[8];
#pragma unroll
    for (int kk = 0; kk < 8; ++kk) v[kk] = __builtin_nontemporal_load((const f32x4*)(s0 + (size_t)kk * N0));
#pragma unroll
    for (int kk = 0; kk < 8; ++kk) w[kk] = __builtin_nontemporal_load((const f32x4*)(s1 + (size_t)kk * N1));
    bf16_t* d0 = T0 + (size_t)(nb0 * 32 + nq * 4) * K + kb0 * 64 + ko * 8; bf16_t* d1 = T1 + (size_t)(nb1 * 32 + nq * 4) * K + kb1 * 64 + ko * 8;
#pragma unroll
    for (int i = 0; i < 4; ++i) { u32x4 o; o.x = cvt_pk_bf16(v[0][i], v[1][i]); o.y = cvt_pk_bf16(v[2][i], v[3][i]); o.z = cvt_pk_bf16(v[4][i], v[5][i]); o.w = cvt_pk_bf16(v[6][i], v[7][i]);
        *(u32x4*)(d0 + (size_t)i * K) = o; }
#pragma unroll
    for (int i = 0; i < 4; ++i) { u32x4 o; o.x = cvt_pk_bf16(w[0][i], w[1][i]); o.y = cvt_pk_bf16(w[2][i], w[3][i]); o.z = cvt_pk_bf16(w[4][i], w[5][i]); o.w = cvt_pk_bf16(w[6][i], w[7][i]);
        *(u32x4*)(d1 + (size_t)i * K) = o; }
}
constexpr int NI_MOE = NEXP * 16 * 64 + NEXP * 16 * 32;
__device__ void conv_moe(const Params& p, int l, int quota) {
    float* const ws = (float*)(gfloat_t*)tab_ld(N_IN);
    const float* const pin_I_WDN = PIN(I_WDN);
    const float* const pin_I_WGU = PIN(I_WGU);
    const int tid = tid_(), bid = bid_();
    const int lane = tid & 63;
    int* cursor = (int*)(ws + W_BAR) + 3584 + l * 64;
    bf16_t* wgu = (bf16_t*)(ws + W_WGU) + (size_t)l * NEXP * 2048 * D; bf16_t* wdn = (bf16_t*)(ws + W_WDN) + (size_t)l * NEXP * D * D;
    const float* sgu = pin_I_WGU + (size_t)l * NEXP * D * 2048; const float* sdn = pin_I_WDN + (size_t)l * NEXP * D * D;
#define CONV_DEC(it, S_, N_, T_, KB_, NB_) const float* S_; bf16_t* T_; int N_, KB_, NB_; \
        if ((it) < NEXP * 1024) { const int mat = (it) >> 10, q = (it) & 1023; S_ = sgu + (size_t)mat * D * 2048; N_ = 2048; T_ = wgu + (size_t)mat * 2048 * D; KB_ = q >> 6; NB_ = q & 63; } \
        else { const int r_ = (it) - NEXP * 1024, mat = r_ >> 9, q = r_ & 511; S_ = sdn + (size_t)mat * D * D; N_ = D; T_ = wdn + (size_t)mat * D * D; KB_ = q >> 5; NB_ = q & 31; }
#define CONV_PAIR(i0, i1) do { CONV_DEC(i0, sa_, na_, ta_, ka_, ba_) CONV_DEC(i1, sb_, nb_, tb_, kb_, bb_) conv_item2(sa_, na_, ta_, ka_, ba_, sb_, nb_, tb_, kb_, bb_, lane); } while (0)
    if (quota > 0) {
        int c0 = 0;
        if (lane == 0) c0 = atomicAdd(cursor, quota);
        c0 = __builtin_amdgcn_readfirstlane(c0);
        for (int it = c0; it < c0 + quota && it + 1 < NI_MOE; it += 2) CONV_PAIR(it, it + 1);
    } else {
        int c0 = __hip_atomic_load(cursor, __ATOMIC_RELAXED, __HIP_MEMORY_SCOPE_AGENT);
        c0 = __builtin_amdgcn_readfirstlane(c0); if (c0 > NI_MOE) c0 = NI_MOE;
        const int gw = bid * (NTHR / 64) + __builtin_amdgcn_readfirstlane(tid >> 6), nw = gridDim.x * (NTHR / 64);
        for (int it = c0 + 2 * gw; it + 1 < NI_MOE; it += 2 * nw) CONV_PAIR(it, it + 1);
    }
#undef CONV_DEC
#undef CONV_PAIR
}

__device__ void phase_tables(const Params& p) {
    float* const ws = (float*)(gfloat_t*)tab_ld(N_IN);
    const float* const pin_I_LAM = PIN(I_LAM);
    const float* const pin_I_SGWS = PIN(I_SGWS);
    const int tid = tid_(), bid = bid_(); (void)tid; (void)bid;
    for (int i = bid * NTHR + tid; i < NLAYER * 4 * 128 * 128; i += gridDim.x * NTHR) ((bf16_t*)(ws + W_WSB))[i] = f2bf(pin_I_SGWS[i]);
    for (int i = bid * NTHR + tid; i < NLAT * 16; i += gridDim.x * NTHR) {
        const int t = i >> 4, f = i & 15; const float pos = (f < 8) ? (float)(t >> 6) : (float)(t & 63);
        const float ang = pos * powf(10000.f, -(float)(f & 7) / 8.f);
        ws[W_ROPE + (size_t)t * 32 + f] = cosf(ang); ws[W_ROPE + (size_t)t * 32 + 16 + f] = sinf(ang);
    }
    if (bid == 1) for (int i = tid; i < NLAYER * 2 * 256; i += NTHR) ws[W_SP + i] = log1pf(expf(-pin_I_LAM[i]));
    if (bid == 0) for (int i = tid; i < NLAYER * NEXP * 64; i += NTHR) ((int*)(ws + W_CNT))[i] = 0;
}

DEVI void norm1_store(const Params& p, int l, int t, int lane, const float4 (&v)[4]) {
    const float* g = p.in[I_NMIX] + l * D;
    const float* mod = p.ws + W_MOD + (size_t)(l * 2 + (t >= NLAT ? 1 : 0)) * 6144;
    float ss = 0.f;
#pragma unroll
    for (int j = 0; j < 4; ++j) ss += v[j].x * v[j].x + v[j].y * v[j].y + v[j].z * v[j].z + v[j].w * v[j].w;
    const float rstd = rsqrtf(wave_sum(ss) * (1.f / D) + EPS);
    bf16_t* hb = (bf16_t*)(p.ws + W_HB) + (size_t)t * D;
#pragma unroll
    for (int j = 0; j < 4; ++j) {
        const int c = j * 256 + lane * 4;
        const float4 gg = *(const float4*)(g + c), s1 = *(const float4*)(mod + D + c), s0 = *(const float4*)(mod + c);
        u32x2 w; w.x = cvt_pk_bf16(v[j].x * rstd * gg.x * (1.f + s1.x) + s0.x, v[j].y * rstd * gg.y * (1.f + s1.y) + s0.y);
        w.y = cvt_pk_bf16(v[j].z * rstd * gg.z * (1.f + s1.z) + s0.z, v[j].w * rstd * gg.w * (1.f + s1.w) + s0.w);
        *(u32x2*)(hb + c) = w;
    }
}
__device__ void phase_init(const Params& p) {
    float* const ws = (float*)(gfloat_t*)tab_ld(N_IN);
    const float* const pin_I_CTX = PIN(I_CTX);
    const float* const pin_I_X = PIN(I_X);
    const int tid = tid_(), bid = bid_();
    const int lane = tid & 63, gw = bid * (NTHR / 64) + __builtin_amdgcn_readfirstlane(tid >> 6), nw = gridDim.x * (NTHR / 64);
    for (int t = gw; t < T; t += nw) {
        const float* src = (t < NLAT) ? pin_I_X + (size_t)t * D : pin_I_CTX + (size_t)(t - NLAT) * D;
        float4 v[4];
#pragma unroll
        for (int j = 0; j < 4; ++j) { v[j] = *(const float4*)(src + j * 256 + lane * 4); if (t >= NLAT) *(float4*)(ws + W_X + (size_t)t * D + j * 256 + lane * 4) = v[j]; }
        norm1_store(p, 0, t, lane, v);
    }
}

__device__ void phase_mod(const Params& p, float* smem) {
    float* const ws = (float*)(gfloat_t*)tab_ld(N_IN);
    const float* const pin_I_BMOD = PIN(I_BMOD);
    const float* const pin_I_C = PIN(I_C);
    const float* const pin_I_CCTX = PIN(I_CCTX);
    const float* const pin_I_WMOD = PIN(I_WMOD);
    const int tid = tid_(), bid = bid_();
    const int wave = tid >> 6, lane = tid & 63;
    float* sc = smem + 1024;
    for (int i = tid; i < 1024; i += NTHR) { sc[i] = silu(pin_I_C[i]); sc[1024 + i] = silu(pin_I_CCTX[i]); }
    __syncthreads();
    for (int it = bid; it < NLAYER * 96; it += gridDim.x) {
        const int l = it / 96, j = (it % 96) * 64 + lane;
        const float* W = pin_I_WMOD + (size_t)l * 1024 * 6144 + j;
        float a0 = 0.f, a1 = 0.f;
        for (int k0 = wave * 128; k0 < wave * 128 + 128; k0 += 16) {
            float w[16];
#pragma unroll
            for (int q = 0; q < 16; ++q) w[q] = W[(size_t)(k0 + q) * 6144];
#pragma unroll
            for (int q = 0; q < 16; ++q) { a0 = fmaf(sc[k0 + q], w[q], a0); a1 = fmaf(sc[1024 + k0 + q], w[q], a1); }
        }
        smem[(wave * 2 + 0) * 64 + lane] = a0; smem[(wave * 2 + 1) * 64 + lane] = a1;
        __syncthreads();
        if (wave < 2) {
            float s = 0.f;
            for (int w = 0; w < 8; ++w) s += smem[(w * 2 + wave) * 64 + lane];
            ws[W_MOD + (size_t)(l * 2 + wave) * 6144 + j] = s + pin_I_BMOD[l * 6144 + j];
        }
        __syncthreads();
    }
}


struct InprojSched {
    UnitRange ur; const char* A; const char* Bt;
    DEVI bool next(int i, pg8::Unit& u) const {
        const int id = ur.lo + i * ur.step; if (id >= ur.hi) return false;
        const int tm = id / 7, tn = id % 7;
        u.a = A + (size_t)tm * 256 * D * 2; u.b = Bt + (size_t)tn * 256 * D * 2; u.x0 = tm * 256; u.x1 = tn * 256; u.x2 = 0; u.g = nullptr; u.gn = 0; return true;
    }
};
struct EpiInproj { static constexpr bool PERM = true; bf16_t* P;
    DEVI void operator()(const f32x4 (&acc)[2][2][4][2], const pg8::Unit& u, int wr, int wc, int fr, int fq) const {
#pragma unroll
        for (int ai = 0; ai < 2; ++ai)
#pragma unroll
            for (int m = 0; m < 4; ++m) { bf16_t* row = P + (size_t)(u.x0 + ai * 128 + wr * 64 + m * 16 + fr) * INC;
#pragma unroll
                for (int bj = 0; bj < 2; ++bj) { const int c = u.x1 + bj * 128 + wc * 32 + 8 * fq;
                    if (c < INC) { const f32x4 v0 = acc[ai][bj][m][0], v1 = acc[ai][bj][m][1];
                        u32x4 w; w.x = cvt_pk_bf16(v0[0], v0[1]); w.y = cvt_pk_bf16(v0[2], v0[3]); w.z = cvt_pk_bf16(v1[0], v1[1]); w.w = cvt_pk_bf16(v1[2], v1[3]);
                        *(u32x4*)(row + c) = w; } } }
    }
};
__device__ void phase_inproj(const Params& p, int l, char* lds) {
    float* const ws = (float*)(gfloat_t*)tab_ld(N_IN);
    const int tid = tid_(), bid = bid_(); (void)tid;
    InprojSched S; S.ur = unit_range((T / 256) * 7, bid); S.A = (const char*)(ws + W_HB); S.Bt = (const char*)((const bf16_t*)(ws + W_WIN) + (size_t)l * NPAD_IN * D);
    EpiInproj E; E.P = (bf16_t*)(ws + W_P);
    pg8::gemm_phase((PG8_LAS unsigned char*)lds, D, (size_t)128 * D * 2, S, E);
    { const int mine = (S.ur.hi - S.ur.lo + S.ur.step - 1) / S.ur.step, most = ((T / 256) * 7 / 8 + 1 + S.ur.step - 1) / S.ur.step;
      if (mine < most) conv_moe(p, l, 12); }
}

__device__ void phase_prep1(const Params& p, int l) {
    float* const ws = (float*)(gfloat_t*)tab_ld(N_IN);
    const float* const pin_I_CONVB = PIN(I_CONVB);
    const float* const pin_I_CONVW = PIN(I_CONVW);
    const float* const pin_I_KVAN = PIN(I_KVAN);
    const float* const pin_I_QAN = PIN(I_QAN);
    const float* const pin_I_SGB = PIN(I_SGB);
    const float* const pin_I_SGG = PIN(I_SGG);
    const int tid = tid_(), bid = bid_(); (void)tid; (void)bid;
    const int lane = tid & 63, gw = bid * (NTHR / 64) + __builtin_amdgcn_readfirstlane(tid >> 6), nw = gridDim.x * (NTHR / 64);
    float qan[3], kvan[2];
#pragma unroll
    for (int j = 0; j < 3; ++j) qan[j] = pin_I_QAN[l * 192 + j * 64 + lane];
#pragma unroll
    for (int j = 0; j < 2; ++j) kvan[j] = pin_I_KVAN[l * 128 + j * 64 + lane];
    const f32x4 sgg = *(const f32x4*)(pin_I_SGG + l * 256 + lane * 4), sgb = *(const f32x4*)(pin_I_SGB + l * 256 + lane * 4);
    const f32x4 cb = *(const f32x4*)(pin_I_CONVB + l * 256 + lane * 4);
    f32x4 cw[4];
#pragma unroll
    for (int k = 0; k < 4; ++k) cw[k] = *(const f32x4*)(pin_I_CONVW + (size_t)l * 4 * 256 + k * 256 + lane * 4);
    const int g = lane >> 4, w = 2 << g;
    const bf16_t* P = (const bf16_t*)(ws + W_P);
    for (int t = gw; t < T; t += nw) {
        const int s0 = (t < NLAT) ? 0 : NLAT, sl = (t < NLAT) ? NLAT : NCTX, n = t - s0;
        const bf16_t* pr = P + (size_t)t * INC;
        const int lo = max(n - w / 2, 0), hi = min(n + w / 2, sl);
        f32x4 pw[16];
#pragma unroll
        for (int j = 0; j < 16; ++j) { const int m = min(lo + j, hi - 1); pw[j] = ld4bf(P + (size_t)(s0 + m) * INC + OFF_A + lane * 4); }
        const f32x4 xa = ld4bf(pr + OFF_A + lane * 4);
        float qv[3], kvv[2];
#pragma unroll
        for (int j = 0; j < 3; ++j) qv[j] = bf2f(pr[OFF_Q + j * 64 + lane]);
#pragma unroll
        for (int j = 0; j < 2; ++j) kvv[j] = bf2f(pr[OFF_KV + j * 64 + lane]);
        const f32x4 zu = ld4bf(pr + OFF_C + lane * 4), zv = ld4bf(pr + OFF_C + 256 + lane * 4);
        f32x4 xc[4];
#pragma unroll
        for (int k = 0; k < 4; ++k) { const int m = min(max(n - 1 + k, 0), sl - 1); xc[k] = ld4bf(P + (size_t)(s0 + m) * INC + OFF_DX + lane * 4); }
        {   f32x4 sacc = (f32x4){0.f, 0.f, 0.f, 0.f};
#pragma unroll
            for (int j = 0; j < 16; ++j) sacc = sacc + ((lo + j < hi) ? pw[j] : (f32x4){0.f, 0.f, 0.f, 0.f});
            const float inv = 1.f / (float)(hi - lo);
            const f32x4 d = sacc * inv - xa;
            u32x2 o; o.x = cvt_pk_bf16(d[0], d[1]); o.y = cvt_pk_bf16(d[2], d[3]); *(u32x2*)((bf16_t*)(ws + W_DIFF) + (size_t)t * 256 + lane * 4) = o; }
        {   const float rq = rsqrtf(wave_sum(qv[0] * qv[0] + qv[1] * qv[1] + qv[2] * qv[2]) * (1.f / 192.f) + EPS);
#pragma unroll
            for (int j = 0; j < 3; ++j) ((bf16_t*)(ws + W_QN))[(size_t)t * 192 + j * 64 + lane] = f2bf(qv[j] * rq * qan[j]);
            const float rk = rsqrtf(wave_sum(kvv[0] * kvv[0] + kvv[1] * kvv[1]) * (1.f / 128.f) + EPS);
#pragma unroll
            for (int j = 0; j < 2; ++j) ((bf16_t*)(ws + W_KVN))[(size_t)t * 128 + j * 64 + lane] = f2bf(kvv[j] * rk * kvan[j]); }
        {   f32x4 u, gv;
#pragma unroll
            for (int j = 0; j < 4; ++j) { u[j] = gelu_tanh(zu[j]); gv[j] = gelu_tanh(zv[j]); }
            *(f32x4*)(ws + W_U + (size_t)t * 256 + lane * 4) = u;
            const float mu = wave_sum(gv[0] + gv[1] + gv[2] + gv[3]) * (1.f / 256.f);
            gv = gv - mu;
            const float rstd = rsqrtf(wave_sum(gv[0] * gv[0] + gv[1] * gv[1] + gv[2] * gv[2] + gv[3] * gv[3]) * (1.f / 256.f) + EPS);
            *(f32x4*)(ws + W_VN + (size_t)t * 256 + lane * 4) = gv * rstd * sgg + sgb; }
        {   f32x4 o = cb;
#pragma unroll
            for (int k = 0; k < 4; ++k) { const int m = n - 1 + k; if (m >= 0 && m < sl) o = o + xc[k] * cw[k]; }
            u32x2 ob; ob.x = cvt_pk_bf16(o[0], o[1]); ob.y = cvt_pk_bf16(o[2], o[3]); *(u32x2*)((bf16_t*)(ws + W_XCB) + (size_t)t * 256 + lane * 4) = ob; }
    }
}

__device__ void phase_small(const Params& p, int l, char* lds) {
    float* const ws = (float*)(gfloat_t*)tab_ld(N_IN);
    const float* const pin_I_BA = PIN(I_BA);
    const float* const pin_I_BX = PIN(I_BX);
    const float* const pin_I_POOLS = PIN(I_POOLS);
    const float* const pin_I_POOLW = PIN(I_POOLW);
    const float* const pin_I_SGBS = PIN(I_SGBS);
    const float* const pin_I_WA = PIN(I_WA);
    const float* const pin_I_WUKV = PIN(I_WUKV);
    const float* const pin_I_WUQ = PIN(I_WUQ);
    const float* const pin_I_WX = PIN(I_WX);
    const int tid = tid_(), bid = bid_(); (void)tid;
    constexpr int NK = 19, NU1 = (T / 256) * NK, NU2 = NCHUNK * 2;
    bf16_t* Y = (bf16_t*)(ws + W_YC);
    for (int u = bid; u < NU1 + NU2; u += gridDim.x) {
        if (u < NU1) {
            const int tm = u / NK, kind = u % NK, m0 = tm * 256;
            if (kind < 11) {
                const bf16_t* A; int lda, K, ldb, nval; const float* B;
                if (kind < 4) { A = (const bf16_t*)(ws + W_DIFF) + kind * 64; lda = 256; K = 64; B = pin_I_POOLW + (size_t)(l * 4 + kind) * 64 * 64; ldb = 64; nval = 64; }
                else if (kind < 7) { A = (const bf16_t*)(ws + W_QN); lda = 192; K = 192; B = pin_I_WUQ + (size_t)l * 192 * 384 + (kind - 4) * 128; ldb = 384; nval = 128; }
                else { A = (const bf16_t*)(ws + W_KVN); lda = 128; K = 128; B = pin_I_WUKV + (size_t)l * 128 * 512 + (kind - 7) * 128; ldb = 512; nval = 128; }
                gemm_unit<false>(lds, K, [&](int r) { return A + (size_t)(m0 + r) * lda; }, B, B, ldb, nval,
                    [&](const f32x4 (&acc)[4][4], int wr, int wc, int fr, int fq) {
#pragma unroll
                        for (int m = 0; m < 4; ++m) { const int t = m0 + wr * 64 + m * 16 + fr;
#pragma unroll
                            for (int n = 0; n < 4; ++n) { const int c = wc * 64 + n * 16 + 4 * fq;
                                if (kind < 4) { if (wc == 0) { const f32x4 sc = *(const f32x4*)(pin_I_POOLS + l * 256 + kind * 64 + c); const f32x4 v = acc[m][n] * sc;
                                        u32x2 w; w.x = cvt_pk_bf16(v[0], v[1]); w.y = cvt_pk_bf16(v[2], v[3]); *(u32x2*)(Y + (size_t)t * D + kind * 64 + c) = w; } }
                                else if (kind < 7) { const f32x4 v_ = acc[m][n]; u32x2 w_; w_.x = cvt_pk_bf16(v_[0], v_[1]); w_.y = cvt_pk_bf16(v_[2], v_[3]); *(u32x2*)((bf16_t*)(ws + W_QUP) + (size_t)t * 384 + (kind - 4) * 128 + c) = w_; }
                                else { const f32x4 v_ = acc[m][n]; u32x2 w_; w_.x = cvt_pk_bf16(v_[0], v_[1]); w_.y = cvt_pk_bf16(v_[2], v_[3]); *(u32x2*)((bf16_t*)(ws + W_KVUP) + (size_t)t * 512 + (kind - 7) * 128 + c) = w_; } } }
                    });
            } else {
                const int d = (kind - 11) >> 2, h = (kind - 11) & 3;
                const bf16_t* A = (const bf16_t*)(ws + W_XCB) + h * 64;
                const float* Ba = pin_I_WA + (size_t)((l * 2 + d) * 4 + h) * 64 * 64; const float* Bx = pin_I_WX + (size_t)((l * 2 + d) * 4 + h) * 64 * 64;
                const int pb = (l * 2 + d) * 256 + h * 64;
                gemm_unit<true>(lds, 64, [&](int r) { return A + (size_t)(m0 + r) * 256; }, Ba, Bx, 64, 64,
                    [&](const f32x4 (&acc)[4][4], int wr, int wc, int fr, int fq) {
                        const int sub = tm * 4 + wr;
                        const int lane16 = (fr == (d ? 0 : 15));
#pragma unroll
                        for (int pp = 0; pp < 2; ++pp) { const int idx = (wc * 2 + pp) * 16 + 4 * fq;
                            const f32x4 ba = *(const f32x4*)(pin_I_BA + pb + idx), bx = *(const f32x4*)(pin_I_BX + pb + idx), sp = *(const f32x4*)(ws + W_SP + pb + idx);
                            f32x4 Hc = (f32x4){0.f, 0.f, 0.f, 0.f}, Ac = (f32x4){1.f, 1.f, 1.f, 1.f};
#pragma unroll
                            for (int mm = 0; mm < 4; ++mm) { const int m = d ? 3 - mm : mm; const int t = m0 + wr * 64 + m * 16 + fr;
                                const f32x4 xv = ld4bf((const bf16_t*)(ws + W_XCB) + (size_t)t * 256 + h * 64 + idx);
                                f32x4 av, dv;
#pragma unroll
                                for (int j = 0; j < 4; ++j) { const float r = fsigm(acc[m][2 * pp][j] + ba[j]), ig = fsigm(acc[m][2 * pp + 1][j] + bx[j]);
                                    const float loga = -8.f * r * sp[j], x2 = 2.f * loga;
                                    const float om = (x2 > -0.0625f) ? -x2 * (1.f + x2 * (0.5f + x2 * (0.16666667f + x2 * 0.041666668f))) : 1.f - fexp(x2);
                                    float a_ = fexp(loga), b_ = __builtin_amdgcn_sqrtf(om) * (ig * xv[j]);
                                    if (d) scan16<true>(a_, b_); else scan16<false>(a_, b_);
                                    b_ = fmaf(a_, Hc[j], b_); a_ = a_ * Ac[j];
                                    av[j] = a_; dv[j] = b_; }
                                { const f32x4 v_ = av; u32x2 w_; w_.x = cvt_pk_bf16(v_[0], v_[1]); w_.y = cvt_pk_bf16(v_[2], v_[3]); *(u32x2*)((bf16_t*)(ws + W_LA2) + ((size_t)d * T + t) * 256 + h * 64 + idx) = w_; }
                                { const f32x4 v_ = dv; u32x2 w_; w_.x = cvt_pk_bf16(v_[0], v_[1]); w_.y = cvt_pk_bf16(v_[2], v_[3]); *(u32x2*)((bf16_t*)(ws + W_LB2) + ((size_t)d * T + t) * 256 + h * 64 + idx) = w_; }
                                const int src = ((fq << 4) | (d ? 0 : 15)) << 2;
#pragma unroll
                                for (int j = 0; j < 4; ++j) { Ac[j] = __int_as_float(__builtin_amdgcn_ds_bpermute(src, __float_as_int(av[j]))); Hc[j] = __int_as_float(__builtin_amdgcn_ds_bpermute(src, __float_as_int(dv[j]))); }
                            }
                            if (lane16) { *(f32x4*)(ws + W_AGG + ((size_t)(sub * 2 + d) * 2 + 0) * 256 + h * 64 + idx) = Ac; *(f32x4*)(ws + W_AGG + ((size_t)(sub * 2 + d) * 2 + 1) * 256 + h * 64 + idx) = Hc; }
                        }
                    });
            }
        } else {
            const int v = u - NU1, c = v >> 1, hp = v & 1;
            const bf16_t* A = (const bf16_t*)(ws + W_WSB) + ((size_t)l * 512 + hp * 256) * 128;
            const float* B = ws + W_VN + (size_t)c * 128 * 256 + hp * 128;
            gemm_unit<false>(lds, 128, [&](int r) { return A + (size_t)r * 128; }, B, B, 256, 128,
                [&](const f32x4 (&acc)[4][4], int wr, int wc, int fr, int fq) {
                    if ((wr >> 1) == wc) {
                        const int h = hp * 2 + wc;
#pragma unroll
                        for (int m = 0; m < 4; ++m) { const int pp = (wr & 1) * 64 + m * 16 + fr, t = c * 128 + pp; const float bs = pin_I_SGBS[(l * 4 + h) * 128 + pp];
#pragma unroll
                            for (int n = 0; n < 4; ++n) { const int ch = h * 64 + n * 16 + 4 * fq; const f32x4 uu = *(const f32x4*)(ws + W_U + (size_t)t * 256 + ch);
                                const f32x4 o = uu * (acc[m][n] + bs);
                                u32x2 w; w.x = cvt_pk_bf16(o[0], o[1]); w.y = cvt_pk_bf16(o[2], o[3]); *(u32x2*)(Y + (size_t)t * D + 512 + ch) = w; } }
                    }
                });
        }
    }
}

__device__ void phase_prep2(const Params& p, int l) {
    float* const ws = (float*)(gfloat_t*)tab_ld(N_IN);
    const float* const pin_I_KN = PIN(I_KN);
    const float* const pin_I_QN = PIN(I_QN);
    const int tid = tid_(), bid = bid_();
    const int lane = tid & 63, gw = bid * (NTHR / 64) + __builtin_amdgcn_readfirstlane(tid >> 6), nw = gridDim.x * (NTHR / 64);
    {
        const int h = lane >> 4, j = lane & 15;
        const f32x4 qw = *(const f32x4*)(pin_I_QN + l * 96 + 4 * j), kw = *(const f32x4*)(pin_I_KN + l * 96 + 4 * j);
        const float qw1 = pin_I_QN[l * 96 + 64 + j], qw2 = pin_I_QN[l * 96 + 80 + j], kw1 = pin_I_KN[l * 96 + 64 + j], kw2 = pin_I_KN[l * 96 + 80 + j];
        for (int t = gw; t < T; t += nw) {
            const bool lat = t < NLAT;
            float cs = 1.f, sn = 0.f;
            if (lat) { cs = ws[W_ROPE + (size_t)t * 32 + j]; sn = ws[W_ROPE + (size_t)t * 32 + 16 + j]; }
            const bf16_t* qr = (const bf16_t*)(ws + W_QUP) + (size_t)t * 384 + h * 96; const bf16_t* kr = (const bf16_t*)(ws + W_KVUP) + (size_t)t * 512 + h * 128; const bf16_t* pr = (const bf16_t*)(ws + W_P) + (size_t)t * INC + OFF_KR;
            f32x4 qn = ld4bf(qr + 4 * j); float q1 = bf2f(qr[64 + j]), q2 = bf2f(qr[80 + j]);
            f32x4 kn = ld4bf(kr + 4 * j); float k1 = bf2f(pr[j]), k2 = bf2f(pr[16 + j]);
            const u32x2 vraw = *(const u32x2*)(kr + 64 + 4 * j);
            float sq = qn[0] * qn[0] + qn[1] * qn[1] + qn[2] * qn[2] + qn[3] * qn[3] + q1 * q1 + q2 * q2;
            float sk = kn[0] * kn[0] + kn[1] * kn[1] + kn[2] * kn[2] + kn[3] * kn[3] + k1 * k1 + k2 * k2;
#pragma unroll
            for (int o = 1; o < 16; o <<= 1) { sq += __shfl_xor(sq, o); sk += __shfl_xor(sk, o); }
            const float rq = rsqrtf(sq * (1.f / 96.f) + EPS), rk = rsqrtf(sk * (1.f / 96.f) + EPS);
            qn = qn * qw * rq; q1 *= qw1 * rq; q2 *= qw2 * rq; kn = kn * kw * rk; k1 *= kw1 * rk; k2 *= kw2 * rk;
            const float qa = q1 * cs - q2 * sn, qb = q1 * sn + q2 * cs, ka = k1 * cs - k2 * sn, kb = k1 * sn + k2 * cs;
            bf16_t* qo = (bf16_t*)(ws + W_Q) + ((size_t)h * T + t) * 96; bf16_t* ko = (bf16_t*)(ws + W_K) + ((size_t)h * T + t) * 96; bf16_t* vo = (bf16_t*)(ws + W_V) + ((size_t)h * T + t) * 64;
            { u32x2 w; w.x = cvt_pk_bf16(qn[0], qn[1]); w.y = cvt_pk_bf16(qn[2], qn[3]); *(u32x2*)(qo + 4 * j) = w; qo[64 + j] = f2bf(qa); qo[80 + j] = f2bf(qb); }
            { u32x2 w; w.x = cvt_pk_bf16(kn[0], kn[1]); w.y = cvt_pk_bf16(kn[2], kn[3]); *(u32x2*)(ko + 4 * j) = w; ko[64 + j] = f2bf(ka); ko[80 + j] = f2bf(kb); }
            *(u32x2*)(vo + 4 * j) = vraw;
        }
    }
    for (int chain = gw; chain < 512; chain += nw) {
        const int d = chain >> 8, ch = chain & 255;
        const float* ag = ws + W_AGG + (size_t)d * 512 + ch;
        float* cr = ws + W_CARRY + (size_t)d * 256 + ch;
        float run = 0.f;
        for (int k0 = 0; k0 < NSUB; k0 += 64) {
            const int k = k0 + lane; const bool valid = k < NSUB;
            const int q = d ? (NSUB - 1 - k) : (k < 4 ? 256 + k : k - 4);
            float a = 1.f, b = 0.f;
            if (valid) { a = ag[(size_t)q * 1024]; b = ag[(size_t)q * 1024 + 256]; }
#pragma unroll
            for (int o = 1; o < 64; o <<= 1) { const float pa = __shfl_up(a, o), pb = __shfl_up(b, o); if (lane >= o) { b = fmaf(a, pb, b); a = a * pa; } }
            float ea = __shfl_up(a, 1), eb = __shfl_up(b, 1); if (lane == 0) { ea = 1.f; eb = 0.f; }
            if (valid) cr[(size_t)q * 512] = fmaf(ea, run, eb);
            const float ta = __shfl(a, 63), tb = __shfl(b, 63);
            run = fmaf(ta, run, tb);
        }
    }
}


__device__ void phase_attn(const Params& p, int l, char* lds) {
    float* const ws = (float*)(gfloat_t*)tab_ld(N_IN);
    const int tid = tid_(), bid = bid_(); (void)tid;
    const bf16_t* Qb = (const bf16_t*)(ws + W_Q); const bf16_t* Kb = (const bf16_t*)(ws + W_K); const bf16_t* Vb = (const bf16_t*)(ws + W_V);
    bf16_t* Y = (bf16_t*)(ws + W_YC);
    const int nunits = (l == 0) ? 260 : 256;
    for (int u = bid; u < nunits; u += gridDim.x) {
        int h, t0, k0, seq;
        if (u < 256) { h = (u & 7) >> 1; t0 = (((u >> 3) << 1) | (u & 1)) * 256; k0 = 0; seq = T; }
        else { h = u - 256; t0 = NLAT; k0 = NLAT; seq = NCTX; }
        att::attn_unit(Qb + ((size_t)h * T + t0) * 96, Kb + ((size_t)h * T + k0) * 96, Vb + ((size_t)h * T + k0) * 64, seq, Y + (size_t)t0 * D + 256 + h * 64, D, lds);
    }
}

__device__ void phase_lru_fin(const Params& p, char* lds) {
    float* const ws = (float*)(gfloat_t*)tab_ld(N_IN);
    const int tid = tid_(), bid = bid_();
    float* carry = (float*)lds;
    for (int sub = bid; sub < NSUB; sub += gridDim.x) {
        carry[tid] = ws[W_CARRY + (size_t)sub * 512 + tid];
        __syncthreads();
        for (int i = tid; i < 64 * 64; i += NTHR) {
            const int t = sub * 64 + (i >> 6), ch = (i & 63) * 4;
            const bf16_t* la = (const bf16_t*)(ws + W_LA2); const bf16_t* lb = (const bf16_t*)(ws + W_LB2);
            f32x4 hs = ld4bf(lb + (size_t)t * 256 + ch) + ld4bf(la + (size_t)t * 256 + ch) * *(const f32x4*)(carry + ch);
            hs = hs + ld4bf(lb + ((size_t)T + t) * 256 + ch) + ld4bf(la + ((size_t)T + t) * 256 + ch) * *(const f32x4*)(carry + 256 + ch);
            const f32x4 g = ld4bf((const bf16_t*)(ws + W_P) + (size_t)t * INC + OFF_DG + ch);
            u32x2 w; w.x = cvt_pk_bf16(gelu_tanh(g[0]) * hs[0], gelu_tanh(g[1]) * hs[1]); w.y = cvt_pk_bf16(gelu_tanh(g[2]) * hs[2], gelu_tanh(g[3]) * hs[3]);
            *(u32x2*)((bf16_t*)(ws + W_YC) + (size_t)t * D + 768 + ch) = w;
        }
        __syncthreads();
    }
}

struct OutprojSched {
    UnitRange ur; const char* A; const char* Bt;
    DEVI bool next(int i, pg8::Unit& u) const {
        const int id = ur.lo + i * ur.step; if (id >= ur.hi) return false;
        const int tm = id >> 2, tn = id & 3;
        u.a = A + (size_t)tm * 256 * D * 2; u.b = Bt + (size_t)tn * 256 * D * 2; u.x0 = tm * 256; u.x1 = tn * 256; u.x2 = 0; u.g = nullptr; u.gn = 0; return true;
    }
};
struct EpiOutproj { static constexpr bool PERM = false; float* X; const float* Xin; const float* modv;
    DEVI void operator()(const f32x4 (&acc)[2][2][4][2], const pg8::Unit& u, int wr, int wc, int fr, int fq) const {
        const float* g1 = modv + (u.x0 >= NLAT ? 6144 : 0) + 2 * D;
#pragma unroll
        for (int ai = 0; ai < 2; ++ai)
#pragma unroll
            for (int m = 0; m < 4; ++m) { const size_t ro = (size_t)(u.x0 + ai * 128 + wr * 64 + m * 16 + fr) * D; float* row = X + ro; const float* rin = Xin + ro;
#pragma unroll
                for (int bj = 0; bj < 2; ++bj)
#pragma unroll
                    for (int n = 0; n < 2; ++n) { const int c = u.x1 + bj * 128 + wc * 32 + n * 16 + 4 * fq; const f32x4 g = *(const f32x4*)(g1 + c); f32x4 x = *(const f32x4*)(rin + c);
                        x = x + g * acc[ai][bj][m][n]; *(f32x4*)(row + c) = x; } }
    }
};
struct CtxSplitSched {
    int first, step; const char* A; const char* Bt;
    DEVI bool next(int i, pg8::Unit& u) const {
        const int id = first + i * step; if (id >= 16) return false;
        const int tn = id >> 2, ks = id & 3;
        u.a = A + (size_t)NLAT * D * 2 + (size_t)ks * 256 * 2; u.b = Bt + (size_t)tn * 256 * D * 2 + (size_t)ks * 256 * 2; u.x0 = ks; u.x1 = tn * 256; u.x2 = 0; u.g = nullptr; u.gn = 0; return true;
    }
};
struct EpiCtxPart { static constexpr bool PERM = false; float* PART; const float* g1;
    DEVI void operator()(const f32x4 (&acc)[2][2][4][2], const pg8::Unit& u, int wr, int wc, int fr, int fq) const {
#pragma unroll
        for (int ai = 0; ai < 2; ++ai)
#pragma unroll
            for (int m = 0; m < 4; ++m) { float* row = PART + ((size_t)u.x0 * NCTX + ai * 128 + wr * 64 + m * 16 + fr) * D;
#pragma unroll
                for (int bj = 0; bj < 2; ++bj)
#pragma unroll
                    for (int n = 0; n < 2; ++n) { const int c = u.x1 + bj * 128 + wc * 32 + n * 16 + 4 * fq; *(f32x4*)(row + c) = *(const f32x4*)(g1 + c) * acc[ai][bj][m][n]; } }
    }
};
__device__ void phase_outproj(const Params& p, int l, char* lds) {
    float* const ws = (float*)(gfloat_t*)tab_ld(N_IN);
    const int tid = tid_(), bid = bid_(); (void)tid;
    OutprojSched S; S.ur = unit_range((NLAT / 256) * 4, bid); S.A = (const char*)(ws + W_YC); S.Bt = (const char*)((const bf16_t*)(ws + W_WOUT) + (size_t)l * D * D);
    EpiOutproj E; E.X = ws + W_X; E.Xin = (l == 0) ? PIN(I_X) : (const float*)(ws + W_X); E.modv = ws + W_MOD + (size_t)l * 2 * 6144;
    pg8::gemm_phase((PG8_LAS unsigned char*)lds, D, (size_t)128 * D * 2, S, E);
    if (l < NLAYER - 1) {
        CtxSplitSched S2; S2.first = bid; S2.step = gridDim.x; S2.A = S.A; S2.Bt = S.Bt;
        EpiCtxPart E2; E2.PART = ws + W_PART; E2.g1 = ws + W_MOD + (size_t)(l * 2 + 1) * 6144 + 2 * D;
        pg8::gemm_phase((PG8_LAS unsigned char*)lds, D, (size_t)128 * D * 2, S2, E2, 4);
    }
}

constexpr int R_LDS = 1024 * 36 * 4;
__device__ void phase_router(const Params& p, int l, char* lds) {
    float* const ws = (float*)(gfloat_t*)tab_ld(N_IN);
    const float* const pin_I_NFFN = PIN(I_NFFN);
    const float* const pin_I_RB = PIN(I_RB);
    const float* const pin_I_RW = PIN(I_RW);
    const int tid = tid_(), bid = bid_();
    float* wl = (float*)lds;
    int* hist = (int*)(lds + R_LDS); int* bbase = hist + 32; int* tinfo = hist + 64 + (tid >> 6) * 40;
    __attribute__((address_space(3))) float* wsc = (__attribute__((address_space(3))) float*)((__attribute__((address_space(3))) char*)g_lds + RSC_OFF) + (tid >> 6) * 96;
    if (tid < 32) hist[tid] = 0;
    {   const float* rw = pin_I_RW + (size_t)l * D * NEXP;
        for (int i = tid; i < 1024 * 8; i += NTHR) { const int k = i >> 3, e4 = i & 7; *(f32x4*)(wl + k * 36 + e4 * 4) = *(const f32x4*)(rw + k * 32 + e4 * 4); }
    }
    __syncthreads();
    const int lane = tid & 63, gw = bid * (NTHR / 64) + __builtin_amdgcn_readfirstlane(tid >> 6), nw = gridDim.x * (NTHR / 64);
    const float* g = pin_I_NFFN + l * D;
    int* cnt = (int*)(ws + W_CNT) + l * NEXP * 64;
    bf16_t* HB = (bf16_t*)(ws + W_HB);
    const int e = lane >> 1;
    const float rb = pin_I_RB[l * NEXP + e];
    const int TL = (l == NLAYER - 1) ? NLAT : T;
    int ti = 0;
    for (int t0 = gw; t0 < TL; t0 += 2 * nw, ti += 2) {
        const int t1 = t0 + nw; const bool v1 = t1 < TL; const int t1c = v1 ? t1 : t0;
        const float* mod = ws + W_MOD + (size_t)(l * 2 + (t0 >= NLAT ? 1 : 0)) * 6144;
        float f0[16], f1[16]; float ss0 = 0.f, ss1 = 0.f;
#pragma unroll
        for (int m = 0; m < 16; ++m) { f0[m] = ws[W_X + (size_t)t0 * D + lane + 64 * m]; f1[m] = ws[W_X + (size_t)t1c * D + lane + 64 * m]; }
        if (t0 >= NLAT) {
#pragma unroll
            for (int m = 0; m < 16; ++m) { const size_t o0 = (size_t)(t0 - NLAT) * D + lane + 64 * m, o1 = (size_t)(t1c - NLAT) * D + lane + 64 * m;
#pragma unroll
                for (int ks = 0; ks < 4; ++ks) { f0[m] += ws[W_PART + (size_t)ks * NCTX * D + o0]; f1[m] += ws[W_PART + (size_t)ks * NCTX * D + o1]; }
                ws[W_X + (size_t)t0 * D + lane + 64 * m] = f0[m]; if (v1) ws[W_X + (size_t)t1 * D + lane + 64 * m] = f1[m]; }
        }
#pragma unroll
        for (int m = 0; m < 16; ++m) { ss0 = fmaf(f0[m], f0[m], ss0); ss1 = fmaf(f1[m], f1[m], ss1); }
#pragma unroll
        for (int o = 32; o > 0; o >>= 1) { ss0 += __shfl_xor(ss0, o); ss1 += __shfl_xor(ss1, o); }
        const float r0 = rsqrtf(ss0 * (1.f / D) + EPS), r1 = rsqrtf(ss1 * (1.f / D) + EPS);
#pragma unroll
        for (int m = 0; m < 16; ++m) { const int k = lane + 64 * m; const float gkm = g[k] * (1.f + mod[4 * D + k]), shm = mod[3 * D + k]; f0[m] = f0[m] * r0 * gkm + shm; f1[m] = f1[m] * r1 * gkm + shm;
            HB[(size_t)t0 * D + k] = f2bf(f0[m]); if (v1) HB[(size_t)t1 * D + k] = f2bf(f1[m]); }
        float acc0[32], acc1[32];
#pragma unroll
        for (int j = 0; j < 32; ++j) { acc0[j] = 0.f; acc1[j] = 0.f; }
#pragma unroll
        for (int m = 0; m < 16; ++m) {
            const float* wr = wl + (lane + 64 * m) * 36;
#pragma unroll
            for (int e4 = 0; e4 < 8; ++e4) { const f32x4 w4 = *(const f32x4*)(wr + e4 * 4);
#pragma unroll
                for (int j = 0; j < 4; ++j) { acc0[e4 * 4 + j] = fmaf(f0[m], w4[j], acc0[e4 * 4 + j]); acc1[e4 * 4 + j] = fmaf(f1[m], w4[j], acc1[e4 * 4 + j]); } }
            __builtin_amdgcn_sched_barrier(0);
        }
#define RS_STEP(W_, MSK_) do { const bool up = (lane & (MSK_)) != 0; \
            _Pragma("unroll") for (int j = 0; j < (W_); ++j) { const float s0_ = up ? acc0[j] : acc0[j + (W_)], k0_ = up ? acc0[j + (W_)] : acc0[j]; acc0[j] = k0_ + __shfl_xor(s0_, (MSK_)); \
                const float s1_ = up ? acc1[j] : acc1[j + (W_)], k1_ = up ? acc1[j + (W_)] : acc1[j]; acc1[j] = k1_ + __shfl_xor(s1_, (MSK_)); } } while (0)
        RS_STEP(16, 32); RS_STEP(8, 16); RS_STEP(4, 8); RS_STEP(2, 4); RS_STEP(1, 2);
#undef RS_STEP
        const float a0 = acc0[0] + __shfl_xor(acc0[0], 1) + rb, a1 = acc1[0] + __shfl_xor(acc1[0], 1) + rb;
        if ((lane & 1) == 0) { wsc[e] = a0; wsc[48 + e] = a1; }
        asm volatile("s_waitcnt lgkmcnt(0)" ::: "memory"); __builtin_amdgcn_wave_barrier();
        int rank0 = 0, rank1 = 0;
#pragma unroll
        for (int q = 0; q < 8; ++q) { const f32x4 x0 = *(const volatile __attribute__((address_space(3))) f32x4*)(wsc + 4 * q), x1 = *(const volatile __attribute__((address_space(3))) f32x4*)(wsc + 48 + 4 * q);
#pragma unroll
            for (int j = 0; j < 4; ++j) { const int eo = 4 * q + j;
                rank0 += (x0[j] > a0 || (x0[j] == a0 && eo < e)) ? 1 : 0; rank1 += (x1[j] > a1 || (x1[j] == a1 && eo < e)) ? 1 : 0; } }
        if ((lane & 1) == 0) {
            if (rank0 < 4) { ((__attribute__((address_space(3))) int*)wsc)[32 + rank0] = e; wsc[36 + rank0] = a0; }
            if (rank1 < 4) { ((__attribute__((address_space(3))) int*)wsc)[80 + rank1] = e; wsc[84 + rank1] = a1; }
        }
        asm volatile("s_waitcnt lgkmcnt(0)" ::: "memory"); __builtin_amdgcn_wave_barrier();
        if (lane < 8 && (lane < 4 || v1)) {
            const int u = lane >> 2, k = lane & 3, tt = u ? t1 : t0;
            const volatile __attribute__((address_space(3))) float* sv = wsc + u * 48;
            const float mx = sv[36];
            const float sm = expf(sv[36] - mx) + expf(sv[37] - mx) + expf(sv[38] - mx) + expf(sv[39] - mx);
            const int ee = ((const volatile __attribute__((address_space(3))) int*)sv)[32 + k]; const float eg = expf(sv[36 + k] - mx);
            const int lidx = atomicAdd(&hist[ee], 1);
            tinfo[(ti + u) * 4 + k] = (ee << 16) | lidx;
            ((int*)(ws + W_TOPE))[tt * 4 + k] = ee;
            ws[W_TOPG + tt * 4 + k] = eg / sm;
        }
        __builtin_amdgcn_wave_barrier();
    }
    __syncthreads();
    if (tid < 32) bbase[tid] = atomicAdd(&cnt[tid * 64], hist[tid]);
    __syncthreads();
    ti = 0;
    for (int t = gw; t < TL; t += nw, ++ti)
        if (lane < 4) { const int v = tinfo[ti * 4 + lane]; const int slot = bbase[v >> 16] + (v & 0xffff);
            ((int*)(ws + W_TOPI))[t * 4 + lane] = slot; ((int*)(ws + W_XS))[(size_t)(v >> 16) * T + slot] = t; }
    __syncthreads();
    conv_moe(p, l, 0);
}

DEVI void moe_bases(const Params& p, int l, int* sb) {
    float* const ws = (float*)(gfloat_t*)tab_ld(N_IN);
    const int tid = tid_();
    if (tid == 0) {
        const int* cnt = (const int*)(ws + W_CNT) + l * NEXP * 64;
        int b = 0, tb = 0;
        for (int e = 0; e < NEXP; ++e) { sb[e] = b; sb[40 + e] = tb; const int c = cnt[e * 64]; sb[80 + e] = c; const int mt = (c + 255) / 256; b += mt * 256; tb += mt; }
        sb[32] = b; sb[72] = tb;
    }
    __syncthreads();
}


struct MoeSched {
    UnitRange ur; const int* sb; int ntn; const char* A; const char* Bt; size_t bstride_e, bstride_tn; const int* lists;
    DEVI bool next(int i, pg8::Unit& u) const {
        const int id = ur.lo + i * ur.step; if (id >= ur.hi) return false;
        int e = 0; while (e < NEXP - 1 && sb[40 + e + 1] * ntn <= id) ++e;
        const int mts = sb[40 + e + 1] - sb[40 + e], loc = id - sb[40 + e] * ntn, tng = loc / (mts * 4), rr = loc % (mts * 4), mt = rr >> 2, tn = tng * 4 + (rr & 3);
        const int r0 = __builtin_amdgcn_readfirstlane(sb[e] + mt * 256), tn_s = __builtin_amdgcn_readfirstlane(tn), e_s = __builtin_amdgcn_readfirstlane(e);
        u.a = A + (size_t)r0 * D * 2; u.b = Bt + (size_t)e_s * bstride_e + (size_t)tn_s * bstride_tn; u.x0 = r0; u.x1 = tn_s; u.x2 = e_s;
        const int mt_s = __builtin_amdgcn_readfirstlane(mt), cnt_s = __builtin_amdgcn_readfirstlane(sb[80 + e]);
        u.g = lists ? lists + (size_t)e_s * T + mt_s * 256 : nullptr; u.gn = cnt_s - mt_s * 256 < 256 ? cnt_s - mt_s * 256 : 256; return true;
    }
};
struct EpiMoe1 { static constexpr bool PERM = true; bf16_t* ACT; const float* bias;
    DEVI void operator()(const f32x4 (&acc)[2][2][4][2], const pg8::Unit& u, int wr, int wc, int fr, int fq) const {
        const int c0 = u.x1 * 128 + wc * 32 + 8 * fq;
        const float* bg = bias + (size_t)u.x2 * 2048 + c0; const float* bu = bg + 1024;
        f32x4 vg[2], vu[2];
#pragma unroll
        for (int n = 0; n < 2; ++n) { vg[n] = *(const f32x4*)(bg + 4 * n); vu[n] = *(const f32x4*)(bu + 4 * n); }
#pragma unroll
        for (int ai = 0; ai < 2; ++ai)
#pragma unroll
            for (int m = 0; m < 4; ++m) { bf16_t* rowp = ACT + (size_t)(u.x0 + ai * 128 + wr * 64 + m * 16 + fr) * D + c0;
                float a[8];
#pragma unroll
                for (int n = 0; n < 2; ++n)
#pragma unroll
                    for (int j = 0; j < 4; ++j) { float g = acc[ai][0][m][n][j] + vg[n][j], uu = acc[ai][1][m][n][j] + vu[n][j];
                        g = fminf(g, 7.f); uu = fminf(fmaxf(uu, -7.f), 7.f); a[n * 4 + j] = (uu + 1.f) * (g * sigm(1.702f * g)); }
                u32x4 w; w.x = cvt_pk_bf16(a[0], a[1]); w.y = cvt_pk_bf16(a[2], a[3]); w.z = cvt_pk_bf16(a[4], a[5]); w.w = cvt_pk_bf16(a[6], a[7]);
                *(u32x4*)rowp = w; }
    }
};
__device__ void phase_moe1(const Params& p, int l, char* lds) {
    float* const ws = (float*)(gfloat_t*)tab_ld(N_IN);
    const float* const pin_I_BGU = PIN(I_BGU);
    const int tid = tid_(), bid = bid_(); (void)tid;
    int* sb = (int*)(lds + pg8::STAGE_BYTES);
    moe_bases(p, l, sb);
    MoeSched S; S.sb = sb; S.ntn = 8; S.ur = unit_range(sb[72] * 8, bid); S.A = (const char*)(ws + W_HB); S.lists = (const int*)(ws + W_XS);
    S.Bt = (const char*)((const bf16_t*)(ws + W_WGU) + (size_t)l * NEXP * 2048 * D); S.bstride_e = (size_t)2048 * D * 2; S.bstride_tn = (size_t)128 * D * 2;
    EpiMoe1 E; E.ACT = (bf16_t*)(ws + W_ACT); E.bias = pin_I_BGU + (size_t)l * NEXP * 2048;
    pg8::gemm_phase<EpiMoe1, MoeSched, true>((PG8_LAS unsigned char*)lds, D, (size_t)1024 * D * 2, S, E, 0, (const char*)(ws + W_HB));
    __syncthreads();
}

struct EpiMoe2 { static constexpr bool PERM = true; bf16_t* YR; const float* bias;
    DEVI void operator()(const f32x4 (&acc)[2][2][4][2], const pg8::Unit& u, int wr, int wc, int fr, int fq) const {
        const int c0 = u.x1 * 256 + wc * 32 + 8 * fq;
        const float* bb = bias + (size_t)u.x2 * D + c0;
        f32x4 bv[2][2];
#pragma unroll
        for (int bj = 0; bj < 2; ++bj)
#pragma unroll
            for (int n = 0; n < 2; ++n) bv[bj][n] = *(const f32x4*)(bb + bj * 128 + 4 * n);
#pragma unroll
        for (int ai = 0; ai < 2; ++ai)
#pragma unroll
            for (int m = 0; m < 4; ++m) { bf16_t* rowp = YR + (size_t)(u.x0 + ai * 128 + wr * 64 + m * 16 + fr) * D + c0;
#pragma unroll
                for (int bj = 0; bj < 2; ++bj) { const f32x4 v0 = acc[ai][bj][m][0] + bv[bj][0], v1 = acc[ai][bj][m][1] + bv[bj][1];
                    u32x4 w; w.x = cvt_pk_bf16(v0[0], v0[1]); w.y = cvt_pk_bf16(v0[2], v0[3]); w.z = cvt_pk_bf16(v1[0], v1[1]); w.w = cvt_pk_bf16(v1[2], v1[3]);
                    *(u32x4*)(rowp + bj * 128) = w; } }
    }
};
__device__ void phase_moe2(const Params& p, int l, char* lds) {
    float* const ws = (float*)(gfloat_t*)tab_ld(N_IN);
    const float* const pin_I_BDN = PIN(I_BDN);
    const int tid = tid_(), bid = bid_(); (void)tid;
    int* sb = (int*)(lds + pg8::STAGE_BYTES);
    moe_bases(p, l, sb);
    MoeSched S; S.sb = sb; S.ntn = 4; S.ur = unit_range(sb[72] * 4, bid); S.A = (const char*)(ws + W_ACT); S.lists = nullptr;
    S.Bt = (const char*)((const bf16_t*)(ws + W_WDN) + (size_t)l * NEXP * D * D); S.bstride_e = (size_t)D * D * 2; S.bstride_tn = (size_t)256 * D * 2;
    EpiMoe2 E; E.YR = (bf16_t*)(ws + W_YR); E.bias = pin_I_BDN + (size_t)l * NEXP * D;
    pg8::gemm_phase((PG8_LAS unsigned char*)lds, D, (size_t)128 * D * 2, S, E);
    __syncthreads();
}

DEVI void norm1_store8(float* ws, const float* g, int l, int t, int lane, const float (&v)[2][8]) {
    const float* mod = ws + W_MOD + (size_t)(l * 2 + (t >= NLAT ? 1 : 0)) * 6144;
    float ss = 0.f;
#pragma unroll
    for (int jj = 0; jj < 2; ++jj)
#pragma unroll
        for (int i = 0; i < 8; ++i) ss = fmaf(v[jj][i], v[jj][i], ss);
    const float rstd = rsqrtf(wave_sum(ss) * (1.f / D) + EPS);
    bf16_t* hb = (bf16_t*)(ws + W_HB) + (size_t)t * D;
#pragma unroll
    for (int jj = 0; jj < 2; ++jj) {
        const int c = jj * 512 + lane * 8;
        float o[8];
#pragma unroll
        for (int q = 0; q < 2; ++q) { const f32x4 gg = *(const f32x4*)(g + c + 4 * q), s1 = *(const f32x4*)(mod + D + c + 4 * q), s0 = *(const f32x4*)(mod + c + 4 * q);
#pragma unroll
            for (int i = 0; i < 4; ++i) o[4 * q + i] = v[jj][4 * q + i] * rstd * gg[i] * (1.f + s1[i]) + s0[i]; }
        u32x4 w; w.x = cvt_pk_bf16(o[0], o[1]); w.y = cvt_pk_bf16(o[2], o[3]); w.z = cvt_pk_bf16(o[4], o[5]); w.w = cvt_pk_bf16(o[6], o[7]);
        *(u32x4*)(hb + c) = w;
    }
}
__device__ void phase_combine(const Params& p, int l, char* lds, bool last) {
    float* const ws = (float*)(gfloat_t*)tab_ld(N_IN);
    float* const pout = (float*)(gfloat_t*)tab_ld(N_IN + 1);
    const float* const pin_I_NMIX = PIN(I_NMIX);
    const int tid = tid_(), bid = bid_();
    const bf16_t* YR = (const bf16_t*)(ws + W_YR);
    int* sb = (int*)(lds + G_LDS);
    moe_bases(p, l, sb);
    const int lane = tid & 63, gw = bid * (NTHR / 64) + __builtin_amdgcn_readfirstlane(tid >> 6), nw = gridDim.x * (NTHR / 64);
    const int TL = last ? NLAT : T;
    const float* gn = pin_I_NMIX + (last ? 0 : (l + 1) * D);
    for (int t0 = gw; t0 < TL; t0 += 2 * nw) {
        const int t1 = t0 + nw; const bool v1 = t1 < TL; const int t1c = v1 ? t1 : t0;
        const float* g2 = ws + W_MOD + (size_t)(l * 2 + (t0 >= NLAT ? 1 : 0)) * 6144 + 5 * D;
        const bf16_t* ya[4]; const bf16_t* yb[4]; float ga[4], gb[4];
#pragma unroll
        for (int k = 0; k < 4; ++k) { ya[k] = YR + (size_t)(sb[((const int*)(ws + W_TOPE))[t0 * 4 + k]] + ((const int*)(ws + W_TOPI))[t0 * 4 + k]) * D; ga[k] = ws[W_TOPG + t0 * 4 + k];
                                      yb[k] = YR + (size_t)(sb[((const int*)(ws + W_TOPE))[t1c * 4 + k]] + ((const int*)(ws + W_TOPI))[t1c * 4 + k]) * D; gb[k] = ws[W_TOPG + t1c * 4 + k]; }
        float* xa = ws + W_X + (size_t)t0 * D; float* xb = ws + W_X + (size_t)t1c * D;
        float ra[2][8], rb[2][8];
#pragma unroll
        for (int jj = 0; jj < 2; ++jj) {
            const int c = jj * 512 + lane * 8;
            u32x4 ua[4], ub[4];
#pragma unroll
            for (int k = 0; k < 4; ++k) { ua[k] = *(const u32x4*)(ya[k] + c); ub[k] = *(const u32x4*)(yb[k] + c); }
            const f32x4 xa0 = *(const f32x4*)(xa + c), xa1 = *(const f32x4*)(xa + c + 4), xb0 = *(const f32x4*)(xb + c), xb1 = *(const f32x4*)(xb + c + 4);
            const f32x4 gg0 = *(const f32x4*)(g2 + c), gg1 = *(const f32x4*)(g2 + c + 4);
            float a[8], b[8];
#pragma unroll
            for (int i = 0; i < 8; ++i) { a[i] = 0.f; b[i] = 0.f; }
#pragma unroll
            for (int k = 0; k < 4; ++k)
#pragma unroll
                for (int q = 0; q < 4; ++q) { const unsigned wa = ua[k][q], wb = ub[k][q];
                    a[2 * q] = fmaf(ga[k], __uint_as_float(wa << 16), a[2 * q]); a[2 * q + 1] = fmaf(ga[k], __uint_as_float(wa & 0xffff0000u), a[2 * q + 1]);
                    b[2 * q] = fmaf(gb[k], __uint_as_float(wb << 16), b[2 * q]); b[2 * q + 1] = fmaf(gb[k], __uint_as_float(wb & 0xffff0000u), b[2 * q + 1]); }
#pragma unroll
            for (int i = 0; i < 4; ++i) { ra[jj][i] = fmaf(gg0[i], a[i], xa0[i]); ra[jj][4 + i] = fmaf(gg1[i], a[4 + i], xa1[i]); rb[jj][i] = fmaf(gg0[i], b[i], xb0[i]); rb[jj][4 + i] = fmaf(gg1[i], b[4 + i], xb1[i]); }
            float* da = last ? pout + (size_t)t0 * D + c : xa + c; float* db = last ? pout + (size_t)t1c * D + c : xb + c;
            *(f32x4*)da = (f32x4){ra[jj][0], ra[jj][1], ra[jj][2], ra[jj][3]}; *(f32x4*)(da + 4) = (f32x4){ra[jj][4], ra[jj][5], ra[jj][6], ra[jj][7]};
            if (v1) { *(f32x4*)db = (f32x4){rb[jj][0], rb[jj][1], rb[jj][2], rb[jj][3]}; *(f32x4*)(db + 4) = (f32x4){rb[jj][4], rb[jj][5], rb[jj][6], rb[jj][7]}; }
        }
        if (!last) { norm1_store8(ws, gn, l + 1, t0, lane, ra); if (v1) norm1_store8(ws, gn, l + 1, t1, lane, rb); }
    }
}

constexpr int XST_OFF = R_LDS + 2048 - 16, STAMP_OFF = R_LDS + 2048 - 16 - 256;
constexpr int LDS_BYTES = RSC_OFF + 8 * 96 * 4;

#define XB_TMO      128
#define XB_XCNT(j)  (256  + 64 * (j))
#define XB_XSUB(j)  (1280 + 64 * (j))
#define XB_XGEN(j)  (2304 + 64 * (j))
#define XB_TOP      3328
#define XB_TOPGEN   3392
#define XCD_BAR_WORDS 3456
#define XB_SPIN_CAP (1u << 18)
#define LAS __attribute__((address_space(3)))
__device__ __forceinline__ unsigned xb_ld(unsigned* p)              { return __hip_atomic_load(p, __ATOMIC_RELAXED, __HIP_MEMORY_SCOPE_AGENT); }
__device__ __forceinline__ unsigned xb_add(unsigned* p, unsigned v) { return __hip_atomic_fetch_add(p, v, __ATOMIC_RELAXED, __HIP_MEMORY_SCOPE_AGENT); }
__device__ __forceinline__ unsigned xb_xcc_id() { return (unsigned)__builtin_amdgcn_s_getreg((3 << 11) | 20) & 0xFu; }
#define XB_SPIN(cond, bar) do { unsigned _sp = 0; while (cond) { __builtin_amdgcn_s_sleep(1); \
    if ((++_sp & 255u) == 0u) { if (xb_ld(&(bar)[XB_TMO])) break; if (_sp > XB_SPIN_CAP) { atomicAdd(&(bar)[XB_TMO], 1u); break; } } } } while (0)
struct XcdBarrier { unsigned* bar; unsigned x; volatile LAS unsigned* st; };
__device__ __forceinline__ XcdBarrier xcd_barrier_post(unsigned* bar, volatile LAS unsigned* st) {
    XcdBarrier b; b.bar = bar; b.x = xb_xcc_id(); b.st = st;
    if (threadIdx.x == 0) (void)xb_add(&bar[XB_XCNT(b.x)], 1u);
    return b;
}
__device__ __forceinline__ void xcd_barrier_complete(unsigned* bar, unsigned x, unsigned& nloc, unsigned& nx) {
    const unsigned G = gridDim.x * gridDim.y * gridDim.z;
    unsigned sum, cnt, mine, sp = 0u;
    for (;;) {
        sum = 0u; cnt = 0u; mine = 0u;
#pragma unroll
        for (unsigned j = 0; j < 16; ++j) { const unsigned c = xb_ld(&bar[XB_XCNT(j)]); sum += c; cnt += (c > 0u) ? 1u : 0u; mine = (j == x) ? c : mine; }
        if (sum == G) break;
        __builtin_amdgcn_s_sleep(1);
        if ((++sp & 255u) == 0u) { if (xb_ld(&bar[XB_TMO])) break; if (sp > XB_SPIN_CAP) { atomicAdd(&bar[XB_TMO], 1u); break; } }
    }
    nloc = mine > 0u ? mine : 1u; nx = cnt > 0u ? cnt : 1u;
}
__device__ __noinline__ void xcd_barrier(const XcdBarrier b, const int tid) {
    asm volatile("s_waitcnt vmcnt(0)" ::: "memory");
    __syncthreads();
    if (tid == 0) {
        unsigned* bar = b.bar;
        __builtin_amdgcn_s_waitcnt(0);
        unsigned nloc = b.st[0], nx = b.st[1];
        if (nloc == 0u) { xcd_barrier_complete(bar, b.x, nloc, nx); b.st[0] = nloc; b.st[1] = nx; }
        const unsigned old = xb_add(&bar[XB_XSUB(b.x)], 1u);
        const unsigned gen = old / nloc;
        if (old + 1u == (gen + 1u) * nloc) {
            __builtin_amdgcn_fence(__ATOMIC_RELEASE, "agent");
            asm volatile("s_waitcnt vmcnt(0)" ::: "memory");
            const unsigned og = xb_add(&bar[XB_TOP], 1u);
            const unsigned tg = og / nx;
            if (og + 1u == (tg + 1u) * nx) xb_add(&bar[XB_TOPGEN], 1u);
            else XB_SPIN(xb_ld(&bar[XB_TOPGEN]) == tg, bar);
            __builtin_amdgcn_fence(__ATOMIC_ACQUIRE, "agent");
            xb_add(&bar[XB_XGEN(b.x)], 1u);
            asm volatile("s_waitcnt vmcnt(0)" ::: "memory");
        } else {
            XB_SPIN(xb_ld(&bar[XB_XGEN(b.x)]) == gen, bar);
            __builtin_amdgcn_fence(__ATOMIC_ACQUIRE, "agent");
            asm volatile("s_waitcnt vmcnt(0)" ::: "memory");
        }
    }
    __syncthreads();
}

constexpr int PROBE_IDX = -1, PROBE_END = -1, PROBE_DIV = 10;
constexpr int REP_NORM = 1, REP_INPROJ = 1, REP_PREP1 = 1, REP_SMALL = 1, REP_ATTN = 1, REP_FIN = 1, REP_MOE1 = 1, REP_MOE2 = 1, REP_SYNC = 1, REP_CONV = 1;
__global__ void __launch_bounds__(NTHR) fwd_kernel(Params p) {
    cg::grid_group grid = cg::this_grid();
    char* lds = g_lds;
    float* smem = (float*)lds;
    if (threadIdx.x == 0) {
        unsigned long long* tab = (unsigned long long*)(lds + TAB_OFF);
#pragma unroll
        for (int i = 0; i < N_IN; ++i) tab[i] = (unsigned long long)p.in[i];
        tab[N_IN] = (unsigned long long)p.ws; tab[N_IN + 1] = (unsigned long long)p.out;
    }
    __syncthreads();
    volatile LAS unsigned* xst = (volatile LAS unsigned*)(lds + XST_OFF);
    if (threadIdx.x < 4) xst[threadIdx.x] = 0u;
    if (blockIdx.x == 0) for (int i = threadIdx.x; i < 4096; i += NTHR) ((unsigned*)(p.ws + W_BAR))[i] = 0u;
    for (int r = 0; r < REP_CONV; ++r) phase_convert(p);
    phase_tables(p);
    phase_mod(p, smem);
    grid.sync();
    XcdBarrier xbar = xcd_barrier_post((unsigned*)(p.ws + W_BAR), xst);
    unsigned long long* stamps = (unsigned long long*)(lds + STAMP_OFF); int nstamp = 0;
#define GSYNC() do { for (int r_ = 0; r_ < REP_SYNC; ++r_) { XcdBarrier b_ = xbar; unsigned long long bp_ = (unsigned long long)b_.bar; unsigned bx_ = b_.x; asm volatile("" : "+s"(bp_), "+s"(bx_)); b_.bar = (unsigned*)bp_; b_.x = bx_; xcd_barrier(b_, (int)threadIdx.x); } if (PROBE_IDX >= 0) { if (blockIdx.x == 0 && threadIdx.x == 0) stamps[nstamp] = __builtin_amdgcn_s_memrealtime(); ++nstamp; } } while (0)
    phase_init(p);
    GSYNC();
    for (int lv = 0; lv < NLAYER; ++lv) {
        int l = lv; asm volatile("" : "+s"(l));
        for (int r = 0; r < REP_INPROJ; ++r) phase_inproj(p, l, lds);
        GSYNC();
        for (int r = 0; r < REP_PREP1; ++r) phase_prep1(p, l);
        GSYNC();
        for (int r = 0; r < REP_SMALL; ++r) phase_small(p, l, lds);
        GSYNC();
        phase_prep2(p, l);
        GSYNC();
        for (int r = 0; r < REP_ATTN; ++r) phase_attn(p, l, lds);
        for (int r = 0; r < REP_FIN; ++r) phase_lru_fin(p, lds);
        GSYNC();
        phase_outproj(p, l, lds);
        GSYNC();
        phase_router(p, l, lds);
        GSYNC();
        for (int r = 0; r < REP_MOE1; ++r) phase_moe1(p, l, lds);
        GSYNC();
        for (int r = 0; r < REP_MOE2; ++r) phase_moe2(p, l, lds);
        GSYNC();
        phase_combine(p, l, lds, l == NLAYER - 1);
        if (l + 1 < NLAYER || PROBE_IDX >= 0) GSYNC();
    }
    if (PROBE_IDX >= 0 && blockIdx.x == 0 && threadIdx.x == 0) {
        const float us = (float)(stamps[PROBE_END < 0 ? PROBE_IDX + 1 : PROBE_END] - stamps[PROBE_IDX]) * 0.01f;
        ((float*)(gfloat_t*)tab_ld(N_IN + 1))[0] += 2.f + us / (float)PROBE_DIV;
    }
}

extern "C" void kernel_launch(void* const* d_in, const int* in_sizes, int n_in, void* d_out, int out_size, void* d_ws, size_t ws_size, hipStream_t stream) {
    static int grid_blocks = 0;
    if (!grid_blocks) {
        int dev = 0, cus = 0, per_cu = 0;
        (void)hipGetDevice(&dev);
        (void)hipDeviceGetAttribute(&cus, hipDeviceAttributeMultiprocessorCount, dev);
        if (hipFuncSetAttribute((const void*)fwd_kernel, hipFuncAttributeMaxDynamicSharedMemorySize, LDS_BYTES) != hipSuccess) fprintf(stderr, "kernel_launch: hipFuncSetAttribute failed\n");
        if (hipOccupancyMaxActiveBlocksPerMultiprocessor(&per_cu, fwd_kernel, NTHR, LDS_BYTES) != hipSuccess || per_cu < 1) { fprintf(stderr, "kernel_launch: occupancy query says %d\n", per_cu); per_cu = 1; }
        if (per_cu > 1) per_cu = 1;
        grid_blocks = cus * per_cu;
        if (ws_size < W_END * sizeof(float)) fprintf(stderr, "kernel_launch: workspace too small: %zu < %zu\n", ws_size, W_END * sizeof(float));
        if (n_in != N_IN) fprintf(stderr, "kernel_launch: n_in %d != %d\n", n_in, (int)N_IN);
    }
    Params p{};
    for (int i = 0; i < N_IN; ++i) p.in[i] = (const float*)d_in[i];
    p.out = (float*)d_out;
    p.ws = (float*)d_ws;
    void* args[] = {&p};
    hipError_t e = hipLaunchCooperativeKernel((void*)fwd_kernel, dim3(grid_blocks), dim3(NTHR), args, LDS_BYTES, stream);
    if (e != hipSuccess) fprintf(stderr, "cooperative launch failed: %s (grid %d)\n", hipGetErrorString(e), grid_blocks);
}
```

```cpp
#include <hip/hip_runtime.h>
#include <hip/hip_cooperative_groups.h>
#include <cstdio>
#include <cstdint>
namespace cg = cooperative_groups;

#define DEVI __device__ __forceinline__
constexpr int NTHR = 512;
constexpr int D = 1024, NLAT = 16384, NCTX = 256, T = NLAT + NCTX, NLAYER = 2;
constexpr int INC = 1632;
constexpr int OFF_A = 0, OFF_Q = 256, OFF_KV = 448, OFF_KR = 576, OFF_C = 608, OFF_DX = 1120, OFF_DG = 1376;
constexpr int NCHUNK = T / 128;
constexpr int NEXP = 32, TOPK = 4;
constexpr int MAXROWS = T * TOPK + NEXP * 256;
constexpr float EPS = 1e-6f;

enum { I_X = 0, I_C, I_CTX, I_CCTX, I_WMOD, I_BMOD, I_NMIX, I_NFFN, I_WIN, I_WOUT, I_POOLW, I_POOLS, I_QAN, I_WUQ, I_KVAN, I_WUKV,
       I_QN, I_KN, I_SGG, I_SGB, I_SGWS, I_SGBS, I_CONVW, I_CONVB, I_WA, I_BA, I_WX, I_BX, I_LAM, I_RW, I_RB, I_WGU, I_BGU, I_WDN, I_BDN, N_IN };

constexpr size_t al(size_t x) { return (x + 63) / 64 * 64; }
constexpr size_t W_X = 0;
constexpr size_t W_MOD = W_X + al((size_t)T * D);
constexpr size_t W_P = W_MOD + al(2 * 2 * 6144);
constexpr size_t W_YC = W_P + al((size_t)T * INC);
constexpr size_t W_Q = W_YC + al((size_t)T * D);
constexpr size_t W_K = W_Q + al((size_t)T * 384);
constexpr size_t W_V = W_K + al((size_t)T * 384);
constexpr size_t W_DIFF = W_V + al((size_t)T * 256);
constexpr size_t W_QN = W_DIFF + al((size_t)T * 256);
constexpr size_t W_KVN = W_QN + al((size_t)T * 192);
constexpr size_t W_U = W_KVN + al((size_t)T * 128);
constexpr size_t W_VN = W_U + al((size_t)T * 256);
constexpr size_t W_XC = W_VN + al((size_t)T * 256);
constexpr size_t W_QUP = W_XC + al((size_t)T * 256);
constexpr size_t W_KVUP = W_QUP + al((size_t)T * 384);
constexpr size_t W_LA = W_KVUP + al((size_t)T * 512);
constexpr size_t W_LB = W_LA + al((size_t)2 * T * 256);
constexpr size_t W_AGG = W_LB + al((size_t)2 * T * 256);
constexpr int NSUB = T / 64;
constexpr size_t W_CARRY = W_AGG + al((size_t)NSUB * 2 * 2 * 256);
constexpr size_t W_TOPE = W_CARRY + al((size_t)NSUB * 2 * 256);
constexpr size_t W_TOPG = W_TOPE + al((size_t)T * 4);
constexpr size_t W_TOPI = W_TOPG + al((size_t)T * 4);
constexpr size_t W_CNT = W_TOPI + al((size_t)T * 4);
constexpr size_t W_ACT = W_CNT + al(NLAYER * NEXP * 64);
constexpr size_t W_YR = W_ACT + al((size_t)MAXROWS * D / 2);
constexpr size_t W_XS = W_YR + al((size_t)MAXROWS * D / 2);
constexpr size_t W_HB = W_XS + al((size_t)MAXROWS * D / 2);
constexpr size_t W_XCB = W_HB + al((size_t)T * D / 2);
constexpr size_t W_WSB = W_XCB + al((size_t)T * 256 / 2);
constexpr size_t W_BAR = W_WSB + al((size_t)NLAYER * 4 * 128 * 128 / 2);
constexpr size_t W_ROPE = W_BAR + al(4096);
constexpr size_t W_LA2 = W_ROPE + al((size_t)NLAT * 32);
constexpr size_t W_LB2 = W_LA2 + al((size_t)2 * T * 256);
constexpr size_t W_SP = W_LB2 + al((size_t)2 * T * 256);
constexpr size_t W_PART = W_SP + al(NLAYER * 2 * 256);
constexpr int NPAD_IN = 1792;
constexpr size_t W_WIN = W_PART + al((size_t)4 * NCTX * D);
constexpr size_t W_WOUT = W_WIN + al((size_t)NLAYER * NPAD_IN * D / 2);
constexpr size_t W_WGU = W_WOUT + al((size_t)NLAYER * D * D / 2);
constexpr size_t W_WDN = W_WGU + al((size_t)NLAYER * NEXP * 2048 * D / 2);
constexpr size_t W_END = W_WDN + al((size_t)NLAYER * NEXP * D * D / 2);

struct Params {
    const float* in[N_IN];
    float* out;
    float* ws;
};

DEVI int tid_() { int t = threadIdx.x; asm volatile("" : "+v"(t)); return t; }
DEVI float* ws_(float* w) { unsigned long long v = (unsigned long long)w; asm volatile("" : "+s"(v)); return (float*)v; }
extern __shared__ __attribute__((aligned(16))) char g_lds[];
constexpr int RSC_OFF = 149504 + 512;
constexpr int TAB_OFF = 149504;
DEVI unsigned long long tab_ld(int i) { const unsigned long long v = ((const volatile unsigned long long*)(g_lds + TAB_OFF))[i];
    return ((unsigned long long)(unsigned)__builtin_amdgcn_readfirstlane((int)(v >> 32)) << 32) | (unsigned)__builtin_amdgcn_readfirstlane((int)v); }
typedef __attribute__((address_space(1))) float gfloat_t;
#define PIN(i) ((const float*)(const gfloat_t*)tab_ld(i))
DEVI int bid_() { int b = blockIdx.x; asm volatile("" : "+s"(b)); return b; }
DEVI float wave_sum(float v) {
#pragma unroll
    for (int o = 32; o > 0; o >>= 1) v += __shfl_xor(v, o);
    return v;
}
DEVI float fexp(float x) { return __builtin_amdgcn_exp2f(x * 1.4426950408889634f); }
DEVI float gelu_tanh(float x) { const float u = 1.5957691216057308f * (x + 0.044715f * x * x * x); return x * __builtin_amdgcn_rcpf(1.f + fexp(-u)); }
DEVI float sigm(float x) { return 1.f / (1.f + expf(-x)); }
DEVI float silu(float x) { return x * sigm(x); }
DEVI float fsigm(float x) { return __builtin_amdgcn_rcpf(1.f + fexp(-x)); }


typedef unsigned short bf16_t;
typedef short bf16x8 __attribute__((ext_vector_type(8)));
typedef float f32x4 __attribute__((ext_vector_type(4)));
typedef unsigned u32x4 __attribute__((ext_vector_type(4)));
typedef unsigned u32x2 __attribute__((ext_vector_type(2)));
DEVI unsigned cvt_pk_bf16(float lo, float hi) { unsigned r; asm volatile("v_cvt_pk_bf16_f32 %0, %1, %2" : "=v"(r) : "v"(lo), "v"(hi)); return r; }
constexpr float W8_SCALE = 64.f, A8_SCALE = 4.f, INV8 = 1.f / (W8_SCALE * A8_SCALE);
DEVI unsigned pk_fp8x4(float a, float b, float c, float d) { int v = __builtin_amdgcn_cvt_pk_fp8_f32(a, b, 0, false); v = __builtin_amdgcn_cvt_pk_fp8_f32(c, d, v, true); return (unsigned)v; }
DEVI bf16_t f2bf(float f) { return (bf16_t)(cvt_pk_bf16(f, 0.f) & 0xffffu); }
DEVI f32x4 ld4bf(const bf16_t* p) { const u32x2 w = *(const u32x2*)p; return (f32x4){__uint_as_float(w.x << 16), __uint_as_float(w.x & 0xffff0000u), __uint_as_float(w.y << 16), __uint_as_float(w.y & 0xffff0000u)}; }
typedef int i32x8 __attribute__((ext_vector_type(8)));
typedef int i32x4 __attribute__((ext_vector_type(4)));
DEVI float bf2f(bf16_t b) { return __uint_as_float(((unsigned)b) << 16); }

constexpr int G_STAGE = 49152;
constexpr int G_LDS = 2 * G_STAGE;
DEVI int swz(int row, int chunk) { return row * 128 + ((chunk ^ ((row >> 1) & 7)) << 4); }

template <bool PAIRED, class ARow, class Epi>
DEVI void gemm_unit(char* lds, int K, ARow arow, const float* __restrict__ B0, const float* __restrict__ B1, int ldb, int ncol_valid, Epi epi) {
    const int tid = tid_(), wave = tid >> 6, lane = tid & 63, fr = lane & 15, fq = lane >> 4, wr = wave >> 1, wc = wave & 1;
    const int ac = tid & 7;
    const bf16_t* ap[4]; int a_lds[4];
#pragma unroll
    for (int i = 0; i < 4; ++i) { const int r = (tid >> 3) + 64 * i; ap[i] = arow(r) + ac * 8; a_lds[i] = swz(r, ac); }
    const int kq = lane & 15, nq = (lane >> 4) + 4 * wave;
    const float* bp;
    if (PAIRED) { const int seg = (nq >> 2) & 1, idx = (nq >> 3) * 16 + (nq & 3) * 4; bp = (seg ? B1 : B0) + idx; }
    else { const int c4 = 4 * nq < ncol_valid ? 4 * nq : ncol_valid - 4; bp = B0 + c4; }
    bp += (size_t)(4 * kq) * ldb;
    int b_lds[4];
#pragma unroll
    for (int i = 0; i < 4; ++i) b_lds[i] = 32768 + swz(4 * nq + i, kq >> 1) + (kq & 1) * 8;
    const int sx = (fr >> 1) & 7;
    const int aoff0 = (wr * 64 + fr) * 128 + ((fq ^ sx) << 4), aoff1 = (wr * 64 + fr) * 128 + (((4 + fq) ^ sx) << 4);
    const int boff0 = 32768 + (wc * 64 + fr) * 128 + ((fq ^ sx) << 4), boff1 = 32768 + (wc * 64 + fr) * 128 + (((4 + fq) ^ sx) << 4);
    u32x4 av0[4], av1[4]; f32x4 bv0[4], bv1[4];
#define G_LOAD(av, bv, t) do { _Pragma("unroll") for (int i = 0; i < 4; ++i) av[i] = *(const u32x4*)(ap[i] + (t) * 64); \
        _Pragma("unroll") for (int kk = 0; kk < 4; ++kk) bv[kk] = *(const f32x4*)(bp + ((size_t)(t) * 64 + kk) * ldb); } while (0)
#define G_WRITE(s_, av, bv) do { _Pragma("unroll") for (int i = 0; i < 4; ++i) *(u32x4*)((s_) + a_lds[i]) = av[i]; \
        _Pragma("unroll") for (int i = 0; i < 4; ++i) { u32x2 w_; w_.x = cvt_pk_bf16(bv[0][i], bv[1][i]); w_.y = cvt_pk_bf16(bv[2][i], bv[3][i]); *(u32x2*)((s_) + b_lds[i]) = w_; } } while (0)
#define G_MMA(Af, Bf) do { __builtin_amdgcn_s_setprio(1); _Pragma("unroll") for (int m = 0; m < 4; ++m) _Pragma("unroll") for (int n = 0; n < 4; ++n) \
        acc[m][n] = __builtin_amdgcn_mfma_f32_16x16x32_bf16(Bf[n], Af[m], acc[m][n], 0, 0, 0); __builtin_amdgcn_s_setprio(0); } while (0)
#define G_SB() __builtin_amdgcn_sched_barrier(0)
#define G_ITER(t, c_, n_, av, bv, W_, L_) do { \
        bf16x8 Af[4], Bf[4]; \
        _Pragma("unroll") for (int m = 0; m < 4; ++m) Af[m] = *(const bf16x8*)((c_) + aoff0 + m * 2048); \
        _Pragma("unroll") for (int n = 0; n < 4; ++n) Bf[n] = *(const bf16x8*)((c_) + boff0 + n * 2048); \
        G_SB(); asm volatile("s_waitcnt lgkmcnt(0)" ::: "memory"); G_SB(); \
        G_MMA(Af, Bf); G_SB(); \
        _Pragma("unroll") for (int m = 0; m < 4; ++m) Af[m] = *(const bf16x8*)((c_) + aoff1 + m * 2048); \
        _Pragma("unroll") for (int n = 0; n < 4; ++n) Bf[n] = *(const bf16x8*)((c_) + boff1 + n * 2048); \
        G_SB(); \
        if (W_) { G_WRITE(n_, av, bv); G_SB(); asm volatile("s_waitcnt lgkmcnt(8)" ::: "memory"); } else { asm volatile("s_waitcnt lgkmcnt(0)" ::: "memory"); } \
        G_SB(); \
        G_MMA(Af, Bf); G_SB(); \
        if (L_) G_LOAD(av, bv, (t) + 3); \
        G_SB(); asm volatile("s_waitcnt lgkmcnt(0)" ::: "memory"); __builtin_amdgcn_s_barrier(); G_SB(); } while (0)
    f32x4 acc[4][4];
#pragma unroll
    for (int m = 0; m < 4; ++m)
#pragma unroll
        for (int n = 0; n < 4; ++n) acc[m][n] = (f32x4){0.f, 0.f, 0.f, 0.f};
    const int nk = K >> 6;
    char* L0 = lds; char* L1 = lds + G_STAGE;
    G_LOAD(av0, bv0, 0);
    G_WRITE(L0, av0, bv0);
    if (nk > 1) G_LOAD(av1, bv1, 1);
    if (nk > 2) G_LOAD(av0, bv0, 2);
    asm volatile("s_waitcnt lgkmcnt(0)" ::: "memory"); __builtin_amdgcn_s_barrier(); G_SB();
    int t = 0;
    for (; t + 4 < nk; t += 2) {
        G_ITER(t, L0, L1, av1, bv1, true, true);
        G_ITER(t + 1, L1, L0, av0, bv0, true, true);
    }
    for (; t < nk; t += 2) {
        G_ITER(t, L0, L1, av1, bv1, t + 1 < nk, t + 3 < nk);
        if (t + 1 < nk) G_ITER(t + 1, L1, L0, av0, bv0, t + 2 < nk, t + 4 < nk);
    }
#undef G_LOAD
#undef G_WRITE
#undef G_MMA
#undef G_ITER
#undef G_SB
    { int fr_ = fr, fq_ = fq; asm volatile("" : "+v"(fr_), "+v"(fq_)); epi(acc, wr, wc, fr_, fq_); }
}


#define PG8_LAS __attribute__((address_space(3)))
namespace pg8 {
constexpr int BM = 256, BK = 64, HALF = 128, HTB = HALF * BK * 2, STAGE_BYTES = 8 * HTB;
DEVI int lds_byte(int r, int c) { const int st = (r >> 4) * 2 + (c >> 5), rr = r & 15, cc = c & 31, ob = rr * 64 + cc * 2; return st * 1024 + (ob ^ (((ob >> 9) & 1) << 5)); }
DEVI void stage_rc(int b, int& R, int& C) { const int st = b / 1024, sb = b % 1024, swz_ = sb ^ (((sb >> 9) & 1) << 5); R = (st >> 1) * 16 + swz_ / 64; C = (st & 1) * 32 + (swz_ % 64) / 2; }
DEVI int perm32(int rho) { const int n = rho >> 4, i = rho & 15; return 8 * (i >> 2) + 4 * n + (i & 3); }
struct Unit { const char* a; const char* b; int x0, x1, x2; const int* g; int gn; };
template <class Epi, class Sched, bool GATHER = false, bool F8 = false>
DEVI void gemm_phase(PG8_LAS unsigned char* lds, int K, size_t hstepB, const Sched& S, const Epi& E, int ktiles = 0, const char* Abase = nullptr) {
    const int tid = tid_(), wid = __builtin_amdgcn_readfirstlane(tid >> 6), lane = tid & 63, wr = wid >> 2, wc = wid & 3, fr = lane & 15, fq = lane >> 4;
    const int nt = ktiles ? ktiles : K / BK;
    unsigned voffA[2], voffB[2]; int Rr[2], Cc[2];
#pragma unroll
    for (int i = 0; i < 2; ++i) { int R, C; stage_rc(tid * 16 + i * 8192, R, C); const int Rb = Epi::PERM ? ((R & ~31) + perm32(R & 31)) : R; Rr[i] = R; Cc[i] = C;
        voffA[i] = (unsigned)(R * K + C) * 2u; voffB[i] = (unsigned)(Rb * K + C) * 2u; }
    unsigned offc[2][2], offn[2][2];
#define PG8_GOFF(dst, u_) do { _Pragma("unroll") for (int h_ = 0; h_ < 2; ++h_) _Pragma("unroll") for (int i_ = 0; i_ < 2; ++i_) { const int r_ = h_ * HALF + Rr[i_]; \
        const int row_ = (u_).g[r_ < (u_).gn ? r_ : 0]; dst[h_][i_] = (unsigned)(row_ * K + Cc[i_]) * 2u; } } while (0)
#define PG8_STAGE_A(bufoff, ptr, h_, offs, kb) do { if (GATHER) PG8_STAGE(bufoff, Abase + (kb), offs[h_]); else PG8_STAGE(bufoff, ptr, voffA); } while (0)
    const size_t kstep = (size_t)(BK * 2);
    const size_t hstep = (size_t)HALF * K * 2;
    const unsigned ldsw = (unsigned)wid * 1024u;
    const int aoff = lds_byte(wr * 64 + fr, fq * 8), boff = lds_byte(wc * 32 + fr, fq * 8);
#define PG8_SA(b, h) (((b) * 2 + (h)) * HTB)
#define PG8_SB(b, h) ((4 + (b) * 2 + (h)) * HTB)
#define PG8_STAGE(bufoff, gbase, voff) do { _Pragma("unroll") for (int _i = 0; _i < 2; ++_i) \
        __builtin_amdgcn_global_load_lds((const unsigned*)((const char*)(gbase) + (voff)[_i]), (PG8_LAS unsigned*)(lds + (bufoff) + ldsw + _i * 8192), 16, 0, 0); } while (0)
#define PG8_LDA(dst, b, h) do { _Pragma("unroll") for (int m = 0; m < 4; ++m) { dst##L[m] = *(const PG8_LAS i32x4*)(lds + PG8_SA(b, h) + aoff + m * 2048); dst##H[m] = *(const PG8_LAS i32x4*)(lds + PG8_SA(b, h) + aoff + m * 2048 + 1024); } } while (0)
#define PG8_LDB(dst, b, h) do { _Pragma("unroll") for (int n = 0; n < 2; ++n) { dst##L[n] = *(const PG8_LAS i32x4*)(lds + PG8_SB(b, h) + boff + n * 2048); dst##H[n] = *(const PG8_LAS i32x4*)(lds + PG8_SB(b, h) + boff + n * 2048 + 1024); } } while (0)
#define PG8_CAT(x, y) __builtin_shufflevector(x, y, 0, 1, 2, 3, 4, 5, 6, 7)
#define PG8_MMA(ai, bj, At, Bt) do { __builtin_amdgcn_s_setprio(1); \
        if (F8) { _Pragma("unroll") for (int m = 0; m < 4; ++m) _Pragma("unroll") for (int n = 0; n < 2; ++n) \
            asm volatile("v_mfma_scale_f32_16x16x128_f8f6f4 %0, %1, %2, %0, %3, %3 op_sel_hi:[0,0,0]" : "+v"(acc[ai][bj][m][n]) : "v"(PG8_CAT(Bt##L[n], Bt##H[n])), "v"(PG8_CAT(At##L[m], At##H[m])), "v"(sc_one)); } \
        else { _Pragma("unroll") for (int m = 0; m < 4; ++m) _Pragma("unroll") for (int n = 0; n < 2; ++n) { \
            acc[ai][bj][m][n] = __builtin_amdgcn_mfma_f32_16x16x32_bf16(__builtin_bit_cast(bf16x8, Bt##L[n]), __builtin_bit_cast(bf16x8, At##L[m]), acc[ai][bj][m][n], 0, 0, 0); \
            acc[ai][bj][m][n] = __builtin_amdgcn_mfma_f32_16x16x32_bf16(__builtin_bit_cast(bf16x8, Bt##H[n]), __builtin_bit_cast(bf16x8, At##H[m]), acc[ai][bj][m][n], 0, 0, 0); } } \
        __builtin_amdgcn_s_setprio(0); } while (0)
#define PG8_WAIT_V(n) asm volatile("s_waitcnt vmcnt(" #n ")" ::: "memory")
#define PG8_WAIT_L(n) asm volatile("s_waitcnt lgkmcnt(" #n ")" ::: "memory")
#define PG8_BAR __builtin_amdgcn_s_barrier()
#define PG8_SCHED __builtin_amdgcn_sched_barrier(0)
    Unit cur, nxt; int ui = 0;
    if (!S.next(0, cur)) return;
    f32x4 acc[2][2][4][2];
#pragma unroll
    for (int a = 0; a < 2; ++a)
#pragma unroll
        for (int b = 0; b < 2; ++b)
#pragma unroll
            for (int m = 0; m < 4; ++m)
#pragma unroll
                for (int n = 0; n < 2; ++n) acc[a][b][m][n] = (f32x4){0.f, 0.f, 0.f, 0.f};
    int sc_one = 0x7f7f7f7f; asm volatile("" : "+v"(sc_one));
    i32x4 AtL[4], AtH[4], B0L[2], B0H[2], B1L[2], B1H[2];
    const char* cA = cur.a; const char* cB = cur.b;
    if (GATHER) { PG8_GOFF(offc, cur); asm volatile("s_waitcnt vmcnt(0)" ::: "memory"); }
    PG8_STAGE(PG8_SB(0, 0), cB, voffB); PG8_STAGE_A(PG8_SA(0, 0), cA, 0, offc, 0); PG8_STAGE(PG8_SB(0, 1), cB + hstepB, voffB); PG8_STAGE_A(PG8_SA(0, 1), cA + hstep, 1, offc, 0);
    if (wr == 1) PG8_BAR;
    PG8_WAIT_V(4); PG8_BAR;
    PG8_STAGE(PG8_SB(1, 0), cB + kstep, voffB); PG8_STAGE_A(PG8_SA(1, 0), cA + kstep, 0, offc, kstep); PG8_STAGE(PG8_SB(1, 1), cB + hstepB + kstep, voffB);
    PG8_WAIT_V(6); PG8_BAR;
    for (;;) {
        const bool has_next = S.next(ui + 1, nxt);
        const char* nA = has_next ? nxt.a : cA; const char* nB = has_next ? nxt.b : cB;
        if (GATHER) { if (has_next) PG8_GOFF(offn, nxt); else {
#pragma unroll
            for (int h_ = 0; h_ < 2; ++h_)
#pragma unroll
                for (int i_ = 0; i_ < 2; ++i_) offn[h_][i_] = offc[h_][i_]; } }
        for (int t = 0; t < nt; t += 2) {
            const bool last = (t == nt - 2);
            const char* a1 = cA + (size_t)(t + 1) * kstep;
            const char* a2 = last ? nA : cA + (size_t)(t + 2) * kstep; const char* b2 = last ? nB : cB + (size_t)(t + 2) * kstep;
            const char* a3 = a2 + kstep; const char* b3 = b2 + kstep;
            unsigned o2[2][2]; const size_t k1 = (size_t)(t + 1) * kstep, k2 = last ? 0 : (size_t)(t + 2) * kstep, k3 = k2 + kstep;
            if (GATHER) {
                if (last) { asm volatile("" ::: "memory");
#pragma unroll
                    for (int h_ = 0; h_ < 2; ++h_)
#pragma unroll
                        for (int i_ = 0; i_ < 2; ++i_) o2[h_][i_] = offn[h_][i_]; }
                else {
#pragma unroll
                    for (int h_ = 0; h_ < 2; ++h_)
#pragma unroll
                        for (int i_ = 0; i_ < 2; ++i_) o2[h_][i_] = offc[h_][i_]; } }
            PG8_LDB(B0, 0, 0); PG8_SCHED; PG8_LDA(At, 0, 0); PG8_STAGE_A(PG8_SA(1, 1), a1 + hstep, 1, offc, k1);
            PG8_WAIT_L(8); PG8_BAR; PG8_WAIT_L(0); PG8_MMA(0, 0, At, B0); PG8_BAR; PG8_SCHED;
            PG8_LDB(B1, 0, 1); PG8_STAGE(PG8_SB(0, 0), b2, voffB);
            PG8_BAR; PG8_WAIT_L(0); PG8_MMA(0, 1, At, B1); PG8_BAR;
            PG8_LDA(At, 0, 1); PG8_STAGE_A(PG8_SA(0, 0), a2, 0, o2, k2);
            PG8_BAR; PG8_WAIT_L(0); PG8_MMA(1, 0, At, B0); PG8_BAR; PG8_SCHED;
            PG8_STAGE(PG8_SB(0, 1), b2 + hstepB, voffB);
            PG8_WAIT_V(6); PG8_BAR; PG8_MMA(1, 1, At, B1); PG8_BAR;
            PG8_LDB(B0, 1, 0); PG8_SCHED; PG8_LDA(At, 1, 0); PG8_STAGE_A(PG8_SA(0, 1), a2 + hstep, 1, o2, k2);
            PG8_WAIT_L(8); PG8_BAR; PG8_WAIT_L(0); PG8_MMA(0, 0, At, B0); PG8_BAR; PG8_SCHED;
            PG8_LDB(B1, 1, 1); PG8_STAGE(PG8_SB(1, 0), b3, voffB);
            PG8_BAR; PG8_WAIT_L(0); PG8_MMA(0, 1, At, B1); PG8_BAR;
            PG8_LDA(At, 1, 1); PG8_STAGE_A(PG8_SA(1, 0), a3, 0, o2, k3);
            PG8_BAR; PG8_WAIT_L(0); PG8_MMA(1, 0, At, B0); PG8_BAR; PG8_SCHED;
            PG8_STAGE(PG8_SB(1, 1), b3 + hstepB, voffB);
            PG8_WAIT_V(6); PG8_BAR; PG8_MMA(1, 1, At, B1); PG8_BAR;
        }
        if (F8) asm volatile("s_nop 15\n\ts_nop 15" ::: "memory");
        { int fr_ = fr, fq_ = fq; asm volatile("" : "+v"(fr_), "+v"(fq_));
          E(acc, cur, wr, wc, fr_, fq_); }
        if (!has_next) break;
#pragma unroll
        for (int a = 0; a < 2; ++a)
#pragma unroll
            for (int b = 0; b < 2; ++b)
#pragma unroll
                for (int m = 0; m < 4; ++m)
#pragma unroll
                    for (int n = 0; n < 2; ++n) acc[a][b][m][n] = (f32x4){0.f, 0.f, 0.f, 0.f};
        cur = nxt; cA = nA; cB = nB; ++ui;
        if (GATHER) {
#pragma unroll
            for (int h_ = 0; h_ < 2; ++h_)
#pragma unroll
                for (int i_ = 0; i_ < 2; ++i_) offc[h_][i_] = offn[h_][i_]; }
    }
    PG8_WAIT_V(0);
    if (wr == 0) PG8_BAR;
    PG8_BAR;
#undef PG8_SA
#undef PG8_SB
#undef PG8_STAGE
#undef PG8_STAGE_A
#undef PG8_GOFF
#undef PG8_LDA
#undef PG8_LDB
#undef PG8_MMA
#undef PG8_WAIT_V
#undef PG8_WAIT_L
#undef PG8_BAR
#undef PG8_SCHED
}
}

DEVI void conv_item(const float* __restrict__ W, int K, int N, bf16_t* __restrict__ Wt, int kb, int nb, int lane) {
    const int ko = lane & 7, nq = lane >> 3;
    const float* src = W + (size_t)(kb * 64 + ko * 8) * N + nb * 32 + nq * 4;
    f32x4 v[8];
#pragma unroll
    for (int kk = 0; kk < 8; ++kk) v[kk] = *(const f32x4*)(src + (size_t)kk * N);
    bf16_t* dst = Wt + (size_t)(nb * 32 + nq * 4) * K + kb * 64 + ko * 8;
#pragma unroll
    for (int i = 0; i < 4; ++i) { u32x4 o; o.x = cvt_pk_bf16(v[0][i], v[1][i]); o.y = cvt_pk_bf16(v[2][i], v[3][i]); o.z = cvt_pk_bf16(v[4][i], v[5][i]); o.w = cvt_pk_bf16(v[6][i], v[7][i]);
        *(u32x4*)(dst + (size_t)i * K) = o; }
}

namespace att {
typedef short s16x4 __attribute__((ext_vector_type(4)));
typedef float f32x16 __attribute__((ext_vector_type(16)));
constexpr int KVBLK = 64;
constexpr float SCALE = 0.10206207261596577f;
constexpr float THR = 8.f;
constexpr int SHM_V = 16384, SHM_K = 16384, NBUF = 3, SHM_ATTN = NBUF * SHM_V + NBUF * SHM_K + 8 * 64 * 4;
#define KSWZ(row, colB) ((row) * 256 + ((colB) ^ (((row) & 7) << 4)))
#define SBAR() __builtin_amdgcn_sched_barrier(0)
DEVI int crow(int r, int hi) { return (r & 3) + 8 * (r >> 2) + 4 * hi; }
DEVI void partialSM(f32x16& p0, f32x16& p1, float& m_reg, float& mn, float& alpha) {
    constexpr float C = SCALE * 1.4426950408889634f;
    float pmax = p0[0];
#pragma unroll
    for (int r = 1; r < 16; ++r) pmax = fmaxf(pmax, p0[r]);
#pragma unroll
    for (int r = 0; r < 16; ++r) pmax = fmaxf(pmax, p1[r]);
    { auto rr = __builtin_amdgcn_permlane32_swap(__float_as_uint(pmax), __float_as_uint(pmax), false, false);
      pmax = fmaxf(__uint_as_float(rr[0]), __uint_as_float(rr[1])); }
    if (__builtin_expect(__all(pmax - m_reg <= THR / SCALE), 1)) { mn = m_reg; alpha = 1.f; }
    else { mn = fmaxf(m_reg, pmax); alpha = __builtin_amdgcn_exp2f((m_reg - mn) * C); m_reg = mn; }
    const float mnC = -mn * C;
#pragma unroll
    for (int r = 0; r < 16; ++r) p0[r] = fmaf(p0[r], C, mnC);
#pragma unroll
    for (int r = 0; r < 16; ++r) p1[r] = fmaf(p1[r], C, mnC);
#pragma unroll
    for (int r = 0; r < 16; ++r) p0[r] = __builtin_amdgcn_exp2f(p0[r]);
}
DEVI void finishSM(f32x16& p0, f32x16& p1, float alpha, float& l_reg, bf16x8& pa0, bf16x8& pa1, bf16x8& pa2, bf16x8& pa3) {
#pragma unroll
    for (int r = 0; r < 16; ++r) p1[r] = __builtin_amdgcn_exp2f(p1[r]);
    float ps = 0.f;
#pragma unroll
    for (int r = 0; r < 16; ++r) ps += p0[r];
#pragma unroll
    for (int r = 0; r < 16; ++r) ps += p1[r];
    { auto rr = __builtin_amdgcn_permlane32_swap(__float_as_uint(ps), __float_as_uint(ps), false, false);
      ps = __uint_as_float(rr[0]) + __uint_as_float(rr[1]); }
    l_reg = l_reg * alpha + ps;
#define PK4(P, BASE, OUT) do { unsigned a0 = cvt_pk_bf16(P[BASE + 0], P[BASE + 1]), a1 = cvt_pk_bf16(P[BASE + 2], P[BASE + 3]);   \
    unsigned b0 = cvt_pk_bf16(P[BASE + 4], P[BASE + 5]), b1 = cvt_pk_bf16(P[BASE + 6], P[BASE + 7]);                              \
    auto r0 = __builtin_amdgcn_permlane32_swap(a0, b0, false, false); auto r1 = __builtin_amdgcn_permlane32_swap(a1, b1, false, false); \
    u32x4 w = {r0[0], r1[0], r0[1], r1[1]}; OUT = *reinterpret_cast<bf16x8*>(&w); } while (0)
    PK4(p0, 0, pa0); PK4(p0, 8, pa1); PK4(p1, 0, pa2); PK4(p1, 8, pa3);
#undef PK4
}
DEVI void qkt(f32x16& p0, f32x16& p1, const char* Ks, const bf16x8* qr, int r32, int hi) {
    p0 = f32x16{}; p1 = f32x16{};
#pragma unroll
    for (int d0 = 0; d0 < 6; ++d0) { const int cb = (d0 * 16 + hi * 8) * 2;
        const bf16x8 b0 = *reinterpret_cast<const bf16x8*>(Ks + KSWZ(r32, cb));
        const bf16x8 b1 = *reinterpret_cast<const bf16x8*>(Ks + KSWZ(32 + r32, cb));
        p0 = __builtin_amdgcn_mfma_f32_32x32x16_bf16(b0, qr[d0], p0, 0, 0, 0);
        p1 = __builtin_amdgcn_mfma_f32_32x32x16_bf16(b1, qr[d0], p1, 0, 0, 0); }
}
DEVI int v_st(int k, int c) { const int kk = (k & ~0xC) | ((k & 4) << 1) | ((k & 8) >> 1); return ((kk >> 3) * 4 + (c >> 5)) * 512 + ((kk & 7) * 32 + (c & 31)) * 2; }
DEVI int v_rd_base(int lane) { return ((lane & 3) << 3) | (((lane >> 2) & 3) << 6) | (((lane >> 4) & 1) << 5) | (((lane >> 5) & 1) << 8); }
constexpr int v_rd_off(int d0, int ks, int half) { return d0 * 512 + ks * 4096 + half * 2048; }
template <int OFF> DEVI s16x4 tr_read(int vb) {
    s16x4 r; asm volatile("ds_read_b64_tr_b16 %0, %1 offset:%2" : "=&v"(r) : "v"(vb), "i"(OFF) : "memory"); return r;
}
template <int D0> DEVI void pv_one(f32x16& od, int vb, bf16x8 pa0, bf16x8 pa1, bf16x8 pa2, bf16x8 pa3) {
    const s16x4 l0 = tr_read<v_rd_off(D0, 0, 0)>(vb), h0 = tr_read<v_rd_off(D0, 0, 1)>(vb), l1 = tr_read<v_rd_off(D0, 1, 0)>(vb), h1 = tr_read<v_rd_off(D0, 1, 1)>(vb);
    const s16x4 l2 = tr_read<v_rd_off(D0, 2, 0)>(vb), h2 = tr_read<v_rd_off(D0, 2, 1)>(vb), l3 = tr_read<v_rd_off(D0, 3, 0)>(vb), h3 = tr_read<v_rd_off(D0, 3, 1)>(vb);
    asm volatile("s_waitcnt lgkmcnt(0)" ::: "memory"); SBAR();
#define PKV(L, H) (bf16x8){L[0], L[1], L[2], L[3], H[0], H[1], H[2], H[3]}
    od = __builtin_amdgcn_mfma_f32_32x32x16_bf16(pa0, PKV(l0, h0), od, 0, 0, 0);
    od = __builtin_amdgcn_mfma_f32_32x32x16_bf16(pa1, PKV(l1, h1), od, 0, 0, 0);
    od = __builtin_amdgcn_mfma_f32_32x32x16_bf16(pa2, PKV(l2, h2), od, 0, 0, 0);
    od = __builtin_amdgcn_mfma_f32_32x32x16_bf16(pa3, PKV(l3, h3), od, 0, 0, 0);
#undef PKV
}
DEVI void pv_d0(f32x16* o, int vb, bf16x8 pa0, bf16x8 pa1, bf16x8 pa2, bf16x8 pa3) {
    pv_one<0>(o[0], vb, pa0, pa1, pa2, pa3); pv_one<1>(o[1], vb, pa0, pa1, pa2, pa3);
}
DEVI void attn_unit(const bf16_t* __restrict__ Qb, const bf16_t* __restrict__ Kh, const bf16_t* __restrict__ Vh, int seq, bf16_t* __restrict__ Ob, int ldo, char* lds) {
    const int tid = tid_(), wid = tid >> 6, lane = tid & 63, r32 = lane & 31, hi = lane >> 5;
    char* V_lds = lds; char* K_lds = lds + NBUF * SHM_V;
    float* wsl = (float*)(lds + NBUF * SHM_V + NBUF * SHM_K) + wid * 64; float* li_l = wsl; float* al_l = wsl + 32;
    float m_reg = -1e30f, l_reg = 0.f; f32x16 o[2] = {}; bf16x8 qr[6];
    const bf16_t* Qw = Qb + (size_t)(wid * 32 + r32) * 96 + hi * 8;
#pragma unroll
    for (int d0 = 0; d0 < 6; ++d0) qr[d0] = *reinterpret_cast<const bf16x8*>(Qw + d0 * 16);
    const int sr = tid >> 4, kc = tid & 15, kcl = (kc < 12 ? kc : 11) * 8;
    const int vr = tid >> 3, vc = (tid & 7) * 8, vst0 = v_st(vr, vc);
    const int kst0 = KSWZ(sr, kc * 16), kst1 = KSWZ(32 + sr, kc * 16);
    const int vb0 = (int)(uintptr_t)V_lds + v_rd_base(lane);
    bf16x8 sv0, sk00, sk01, sv1, sk10, sk11;
#define SLOAD0(k0) do { sv0 = *reinterpret_cast<const bf16x8*>(Vh + (size_t)((k0) + vr) * 64 + vc); sk00 = *reinterpret_cast<const bf16x8*>(Kh + (size_t)((k0) + sr) * 96 + kcl); \
    sk01 = *reinterpret_cast<const bf16x8*>(Kh + (size_t)((k0) + 32 + sr) * 96 + kcl); } while (0)
#define SLOAD1(k0) do { sv1 = *reinterpret_cast<const bf16x8*>(Vh + (size_t)((k0) + vr) * 64 + vc); sk10 = *reinterpret_cast<const bf16x8*>(Kh + (size_t)((k0) + sr) * 96 + kcl); \
    sk11 = *reinterpret_cast<const bf16x8*>(Kh + (size_t)((k0) + 32 + sr) * 96 + kcl); } while (0)
#define SWRITE0(b) do { *(bf16x8*)(V_lds + (b) * SHM_V + vst0) = sv0; *(bf16x8*)(K_lds + (b) * SHM_K + kst0) = sk00; *(bf16x8*)(K_lds + (b) * SHM_K + kst1) = sk01; } while (0)
#define SWRITE1(b) do { *(bf16x8*)(V_lds + (b) * SHM_V + vst0) = sv1; *(bf16x8*)(K_lds + (b) * SHM_K + kst0) = sk10; *(bf16x8*)(K_lds + (b) * SHM_K + kst1) = sk11; } while (0)
#define SWAIT() asm volatile("s_waitcnt vmcnt(3)" ::: "memory")
#define RESC(a) do { if (__any((a) < 1.f)) { if (hi == 0) al_l[r32] = (a); asm volatile("s_waitcnt lgkmcnt(0)" ::: "memory"); \
    _Pragma("unroll") for (int d = 0; d < 2; ++d) _Pragma("unroll") for (int r = 0; r < 16; ++r) o[d][r] *= al_l[crow(r, hi)]; } } while (0)
#define BNEXT(b) ((b) == NBUF - 1 ? 0 : (b) + 1)
    f32x16 pA0, pA1, pB0, pB1; float mnA, mnB, alA, alB; bf16x8 pa0, pa1, pa2, pa3; const int NT = seq / KVBLK;
    SLOAD0(0); asm volatile("s_waitcnt vmcnt(0)" ::: "memory"); SWRITE0(0); __syncthreads();
    qkt(pA0, pA1, K_lds, qr, r32, hi); partialSM(pA0, pA1, m_reg, mnA, alA);
    SLOAD1(KVBLK); if (2 < NT) SLOAD0(2 * KVBLK);
    SWAIT(); SWRITE1(1); __syncthreads();
    int bp = 0, bc = 1, bn = 2;
    for (int j = 1; j + 1 < NT; j += 2) {
        SBAR(); qkt(pB0, pB1, K_lds + bc * SHM_K, qr, r32, hi);
        finishSM(pA0, pA1, alA, l_reg, pa0, pa1, pa2, pa3); SBAR();
        SLOAD1((j + 2) * KVBLK); SBAR();
        pv_d0(o, vb0 + bp * SHM_V, pa0, pa1, pa2, pa3); partialSM(pB0, pB1, m_reg, mnB, alB);
        SWAIT(); SWRITE0(bn);
        RESC(alB); __syncthreads();
        bp = bc; bc = bn; bn = BNEXT(bn);
        SBAR(); qkt(pA0, pA1, K_lds + bc * SHM_K, qr, r32, hi);
        finishSM(pB0, pB1, alB, l_reg, pa0, pa1, pa2, pa3); SBAR();
        if (j + 3 < NT) SLOAD0((j + 3) * KVBLK); SBAR();
        pv_d0(o, vb0 + bp * SHM_V, pa0, pa1, pa2, pa3); partialSM(pA0, pA1, m_reg, mnA, alA);
        SWAIT(); SWRITE1(bn);
        RESC(alA); __syncthreads();
        bp = bc; bc = bn; bn = BNEXT(bn);
    }
    SBAR(); qkt(pB0, pB1, K_lds + bc * SHM_K, qr, r32, hi);
    finishSM(pA0, pA1, alA, l_reg, pa0, pa1, pa2, pa3); SBAR();
    pv_d0(o, vb0 + bp * SHM_V, pa0, pa1, pa2, pa3); partialSM(pB0, pB1, m_reg, mnB, alB);
    RESC(alB);
    finishSM(pB0, pB1, alB, l_reg, pa0, pa1, pa2, pa3); SBAR();
    pv_d0(o, vb0 + bc * SHM_V, pa0, pa1, pa2, pa3);
    if (hi == 0) li_l[r32] = l_reg; asm volatile("s_waitcnt lgkmcnt(0)" ::: "memory");
    float rli[16];
#pragma unroll
    for (int r = 0; r < 16; ++r) rli[r] = __builtin_amdgcn_rcpf(li_l[crow(r, hi)]);
    bf16_t* Ow = Ob + (size_t)(wid * 32) * ldo;
#pragma unroll
    for (int r = 0; r < 16; ++r) { const int orow = crow(r, hi);
#pragma unroll
        for (int d0 = 0; d0 < 2; ++d0) Ow[(size_t)orow * ldo + d0 * 32 + r32] = f2bf(o[d0][r] * rli[r]); }
    __syncthreads();
#undef SLOAD0
#undef SLOAD1
#undef SWRITE0
#undef SWRITE1
#undef SWAIT
#undef RESC
#undef BNEXT
}
#undef KSWZ
#undef SBAR
}

template <class ARow, class BMap, class Epi>
DEVI void gemm_tile(int K, ARow arow, const float* __restrict__ B, int ldb, BMap bmap, Epi epi, float* smem) {
    float (*As)[132] = (float (*)[132])smem;
    float (*Bs)[64] = (float (*)[64])(smem + 16 * 132);
    const int tid = tid_(), ty = tid >> 4, tx = tid & 15;
    float acc[4][4];
#pragma unroll
    for (int i = 0; i < 4; ++i)
#pragma unroll
        for (int j = 0; j < 4; ++j) acc[i][j] = 0.f;
    const int ar = tid >> 2, akq = tid & 3;
    const float* ap = arow(ar);
    const int bk0 = tid >> 6, bc = tid & 63;
    const int bcol = bmap(bc);
    for (int k0 = 0; k0 < K; k0 += 16) {
        float4 av = make_float4(0.f, 0.f, 0.f, 0.f);
        if (ap) av = *(const float4*)(ap + k0 + akq * 4);
        float b0 = 0.f, b1 = 0.f;
        if (bcol >= 0) { b0 = B[(size_t)(k0 + bk0) * ldb + bcol]; b1 = B[(size_t)(k0 + bk0 + 8) * ldb + bcol]; }
        __syncthreads();
        As[akq * 4 + 0][ar] = av.x; As[akq * 4 + 1][ar] = av.y; As[akq * 4 + 2][ar] = av.z; As[akq * 4 + 3][ar] = av.w;
        Bs[bk0][bc] = b0; Bs[bk0 + 8][bc] = b1;
        __syncthreads();
#pragma unroll
        for (int kk = 0; kk < 16; ++kk) {
            const float4 a = *(const float4*)&As[kk][ty * 4];
            const float4 b = *(const float4*)&Bs[kk][tx * 4];
            const float aa[4] = {a.x, a.y, a.z, a.w}, bb[4] = {b.x, b.y, b.z, b.w};
#pragma unroll
            for (int i = 0; i < 4; ++i)
#pragma unroll
                for (int j = 0; j < 4; ++j) acc[i][j] = fmaf(aa[i], bb[j], acc[i][j]);
        }
    }
#pragma unroll
    for (int i = 0; i < 4; ++i) epi(ty * 4 + i, tx, acc[i]);
    __syncthreads();
}


struct UnitRange { int lo, hi, step; };
DEVI UnitRange unit_range(int nunits, int bid) {
    UnitRange r;
    if ((gridDim.x & 7) == 0) { const int x = bid & 7, j = bid >> 3; r.lo = (int)(((long)nunits * x) >> 3) + j; r.hi = (int)(((long)nunits * (x + 1)) >> 3); r.step = gridDim.x >> 3; }
    else { r.lo = bid; r.hi = nunits; r.step = gridDim.x; }
    return r;
}


template <bool REV> DEVI void scan16(float& a, float& b) {
#define SC_STEP(N_) do { const int ctrl_ = (REV ? 0x100 : 0x110) | (N_); \
        const float pa = __int_as_float(__builtin_amdgcn_update_dpp(0x3f800000, __float_as_int(a), ctrl_, 0xf, 0xf, false)); \
        const float pb = __int_as_float(__builtin_amdgcn_update_dpp(0, __float_as_int(b), ctrl_, 0xf, 0xf, false)); \
        b = fmaf(a, pb, b); a = a * pa; } while (0)
    SC_STEP(1); SC_STEP(2); SC_STEP(4); SC_STEP(8);
#undef SC_STEP
}

__device__ void phase_convert(const Params& p) {
    float* const ws = (float*)(gfloat_t*)tab_ld(N_IN);
    const float* const pin_I_WIN = PIN(I_WIN);
    const float* const pin_I_WOUT = PIN(I_WOUT);
    const int tid = tid_(), bid = bid_();
    const int lane = tid & 63, gw = bid * (NTHR / 64) + __builtin_amdgcn_readfirstlane(tid >> 6), nw = gridDim.x * (NTHR / 64);
    constexpr int NI_OUT = NLAYER * 16 * 32, NI_IN = NLAYER * 16 * 51;
    bf16_t* wout = (bf16_t*)(ws + W_WOUT); bf16_t* win = (bf16_t*)(ws + W_WIN);
    for (int it = gw; it < NI_OUT + NI_IN; it += nw) {
        int r = it;
        if (r < NI_OUT) { const int mat = r >> 9, q = r & 511; conv_item(pin_I_WOUT + (size_t)mat * D * D, D, D, wout + (size_t)mat * D * D, q >> 5, q & 31, lane); continue; }
        r -= NI_OUT;
        { const int mat = r / 816, q = r % 816; conv_item(pin_I_WIN + (size_t)mat * D * INC, D, INC, win + (size_t)mat * NPAD_IN * D, q / 51, q % 51, lane); }
    }
}
template <bool F8O>
DEVI void conv_item2(const float* __restrict__ W0, int N0, void* __restrict__ T0, int kb0, int nb0, const float* __restrict__ W1, int N1, void* __restrict__ T1, int kb1, int nb1, int lane) {
    constexpr int K = D;
    const int ko = lane & 7, nq = lane >> 3;
    const float* s0 = W0 + (size_t)(kb0 * 64 + ko * 8) * N0 + nb0 * 32 + nq * 4; const float* s1 = W1 + (size_t)(kb1 * 64 + ko * 8) * N1 + nb1 * 32 + nq * 4;
    f32x4 v[8], w[8];
#pragma unroll
    for (int kk = 0; kk < 8; ++kk) v[kk] = __builtin_nontemporal_load((const f32x4*)(s0 + (size_t)kk * N0));
#pragma unroll
    for (int kk = 0; kk < 8; ++kk) w[kk] = __builtin_nontemporal_load((const f32x4*)(s1 + (size_t)kk * N1));
    if (F8O) {
        unsigned char* d0 = (unsigned char*)T0 + (size_t)(nb0 * 32 + nq * 4) * K + kb0 * 64 + ko * 8; unsigned char* d1 = (unsigned char*)T1 + (size_t)(nb1 * 32 + nq * 4) * K + kb1 * 64 + ko * 8;
#pragma unroll
        for (int i = 0; i < 4; ++i) { u32x2 o; o.x = pk_fp8x4(v[0][i] * W8_SCALE, v[1][i] * W8_SCALE, v[2][i] * W8_SCALE, v[3][i] * W8_SCALE); o.y = pk_fp8x4(v[4][i] * W8_SCALE, v[5][i] * W8_SCALE, v[6][i] * W8_SCALE, v[7][i] * W8_SCALE);
            *(u32x2*)(d0 + (size_t)i * K) = o; }
#pragma unroll
        for (int i = 0; i < 4; ++i) { u32x2 o; o.x = pk_fp8x4(w[0][i] * W8_SCALE, w[1][i] * W8_SCALE, w[2][i] * W8_SCALE, w[3][i] * W8_SCALE); o.y = pk_fp8x4(w[4][i] * W8_SCALE, w[5][i] * W8_SCALE, w[6][i] * W8_SCALE, w[7][i] * W8_SCALE);
            *(u32x2*)(d1 + (size_t)i * K) = o; }
    } else {
        bf16_t* d0 = (bf16_t*)T0 + (size_t)(nb0 * 32 + nq * 4) * K + kb0 * 64 + ko * 8; bf16_t* d1 = (bf16_t*)T1 + (size_t)(nb1 * 32 + nq * 4) * K + kb1 * 64 + ko * 8;
#pragma unroll
        for (int i = 0; i < 4; ++i) { u32x4 o; o.x = cvt_pk_bf16(v[0][i], v[1][i]); o.y = cvt_pk_bf16(v[2][i], v[3][i]); o.z = cvt_pk_bf16(v[4][i], v[5][i]); o.w = cvt_pk_bf16(v[6][i], v[7][i]);
            *(u32x4*)(d0 + (size_t)i * K) = o; }
#pragma unroll
        for (int i = 0; i < 4; ++i) { u32x4 o; o.x = cvt_pk_bf16(w[0][i], w[1][i]); o.y = cvt_pk_bf16(w[2][i], w[3][i]); o.z = cvt_pk_bf16(w[4][i], w[5][i]); o.w = cvt_pk_bf16(w[6][i], w[7][i]);
            *(u32x4*)(d1 + (size_t)i * K) = o; }
    }
}
constexpr int NI_MOE = NEXP * 16 * 64 + NEXP * 16 * 32;
__device__ void conv_moe(const Params& p, int l, int quota) {
    float* const ws = (float*)(gfloat_t*)tab_ld(N_IN);
    const float* const pin_I_WDN = PIN(I_WDN);
    const float* const pin_I_WGU = PIN(I_WGU);
    const int tid = tid_(), bid = bid_();
    const int lane = tid & 63;
    int* cursor = (int*)(ws + W_BAR) + 3584 + l * 64;
    bf16_t* wgu = (bf16_t*)(ws + W_WGU) + (size_t)l * NEXP * 2048 * D; unsigned char* wdn = (unsigned char*)(ws + W_WDN) + (size_t)l * NEXP * D * D;
    const float* sgu = pin_I_WGU + (size_t)l * NEXP * D * 2048; const float* sdn = pin_I_WDN + (size_t)l * NEXP * D * D;
#define CONV_DEC(it, S_, N_, T_, KB_, NB_) const float* S_; void* T_; int N_, KB_, NB_; \
        if ((it) < NEXP * 1024) { const int mat = (it) >> 10, q = (it) & 1023; S_ = sgu + (size_t)mat * D * 2048; N_ = 2048; T_ = wgu + (size_t)mat * 2048 * D; KB_ = q >> 6; NB_ = q & 63; } \
        else { const int r_ = (it) - NEXP * 1024, mat = r_ >> 9, q = r_ & 511; S_ = sdn + (size_t)mat * D * D; N_ = D; T_ = wdn + (size_t)mat * D * D; KB_ = q >> 5; NB_ = q & 31; }
#define CONV_PAIR(i0, i1) do { CONV_DEC(i0, sa_, na_, ta_, ka_, ba_) CONV_DEC(i1, sb_, nb_, tb_, kb_, bb_) \
        if ((i0) < NEXP * 1024) conv_item2<false>(sa_, na_, ta_, ka_, ba_, sb_, nb_, tb_, kb_, bb_, lane); else conv_item2<true>(sa_, na_, ta_, ka_, ba_, sb_, nb_, tb_, kb_, bb_, lane); } while (0)
    if (quota > 0) {
        int c0 = 0;
        if (lane == 0) c0 = atomicAdd(cursor, quota);
        c0 = __builtin_amdgcn_readfirstlane(c0);
        for (int it = c0; it < c0 + quota && it + 1 < NI_MOE; it += 2) CONV_PAIR(it, it + 1);
    } else {
        int c0 = __hip_atomic_load(cursor, __ATOMIC_RELAXED, __HIP_MEMORY_SCOPE_AGENT);
        c0 = __builtin_amdgcn_readfirstlane(c0); if (c0 > NI_MOE) c0 = NI_MOE;
        const int gw = bid * (NTHR / 64) + __builtin_amdgcn_readfirstlane(tid >> 6), nw = gridDim.x * (NTHR / 64);
        for (int it = c0 + 2 * gw; it + 1 < NI_MOE; it += 2 * nw) CONV_PAIR(it, it + 1);
    }
#undef CONV_DEC
#undef CONV_PAIR
}

__device__ void phase_tables(const Params& p) {
    float* const ws = (float*)(gfloat_t*)tab_ld(N_IN);
    const float* const pin_I_LAM = PIN(I_LAM);
    const float* const pin_I_SGWS = PIN(I_SGWS);
    const int tid = tid_(), bid = bid_(); (void)tid; (void)bid;
    for (int i = bid * NTHR + tid; i < NLAYER * 4 * 128 * 128; i += gridDim.x * NTHR) ((bf16_t*)(ws + W_WSB))[i] = f2bf(pin_I_SGWS[i]);
    for (int i = bid * NTHR + tid; i < NLAT * 16; i += gridDim.x * NTHR) {
        const int t = i >> 4, f = i & 15; const float pos = (f < 8) ? (float)(t >> 6) : (float)(t & 63);
        const float ang = pos * powf(10000.f, -(float)(f & 7) / 8.f);
        ws[W_ROPE + (size_t)t * 32 + f] = cosf(ang); ws[W_ROPE + (size_t)t * 32 + 16 + f] = sinf(ang);
    }
    if (bid == 1) for (int i = tid; i < NLAYER * 2 * 256; i += NTHR) ws[W_SP + i] = log1pf(expf(-pin_I_LAM[i]));
    if (bid == 0) for (int i = tid; i < NLAYER * NEXP * 64; i += NTHR) ((int*)(ws + W_CNT))[i] = 0;
}

DEVI void norm1_store(const Params& p, int l, int t, int lane, const float4 (&v)[4]) {
    const float* g = p.in[I_NMIX] + l * D;
    const float* mod = p.ws + W_MOD + (size_t)(l * 2 + (t >= NLAT ? 1 : 0)) * 6144;
    float ss = 0.f;
#pragma unroll
    for (int j = 0; j < 4; ++j) ss += v[j].x * v[j].x + v[j].y * v[j].y + v[j].z * v[j].z + v[j].w * v[j].w;
    const float rstd = rsqrtf(wave_sum(ss) * (1.f / D) + EPS);
    bf16_t* hb = (bf16_t*)(p.ws + W_HB) + (size_t)t * D;
#pragma unroll
    for (int j = 0; j < 4; ++j) {
        const int c = j * 256 + lane * 4;
        const float4 gg = *(const float4*)(g + c), s1 = *(const float4*)(mod + D + c), s0 = *(const float4*)(mod + c);
        u32x2 w; w.x = cvt_pk_bf16(v[j].x * rstd * gg.x * (1.f + s1.x) + s0.x, v[j].y * rstd * gg.y * (1.f + s1.y) + s0.y);
        w.y = cvt_pk_bf16(v[j].z * rstd * gg.z * (1.f + s1.z) + s0.z, v[j].w * rstd * gg.w * (1.f + s1.w) + s0.w);
        *(u32x2*)(hb + c) = w;
    }
}
__device__ void phase_init(const Params& p) {
    float* const ws = (float*)(gfloat_t*)tab_ld(N_IN);
    const float* const pin_I_CTX = PIN(I_CTX);
    const float* const pin_I_X = PIN(I_X);
    const int tid = tid_(), bid = bid_();
    const int lane = tid & 63, gw = bid * (NTHR / 64) + __builtin_amdgcn_readfirstlane(tid >> 6), nw = gridDim.x * (NTHR / 64);
    for (int t = gw; t < T; t += nw) {
        const float* src = (t < NLAT) ? pin_I_X + (size_t)t * D : pin_I_CTX + (size_t)(t - NLAT) * D;
        float4 v[4];
#pragma unroll
        for (int j = 0; j < 4; ++j) { v[j] = *(const float4*)(src + j * 256 + lane * 4); if (t >= NLAT) *(float4*)(ws + W_X + (size_t)t * D + j * 256 + lane * 4) = v[j]; }
        norm1_store(p, 0, t, lane, v);
    }
}

__device__ void phase_mod(const Params& p, float* smem) {
    float* const ws = (float*)(gfloat_t*)tab_ld(N_IN);
    const float* const pin_I_BMOD = PIN(I_BMOD);
    const float* const pin_I_C = PIN(I_C);
    const float* const pin_I_CCTX = PIN(I_CCTX);
    const float* const pin_I_WMOD = PIN(I_WMOD);
    const int tid = tid_(), bid = bid_();
    const int wave = tid >> 6, lane = tid & 63;
    float* sc = smem + 1024;
    for (int i = tid; i < 1024; i += NTHR) { sc[i] = silu(pin_I_C[i]); sc[1024 + i] = silu(pin_I_CCTX[i]); }
    __syncthreads();
    for (int it = bid; it < NLAYER * 96; it += gridDim.x) {
        const int l = it / 96, j = (it % 96) * 64 + lane;
        const float* W = pin_I_WMOD + (size_t)l * 1024 * 6144 + j;
        float a0 = 0.f, a1 = 0.f;
        for (int k0 = wave * 128; k0 < wave * 128 + 128; k0 += 16) {
            float w[16];
#pragma unroll
            for (int q = 0; q < 16; ++q) w[q] = W[(size_t)(k0 + q) * 6144];
#pragma unroll
            for (int q = 0; q < 16; ++q) { a0 = fmaf(sc[k0 + q], w[q], a0); a1 = fmaf(sc[1024 + k0 + q], w[q], a1); }
        }
        smem[(wave * 2 + 0) * 64 + lane] = a0; smem[(wave * 2 + 1) * 64 + lane] = a1;
        __syncthreads();
        if (wave < 2) {
            float s = 0.f;
            for (int w = 0; w < 8; ++w) s += smem[(w * 2 + wave) * 64 + lane];
            ws[W_MOD + (size_t)(l * 2 + wave) * 6144 + j] = s + pin_I_BMOD[l * 6144 + j];
        }
        __syncthreads();
    }
}


struct InprojSched {
    UnitRange ur; const char* A; const char* Bt;
    DEVI bool next(int i, pg8::Unit& u) const {
        const int id = ur.lo + i * ur.step; if (id >= ur.hi) return false;
        const int tm = id / 7, tn = id % 7;
        u.a = A + (size_t)tm * 256 * D * 2; u.b = Bt + (size_t)tn * 256 * D * 2; u.x0 = tm * 256; u.x1 = tn * 256; u.x2 = 0; u.g = nullptr; u.gn = 0; return true;
    }
};
struct EpiInproj { static constexpr bool PERM = true; bf16_t* P;
    DEVI void operator()(const f32x4 (&acc)[2][2][4][2], const pg8::Unit& u, int wr, int wc, int fr, int fq) const {
#pragma unroll
        for (int ai = 0; ai < 2; ++ai)
#pragma unroll
            for (int m = 0; m < 4; ++m) { bf16_t* row = P + (size_t)(u.x0 + ai * 128 + wr * 64 + m * 16 + fr) * INC;
#pragma unroll
                for (int bj = 0; bj < 2; ++bj) { const int c = u.x1 + bj * 128 + wc * 32 + 8 * fq;
                    if (c < INC) { const f32x4 v0 = acc[ai][bj][m][0], v1 = acc[ai][bj][m][1];
                        u32x4 w; w.x = cvt_pk_bf16(v0[0], v0[1]); w.y = cvt_pk_bf16(v0[2], v0[3]); w.z = cvt_pk_bf16(v1[0], v1[1]); w.w = cvt_pk_bf16(v1[2], v1[3]);
                        *(u32x4*)(row + c) = w; } } }
    }
};
__device__ void phase_inproj(const Params& p, int l, char* lds) {
    float* const ws = (float*)(gfloat_t*)tab_ld(N_IN);
    const int tid = tid_(), bid = bid_(); (void)tid;
    InprojSched S; S.ur = unit_range((T / 256) * 7, bid); S.A = (const char*)(ws + W_HB); S.Bt = (const char*)((const bf16_t*)(ws + W_WIN) + (size_t)l * NPAD_IN * D);
    EpiInproj E; E.P = (bf16_t*)(ws + W_P);
    pg8::gemm_phase((PG8_LAS unsigned char*)lds, D, (size_t)128 * D * 2, S, E);
    { const int mine = (S.ur.hi - S.ur.lo + S.ur.step - 1) / S.ur.step, most = ((T / 256) * 7 / 8 + 1 + S.ur.step - 1) / S.ur.step;
      if (mine < most) conv_moe(p, l, 12); }
}

__device__ void phase_prep1(const Params& p, int l) {
    float* const ws = (float*)(gfloat_t*)tab_ld(N_IN);
    const float* const pin_I_CONVB = PIN(I_CONVB);
    const float* const pin_I_CONVW = PIN(I_CONVW);
    const float* const pin_I_KVAN = PIN(I_KVAN);
    const float* const pin_I_QAN = PIN(I_QAN);
    const float* const pin_I_SGB = PIN(I_SGB);
    const float* const pin_I_SGG = PIN(I_SGG);
    const int tid = tid_(), bid = bid_(); (void)tid; (void)bid;
    const int lane = tid & 63, gw = bid * (NTHR / 64) + __builtin_amdgcn_readfirstlane(tid >> 6), nw = gridDim.x * (NTHR / 64);
    float qan[3], kvan[2];
#pragma unroll
    for (int j = 0; j < 3; ++j) qan[j] = pin_I_QAN[l * 192 + j * 64 + lane];
#pragma unroll
    for (int j = 0; j < 2; ++j) kvan[j] = pin_I_KVAN[l * 128 + j * 64 + lane];
    const f32x4 sgg = *(const f32x4*)(pin_I_SGG + l * 256 + lane * 4), sgb = *(const f32x4*)(pin_I_SGB + l * 256 + lane * 4);
    const f32x4 cb = *(const f32x4*)(pin_I_CONVB + l * 256 + lane * 4);
    f32x4 cw[4];
#pragma unroll
    for (int k = 0; k < 4; ++k) cw[k] = *(const f32x4*)(pin_I_CONVW + (size_t)l * 4 * 256 + k * 256 + lane * 4);
    const int g = lane >> 4, w = 2 << g;
    const bf16_t* P = (const bf16_t*)(ws + W_P);
    for (int t = gw; t < T; t += nw) {
        const int s0 = (t < NLAT) ? 0 : NLAT, sl = (t < NLAT) ? NLAT : NCTX, n = t - s0;
        const bf16_t* pr = P + (size_t)t * INC;
        const int lo = max(n - w / 2, 0), hi = min(n + w / 2, sl);
        f32x4 pw[16];
#pragma unroll
        for (int j = 0; j < 16; ++j) { const int m = min(lo + j, hi - 1); pw[j] = ld4bf(P + (size_t)(s0 + m) * INC + OFF_A + lane * 4); }
        const f32x4 xa = ld4bf(pr + OFF_A + lane * 4);
        float qv[3], kvv[2];
#pragma unroll
        for (int j = 0; j < 3; ++j) qv[j] = bf2f(pr[OFF_Q + j * 64 + lane]);
#pragma unroll
        for (int j = 0; j < 2; ++j) kvv[j] = bf2f(pr[OFF_KV + j * 64 + lane]);
        const f32x4 zu = ld4bf(pr + OFF_C + lane * 4), zv = ld4bf(pr + OFF_C + 256 + lane * 4);
        f32x4 xc[4];
#pragma unroll
        for (int k = 0; k < 4; ++k) { const int m = min(max(n - 1 + k, 0), sl - 1); xc[k] = ld4bf(P + (size_t)(s0 + m) * INC + OFF_DX + lane * 4); }
        {   f32x4 sacc = (f32x4){0.f, 0.f, 0.f, 0.f};
#pragma unroll
            for (int j = 0; j < 16; ++j) sacc = sacc + ((lo + j < hi) ? pw[j] : (f32x4){0.f, 0.f, 0.f, 0.f});
            const float inv = 1.f / (float)(hi - lo);
            const f32x4 d = sacc * inv - xa;
            u32x2 o; o.x = cvt_pk_bf16(d[0], d[1]); o.y = cvt_pk_bf16(d[2], d[3]); *(u32x2*)((bf16_t*)(ws + W_DIFF) + (size_t)t * 256 + lane * 4) = o; }
        {   const float rq = rsqrtf(wave_sum(qv[0] * qv[0] + qv[1] * qv[1] + qv[2] * qv[2]) * (1.f / 192.f) + EPS);
#pragma unroll
            for (int j = 0; j < 3; ++j) ((bf16_t*)(ws + W_QN))[(size_t)t * 192 + j * 64 + lane] = f2bf(qv[j] * rq * qan[j]);
            const float rk = rsqrtf(wave_sum(kvv[0] * kvv[0] + kvv[1] * kvv[1]) * (1.f / 128.f) + EPS);
#pragma unroll
            for (int j = 0; j < 2; ++j) ((bf16_t*)(ws + W_KVN))[(size_t)t * 128 + j * 64 + lane] = f2bf(kvv[j] * rk * kvan[j]); }
        {   f32x4 u, gv;
#pragma unroll
            for (int j = 0; j < 4; ++j) { u[j] = gelu_tanh(zu[j]); gv[j] = gelu_tanh(zv[j]); }
            *(f32x4*)(ws + W_U + (size_t)t * 256 + lane * 4) = u;
            const float mu = wave_sum(gv[0] + gv[1] + gv[2] + gv[3]) * (1.f / 256.f);
            gv = gv - mu;
            const float rstd = rsqrtf(wave_sum(gv[0] * gv[0] + gv[1] * gv[1] + gv[2] * gv[2] + gv[3] * gv[3]) * (1.f / 256.f) + EPS);
            *(f32x4*)(ws + W_VN + (size_t)t * 256 + lane * 4) = gv * rstd * sgg + sgb; }
        {   f32x4 o = cb;
#pragma unroll
            for (int k = 0; k < 4; ++k) { const int m = n - 1 + k; if (m >= 0 && m < sl) o = o + xc[k] * cw[k]; }
            u32x2 ob; ob.x = cvt_pk_bf16(o[0], o[1]); ob.y = cvt_pk_bf16(o[2], o[3]); *(u32x2*)((bf16_t*)(ws + W_XCB) + (size_t)t * 256 + lane * 4) = ob; }
    }
}

__device__ void phase_small(const Params& p, int l, char* lds) {
    float* const ws = (float*)(gfloat_t*)tab_ld(N_IN);
    const float* const pin_I_BA = PIN(I_BA);
    const float* const pin_I_BX = PIN(I_BX);
    const float* const pin_I_POOLS = PIN(I_POOLS);
    const float* const pin_I_POOLW = PIN(I_POOLW);
    const float* const pin_I_SGBS = PIN(I_SGBS);
    const float* const pin_I_WA = PIN(I_WA);
    const float* const pin_I_WUKV = PIN(I_WUKV);
    const float* const pin_I_WUQ = PIN(I_WUQ);
    const float* const pin_I_WX = PIN(I_WX);
    const int tid = tid_(), bid = bid_(); (void)tid;
    constexpr int NK = 19, NU1 = (T / 256) * NK, NU2 = NCHUNK * 2;
    bf16_t* Y = (bf16_t*)(ws + W_YC);
    for (int u = bid; u < NU1 + NU2; u += gridDim.x) {
        if (u < NU1) {
            const int tm = u / NK, kind = u % NK, m0 = tm * 256;
            if (kind < 11) {
                const bf16_t* A; int lda, K, ldb, nval; const float* B;
                if (kind < 4) { A = (const bf16_t*)(ws + W_DIFF) + kind * 64; lda = 256; K = 64; B = pin_I_POOLW + (size_t)(l * 4 + kind) * 64 * 64; ldb = 64; nval = 64; }
                else if (kind < 7) { A = (const bf16_t*)(ws + W_QN); lda = 192; K = 192; B = pin_I_WUQ + (size_t)l * 192 * 384 + (kind - 4) * 128; ldb = 384; nval = 128; }
                else { A = (const bf16_t*)(ws + W_KVN); lda = 128; K = 128; B = pin_I_WUKV + (size_t)l * 128 * 512 + (kind - 7) * 128; ldb = 512; nval = 128; }
                gemm_unit<false>(lds, K, [&](int r) { return A + (size_t)(m0 + r) * lda; }, B, B, ldb, nval,
                    [&](const f32x4 (&acc)[4][4], int wr, int wc, int fr, int fq) {
#pragma unroll
                        for (int m = 0; m < 4; ++m) { const int t = m0 + wr * 64 + m * 16 + fr;
#pragma unroll
                            for (int n = 0; n < 4; ++n) { const int c = wc * 64 + n * 16 + 4 * fq;
                                if (kind < 4) { if (wc == 0) { const f32x4 sc = *(const f32x4*)(pin_I_POOLS + l * 256 + kind * 64 + c); const f32x4 v = acc[m][n] * sc;
                                        u32x2 w; w.x = cvt_pk_bf16(v[0], v[1]); w.y = cvt_pk_bf16(v[2], v[3]); *(u32x2*)(Y + (size_t)t * D + kind * 64 + c) = w; } }
                                else if (kind < 7) { const f32x4 v_ = acc[m][n]; u32x2 w_; w_.x = cvt_pk_bf16(v_[0], v_[1]); w_.y = cvt_pk_bf16(v_[2], v_[3]); *(u32x2*)((bf16_t*)(ws + W_QUP) + (size_t)t * 384 + (kind - 4) * 128 + c) = w_; }
                                else { const f32x4 v_ = acc[m][n]; u32x2 w_; w_.x = cvt_pk_bf16(v_[0], v_[1]); w_.y = cvt_pk_bf16(v_[2], v_[3]); *(u32x2*)((bf16_t*)(ws + W_KVUP) + (size_t)t * 512 + (kind - 7) * 128 + c) = w_; } } }
                    });
            } else {
                const int d = (kind - 11) >> 2, h = (kind - 11) & 3;
                const bf16_t* A = (const bf16_t*)(ws + W_XCB) + h * 64;
                const float* Ba = pin_I_WA + (size_t)((l * 2 + d) * 4 + h) * 64 * 64; const float* Bx = pin_I_WX + (size_t)((l * 2 + d) * 4 + h) * 64 * 64;
                const int pb = (l * 2 + d) * 256 + h * 64;
                gemm_unit<true>(lds, 64, [&](int r) { return A + (size_t)(m0 + r) * 256; }, Ba, Bx, 64, 64,
                    [&](const f32x4 (&acc)[4][4], int wr, int wc, int fr, int fq) {
                        const int sub = tm * 4 + wr;
                        const int lane16 = (fr == (d ? 0 : 15));
#pragma unroll
                        for (int pp = 0; pp < 2; ++pp) { const int idx = (wc * 2 + pp) * 16 + 4 * fq;
                            const f32x4 ba = *(const f32x4*)(pin_I_BA + pb + idx), bx = *(const f32x4*)(pin_I_BX + pb + idx), sp = *(const f32x4*)(ws + W_SP + pb + idx);
                            f32x4 Hc = (f32x4){0.f, 0.f, 0.f, 0.f}, Ac = (f32x4){1.f, 1.f, 1.f, 1.f};
#pragma unroll
                            for (int mm = 0; mm < 4; ++mm) { const int m = d ? 3 - mm : mm; const int t = m0 + wr * 64 + m * 16 + fr;
                                const f32x4 xv = ld4bf((const bf16_t*)(ws + W_XCB) + (size_t)t * 256 + h * 64 + idx);
                                f32x4 av, dv;
#pragma unroll
                                for (int j = 0; j < 4; ++j) { const float r = fsigm(acc[m][2 * pp][j] + ba[j]), ig = fsigm(acc[m][2 * pp + 1][j] + bx[j]);
                                    const float loga = -8.f * r * sp[j], x2 = 2.f * loga;
                                    const float om = (x2 > -0.0625f) ? -x2 * (1.f + x2 * (0.5f + x2 * (0.16666667f + x2 * 0.041666668f))) : 1.f - fexp(x2);
                                    float a_ = fexp(loga), b_ = __builtin_amdgcn_sqrtf(om) * (ig * xv[j]);
                                    if (d) scan16<true>(a_, b_); else scan16<false>(a_, b_);
                                    b_ = fmaf(a_, Hc[j], b_); a_ = a_ * Ac[j];
                                    av[j] = a_; dv[j] = b_; }
                                { const f32x4 v_ = av; u32x2 w_; w_.x = cvt_pk_bf16(v_[0], v_[1]); w_.y = cvt_pk_bf16(v_[2], v_[3]); *(u32x2*)((bf16_t*)(ws + W_LA2) + ((size_t)d * T + t) * 256 + h * 64 + idx) = w_; }
                                { const f32x4 v_ = dv; u32x2 w_; w_.x = cvt_pk_bf16(v_[0], v_[1]); w_.y = cvt_pk_bf16(v_[2], v_[3]); *(u32x2*)((bf16_t*)(ws + W_LB2) + ((size_t)d * T + t) * 256 + h * 64 + idx) = w_; }
                                const int src = ((fq << 4) | (d ? 0 : 15)) << 2;
#pragma unroll
                                for (int j = 0; j < 4; ++j) { Ac[j] = __int_as_float(__builtin_amdgcn_ds_bpermute(src, __float_as_int(av[j]))); Hc[j] = __int_as_float(__builtin_amdgcn_ds_bpermute(src, __float_as_int(dv[j]))); }
                            }
                            if (lane16) { *(f32x4*)(ws + W_AGG + ((size_t)(sub * 2 + d) * 2 + 0) * 256 + h * 64 + idx) = Ac; *(f32x4*)(ws + W_AGG + ((size_t)(sub * 2 + d) * 2 + 1) * 256 + h * 64 + idx) = Hc; }
                        }
                    });
            }
        } else {
            const int v = u - NU1, c = v >> 1, hp = v & 1;
            const bf16_t* A = (const bf16_t*)(ws + W_WSB) + ((size_t)l * 512 + hp * 256) * 128;
            const float* B = ws + W_VN + (size_t)c * 128 * 256 + hp * 128;
            gemm_unit<false>(lds, 128, [&](int r) { return A + (size_t)r * 128; }, B, B, 256, 128,
                [&](const f32x4 (&acc)[4][4], int wr, int wc, int fr, int fq) {
                    if ((wr >> 1) == wc) {
                        const int h = hp * 2 + wc;
#pragma unroll
                        for (int m = 0; m < 4; ++m) { const int pp = (wr & 1) * 64 + m * 16 + fr, t = c * 128 + pp; const float bs = pin_I_SGBS[(l * 4 + h) * 128 + pp];
#pragma unroll
                            for (int n = 0; n < 4; ++n) { const int ch = h * 64 + n * 16 + 4 * fq; const f32x4 uu = *(const f32x4*)(ws + W_U + (size_t)t * 256 + ch);
                                const f32x4 o = uu * (acc[m][n] + bs);
                                u32x2 w; w.x = cvt_pk_bf16(o[0], o[1]); w.y = cvt_pk_bf16(o[2], o[3]); *(u32x2*)(Y + (size_t)t * D + 512 + ch) = w; } }
                    }
                });
        }
    }
}

__device__ void phase_prep2(const Params& p, int l) {
    float* const ws = (float*)(gfloat_t*)tab_ld(N_IN);
    const float* const pin_I_KN = PIN(I_KN);
    const float* const pin_I_QN = PIN(I_QN);
    const int tid = tid_(), bid = bid_();
    const int lane = tid & 63, gw = bid * (NTHR / 64) + __builtin_amdgcn_readfirstlane(tid >> 6), nw = gridDim.x * (NTHR / 64);
    {
        const int h = lane >> 4, j = lane & 15;
        const f32x4 qw = *(const f32x4*)(pin_I_QN + l * 96 + 4 * j), kw = *(const f32x4*)(pin_I_KN + l * 96 + 4 * j);
        const float qw1 = pin_I_QN[l * 96 + 64 + j], qw2 = pin_I_QN[l * 96 + 80 + j], kw1 = pin_I_KN[l * 96 + 64 + j], kw2 = pin_I_KN[l * 96 + 80 + j];
        for (int t = gw; t < T; t += nw) {
            const bool lat = t < NLAT;
            float cs = 1.f, sn = 0.f;
            if (lat) { cs = ws[W_ROPE + (size_t)t * 32 + j]; sn = ws[W_ROPE + (size_t)t * 32 + 16 + j]; }
            const bf16_t* qr = (const bf16_t*)(ws + W_QUP) + (size_t)t * 384 + h * 96; const bf16_t* kr = (const bf16_t*)(ws + W_KVUP) + (size_t)t * 512 + h * 128; const bf16_t* pr = (const bf16_t*)(ws + W_P) + (size_t)t * INC + OFF_KR;
            f32x4 qn = ld4bf(qr + 4 * j); float q1 = bf2f(qr[64 + j]), q2 = bf2f(qr[80 + j]);
            f32x4 kn = ld4bf(kr + 4 * j); float k1 = bf2f(pr[j]), k2 = bf2f(pr[16 + j]);
            const u32x2 vraw = *(const u32x2*)(kr + 64 + 4 * j);
            float sq = qn[0] * qn[0] + qn[1] * qn[1] + qn[2] * qn[2] + qn[3] * qn[3] + q1 * q1 + q2 * q2;
            float sk = kn[0] * kn[0] + kn[1] * kn[1] + kn[2] * kn[2] + kn[3] * kn[3] + k1 * k1 + k2 * k2;
#pragma unroll
            for (int o = 1; o < 16; o <<= 1) { sq += __shfl_xor(sq, o); sk += __shfl_xor(sk, o); }
            const float rq = rsqrtf(sq * (1.f / 96.f) + EPS), rk = rsqrtf(sk * (1.f / 96.f) + EPS);
            qn = qn * qw * rq; q1 *= qw1 * rq; q2 *= qw2 * rq; kn = kn * kw * rk; k1 *= kw1 * rk; k2 *= kw2 * rk;
            const float qa = q1 * cs - q2 * sn, qb = q1 * sn + q2 * cs, ka = k1 * cs - k2 * sn, kb = k1 * sn + k2 * cs;
            bf16_t* qo = (bf16_t*)(ws + W_Q) + ((size_t)h * T + t) * 96; bf16_t* ko = (bf16_t*)(ws + W_K) + ((size_t)h * T + t) * 96; bf16_t* vo = (bf16_t*)(ws + W_V) + ((size_t)h * T + t) * 64;
            { u32x2 w; w.x = cvt_pk_bf16(qn[0], qn[1]); w.y = cvt_pk_bf16(qn[2], qn[3]); *(u32x2*)(qo + 4 * j) = w; qo[64 + j] = f2bf(qa); qo[80 + j] = f2bf(qb); }
            { u32x2 w; w.x = cvt_pk_bf16(kn[0], kn[1]); w.y = cvt_pk_bf16(kn[2], kn[3]); *(u32x2*)(ko + 4 * j) = w; ko[64 + j] = f2bf(ka); ko[80 + j] = f2bf(kb); }
            *(u32x2*)(vo + 4 * j) = vraw;
        }
    }
    for (int chain = gw; chain < 512; chain += nw) {
        const int d = chain >> 8, ch = chain & 255;
        const float* ag = ws + W_AGG + (size_t)d * 512 + ch;
        float* cr = ws + W_CARRY + (size_t)d * 256 + ch;
        float run = 0.f;
        for (int k0 = 0; k0 < NSUB; k0 += 64) {
            const int k = k0 + lane; const bool valid = k < NSUB;
            const int q = d ? (NSUB - 1 - k) : (k < 4 ? 256 + k : k - 4);
            float a = 1.f, b = 0.f;
            if (valid) { a = ag[(size_t)q * 1024]; b = ag[(size_t)q * 1024 + 256]; }
#pragma unroll
            for (int o = 1; o < 64; o <<= 1) { const float pa = __shfl_up(a, o), pb = __shfl_up(b, o); if (lane >= o) { b = fmaf(a, pb, b); a = a * pa; } }
            float ea = __shfl_up(a, 1), eb = __shfl_up(b, 1); if (lane == 0) { ea = 1.f; eb = 0.f; }
            if (valid) cr[(size_t)q * 512] = fmaf(ea, run, eb);
            const float ta = __shfl(a, 63), tb = __shfl(b, 63);
            run = fmaf(ta, run, tb);
        }
    }
}


__device__ void phase_attn(const Params& p, int l, char* lds) {
    float* const ws = (float*)(gfloat_t*)tab_ld(N_IN);
    const int tid = tid_(), bid = bid_(); (void)tid;
    const bf16_t* Qb = (const bf16_t*)(ws + W_Q); const bf16_t* Kb = (const bf16_t*)(ws + W_K); const bf16_t* Vb = (const bf16_t*)(ws + W_V);
    bf16_t* Y = (bf16_t*)(ws + W_YC);
    const int nunits = (l == 0) ? 260 : 256;
    for (int u = bid; u < nunits; u += gridDim.x) {
        int h, t0, k0, seq;
        if (u < 256) { h = (u & 7) >> 1; t0 = (((u >> 3) << 1) | (u & 1)) * 256; k0 = 0; seq = T; }
        else { h = u - 256; t0 = NLAT; k0 = NLAT; seq = NCTX; }
        att::attn_unit(Qb + ((size_t)h * T + t0) * 96, Kb + ((size_t)h * T + k0) * 96, Vb + ((size_t)h * T + k0) * 64, seq, Y + (size_t)t0 * D + 256 + h * 64, D, lds);
    }
}

__device__ void phase_lru_fin(const Params& p, char* lds) {
    float* const ws = (float*)(gfloat_t*)tab_ld(N_IN);
    const int tid = tid_(), bid = bid_();
    float* carry = (float*)lds;
    for (int sub = bid; sub < NSUB; sub += gridDim.x) {
        carry[tid] = ws[W_CARRY + (size_t)sub * 512 + tid];
        __syncthreads();
        for (int i = tid; i < 64 * 64; i += NTHR) {
            const int t = sub * 64 + (i >> 6), ch = (i & 63) * 4;
            const bf16_t* la = (const bf16_t*)(ws + W_LA2); const bf16_t* lb = (const bf16_t*)(ws + W_LB2);
            f32x4 hs = ld4bf(lb + (size_t)t * 256 + ch) + ld4bf(la + (size_t)t * 256 + ch) * *(const f32x4*)(carry + ch);
            hs = hs + ld4bf(lb + ((size_t)T + t) * 256 + ch) + ld4bf(la + ((size_t)T + t) * 256 + ch) * *(const f32x4*)(carry + 256 + ch);
            const f32x4 g = ld4bf((const bf16_t*)(ws + W_P) + (size_t)t * INC + OFF_DG + ch);
            u32x2 w; w.x = cvt_pk_bf16(gelu_tanh(g[0]) * hs[0], gelu_tanh(g[1]) * hs[1]); w.y = cvt_pk_bf16(gelu_tanh(g[2]) * hs[2], gelu_tanh(g[3]) * hs[3]);
            *(u32x2*)((bf16_t*)(ws + W_YC) + (size_t)t * D + 768 + ch) = w;
        }
        __syncthreads();
    }
}

struct OutprojSched {
    UnitRange ur; const char* A; const char* Bt;
    DEVI bool next(int i, pg8::Unit& u) const {
        const int id = ur.lo + i * ur.step; if (id >= ur.hi) return false;
        const int tm = id >> 2, tn = id & 3;
        u.a = A + (size_t)tm * 256 * D * 2; u.b = Bt + (size_t)tn * 256 * D * 2; u.x0 = tm * 256; u.x1 = tn * 256; u.x2 = 0; u.g = nullptr; u.gn = 0; return true;
    }
};
struct EpiOutproj { static constexpr bool PERM = false; float* X; const float* Xin; const float* modv;
    DEVI void operator()(const f32x4 (&acc)[2][2][4][2], const pg8::Unit& u, int wr, int wc, int fr, int fq) const {
        const float* g1 = modv + (u.x0 >= NLAT ? 6144 : 0) + 2 * D;
#pragma unroll
        for (int ai = 0; ai < 2; ++ai)
#pragma unroll
            for (int m = 0; m < 4; ++m) { const size_t ro = (size_t)(u.x0 + ai * 128 + wr * 64 + m * 16 + fr) * D; float* row = X + ro; const float* rin = Xin + ro;
#pragma unroll
                for (int bj = 0; bj < 2; ++bj)
#pragma unroll
                    for (int n = 0; n < 2; ++n) { const int c = u.x1 + bj * 128 + wc * 32 + n * 16 + 4 * fq; const f32x4 g = *(const f32x4*)(g1 + c); f32x4 x = *(const f32x4*)(rin + c);
                        x = x + g * acc[ai][bj][m][n]; *(f32x4*)(row + c) = x; } }
    }
};
struct CtxSplitSched {
    int first, step; const char* A; const char* Bt;
    DEVI bool next(int i, pg8::Unit& u) const {
        const int id = first + i * step; if (id >= 16) return false;
        const int tn = id >> 2, ks = id & 3;
        u.a = A + (size_t)NLAT * D * 2 + (size_t)ks * 256 * 2; u.b = Bt + (size_t)tn * 256 * D * 2 + (size_t)ks * 256 * 2; u.x0 = ks; u.x1 = tn * 256; u.x2 = 0; u.g = nullptr; u.gn = 0; return true;
    }
};
struct EpiCtxPart { static constexpr bool PERM = false; float* PART; const float* g1;
    DEVI void operator()(const f32x4 (&acc)[2][2][4][2], const pg8::Unit& u, int wr, int wc, int fr, int fq) const {
#pragma unroll
        for (int ai = 0; ai < 2; ++ai)
#pragma unroll
            for (int m = 0; m < 4; ++m) { float* row = PART + ((size_t)u.x0 * NCTX + ai * 128 + wr * 64 + m * 16 + fr) * D;
#pragma unroll
                for (int bj = 0; bj < 2; ++bj)
#pragma unroll
                    for (int n = 0; n < 2; ++n) { const int c = u.x1 + bj * 128 + wc * 32 + n * 16 + 4 * fq; *(f32x4*)(row + c) = *(const f32x4*)(g1 + c) * acc[ai][bj][m][n]; } }
    }
};
__device__ void phase_outproj(const Params& p, int l, char* lds) {
    float* const ws = (float*)(gfloat_t*)tab_ld(N_IN);
    const int tid = tid_(), bid = bid_(); (void)tid;
    OutprojSched S; S.ur = unit_range((NLAT / 256) * 4, bid); S.A = (const char*)(ws + W_YC); S.Bt = (const char*)((const bf16_t*)(ws + W_WOUT) + (size_t)l * D * D);
    EpiOutproj E; E.X = ws + W_X; E.Xin = (l == 0) ? PIN(I_X) : (const float*)(ws + W_X); E.modv = ws + W_MOD + (size_t)l * 2 * 6144;
    pg8::gemm_phase((PG8_LAS unsigned char*)lds, D, (size_t)128 * D * 2, S, E);
    if (l < NLAYER - 1) {
        CtxSplitSched S2; S2.first = bid; S2.step = gridDim.x; S2.A = S.A; S2.Bt = S.Bt;
        EpiCtxPart E2; E2.PART = ws + W_PART; E2.g1 = ws + W_MOD + (size_t)(l * 2 + 1) * 6144 + 2 * D;
        pg8::gemm_phase((PG8_LAS unsigned char*)lds, D, (size_t)128 * D * 2, S2, E2, 4);
    }
}

constexpr int R_LDS = 1024 * 36 * 4;
__device__ void phase_router(const Params& p, int l, char* lds) {
    float* const ws = (float*)(gfloat_t*)tab_ld(N_IN);
    const float* const pin_I_NFFN = PIN(I_NFFN);
    const float* const pin_I_RB = PIN(I_RB);
    const float* const pin_I_RW = PIN(I_RW);
    const int tid = tid_(), bid = bid_();
    float* wl = (float*)lds;
    int* hist = (int*)(lds + R_LDS); int* bbase = hist + 32; int* tinfo = hist + 64 + (tid >> 6) * 40;
    __attribute__((address_space(3))) float* wsc = (__attribute__((address_space(3))) float*)((__attribute__((address_space(3))) char*)g_lds + RSC_OFF) + (tid >> 6) * 96;
    if (tid < 32) hist[tid] = 0;
    {   const float* rw = pin_I_RW + (size_t)l * D * NEXP;
        for (int i = tid; i < 1024 * 8; i += NTHR) { const int k = i >> 3, e4 = i & 7; *(f32x4*)(wl + k * 36 + e4 * 4) = *(const f32x4*)(rw + k * 32 + e4 * 4); }
    }
    __syncthreads();
    const int lane = tid & 63, gw = bid * (NTHR / 64) + __builtin_amdgcn_readfirstlane(tid >> 6), nw = gridDim.x * (NTHR / 64);
    const float* g = pin_I_NFFN + l * D;
    int* cnt = (int*)(ws + W_CNT) + l * NEXP * 64;
    bf16_t* HB = (bf16_t*)(ws + W_HB);
    const int e = lane >> 1;
    const float rb = pin_I_RB[l * NEXP + e];
    const int TL = (l == NLAYER - 1) ? NLAT : T;
    int ti = 0;
    for (int t0 = gw; t0 < TL; t0 += 2 * nw, ti += 2) {
        const int t1 = t0 + nw; const bool v1 = t1 < TL; const int t1c = v1 ? t1 : t0;
        const float* mod = ws + W_MOD + (size_t)(l * 2 + (t0 >= NLAT ? 1 : 0)) * 6144;
        float f0[16], f1[16]; float ss0 = 0.f, ss1 = 0.f;
#pragma unroll
        for (int m = 0; m < 16; ++m) { f0[m] = ws[W_X + (size_t)t0 * D + lane + 64 * m]; f1[m] = ws[W_X + (size_t)t1c * D + lane + 64 * m]; }
        if (t0 >= NLAT) {
#pragma unroll
            for (int m = 0; m < 16; ++m) { const size_t o0 = (size_t)(t0 - NLAT) * D + lane + 64 * m, o1 = (size_t)(t1c - NLAT) * D + lane + 64 * m;
#pragma unroll
                for (int ks = 0; ks < 4; ++ks) { f0[m] += ws[W_PART + (size_t)ks * NCTX * D + o0]; f1[m] += ws[W_PART + (size_t)ks * NCTX * D + o1]; }
                ws[W_X + (size_t)t0 * D + lane + 64 * m] = f0[m]; if (v1) ws[W_X + (size_t)t1 * D + lane + 64 * m] = f1[m]; }
        }
#pragma unroll
        for (int m = 0; m < 16; ++m) { ss0 = fmaf(f0[m], f0[m], ss0); ss1 = fmaf(f1[m], f1[m], ss1); }
#pragma unroll
        for (int o = 32; o > 0; o >>= 1) { ss0 += __shfl_xor(ss0, o); ss1 += __shfl_xor(ss1, o); }
        const float r0 = rsqrtf(ss0 * (1.f / D) + EPS), r1 = rsqrtf(ss1 * (1.f / D) + EPS);
#pragma unroll
        for (int m = 0; m < 16; ++m) { const int k = lane + 64 * m; const float gkm = g[k] * (1.f + mod[4 * D + k]), shm = mod[3 * D + k]; f0[m] = f0[m] * r0 * gkm + shm; f1[m] = f1[m] * r1 * gkm + shm;
            HB[(size_t)t0 * D + k] = f2bf(f0[m]); if (v1) HB[(size_t)t1 * D + k] = f2bf(f1[m]); }
        float acc0[32], acc1[32];
#pragma unroll
        for (int j = 0; j < 32; ++j) { acc0[j] = 0.f; acc1[j] = 0.f; }
#pragma unroll
        for (int m = 0; m < 16; ++m) {
            const float* wr = wl + (lane + 64 * m) * 36;
#pragma unroll
            for (int e4 = 0; e4 < 8; ++e4) { const f32x4 w4 = *(const f32x4*)(wr + e4 * 4);
#pragma unroll
                for (int j = 0; j < 4; ++j) { acc0[e4 * 4 + j] = fmaf(f0[m], w4[j], acc0[e4 * 4 + j]); acc1[e4 * 4 + j] = fmaf(f1[m], w4[j], acc1[e4 * 4 + j]); } }
            __builtin_amdgcn_sched_barrier(0);
        }
#define RS_STEP(W_, MSK_) do { const bool up = (lane & (MSK_)) != 0; \
            _Pragma("unroll") for (int j = 0; j < (W_); ++j) { const float s0_ = up ? acc0[j] : acc0[j + (W_)], k0_ = up ? acc0[j + (W_)] : acc0[j]; acc0[j] = k0_ + __shfl_xor(s0_, (MSK_)); \
                const float s1_ = up ? acc1[j] : acc1[j + (W_)], k1_ = up ? acc1[j + (W_)] : acc1[j]; acc1[j] = k1_ + __shfl_xor(s1_, (MSK_)); } } while (0)
        RS_STEP(16, 32); RS_STEP(8, 16); RS_STEP(4, 8); RS_STEP(2, 4); RS_STEP(1, 2);
#undef RS_STEP
        const float a0 = acc0[0] + __shfl_xor(acc0[0], 1) + rb, a1 = acc1[0] + __shfl_xor(acc1[0], 1) + rb;
        if ((lane & 1) == 0) { wsc[e] = a0; wsc[48 + e] = a1; }
        asm volatile("s_waitcnt lgkmcnt(0)" ::: "memory"); __builtin_amdgcn_wave_barrier();
        int rank0 = 0, rank1 = 0;
#pragma unroll
        for (int q = 0; q < 8; ++q) { const f32x4 x0 = *(const volatile __attribute__((address_space(3))) f32x4*)(wsc + 4 * q), x1 = *(const volatile __attribute__((address_space(3))) f32x4*)(wsc + 48 + 4 * q);
#pragma unroll
            for (int j = 0; j < 4; ++j) { const int eo = 4 * q + j;
                rank0 += (x0[j] > a0 || (x0[j] == a0 && eo < e)) ? 1 : 0; rank1 += (x1[j] > a1 || (x1[j] == a1 && eo < e)) ? 1 : 0; } }
        if ((lane & 1) == 0) {
            if (rank0 < 4) { ((__attribute__((address_space(3))) int*)wsc)[32 + rank0] = e; wsc[36 + rank0] = a0; }
            if (rank1 < 4) { ((__attribute__((address_space(3))) int*)wsc)[80 + rank1] = e; wsc[84 + rank1] = a1; }
        }
        asm volatile("s_waitcnt lgkmcnt(0)" ::: "memory"); __builtin_amdgcn_wave_barrier();
        if (lane < 8 && (lane < 4 || v1)) {
            const int u = lane >> 2, k = lane & 3, tt = u ? t1 : t0;
            const volatile __attribute__((address_space(3))) float* sv = wsc + u * 48;
            const float mx = sv[36];
            const float sm = expf(sv[36] - mx) + expf(sv[37] - mx) + expf(sv[38] - mx) + expf(sv[39] - mx);
            const int ee = ((const volatile __attribute__((address_space(3))) int*)sv)[32 + k]; const float eg = expf(sv[36 + k] - mx);
            const int lidx = atomicAdd(&hist[ee], 1);
            tinfo[(ti + u) * 4 + k] = (ee << 16) | lidx;
            ((int*)(ws + W_TOPE))[tt * 4 + k] = ee;
            ws[W_TOPG + tt * 4 + k] = eg / sm;
        }
        __builtin_amdgcn_wave_barrier();
    }
    __syncthreads();
    if (tid < 32) bbase[tid] = atomicAdd(&cnt[tid * 64], hist[tid]);
    __syncthreads();
    ti = 0;
    for (int t = gw; t < TL; t += nw, ++ti)
        if (lane < 4) { const int v = tinfo[ti * 4 + lane]; const int slot = bbase[v >> 16] + (v & 0xffff);
            ((int*)(ws + W_TOPI))[t * 4 + lane] = slot; ((int*)(ws + W_XS))[(size_t)(v >> 16) * T + slot] = t; }
    __syncthreads();
    conv_moe(p, l, 0);
}

DEVI void moe_bases(const Params& p, int l, int* sb) {
    float* const ws = (float*)(gfloat_t*)tab_ld(N_IN);
    const int tid = tid_();
    if (tid == 0) {
        const int* cnt = (const int*)(ws + W_CNT) + l * NEXP * 64;
        int b = 0, tb = 0;
        for (int e = 0; e < NEXP; ++e) { sb[e] = b; sb[40 + e] = tb; const int c = cnt[e * 64]; sb[80 + e] = c; const int mt = (c + 255) / 256; b += mt * 256; tb += mt; }
        sb[32] = b; sb[72] = tb;
    }
    __syncthreads();
}


struct MoeSched {
    UnitRange ur; const int* sb; int ntn; const char* A; const char* Bt; size_t bstride_e, bstride_tn, arow; const int* lists;
    DEVI bool next(int i, pg8::Unit& u) const {
        const int id = ur.lo + i * ur.step; if (id >= ur.hi) return false;
        int e = 0; while (e < NEXP - 1 && sb[40 + e + 1] * ntn <= id) ++e;
        const int mts = sb[40 + e + 1] - sb[40 + e], loc = id - sb[40 + e] * ntn, tng = loc / (mts * 4), rr = loc % (mts * 4), mt = rr >> 2, tn = tng * 4 + (rr & 3);
        const int r0 = __builtin_amdgcn_readfirstlane(sb[e] + mt * 256), tn_s = __builtin_amdgcn_readfirstlane(tn), e_s = __builtin_amdgcn_readfirstlane(e);
        u.a = A + (size_t)r0 * arow; u.b = Bt + (size_t)e_s * bstride_e + (size_t)tn_s * bstride_tn; u.x0 = r0; u.x1 = tn_s; u.x2 = e_s;
        const int mt_s = __builtin_amdgcn_readfirstlane(mt), cnt_s = __builtin_amdgcn_readfirstlane(sb[80 + e]);
        u.g = lists ? lists + (size_t)e_s * T + mt_s * 256 : nullptr; u.gn = cnt_s - mt_s * 256 < 256 ? cnt_s - mt_s * 256 : 256; return true;
    }
};
struct EpiMoe1 { static constexpr bool PERM = true; unsigned char* ACT; const float* bias;
    DEVI void operator()(const f32x4 (&acc)[2][2][4][2], const pg8::Unit& u, int wr, int wc, int fr, int fq) const {
        const int c0 = u.x1 * 128 + wc * 32 + 8 * fq;
        const float* bg = bias + (size_t)u.x2 * 2048 + c0; const float* bu = bg + 1024;
        f32x4 vg[2], vu[2];
#pragma unroll
        for (int n = 0; n < 2; ++n) { vg[n] = *(const f32x4*)(bg + 4 * n); vu[n] = *(const f32x4*)(bu + 4 * n); }
#pragma unroll
        for (int ai = 0; ai < 2; ++ai)
#pragma unroll
            for (int m = 0; m < 4; ++m) { unsigned char* rowp = ACT + (size_t)(u.x0 + ai * 128 + wr * 64 + m * 16 + fr) * D + c0;
                float a[8];
#pragma unroll
                for (int n = 0; n < 2; ++n)
#pragma unroll
                    for (int j = 0; j < 4; ++j) { float g = acc[ai][0][m][n][j] + vg[n][j], uu = acc[ai][1][m][n][j] + vu[n][j];
                        g = fminf(g, 7.f); uu = fminf(fmaxf(uu, -7.f), 7.f); a[n * 4 + j] = (uu + 1.f) * (g * sigm(1.702f * g)) * A8_SCALE; }
                u32x2 w; w.x = pk_fp8x4(a[0], a[1], a[2], a[3]); w.y = pk_fp8x4(a[4], a[5], a[6], a[7]);
                *(u32x2*)rowp = w; }
    }
};
__device__ void phase_moe1(const Params& p, int l, char* lds) {
    float* const ws = (float*)(gfloat_t*)tab_ld(N_IN);
    const float* const pin_I_BGU = PIN(I_BGU);
    const int tid = tid_(), bid = bid_(); (void)tid;
    int* sb = (int*)(lds + pg8::STAGE_BYTES);
    moe_bases(p, l, sb);
    MoeSched S; S.sb = sb; S.ntn = 8; S.ur = unit_range(sb[72] * 8, bid); S.A = (const char*)(ws + W_HB); S.arow = (size_t)D * 2; S.lists = (const int*)(ws + W_XS);
    S.Bt = (const char*)((const bf16_t*)(ws + W_WGU) + (size_t)l * NEXP * 2048 * D); S.bstride_e = (size_t)2048 * D * 2; S.bstride_tn = (size_t)128 * D * 2;
    EpiMoe1 E; E.ACT = (unsigned char*)(ws + W_ACT); E.bias = pin_I_BGU + (size_t)l * NEXP * 2048;
    pg8::gemm_phase<EpiMoe1, MoeSched, true>((PG8_LAS unsigned char*)lds, D, (size_t)1024 * D * 2, S, E, 0, (const char*)(ws + W_HB));
    __syncthreads();
}

struct EpiMoe2 { static constexpr bool PERM = true; bf16_t* YR; const float* bias;
    DEVI void operator()(const f32x4 (&acc)[2][2][4][2], const pg8::Unit& u, int wr, int wc, int fr, int fq) const {
        const int c0 = u.x1 * 256 + wc * 32 + 8 * fq;
        const float* bb = bias + (size_t)u.x2 * D + c0;
        f32x4 bv[2][2];
#pragma unroll
        for (int bj = 0; bj < 2; ++bj)
#pragma unroll
            for (int n = 0; n < 2; ++n) bv[bj][n] = *(const f32x4*)(bb + bj * 128 + 4 * n);
#pragma unroll
        for (int ai = 0; ai < 2; ++ai)
#pragma unroll
            for (int m = 0; m < 4; ++m) { bf16_t* rowp = YR + (size_t)(u.x0 + ai * 128 + wr * 64 + m * 16 + fr) * D + c0;
#pragma unroll
                for (int bj = 0; bj < 2; ++bj) { const f32x4 v0 = acc[ai][bj][m][0] * INV8 + bv[bj][0], v1 = acc[ai][bj][m][1] * INV8 + bv[bj][1];
                    u32x4 w; w.x = cvt_pk_bf16(v0[0], v0[1]); w.y = cvt_pk_bf16(v0[2], v0[3]); w.z = cvt_pk_bf16(v1[0], v1[1]); w.w = cvt_pk_bf16(v1[2], v1[3]);
                    *(u32x4*)(rowp + bj * 128) = w; } }
    }
};
__device__ void phase_moe2(const Params& p, int l, char* lds) {
    float* const ws = (float*)(gfloat_t*)tab_ld(N_IN);
    const float* const pin_I_BDN = PIN(I_BDN);
    const int tid = tid_(), bid = bid_(); (void)tid;
    int* sb = (int*)(lds + pg8::STAGE_BYTES);
    moe_bases(p, l, sb);
    MoeSched S; S.sb = sb; S.ntn = 4; S.ur = unit_range(sb[72] * 4, bid); S.A = (const char*)(ws + W_ACT); S.arow = (size_t)D; S.lists = nullptr;
    S.Bt = (const char*)(ws + W_WDN) + (size_t)l * NEXP * D * D; S.bstride_e = (size_t)D * D; S.bstride_tn = (size_t)256 * D;
    EpiMoe2 E; E.YR = (bf16_t*)(ws + W_YR); E.bias = pin_I_BDN + (size_t)l * NEXP * D;
    pg8::gemm_phase<EpiMoe2, MoeSched, false, true>((PG8_LAS unsigned char*)lds, D / 2, (size_t)128 * D, S, E);
    __syncthreads();
}

DEVI void norm1_store8(float* ws, const float* g, int l, int t, int lane, const float (&v)[2][8]) {
    const float* mod = ws + W_MOD + (size_t)(l * 2 + (t >= NLAT ? 1 : 0)) * 6144;
    float ss = 0.f;
#pragma unroll
    for (int jj = 0; jj < 2; ++jj)
#pragma unroll
        for (int i = 0; i < 8; ++i) ss = fmaf(v[jj][i], v[jj][i], ss);
    const float rstd = rsqrtf(wave_sum(ss) * (1.f / D) + EPS);
    bf16_t* hb = (bf16_t*)(ws + W_HB) + (size_t)t * D;
#pragma unroll
    for (int jj = 0; jj < 2; ++jj) {
        const int c = jj * 512 + lane * 8;
        float o[8];
#pragma unroll
        for (int q = 0; q < 2; ++q) { const f32x4 gg = *(const f32x4*)(g + c + 4 * q), s1 = *(const f32x4*)(mod + D + c + 4 * q), s0 = *(const f32x4*)(mod + c + 4 * q);
#pragma unroll
            for (int i = 0; i < 4; ++i) o[4 * q + i] = v[jj][4 * q + i] * rstd * gg[i] * (1.f + s1[i]) + s0[i]; }
        u32x4 w; w.x = cvt_pk_bf16(o[0], o[1]); w.y = cvt_pk_bf16(o[2], o[3]); w.z = cvt_pk_bf16(o[4], o[5]); w.w = cvt_pk_bf16(o[6], o[7]);
        *(u32x4*)(hb + c) = w;
    }
}
__device__ void phase_combine(const Params& p, int l, char* lds, bool last) {
    float* const ws = (float*)(gfloat_t*)tab_ld(N_IN);
    float* const pout = (float*)(gfloat_t*)tab_ld(N_IN + 1);
    const float* const pin_I_NMIX = PIN(I_NMIX);
    const int tid = tid_(), bid = bid_();
    const bf16_t* YR = (const bf16_t*)(ws + W_YR);
    int* sb = (int*)(lds + G_LDS);
    moe_bases(p, l, sb);
    const int lane = tid & 63, gw = bid * (NTHR / 64) + __builtin_amdgcn_readfirstlane(tid >> 6), nw = gridDim.x * (NTHR / 64);
    const int TL = last ? NLAT : T;
    const float* gn = pin_I_NMIX + (last ? 0 : (l + 1) * D);
    for (int t0 = gw; t0 < TL; t0 += 2 * nw) {
        const int t1 = t0 + nw; const bool v1 = t1 < TL; const int t1c = v1 ? t1 : t0;
        const float* g2 = ws + W_MOD + (size_t)(l * 2 + (t0 >= NLAT ? 1 : 0)) * 6144 + 5 * D;
        const bf16_t* ya[4]; const bf16_t* yb[4]; float ga[4], gb[4];
#pragma unroll
        for (int k = 0; k < 4; ++k) { ya[k] = YR + (size_t)(sb[((const int*)(ws + W_TOPE))[t0 * 4 + k]] + ((const int*)(ws + W_TOPI))[t0 * 4 + k]) * D; ga[k] = ws[W_TOPG + t0 * 4 + k];
                                      yb[k] = YR + (size_t)(sb[((const int*)(ws + W_TOPE))[t1c * 4 + k]] + ((const int*)(ws + W_TOPI))[t1c * 4 + k]) * D; gb[k] = ws[W_TOPG + t1c * 4 + k]; }
        float* xa = ws + W_X + (size_t)t0 * D; float* xb = ws + W_X + (size_t)t1c * D;
        float ra[2][8], rb[2][8];
#pragma unroll
        for (int jj = 0; jj < 2; ++jj) {
            const int c = jj * 512 + lane * 8;
            u32x4 ua[4], ub[4];
#pragma unroll
            for (int k = 0; k < 4; ++k) { ua[k] = *(const u32x4*)(ya[k] + c); ub[k] = *(const u32x4*)(yb[k] + c); }
            const f32x4 xa0 = *(const f32x4*)(xa + c), xa1 = *(const f32x4*)(xa + c + 4), xb0 = *(const f32x4*)(xb + c), xb1 = *(const f32x4*)(xb + c + 4);
            const f32x4 gg0 = *(const f32x4*)(g2 + c), gg1 = *(const f32x4*)(g2 + c + 4);
            float a[8], b[8];
#pragma unroll
            for (int i = 0; i < 8; ++i) { a[i] = 0.f; b[i] = 0.f; }
#pragma unroll
            for (int k = 0; k < 4; ++k)
#pragma unroll
                for (int q = 0; q < 4; ++q) { const unsigned wa = ua[k][q], wb = ub[k][q];
                    a[2 * q] = fmaf(ga[k], __uint_as_float(wa << 16), a[2 * q]); a[2 * q + 1] = fmaf(ga[k], __uint_as_float(wa & 0xffff0000u), a[2 * q + 1]);
                    b[2 * q] = fmaf(gb[k], __uint_as_float(wb << 16), b[2 * q]); b[2 * q + 1] = fmaf(gb[k], __uint_as_float(wb & 0xffff0000u), b[2 * q + 1]); }
#pragma unroll
            for (int i = 0; i < 4; ++i) { ra[jj][i] = fmaf(gg0[i], a[i], xa0[i]); ra[jj][4 + i] = fmaf(gg1[i], a[4 + i], xa1[i]); rb[jj][i] = fmaf(gg0[i], b[i], xb0[i]); rb[jj][4 + i] = fmaf(gg1[i], b[4 + i], xb1[i]); }
            float* da = last ? pout + (size_t)t0 * D + c : xa + c; float* db = last ? pout + (size_t)t1c * D + c : xb + c;
            *(f32x4*)da = (f32x4){ra[jj][0], ra[jj][1], ra[jj][2], ra[jj][3]}; *(f32x4*)(da + 4) = (f32x4){ra[jj][4], ra[jj][5], ra[jj][6], ra[jj][7]};
            if (v1) { *(f32x4*)db = (f32x4){rb[jj][0], rb[jj][1], rb[jj][2], rb[jj][3]}; *(f32x4*)(db + 4) = (f32x4){rb[jj][4], rb[jj][5], rb[jj][6], rb[jj][7]}; }
        }
        if (!last) { norm1_store8(ws, gn, l + 1, t0, lane, ra); if (v1) norm1_store8(ws, gn, l + 1, t1, lane, rb); }
    }
}

constexpr int XST_OFF = R_LDS + 2048 - 16, STAMP_OFF = R_LDS + 2048 - 16 - 256;
constexpr int LDS_BYTES = RSC_OFF + 8 * 96 * 4;

#define XB_TMO      128
#define XB_XCNT(j)  (256  + 64 * (j))
#define XB_XSUB(j)  (1280 + 64 * (j))
#define XB_XGEN(j)  (2304 + 64 * (j))
#define XB_TOP      3328
#define XB_TOPGEN   3392
#define XCD_BAR_WORDS 3456
#define XB_SPIN_CAP (1u << 18)
#define LAS __attribute__((address_space(3)))
__device__ __forceinline__ unsigned xb_ld(unsigned* p)              { return __hip_atomic_load(p, __ATOMIC_RELAXED, __HIP_MEMORY_SCOPE_AGENT); }
__device__ __forceinline__ unsigned xb_add(unsigned* p, unsigned v) { return __hip_atomic_fetch_add(p, v, __ATOMIC_RELAXED, __HIP_MEMORY_SCOPE_AGENT); }
__device__ __forceinline__ unsigned xb_xcc_id() { return (unsigned)__builtin_amdgcn_s_getreg((3 << 11) | 20) & 0xFu; }
#define XB_SPIN(cond, bar) do { unsigned _sp = 0; while (cond) { __builtin_amdgcn_s_sleep(1); \
    if ((++_sp & 255u) == 0u) { if (xb_ld(&(bar)[XB_TMO])) break; if (_sp > XB_SPIN_CAP) { atomicAdd(&(bar)[XB_TMO], 1u); break; } } } } while (0)
struct XcdBarrier { unsigned* bar; unsigned x; volatile LAS unsigned* st; };
__device__ __forceinline__ XcdBarrier xcd_barrier_post(unsigned* bar, volatile LAS unsigned* st) {
    XcdBarrier b; b.bar = bar; b.x = xb_xcc_id(); b.st = st;
    if (threadIdx.x == 0) (void)xb_add(&bar[XB_XCNT(b.x)], 1u);
    return b;
}
__device__ __forceinline__ void xcd_barrier_complete(unsigned* bar, unsigned x, unsigned& nloc, unsigned& nx) {
    const unsigned G = gridDim.x * gridDim.y * gridDim.z;
    unsigned sum, cnt, mine, sp = 0u;
    for (;;) {
        sum = 0u; cnt = 0u; mine = 0u;
#pragma unroll
        for (unsigned j = 0; j < 16; ++j) { const unsigned c = xb_ld(&bar[XB_XCNT(j)]); sum += c; cnt += (c > 0u) ? 1u : 0u; mine = (j == x) ? c : mine; }
        if (sum == G) break;
        __builtin_amdgcn_s_sleep(1);
        if ((++sp & 255u) == 0u) { if (xb_ld(&bar[XB_TMO])) break; if (sp > XB_SPIN_CAP) { atomicAdd(&bar[XB_TMO], 1u); break; } }
    }
    nloc = mine > 0u ? mine : 1u; nx = cnt > 0u ? cnt : 1u;
}
__device__ __noinline__ void xcd_barrier(const XcdBarrier b, const int tid) {
    asm volatile("s_waitcnt vmcnt(0)" ::: "memory");
    __syncthreads();
    if (tid == 0) {
        unsigned* bar = b.bar;
        __builtin_amdgcn_s_waitcnt(0);
        unsigned nloc = b.st[0], nx = b.st[1];
        if (nloc == 0u) { xcd_barrier_complete(bar, b.x, nloc, nx); b.st[0] = nloc; b.st[1] = nx; }
        const unsigned old = xb_add(&bar[XB_XSUB(b.x)], 1u);
        const unsigned gen = old / nloc;
        if (old + 1u == (gen + 1u) * nloc) {
            __builtin_amdgcn_fence(__ATOMIC_RELEASE, "agent");
            asm volatile("s_waitcnt vmcnt(0)" ::: "memory");
            const unsigned og = xb_add(&bar[XB_TOP], 1u);
            const unsigned tg = og / nx;
            if (og + 1u == (tg + 1u) * nx) xb_add(&bar[XB_TOPGEN], 1u);
            else XB_SPIN(xb_ld(&bar[XB_TOPGEN]) == tg, bar);
            __builtin_amdgcn_fence(__ATOMIC_ACQUIRE, "agent");
            xb_add(&bar[XB_XGEN(b.x)], 1u);
            asm volatile("s_waitcnt vmcnt(0)" ::: "memory");
        } else {
            XB_SPIN(xb_ld(&bar[XB_XGEN(b.x)]) == gen, bar);
            __builtin_amdgcn_fence(__ATOMIC_ACQUIRE, "agent");
            asm volatile("s_waitcnt vmcnt(0)" ::: "memory");
        }
    }
    __syncthreads();
}

constexpr int PROBE_IDX = -1, PROBE_END = -1, PROBE_DIV = 10;
constexpr int REP_NORM = 1, REP_INPROJ = 1, REP_PREP1 = 1, REP_SMALL = 1, REP_ATTN = 1, REP_FIN = 1, REP_MOE1 = 1, REP_MOE2 = 1, REP_SYNC = 1, REP_CONV = 1;
__global__ void __launch_bounds__(NTHR) fwd_kernel(Params p) {
    cg::grid_group grid = cg::this_grid();
    char* lds = g_lds;
    float* smem = (float*)lds;
    if (threadIdx.x == 0) {
        unsigned long long* tab = (unsigned long long*)(lds + TAB_OFF);
#pragma unroll
        for (int i = 0; i < N_IN; ++i) tab[i] = (unsigned long long)p.in[i];
        tab[N_IN] = (unsigned long long)p.ws; tab[N_IN + 1] = (unsigned long long)p.out;
    }
    __syncthreads();
    volatile LAS unsigned* xst = (volatile LAS unsigned*)(lds + XST_OFF);
    if (threadIdx.x < 4) xst[threadIdx.x] = 0u;
    if (blockIdx.x == 0) for (int i = threadIdx.x; i < 4096; i += NTHR) ((unsigned*)(p.ws + W_BAR))[i] = 0u;
    for (int r = 0; r < REP_CONV; ++r) phase_convert(p);
    phase_tables(p);
    phase_mod(p, smem);
    grid.sync();
    XcdBarrier xbar = xcd_barrier_post((unsigned*)(p.ws + W_BAR), xst);
    unsigned long long* stamps = (unsigned long long*)(lds + STAMP_OFF); int nstamp = 0;
#define GSYNC() do { for (int r_ = 0; r_ < REP_SYNC; ++r_) { XcdBarrier b_ = xbar; unsigned long long bp_ = (unsigned long long)b_.bar; unsigned bx_ = b_.x; asm volatile("" : "+s"(bp_), "+s"(bx_)); b_.bar = (unsigned*)bp_; b_.x = bx_; xcd_barrier(b_, (int)threadIdx.x); } if (PROBE_IDX >= 0) { if (blockIdx.x == 0 && threadIdx.x == 0) stamps[nstamp] = __builtin_amdgcn_s_memrealtime(); ++nstamp; } } while (0)
    phase_init(p);
    GSYNC();
    for (int lv = 0; lv < NLAYER; ++lv) {
        int l = lv; asm volatile("" : "+s"(l));
        for (int r = 0; r < REP_INPROJ; ++r) phase_inproj(p, l, lds);
        GSYNC();
        for (int r = 0; r < REP_PREP1; ++r) phase_prep1(p, l);
        GSYNC();
        for (int r = 0; r < REP_SMALL; ++r) phase_small(p, l, lds);
        GSYNC();
        phase_prep2(p, l);
        GSYNC();
        for (int r = 0; r < REP_ATTN; ++r) phase_attn(p, l, lds);
        for (int r = 0; r < REP_FIN; ++r) phase_lru_fin(p, lds);
        GSYNC();
        phase_outproj(p, l, lds);
        GSYNC();
        phase_router(p, l, lds);
        GSYNC();
        for (int r = 0; r < REP_MOE1; ++r) phase_moe1(p, l, lds);
        GSYNC();
        for (int r = 0; r < REP_MOE2; ++r) phase_moe2(p, l, lds);
        GSYNC();
        phase_combine(p, l, lds, l == NLAYER - 1);
        if (l + 1 < NLAYER || PROBE_IDX >= 0) GSYNC();
    }
    if (PROBE_IDX >= 0 && blockIdx.x == 0 && threadIdx.x == 0) {
        const float us = (float)(stamps[PROBE_END < 0 ? PROBE_IDX + 1 : PROBE_END] - stamps[PROBE_IDX]) * 0.01f;
        ((float*)(gfloat_t*)tab_ld(N_IN + 1))[0] += 2.f + us / (float)PROBE_DIV;
    }
}

extern "C" void kernel_launch(void* const* d_in, const int* in_sizes, int n_in, void* d_out, int out_size, void* d_ws, size_t ws_size, hipStream_t stream) {
    static int grid_blocks = 0;
    if (!grid_blocks) {
        int dev = 0, cus = 0, per_cu = 0;
        (void)hipGetDevice(&dev);
        (void)hipDeviceGetAttribute(&cus, hipDeviceAttributeMultiprocessorCount, dev);
        if (hipFuncSetAttribute((const void*)fwd_kernel, hipFuncAttributeMaxDynamicSharedMemorySize, LDS_BYTES) != hipSuccess) fprintf(stderr, "kernel_launch: hipFuncSetAttribute failed\n");
        if (hipOccupancyMaxActiveBlocksPerMultiprocessor(&per_cu, fwd_kernel, NTHR, LDS_BYTES) != hipSuccess || per_cu < 1) { fprintf(stderr, "kernel_launch: occupancy query says %d\n", per_cu); per_cu = 1; }
        if (per_cu > 1) per_cu = 1;
        grid_blocks = cus * per_cu;
        if (ws_size < W_END * sizeof(float)) fprintf(stderr, "kernel_launch: workspace too small: %zu < %zu\n", ws_size, W_END * sizeof(float));
        if (n_in != N_IN) fprintf(stderr, "kernel_launch: n_in %d != %d\n", n_in, (int)N_IN);
    }
    Params p{};
    for (int i = 0; i < N_IN; ++i) p.in[i] = (const float*)d_in[i];
    p.out = (float*)d_out;
    p.ws = (float*)d_ws;
    void* args[] = {&p};
    hipError_t e = hipLaunchCooperativeKernel((void*)fwd_kernel, dim3(grid_blocks), dim3(NTHR), args, LDS_BYTES, stream);
    if (e != hipSuccess) fprintf(stderr, "cooperative launch failed: %s (grid %d)\n", hipGetErrorString(e), grid_blocks);
}
```

```cpp
#include <hip/hip_runtime.h>
#include <hip/hip_cooperative_groups.h>
#include <cstdio>
#include <cstdint>
namespace cg = cooperative_groups;

#define DEVI __device__ __forceinline__
constexpr int NTHR = 512;
constexpr int D = 1024, NLAT = 16384, NCTX = 256, T = NLAT + NCTX, NLAYER = 2;
constexpr int INC = 1632;
constexpr int OFF_A = 0, OFF_Q = 256, OFF_KV = 448, OFF_KR = 576, OFF_C = 608, OFF_DX = 1120, OFF_DG = 1376;
constexpr int NCHUNK = T / 128;
constexpr int NEXP = 32, TOPK = 4;
constexpr int MAXROWS = T * TOPK + NEXP * 256;
constexpr float EPS = 1e-6f;

enum { I_X = 0, I_C, I_CTX, I_CCTX, I_WMOD, I_BMOD, I_NMIX, I_NFFN, I_WIN, I_WOUT, I_POOLW, I_POOLS, I_QAN, I_WUQ, I_KVAN, I_WUKV,
       I_QN, I_KN, I_SGG, I_SGB, I_SGWS, I_SGBS, I_CONVW, I_CONVB, I_WA, I_BA, I_WX, I_BX, I_LAM, I_RW, I_RB, I_WGU, I_BGU, I_WDN, I_BDN, N_IN };

constexpr size_t al(size_t x) { return (x + 63) / 64 * 64; }
constexpr size_t W_X = 0;
constexpr size_t W_MOD = W_X + al((size_t)T * D);
constexpr size_t W_P = W_MOD + al(2 * 2 * 6144);
constexpr size_t W_YC = W_P + al((size_t)T * INC);
constexpr size_t W_Q = W_YC + al((size_t)T * D);
constexpr size_t W_K = W_Q + al((size_t)T * 384);
constexpr size_t W_V = W_K + al((size_t)T * 384);
constexpr size_t W_DIFF = W_V + al((size_t)T * 256);
constexpr size_t W_QN = W_DIFF + al((size_t)T * 256);
constexpr size_t W_KVN = W_QN + al((size_t)T * 192);
constexpr size_t W_U = W_KVN + al((size_t)T * 128);
constexpr size_t W_VN = W_U + al((size_t)T * 256);
constexpr size_t W_XC = W_VN + al((size_t)T * 256);
constexpr size_t W_QUP = W_XC + al((size_t)T * 256);
constexpr size_t W_KVUP = W_QUP + al((size_t)T * 384);
constexpr size_t W_LA = W_KVUP + al((size_t)T * 512);
constexpr size_t W_LB = W_LA + al((size_t)2 * T * 256);
constexpr size_t W_AGG = W_LB + al((size_t)2 * T * 256);
constexpr int NSUB = T / 64;
constexpr size_t W_CARRY = W_AGG + al((size_t)NSUB * 2 * 2 * 256);
constexpr size_t W_TOPE = W_CARRY + al((size_t)NSUB * 2 * 256);
constexpr size_t W_TOPG = W_TOPE + al((size_t)T * 4);
constexpr size_t W_TOPI = W_TOPG + al((size_t)T * 4);
constexpr size_t W_CNT = W_TOPI + al((size_t)T * 4);
constexpr size_t W_ACT = W_CNT + al(NLAYER * NEXP * 64);
constexpr size_t W_YR = W_ACT + al((size_t)MAXROWS * D / 2);
constexpr size_t W_XS = W_YR + al((size_t)MAXROWS * D / 2);
constexpr size_t W_HB = W_XS + al((size_t)MAXROWS * D / 2);
constexpr size_t W_XCB = W_HB + al((size_t)T * D / 2);
constexpr size_t W_WSB = W_XCB + al((size_t)T * 256 / 2);
constexpr size_t W_BAR = W_WSB + al((size_t)NLAYER * 4 * 128 * 128 / 2);
constexpr size_t W_ROPE = W_BAR + al(4096);
constexpr size_t W_LA2 = W_ROPE + al((size_t)NLAT * 32);
constexpr size_t W_LB2 = W_LA2 + al((size_t)2 * T * 256);
constexpr size_t W_SP = W_LB2 + al((size_t)2 * T * 256);
constexpr size_t W_PART = W_SP + al(NLAYER * 2 * 256);
constexpr int NPAD_IN = 1792;
constexpr size_t W_WIN = W_PART + al((size_t)4 * NCTX * D);
constexpr size_t W_WOUT = W_WIN + al((size_t)NLAYER * NPAD_IN * D / 2);
constexpr size_t W_WGU = W_WOUT + al((size_t)NLAYER * D * D / 2);
constexpr size_t W_WDN = W_WGU + al((size_t)NLAYER * NEXP * 2048 * D / 2);
constexpr size_t W_END = W_WDN + al((size_t)NLAYER * NEXP * D * D / 2);

struct Params {
    const float* in[N_IN];
    float* out;
    float* ws;
};

DEVI int tid_() { int t = threadIdx.x; asm volatile("" : "+v"(t)); return t; }
DEVI float* ws_(float* w) { unsigned long long v = (unsigned long long)w; asm volatile("" : "+s"(v)); return (float*)v; }
extern __shared__ __attribute__((aligned(16))) char g_lds[];
constexpr int RSC_OFF = 149504 + 512;
constexpr int TAB_OFF = 149504;
DEVI unsigned long long tab_ld(int i) { const unsigned long long v = ((const volatile unsigned long long*)(g_lds + TAB_OFF))[i];
    return ((unsigned long long)(unsigned)__builtin_amdgcn_readfirstlane((int)(v >> 32)) << 32) | (unsigned)__builtin_amdgcn_readfirstlane((int)v); }
typedef __attribute__((address_space(1))) float gfloat_t;
#define PIN(i) ((const float*)(const gfloat_t*)tab_ld(i))
DEVI int bid_() { int b = blockIdx.x; asm volatile("" : "+s"(b)); return b; }
DEVI float wave_sum(float v) {
#pragma unroll
    for (int o = 32; o > 0; o >>= 1) v += __shfl_xor(v, o);
    return v;
}
DEVI float fexp(float x) { return __builtin_amdgcn_exp2f(x * 1.4426950408889634f); }
DEVI float gelu_tanh(float x) { const float u = 1.5957691216057308f * (x + 0.044715f * x * x * x); return x * __builtin_amdgcn_rcpf(1.f + fexp(-u)); }
DEVI float sigm(float x) { return 1.f / (1.f + expf(-x)); }
DEVI float silu(float x) { return x * sigm(x); }
DEVI float fsigm(float x) { return __builtin_amdgcn_rcpf(1.f + fexp(-x)); }


typedef unsigned short bf16_t;
typedef short bf16x8 __attribute__((ext_vector_type(8)));
typedef float f32x4 __attribute__((ext_vector_type(4)));
typedef unsigned u32x4 __attribute__((ext_vector_type(4)));
typedef unsigned u32x2 __attribute__((ext_vector_type(2)));
DEVI unsigned cvt_pk_bf16(float lo, float hi) { unsigned r; asm volatile("v_cvt_pk_bf16_f32 %0, %1, %2" : "=v"(r) : "v"(lo), "v"(hi)); return r; }
constexpr float W8_SCALE = 64.f, A8_SCALE = 4.f, INV8 = 1.f / (W8_SCALE * A8_SCALE);
DEVI unsigned pk_fp8x4(float a, float b, float c, float d) { int v = __builtin_amdgcn_cvt_pk_fp8_f32(a, b, 0, false); v = __builtin_amdgcn_cvt_pk_fp8_f32(c, d, v, true); return (unsigned)v; }
DEVI bf16_t f2bf(float f) { return (bf16_t)(cvt_pk_bf16(f, 0.f) & 0xffffu); }
DEVI f32x4 ld4bf(const bf16_t* p) { const u32x2 w = *(const u32x2*)p; return (f32x4){__uint_as_float(w.x << 16), __uint_as_float(w.x & 0xffff0000u), __uint_as_float(w.y << 16), __uint_as_float(w.y & 0xffff0000u)}; }
typedef int i32x8 __attribute__((ext_vector_type(8)));
typedef int i32x4 __attribute__((ext_vector_type(4)));
DEVI float bf2f(bf16_t b) { return __uint_as_float(((unsigned)b) << 16); }

constexpr int G_STAGE = 49152;
constexpr int G_LDS = 2 * G_STAGE;
DEVI int swz(int row, int chunk) { return row * 128 + ((chunk ^ ((row >> 1) & 7)) << 4); }

template <bool PAIRED, class ARow, class Epi>
DEVI void gemm_unit(char* lds, int K, ARow arow, const float* __restrict__ B0, const float* __restrict__ B1, int ldb, int ncol_valid, Epi epi) {
    const int tid = tid_(), wave = tid >> 6, lane = tid & 63, fr = lane & 15, fq = lane >> 4, wr = wave >> 1, wc = wave & 1;
    const int ac = tid & 7;
    const bf16_t* ap[4]; int a_lds[4];
#pragma unroll
    for (int i = 0; i < 4; ++i) { const int r = (tid >> 3) + 64 * i; ap[i] = arow(r) + ac * 8; a_lds[i] = swz(r, ac); }
    const int kq = lane & 15, nq = (lane >> 4) + 4 * wave;
    const float* bp;
    if (PAIRED) { const int seg = (nq >> 2) & 1, idx = (nq >> 3) * 16 + (nq & 3) * 4; bp = (seg ? B1 : B0) + idx; }
    else { const int c4 = 4 * nq < ncol_valid ? 4 * nq : ncol_valid - 4; bp = B0 + c4; }
    bp += (size_t)(4 * kq) * ldb;
    int b_lds[4];
#pragma unroll
    for (int i = 0; i < 4; ++i) b_lds[i] = 32768 + swz(4 * nq + i, kq >> 1) + (kq & 1) * 8;
    const int sx = (fr >> 1) & 7;
    const int aoff0 = (wr * 64 + fr) * 128 + ((fq ^ sx) << 4), aoff1 = (wr * 64 + fr) * 128 + (((4 + fq) ^ sx) << 4);
    const int boff0 = 32768 + (wc * 64 + fr) * 128 + ((fq ^ sx) << 4), boff1 = 32768 + (wc * 64 + fr) * 128 + (((4 + fq) ^ sx) << 4);
    u32x4 av0[4], av1[4]; f32x4 bv0[4], bv1[4];
#define G_LOAD(av, bv, t) do { _Pragma("unroll") for (int i = 0; i < 4; ++i) av[i] = *(const u32x4*)(ap[i] + (t) * 64); \
        _Pragma("unroll") for (int kk = 0; kk < 4; ++kk) bv[kk] = *(const f32x4*)(bp + ((size_t)(t) * 64 + kk) * ldb); } while (0)
#define G_WRITE(s_, av, bv) do { _Pragma("unroll") for (int i = 0; i < 4; ++i) *(u32x4*)((s_) + a_lds[i]) = av[i]; \
        _Pragma("unroll") for (int i = 0; i < 4; ++i) { u32x2 w_; w_.x = cvt_pk_bf16(bv[0][i], bv[1][i]); w_.y = cvt_pk_bf16(bv[2][i], bv[3][i]); *(u32x2*)((s_) + b_lds[i]) = w_; } } while (0)
#define G_MMA(Af, Bf) do { __builtin_amdgcn_s_setprio(1); _Pragma("unroll") for (int m = 0; m < 4; ++m) _Pragma("unroll") for (int n = 0; n < 4; ++n) \
        acc[m][n] = __builtin_amdgcn_mfma_f32_16x16x32_bf16(Bf[n], Af[m], acc[m][n], 0, 0, 0); __builtin_amdgcn_s_setprio(0); } while (0)
#define G_SB() __builtin_amdgcn_sched_barrier(0)
#define G_ITER(t, c_, n_, av, bv, W_, L_) do { \
        bf16x8 Af[4], Bf[4]; \
        _Pragma("unroll") for (int m = 0; m < 4; ++m) Af[m] = *(const bf16x8*)((c_) + aoff0 + m * 2048); \
        _Pragma("unroll") for (int n = 0; n < 4; ++n) Bf[n] = *(const bf16x8*)((c_) + boff0 + n * 2048); \
        G_SB(); asm volatile("s_waitcnt lgkmcnt(0)" ::: "memory"); G_SB(); \
        G_MMA(Af, Bf); G_SB(); \
        _Pragma("unroll") for (int m = 0; m < 4; ++m) Af[m] = *(const bf16x8*)((c_) + aoff1 + m * 2048); \
        _Pragma("unroll") for (int n = 0; n < 4; ++n) Bf[n] = *(const bf16x8*)((c_) + boff1 + n * 2048); \
        G_SB(); \
        if (W_) { G_WRITE(n_, av, bv); G_SB(); asm volatile("s_waitcnt lgkmcnt(8)" ::: "memory"); } else { asm volatile("s_waitcnt lgkmcnt(0)" ::: "memory"); } \
        G_SB(); \
        G_MMA(Af, Bf); G_SB(); \
        if (L_) G_LOAD(av, bv, (t) + 3); \
        G_SB(); asm volatile("s_waitcnt lgkmcnt(0)" ::: "memory"); __builtin_amdgcn_s_barrier(); G_SB(); } while (0)
    f32x4 acc[4][4];
#pragma unroll
    for (int m = 0; m < 4; ++m)
#pragma unroll
        for (int n = 0; n < 4; ++n) acc[m][n] = (f32x4){0.f, 0.f, 0.f, 0.f};
    const int nk = K >> 6;
    char* L0 = lds; char* L1 = lds + G_STAGE;
    G_LOAD(av0, bv0, 0);
    G_WRITE(L0, av0, bv0);
    if (nk > 1) G_LOAD(av1, bv1, 1);
    if (nk > 2) G_LOAD(av0, bv0, 2);
    asm volatile("s_waitcnt lgkmcnt(0)" ::: "memory"); __builtin_amdgcn_s_barrier(); G_SB();
    int t = 0;
    for (; t + 4 < nk; t += 2) {
        G_ITER(t, L0, L1, av1, bv1, true, true);
        G_ITER(t + 1, L1, L0, av0, bv0, true, true);
    }
    for (; t < nk; t += 2) {
        G_ITER(t, L0, L1, av1, bv1, t + 1 < nk, t + 3 < nk);
        if (t + 1 < nk) G_ITER(t + 1, L1, L0, av0, bv0, t + 2 < nk, t + 4 < nk);
    }
#undef G_LOAD
#undef G_WRITE
#undef G_MMA
#undef G_ITER
#undef G_SB
    { int fr_ = fr, fq_ = fq; asm volatile("" : "+v"(fr_), "+v"(fq_)); epi(acc, wr, wc, fr_, fq_); }
}


#define PG8_LAS __attribute__((address_space(3)))
namespace pg8 {
constexpr int BM = 256, BK = 64, HALF = 128, HTB = HALF * BK * 2, STAGE_BYTES = 8 * HTB;
DEVI int lds_byte(int r, int c) { const int st = (r >> 4) * 2 + (c >> 5), rr = r & 15, cc = c & 31, ob = rr * 64 + cc * 2; return st * 1024 + (ob ^ (((ob >> 9) & 1) << 5)); }
DEVI void stage_rc(int b, int& R, int& C) { const int st = b / 1024, sb = b % 1024, swz_ = sb ^ (((sb >> 9) & 1) << 5); R = (st >> 1) * 16 + swz_ / 64; C = (st & 1) * 32 + (swz_ % 64) / 2; }
DEVI int perm32(int rho) { const int n = rho >> 4, i = rho & 15; return 8 * (i >> 2) + 4 * n + (i & 3); }
struct Unit { const char* a; const char* b; int x0, x1, x2; const int* g; int gn; };
template <class Epi, class Sched, bool GATHER = false, bool F8 = false>
DEVI void gemm_phase(PG8_LAS unsigned char* lds, int K, size_t hstepB, const Sched& S, const Epi& E, int ktiles = 0, const char* Abase = nullptr) {
    const int tid = tid_(), wid = __builtin_amdgcn_readfirstlane(tid >> 6), lane = tid & 63, wr = wid >> 2, wc = wid & 3, fr = lane & 15, fq = lane >> 4;
    const int nt = ktiles ? ktiles : K / BK;
    unsigned voffA[2], voffB[2]; int Rr[2], Cc[2];
#pragma unroll
    for (int i = 0; i < 2; ++i) { int R, C; stage_rc(tid * 16 + i * 8192, R, C); const int Rb = Epi::PERM ? ((R & ~31) + perm32(R & 31)) : R; Rr[i] = R; Cc[i] = C;
        voffA[i] = (unsigned)(R * K + C) * 2u; voffB[i] = (unsigned)(Rb * K + C) * 2u; }
    unsigned offc[2][2], offn[2][2];
#define PG8_GOFF(dst, u_) do { _Pragma("unroll") for (int h_ = 0; h_ < 2; ++h_) _Pragma("unroll") for (int i_ = 0; i_ < 2; ++i_) { const int r_ = h_ * HALF + Rr[i_]; \
        const int row_ = (u_).g[r_ < (u_).gn ? r_ : 0]; dst[h_][i_] = (unsigned)(row_ * K + Cc[i_]) * 2u; } } while (0)
#define PG8_STAGE_A(bufoff, ptr, h_, offs, kb) do { if (GATHER) PG8_STAGE(bufoff, Abase + (kb), offs[h_]); else PG8_STAGE(bufoff, ptr, voffA); } while (0)
    const size_t kstep = (size_t)(BK * 2);
    const size_t hstep = (size_t)HALF * K * 2;
    const unsigned ldsw = (unsigned)wid * 1024u;
    const int aoff = lds_byte(wr * 64 + fr, fq * 8), boff = lds_byte(wc * 32 + fr, fq * 8);
#define PG8_SA(b, h) (((b) * 2 + (h)) * HTB)
#define PG8_SB(b, h) ((4 + (b) * 2 + (h)) * HTB)
#define PG8_STAGE(bufoff, gbase, voff) do { _Pragma("unroll") for (int _i = 0; _i < 2; ++_i) \
        __builtin_amdgcn_global_load_lds((const unsigned*)((const char*)(gbase) + (voff)[_i]), (PG8_LAS unsigned*)(lds + (bufoff) + ldsw + _i * 8192), 16, 0, 0); } while (0)
#define PG8_LDA(dst, b, h) do { _Pragma("unroll") for (int m = 0; m < 4; ++m) { dst##L[m] = *(const PG8_LAS i32x4*)(lds + PG8_SA(b, h) + aoff + m * 2048); dst##H[m] = *(const PG8_LAS i32x4*)(lds + PG8_SA(b, h) + aoff + m * 2048 + 1024); } } while (0)
#define PG8_LDB(dst, b, h) do { _Pragma("unroll") for (int n = 0; n < 2; ++n) { dst##L[n] = *(const PG8_LAS i32x4*)(lds + PG8_SB(b, h) + boff + n * 2048); dst##H[n] = *(const PG8_LAS i32x4*)(lds + PG8_SB(b, h) + boff + n * 2048 + 1024); } } while (0)
#define PG8_CAT(x, y) __builtin_shufflevector(x, y, 0, 1, 2, 3, 4, 5, 6, 7)
#define PG8_MMA(ai, bj, At, Bt) do { __builtin_amdgcn_s_setprio(1); \
        if (F8) { _Pragma("unroll") for (int m = 0; m < 4; ++m) _Pragma("unroll") for (int n = 0; n < 2; ++n) \
            asm volatile("v_mfma_scale_f32_16x16x128_f8f6f4 %0, %1, %2, %0, %3, %3 op_sel_hi:[0,0,0]" : "+v"(acc[ai][bj][m][n]) : "v"(PG8_CAT(Bt##L[n], Bt##H[n])), "v"(PG8_CAT(At##L[m], At##H[m])), "v"(sc_one)); } \
        else { _Pragma("unroll") for (int m = 0; m < 4; ++m) _Pragma("unroll") for (int n = 0; n < 2; ++n) { \
            acc[ai][bj][m][n] = __builtin_amdgcn_mfma_f32_16x16x32_bf16(__builtin_bit_cast(bf16x8, Bt##L[n]), __builtin_bit_cast(bf16x8, At##L[m]), acc[ai][bj][m][n], 0, 0, 0); \
            acc[ai][bj][m][n] = __builtin_amdgcn_mfma_f32_16x16x32_bf16(__builtin_bit_cast(bf16x8, Bt##H[n]), __builtin_bit_cast(bf16x8, At##H[m]), acc[ai][bj][m][n], 0, 0, 0); } } \
        __builtin_amdgcn_s_setprio(0); } while (0)
#define PG8_WAIT_V(n) asm volatile("s_waitcnt vmcnt(" #n ")" ::: "memory")
#define PG8_WAIT_L(n) asm volatile("s_waitcnt lgkmcnt(" #n ")" ::: "memory")
#define PG8_BAR __builtin_amdgcn_s_barrier()
#define PG8_SCHED __builtin_amdgcn_sched_barrier(0)
    Unit cur, nxt; int ui = 0;
    if (!S.next(0, cur)) return;
    f32x4 acc[2][2][4][2];
#pragma unroll
    for (int a = 0; a < 2; ++a)
#pragma unroll
        for (int b = 0; b < 2; ++b)
#pragma unroll
            for (int m = 0; m < 4; ++m)
#pragma unroll
                for (int n = 0; n < 2; ++n) acc[a][b][m][n] = (f32x4){0.f, 0.f, 0.f, 0.f};
    int sc_one = 0x7f7f7f7f; asm volatile("" : "+v"(sc_one));
    i32x4 AtL[4], AtH[4], B0L[2], B0H[2], B1L[2], B1H[2];
    const char* cA = cur.a; const char* cB = cur.b;
    if (GATHER) { PG8_GOFF(offc, cur); asm volatile("s_waitcnt vmcnt(0)" ::: "memory"); }
    PG8_STAGE(PG8_SB(0, 0), cB, voffB); PG8_STAGE_A(PG8_SA(0, 0), cA, 0, offc, 0); PG8_STAGE(PG8_SB(0, 1), cB + hstepB, voffB); PG8_STAGE_A(PG8_SA(0, 1), cA + hstep, 1, offc, 0);
    if (wr == 1) PG8_BAR;
    PG8_WAIT_V(4); PG8_BAR;
    PG8_STAGE(PG8_SB(1, 0), cB + kstep, voffB); PG8_STAGE_A(PG8_SA(1, 0), cA + kstep, 0, offc, kstep); PG8_STAGE(PG8_SB(1, 1), cB + hstepB + kstep, voffB);
    PG8_WAIT_V(6); PG8_BAR;
    for (;;) {
        const bool has_next = S.next(ui + 1, nxt);
        const char* nA = has_next ? nxt.a : cA; const char* nB = has_next ? nxt.b : cB;
        if (GATHER) { if (has_next) PG8_GOFF(offn, nxt); else {
#pragma unroll
            for (int h_ = 0; h_ < 2; ++h_)
#pragma unroll
                for (int i_ = 0; i_ < 2; ++i_) offn[h_][i_] = offc[h_][i_]; } }
        for (int t = 0; t < nt; t += 2) {
            const bool last = (t == nt - 2);
            const char* a1 = cA + (size_t)(t + 1) * kstep;
            const char* a2 = last ? nA : cA + (size_t)(t + 2) * kstep; const char* b2 = last ? nB : cB + (size_t)(t + 2) * kstep;
            const char* a3 = a2 + kstep; const char* b3 = b2 + kstep;
            unsigned o2[2][2]; const size_t k1 = (size_t)(t + 1) * kstep, k2 = last ? 0 : (size_t)(t + 2) * kstep, k3 = k2 + kstep;
            if (GATHER) {
                if (last) { asm volatile("" ::: "memory");
#pragma unroll
                    for (int h_ = 0; h_ < 2; ++h_)
#pragma unroll
                        for (int i_ = 0; i_ < 2; ++i_) o2[h_][i_] = offn[h_][i_]; }
                else {
#pragma unroll
                    for (int h_ = 0; h_ < 2; ++h_)
#pragma unroll
                        for (int i_ = 0; i_ < 2; ++i_) o2[h_][i_] = offc[h_][i_]; } }
            PG8_LDB(B0, 0, 0); PG8_SCHED; PG8_LDA(At, 0, 0); PG8_STAGE_A(PG8_SA(1, 1), a1 + hstep, 1, offc, k1);
            PG8_WAIT_L(8); PG8_BAR; PG8_WAIT_L(0); PG8_MMA(0, 0, At, B0); PG8_BAR; PG8_SCHED;
            PG8_LDB(B1, 0, 1); PG8_STAGE(PG8_SB(0, 0), b2, voffB);
            PG8_BAR; PG8_WAIT_L(0); PG8_MMA(0, 1, At, B1); PG8_BAR;
            PG8_LDA(At, 0, 1); PG8_STAGE_A(PG8_SA(0, 0), a2, 0, o2, k2);
            PG8_BAR; PG8_WAIT_L(0); PG8_MMA(1, 0, At, B0); PG8_BAR; PG8_SCHED;
            PG8_STAGE(PG8_SB(0, 1), b2 + hstepB, voffB);
            PG8_WAIT_V(6); PG8_BAR; PG8_MMA(1, 1, At, B1); PG8_BAR;
            PG8_LDB(B0, 1, 0); PG8_SCHED; PG8_LDA(At, 1, 0); PG8_STAGE_A(PG8_SA(0, 1), a2 + hstep, 1, o2, k2);
            PG8_WAIT_L(8); PG8_BAR; PG8_WAIT_L(0); PG8_MMA(0, 0, At, B0); PG8_BAR; PG8_SCHED;
            PG8_LDB(B1, 1, 1); PG8_STAGE(PG8_SB(1, 0), b3, voffB);
            PG8_BAR; PG8_WAIT_L(0); PG8_MMA(0, 1, At, B1); PG8_BAR;
            PG8_LDA(At, 1, 1); PG8_STAGE_A(PG8_SA(1, 0), a3, 0, o2, k3);
            PG8_BAR; PG8_WAIT_L(0); PG8_MMA(1, 0, At, B0); PG8_BAR; PG8_SCHED;
            PG8_STAGE(PG8_SB(1, 1), b3 + hstepB, voffB);
            PG8_WAIT_V(6); PG8_BAR; PG8_MMA(1, 1, At, B1); PG8_BAR;
        }
        if (F8) asm volatile("s_nop 15\n\ts_nop 15" ::: "memory");
        { int fr_ = fr, fq_ = fq; asm volatile("" : "+v"(fr_), "+v"(fq_));
          E(acc, cur, wr, wc, fr_, fq_); }
        if (!has_next) break;
#pragma unroll
        for (int a = 0; a < 2; ++a)
#pragma unroll
            for (int b = 0; b < 2; ++b)
#pragma unroll
                for (int m = 0; m < 4; ++m)
#pragma unroll
                    for (int n = 0; n < 2; ++n) acc[a][b][m][n] = (f32x4){0.f, 0.f, 0.f, 0.f};
        cur = nxt; cA = nA; cB = nB; ++ui;
        if (GATHER) {
#pragma unroll
            for (int h_ = 0; h_ < 2; ++h_)
#pragma unroll
                for (int i_ = 0; i_ < 2; ++i_) offc[h_][i_] = offn[h_][i_]; }
    }
    PG8_WAIT_V(0);
    if (wr == 0) PG8_BAR;
    PG8_BAR;
#undef PG8_SA
#undef PG8_SB
#undef PG8_STAGE
#undef PG8_STAGE_A
#undef PG8_GOFF
#undef PG8_LDA
#undef PG8_LDB
#undef PG8_MMA
#undef PG8_WAIT_V
#undef PG8_WAIT_L
#undef PG8_BAR
#undef PG8_SCHED
}
}

DEVI void conv_item(const float* __restrict__ W, int K, int N, bf16_t* __restrict__ Wt, int kb, int nb, int lane) {
    const int ko = lane & 7, nq = lane >> 3;
    const float* src = W + (size_t)(kb * 64 + ko * 8) * N + nb * 32 + nq * 4;
    f32x4 v[8];
#pragma unroll
    for (int kk = 0; kk < 8; ++kk) v[kk] = *(const f32x4*)(src + (size_t)kk * N);
    bf16_t* dst = Wt + (size_t)(nb * 32 + nq * 4) * K + kb * 64 + ko * 8;
#pragma unroll
    for (int i = 0; i < 4; ++i) { u32x4 o; o.x = cvt_pk_bf16(v[0][i], v[1][i]); o.y = cvt_pk_bf16(v[2][i], v[3][i]); o.z = cvt_pk_bf16(v[4][i], v[5][i]); o.w = cvt_pk_bf16(v[6][i], v[7][i]);
        *(u32x4*)(dst + (size_t)i * K) = o; }
}

namespace att {
typedef short s16x4 __attribute__((ext_vector_type(4)));
typedef float f32x16 __attribute__((ext_vector_type(16)));
constexpr int KVBLK = 64;
constexpr float SCALE = 0.10206207261596577f;
constexpr float THR = 8.f;
constexpr int SHM_V = 16384, SHM_K = 16384, NBUF = 3, SHM_ATTN = NBUF * SHM_V + NBUF * SHM_K + 8 * 64 * 4;
#define KSWZ(row, colB) ((row) * 256 + ((colB) ^ (((row) & 7) << 4)))
#define SBAR() __builtin_amdgcn_sched_barrier(0)
DEVI int crow(int r, int hi) { return (r & 3) + 8 * (r >> 2) + 4 * hi; }
DEVI void partialSM(f32x16& p0, f32x16& p1, float& m_reg, float& mn, float& alpha) {
    constexpr float C = SCALE * 1.4426950408889634f;
    float pmax = p0[0];
#pragma unroll
    for (int r = 1; r < 16; ++r) pmax = fmaxf(pmax, p0[r]);
#pragma unroll
    for (int r = 0; r < 16; ++r) pmax = fmaxf(pmax, p1[r]);
    { auto rr = __builtin_amdgcn_permlane32_swap(__float_as_uint(pmax), __float_as_uint(pmax), false, false);
      pmax = fmaxf(__uint_as_float(rr[0]), __uint_as_float(rr[1])); }
    if (__builtin_expect(__all(pmax - m_reg <= THR / SCALE), 1)) { mn = m_reg; alpha = 1.f; }
    else { mn = fmaxf(m_reg, pmax); alpha = __builtin_amdgcn_exp2f((m_reg - mn) * C); m_reg = mn; }
    const float mnC = -mn * C;
#pragma unroll
    for (int r = 0; r < 16; ++r) p0[r] = fmaf(p0[r], C, mnC);
#pragma unroll
    for (int r = 0; r < 16; ++r) p1[r] = fmaf(p1[r], C, mnC);
#pragma unroll
    for (int r = 0; r < 16; ++r) p0[r] = __builtin_amdgcn_exp2f(p0[r]);
}
DEVI void finishSM(f32x16& p0, f32x16& p1, float alpha, float& l_reg, bf16x8& pa0, bf16x8& pa1, bf16x8& pa2, bf16x8& pa3) {
#pragma unroll
    for (int r = 0; r < 16; ++r) p1[r] = __builtin_amdgcn_exp2f(p1[r]);
    float ps = 0.f;
#pragma unroll
    for (int r = 0; r < 16; ++r) ps += p0[r];
#pragma unroll
    for (int r = 0; r < 16; ++r) ps += p1[r];
    { auto rr = __builtin_amdgcn_permlane32_swap(__float_as_uint(ps), __float_as_uint(ps), false, false);
      ps = __uint_as_float(rr[0]) + __uint_as_float(rr[1]); }
    l_reg = l_reg * alpha + ps;
#define PK4(P, BASE, OUT) do { unsigned a0 = cvt_pk_bf16(P[BASE + 0], P[BASE + 1]), a1 = cvt_pk_bf16(P[BASE + 2], P[BASE + 3]);   \
    unsigned b0 = cvt_pk_bf16(P[BASE + 4], P[BASE + 5]), b1 = cvt_pk_bf16(P[BASE + 6], P[BASE + 7]);                              \
    auto r0 = __builtin_amdgcn_permlane32_swap(a0, b0, false, false); auto r1 = __builtin_amdgcn_permlane32_swap(a1, b1, false, false); \
    u32x4 w = {r0[0], r1[0], r0[1], r1[1]}; OUT = *reinterpret_cast<bf16x8*>(&w); } while (0)
    PK4(p0, 0, pa0); PK4(p0, 8, pa1); PK4(p1, 0, pa2); PK4(p1, 8, pa3);
#undef PK4
}
DEVI void qkt(f32x16& p0, f32x16& p1, const char* Ks, const bf16x8* qr, int r32, int hi) {
    p0 = f32x16{}; p1 = f32x16{};
#pragma unroll
    for (int d0 = 0; d0 < 6; ++d0) { const int cb = (d0 * 16 + hi * 8) * 2;
        const bf16x8 b0 = *reinterpret_cast<const bf16x8*>(Ks + KSWZ(r32, cb));
        const bf16x8 b1 = *reinterpret_cast<const bf16x8*>(Ks + KSWZ(32 + r32, cb));
        p0 = __builtin_amdgcn_mfma_f32_32x32x16_bf16(b0, qr[d0], p0, 0, 0, 0);
        p1 = __builtin_amdgcn_mfma_f32_32x32x16_bf16(b1, qr[d0], p1, 0, 0, 0); }
}
DEVI int v_st(int k, int c) { const int kk = (k & ~0xC) | ((k & 4) << 1) | ((k & 8) >> 1); return ((kk >> 3) * 4 + (c >> 5)) * 512 + ((kk & 7) * 32 + (c & 31)) * 2; }
DEVI int v_rd_base(int lane) { return ((lane & 3) << 3) | (((lane >> 2) & 3) << 6) | (((lane >> 4) & 1) << 5) | (((lane >> 5) & 1) << 8); }
constexpr int v_rd_off(int d0, int ks, int half) { return d0 * 512 + ks * 4096 + half * 2048; }
template <int OFF> DEVI s16x4 tr_read(int vb) {
    s16x4 r; asm volatile("ds_read_b64_tr_b16 %0, %1 offset:%2" : "=&v"(r) : "v"(vb), "i"(OFF) : "memory"); return r;
}
template <int D0> DEVI void pv_one(f32x16& od, int vb, bf16x8 pa0, bf16x8 pa1, bf16x8 pa2, bf16x8 pa3) {
    const s16x4 l0 = tr_read<v_rd_off(D0, 0, 0)>(vb), h0 = tr_read<v_rd_off(D0, 0, 1)>(vb), l1 = tr_read<v_rd_off(D0, 1, 0)>(vb), h1 = tr_read<v_rd_off(D0, 1, 1)>(vb);
    const s16x4 l2 = tr_read<v_rd_off(D0, 2, 0)>(vb), h2 = tr_read<v_rd_off(D0, 2, 1)>(vb), l3 = tr_read<v_rd_off(D0, 3, 0)>(vb), h3 = tr_read<v_rd_off(D0, 3, 1)>(vb);
    asm volatile("s_waitcnt lgkmcnt(0)" ::: "memory"); SBAR();
#define PKV(L, H) (bf16x8){L[0], L[1], L[2], L[3], H[0], H[1], H[2], H[3]}
    od = __builtin_amdgcn_mfma_f32_32x32x16_bf16(pa0, PKV(l0, h0), od, 0, 0, 0);
    od = __builtin_amdgcn_mfma_f32_32x32x16_bf16(pa1, PKV(l1, h1), od, 0, 0, 0);
    od = __builtin_amdgcn_mfma_f32_32x32x16_bf16(pa2, PKV(l2, h2), od, 0, 0, 0);
    od = __builtin_amdgcn_mfma_f32_32x32x16_bf16(pa3, PKV(l3, h3), od, 0, 0, 0);
#undef PKV
}
DEVI void pv_d0(f32x16* o, int vb, bf16x8 pa0, bf16x8 pa1, bf16x8 pa2, bf16x8 pa3) {
    pv_one<0>(o[0], vb, pa0, pa1, pa2, pa3); pv_one<1>(o[1], vb, pa0, pa1, pa2, pa3);
}
DEVI void attn_unit(const bf16_t* __restrict__ Qb, const bf16_t* __restrict__ Kh, const bf16_t* __restrict__ Vh, int seq, bf16_t* __restrict__ Ob, int ldo, char* lds) {
    const int tid = tid_(), wid = tid >> 6, lane = tid & 63, r32 = lane & 31, hi = lane >> 5;
    char* V_lds = lds; char* K_lds = lds + NBUF * SHM_V;
    float* wsl = (float*)(lds + NBUF * SHM_V + NBUF * SHM_K) + wid * 64; float* li_l = wsl; float* al_l = wsl + 32;
    float m_reg = -1e30f, l_reg = 0.f; f32x16 o[2] = {}; bf16x8 qr[6];
    const bf16_t* Qw = Qb + (size_t)(wid * 32 + r32) * 96 + hi * 8;
#pragma unroll
    for (int d0 = 0; d0 < 6; ++d0) qr[d0] = *reinterpret_cast<const bf16x8*>(Qw + d0 * 16);
    const int sr = tid >> 4, kc = tid & 15, kcl = (kc < 12 ? kc : 11) * 8;
    const int vr = tid >> 3, vc = (tid & 7) * 8, vst0 = v_st(vr, vc);
    const int kst0 = KSWZ(sr, kc * 16), kst1 = KSWZ(32 + sr, kc * 16);
    const int vb0 = (int)(uintptr_t)V_lds + v_rd_base(lane);
    bf16x8 sv0, sk00, sk01, sv1, sk10, sk11;
#define SLOAD0(k0) do { sv0 = *reinterpret_cast<const bf16x8*>(Vh + (size_t)((k0) + vr) * 64 + vc); sk00 = *reinterpret_cast<const bf16x8*>(Kh + (size_t)((k0) + sr) * 96 + kcl); \
    sk01 = *reinterpret_cast<const bf16x8*>(Kh + (size_t)((k0) + 32 + sr) * 96 + kcl); } while (0)
#define SLOAD1(k0) do { sv1 = *reinterpret_cast<const bf16x8*>(Vh + (size_t)((k0) + vr) * 64 + vc); sk10 = *reinterpret_cast<const bf16x8*>(Kh + (size_t)((k0) + sr) * 96 + kcl); \
    sk11 = *reinterpret_cast<const bf16x8*>(Kh + (size_t)((k0) + 32 + sr) * 96 + kcl); } while (0)
#define SWRITE0(b) do { *(bf16x8*)(V_lds + (b) * SHM_V + vst0) = sv0; *(bf16x8*)(K_lds + (b) * SHM_K + kst0) = sk00; *(bf16x8*)(K_lds + (b) * SHM_K + kst1) = sk01; } while (0)
#define SWRITE1(b) do { *(bf16x8*)(V_lds + (b) * SHM_V + vst0) = sv1; *(bf16x8*)(K_lds + (b) * SHM_K + kst0) = sk10; *(bf16x8*)(K_lds + (b) * SHM_K + kst1) = sk11; } while (0)
#define SWAIT() asm volatile("s_waitcnt vmcnt(3)" ::: "memory")
#define RESC(a) do { if (__any((a) < 1.f)) { if (hi == 0) al_l[r32] = (a); asm volatile("s_waitcnt lgkmcnt(0)" ::: "memory"); \
    _Pragma("unroll") for (int d = 0; d < 2; ++d) _Pragma("unroll") for (int r = 0; r < 16; ++r) o[d][r] *= al_l[crow(r, hi)]; } } while (0)
#define BNEXT(b) ((b) == NBUF - 1 ? 0 : (b) + 1)
    f32x16 pA0, pA1, pB0, pB1; float mnA, mnB, alA, alB; bf16x8 pa0, pa1, pa2, pa3; const int NT = seq / KVBLK;
    SLOAD0(0); asm volatile("s_waitcnt vmcnt(0)" ::: "memory"); SWRITE0(0); __syncthreads();
    qkt(pA0, pA1, K_lds, qr, r32, hi); partialSM(pA0, pA1, m_reg, mnA, alA);
    SLOAD1(KVBLK); if (2 < NT) SLOAD0(2 * KVBLK);
    SWAIT(); SWRITE1(1); __syncthreads();
    int bp = 0, bc = 1, bn = 2;
    for (int j = 1; j + 1 < NT; j += 2) {
        SBAR(); qkt(pB0, pB1, K_lds + bc * SHM_K, qr, r32, hi);
        finishSM(pA0, pA1, alA, l_reg, pa0, pa1, pa2, pa3); SBAR();
        SLOAD1((j + 2) * KVBLK); SBAR();
        pv_d0(o, vb0 + bp * SHM_V, pa0, pa1, pa2, pa3); partialSM(pB0, pB1, m_reg, mnB, alB);
        SWAIT(); SWRITE0(bn);
        RESC(alB); __syncthreads();
        bp = bc; bc = bn; bn = BNEXT(bn);
        SBAR(); qkt(pA0, pA1, K_lds + bc * SHM_K, qr, r32, hi);
        finishSM(pB0, pB1, alB, l_reg, pa0, pa1, pa2, pa3); SBAR();
        if (j + 3 < NT) SLOAD0((j + 3) * KVBLK); SBAR();
        pv_d0(o, vb0 + bp * SHM_V, pa0, pa1, pa2, pa3); partialSM(pA0, pA1, m_reg, mnA, alA);
        SWAIT(); SWRITE1(bn);
        RESC(alA); __syncthreads();
        bp = bc; bc = bn; bn = BNEXT(bn);
    }
    SBAR(); qkt(pB0, pB1, K_lds + bc * SHM_K, qr, r32, hi);
    finishSM(pA0, pA1, alA, l_reg, pa0, pa1, pa2, pa3); SBAR();
    pv_d0(o, vb0 + bp * SHM_V, pa0, pa1, pa2, pa3); partialSM(pB0, pB1, m_reg, mnB, alB);
    RESC(alB);
    finishSM(pB0, pB1, alB, l_reg, pa0, pa1, pa2, pa3); SBAR();
    pv_d0(o, vb0 + bc * SHM_V, pa0, pa1, pa2, pa3);
    if (hi == 0) li_l[r32] = l_reg; asm volatile("s_waitcnt lgkmcnt(0)" ::: "memory");
    float rli[16];
#pragma unroll
    for (int r = 0; r < 16; ++r) rli[r] = __builtin_amdgcn_rcpf(li_l[crow(r, hi)]);
    bf16_t* Ow = Ob + (size_t)(wid * 32) * ldo;
#pragma unroll
    for (int r = 0; r < 16; ++r) { const int orow = crow(r, hi);
#pragma unroll
        for (int d0 = 0; d0 < 2; ++d0) Ow[(size_t)orow * ldo + d0 * 32 + r32] = f2bf(o[d0][r] * rli[r]); }
    __syncthreads();
#undef SLOAD0
#undef SLOAD1
#undef SWRITE0
#undef SWRITE1
#undef SWAIT
#undef RESC
#undef BNEXT
}
#undef KSWZ
#undef SBAR
}

template <class ARow, class BMap, class Epi>
DEVI void gemm_tile(int K, ARow arow, const float* __restrict__ B, int ldb, BMap bmap, Epi epi, float* smem) {
    float (*As)[132] = (float (*)[132])smem;
    float (*Bs)[64] = (float (*)[64])(smem + 16 * 132);
    const int tid = tid_(), ty = tid >> 4, tx = tid & 15;
    float acc[4][4];
#pragma unroll
    for (int i = 0; i < 4; ++i)
#pragma unroll
        for (int j = 0; j < 4; ++j) acc[i][j] = 0.f;
    const int ar = tid >> 2, akq = tid & 3;
    const float* ap = arow(ar);
    const int bk0 = tid >> 6, bc = tid & 63;
    const int bcol = bmap(bc);
    for (int k0 = 0; k0 < K; k0 += 16) {
        float4 av = make_float4(0.f, 0.f, 0.f, 0.f);
        if (ap) av = *(const float4*)(ap + k0 + akq * 4);
        float b0 = 0.f, b1 = 0.f;
        if (bcol >= 0) { b0 = B[(size_t)(k0 + bk0) * ldb + bcol]; b1 = B[(size_t)(k0 + bk0 + 8) * ldb + bcol]; }
        __syncthreads();
        As[akq * 4 + 0][ar] = av.x; As[akq * 4 + 1][ar] = av.y; As[akq * 4 + 2][ar] = av.z; As[akq * 4 + 3][ar] = av.w;
        Bs[bk0][bc] = b0; Bs[bk0 + 8][bc] = b1;
        __syncthreads();
#pragma unroll
        for (int kk = 0; kk < 16; ++kk) {
            const float4 a = *(const float4*)&As[kk][ty * 4];
            const float4 b = *(const float4*)&Bs[kk][tx * 4];
            const float aa[4] = {a.x, a.y, a.z, a.w}, bb[4] = {b.x, b.y, b.z, b.w};
#pragma unroll
            for (int i = 0; i < 4; ++i)
#pragma unroll
                for (int j = 0; j < 4; ++j) acc[i][j] = fmaf(aa[i], bb[j], acc[i][j]);
        }
    }
#pragma unroll
    for (int i = 0; i < 4; ++i) epi(ty * 4 + i, tx, acc[i]);
    __syncthreads();
}


struct UnitRange { int lo, hi, step; };
DEVI UnitRange unit_range(int nunits, int bid) {
    UnitRange r;
    if ((gridDim.x & 7) == 0) { const int x = bid & 7, j = bid >> 3; r.lo = (int)(((long)nunits * x) >> 3) + j; r.hi = (int)(((long)nunits * (x + 1)) >> 3); r.step = gridDim.x >> 3; }
    else { r.lo = bid; r.hi = nunits; r.step = gridDim.x; }
    return r;
}


template <bool REV> DEVI void scan16(float& a, float& b) {
#define SC_STEP(N_) do { const int ctrl_ = (REV ? 0x100 : 0x110) | (N_); \
        const float pa = __int_as_float(__builtin_amdgcn_update_dpp(0x3f800000, __float_as_int(a), ctrl_, 0xf, 0xf, false)); \
        const float pb = __int_as_float(__builtin_amdgcn_update_dpp(0, __float_as_int(b), ctrl_, 0xf, 0xf, false)); \
        b = fmaf(a, pb, b); a = a * pa; } while (0)
    SC_STEP(1); SC_STEP(2); SC_STEP(4); SC_STEP(8);
#undef SC_STEP
}

__device__ void phase_convert(const Params& p) {
    float* const ws = (float*)(gfloat_t*)tab_ld(N_IN);
    const float* const pin_I_WIN = PIN(I_WIN);
    const float* const pin_I_WOUT = PIN(I_WOUT);
    const int tid = tid_(), bid = bid_();
    const int lane = tid & 63, gw = bid * (NTHR / 64) + __builtin_amdgcn_readfirstlane(tid >> 6), nw = gridDim.x * (NTHR / 64);
    constexpr int NI_OUT = NLAYER * 16 * 32, NI_IN = NLAYER * 16 * 51;
    bf16_t* wout = (bf16_t*)(ws + W_WOUT); bf16_t* win = (bf16_t*)(ws + W_WIN);
    for (int it = gw; it < NI_OUT + NI_IN; it += nw) {
        int r = it;
        if (r < NI_OUT) { const int mat = r >> 9, q = r & 511; conv_item(pin_I_WOUT + (size_t)mat * D * D, D, D, wout + (size_t)mat * D * D, q >> 5, q & 31, lane); continue; }
        r -= NI_OUT;
        { const int mat = r / 816, q = r % 816; conv_item(pin_I_WIN + (size_t)mat * D * INC, D, INC, win + (size_t)mat * NPAD_IN * D, q / 51, q % 51, lane); }
    }
}
template <bool F8O>
DEVI void conv_item2(const float* __restrict__ W0, int N0, void* __restrict__ T0, int kb0, int nb0, const float* __restrict__ W1, int N1, void* __restrict__ T1, int kb1, int nb1, int lane) {
    constexpr int K = D;
    const int ko = lane & 7, nq = lane >> 3;
    const float* s0 = W0 + (size_t)(kb0 * 64 + ko * 8) * N0 + nb0 * 32 + nq * 4; const float* s1 = W1 + (size_t)(kb1 * 64 + ko * 8) * N1 + nb1 * 32 + nq * 4;
    f32x4 v[8], w[8];
#pragma unroll
    for (int kk = 0; kk < 8; ++kk) v[kk] = __builtin_nontemporal_load((const f32x4*)(s0 + (size_t)kk * N0));
#pragma unroll
    for (int kk = 0; kk < 8; ++kk) w[kk] = __builtin_nontemporal_load((const f32x4*)(s1 + (size_t)kk * N1));
    if (F8O) {
        unsigned char* d0 = (unsigned char*)T0 + (size_t)(nb0 * 32 + nq * 4) * K + kb0 * 64 + ko * 8; unsigned char* d1 = (unsigned char*)T1 + (size_t)(nb1 * 32 + nq * 4) * K + kb1 * 64 + ko * 8;
#pragma unroll
        for (int i = 0; i < 4; ++i) { u32x2 o; o.x = pk_fp8x4(v[0][i] * W8_SCALE, v[1][i] * W8_SCALE, v[2][i] * W8_SCALE, v[3][i] * W8_SCALE); o.y = pk_fp8x4(v[4][i] * W8_SCALE, v[5][i] * W8_SCALE, v[6][i] * W8_SCALE, v[7][i] * W8_SCALE);
            *(u32x2*)(d0 + (size_t)i * K) = o; }
#pragma unroll
        for (int i = 0; i < 4; ++i) { u32x2 o; o.x = pk_fp8x4(w[0][i] * W8_SCALE, w[1][i] * W8_SCALE, w[2][i] * W8_SCALE, w[3][i] * W8_SCALE); o.y = pk_fp8x4(w[4][i] * W8_SCALE, w[5][i] * W8_SCALE, w[6][i] * W8_SCALE, w[7][i] * W8_SCALE);
            *(u32x2*)(d1 + (size_t)i * K) = o; }
    } else {
        bf16_t* d0 = (bf16_t*)T0 + (size_t)(nb0 * 32 + nq * 4) * K + kb0 * 64 + ko * 8; bf16_t* d1 = (bf16_t*)T1 + (size_t)(nb1 * 32 + nq * 4) * K + kb1 * 64 + ko * 8;
#pragma unroll
        for (int i = 0; i < 4; ++i) { u32x4 o; o.x = cvt_pk_bf16(v[0][i], v[1][i]); o.y = cvt_pk_bf16(v[2][i], v[3][i]); o.z = cvt_pk_bf16(v[4][i], v[5][i]); o.w = cvt_pk_bf16(v[6][i], v[7][i]);
            *(u32x4*)(d0 + (size_t)i * K) = o; }
#pragma unroll
        for (int i = 0; i < 4; ++i) { u32x4 o; o.x = cvt_pk_bf16(w[0][i], w[1][i]); o.y = cvt_pk_bf16(w[2][i], w[3][i]); o.z = cvt_pk_bf16(w[4][i], w[5][i]); o.w = cvt_pk_bf16(w[6][i], w[7][i]);
            *(u32x4*)(d1 + (size_t)i * K) = o; }
    }
}
constexpr int NI_MOE = NEXP * 16 * 64 + NEXP * 16 * 32;
__device__ void conv_moe(const Params& p, int l, int quota) {
    float* const ws = (float*)(gfloat_t*)tab_ld(N_IN);
    const float* const pin_I_WDN = PIN(I_WDN);
    const float* const pin_I_WGU = PIN(I_WGU);
    const int tid = tid_(), bid = bid_();
    const int lane = tid & 63;
    int* cursor = (int*)(ws + W_BAR) + 3584 + l * 64;
    unsigned char* wgu = (unsigned char*)(ws + W_WGU) + (size_t)l * NEXP * 2048 * D; unsigned char* wdn = (unsigned char*)(ws + W_WDN) + (size_t)l * NEXP * D * D;
    const float* sgu = pin_I_WGU + (size_t)l * NEXP * D * 2048; const float* sdn = pin_I_WDN + (size_t)l * NEXP * D * D;
#define CONV_DEC(it, S_, N_, T_, KB_, NB_) const float* S_; void* T_; int N_, KB_, NB_; \
        if ((it) < NEXP * 1024) { const int mat = (it) >> 10, q = (it) & 1023; S_ = sgu + (size_t)mat * D * 2048; N_ = 2048; T_ = wgu + (size_t)mat * 2048 * D; KB_ = q >> 6; NB_ = q & 63; } \
        else { const int r_ = (it) - NEXP * 1024, mat = r_ >> 9, q = r_ & 511; S_ = sdn + (size_t)mat * D * D; N_ = D; T_ = wdn + (size_t)mat * D * D; KB_ = q >> 5; NB_ = q & 31; }
#define CONV_PAIR(i0, i1) do { CONV_DEC(i0, sa_, na_, ta_, ka_, ba_) CONV_DEC(i1, sb_, nb_, tb_, kb_, bb_) \
        conv_item2<true>(sa_, na_, ta_, ka_, ba_, sb_, nb_, tb_, kb_, bb_, lane); } while (0)
    if (quota > 0) {
        int c0 = 0;
        if (lane == 0) c0 = atomicAdd(cursor, quota);
        c0 = __builtin_amdgcn_readfirstlane(c0);
        for (int it = c0; it < c0 + quota && it + 1 < NI_MOE; it += 2) CONV_PAIR(it, it + 1);
    } else {
        int c0 = __hip_atomic_load(cursor, __ATOMIC_RELAXED, __HIP_MEMORY_SCOPE_AGENT);
        c0 = __builtin_amdgcn_readfirstlane(c0); if (c0 > NI_MOE) c0 = NI_MOE;
        const int gw = bid * (NTHR / 64) + __builtin_amdgcn_readfirstlane(tid >> 6), nw = gridDim.x * (NTHR / 64);
        for (int it = c0 + 2 * gw; it + 1 < NI_MOE; it += 2 * nw) CONV_PAIR(it, it + 1);
    }
#undef CONV_DEC
#undef CONV_PAIR
}

__device__ void phase_tables(const Params& p) {
    float* const ws = (float*)(gfloat_t*)tab_ld(N_IN);
    const float* const pin_I_LAM = PIN(I_LAM);
    const float* const pin_I_SGWS = PIN(I_SGWS);
    const int tid = tid_(), bid = bid_(); (void)tid; (void)bid;
    for (int i = bid * NTHR + tid; i < NLAYER * 4 * 128 * 128; i += gridDim.x * NTHR) ((bf16_t*)(ws + W_WSB))[i] = f2bf(pin_I_SGWS[i]);
    for (int i = bid * NTHR + tid; i < NLAT * 16; i += gridDim.x * NTHR) {
        const int t = i >> 4, f = i & 15; const float pos = (f < 8) ? (float)(t >> 6) : (float)(t & 63);
        const float ang = pos * powf(10000.f, -(float)(f & 7) / 8.f);
        ws[W_ROPE + (size_t)t * 32 + f] = cosf(ang); ws[W_ROPE + (size_t)t * 32 + 16 + f] = sinf(ang);
    }
    if (bid == 1) for (int i = tid; i < NLAYER * 2 * 256; i += NTHR) ws[W_SP + i] = log1pf(expf(-pin_I_LAM[i]));
    if (bid == 0) for (int i = tid; i < NLAYER * NEXP * 64; i += NTHR) ((int*)(ws + W_CNT))[i] = 0;
}

DEVI void norm1_store(const Params& p, int l, int t, int lane, const float4 (&v)[4]) {
    const float* g = p.in[I_NMIX] + l * D;
    const float* mod = p.ws + W_MOD + (size_t)(l * 2 + (t >= NLAT ? 1 : 0)) * 6144;
    float ss = 0.f;
#pragma unroll
    for (int j = 0; j < 4; ++j) ss += v[j].x * v[j].x + v[j].y * v[j].y + v[j].z * v[j].z + v[j].w * v[j].w;
    const float rstd = rsqrtf(wave_sum(ss) * (1.f / D) + EPS);
    bf16_t* hb = (bf16_t*)(p.ws + W_HB) + (size_t)t * D;
#pragma unroll
    for (int j = 0; j < 4; ++j) {
        const int c = j * 256 + lane * 4;
        const float4 gg = *(const float4*)(g + c), s1 = *(const float4*)(mod + D + c), s0 = *(const float4*)(mod + c);
        u32x2 w; w.x = cvt_pk_bf16(v[j].x * rstd * gg.x * (1.f + s1.x) + s0.x, v[j].y * rstd * gg.y * (1.f + s1.y) + s0.y);
        w.y = cvt_pk_bf16(v[j].z * rstd * gg.z * (1.f + s1.z) + s0.z, v[j].w * rstd * gg.w * (1.f + s1.w) + s0.w);
        *(u32x2*)(hb + c) = w;
    }
}
__device__ void phase_init(const Params& p) {
    float* const ws = (float*)(gfloat_t*)tab_ld(N_IN);
    const float* const pin_I_CTX = PIN(I_CTX);
    const float* const pin_I_X = PIN(I_X);
    const int tid = tid_(), bid = bid_();
    const int lane = tid & 63, gw = bid * (NTHR / 64) + __builtin_amdgcn_readfirstlane(tid >> 6), nw = gridDim.x * (NTHR / 64);
    for (int t = gw; t < T; t += nw) {
        const float* src = (t < NLAT) ? pin_I_X + (size_t)t * D : pin_I_CTX + (size_t)(t - NLAT) * D;
        float4 v[4];
#pragma unroll
        for (int j = 0; j < 4; ++j) { v[j] = *(const float4*)(src + j * 256 + lane * 4); if (t >= NLAT) *(float4*)(ws + W_X + (size_t)t * D + j * 256 + lane * 4) = v[j]; }
        norm1_store(p, 0, t, lane, v);
    }
}

__device__ void phase_mod(const Params& p, float* smem) {
    float* const ws = (float*)(gfloat_t*)tab_ld(N_IN);
    const float* const pin_I_BMOD = PIN(I_BMOD);
    const float* const pin_I_C = PIN(I_C);
    const float* const pin_I_CCTX = PIN(I_CCTX);
    const float* const pin_I_WMOD = PIN(I_WMOD);
    const int tid = tid_(), bid = bid_();
    const int wave = tid >> 6, lane = tid & 63;
    float* sc = smem + 1024;
    for (int i = tid; i < 1024; i += NTHR) { sc[i] = silu(pin_I_C[i]); sc[1024 + i] = silu(pin_I_CCTX[i]); }
    __syncthreads();
    for (int it = bid; it < NLAYER * 96; it += gridDim.x) {
        const int l = it / 96, j = (it % 96) * 64 + lane;
        const float* W = pin_I_WMOD + (size_t)l * 1024 * 6144 + j;
        float a0 = 0.f, a1 = 0.f;
        for (int k0 = wave * 128; k0 < wave * 128 + 128; k0 += 16) {
            float w[16];
#pragma unroll
            for (int q = 0; q < 16; ++q) w[q] = W[(size_t)(k0 + q) * 6144];
#pragma unroll
            for (int q = 0; q < 16; ++q) { a0 = fmaf(sc[k0 + q], w[q], a0); a1 = fmaf(sc[1024 + k0 + q], w[q], a1); }
        }
        smem[(wave * 2 + 0) * 64 + lane] = a0; smem[(wave * 2 + 1) * 64 + lane] = a1;
        __syncthreads();
        if (wave < 2) {
            float s = 0.f;
            for (int w = 0; w < 8; ++w) s += smem[(w * 2 + wave) * 64 + lane];
            ws[W_MOD + (size_t)(l * 2 + wave) * 6144 + j] = s + pin_I_BMOD[l * 6144 + j];
        }
        __syncthreads();
    }
}


struct InprojSched {
    UnitRange ur; const char* A; const char* Bt;
    DEVI bool next(int i, pg8::Unit& u) const {
        const int id = ur.lo + i * ur.step; if (id >= ur.hi) return false;
        const int tm = id / 7, tn = id % 7;
        u.a = A + (size_t)tm * 256 * D * 2; u.b = Bt + (size_t)tn * 256 * D * 2; u.x0 = tm * 256; u.x1 = tn * 256; u.x2 = 0; u.g = nullptr; u.gn = 0; return true;
    }
};
struct EpiInproj { static constexpr bool PERM = true; bf16_t* P;
    DEVI void operator()(const f32x4 (&acc)[2][2][4][2], const pg8::Unit& u, int wr, int wc, int fr, int fq) const {
#pragma unroll
        for (int ai = 0; ai < 2; ++ai)
#pragma unroll
            for (int m = 0; m < 4; ++m) { bf16_t* row = P + (size_t)(u.x0 + ai * 128 + wr * 64 + m * 16 + fr) * INC;
#pragma unroll
                for (int bj = 0; bj < 2; ++bj) { const int c = u.x1 + bj * 128 + wc * 32 + 8 * fq;
                    if (c < INC) { const f32x4 v0 = acc[ai][bj][m][0], v1 = acc[ai][bj][m][1];
                        u32x4 w; w.x = cvt_pk_bf16(v0[0], v0[1]); w.y = cvt_pk_bf16(v0[2], v0[3]); w.z = cvt_pk_bf16(v1[0], v1[1]); w.w = cvt_pk_bf16(v1[2], v1[3]);
                        *(u32x4*)(row + c) = w; } } }
    }
};
__device__ void phase_inproj(const Params& p, int l, char* lds) {
    float* const ws = (float*)(gfloat_t*)tab_ld(N_IN);
    const int tid = tid_(), bid = bid_(); (void)tid;
    InprojSched S; S.ur = unit_range((T / 256) * 7, bid); S.A = (const char*)(ws + W_HB); S.Bt = (const char*)((const bf16_t*)(ws + W_WIN) + (size_t)l * NPAD_IN * D);
    EpiInproj E; E.P = (bf16_t*)(ws + W_P);
    pg8::gemm_phase((PG8_LAS unsigned char*)lds, D, (size_t)128 * D * 2, S, E);
    { const int mine = (S.ur.hi - S.ur.lo + S.ur.step - 1) / S.ur.step, most = ((T / 256) * 7 / 8 + 1 + S.ur.step - 1) / S.ur.step;
      if (mine < most) conv_moe(p, l, 12); }
}

__device__ void phase_prep1(const Params& p, int l) {
    float* const ws = (float*)(gfloat_t*)tab_ld(N_IN);
    const float* const pin_I_CONVB = PIN(I_CONVB);
    const float* const pin_I_CONVW = PIN(I_CONVW);
    const float* const pin_I_KVAN = PIN(I_KVAN);
    const float* const pin_I_QAN = PIN(I_QAN);
    const float* const pin_I_SGB = PIN(I_SGB);
    const float* const pin_I_SGG = PIN(I_SGG);
    const int tid = tid_(), bid = bid_(); (void)tid; (void)bid;
    const int lane = tid & 63, gw = bid * (NTHR / 64) + __builtin_amdgcn_readfirstlane(tid >> 6), nw = gridDim.x * (NTHR / 64);
    float qan[3], kvan[2];
#pragma unroll
    for (int j = 0; j < 3; ++j) qan[j] = pin_I_QAN[l * 192 + j * 64 + lane];
#pragma unroll
    for (int j = 0; j < 2; ++j) kvan[j] = pin_I_KVAN[l * 128 + j * 64 + lane];
    const f32x4 sgg = *(const f32x4*)(pin_I_SGG + l * 256 + lane * 4), sgb = *(const f32x4*)(pin_I_SGB + l * 256 + lane * 4);
    const f32x4 cb = *(const f32x4*)(pin_I_CONVB + l * 256 + lane * 4);
    f32x4 cw[4];
#pragma unroll
    for (int k = 0; k < 4; ++k) cw[k] = *(const f32x4*)(pin_I_CONVW + (size_t)l * 4 * 256 + k * 256 + lane * 4);
    const int g = lane >> 4, w = 2 << g;
    const bf16_t* P = (const bf16_t*)(ws + W_P);
    for (int t = gw; t < T; t += nw) {
        const int s0 = (t < NLAT) ? 0 : NLAT, sl = (t < NLAT) ? NLAT : NCTX, n = t - s0;
        const bf16_t* pr = P + (size_t)t * INC;
        const int lo = max(n - w / 2, 0), hi = min(n + w / 2, sl);
        f32x4 pw[16];
#pragma unroll
        for (int j = 0; j < 16; ++j) { const int m = min(lo + j, hi - 1); pw[j] = ld4bf(P + (size_t)(s0 + m) * INC + OFF_A + lane * 4); }
        const f32x4 xa = ld4bf(pr + OFF_A + lane * 4);
        float qv[3], kvv[2];
#pragma unroll
        for (int j = 0; j < 3; ++j) qv[j] = bf2f(pr[OFF_Q + j * 64 + lane]);
#pragma unroll
        for (int j = 0; j < 2; ++j) kvv[j] = bf2f(pr[OFF_KV + j * 64 + lane]);
        const f32x4 zu = ld4bf(pr + OFF_C + lane * 4), zv = ld4bf(pr + OFF_C + 256 + lane * 4);
        f32x4 xc[4];
#pragma unroll
        for (int k = 0; k < 4; ++k) { const int m = min(max(n - 1 + k, 0), sl - 1); xc[k] = ld4bf(P + (size_t)(s0 + m) * INC + OFF_DX + lane * 4); }
        {   f32x4 sacc = (f32x4){0.f, 0.f, 0.f, 0.f};
#pragma unroll
            for (int j = 0; j < 16; ++j) sacc = sacc + ((lo + j < hi) ? pw[j] : (f32x4){0.f, 0.f, 0.f, 0.f});
            const float inv = 1.f / (float)(hi - lo);
            const f32x4 d = sacc * inv - xa;
            u32x2 o; o.x = cvt_pk_bf16(d[0], d[1]); o.y = cvt_pk_bf16(d[2], d[3]); *(u32x2*)((bf16_t*)(ws + W_DIFF) + (size_t)t * 256 + lane * 4) = o; }
        {   const float rq = rsqrtf(wave_sum(qv[0] * qv[0] + qv[1] * qv[1] + qv[2] * qv[2]) * (1.f / 192.f) + EPS);
#pragma unroll
            for (int j = 0; j < 3; ++j) ((bf16_t*)(ws + W_QN))[(size_t)t * 192 + j * 64 + lane] = f2bf(qv[j] * rq * qan[j]);
            const float rk = rsqrtf(wave_sum(kvv[0] * kvv[0] + kvv[1] * kvv[1]) * (1.f / 128.f) + EPS);
#pragma unroll
            for (int j = 0; j < 2; ++j) ((bf16_t*)(ws + W_KVN))[(size_t)t * 128 + j * 64 + lane] = f2bf(kvv[j] * rk * kvan[j]); }
        {   f32x4 u, gv;
#pragma unroll
            for (int j = 0; j < 4; ++j) { u[j] = gelu_tanh(zu[j]); gv[j] = gelu_tanh(zv[j]); }
            *(f32x4*)(ws + W_U + (size_t)t * 256 + lane * 4) = u;
            const float mu = wave_sum(gv[0] + gv[1] + gv[2] + gv[3]) * (1.f / 256.f);
            gv = gv - mu;
            const float rstd = rsqrtf(wave_sum(gv[0] * gv[0] + gv[1] * gv[1] + gv[2] * gv[2] + gv[3] * gv[3]) * (1.f / 256.f) + EPS);
            *(f32x4*)(ws + W_VN + (size_t)t * 256 + lane * 4) = gv * rstd * sgg + sgb; }
        {   f32x4 o = cb;
#pragma unroll
            for (int k = 0; k < 4; ++k) { const int m = n - 1 + k; if (m >= 0 && m < sl) o = o + xc[k] * cw[k]; }
            u32x2 ob; ob.x = cvt_pk_bf16(o[0], o[1]); ob.y = cvt_pk_bf16(o[2], o[3]); *(u32x2*)((bf16_t*)(ws + W_XCB) + (size_t)t * 256 + lane * 4) = ob; }
    }
}

__device__ void phase_small(const Params& p, int l, char* lds) {
    float* const ws = (float*)(gfloat_t*)tab_ld(N_IN);
    const float* const pin_I_BA = PIN(I_BA);
    const float* const pin_I_BX = PIN(I_BX);
    const float* const pin_I_POOLS = PIN(I_POOLS);
    const float* const pin_I_POOLW = PIN(I_POOLW);
    const float* const pin_I_SGBS = PIN(I_SGBS);
    const float* const pin_I_WA = PIN(I_WA);
    const float* const pin_I_WUKV = PIN(I_WUKV);
    const float* const pin_I_WUQ = PIN(I_WUQ);
    const float* const pin_I_WX = PIN(I_WX);
    const int tid = tid_(), bid = bid_(); (void)tid;
    constexpr int NK = 19, NU1 = (T / 256) * NK, NU2 = NCHUNK * 2;
    bf16_t* Y = (bf16_t*)(ws + W_YC);
    for (int u = bid; u < NU1 + NU2; u += gridDim.x) {
        if (u < NU1) {
            const int tm = u / NK, kind = u % NK, m0 = tm * 256;
            if (kind < 11) {
                const bf16_t* A; int lda, K, ldb, nval; const float* B;
                if (kind < 4) { A = (const bf16_t*)(ws + W_DIFF) + kind * 64; lda = 256; K = 64; B = pin_I_POOLW + (size_t)(l * 4 + kind) * 64 * 64; ldb = 64; nval = 64; }
                else if (kind < 7) { A = (const bf16_t*)(ws + W_QN); lda = 192; K = 192; B = pin_I_WUQ + (size_t)l * 192 * 384 + (kind - 4) * 128; ldb = 384; nval = 128; }
                else { A = (const bf16_t*)(ws + W_KVN); lda = 128; K = 128; B = pin_I_WUKV + (size_t)l * 128 * 512 + (kind - 7) * 128; ldb = 512; nval = 128; }
                gemm_unit<false>(lds, K, [&](int r) { return A + (size_t)(m0 + r) * lda; }, B, B, ldb, nval,
                    [&](const f32x4 (&acc)[4][4], int wr, int wc, int fr, int fq) {
#pragma unroll
                        for (int m = 0; m < 4; ++m) { const int t = m0 + wr * 64 + m * 16 + fr;
#pragma unroll
                            for (int n = 0; n < 4; ++n) { const int c = wc * 64 + n * 16 + 4 * fq;
                                if (kind < 4) { if (wc == 0) { const f32x4 sc = *(const f32x4*)(pin_I_POOLS + l * 256 + kind * 64 + c); const f32x4 v = acc[m][n] * sc;
                                        u32x2 w; w.x = cvt_pk_bf16(v[0], v[1]); w.y = cvt_pk_bf16(v[2], v[3]); *(u32x2*)(Y + (size_t)t * D + kind * 64 + c) = w; } }
                                else if (kind < 7) { const f32x4 v_ = acc[m][n]; u32x2 w_; w_.x = cvt_pk_bf16(v_[0], v_[1]); w_.y = cvt_pk_bf16(v_[2], v_[3]); *(u32x2*)((bf16_t*)(ws + W_QUP) + (size_t)t * 384 + (kind - 4) * 128 + c) = w_; }
                                else { const f32x4 v_ = acc[m][n]; u32x2 w_; w_.x = cvt_pk_bf16(v_[0], v_[1]); w_.y = cvt_pk_bf16(v_[2], v_[3]); *(u32x2*)((bf16_t*)(ws + W_KVUP) + (size_t)t * 512 + (kind - 7) * 128 + c) = w_; } } }
                    });
            } else {
                const int d = (kind - 11) >> 2, h = (kind - 11) & 3;
                const bf16_t* A = (const bf16_t*)(ws + W_XCB) + h * 64;
                const float* Ba = pin_I_WA + (size_t)((l * 2 + d) * 4 + h) * 64 * 64; const float* Bx = pin_I_WX + (size_t)((l * 2 + d) * 4 + h) * 64 * 64;
                const int pb = (l * 2 + d) * 256 + h * 64;
                gemm_unit<true>(lds, 64, [&](int r) { return A + (size_t)(m0 + r) * 256; }, Ba, Bx, 64, 64,
                    [&](const f32x4 (&acc)[4][4], int wr, int wc, int fr, int fq) {
                        const int sub = tm * 4 + wr;
                        const int lane16 = (fr == (d ? 0 : 15));
#pragma unroll
                        for (int pp = 0; pp < 2; ++pp) { const int idx = (wc * 2 + pp) * 16 + 4 * fq;
                            const f32x4 ba = *(const f32x4*)(pin_I_BA + pb + idx), bx = *(const f32x4*)(pin_I_BX + pb + idx), sp = *(const f32x4*)(ws + W_SP + pb + idx);
                            f32x4 Hc = (f32x4){0.f, 0.f, 0.f, 0.f}, Ac = (f32x4){1.f, 1.f, 1.f, 1.f};
#pragma unroll
                            for (int mm = 0; mm < 4; ++mm) { const int m = d ? 3 - mm : mm; const int t = m0 + wr * 64 + m * 16 + fr;
                                const f32x4 xv = ld4bf((const bf16_t*)(ws + W_XCB) + (size_t)t * 256 + h * 64 + idx);
                                f32x4 av, dv;
#pragma unroll
                                for (int j = 0; j < 4; ++j) { const float r = fsigm(acc[m][2 * pp][j] + ba[j]), ig = fsigm(acc[m][2 * pp + 1][j] + bx[j]);
                                    const float loga = -8.f * r * sp[j], x2 = 2.f * loga;
                                    const float om = (x2 > -0.0625f) ? -x2 * (1.f + x2 * (0.5f + x2 * (0.16666667f + x2 * 0.041666668f))) : 1.f - fexp(x2);
                                    float a_ = fexp(loga), b_ = __builtin_amdgcn_sqrtf(om) * (ig * xv[j]);
                                    if (d) scan16<true>(a_, b_); else scan16<false>(a_, b_);
                                    b_ = fmaf(a_, Hc[j], b_); a_ = a_ * Ac[j];
                                    av[j] = a_; dv[j] = b_; }
                                { const f32x4 v_ = av; u32x2 w_; w_.x = cvt_pk_bf16(v_[0], v_[1]); w_.y = cvt_pk_bf16(v_[2], v_[3]); *(u32x2*)((bf16_t*)(ws + W_LA2) + ((size_t)d * T + t) * 256 + h * 64 + idx) = w_; }
                                { const f32x4 v_ = dv; u32x2 w_; w_.x = cvt_pk_bf16(v_[0], v_[1]); w_.y = cvt_pk_bf16(v_[2], v_[3]); *(u32x2*)((bf16_t*)(ws + W_LB2) + ((size_t)d * T + t) * 256 + h * 64 + idx) = w_; }
                                const int src = ((fq << 4) | (d ? 0 : 15)) << 2;
#pragma unroll
                                for (int j = 0; j < 4; ++j) { Ac[j] = __int_as_float(__builtin_amdgcn_ds_bpermute(src, __float_as_int(av[j]))); Hc[j] = __int_as_float(__builtin_amdgcn_ds_bpermute(src, __float_as_int(dv[j]))); }
                            }
                            if (lane16) { *(f32x4*)(ws + W_AGG + ((size_t)(sub * 2 + d) * 2 + 0) * 256 + h * 64 + idx) = Ac; *(f32x4*)(ws + W_AGG + ((size_t)(sub * 2 + d) * 2 + 1) * 256 + h * 64 + idx) = Hc; }
                        }
                    });
            }
        } else {
            const int v = u - NU1, c = v >> 1, hp = v & 1;
            const bf16_t* A = (const bf16_t*)(ws + W_WSB) + ((size_t)l * 512 + hp * 256) * 128;
            const float* B = ws + W_VN + (size_t)c * 128 * 256 + hp * 128;
            gemm_unit<false>(lds, 128, [&](int r) { return A + (size_t)r * 128; }, B, B, 256, 128,
                [&](const f32x4 (&acc)[4][4], int wr, int wc, int fr, int fq) {
                    if ((wr >> 1) == wc) {
                        const int h = hp * 2 + wc;
#pragma unroll
                        for (int m = 0; m < 4; ++m) { const int pp = (wr & 1) * 64 + m * 16 + fr, t = c * 128 + pp; const float bs = pin_I_SGBS[(l * 4 + h) * 128 + pp];
#pragma unroll
                            for (int n = 0; n < 4; ++n) { const int ch = h * 64 + n * 16 + 4 * fq; const f32x4 uu = *(const f32x4*)(ws + W_U + (size_t)t * 256 + ch);
                                const f32x4 o = uu * (acc[m][n] + bs);
                                u32x2 w; w.x = cvt_pk_bf16(o[0], o[1]); w.y = cvt_pk_bf16(o[2], o[3]); *(u32x2*)(Y + (size_t)t * D + 512 + ch) = w; } }
                    }
                });
        }
    }
}

__device__ void phase_prep2(const Params& p, int l) {
    float* const ws = (float*)(gfloat_t*)tab_ld(N_IN);
    const float* const pin_I_KN = PIN(I_KN);
    const float* const pin_I_QN = PIN(I_QN);
    const int tid = tid_(), bid = bid_();
    const int lane = tid & 63, gw = bid * (NTHR / 64) + __builtin_amdgcn_readfirstlane(tid >> 6), nw = gridDim.x * (NTHR / 64);
    {
        const int h = lane >> 4, j = lane & 15;
        const f32x4 qw = *(const f32x4*)(pin_I_QN + l * 96 + 4 * j), kw = *(const f32x4*)(pin_I_KN + l * 96 + 4 * j);
        const float qw1 = pin_I_QN[l * 96 + 64 + j], qw2 = pin_I_QN[l * 96 + 80 + j], kw1 = pin_I_KN[l * 96 + 64 + j], kw2 = pin_I_KN[l * 96 + 80 + j];
        for (int t = gw; t < T; t += nw) {
            const bool lat = t < NLAT;
            float cs = 1.f, sn = 0.f;
            if (lat) { cs = ws[W_ROPE + (size_t)t * 32 + j]; sn = ws[W_ROPE + (size_t)t * 32 + 16 + j]; }
            const bf16_t* qr = (const bf16_t*)(ws + W_QUP) + (size_t)t * 384 + h * 96; const bf16_t* kr = (const bf16_t*)(ws + W_KVUP) + (size_t)t * 512 + h * 128; const bf16_t* pr = (const bf16_t*)(ws + W_P) + (size_t)t * INC + OFF_KR;
            f32x4 qn = ld4bf(qr + 4 * j); float q1 = bf2f(qr[64 + j]), q2 = bf2f(qr[80 + j]);
            f32x4 kn = ld4bf(kr + 4 * j); float k1 = bf2f(pr[j]), k2 = bf2f(pr[16 + j]);
            const u32x2 vraw = *(const u32x2*)(kr + 64 + 4 * j);
            float sq = qn[0] * qn[0] + qn[1] * qn[1] + qn[2] * qn[2] + qn[3] * qn[3] + q1 * q1 + q2 * q2;
            float sk = kn[0] * kn[0] + kn[1] * kn[1] + kn[2] * kn[2] + kn[3] * kn[3] + k1 * k1 + k2 * k2;
#pragma unroll
            for (int o = 1; o < 16; o <<= 1) { sq += __shfl_xor(sq, o); sk += __shfl_xor(sk, o); }
            const float rq = rsqrtf(sq * (1.f / 96.f) + EPS), rk = rsqrtf(sk * (1.f / 96.f) + EPS);
            qn = qn * qw * rq; q1 *= qw1 * rq; q2 *= qw2 * rq; kn = kn * kw * rk; k1 *= kw1 * rk; k2 *= kw2 * rk;
            const float qa = q1 * cs - q2 * sn, qb = q1 * sn + q2 * cs, ka = k1 * cs - k2 * sn, kb = k1 * sn + k2 * cs;
            bf16_t* qo = (bf16_t*)(ws + W_Q) + ((size_t)h * T + t) * 96; bf16_t* ko = (bf16_t*)(ws + W_K) + ((size_t)h * T + t) * 96; bf16_t* vo = (bf16_t*)(ws + W_V) + ((size_t)h * T + t) * 64;
            { u32x2 w; w.x = cvt_pk_bf16(qn[0], qn[1]); w.y = cvt_pk_bf16(qn[2], qn[3]); *(u32x2*)(qo + 4 * j) = w; qo[64 + j] = f2bf(qa); qo[80 + j] = f2bf(qb); }
            { u32x2 w; w.x = cvt_pk_bf16(kn[0], kn[1]); w.y = cvt_pk_bf16(kn[2], kn[3]); *(u32x2*)(ko + 4 * j) = w; ko[64 + j] = f2bf(ka); ko[80 + j] = f2bf(kb); }
            *(u32x2*)(vo + 4 * j) = vraw;
        }
    }
    for (int chain = gw; chain < 512; chain += nw) {
        const int d = chain >> 8, ch = chain & 255;
        const float* ag = ws + W_AGG + (size_t)d * 512 + ch;
        float* cr = ws + W_CARRY + (size_t)d * 256 + ch;
        float run = 0.f;
        for (int k0 = 0; k0 < NSUB; k0 += 64) {
            const int k = k0 + lane; const bool valid = k < NSUB;
            const int q = d ? (NSUB - 1 - k) : (k < 4 ? 256 + k : k - 4);
            float a = 1.f, b = 0.f;
            if (valid) { a = ag[(size_t)q * 1024]; b = ag[(size_t)q * 1024 + 256]; }
#pragma unroll
            for (int o = 1; o < 64; o <<= 1) { const float pa = __shfl_up(a, o), pb = __shfl_up(b, o); if (lane >= o) { b = fmaf(a, pb, b); a = a * pa; } }
            float ea = __shfl_up(a, 1), eb = __shfl_up(b, 1); if (lane == 0) { ea = 1.f; eb = 0.f; }
            if (valid) cr[(size_t)q * 512] = fmaf(ea, run, eb);
            const float ta = __shfl(a, 63), tb = __shfl(b, 63);
            run = fmaf(ta, run, tb);
        }
    }
}


__device__ void phase_attn(const Params& p, int l, char* lds) {
    float* const ws = (float*)(gfloat_t*)tab_ld(N_IN);
    const int tid = tid_(), bid = bid_(); (void)tid;
    const bf16_t* Qb = (const bf16_t*)(ws + W_Q); const bf16_t* Kb = (const bf16_t*)(ws + W_K); const bf16_t* Vb = (const bf16_t*)(ws + W_V);
    bf16_t* Y = (bf16_t*)(ws + W_YC);
    const int nunits = (l == 0) ? 260 : 256;
    for (int u = bid; u < nunits; u += gridDim.x) {
        int h, t0, k0, seq;
        if (u < 256) { h = (u & 7) >> 1; t0 = (((u >> 3) << 1) | (u & 1)) * 256; k0 = 0; seq = T; }
        else { h = u - 256; t0 = NLAT; k0 = NLAT; seq = NCTX; }
        att::attn_unit(Qb + ((size_t)h * T + t0) * 96, Kb + ((size_t)h * T + k0) * 96, Vb + ((size_t)h * T + k0) * 64, seq, Y + (size_t)t0 * D + 256 + h * 64, D, lds);
    }
}

__device__ void phase_lru_fin(const Params& p, char* lds) {
    float* const ws = (float*)(gfloat_t*)tab_ld(N_IN);
    const int tid = tid_(), bid = bid_();
    float* carry = (float*)lds;
    for (int sub = bid; sub < NSUB; sub += gridDim.x) {
        carry[tid] = ws[W_CARRY + (size_t)sub * 512 + tid];
        __syncthreads();
        for (int i = tid; i < 64 * 64; i += NTHR) {
            const int t = sub * 64 + (i >> 6), ch = (i & 63) * 4;
            const bf16_t* la = (const bf16_t*)(ws + W_LA2); const bf16_t* lb = (const bf16_t*)(ws + W_LB2);
            f32x4 hs = ld4bf(lb + (size_t)t * 256 + ch) + ld4bf(la + (size_t)t * 256 + ch) * *(const f32x4*)(carry + ch);
            hs = hs + ld4bf(lb + ((size_t)T + t) * 256 + ch) + ld4bf(la + ((size_t)T + t) * 256 + ch) * *(const f32x4*)(carry + 256 + ch);
            const f32x4 g = ld4bf((const bf16_t*)(ws + W_P) + (size_t)t * INC + OFF_DG + ch);
            u32x2 w; w.x = cvt_pk_bf16(gelu_tanh(g[0]) * hs[0], gelu_tanh(g[1]) * hs[1]); w.y = cvt_pk_bf16(gelu_tanh(g[2]) * hs[2], gelu_tanh(g[3]) * hs[3]);
            *(u32x2*)((bf16_t*)(ws + W_YC) + (size_t)t * D + 768 + ch) = w;
        }
        __syncthreads();
    }
}

struct OutprojSched {
    UnitRange ur; const char* A; const char* Bt;
    DEVI bool next(int i, pg8::Unit& u) const {
        const int id = ur.lo + i * ur.step; if (id >= ur.hi) return false;
        const int tm = id >> 2, tn = id & 3;
        u.a = A + (size_t)tm * 256 * D * 2; u.b = Bt + (size_t)tn * 256 * D * 2; u.x0 = tm * 256; u.x1 = tn * 256; u.x2 = 0; u.g = nullptr; u.gn = 0; return true;
    }
};
struct EpiOutproj { static constexpr bool PERM = false; float* X; const float* Xin; const float* modv;
    DEVI void operator()(const f32x4 (&acc)[2][2][4][2], const pg8::Unit& u, int wr, int wc, int fr, int fq) const {
        const float* g1 = modv + (u.x0 >= NLAT ? 6144 : 0) + 2 * D;
#pragma unroll
        for (int ai = 0; ai < 2; ++ai)
#pragma unroll
            for (int m = 0; m < 4; ++m) { const size_t ro = (size_t)(u.x0 + ai * 128 + wr * 64 + m * 16 + fr) * D; float* row = X + ro; const float* rin = Xin + ro;
#pragma unroll
                for (int bj = 0; bj < 2; ++bj)
#pragma unroll
                    for (int n = 0; n < 2; ++n) { const int c = u.x1 + bj * 128 + wc * 32 + n * 16 + 4 * fq; const f32x4 g = *(const f32x4*)(g1 + c); f32x4 x = *(const f32x4*)(rin + c);
                        x = x + g * acc[ai][bj][m][n]; *(f32x4*)(row + c) = x; } }
    }
};
struct CtxSplitSched {
    int first, step; const char* A; const char* Bt;
    DEVI bool next(int i, pg8::Unit& u) const {
        const int id = first + i * step; if (id >= 16) return false;
        const int tn = id >> 2, ks = id & 3;
        u.a = A + (size_t)NLAT * D * 2 + (size_t)ks * 256 * 2; u.b = Bt + (size_t)tn * 256 * D * 2 + (size_t)ks * 256 * 2; u.x0 = ks; u.x1 = tn * 256; u.x2 = 0; u.g = nullptr; u.gn = 0; return true;
    }
};
struct EpiCtxPart { static constexpr bool PERM = false; float* PART; const float* g1;
    DEVI void operator()(const f32x4 (&acc)[2][2][4][2], const pg8::Unit& u, int wr, int wc, int fr, int fq) const {
#pragma unroll
        for (int ai = 0; ai < 2; ++ai)
#pragma unroll
            for (int m = 0; m < 4; ++m) { float* row = PART + ((size_t)u.x0 * NCTX + ai * 128 + wr * 64 + m * 16 + fr) * D;
#pragma unroll
                for (int bj = 0; bj < 2; ++bj)
#pragma unroll
                    for (int n = 0; n < 2; ++n) { const int c = u.x1 + bj * 128 + wc * 32 + n * 16 + 4 * fq; *(f32x4*)(row + c) = *(const f32x4*)(g1 + c) * acc[ai][bj][m][n]; } }
    }
};
__device__ void phase_outproj(const Params& p, int l, char* lds) {
    float* const ws = (float*)(gfloat_t*)tab_ld(N_IN);
    const int tid = tid_(), bid = bid_(); (void)tid;
    OutprojSched S; S.ur = unit_range((NLAT / 256) * 4, bid); S.A = (const char*)(ws + W_YC); S.Bt = (const char*)((const bf16_t*)(ws + W_WOUT) + (size_t)l * D * D);
    EpiOutproj E; E.X = ws + W_X; E.Xin = (l == 0) ? PIN(I_X) : (const float*)(ws + W_X); E.modv = ws + W_MOD + (size_t)l * 2 * 6144;
    pg8::gemm_phase((PG8_LAS unsigned char*)lds, D, (size_t)128 * D * 2, S, E);
    if (l < NLAYER - 1) {
        CtxSplitSched S2; S2.first = bid; S2.step = gridDim.x; S2.A = S.A; S2.Bt = S.Bt;
        EpiCtxPart E2; E2.PART = ws + W_PART; E2.g1 = ws + W_MOD + (size_t)(l * 2 + 1) * 6144 + 2 * D;
        pg8::gemm_phase((PG8_LAS unsigned char*)lds, D, (size_t)128 * D * 2, S2, E2, 4);
    }
}

constexpr int R_LDS = 1024 * 36 * 4;
__device__ void phase_router(const Params& p, int l, char* lds) {
    float* const ws = (float*)(gfloat_t*)tab_ld(N_IN);
    const float* const pin_I_NFFN = PIN(I_NFFN);
    const float* const pin_I_RB = PIN(I_RB);
    const float* const pin_I_RW = PIN(I_RW);
    const int tid = tid_(), bid = bid_();
    float* wl = (float*)lds;
    int* hist = (int*)(lds + R_LDS); int* bbase = hist + 32; int* tinfo = hist + 64 + (tid >> 6) * 40;
    __attribute__((address_space(3))) float* wsc = (__attribute__((address_space(3))) float*)((__attribute__((address_space(3))) char*)g_lds + RSC_OFF) + (tid >> 6) * 96;
    if (tid < 32) hist[tid] = 0;
    {   const float* rw = pin_I_RW + (size_t)l * D * NEXP;
        for (int i = tid; i < 1024 * 8; i += NTHR) { const int k = i >> 3, e4 = i & 7; *(f32x4*)(wl + k * 36 + e4 * 4) = *(const f32x4*)(rw + k * 32 + e4 * 4); }
    }
    __syncthreads();
    const int lane = tid & 63, gw = bid * (NTHR / 64) + __builtin_amdgcn_readfirstlane(tid >> 6), nw = gridDim.x * (NTHR / 64);
    const float* g = pin_I_NFFN + l * D;
    int* cnt = (int*)(ws + W_CNT) + l * NEXP * 64;
    unsigned char* HB = (unsigned char*)(ws + W_HB);
    const int e = lane >> 1;
    const float rb = pin_I_RB[l * NEXP + e];
    const int TL = (l == NLAYER - 1) ? NLAT : T;
    int ti = 0;
    for (int t0 = gw; t0 < TL; t0 += 2 * nw, ti += 2) {
        const int t1 = t0 + nw; const bool v1 = t1 < TL; const int t1c = v1 ? t1 : t0;
        const float* mod = ws + W_MOD + (size_t)(l * 2 + (t0 >= NLAT ? 1 : 0)) * 6144;
        float f0[16], f1[16]; float ss0 = 0.f, ss1 = 0.f;
#pragma unroll
        for (int m = 0; m < 16; ++m) { f0[m] = ws[W_X + (size_t)t0 * D + lane + 64 * m]; f1[m] = ws[W_X + (size_t)t1c * D + lane + 64 * m]; }
        if (t0 >= NLAT) {
#pragma unroll
            for (int m = 0; m < 16; ++m) { const size_t o0 = (size_t)(t0 - NLAT) * D + lane + 64 * m, o1 = (size_t)(t1c - NLAT) * D + lane + 64 * m;
#pragma unroll
                for (int ks = 0; ks < 4; ++ks) { f0[m] += ws[W_PART + (size_t)ks * NCTX * D + o0]; f1[m] += ws[W_PART + (size_t)ks * NCTX * D + o1]; }
                ws[W_X + (size_t)t0 * D + lane + 64 * m] = f0[m]; if (v1) ws[W_X + (size_t)t1 * D + lane + 64 * m] = f1[m]; }
        }
#pragma unroll
        for (int m = 0; m < 16; ++m) { ss0 = fmaf(f0[m], f0[m], ss0); ss1 = fmaf(f1[m], f1[m], ss1); }
#pragma unroll
        for (int o = 32; o > 0; o >>= 1) { ss0 += __shfl_xor(ss0, o); ss1 += __shfl_xor(ss1, o); }
        const float r0 = rsqrtf(ss0 * (1.f / D) + EPS), r1 = rsqrtf(ss1 * (1.f / D) + EPS);
#pragma unroll
        for (int m = 0; m < 16; ++m) { const int k = lane + 64 * m; const float gkm = g[k] * (1.f + mod[4 * D + k]), shm = mod[3 * D + k]; f0[m] = f0[m] * r0 * gkm + shm; f1[m] = f1[m] * r1 * gkm + shm;
            const int q8 = __builtin_amdgcn_cvt_pk_fp8_f32(f0[m] * A8_SCALE, f1[m] * A8_SCALE, 0, false);
            HB[(size_t)t0 * D + k] = (unsigned char)q8; if (v1) HB[(size_t)t1 * D + k] = (unsigned char)(q8 >> 8); }
        float acc0[32], acc1[32];
#pragma unroll
        for (int j = 0; j < 32; ++j) { acc0[j] = 0.f; acc1[j] = 0.f; }
#pragma unroll
        for (int m = 0; m < 16; ++m) {
            const float* wr = wl + (lane + 64 * m) * 36;
#pragma unroll
            for (int e4 = 0; e4 < 8; ++e4) { const f32x4 w4 = *(const f32x4*)(wr + e4 * 4);
#pragma unroll
                for (int j = 0; j < 4; ++j) { acc0[e4 * 4 + j] = fmaf(f0[m], w4[j], acc0[e4 * 4 + j]); acc1[e4 * 4 + j] = fmaf(f1[m], w4[j], acc1[e4 * 4 + j]); } }
            __builtin_amdgcn_sched_barrier(0);
        }
#define RS_STEP(W_, MSK_) do { const bool up = (lane & (MSK_)) != 0; \
            _Pragma("unroll") for (int j = 0; j < (W_); ++j) { const float s0_ = up ? acc0[j] : acc0[j + (W_)], k0_ = up ? acc0[j + (W_)] : acc0[j]; acc0[j] = k0_ + __shfl_xor(s0_, (MSK_)); \
                const float s1_ = up ? acc1[j] : acc1[j + (W_)], k1_ = up ? acc1[j + (W_)] : acc1[j]; acc1[j] = k1_ + __shfl_xor(s1_, (MSK_)); } } while (0)
        RS_STEP(16, 32); RS_STEP(8, 16); RS_STEP(4, 8); RS_STEP(2, 4); RS_STEP(1, 2);
#undef RS_STEP
        const float a0 = acc0[0] + __shfl_xor(acc0[0], 1) + rb, a1 = acc1[0] + __shfl_xor(acc1[0], 1) + rb;
        if ((lane & 1) == 0) { wsc[e] = a0; wsc[48 + e] = a1; }
        asm volatile("s_waitcnt lgkmcnt(0)" ::: "memory"); __builtin_amdgcn_wave_barrier();
        int rank0 = 0, rank1 = 0;
#pragma unroll
        for (int q = 0; q < 8; ++q) { const f32x4 x0 = *(const volatile __attribute__((address_space(3))) f32x4*)(wsc + 4 * q), x1 = *(const volatile __attribute__((address_space(3))) f32x4*)(wsc + 48 + 4 * q);
#pragma unroll
            for (int j = 0; j < 4; ++j) { const int eo = 4 * q + j;
                rank0 += (x0[j] > a0 || (x0[j] == a0 && eo < e)) ? 1 : 0; rank1 += (x1[j] > a1 || (x1[j] == a1 && eo < e)) ? 1 : 0; } }
        if ((lane & 1) == 0) {
            if (rank0 < 4) { ((__attribute__((address_space(3))) int*)wsc)[32 + rank0] = e; wsc[36 + rank0] = a0; }
            if (rank1 < 4) { ((__attribute__((address_space(3))) int*)wsc)[80 + rank1] = e; wsc[84 + rank1] = a1; }
        }
        asm volatile("s_waitcnt lgkmcnt(0)" ::: "memory"); __builtin_amdgcn_wave_barrier();
        if (lane < 8 && (lane < 4 || v1)) {
            const int u = lane >> 2, k = lane & 3, tt = u ? t1 : t0;
            const volatile __attribute__((address_space(3))) float* sv = wsc + u * 48;
            const float mx = sv[36];
            const float sm = expf(sv[36] - mx) + expf(sv[37] - mx) + expf(sv[38] - mx) + expf(sv[39] - mx);
            const int ee = ((const volatile __attribute__((address_space(3))) int*)sv)[32 + k]; const float eg = expf(sv[36 + k] - mx);
            const int lidx = atomicAdd(&hist[ee], 1);
            tinfo[(ti + u) * 4 + k] = (ee << 16) | lidx;
            ((int*)(ws + W_TOPE))[tt * 4 + k] = ee;
            ws[W_TOPG + tt * 4 + k] = eg / sm;
        }
        __builtin_amdgcn_wave_barrier();
    }
    __syncthreads();
    if (tid < 32) bbase[tid] = atomicAdd(&cnt[tid * 64], hist[tid]);
    __syncthreads();
    ti = 0;
    for (int t = gw; t < TL; t += nw, ++ti)
        if (lane < 4) { const int v = tinfo[ti * 4 + lane]; const int slot = bbase[v >> 16] + (v & 0xffff);
            ((int*)(ws + W_TOPI))[t * 4 + lane] = slot; ((int*)(ws + W_XS))[(size_t)(v >> 16) * T + slot] = t; }
    __syncthreads();
    conv_moe(p, l, 0);
}

DEVI void moe_bases(const Params& p, int l, int* sb) {
    float* const ws = (float*)(gfloat_t*)tab_ld(N_IN);
    const int tid = tid_();
    if (tid == 0) {
        const int* cnt = (const int*)(ws + W_CNT) + l * NEXP * 64;
        int b = 0, tb = 0;
        for (int e = 0; e < NEXP; ++e) { sb[e] = b; sb[40 + e] = tb; const int c = cnt[e * 64]; sb[80 + e] = c; const int mt = (c + 255) / 256; b += mt * 256; tb += mt; }
        sb[32] = b; sb[72] = tb;
    }
    __syncthreads();
}


struct MoeSched {
    UnitRange ur; const int* sb; int ntn; const char* A; const char* Bt; size_t bstride_e, bstride_tn, arow; const int* lists;
    DEVI bool next(int i, pg8::Unit& u) const {
        const int id = ur.lo + i * ur.step; if (id >= ur.hi) return false;
        int e = 0; while (e < NEXP - 1 && sb[40 + e + 1] * ntn <= id) ++e;
        const int mts = sb[40 + e + 1] - sb[40 + e], loc = id - sb[40 + e] * ntn, tng = loc / (mts * 4), rr = loc % (mts * 4), mt = rr >> 2, tn = tng * 4 + (rr & 3);
        const int r0 = __builtin_amdgcn_readfirstlane(sb[e] + mt * 256), tn_s = __builtin_amdgcn_readfirstlane(tn), e_s = __builtin_amdgcn_readfirstlane(e);
        u.a = A + (size_t)r0 * arow; u.b = Bt + (size_t)e_s * bstride_e + (size_t)tn_s * bstride_tn; u.x0 = r0; u.x1 = tn_s; u.x2 = e_s;
        const int mt_s = __builtin_amdgcn_readfirstlane(mt), cnt_s = __builtin_amdgcn_readfirstlane(sb[80 + e]);
        u.g = lists ? lists + (size_t)e_s * T + mt_s * 256 : nullptr; u.gn = cnt_s - mt_s * 256 < 256 ? cnt_s - mt_s * 256 : 256; return true;
    }
};
struct EpiMoe1 { static constexpr bool PERM = true; unsigned char* ACT; const float* bias;
    DEVI void operator()(const f32x4 (&acc)[2][2][4][2], const pg8::Unit& u, int wr, int wc, int fr, int fq) const {
        const int c0 = u.x1 * 128 + wc * 32 + 8 * fq;
        const float* bg = bias + (size_t)u.x2 * 2048 + c0; const float* bu = bg + 1024;
        f32x4 vg[2], vu[2];
#pragma unroll
        for (int n = 0; n < 2; ++n) { vg[n] = *(const f32x4*)(bg + 4 * n); vu[n] = *(const f32x4*)(bu + 4 * n); }
#pragma unroll
        for (int ai = 0; ai < 2; ++ai)
#pragma unroll
            for (int m = 0; m < 4; ++m) { unsigned char* rowp = ACT + (size_t)(u.x0 + ai * 128 + wr * 64 + m * 16 + fr) * D + c0;
                float a[8];
#pragma unroll
                for (int n = 0; n < 2; ++n)
#pragma unroll
                    for (int j = 0; j < 4; ++j) { float g = acc[ai][0][m][n][j] * INV8 + vg[n][j], uu = acc[ai][1][m][n][j] * INV8 + vu[n][j];
                        g = fminf(g, 7.f); uu = fminf(fmaxf(uu, -7.f), 7.f); a[n * 4 + j] = (uu + 1.f) * (g * sigm(1.702f * g)) * A8_SCALE; }
                u32x2 w; w.x = pk_fp8x4(a[0], a[1], a[2], a[3]); w.y = pk_fp8x4(a[4], a[5], a[6], a[7]);
                *(u32x2*)rowp = w; }
    }
};
__device__ void phase_moe1(const Params& p, int l, char* lds) {
    float* const ws = (float*)(gfloat_t*)tab_ld(N_IN);
    const float* const pin_I_BGU = PIN(I_BGU);
    const int tid = tid_(), bid = bid_(); (void)tid;
    int* sb = (int*)(lds + pg8::STAGE_BYTES);
    moe_bases(p, l, sb);
    MoeSched S; S.sb = sb; S.ntn = 8; S.ur = unit_range(sb[72] * 8, bid); S.A = (const char*)(ws + W_HB); S.arow = (size_t)D; S.lists = (const int*)(ws + W_XS);
    S.Bt = (const char*)(ws + W_WGU) + (size_t)l * NEXP * 2048 * D; S.bstride_e = (size_t)2048 * D; S.bstride_tn = (size_t)128 * D;
    EpiMoe1 E; E.ACT = (unsigned char*)(ws + W_ACT); E.bias = pin_I_BGU + (size_t)l * NEXP * 2048;
    pg8::gemm_phase<EpiMoe1, MoeSched, true, true>((PG8_LAS unsigned char*)lds, D / 2, (size_t)1024 * D, S, E, 0, (const char*)(ws + W_HB));
    __syncthreads();
}

struct EpiMoe2 { static constexpr bool PERM = true; bf16_t* YR; const float* bias;
    DEVI void operator()(const f32x4 (&acc)[2][2][4][2], const pg8::Unit& u, int wr, int wc, int fr, int fq) const {
        const int c0 = u.x1 * 256 + wc * 32 + 8 * fq;
        const float* bb = bias + (size_t)u.x2 * D + c0;
        f32x4 bv[2][2];
#pragma unroll
        for (int bj = 0; bj < 2; ++bj)
#pragma unroll
            for (int n = 0; n < 2; ++n) bv[bj][n] = *(const f32x4*)(bb + bj * 128 + 4 * n);
#pragma unroll
        for (int ai = 0; ai < 2; ++ai)
#pragma unroll
            for (int m = 0; m < 4; ++m) { bf16_t* rowp = YR + (size_t)(u.x0 + ai * 128 + wr * 64 + m * 16 + fr) * D + c0;
#pragma unroll
                for (int bj = 0; bj < 2; ++bj) { const f32x4 v0 = acc[ai][bj][m][0] * INV8 + bv[bj][0], v1 = acc[ai][bj][m][1] * INV8 + bv[bj][1];
                    u32x4 w; w.x = cvt_pk_bf16(v0[0], v0[1]); w.y = cvt_pk_bf16(v0[2], v0[3]); w.z = cvt_pk_bf16(v1[0], v1[1]); w.w = cvt_pk_bf16(v1[2], v1[3]);
                    *(u32x4*)(rowp + bj * 128) = w; } }
    }
};
__device__ void phase_moe2(const Params& p, int l, char* lds) {
    float* const ws = (float*)(gfloat_t*)tab_ld(N_IN);
    const float* const pin_I_BDN = PIN(I_BDN);
    const int tid = tid_(), bid = bid_(); (void)tid;
    int* sb = (int*)(lds + pg8::STAGE_BYTES);
    moe_bases(p, l, sb);
    MoeSched S; S.sb = sb; S.ntn = 4; S.ur = unit_range(sb[72] * 4, bid); S.A = (const char*)(ws + W_ACT); S.arow = (size_t)D; S.lists = nullptr;
    S.Bt = (const char*)(ws + W_WDN) + (size_t)l * NEXP * D * D; S.bstride_e = (size_t)D * D; S.bstride_tn = (size_t)256 * D;
    EpiMoe2 E; E.YR = (bf16_t*)(ws + W_YR); E.bias = pin_I_BDN + (size_t)l * NEXP * D;
    pg8::gemm_phase<EpiMoe2, MoeSched, false, true>((PG8_LAS unsigned char*)lds, D / 2, (size_t)128 * D, S, E);
    __syncthreads();
}

DEVI void norm1_store8(float* ws, const float* g, int l, int t, int lane, const float (&v)[2][8]) {
    const float* mod = ws + W_MOD + (size_t)(l * 2 + (t >= NLAT ? 1 : 0)) * 6144;
    float ss = 0.f;
#pragma unroll
    for (int jj = 0; jj < 2; ++jj)
#pragma unroll
        for (int i = 0; i < 8; ++i) ss = fmaf(v[jj][i], v[jj][i], ss);
    const float rstd = rsqrtf(wave_sum(ss) * (1.f / D) + EPS);
    bf16_t* hb = (bf16_t*)(ws + W_HB) + (size_t)t * D;
#pragma unroll
    for (int jj = 0; jj < 2; ++jj) {
        const int c = jj * 512 + lane * 8;
        float o[8];
#pragma unroll
        for (int q = 0; q < 2; ++q) { const f32x4 gg = *(const f32x4*)(g + c + 4 * q), s1 = *(const f32x4*)(mod + D + c + 4 * q), s0 = *(const f32x4*)(mod + c + 4 * q);
#pragma unroll
            for (int i = 0; i < 4; ++i) o[4 * q + i] = v[jj][4 * q + i] * rstd * gg[i] * (1.f + s1[i]) + s0[i]; }
        u32x4 w; w.x = cvt_pk_bf16(o[0], o[1]); w.y = cvt_pk_bf16(o[2], o[3]); w.z = cvt_pk_bf16(o[4], o[5]); w.w = cvt_pk_bf16(o[6], o[7]);
        *(u32x4*)(hb + c) = w;
    }
}
__device__ void phase_combine(const Params& p, int l, char* lds, bool last) {
    float* const ws = (float*)(gfloat_t*)tab_ld(N_IN);
    float* const pout = (float*)(gfloat_t*)tab_ld(N_IN + 1);
    const float* const pin_I_NMIX = PIN(I_NMIX);
    const int tid = tid_(), bid = bid_();
    const bf16_t* YR = (const bf16_t*)(ws + W_YR);
    int* sb = (int*)(lds + G_LDS);
    moe_bases(p, l, sb);
    const int lane = tid & 63, gw = bid * (NTHR / 64) + __builtin_amdgcn_readfirstlane(tid >> 6), nw = gridDim.x * (NTHR / 64);
    const int TL = last ? NLAT : T;
    const float* gn = pin_I_NMIX + (last ? 0 : (l + 1) * D);
    for (int t0 = gw; t0 < TL; t0 += 2 * nw) {
        const int t1 = t0 + nw; const bool v1 = t1 < TL; const int t1c = v1 ? t1 : t0;
        const float* g2 = ws + W_MOD + (size_t)(l * 2 + (t0 >= NLAT ? 1 : 0)) * 6144 + 5 * D;
        const bf16_t* ya[4]; const bf16_t* yb[4]; float ga[4], gb[4];
#pragma unroll
        for (int k = 0; k < 4; ++k) { ya[k] = YR + (size_t)(sb[((const int*)(ws + W_TOPE))[t0 * 4 + k]] + ((const int*)(ws + W_TOPI))[t0 * 4 + k]) * D; ga[k] = ws[W_TOPG + t0 * 4 + k];
                                      yb[k] = YR + (size_t)(sb[((const int*)(ws + W_TOPE))[t1c * 4 + k]] + ((const int*)(ws + W_TOPI))[t1c * 4 + k]) * D; gb[k] = ws[W_TOPG + t1c * 4 + k]; }
        float* xa = ws + W_X + (size_t)t0 * D; float* xb = ws + W_X + (size_t)t1c * D;
        float ra[2][8], rb[2][8];
#pragma unroll
        for (int jj = 0; jj < 2; ++jj) {
            const int c = jj * 512 + lane * 8;
            u32x4 ua[4], ub[4];
#pragma unroll
            for (int k = 0; k < 4; ++k) { ua[k] = *(const u32x4*)(ya[k] + c); ub[k] = *(const u32x4*)(yb[k] + c); }
            const f32x4 xa0 = *(const f32x4*)(xa + c), xa1 = *(const f32x4*)(xa + c + 4), xb0 = *(const f32x4*)(xb + c), xb1 = *(const f32x4*)(xb + c + 4);
            const f32x4 gg0 = *(const f32x4*)(g2 + c), gg1 = *(const f32x4*)(g2 + c + 4);
            float a[8], b[8];
#pragma unroll
            for (int i = 0; i < 8; ++i) { a[i] = 0.f; b[i] = 0.f; }
#pragma unroll
            for (int k = 0; k < 4; ++k)
#pragma unroll
                for (int q = 0; q < 4; ++q) { const unsigned wa = ua[k][q], wb = ub[k][q];
                    a[2 * q] = fmaf(ga[k], __uint_as_float(wa << 16), a[2 * q]); a[2 * q + 1] = fmaf(ga[k], __uint_as_float(wa & 0xffff0000u), a[2 * q + 1]);
                    b[2 * q] = fmaf(gb[k], __uint_as_float(wb << 16), b[2 * q]); b[2 * q + 1] = fmaf(gb[k], __uint_as_float(wb & 0xffff0000u), b[2 * q + 1]); }
#pragma unroll
            for (int i = 0; i < 4; ++i) { ra[jj][i] = fmaf(gg0[i], a[i], xa0[i]); ra[jj][4 + i] = fmaf(gg1[i], a[4 + i], xa1[i]); rb[jj][i] = fmaf(gg0[i], b[i], xb0[i]); rb[jj][4 + i] = fmaf(gg1[i], b[4 + i], xb1[i]); }
            float* da = last ? pout + (size_t)t0 * D + c : xa + c; float* db = last ? pout + (size_t)t1c * D + c : xb + c;
            *(f32x4*)da = (f32x4){ra[jj][0], ra[jj][1], ra[jj][2], ra[jj][3]}; *(f32x4*)(da + 4) = (f32x4){ra[jj][4], ra[jj][5], ra[jj][6], ra[jj][7]};
            if (v1) { *(f32x4*)db = (f32x4){rb[jj][0], rb[jj][1], rb[jj][2], rb[jj][3]}; *(f32x4*)(db + 4) = (f32x4){rb[jj][4], rb[jj][5], rb[jj][6], rb[jj][7]}; }
        }
        if (!last) { norm1_store8(ws, gn, l + 1, t0, lane, ra); if (v1) norm1_store8(ws, gn, l + 1, t1, lane, rb); }
    }
}

constexpr int XST_OFF = R_LDS + 2048 - 16, STAMP_OFF = R_LDS + 2048 - 16 - 256;
constexpr int LDS_BYTES = RSC_OFF + 8 * 96 * 4;

#define XB_TMO      128
#define XB_XCNT(j)  (256  + 64 * (j))
#define XB_XSUB(j)  (1280 + 64 * (j))
#define XB_XGEN(j)  (2304 + 64 * (j))
#define XB_TOP      3328
#define XB_TOPGEN   3392
#define XCD_BAR_WORDS 3456
#define XB_SPIN_CAP (1u << 18)
#define LAS __attribute__((address_space(3)))
__device__ __forceinline__ unsigned xb_ld(unsigned* p)              { return __hip_atomic_load(p, __ATOMIC_RELAXED, __HIP_MEMORY_SCOPE_AGENT); }
__device__ __forceinline__ unsigned xb_add(unsigned* p, unsigned v) { return __hip_atomic_fetch_add(p, v, __ATOMIC_RELAXED, __HIP_MEMORY_SCOPE_AGENT); }
__device__ __forceinline__ unsigned xb_xcc_id() { return (unsigned)__builtin_amdgcn_s_getreg((3 << 11) | 20) & 0xFu; }
#define XB_SPIN(cond, bar) do { unsigned _sp = 0; while (cond) { __builtin_amdgcn_s_sleep(1); \
    if ((++_sp & 255u) == 0u) { if (xb_ld(&(bar)[XB_TMO])) break; if (_sp > XB_SPIN_CAP) { atomicAdd(&(bar)[XB_TMO], 1u); break; } } } } while (0)
struct XcdBarrier { unsigned* bar; unsigned x; volatile LAS unsigned* st; };
__device__ __forceinline__ XcdBarrier xcd_barrier_post(unsigned* bar, volatile LAS unsigned* st) {
    XcdBarrier b; b.bar = bar; b.x = xb_xcc_id(); b.st = st;
    if (threadIdx.x == 0) (void)xb_add(&bar[XB_XCNT(b.x)], 1u);
    return b;
}
__device__ __forceinline__ void xcd_barrier_complete(unsigned* bar, unsigned x, unsigned& nloc, unsigned& nx) {
    const unsigned G = gridDim.x * gridDim.y * gridDim.z;
    unsigned sum, cnt, mine, sp = 0u;
    for (;;) {
        sum = 0u; cnt = 0u; mine = 0u;
#pragma unroll
        for (unsigned j = 0; j < 16; ++j) { const unsigned c = xb_ld(&bar[XB_XCNT(j)]); sum += c; cnt += (c > 0u) ? 1u : 0u; mine = (j == x) ? c : mine; }
        if (sum == G) break;
        __builtin_amdgcn_s_sleep(1);
        if ((++sp & 255u) == 0u) { if (xb_ld(&bar[XB_TMO])) break; if (sp > XB_SPIN_CAP) { atomicAdd(&bar[XB_TMO], 1u); break; } }
    }
    nloc = mine > 0u ? mine : 1u; nx = cnt > 0u ? cnt : 1u;
}
__device__ __noinline__ void xcd_barrier(const XcdBarrier b, const int tid) {
    asm volatile("s_waitcnt vmcnt(0)" ::: "memory");
    __syncthreads();
    if (tid == 0) {
        unsigned* bar = b.bar;
        __builtin_amdgcn_s_waitcnt(0);
        unsigned nloc = b.st[0], nx = b.st[1];
        if (nloc == 0u) { xcd_barrier_complete(bar, b.x, nloc, nx); b.st[0] = nloc; b.st[1] = nx; }
        const unsigned old = xb_add(&bar[XB_XSUB(b.x)], 1u);
        const unsigned gen = old / nloc;
        if (old + 1u == (gen + 1u) * nloc) {
            __builtin_amdgcn_fence(__ATOMIC_RELEASE, "agent");
            asm volatile("s_waitcnt vmcnt(0)" ::: "memory");
            const unsigned og = xb_add(&bar[XB_TOP], 1u);
            const unsigned tg = og / nx;
            if (og + 1u == (tg + 1u) * nx) xb_add(&bar[XB_TOPGEN], 1u);
            else XB_SPIN(xb_ld(&bar[XB_TOPGEN]) == tg, bar);
            __builtin_amdgcn_fence(__ATOMIC_ACQUIRE, "agent");
            xb_add(&bar[XB_XGEN(b.x)], 1u);
            asm volatile("s_waitcnt vmcnt(0)" ::: "memory");
        } else {
            XB_SPIN(xb_ld(&bar[XB_XGEN(b.x)]) == gen, bar);
            __builtin_amdgcn_fence(__ATOMIC_ACQUIRE, "agent");
            asm volatile("s_waitcnt vmcnt(0)" ::: "memory");
        }
    }
    __syncthreads();
}

constexpr int PROBE_IDX = -1, PROBE_END = -1, PROBE_DIV = 10;
constexpr int REP_NORM = 1, REP_INPROJ = 1, REP_PREP1 = 1, REP_SMALL = 1, REP_ATTN = 1, REP_FIN = 1, REP_MOE1 = 1, REP_MOE2 = 1, REP_SYNC = 1, REP_CONV = 1;
__global__ void __launch_bounds__(NTHR) fwd_kernel(Params p) {
    cg::grid_group grid = cg::this_grid();
    char* lds = g_lds;
    float* smem = (float*)lds;
    if (threadIdx.x == 0) {
        unsigned long long* tab = (unsigned long long*)(lds + TAB_OFF);
#pragma unroll
        for (int i = 0; i < N_IN; ++i) tab[i] = (unsigned long long)p.in[i];
        tab[N_IN] = (unsigned long long)p.ws; tab[N_IN + 1] = (unsigned long long)p.out;
    }
    __syncthreads();
    volatile LAS unsigned* xst = (volatile LAS unsigned*)(lds + XST_OFF);
    if (threadIdx.x < 4) xst[threadIdx.x] = 0u;
    if (blockIdx.x == 0) for (int i = threadIdx.x; i < 4096; i += NTHR) ((unsigned*)(p.ws + W_BAR))[i] = 0u;
    for (int r = 0; r < REP_CONV; ++r) phase_convert(p);
    phase_tables(p);
    phase_mod(p, smem);
    grid.sync();
    XcdBarrier xbar = xcd_barrier_post((unsigned*)(p.ws + W_BAR), xst);
    unsigned long long* stamps = (unsigned long long*)(lds + STAMP_OFF); int nstamp = 0;
#define GSYNC() do { for (int r_ = 0; r_ < REP_SYNC; ++r_) { XcdBarrier b_ = xbar; unsigned long long bp_ = (unsigned long long)b_.bar; unsigned bx_ = b_.x; asm volatile("" : "+s"(bp_), "+s"(bx_)); b_.bar = (unsigned*)bp_; b_.x = bx_; xcd_barrier(b_, (int)threadIdx.x); } if (PROBE_IDX >= 0) { if (blockIdx.x == 0 && threadIdx.x == 0) stamps[nstamp] = __builtin_amdgcn_s_memrealtime(); ++nstamp; } } while (0)
    phase_init(p);
    GSYNC();
    for (int lv = 0; lv < NLAYER; ++lv) {
        int l = lv; asm volatile("" : "+s"(l));
        for (int r = 0; r < REP_INPROJ; ++r) phase_inproj(p, l, lds);
        GSYNC();
        for (int r = 0; r < REP_PREP1; ++r) phase_prep1(p, l);
        GSYNC();
        for (int r = 0; r < REP_SMALL; ++r) phase_small(p, l, lds);
        GSYNC();
        phase_prep2(p, l);
        GSYNC();
        for (int r = 0; r < REP_ATTN; ++r) phase_attn(p, l, lds);
        for (int r = 0; r < REP_FIN; ++r) phase_lru_fin(p, lds);
        GSYNC();
        phase_outproj(p, l, lds);
        GSYNC();
        phase_router(p, l, lds);
        GSYNC();
        for (int r = 0; r < REP_MOE1; ++r) phase_moe1(p, l, lds);
        GSYNC();
        for (int r = 0; r < REP_MOE2; ++r) phase_moe2(p, l, lds);
        GSYNC();
        phase_combine(p, l, lds, l == NLAYER - 1);
        if (l + 1 < NLAYER || PROBE_IDX >= 0) GSYNC();
    }
    if (PROBE_IDX >= 0 && blockIdx.x == 0 && threadIdx.x == 0) {
        const float us = (float)(stamps[PROBE_END < 0 ? PROBE_IDX + 1 : PROBE_END] - stamps[PROBE_IDX]) * 0.01f;
        ((float*)(gfloat_t*)tab_ld(N_IN + 1))[0] += 2.f + us / (float)PROBE_DIV;
    }
}

extern "C" void kernel_launch(void* const* d_in, const int* in_sizes, int n_in, void* d_out, int out_size, void* d_ws, size_t ws_size, hipStream_t stream) {
    static int grid_blocks = 0;
    if (!grid_blocks) {
        int dev = 0, cus = 0, per_cu = 0;
        (void)hipGetDevice(&dev);
        (void)hipDeviceGetAttribute(&cus, hipDeviceAttributeMultiprocessorCount, dev);
        if (hipFuncSetAttribute((const void*)fwd_kernel, hipFuncAttributeMaxDynamicSharedMemorySize, LDS_BYTES) != hipSuccess) fprintf(stderr, "kernel_launch: hipFuncSetAttribute failed\n");
        if (hipOccupancyMaxActiveBlocksPerMultiprocessor(&per_cu, fwd_kernel, NTHR, LDS_BYTES) != hipSuccess || per_cu < 1) { fprintf(stderr, "kernel_launch: occupancy query says %d\n", per_cu); per_cu = 1; }
        if (per_cu > 1) per_cu = 1;
        grid_blocks = cus * per_cu;
        if (ws_size < W_END * sizeof(float)) fprintf(stderr, "kernel_launch: workspace too small: %zu < %zu\n", ws_size, W_END * sizeof(float));
        if (n_in != N_IN) fprintf(stderr, "kernel_launch: n_in %d != %d\n", n_in, (int)N_IN);
    }
    Params p{};
    for (int i = 0; i < N_IN; ++i) p.in[i] = (const float*)d_in[i];
    p.out = (float*)d_out;
    p.ws = (float*)d_ws;
    void* args[] = {&p};
    hipError_t e = hipLaunchCooperativeKernel((void*)fwd_kernel, dim3(grid_blocks), dim3(NTHR), args, LDS_BYTES, stream);
    if (e != hipSuccess) fprintf(stderr, "cooperative launch failed: %s (grid %d)\n", hipGetErrorString(e), grid_blocks);
}
```
